# Optimizing an MI355X kernel written in HIP

```python
import math
import jax, jax.numpy as jnp
from jax import lax
import numpy as np

D_MODEL = 1024
BATCH = 4
SEQ = 4096
DEPTH = 2

PLE_DIM = 256
HEAD_DIM = 64
ROPE_THETA = 10000.0
Q_BLOCK = 128
NEG = -1e30
BIG = 1e30
EPS = 1e-6
H_A = 8
W_A = H_A * HEAD_DIM
FORGET_BIAS_MEAN = 4.0
H_B = 8
G_B = 2
W_B = H_B * HEAD_DIM
KV_B = G_B * HEAD_DIM
L_CMP = 32
CMP_STRIDE = 16
CMP_HIDDEN = 256
L_SEL = 64
TOP_N = 16
SEL_Q_BLOCK = 64
WINDOW = 512
H_C = 4
DH_C = HEAD_DIM
W_C = H_C * 2 * DH_C
N_BRANCH = 3
SPLIT_SIZES = (W_A, W_A, W_A, H_A, W_A,
               W_B, KV_B, KV_B, KV_B, KV_B, KV_B, KV_B, 3 * H_B, W_B,
               2 * H_C * DH_C, 2 * H_C * DH_C, W_C, W_C,
               N_BRANCH * D_MODEL)
N_IN = sum(SPLIT_SIZES)

kernel_name = 'hybrid_fox_nsa_diff_gated_merge'


def rmsnorm(x, g):
    xf = x.astype(jnp.float32)
    y = xf * lax.rsqrt(jnp.mean(xf * xf, axis=-1, keepdims=True) + EPS)
    return (y * g.astype(jnp.float32)).astype(x.dtype)


def rope(t, positions):
    half = t.shape[-1] // 2
    inv_freq = ROPE_THETA ** (-jnp.arange(half, dtype=jnp.float32) / half)
    ang = positions.astype(jnp.float32)[:, :, None, None] * inv_freq
    cos, sin = jnp.cos(ang), jnp.sin(ang)
    tf = t.astype(jnp.float32)
    t1, t2 = tf[..., :half], tf[..., half:]
    return jnp.concatenate([t1 * cos - t2 * sin, t2 * cos + t1 * sin], axis=-1).astype(t.dtype)


def split_cols(proj):
    points = np.cumsum(np.array(SPLIT_SIZES))[:-1].tolist()
    return jnp.split(proj, points, axis=-1)


def forgetting_attention(q, k, v, logf):
    B, S, H, Dh = q.shape
    nb = S // Q_BLOCK
    scale = Dh ** -0.5
    c = jnp.cumsum(logf, axis=1)
    c_keys = c.transpose(0, 2, 1)
    q_blocks = q.reshape(B, nb, Q_BLOCK, H, Dh).transpose(1, 0, 2, 3, 4)
    c_blocks = c.reshape(B, nb, Q_BLOCK, H).transpose(1, 0, 3, 2)
    kpos = jnp.arange(S)

    def block(args):
        n, qi, ci = args
        s = jnp.einsum('bqhd,bkhd->bhqk', qi, k, preferred_element_type=jnp.float32) * scale
        s = s + ci[..., None] - c_keys[:, :, None, :]
        qpos = n * Q_BLOCK + jnp.arange(Q_BLOCK)
        mask = kpos[None, :] <= qpos[:, None]
        prob = jax.nn.softmax(jnp.where(mask, s, NEG), axis=-1)
        return jnp.einsum('bhqk,bkhd->bqhd', prob.astype(v.dtype), v)

    out = lax.map(block, (jnp.arange(nb), q_blocks, c_blocks))
    return out.transpose(1, 0, 2, 3, 4).reshape(B, S, H, Dh)


def compress_blocks(t, pe, w1, b1, w2):
    B, S, G, Dh = t.shape
    n_c = (S - L_CMP) // CMP_STRIDE + 1
    idx = jnp.arange(n_c)[:, None] * CMP_STRIDE + jnp.arange(L_CMP)[None, :]
    blocks = t[:, idx] + pe[None, None, :, None, :]
    flat = blocks.transpose(0, 1, 3, 2, 4).reshape(B, n_c, G, L_CMP * Dh)
    hid = jax.nn.silu(flat @ w1 + b1)
    return hid @ w2


def nsa_attention(q, q_rot, k_cmp, v_cmp, k_sel, v_sel, k_win, v_win, gates):
    B, S, H, Dh = q.shape
    G = k_sel.shape[2]
    hpg = H // G
    scale = Dh ** -0.5
    n_c = k_cmp.shape[1]
    n_sel = S // L_SEL
    top_n = min(TOP_N, n_sel)
    t = jnp.arange(S)

    qg = q.reshape(B, S, G, hpg, Dh)
    s_c = jnp.einsum('bsghd,bcgd->bghsc', qg, k_cmp, preferred_element_type=jnp.float32) * scale
    c_end = jnp.arange(n_c) * CMP_STRIDE + L_CMP - 1
    mask_c = c_end[None, :] <= t[:, None]
    p_c = jax.nn.softmax(jnp.where(mask_c, s_c, NEG), axis=-1) * mask_c
    o_cmp = jnp.einsum('bghsc,bcgd->bsghd', p_c.astype(v_cmp.dtype), v_cmp).reshape(B, S, H, Dh)

    c_start = jnp.arange(n_c) * CMP_STRIDE
    j_start = jnp.arange(n_sel) * L_SEL
    cover = ((c_start[:, None] < j_start[None, :] + L_SEL)
             & (c_start[:, None] + L_CMP > j_start[None, :])).astype(jnp.float32)
    imp = jnp.einsum('bghsc,cj->bgsj', p_c, cover)
    jj = jnp.arange(n_sel)[None, :]
    tb = (t // L_SEL)[:, None]
    valid = jj <= tb
    forced = (jj == 0) | (jj == tb) | (jj == tb - 1)
    score = jnp.where(forced, BIG, jnp.where(valid, imp, -BIG))
    _, sel_idx = lax.top_k(score, top_n)

    ks_blk = k_sel.reshape(B, n_sel, L_SEL, G, Dh).transpose(0, 3, 1, 2, 4)
    vs_blk = v_sel.reshape(B, n_sel, L_SEL, G, Dh).transpose(0, 3, 1, 2, 4)
    nqb = S // SEL_Q_BLOCK
    q_sb = q_rot.reshape(B, nqb, SEL_Q_BLOCK, G, hpg, Dh).transpose(1, 0, 3, 2, 4, 5)
    idx_sb = sel_idx.reshape(B, G, nqb, SEL_Q_BLOCK, top_n).transpose(2, 0, 1, 3, 4)
    bi = jnp.arange(B)[:, None, None, None]
    gi = jnp.arange(G)[None, :, None, None]

    def sel_block(args):
        n, qi, ii = args
        kg = ks_blk[bi, gi, ii]
        vg = vs_blk[bi, gi, ii]
        s = jnp.einsum('bgqhd,bgqnld->bghqnl', qi, kg, preferred_element_type=jnp.float32) * scale
        kpos = ii[..., None] * L_SEL + jnp.arange(L_SEL)
        qpos = n * SEL_Q_BLOCK + jnp.arange(SEL_Q_BLOCK)
        mask = kpos <= qpos[None, None, :, None, None]
        s = jnp.where(mask[:, :, None], s, NEG).reshape(B, G, hpg, SEL_Q_BLOCK, top_n * L_SEL)
        prob = jax.nn.softmax(s, axis=-1).reshape(B, G, hpg, SEL_Q_BLOCK, top_n, L_SEL)
        return jnp.einsum('bghqnl,bgqnld->bqghd', prob.astype(vg.dtype), vg)

    o_sel = lax.map(sel_block, (jnp.arange(nqb), q_sb, idx_sb))
    o_sel = o_sel.transpose(1, 0, 2, 3, 4, 5).reshape(B, S, H, Dh)

    kw_pad = jnp.pad(k_win, ((0, 0), (WINDOW, 0), (0, 0), (0, 0)))
    vw_pad = jnp.pad(v_win, ((0, 0), (WINDOW, 0), (0, 0), (0, 0)))
    nwb = S // Q_BLOCK
    q_wb = q_rot.reshape(B, nwb, Q_BLOCK, G, hpg, Dh).transpose(1, 0, 2, 3, 4, 5)
    ii_ = jnp.arange(Q_BLOCK)[:, None]
    jw = jnp.arange(Q_BLOCK + WINDOW)[None, :]
    band = (jw > ii_) & (jw <= ii_ + WINDOW)

    def win_block(args):
        n, qi = args
        kk = lax.dynamic_slice_in_dim(kw_pad, n * Q_BLOCK, Q_BLOCK + WINDOW, axis=1)
        vv = lax.dynamic_slice_in_dim(vw_pad, n * Q_BLOCK, Q_BLOCK + WINDOW, axis=1)
        s = jnp.einsum('bqghd,bkgd->bghqk', qi, kk, preferred_element_type=jnp.float32) * scale
        mask = band & (n * Q_BLOCK + jw - WINDOW >= 0)
        prob = jax.nn.softmax(jnp.where(mask, s, NEG), axis=-1)
        return jnp.einsum('bghqk,bkgd->bqghd', prob.astype(vv.dtype), vv)

    o_win = lax.map(win_block, (jnp.arange(nwb), q_wb))
    o_win = o_win.transpose(1, 0, 2, 3, 4, 5).reshape(B, S, H, Dh)

    return gates[..., 0:1] * o_cmp + gates[..., 1:2] * o_sel + gates[..., 2:3] * o_win


def differential_attention(q, k, v, lam, lam_init, subln_g):
    B, S, H, _, Dh = q.shape
    nb = S // Q_BLOCK
    scale = Dh ** -0.5
    q_blocks = q.reshape(B, nb, Q_BLOCK, H, 2, Dh).transpose(1, 0, 2, 3, 4, 5)
    kpos = jnp.arange(S)

    def block(args):
        n, qi = args
        s = jnp.einsum('bqhmd,bkhmd->bhmqk', qi, k, preferred_element_type=jnp.float32) * scale
        qpos = n * Q_BLOCK + jnp.arange(Q_BLOCK)
        mask = kpos[None, :] <= qpos[:, None]
        prob = jax.nn.softmax(jnp.where(mask, s, NEG), axis=-1)
        w = prob[:, :, 0] - lam * prob[:, :, 1]
        return jnp.einsum('bhqk,bkhe->bqhe', w.astype(v.dtype), v)

    out = lax.map(block, (jnp.arange(nb), q_blocks))
    out = out.transpose(1, 0, 2, 3, 4).reshape(B, S, H, 2 * Dh)
    return rmsnorm(out, subln_g) * (1.0 - lam_init)


def setup_inputs(seed: int = 0) -> dict:
    key = jax.random.key(seed)
    ks = jax.random.split(key, 24)
    f32 = jnp.float32

    def nrm(k, shape, scale):
        return jax.random.normal(k, shape, f32) * scale

    x = nrm(ks[0], (BATCH, SEQ, D_MODEL), 1.0)
    p = nrm(ks[1], (DEPTH, BATCH, SEQ, PLE_DIM), 1.0)
    offset = jax.random.randint(ks[2], (BATCH, 1), 0, 1024, dtype=jnp.int32)
    positions = offset + jnp.arange(SEQ, dtype=jnp.int32)[None, :]
    return {
        'x': x,
        'p': p,
        'positions': positions,
        'norm_g': 1.0 + nrm(ks[3], (DEPTH, D_MODEL), 0.02),
        'w_in': nrm(ks[4], (DEPTH, D_MODEL, N_IN), D_MODEL ** -0.5),
        'b_forget': FORGET_BIAS_MEAN + nrm(ks[5], (DEPTH, H_A), 0.5),
        'cmp_pe_k': nrm(ks[6], (DEPTH, L_CMP, HEAD_DIM), 0.1),
        'cmp_w1_k': nrm(ks[7], (DEPTH, L_CMP * HEAD_DIM, CMP_HIDDEN), (L_CMP * HEAD_DIM) ** -0.5),
        'cmp_b1_k': nrm(ks[8], (DEPTH, CMP_HIDDEN), 0.01),
        'cmp_w2_k': nrm(ks[9], (DEPTH, CMP_HIDDEN, HEAD_DIM), CMP_HIDDEN ** -0.5),
        'cmp_pe_v': nrm(ks[10], (DEPTH, L_CMP, HEAD_DIM), 0.1),
        'cmp_w1_v': nrm(ks[11], (DEPTH, L_CMP * HEAD_DIM, CMP_HIDDEN), (L_CMP * HEAD_DIM) ** -0.5),
        'cmp_b1_v': nrm(ks[12], (DEPTH, CMP_HIDDEN), 0.01),
        'cmp_w2_v': nrm(ks[13], (DEPTH, CMP_HIDDEN, HEAD_DIM), CMP_HIDDEN ** -0.5),
        'diff_lam': nrm(ks[14], (DEPTH, 4, DH_C), 0.1),
        'diff_subln_g': 1.0 + nrm(ks[15], (DEPTH, 2 * DH_C), 0.02),
        'w_br_a': nrm(ks[16], (DEPTH, W_A, D_MODEL), W_A ** -0.5),
        'w_br_b': nrm(ks[17], (DEPTH, W_B, D_MODEL), W_B ** -0.5),
        'w_br_c': nrm(ks[18], (DEPTH, W_C, D_MODEL), W_C ** -0.5),
        'w_out': nrm(ks[19], (DEPTH, D_MODEL, D_MODEL), D_MODEL ** -0.5),
        'w_ple': nrm(ks[20], (DEPTH, PLE_DIM, D_MODEL), PLE_DIM ** -0.5),
        'w_ple_gate': nrm(ks[21], (DEPTH, D_MODEL, D_MODEL), D_MODEL ** -0.5),
        'final_g': 1.0 + nrm(ks[22], (D_MODEL,), 0.02),
    }


def reference(x, p, positions, norm_g, w_in, b_forget, cmp_pe_k, cmp_w1_k, cmp_b1_k, cmp_w2_k,
              cmp_pe_v, cmp_w1_v, cmp_b1_v, cmp_w2_v, diff_lam, diff_subln_g,
              w_br_a, w_br_b, w_br_c, w_out, w_ple, w_ple_gate, final_g):
    B, S, D = x.shape
    for i in range(DEPTH):
        h = rmsnorm(x, norm_g[i])
        proj = jnp.einsum('bsd,dn->bsn', h, w_in[i])
        (qa, ka, va, fa, za,
         qb, kcb, vcb, ksb, vsb, kwb, vwb, gb, zb,
         qc, kc, vc, zc, mg) = split_cols(proj)

        logf = jax.nn.log_sigmoid(fa.astype(jnp.float32) + b_forget[i].astype(jnp.float32))
        ya = forgetting_attention(qa.reshape(B, S, H_A, HEAD_DIM), ka.reshape(B, S, H_A, HEAD_DIM),
                                  va.reshape(B, S, H_A, HEAD_DIM), logf)
        ya = ya.reshape(B, S, W_A) * jax.nn.silu(za)

        qb = qb.reshape(B, S, H_B, HEAD_DIM)
        qb_rot = rope(qb, positions)
        k_cmp = compress_blocks(kcb.reshape(B, S, G_B, HEAD_DIM), cmp_pe_k[i], cmp_w1_k[i], cmp_b1_k[i], cmp_w2_k[i])
        v_cmp = compress_blocks(vcb.reshape(B, S, G_B, HEAD_DIM), cmp_pe_v[i], cmp_w1_v[i], cmp_b1_v[i], cmp_w2_v[i])
        k_sel = rope(ksb.reshape(B, S, G_B, HEAD_DIM), positions)
        k_win = rope(kwb.reshape(B, S, G_B, HEAD_DIM), positions)
        gates = jax.nn.sigmoid(gb.reshape(B, S, H_B, 3))
        yb = nsa_attention(qb, qb_rot, k_cmp, v_cmp, k_sel, vsb.reshape(B, S, G_B, HEAD_DIM),
                           k_win, vwb.reshape(B, S, G_B, HEAD_DIM), gates)
        yb = yb.reshape(B, S, W_B) * jax.nn.silu(zb)

        qc = rope(qc.reshape(B, S, 2 * H_C, DH_C), positions).reshape(B, S, H_C, 2, DH_C)
        kc = rope(kc.reshape(B, S, 2 * H_C, DH_C), positions).reshape(B, S, H_C, 2, DH_C)
        lam_init = 0.8 - 0.6 * math.exp(-0.3 * i)
        lq1, lk1, lq2, lk2 = diff_lam[i].astype(jnp.float32)
        lam = jnp.exp(jnp.sum(lq1 * lk1)) - jnp.exp(jnp.sum(lq2 * lk2)) + lam_init
        yc = differential_attention(qc, kc, vc.reshape(B, S, H_C, 2 * DH_C), lam, lam_init, diff_subln_g[i])
        yc = yc.reshape(B, S, W_C) * jax.nn.silu(zc)

        g = jax.nn.sigmoid(mg).reshape(B, S, N_BRANCH, D)
        merged = (g[:, :, 0] * (ya @ w_br_a[i]) + g[:, :, 1] * (yb @ w_br_b[i])
                  + g[:, :, 2] * (yc @ w_br_c[i]))
        x = x + merged @ w_out[i]

        x = x + jax.nn.sigmoid(x @ w_ple_gate[i]) * (p[i] @ w_ple[i])
    return rmsnorm(x, final_g)
```

```cpp
#include <hip/hip_runtime.h>
#include <cstdio>
#include <cstdint>

typedef unsigned short bf16;
typedef short bf16x8 __attribute__((ext_vector_type(8)));
typedef float f32x4 __attribute__((ext_vector_type(4)));
typedef float f32x16 __attribute__((ext_vector_type(16)));
typedef unsigned u32x4 __attribute__((ext_vector_type(4)));
typedef unsigned u32x2 __attribute__((ext_vector_type(2)));

constexpr int BATCH = 4, SEQ = 4096, DM = 1024, M = BATCH * SEQ, DEPTH = 2, NIN = 8992, NP = 6144;
constexpr float EPS = 1e-6f;
constexpr float LOG2E = 1.4426950408889634f;
constexpr float C2 = 0.125f * LOG2E;
constexpr size_t MiB = 1u << 20;
constexpr size_t OFF_CTL = 0;
constexpr size_t OFF_WIN = 1 * MiB, OFF_WMG = 13 * MiB, OFF_WBR = 19 * MiB, OFF_CW1 = 22 * MiB, OFF_CW2 = 24 * MiB, OFF_CB1 = 24 * MiB + 128 * 1024;
constexpr size_t OFF_WOUT = 25 * MiB, OFF_WPG = 29 * MiB, OFF_WPL = 33 * MiB;
constexpr size_t OFF_XB = 34 * MiB, OFF_ZA = 66 * MiB, OFF_ZB = 82 * MiB, OFF_ZC = 98 * MiB;
constexpr size_t OFF_COS = 114 * MiB, OFF_SIN = 116 * MiB, OFF_PB = 118 * MiB;
constexpr size_t OFF_LOGF = 134 * MiB, OFF_CF = 134 * MiB + 512 * 1024, OFF_GATES = 135 * MiB, OFF_SSP = 136 * MiB + 512 * 1024;
constexpr size_t OFF_KCMP = 136 * MiB + 768 * 1024, OFF_VCMP = 137 * MiB, OFF_SELM = 137 * MiB + 256 * 1024;
constexpr size_t OFF_QA = 139 * MiB, OFF_KA = 155 * MiB, OFF_VA = 171 * MiB, OFF_QB = 187 * MiB, OFF_QC = 203 * MiB, OFF_KC = 219 * MiB, OFF_VC = 235 * MiB;
constexpr size_t OFF_KCB = 251 * MiB, OFF_VCB = 255 * MiB, OFF_KSEL = 259 * MiB, OFF_KWIN = 263 * MiB, OFF_VSEL = 267 * MiB, OFF_VWIN = 271 * MiB;
constexpr size_t WS_NEED = 275 * MiB;
constexpr size_t OFF_G = 139 * MiB, OFF_MERGED = 171 * MiB, OFF_T = 203 * MiB, OFF_X1B = 203 * MiB, OFF_U = 139 * MiB;
constexpr int CTL_LAM = 64;

__device__ __forceinline__ bf16 f2bf(float f) { unsigned u = __float_as_uint(f); return (bf16)((u + 0x7fffu + ((u >> 16) & 1u)) >> 16); }
__device__ __forceinline__ float bf2f(bf16 h) { return __uint_as_float(((unsigned)h) << 16); }
__device__ __forceinline__ unsigned pk2(float lo, float hi) { return (unsigned)f2bf(lo) | ((unsigned)f2bf(hi) << 16); }
__device__ __forceinline__ float sigmoidf_(float x) { return 1.f / (1.f + __expf(-x)); }
__device__ __forceinline__ float siluf_(float x) { return x / (1.f + __expf(-x)); }
__device__ __forceinline__ float logsigmoidf_(float x) { return x >= 0.f ? -log1pf(expf(-x)) : x - log1pf(expf(x)); }

__device__ __forceinline__ int ktile_off(int s, int d) { return (s >> 6) * 4096 + (d >> 3) * 512 + (s & 63) * 8 + (d & 7); }
__device__ __forceinline__ int vtile_off(int s, int d) { return (s >> 6) * 4096 + (d >> 5) * 2048 + ((s & 63) >> 4) * 512 + (s & 15) * 32 + (d & 31); }
__device__ __forceinline__ int v128_off(int s, int d) { return (s >> 6) * 8192 + (d >> 5) * 2048 + ((s & 63) >> 4) * 512 + (s & 15) * 32 + (d & 31); }

template <int W> __device__ __forceinline__ void store_bf(bf16* dst, const float* v) {
    if constexpr (W == 4) { u32x2 o; o.x = pk2(v[0], v[1]); o.y = pk2(v[2], v[3]); *(u32x2*)dst = o; }
    else { u32x4 o; o.x = pk2(v[0], v[1]); o.y = pk2(v[2], v[3]); o.z = pk2(v[4], v[5]); o.w = pk2(v[6], v[7]); *(u32x4*)dst = o; }
}

__device__ __forceinline__ int win_srccol(int n) {
    const int seg = n >> 6, j = n & 63; const int il = ((j & 1) << 5) + (j >> 1);
    if (seg < 8) return 0 + n;
    if (seg < 16) return 512 + (n - 512);
    if (seg < 24) return 1024 + (n - 1024);
    if (seg < 32) return 1544 + (n - 1536);
    if (seg < 40) return 2056 + (seg - 32) * 64 + il;
    if (seg < 42) return 2568 + (n - 2560);
    if (seg < 44) return 2696 + (n - 2688);
    if (seg < 46) return 2824 + (seg - 44) * 64 + il;
    if (seg < 48) return 3080 + (seg - 46) * 64 + il;
    if (seg < 50) return 2952 + (n - 3072);
    if (seg < 52) return 3208 + (n - 3200);
    if (seg < 60) return 3360 + (n - 3328);
    if (seg < 68) return 3872 + (seg - 60) * 64 + il;
    if (seg < 76) return 4384 + (seg - 68) * 64 + il;
    if (seg < 84) return 4896 + (n - 4864);
    if (seg < 92) return 5408 + (n - 5376);
    if (seg == 92) { if (j < 8) return 1536 + j; if (j < 32) return 3336 + (j - 8); return -1; }
    return -1;
}

enum { EPI_INPROJ = 0, EPI_GATE = 1, EPI_BR0 = 2, EPI_BR1 = 3, EPI_BR2 = 4, EPI_OUT = 5, EPI_U = 6, EPI_PLE = 7 };
struct EpiCtx { unsigned char* ws; const float* bfg; const float* xin; float* X; int gi; };

__device__ __forceinline__ float row_rstd(const unsigned char* ws, int row) {
    const f32x4 sp = *(const f32x4*)(ws + OFF_SSP + (size_t)row * 16);
    return rsqrtf(((sp[0] + sp[1]) + (sp[2] + sp[3])) * (1.f / 1024.f) + EPS);
}
template <int W> __device__ __forceinline__ void rope_apply(const unsigned char* ws, int row, int d, float* v) {
    const float* cs = (const float*)(ws + OFF_COS) + (size_t)row * 32 + (d >> 1);
    const float* sn = (const float*)(ws + OFF_SIN) + (size_t)row * 32 + (d >> 1);
#pragma unroll
    for (int j = 0; j < W / 2; ++j) { const float c = cs[j], s = sn[j], x1 = v[2 * j], x2 = v[2 * j + 1]; v[2 * j] = x1 * c - x2 * s; v[2 * j + 1] = x2 * c + x1 * s; }
}

enum { T_QA = 0, T_KA, T_VA, T_ZA, T_QB, T_CB, T_KROPE, T_VSW, T_ZB, T_QC, T_KC, T_VC, T_ZC, T_SPECIAL };
__device__ __forceinline__ int inproj_type(int t) {
    return t < 2 ? T_QA : t < 4 ? T_KA : t < 6 ? T_VA : t < 8 ? T_ZA : t < 10 ? T_QB : t == 10 ? T_CB : t == 11 ? T_KROPE : t == 12 ? T_VSW : t < 15 ? T_ZB : t < 17 ? T_QC : t < 19 ? T_KC : t < 21 ? T_VC : t < 23 ? T_ZC : T_SPECIAL;
}
template <int T, int W> __device__ __forceinline__ void emit_inproj(const EpiCtx& E, int row, int col, const float* a) {
    unsigned char* ws = E.ws;
    const float rs = row_rstd(ws, row);
    float v[W];
#pragma unroll
    for (int i = 0; i < W; ++i) v[i] = a[i] * rs;
    const int b = row >> 12, s = row & 4095;
    if constexpr (T == T_QA) { const int cc = col, h = cc >> 6, d = cc & 63;
#pragma unroll
        for (int i = 0; i < W; ++i) v[i] *= C2;
        store_bf<W>((bf16*)(ws + OFF_QA) + ((size_t)(b * 8 + h) * 4096 + s) * 64 + d, v);
    } else if constexpr (T == T_KA) { const int cc = col - 512, h = cc >> 6, d = cc & 63;
        store_bf<W>((bf16*)(ws + OFF_KA) + (size_t)(b * 8 + h) * 262144 + ktile_off(s, d), v);
    } else if constexpr (T == T_VA) { const int cc = col - 1024, h = cc >> 6, d = cc & 63;
        store_bf<W>((bf16*)(ws + OFF_VA) + (size_t)(b * 8 + h) * 262144 + vtile_off(s, d), v);
    } else if constexpr (T == T_ZA || T == T_ZB || T == T_ZC) { const int cc = col - (T == T_ZA ? 1536 : T == T_ZB ? 3328 : 5376);
#pragma unroll
        for (int i = 0; i < W; ++i) v[i] = siluf_(v[i]);
        store_bf<W>((bf16*)(ws + (T == T_ZA ? OFF_ZA : T == T_ZB ? OFF_ZB : OFF_ZC)) + (size_t)row * 512 + cc, v);
    } else if constexpr (T == T_QB) { const int cc = col - 2048, h = cc >> 6, d = cc & 63;
#pragma unroll
        for (int i = 0; i < W; ++i) v[i] *= C2;
        store_bf<W>((bf16*)(ws + OFF_QB) + ((size_t)(b * 8 + h) * 4096 + s) * 64 + d, v);
    } else if constexpr (T == T_CB) { const int cc = col - 2560, g = (cc >> 6) & 1, d = cc & 63;
        store_bf<W>((bf16*)(ws + (cc < 128 ? OFF_KCB : OFF_VCB)) + ((size_t)(b * 2 + g) * 4096 + s) * 64 + d, v);
    } else if constexpr (T == T_KROPE) { const int cc = col - 2816, g = (cc >> 6) & 1, d = cc & 63;
        rope_apply<W>(ws, row, d, v);
        store_bf<W>((bf16*)(ws + (cc < 128 ? OFF_KSEL : OFF_KWIN)) + (size_t)(b * 2 + g) * 262144 + ktile_off(s, d), v);
    } else if constexpr (T == T_VSW) { const int cc = col - 3072, g = (cc >> 6) & 1, d = cc & 63;
        store_bf<W>((bf16*)(ws + (cc < 128 ? OFF_VSEL : OFF_VWIN)) + (size_t)(b * 2 + g) * 262144 + vtile_off(s, d), v);
    } else if constexpr (T == T_QC) { const int cc = col - 3840, h = cc >> 6, d = cc & 63;
        rope_apply<W>(ws, row, d, v);
#pragma unroll
        for (int i = 0; i < W; ++i) v[i] *= C2;
        store_bf<W>((bf16*)(ws + OFF_QC) + ((size_t)(b * 8 + h) * 4096 + s) * 64 + d, v);
    } else if constexpr (T == T_KC) { const int cc = col - 4352, h = cc >> 6, d = cc & 63;
        rope_apply<W>(ws, row, d, v);
        store_bf<W>((bf16*)(ws + OFF_KC) + (size_t)(b * 8 + h) * 262144 + ktile_off(s, d), v);
    } else if constexpr (T == T_VC) { const int cc = col - 4864, hc = cc >> 7, d = cc & 127;
        store_bf<W>((bf16*)(ws + OFF_VC) + (size_t)(b * 4 + hc) * 524288 + v128_off(s, d), v);
    } else { const int cc = col - 5888;
        if (cc < 8) { float* o = (float*)(ws + OFF_LOGF) + (size_t)row * 8 + cc;
#pragma unroll
            for (int i = 0; i < W; ++i) o[i] = logsigmoidf_(v[i] + E.bfg[cc + i]) * LOG2E;
        } else if (cc < 32) { float* o = (float*)(ws + OFF_GATES) + (size_t)row * 24 + (cc - 8);
#pragma unroll
            for (int i = 0; i < W; ++i) o[i] = sigmoidf_(v[i]);
        }
    }
}

template <int KIND, int W> __device__ __forceinline__ void emit(const EpiCtx& E, int row, int col, const float* a) {
    unsigned char* ws = E.ws;
    const size_t idx = (size_t)row * 1024 + col;
    if constexpr (KIND == EPI_GATE) {
        const float rs = row_rstd(ws, row); float v[W];
#pragma unroll
        for (int i = 0; i < W; ++i) v[i] = sigmoidf_(a[i] * rs);
        store_bf<W>((bf16*)(ws + OFF_G) + idx, v);
    } else if constexpr (KIND == EPI_BR0 || KIND == EPI_BR1 || KIND == EPI_BR2) {
        const bf16* g = (const bf16*)(ws + OFF_G) + idx; float* T = (float*)(ws + OFF_T) + idx; float v[W];
#pragma unroll
        for (int i = 0; i < W; ++i) { v[i] = bf2f(g[i]) * a[i]; if (KIND != EPI_BR0) v[i] += T[i]; }
        if constexpr (KIND == EPI_BR2) store_bf<W>((bf16*)(ws + OFF_MERGED) + idx, v);
        else {
#pragma unroll
            for (int i = 0; i < W; ++i) T[i] = v[i]; }
    } else if constexpr (KIND == EPI_OUT) {
        float v[W];
#pragma unroll
        for (int i = 0; i < W; ++i) { v[i] = E.xin[idx + i] + a[i]; E.X[idx + i] = v[i]; }
        store_bf<W>((bf16*)(ws + OFF_X1B) + idx, v);
    } else if constexpr (KIND == EPI_U) {
        float* U = (float*)(ws + OFF_U) + idx;
#pragma unroll
        for (int i = 0; i < W; ++i) U[i] = a[i];
    } else if constexpr (KIND == EPI_PLE) {
        const float* U = (const float*)(ws + OFF_U) + idx; float v[W];
#pragma unroll
        for (int i = 0; i < W; ++i) { v[i] = E.X[idx + i] + sigmoidf_(a[i]) * U[i]; E.X[idx + i] = v[i]; }
        store_bf<W>((bf16*)(ws + OFF_XB) + idx, v);
    }
}

template <int KIND> __global__ void __launch_bounds__(256) k_gemm(const bf16* __restrict__ A, const bf16* __restrict__ Bt, int K, EpiCtx E) {
    const int lane = threadIdx.x & 63, wid = threadIdx.x >> 6, r32 = lane & 31, hi = lane >> 5;
    const int m0 = blockIdx.y * 128 + (wid >> 1) * 64, n0 = blockIdx.x * 128 + (wid & 1) * 64;
    f32x16 acc[2][2];
#pragma unroll
    for (int i = 0; i < 2; ++i)
#pragma unroll
        for (int j = 0; j < 2; ++j)
#pragma unroll
            for (int r = 0; r < 16; ++r) acc[i][j][r] = 0.f;
    const bf16* Ap = A + (size_t)(m0 + r32) * K + 8 * hi;
    const bf16* Bp = Bt + (size_t)(n0 + r32) * K + 8 * hi;
    for (int k = 0; k < K; k += 16) {
        const bf16x8 a0 = *(const bf16x8*)(Ap + k), a1 = *(const bf16x8*)(Ap + (size_t)32 * K + k);
        const bf16x8 b0 = *(const bf16x8*)(Bp + k), b1 = *(const bf16x8*)(Bp + (size_t)32 * K + k);
        acc[0][0] = __builtin_amdgcn_mfma_f32_32x32x16_bf16(b0, a0, acc[0][0], 0, 0, 0);
        acc[0][1] = __builtin_amdgcn_mfma_f32_32x32x16_bf16(b0, a1, acc[0][1], 0, 0, 0);
        acc[1][0] = __builtin_amdgcn_mfma_f32_32x32x16_bf16(b1, a0, acc[1][0], 0, 0, 0);
        acc[1][1] = __builtin_amdgcn_mfma_f32_32x32x16_bf16(b1, a1, acc[1][1], 0, 0, 0);
    }
#define KG_LOOP(CALL) _Pragma("unroll") for (int jn = 0; jn < 2; ++jn) _Pragma("unroll") for (int im = 0; im < 2; ++im) _Pragma("unroll") for (int rq = 0; rq < 4; ++rq) { \
        float v[4] = {acc[jn][im][4 * rq], acc[jn][im][4 * rq + 1], acc[jn][im][4 * rq + 2], acc[jn][im][4 * rq + 3]}; \
        const int row = m0 + 32 * im + r32, col = n0 + 32 * jn + 8 * rq + 4 * hi; CALL; }
    if constexpr (KIND == EPI_INPROJ) {
        switch (inproj_type(n0 >> 8)) {
            case T_QA: KG_LOOP((emit_inproj<T_QA, 4>(E, row, col, v))) break;
            case T_KA: KG_LOOP((emit_inproj<T_KA, 4>(E, row, col, v))) break;
            case T_VA: KG_LOOP((emit_inproj<T_VA, 4>(E, row, col, v))) break;
            case T_ZA: KG_LOOP((emit_inproj<T_ZA, 4>(E, row, col, v))) break;
            case T_QB: KG_LOOP((emit_inproj<T_QB, 4>(E, row, col, v))) break;
            case T_CB: KG_LOOP((emit_inproj<T_CB, 4>(E, row, col, v))) break;
            case T_KROPE: KG_LOOP((emit_inproj<T_KROPE, 4>(E, row, col, v))) break;
            case T_VSW: KG_LOOP((emit_inproj<T_VSW, 4>(E, row, col, v))) break;
            case T_ZB: KG_LOOP((emit_inproj<T_ZB, 4>(E, row, col, v))) break;
            case T_QC: KG_LOOP((emit_inproj<T_QC, 4>(E, row, col, v))) break;
            case T_KC: KG_LOOP((emit_inproj<T_KC, 4>(E, row, col, v))) break;
            case T_VC: KG_LOOP((emit_inproj<T_VC, 4>(E, row, col, v))) break;
            case T_ZC: KG_LOOP((emit_inproj<T_ZC, 4>(E, row, col, v))) break;
            default: KG_LOOP((emit_inproj<T_SPECIAL, 4>(E, row, col, v))) break;
        }
    } else { KG_LOOP((emit<KIND, 4>(E, row, col, v))) }
#undef KG_LOOP
}

template <int MODE> __global__ void __launch_bounds__(256) k_convT(const float* __restrict__ src, int ld, int K, bf16* __restrict__ dst, const float* __restrict__ kscale) {
    __shared__ float tile[64][65];
    const int n0 = blockIdx.x * 64, k0 = blockIdx.y * 64, tx = threadIdx.x & 63, ty = threadIdx.x >> 6;
    const int n = n0 + tx;
    int sc;
    if (MODE == 0) sc = n; else if (MODE == 1) sc = win_srccol(n); else sc = (n & ~63) + ((n & 1) << 5) + ((n & 63) >> 1);
#pragma unroll 4
    for (int i = 0; i < 16; ++i) { const int kk = 4 * i + ty; float v = 0.f; if (sc >= 0) { v = src[(size_t)(k0 + kk) * ld + sc]; if (kscale) v *= kscale[k0 + kk]; } tile[tx][kk] = v; }
    __syncthreads();
#pragma unroll
    for (int p = 0; p < 2; ++p) { const int it = threadIdx.x + 256 * p, r = it >> 3, c = it & 7; const float* t = &tile[r][8 * c];
        u32x4 o; o.x = pk2(t[0], t[1]); o.y = pk2(t[2], t[3]); o.z = pk2(t[4], t[5]); o.w = pk2(t[6], t[7]);
        *(u32x4*)(dst + (size_t)(n0 + r) * K + k0 + 8 * c) = o; }
}
__global__ void __launch_bounds__(256) k_xprep(const float* __restrict__ x, unsigned char* ws) {
    const int row = blockIdx.x * 4 + (threadIdx.x >> 6), lane = threadIdx.x & 63;
    const f32x4* xr = (const f32x4*)(x + (size_t)row * 1024) + lane; float ss = 0.f;
    bf16* o = (bf16*)(ws + OFF_XB) + (size_t)row * 1024;
#pragma unroll
    for (int j = 0; j < 4; ++j) { const f32x4 v = xr[64 * j]; ss += (v[0] * v[0] + v[1] * v[1]) + (v[2] * v[2] + v[3] * v[3]); float t[4] = {v[0], v[1], v[2], v[3]}; store_bf<4>(o + 256 * j + 4 * lane, t); }
#pragma unroll
    for (int of = 1; of < 64; of <<= 1) ss += __shfl_xor(ss, of);
    if (lane == 0) { f32x4 s = {ss, 0.f, 0.f, 0.f}; *(f32x4*)(ws + OFF_SSP + (size_t)row * 16) = s; }
}
__global__ void __launch_bounds__(256) k_sumsq(const float* __restrict__ x, unsigned char* ws) {
    const int row = blockIdx.x * 4 + (threadIdx.x >> 6), lane = threadIdx.x & 63;
    const f32x4* xr = (const f32x4*)(x + (size_t)row * 1024) + lane; float ss = 0.f;
#pragma unroll
    for (int j = 0; j < 4; ++j) { const f32x4 v = xr[64 * j]; ss += (v[0] * v[0] + v[1] * v[1]) + (v[2] * v[2] + v[3] * v[3]); }
#pragma unroll
    for (int of = 1; of < 64; of <<= 1) ss += __shfl_xor(ss, of);
    if (lane == 0) { f32x4 s = {ss, 0.f, 0.f, 0.f}; *(f32x4*)(ws + OFF_SSP + (size_t)row * 16) = s; }
}
__global__ void __launch_bounds__(256) k_rope_table(const int* __restrict__ pos, unsigned char* ws) {
    const int idx = blockIdx.x * 256 + threadIdx.x, row = idx >> 5, i = idx & 31;
    const float inv = exp2f(-(float)i * (13.287712379549449f / 32.f));
    const float ang = (float)pos[row] * inv;
    float s, c; sincosf(ang, &s, &c);
    ((float*)(ws + OFF_COS))[idx] = c; ((float*)(ws + OFF_SIN))[idx] = s;
}
__global__ void __launch_bounds__(256) k_pconv(const float* __restrict__ p, unsigned char* ws) {
    const size_t i = ((size_t)blockIdx.x * 256 + threadIdx.x) * 4;
    const f32x4 v = *(const f32x4*)(p + i); float t[4] = {v[0], v[1], v[2], v[3]}; store_bf<4>((bf16*)(ws + OFF_PB) + i, t);
}
__global__ void __launch_bounds__(256) k_cb1(const float* __restrict__ pe, const float* __restrict__ w1, const float* __restrict__ b1, float* __restrict__ o) {
    const int j = threadIdx.x; float acc = b1[j];
    for (int k = 0; k < 2048; ++k) acc += pe[k] * w1[(size_t)k * 256 + j];
    o[j] = acc;
}
__global__ void k_lam(const float* __restrict__ dl, unsigned char* ws, int l) {
    if (threadIdx.x == 0) { float s1 = 0.f, s2 = 0.f; for (int i = 0; i < 64; ++i) { s1 += dl[i] * dl[64 + i]; s2 += dl[128 + i] * dl[192 + i]; }
        const float li = 0.8f - 0.6f * expf(-0.3f * (float)l); ((float*)(ws + OFF_CTL))[CTL_LAM + l] = expf(s1) - expf(s2) + li; }
}
__global__ void __launch_bounds__(64) k_cumsum(unsigned char* ws) {
    const int bh = blockIdx.x, b = bh >> 3, h = bh & 7, lane = threadIdx.x;
    const float* lf = (const float*)(ws + OFF_LOGF) + ((size_t)(b * 4096 + 64 * lane)) * 8 + h;
    float s = 0.f;
    for (int i = 0; i < 64; ++i) s += lf[i * 8];
    float incl = s;
#pragma unroll
    for (int of = 1; of < 64; of <<= 1) { const float t = __shfl_up(incl, of); if (lane >= of) incl += t; }
    float run = incl - s;
    float* cf = (float*)(ws + OFF_CF) + (size_t)bh * 4096 + 64 * lane;
    for (int i = 0; i < 64; ++i) { run += lf[i * 8]; cf[i] = run; }
}
__global__ void __launch_bounds__(256) k_compress(unsigned char* ws) {
    __shared__ float hid[256];
    const int c = blockIdx.x, bg = blockIdx.y, kv = blockIdx.z, j = threadIdx.x;
    bf16* dstK = (bf16*)(ws + OFF_KCMP) + (size_t)bg * 16384; bf16* dstV = (bf16*)(ws + OFF_VCMP) + (size_t)bg * 16384;
    if (c == 255) { if (j < 64) { if (kv == 0) dstK[ktile_off(c, j)] = 0; else dstV[vtile_off(c, j)] = 0; } return; }
    const bf16* src = (const bf16*)(ws + (kv ? OFF_VCB : OFF_KCB)) + ((size_t)bg * 4096 + 16 * c) * 64;
    const bf16* w = (const bf16*)(ws + OFF_CW1) + (size_t)(kv * 256 + j) * 2048;
    float acc = ((const float*)(ws + OFF_CB1))[kv * 256 + j];
    for (int k = 0; k < 2048; k += 8) { const bf16x8 a = *(const bf16x8*)(src + k), bb = *(const bf16x8*)(w + k);
#pragma unroll
        for (int i = 0; i < 8; ++i) acc += bf2f((bf16)a[i]) * bf2f((bf16)bb[i]); }
    hid[j] = bf2f(f2bf(siluf_(acc)));
    __syncthreads();
    if (j < 64) { const bf16* w2 = (const bf16*)(ws + OFF_CW2) + (size_t)(kv * 64 + j) * 256; float o = 0.f;
        for (int k = 0; k < 256; ++k) o += hid[k] * bf2f(w2[k]);
        if (kv == 0) dstK[ktile_off(c, j)] = f2bf(o); else dstV[vtile_off(c, j)] = f2bf(o); }
}
__global__ void __launch_bounds__(64) k_fox(unsigned char* ws) {
    const int bh = blockIdx.x, b = bh >> 3, h = bh & 7, t = blockIdx.y * 64 + threadIdx.x, tmax = blockIdx.y * 64 + 63;
    const bf16* Q = (const bf16*)(ws + OFF_QA) + ((size_t)bh * 4096 + t) * 64;
    const bf16* Kb = (const bf16*)(ws + OFF_KA) + (size_t)bh * 262144; const bf16* Vb = (const bf16*)(ws + OFF_VA) + (size_t)bh * 262144;
    const float* cf = (const float*)(ws + OFF_CF) + (size_t)bh * 4096;
    float q[64], o[64];
#pragma unroll
    for (int d = 0; d < 64; ++d) { q[d] = bf2f(Q[d]); o[d] = 0.f; }
    const float ci = cf[t]; float m = -1e30f, l = 0.f;
    for (int j = 0; j <= tmax; ++j) {
        float s = 0.f;
#pragma unroll
        for (int d = 0; d < 64; ++d) s += q[d] * bf2f(Kb[ktile_off(j, d)]);
        s += ci - cf[j];
        if (j <= t) { const float mn = fmaxf(m, s), al = exp2f(m - mn), p = exp2f(s - mn); l = l * al + p; m = mn;
#pragma unroll
            for (int d = 0; d < 64; ++d) o[d] = o[d] * al + p * bf2f(Vb[vtile_off(j, d)]); }
    }
    const float il = 1.f / l; bf16* Y = (bf16*)(ws + OFF_ZA) + (size_t)(b * 4096 + t) * 512 + h * 64;
#pragma unroll
    for (int d = 0; d < 64; ++d) Y[d] = f2bf(o[d] * il * bf2f(Y[d]));
}
__global__ void __launch_bounds__(64) k_diff(unsigned char* ws, const float* __restrict__ subg, int l) {
    __shared__ float res[64][129];
    const int bhc = blockIdx.x, b = bhc >> 2, hc = bhc & 3, t = blockIdx.y * 64 + threadIdx.x, tmax = blockIdx.y * 64 + 63;
    const float lam = ((const float*)(ws + OFF_CTL))[CTL_LAM + l], lam_init = 0.8f - 0.6f * expf(-0.3f * (float)l);
    const bf16* Vb = (const bf16*)(ws + OFF_VC) + (size_t)bhc * 524288;
    for (int dh = 0; dh < 2; ++dh) {
        float r[64];
        for (int mp = 0; mp < 2; ++mp) {
            const int hh = b * 8 + hc * 2 + mp;
            const bf16* Q = (const bf16*)(ws + OFF_QC) + ((size_t)hh * 4096 + t) * 64; const bf16* Kb = (const bf16*)(ws + OFF_KC) + (size_t)hh * 262144;
            float q[64], o[64];
#pragma unroll
            for (int d = 0; d < 64; ++d) { q[d] = bf2f(Q[d]); o[d] = 0.f; }
            float m = -1e30f, ls = 0.f;
            for (int j = 0; j <= tmax; ++j) {
                float s = 0.f;
#pragma unroll
                for (int d = 0; d < 64; ++d) s += q[d] * bf2f(Kb[ktile_off(j, d)]);
                if (j <= t) { const float mn = fmaxf(m, s), al = exp2f(m - mn), p = exp2f(s - mn); ls = ls * al + p; m = mn;
#pragma unroll
                    for (int d = 0; d < 64; ++d) o[d] = o[d] * al + p * bf2f(Vb[v128_off(j, dh * 64 + d)]); }
            }
            const float il = 1.f / ls;
#pragma unroll
            for (int d = 0; d < 64; ++d) { if (mp == 0) r[d] = o[d] * il; else r[d] -= lam * o[d] * il; }
        }
#pragma unroll
        for (int d = 0; d < 64; ++d) res[threadIdx.x][dh * 64 + d] = r[d];
    }
    float ss = 0.f;
    for (int d = 0; d < 128; ++d) { const float v = res[threadIdx.x][d]; ss += v * v; }
    const float rs = rsqrtf(ss * (1.f / 128.f) + EPS) * (1.f - lam_init);
    bf16* Y = (bf16*)(ws + OFF_ZC) + (size_t)(b * 4096 + t) * 512 + hc * 128;
    for (int d = 0; d < 128; ++d) Y[d] = f2bf(res[threadIdx.x][d] * rs * subg[d] * bf2f(Y[d]));
}
__global__ void __launch_bounds__(64) k_nsa_topk(unsigned char* ws) {
    __shared__ float imp[64][65];
    const int bg = blockIdx.x, b = bg >> 1, g = bg & 1, tb = blockIdx.y, t = tb * 64 + threadIdx.x;
    for (int j = 0; j < 64; ++j) imp[threadIdx.x][j] = 0.f;
    const int nv = (t >= 31) ? ((t - 31) >> 4) + 1 : 0, nvmax = ((tb * 64 + 63 - 31) >> 4) + 1;
    const bf16* Kc = (const bf16*)(ws + OFF_KCMP) + (size_t)bg * 16384;
    for (int hq = 0; hq < 4; ++hq) {
        const int h = g * 4 + hq;
        const bf16* Q = (const bf16*)(ws + OFF_QB) + ((size_t)(b * 8 + h) * 4096 + t) * 64;
        float q[64];
#pragma unroll
        for (int d = 0; d < 64; ++d) q[d] = bf2f(Q[d]);
        float m = -1e30f, ls = 0.f;
        for (int c = 0; c < nvmax; ++c) { float s = 0.f;
#pragma unroll
            for (int d = 0; d < 64; ++d) s += q[d] * bf2f(Kc[ktile_off(c, d)]);
            if (c < nv) { const float mn = fmaxf(m, s); ls = ls * exp2f(m - mn) + exp2f(s - mn); m = mn; } }
        const float il = nv > 0 ? 1.f / ls : 0.f;
        for (int c = 0; c < nvmax; ++c) { float s = 0.f;
#pragma unroll
            for (int d = 0; d < 64; ++d) s += q[d] * bf2f(Kc[ktile_off(c, d)]);
            if (c < nv) { const float p = exp2f(s - m) * il; imp[threadIdx.x][c >> 2] += p; if ((c & 3) == 3 && (c >> 2) + 1 < 64) imp[threadIdx.x][(c >> 2) + 1] += p; } }
    }
    for (int j = 0; j < 64; ++j) { const bool forced = (j == 0) || (j == tb) || (j == tb - 1), valid = j <= tb; const float v = imp[threadIdx.x][j];
        imp[threadIdx.x][j] = forced ? 1e30f : (valid ? v : -1e30f); }
    unsigned long long mask = 0ull;
    for (int j = 0; j < 64; ++j) { const float sj = imp[threadIdx.x][j]; int rank = 0;
        for (int k = 0; k < 64; ++k) { const float sk = imp[threadIdx.x][k]; rank += (sk > sj || (sk == sj && k < j)) ? 1 : 0; }
        if (rank < 16) mask |= (1ull << j); }
    ((unsigned long long*)(ws + OFF_SELM))[(size_t)bg * 4096 + t] = mask;
}
__global__ void __launch_bounds__(64) k_nsa_attn(unsigned char* ws) {
    const int bh = blockIdx.x, b = bh >> 3, h = bh & 7, g = h >> 2, bg = b * 2 + g, tb = blockIdx.y, t = tb * 64 + threadIdx.x, row = b * 4096 + t;
    const bf16* Q = (const bf16*)(ws + OFF_QB) + ((size_t)bh * 4096 + t) * 64;
    float q[64], qr[64], o[64], y[64];
#pragma unroll
    for (int d = 0; d < 64; ++d) { q[d] = bf2f(Q[d]); y[d] = 0.f; }
    { const float* cs = (const float*)(ws + OFF_COS) + (size_t)row * 32; const float* sn = (const float*)(ws + OFF_SIN) + (size_t)row * 32;
#pragma unroll
      for (int i = 0; i < 32; ++i) { const float c = cs[i], s = sn[i]; qr[2 * i] = bf2f(f2bf(q[2 * i] * c - q[2 * i + 1] * s)); qr[2 * i + 1] = bf2f(f2bf(q[2 * i + 1] * c + q[2 * i] * s)); } }
    const float* gt = (const float*)(ws + OFF_GATES) + (size_t)row * 24 + h * 3;
    const float g0 = gt[0], g1 = gt[1], g2 = gt[2];
    { const int nv = (t >= 31) ? ((t - 31) >> 4) + 1 : 0, nvmax = ((tb * 64 + 63 - 31) >> 4) + 1;
      const bf16* Kc = (const bf16*)(ws + OFF_KCMP) + (size_t)bg * 16384; const bf16* Vc = (const bf16*)(ws + OFF_VCMP) + (size_t)bg * 16384;
      float m = -1e30f, ls = 0.f;
#pragma unroll
      for (int d = 0; d < 64; ++d) o[d] = 0.f;
      for (int c = 0; c < nvmax; ++c) { float s = 0.f;
#pragma unroll
          for (int d = 0; d < 64; ++d) s += q[d] * bf2f(Kc[ktile_off(c, d)]);
          if (c < nv) { const float mn = fmaxf(m, s), al = exp2f(m - mn), p = exp2f(s - mn); ls = ls * al + p; m = mn;
#pragma unroll
              for (int d = 0; d < 64; ++d) o[d] = o[d] * al + p * bf2f(Vc[vtile_off(c, d)]); } }
      const float il = nv > 0 ? g0 / ls : 0.f;
#pragma unroll
      for (int d = 0; d < 64; ++d) y[d] += o[d] * il; }
    { const unsigned long long mask = ((const unsigned long long*)(ws + OFF_SELM))[(size_t)bg * 4096 + t];
      const bf16* Kb = (const bf16*)(ws + OFF_KSEL) + (size_t)bg * 262144; const bf16* Vb = (const bf16*)(ws + OFF_VSEL) + (size_t)bg * 262144;
      float m = -1e30f, ls = 0.f;
#pragma unroll
      for (int d = 0; d < 64; ++d) o[d] = 0.f;
      for (int j = 0; j <= tb; ++j) { const bool sel = (mask >> j) & 1ull;
          for (int kk = 0; kk < 64; ++kk) { const int kp = j * 64 + kk; float s = 0.f;
#pragma unroll
              for (int d = 0; d < 64; ++d) s += qr[d] * bf2f(Kb[ktile_off(kp, d)]);
              if (sel && kp <= t) { const float mn = fmaxf(m, s), al = exp2f(m - mn), p = exp2f(s - mn); ls = ls * al + p; m = mn;
#pragma unroll
                  for (int d = 0; d < 64; ++d) o[d] = o[d] * al + p * bf2f(Vb[vtile_off(kp, d)]); } } }
      const float il = g1 / ls;
#pragma unroll
      for (int d = 0; d < 64; ++d) y[d] += o[d] * il; }
    { const bf16* Kb = (const bf16*)(ws + OFF_KWIN) + (size_t)bg * 262144; const bf16* Vb = (const bf16*)(ws + OFF_VWIN) + (size_t)bg * 262144;
      float m = -1e30f, ls = 0.f;
#pragma unroll
      for (int d = 0; d < 64; ++d) o[d] = 0.f;
      const int k_lo = max(0, tb * 64 - 511), k_hi = tb * 64 + 63;
      for (int kp = k_lo; kp <= k_hi; ++kp) { float s = 0.f;
#pragma unroll
          for (int d = 0; d < 64; ++d) s += qr[d] * bf2f(Kb[ktile_off(kp, d)]);
          if (kp <= t && kp > t - 512) { const float mn = fmaxf(m, s), al = exp2f(m - mn), p = exp2f(s - mn); ls = ls * al + p; m = mn;
#pragma unroll
              for (int d = 0; d < 64; ++d) o[d] = o[d] * al + p * bf2f(Vb[vtile_off(kp, d)]); } }
      const float il = g2 / ls;
#pragma unroll
      for (int d = 0; d < 64; ++d) y[d] += o[d] * il; }
    bf16* Y = (bf16*)(ws + OFF_ZB) + (size_t)row * 512 + h * 64;
#pragma unroll
    for (int d = 0; d < 64; ++d) Y[d] = f2bf(y[d] * bf2f(Y[d]));
}
__global__ void __launch_bounds__(256) k_final(float* X, const float* __restrict__ g) {
    const int row = blockIdx.x * 4 + (threadIdx.x >> 6), lane = threadIdx.x & 63;
    f32x4* xr = (f32x4*)(X + (size_t)row * 1024) + lane; f32x4 v[4]; float ss = 0.f;
#pragma unroll
    for (int j = 0; j < 4; ++j) { v[j] = xr[64 * j]; ss += (v[j][0] * v[j][0] + v[j][1] * v[j][1]) + (v[j][2] * v[j][2] + v[j][3] * v[j][3]); }
#pragma unroll
    for (int of = 1; of < 64; of <<= 1) ss += __shfl_xor(ss, of);
    const float rs = rsqrtf(ss * (1.f / 1024.f) + EPS);
#pragma unroll
    for (int j = 0; j < 4; ++j) { const f32x4 gg = *((const f32x4*)g + 64 * j + lane); xr[64 * j] = v[j] * rs * gg; }
}

extern "C" void kernel_launch(void* const* d_in, const int* in_sizes, int n_in, void* d_out, int out_size, void* d_ws, size_t ws_size, hipStream_t stream) {
    if (n_in != 23 || ws_size < WS_NEED || out_size != M * DM) { fprintf(stderr, "kernel_launch: unexpected sizes (n_in %d ws %zu out %d)\n", n_in, ws_size, out_size); return; }
    unsigned char* ws = (unsigned char*)d_ws; float* X = (float*)d_out;
    const float* x = (const float*)d_in[0]; const float* p = (const float*)d_in[1]; const int* pos = (const int*)d_in[2];
    const float *norm_g = (const float*)d_in[3], *w_in = (const float*)d_in[4], *b_forget = (const float*)d_in[5];
    const float *pe_k = (const float*)d_in[6], *w1_k = (const float*)d_in[7], *b1_k = (const float*)d_in[8], *w2_k = (const float*)d_in[9];
    const float *pe_v = (const float*)d_in[10], *w1_v = (const float*)d_in[11], *b1_v = (const float*)d_in[12], *w2_v = (const float*)d_in[13];
    const float *diff_lam = (const float*)d_in[14], *subln = (const float*)d_in[15];
    const float *w_br[3] = {(const float*)d_in[16], (const float*)d_in[17], (const float*)d_in[18]};
    const float *w_out = (const float*)d_in[19], *w_ple = (const float*)d_in[20], *w_pg = (const float*)d_in[21], *final_g = (const float*)d_in[22];
    k_xprep<<<M / 4, 256, 0, stream>>>(x, ws);
    k_rope_table<<<M * 32 / 256, 256, 0, stream>>>(pos, ws);
    k_pconv<<<(2 * M * 256 / 4) / 256, 256, 0, stream>>>(p, ws);
    for (int l = 0; l < DEPTH; ++l) {
        k_convT<0><<<dim3(1024 / 64, 1024 / 64), 256, 0, stream>>>(w_out + (size_t)l * 1024 * 1024, 1024, 1024, (bf16*)(ws + OFF_WOUT) + (size_t)l * 1024 * 1024, nullptr);
        k_convT<0><<<dim3(1024 / 64, 1024 / 64), 256, 0, stream>>>(w_pg + (size_t)l * 1024 * 1024, 1024, 1024, (bf16*)(ws + OFF_WPG) + (size_t)l * 1024 * 1024, nullptr);
        k_convT<0><<<dim3(1024 / 64, 256 / 64), 256, 0, stream>>>(w_ple + (size_t)l * 256 * 1024, 1024, 256, (bf16*)(ws + OFF_WPL) + (size_t)l * 1024 * 256, nullptr);
        k_lam<<<1, 64, 0, stream>>>(diff_lam + l * 256, ws, l);
    }
    for (int l = 0; l < DEPTH; ++l) {
        const float* wl = w_in + (size_t)l * 1024 * NIN; const float* ng = norm_g + l * 1024;
        k_convT<1><<<dim3(NP / 64, 1024 / 64), 256, 0, stream>>>(wl, NIN, 1024, (bf16*)(ws + OFF_WIN), ng);
        k_convT<0><<<dim3(3072 / 64, 1024 / 64), 256, 0, stream>>>(wl + 5920, NIN, 1024, (bf16*)(ws + OFF_WMG), ng);
        for (int i = 0; i < 3; ++i) k_convT<0><<<dim3(1024 / 64, 512 / 64), 256, 0, stream>>>(w_br[i] + (size_t)l * 512 * 1024, 1024, 512, (bf16*)(ws + OFF_WBR) + (size_t)i * 1024 * 512, nullptr);
        k_convT<0><<<dim3(256 / 64, 2048 / 64), 256, 0, stream>>>(w1_k + (size_t)l * 2048 * 256, 256, 2048, (bf16*)(ws + OFF_CW1), nullptr);
        k_convT<0><<<dim3(256 / 64, 2048 / 64), 256, 0, stream>>>(w1_v + (size_t)l * 2048 * 256, 256, 2048, (bf16*)(ws + OFF_CW1) + 256 * 2048, nullptr);
        k_convT<2><<<dim3(1, 256 / 64), 256, 0, stream>>>(w2_k + (size_t)l * 256 * 64, 64, 256, (bf16*)(ws + OFF_CW2), nullptr);
        k_convT<0><<<dim3(1, 256 / 64), 256, 0, stream>>>(w2_v + (size_t)l * 256 * 64, 64, 256, (bf16*)(ws + OFF_CW2) + 64 * 256, nullptr);
        k_cb1<<<1, 256, 0, stream>>>(pe_k + l * 2048, w1_k + (size_t)l * 2048 * 256, b1_k + l * 256, (float*)(ws + OFF_CB1));
        k_cb1<<<1, 256, 0, stream>>>(pe_v + l * 2048, w1_v + (size_t)l * 2048 * 256, b1_v + l * 256, (float*)(ws + OFF_CB1) + 256);
        EpiCtx E{ws, b_forget + l * 8, l == 0 ? x : X, X, 0};
        k_gemm<EPI_INPROJ><<<dim3(NP / 128, M / 128), 256, 0, stream>>>((const bf16*)(ws + OFF_XB), (const bf16*)(ws + OFF_WIN), 1024, E);
        k_cumsum<<<32, 64, 0, stream>>>(ws);
        k_compress<<<dim3(256, 8, 2), 256, 0, stream>>>(ws);
        k_fox<<<dim3(32, 64), 64, 0, stream>>>(ws);
        k_diff<<<dim3(16, 64), 64, 0, stream>>>(ws, subln + l * 128, l);
        k_nsa_topk<<<dim3(8, 64), 64, 0, stream>>>(ws);
        k_nsa_attn<<<dim3(32, 64), 64, 0, stream>>>(ws);
        for (int i = 0; i < 3; ++i) {
            k_gemm<EPI_GATE><<<dim3(8, M / 128), 256, 0, stream>>>((const bf16*)(ws + OFF_XB), (const bf16*)(ws + OFF_WMG) + (size_t)i * 1024 * 1024, 1024, E);
            const bf16* Y = (const bf16*)(ws + (i == 0 ? OFF_ZA : i == 1 ? OFF_ZB : OFF_ZC)); const bf16* Wb = (const bf16*)(ws + OFF_WBR) + (size_t)i * 1024 * 512;
            if (i == 0) k_gemm<EPI_BR0><<<dim3(8, M / 128), 256, 0, stream>>>(Y, Wb, 512, E);
            else if (i == 1) k_gemm<EPI_BR1><<<dim3(8, M / 128), 256, 0, stream>>>(Y, Wb, 512, E);
            else k_gemm<EPI_BR2><<<dim3(8, M / 128), 256, 0, stream>>>(Y, Wb, 512, E);
        }
        k_gemm<EPI_OUT><<<dim3(8, M / 128), 256, 0, stream>>>((const bf16*)(ws + OFF_MERGED), (const bf16*)(ws + OFF_WOUT) + (size_t)l * 1024 * 1024, 1024, E);
        k_gemm<EPI_U><<<dim3(8, M / 128), 256, 0, stream>>>((const bf16*)(ws + OFF_PB) + (size_t)l * M * 256, (const bf16*)(ws + OFF_WPL) + (size_t)l * 1024 * 256, 256, E);
        k_gemm<EPI_PLE><<<dim3(8, M / 128), 256, 0, stream>>>((const bf16*)(ws + OFF_X1B), (const bf16*)(ws + OFF_WPG) + (size_t)l * 1024 * 1024, 1024, E);
        if (l + 1 < DEPTH) k_sumsq<<<M / 4, 256, 0, stream>>>(X, ws);
    }
    k_final<<<M / 4, 256, 0, stream>>>(X, final_g);
}
```

```cpp
#include <hip/hip_runtime.h>
#include <hip/hip_cooperative_groups.h>
#include <cstdio>
#include <cstdint>

typedef unsigned short bf16;
typedef short bf16x8 __attribute__((ext_vector_type(8)));
typedef float f32x4 __attribute__((ext_vector_type(4)));
typedef float f32x16 __attribute__((ext_vector_type(16)));
typedef unsigned u32x4 __attribute__((ext_vector_type(4)));
typedef unsigned u32x2 __attribute__((ext_vector_type(2)));

constexpr int BATCH = 4, SEQ = 4096, DM = 1024, M = BATCH * SEQ, DEPTH = 2, NIN = 8992, NP = 6144;
constexpr float EPS = 1e-6f;
constexpr float LOG2E = 1.4426950408889634f;
constexpr float C2 = 0.125f * LOG2E;
constexpr size_t MiB = 1u << 20;
constexpr size_t OFF_CTL = 0;
constexpr size_t OFF_WIN = 1 * MiB, OFF_WMG = 13 * MiB, OFF_WBR = 19 * MiB, OFF_CW1 = 22 * MiB, OFF_CW2 = 24 * MiB, OFF_CB1 = 24 * MiB + 128 * 1024;
constexpr size_t OFF_WOUT = 25 * MiB, OFF_WPG = 29 * MiB, OFF_WPL = 33 * MiB;
constexpr size_t OFF_XB = 34 * MiB, OFF_ZA = 66 * MiB, OFF_ZB = 82 * MiB, OFF_ZC = 98 * MiB;
constexpr size_t OFF_COS = 114 * MiB, OFF_SIN = 116 * MiB, OFF_PB = 118 * MiB;
constexpr size_t OFF_LOGF = 134 * MiB, OFF_CF = 134 * MiB + 512 * 1024, OFF_GATES = 135 * MiB, OFF_SSP = 136 * MiB + 512 * 1024;
constexpr size_t OFF_KCMP = 136 * MiB + 768 * 1024, OFF_VCMP = 137 * MiB, OFF_SELM = 137 * MiB + 256 * 1024;
constexpr size_t OFF_QA = 139 * MiB, OFF_KA = 155 * MiB, OFF_VA = 171 * MiB, OFF_QB = 187 * MiB, OFF_QC = 203 * MiB, OFF_KC = 219 * MiB, OFF_VC = 235 * MiB;
constexpr size_t OFF_KCB = 251 * MiB, OFF_VCB = 255 * MiB, OFF_KSEL = 259 * MiB, OFF_KWIN = 263 * MiB, OFF_VSEL = 267 * MiB, OFF_VWIN = 271 * MiB;
constexpr size_t WS_NEED = 275 * MiB;
constexpr size_t OFF_G = 139 * MiB, OFF_MERGED = 171 * MiB, OFF_T = 203 * MiB, OFF_X1B = 203 * MiB, OFF_U = 139 * MiB;
constexpr int CTL_LAM = 64;

__device__ __forceinline__ bf16 f2bf(float f) { unsigned u = __float_as_uint(f); return (bf16)((u + 0x7fffu + ((u >> 16) & 1u)) >> 16); }
__device__ __forceinline__ float bf2f(bf16 h) { return __uint_as_float(((unsigned)h) << 16); }
__device__ __forceinline__ unsigned pk2(float lo, float hi) { return (unsigned)f2bf(lo) | ((unsigned)f2bf(hi) << 16); }
__device__ __forceinline__ float sigmoidf_(float x) { return 1.f / (1.f + __expf(-x)); }
__device__ __forceinline__ float siluf_(float x) { return x / (1.f + __expf(-x)); }
__device__ __forceinline__ float logsigmoidf_(float x) { return x >= 0.f ? -log1pf(expf(-x)) : x - log1pf(expf(x)); }

__device__ __forceinline__ int ktile_off(int s, int d) { return (s >> 6) * 4096 + (d >> 3) * 512 + (s & 63) * 8 + (d & 7); }
__device__ __forceinline__ int vtile_off(int s, int d) { return (s >> 6) * 4096 + (d >> 5) * 2048 + ((s & 63) >> 4) * 512 + (s & 15) * 32 + (d & 31); }
__device__ __forceinline__ int v128_off(int s, int d) { return (s >> 6) * 8192 + (d >> 5) * 2048 + ((s & 63) >> 4) * 512 + (s & 15) * 32 + (d & 31); }

template <int W> __device__ __forceinline__ void store_bf(bf16* dst, const float* v) {
    if constexpr (W == 4) { u32x2 o; o.x = pk2(v[0], v[1]); o.y = pk2(v[2], v[3]); *(u32x2*)dst = o; }
    else { u32x4 o; o.x = pk2(v[0], v[1]); o.y = pk2(v[2], v[3]); o.z = pk2(v[4], v[5]); o.w = pk2(v[6], v[7]); *(u32x4*)dst = o; }
}

__device__ __forceinline__ int win_srccol(int n) {
    const int seg = n >> 6, j = n & 63; const int il = ((j & 1) << 5) + (j >> 1);
    if (seg < 8) return 0 + n;
    if (seg < 16) return 512 + (n - 512);
    if (seg < 24) return 1024 + (n - 1024);
    if (seg < 32) return 1544 + (n - 1536);
    if (seg < 40) return 2056 + (seg - 32) * 64 + il;
    if (seg < 42) return 2568 + (n - 2560);
    if (seg < 44) return 2696 + (n - 2688);
    if (seg < 46) return 2824 + (seg - 44) * 64 + il;
    if (seg < 48) return 3080 + (seg - 46) * 64 + il;
    if (seg < 50) return 2952 + (n - 3072);
    if (seg < 52) return 3208 + (n - 3200);
    if (seg < 60) return 3360 + (n - 3328);
    if (seg < 68) return 3872 + (seg - 60) * 64 + il;
    if (seg < 76) return 4384 + (seg - 68) * 64 + il;
    if (seg < 84) return 4896 + (n - 4864);
    if (seg < 92) return 5408 + (n - 5376);
    if (seg == 92) { if (j < 8) return 1536 + j; if (j < 32) return 3336 + (j - 8); return -1; }
    return -1;
}

enum { EPI_INPROJ = 0, EPI_GATE = 1, EPI_BR0 = 2, EPI_BR1 = 3, EPI_BR2 = 4, EPI_OUT = 5, EPI_U = 6, EPI_PLE = 7 };
struct EpiCtx { unsigned char* ws; const float* bfg; const float* xin; float* X; int gi; };

__device__ __forceinline__ float row_rstd(const unsigned char* ws, int row) {
    const f32x4 sp = *(const f32x4*)(ws + OFF_SSP + (size_t)row * 16);
    return rsqrtf(((sp[0] + sp[1]) + (sp[2] + sp[3])) * (1.f / 1024.f) + EPS);
}
template <int W> __device__ __forceinline__ void rope_apply(const unsigned char* ws, int row, int d, float* v) {
    const float* cs = (const float*)(ws + OFF_COS) + (size_t)row * 32 + (d >> 1);
    const float* sn = (const float*)(ws + OFF_SIN) + (size_t)row * 32 + (d >> 1);
#pragma unroll
    for (int j = 0; j < W / 2; ++j) { const float c = cs[j], s = sn[j], x1 = v[2 * j], x2 = v[2 * j + 1]; v[2 * j] = x1 * c - x2 * s; v[2 * j + 1] = x2 * c + x1 * s; }
}

enum { T_QA = 0, T_KA, T_VA, T_ZA, T_QB, T_CB, T_KROPE, T_VSW, T_ZB, T_QC, T_KC, T_VC, T_ZC, T_SPECIAL };
__device__ __forceinline__ int inproj_type(int t) {
    return t < 2 ? T_QA : t < 4 ? T_KA : t < 6 ? T_VA : t < 8 ? T_ZA : t < 10 ? T_QB : t == 10 ? T_CB : t == 11 ? T_KROPE : t == 12 ? T_VSW : t < 15 ? T_ZB : t < 17 ? T_QC : t < 19 ? T_KC : t < 21 ? T_VC : t < 23 ? T_ZC : T_SPECIAL;
}
template <int T, int W> __device__ __forceinline__ void emit_inproj(const EpiCtx& E, int row, int col, const float* a) {
    unsigned char* ws = E.ws;
    const float rs = row_rstd(ws, row);
    float v[W];
#pragma unroll
    for (int i = 0; i < W; ++i) v[i] = a[i] * rs;
    const int b = row >> 12, s = row & 4095;
    if constexpr (T == T_QA) { const int cc = col, h = cc >> 6, d = cc & 63;
#pragma unroll
        for (int i = 0; i < W; ++i) v[i] *= C2;
        store_bf<W>((bf16*)(ws + OFF_QA) + ((size_t)(b * 8 + h) * 4096 + s) * 64 + d, v);
    } else if constexpr (T == T_KA) { const int cc = col - 512, h = cc >> 6, d = cc & 63;
        store_bf<W>((bf16*)(ws + OFF_KA) + (size_t)(b * 8 + h) * 262144 + ktile_off(s, d), v);
    } else if constexpr (T == T_VA) { const int cc = col - 1024, h = cc >> 6, d = cc & 63;
        store_bf<W>((bf16*)(ws + OFF_VA) + (size_t)(b * 8 + h) * 262144 + vtile_off(s, d), v);
    } else if constexpr (T == T_ZA || T == T_ZB || T == T_ZC) { const int cc = col - (T == T_ZA ? 1536 : T == T_ZB ? 3328 : 5376);
#pragma unroll
        for (int i = 0; i < W; ++i) v[i] = siluf_(v[i]);
        store_bf<W>((bf16*)(ws + (T == T_ZA ? OFF_ZA : T == T_ZB ? OFF_ZB : OFF_ZC)) + (size_t)row * 512 + cc, v);
    } else if constexpr (T == T_QB) { const int cc = col - 2048, h = cc >> 6, d = cc & 63;
#pragma unroll
        for (int i = 0; i < W; ++i) v[i] *= C2;
        store_bf<W>((bf16*)(ws + OFF_QB) + ((size_t)(b * 8 + h) * 4096 + s) * 64 + d, v);
    } else if constexpr (T == T_CB) { const int cc = col - 2560, g = (cc >> 6) & 1, d = cc & 63;
        store_bf<W>((bf16*)(ws + (cc < 128 ? OFF_KCB : OFF_VCB)) + ((size_t)(b * 2 + g) * 4096 + s) * 64 + d, v);
    } else if constexpr (T == T_KROPE) { const int cc = col - 2816, g = (cc >> 6) & 1, d = cc & 63;
        rope_apply<W>(ws, row, d, v);
        store_bf<W>((bf16*)(ws + (cc < 128 ? OFF_KSEL : OFF_KWIN)) + (size_t)(b * 2 + g) * 262144 + ktile_off(s, d), v);
    } else if constexpr (T == T_VSW) { const int cc = col - 3072, g = (cc >> 6) & 1, d = cc & 63;
        store_bf<W>((bf16*)(ws + (cc < 128 ? OFF_VSEL : OFF_VWIN)) + (size_t)(b * 2 + g) * 262144 + vtile_off(s, d), v);
    } else if constexpr (T == T_QC) { const int cc = col - 3840, h = cc >> 6, d = cc & 63;
        rope_apply<W>(ws, row, d, v);
#pragma unroll
        for (int i = 0; i < W; ++i) v[i] *= C2;
        store_bf<W>((bf16*)(ws + OFF_QC) + ((size_t)(b * 8 + h) * 4096 + s) * 64 + d, v);
    } else if constexpr (T == T_KC) { const int cc = col - 4352, h = cc >> 6, d = cc & 63;
        rope_apply<W>(ws, row, d, v);
        store_bf<W>((bf16*)(ws + OFF_KC) + (size_t)(b * 8 + h) * 262144 + ktile_off(s, d), v);
    } else if constexpr (T == T_VC) { const int cc = col - 4864, hc = cc >> 7, d = cc & 127;
        store_bf<W>((bf16*)(ws + OFF_VC) + (size_t)(b * 4 + hc) * 524288 + v128_off(s, d), v);
    } else { const int cc = col - 5888;
        if (cc < 8) { float* o = (float*)(ws + OFF_LOGF) + (size_t)row * 8 + cc;
#pragma unroll
            for (int i = 0; i < W; ++i) o[i] = logsigmoidf_(v[i] + E.bfg[cc + i]) * LOG2E;
        } else if (cc < 32) { float* o = (float*)(ws + OFF_GATES) + (size_t)row * 24 + (cc - 8);
#pragma unroll
            for (int i = 0; i < W; ++i) o[i] = sigmoidf_(v[i]);
        }
    }
}

template <int KIND, int W> __device__ __forceinline__ void emit(const EpiCtx& E, int row, int col, const float* a) {
    unsigned char* ws = E.ws;
    const size_t idx = (size_t)row * 1024 + col;
    if constexpr (KIND == EPI_GATE) {
        const float rs = row_rstd(ws, row); float v[W];
#pragma unroll
        for (int i = 0; i < W; ++i) v[i] = sigmoidf_(a[i] * rs);
        store_bf<W>((bf16*)(ws + OFF_G) + idx, v);
    } else if constexpr (KIND == EPI_BR0 || KIND == EPI_BR1 || KIND == EPI_BR2) {
        const bf16* g = (const bf16*)(ws + OFF_G) + idx; float* T = (float*)(ws + OFF_T) + idx; float v[W];
#pragma unroll
        for (int i = 0; i < W; ++i) { v[i] = bf2f(g[i]) * a[i]; if (KIND != EPI_BR0) v[i] += T[i]; }
        if constexpr (KIND == EPI_BR2) store_bf<W>((bf16*)(ws + OFF_MERGED) + idx, v);
        else {
#pragma unroll
            for (int i = 0; i < W; ++i) T[i] = v[i]; }
    } else if constexpr (KIND == EPI_OUT) {
        float v[W];
#pragma unroll
        for (int i = 0; i < W; ++i) { v[i] = E.xin[idx + i] + a[i]; E.X[idx + i] = v[i]; }
        store_bf<W>((bf16*)(ws + OFF_X1B) + idx, v);
    } else if constexpr (KIND == EPI_U) {
        float* U = (float*)(ws + OFF_U) + idx;
#pragma unroll
        for (int i = 0; i < W; ++i) U[i] = a[i];
    } else if constexpr (KIND == EPI_PLE) {
        const float* U = (const float*)(ws + OFF_U) + idx; float v[W];
#pragma unroll
        for (int i = 0; i < W; ++i) { v[i] = E.X[idx + i] + sigmoidf_(a[i]) * U[i]; E.X[idx + i] = v[i]; }
        store_bf<W>((bf16*)(ws + OFF_XB) + idx, v);
    }
}

template <int KIND> __device__ __forceinline__ void d_gemm(int vb, int vt, int nbx, const bf16* A, const bf16* Bt, int K, const EpiCtx& E) {
    const int lane = vt & 63, wid = vt >> 6, r32 = lane & 31, hi = lane >> 5;
    const int m0 = (vb / nbx) * 128 + (wid >> 1) * 64, n0 = (vb % nbx) * 128 + (wid & 1) * 64;
    f32x16 acc[2][2];
#pragma unroll
    for (int i = 0; i < 2; ++i)
#pragma unroll
        for (int j = 0; j < 2; ++j)
#pragma unroll
            for (int r = 0; r < 16; ++r) acc[i][j][r] = 0.f;
    const bf16* Ap = A + (size_t)(m0 + r32) * K + 8 * hi;
    const bf16* Bp = Bt + (size_t)(n0 + r32) * K + 8 * hi;
    for (int k = 0; k < K; k += 16) {
        const bf16x8 a0 = *(const bf16x8*)(Ap + k), a1 = *(const bf16x8*)(Ap + (size_t)32 * K + k);
        const bf16x8 b0 = *(const bf16x8*)(Bp + k), b1 = *(const bf16x8*)(Bp + (size_t)32 * K + k);
        acc[0][0] = __builtin_amdgcn_mfma_f32_32x32x16_bf16(b0, a0, acc[0][0], 0, 0, 0);
        acc[0][1] = __builtin_amdgcn_mfma_f32_32x32x16_bf16(b0, a1, acc[0][1], 0, 0, 0);
        acc[1][0] = __builtin_amdgcn_mfma_f32_32x32x16_bf16(b1, a0, acc[1][0], 0, 0, 0);
        acc[1][1] = __builtin_amdgcn_mfma_f32_32x32x16_bf16(b1, a1, acc[1][1], 0, 0, 0);
    }
#define KG_LOOP(CALL) _Pragma("unroll") for (int jn = 0; jn < 2; ++jn) _Pragma("unroll") for (int im = 0; im < 2; ++im) _Pragma("unroll") for (int rq = 0; rq < 4; ++rq) { \
        float v[4] = {acc[jn][im][4 * rq], acc[jn][im][4 * rq + 1], acc[jn][im][4 * rq + 2], acc[jn][im][4 * rq + 3]}; \
        const int row = m0 + 32 * im + r32, col = n0 + 32 * jn + 8 * rq + 4 * hi; CALL; }
    if constexpr (KIND == EPI_INPROJ) {
        switch (inproj_type(n0 >> 8)) {
            case T_QA: KG_LOOP((emit_inproj<T_QA, 4>(E, row, col, v))) break;
            case T_KA: KG_LOOP((emit_inproj<T_KA, 4>(E, row, col, v))) break;
            case T_VA: KG_LOOP((emit_inproj<T_VA, 4>(E, row, col, v))) break;
            case T_ZA: KG_LOOP((emit_inproj<T_ZA, 4>(E, row, col, v))) break;
            case T_QB: KG_LOOP((emit_inproj<T_QB, 4>(E, row, col, v))) break;
            case T_CB: KG_LOOP((emit_inproj<T_CB, 4>(E, row, col, v))) break;
            case T_KROPE: KG_LOOP((emit_inproj<T_KROPE, 4>(E, row, col, v))) break;
            case T_VSW: KG_LOOP((emit_inproj<T_VSW, 4>(E, row, col, v))) break;
            case T_ZB: KG_LOOP((emit_inproj<T_ZB, 4>(E, row, col, v))) break;
            case T_QC: KG_LOOP((emit_inproj<T_QC, 4>(E, row, col, v))) break;
            case T_KC: KG_LOOP((emit_inproj<T_KC, 4>(E, row, col, v))) break;
            case T_VC: KG_LOOP((emit_inproj<T_VC, 4>(E, row, col, v))) break;
            case T_ZC: KG_LOOP((emit_inproj<T_ZC, 4>(E, row, col, v))) break;
            default: KG_LOOP((emit_inproj<T_SPECIAL, 4>(E, row, col, v))) break;
        }
    } else { KG_LOOP((emit<KIND, 4>(E, row, col, v))) }
#undef KG_LOOP
}

template <int MODE> __device__ __forceinline__ void d_convT(bool active, int bx, int by, int vt, float (*tile)[65], const float* src, int ld, int K, bf16* dst, const float* kscale) {
    const int n0 = bx * 64, k0 = by * 64, tx = vt & 63, ty = vt >> 6;
    const int n = n0 + tx;
    int sc;
    if (MODE == 0) sc = n; else if (MODE == 1) sc = win_srccol(n); else sc = (n & ~63) + ((n & 1) << 5) + ((n & 63) >> 1);
    if (active) {
#pragma unroll 4
        for (int i = 0; i < 16; ++i) { const int kk = 4 * i + ty; float v = 0.f; if (sc >= 0) { v = src[(size_t)(k0 + kk) * ld + sc]; if (kscale) v *= kscale[k0 + kk]; } tile[tx][kk] = v; }
    }
    __syncthreads();
    if (active) {
#pragma unroll
        for (int p = 0; p < 2; ++p) { const int it = vt + 256 * p, r = it >> 3, c = it & 7; const float* t = &tile[r][8 * c];
            u32x4 o; o.x = pk2(t[0], t[1]); o.y = pk2(t[2], t[3]); o.z = pk2(t[4], t[5]); o.w = pk2(t[6], t[7]);
            *(u32x4*)(dst + (size_t)(n0 + r) * K + k0 + 8 * c) = o; }
    }
    __syncthreads();
}
__device__ __forceinline__ void d_xprep(int vb, int vt, const float* x, unsigned char* ws) {
    const int row = vb * 4 + (vt >> 6), lane = vt & 63;
    const f32x4* xr = (const f32x4*)(x + (size_t)row * 1024) + lane; float ss = 0.f;
    bf16* o = (bf16*)(ws + OFF_XB) + (size_t)row * 1024;
#pragma unroll
    for (int j = 0; j < 4; ++j) { const f32x4 v = xr[64 * j]; ss += (v[0] * v[0] + v[1] * v[1]) + (v[2] * v[2] + v[3] * v[3]); float t[4] = {v[0], v[1], v[2], v[3]}; store_bf<4>(o + 256 * j + 4 * lane, t); }
#pragma unroll
    for (int of = 1; of < 64; of <<= 1) ss += __shfl_xor(ss, of);
    if (lane == 0) { f32x4 s = {ss, 0.f, 0.f, 0.f}; *(f32x4*)(ws + OFF_SSP + (size_t)row * 16) = s; }
}
__device__ __forceinline__ void d_sumsq(int vb, int vt, const float* x, unsigned char* ws) {
    const int row = vb * 4 + (vt >> 6), lane = vt & 63;
    const f32x4* xr = (const f32x4*)(x + (size_t)row * 1024) + lane; float ss = 0.f;
#pragma unroll
    for (int j = 0; j < 4; ++j) { const f32x4 v = xr[64 * j]; ss += (v[0] * v[0] + v[1] * v[1]) + (v[2] * v[2] + v[3] * v[3]); }
#pragma unroll
    for (int of = 1; of < 64; of <<= 1) ss += __shfl_xor(ss, of);
    if (lane == 0) { f32x4 s = {ss, 0.f, 0.f, 0.f}; *(f32x4*)(ws + OFF_SSP + (size_t)row * 16) = s; }
}
__device__ __forceinline__ void d_rope_table(int vb, int vt, const int* pos, unsigned char* ws) {
    const int idx = vb * 256 + vt, row = idx >> 5, i = idx & 31;
    const float inv = exp2f(-(float)i * (13.287712379549449f / 32.f));
    const float ang = (float)pos[row] * inv;
    float s, c; sincosf(ang, &s, &c);
    ((float*)(ws + OFF_COS))[idx] = c; ((float*)(ws + OFF_SIN))[idx] = s;
}
__device__ __forceinline__ void d_pconv(int vb, int vt, const float* p, unsigned char* ws) {
    const size_t i = ((size_t)vb * 256 + vt) * 4;
    const f32x4 v = *(const f32x4*)(p + i); float t[4] = {v[0], v[1], v[2], v[3]}; store_bf<4>((bf16*)(ws + OFF_PB) + i, t);
}
__device__ __forceinline__ void d_cb1(int vt, const float* pe, const float* w1, const float* b1, float* o) {
    const int j = vt; float acc = b1[j];
    for (int k = 0; k < 2048; ++k) acc += pe[k] * w1[(size_t)k * 256 + j];
    o[j] = acc;
}
__device__ __forceinline__ void d_lam(int vt, const float* dl, unsigned char* ws, int l) {
    if (vt == 0) { float s1 = 0.f, s2 = 0.f; for (int i = 0; i < 64; ++i) { s1 += dl[i] * dl[64 + i]; s2 += dl[128 + i] * dl[192 + i]; }
        const float li = 0.8f - 0.6f * expf(-0.3f * (float)l); ((float*)(ws + OFF_CTL))[CTL_LAM + l] = expf(s1) - expf(s2) + li; }
}
__device__ __forceinline__ void d_cumsum(int vb, int vt, unsigned char* ws) {
    const int bh = vb, b = bh >> 3, h = bh & 7, lane = vt;
    const float* lf = (const float*)(ws + OFF_LOGF) + ((size_t)(b * 4096 + 64 * lane)) * 8 + h;
    float s = 0.f;
    for (int i = 0; i < 64; ++i) s += lf[i * 8];
    float incl = s;
#pragma unroll
    for (int of = 1; of < 64; of <<= 1) { const float t = __shfl_up(incl, of); if (lane >= of) incl += t; }
    float run = incl - s;
    float* cf = (float*)(ws + OFF_CF) + (size_t)bh * 4096 + 64 * lane;
    for (int i = 0; i < 64; ++i) { run += lf[i * 8]; cf[i] = run; }
}
__device__ __forceinline__ void d_compress(bool active, int vb, int vt, float* hid, unsigned char* ws) {
    const int c = vb & 255, bg = (vb >> 8) & 7, kv = vb >> 11, j = vt;
    bf16* dstK = (bf16*)(ws + OFF_KCMP) + (size_t)bg * 16384; bf16* dstV = (bf16*)(ws + OFF_VCMP) + (size_t)bg * 16384;
    const bool pad = (c == 255);
    if (active && pad) { if (j < 64) { if (kv == 0) dstK[ktile_off(c, j)] = 0; else dstV[vtile_off(c, j)] = 0; } }
    if (active && !pad) {
        const bf16* src = (const bf16*)(ws + (kv ? OFF_VCB : OFF_KCB)) + ((size_t)bg * 4096 + 16 * c) * 64;
        const bf16* w = (const bf16*)(ws + OFF_CW1) + (size_t)(kv * 256 + j) * 2048;
        float acc = ((const float*)(ws + OFF_CB1))[kv * 256 + j];
        for (int k = 0; k < 2048; k += 8) { const bf16x8 a = *(const bf16x8*)(src + k), bb = *(const bf16x8*)(w + k);
#pragma unroll
            for (int i = 0; i < 8; ++i) acc += bf2f((bf16)a[i]) * bf2f((bf16)bb[i]); }
        hid[j] = bf2f(f2bf(siluf_(acc)));
    }
    __syncthreads();
    if (active && !pad && j < 64) { const bf16* w2 = (const bf16*)(ws + OFF_CW2) + (size_t)(kv * 64 + j) * 256; float o = 0.f;
        for (int k = 0; k < 256; ++k) o += hid[k] * bf2f(w2[k]);
        if (kv == 0) dstK[ktile_off(c, j)] = f2bf(o); else dstV[vtile_off(c, j)] = f2bf(o); }
    __syncthreads();
}
__device__ __forceinline__ void d_fox(int vb, int vt, unsigned char* ws) {
    const int bh = (vb & 31), b = bh >> 3, h = bh & 7, t = (vb >> 5) * 64 + vt, tmax = (vb >> 5) * 64 + 63;
    const bf16* Q = (const bf16*)(ws + OFF_QA) + ((size_t)bh * 4096 + t) * 64;
    const bf16* Kb = (const bf16*)(ws + OFF_KA) + (size_t)bh * 262144; const bf16* Vb = (const bf16*)(ws + OFF_VA) + (size_t)bh * 262144;
    const float* cf = (const float*)(ws + OFF_CF) + (size_t)bh * 4096;
    float q[64], o[64];
#pragma unroll
    for (int d = 0; d < 64; ++d) { q[d] = bf2f(Q[d]); o[d] = 0.f; }
    const float ci = cf[t]; float m = -1e30f, l = 0.f;
    for (int j = 0; j <= tmax; ++j) {
        float s = 0.f;
#pragma unroll
        for (int d = 0; d < 64; ++d) s += q[d] * bf2f(Kb[ktile_off(j, d)]);
        s += ci - cf[j];
        if (j <= t) { const float mn = fmaxf(m, s), al = exp2f(m - mn), p = exp2f(s - mn); l = l * al + p; m = mn;
#pragma unroll
            for (int d = 0; d < 64; ++d) o[d] = o[d] * al + p * bf2f(Vb[vtile_off(j, d)]); }
    }
    const float il = 1.f / l; bf16* Y = (bf16*)(ws + OFF_ZA) + (size_t)(b * 4096 + t) * 512 + h * 64;
#pragma unroll
    for (int d = 0; d < 64; ++d) Y[d] = f2bf(o[d] * il * bf2f(Y[d]));
}
__device__ __forceinline__ void d_diff(int vb, int vt, float (*res)[129], unsigned char* ws, const float* subg, int l) {
    const int bhc = (vb & 15), b = bhc >> 2, hc = bhc & 3, t = (vb >> 4) * 64 + vt, tmax = (vb >> 4) * 64 + 63;
    const float lam = ((const float*)(ws + OFF_CTL))[CTL_LAM + l], lam_init = 0.8f - 0.6f * expf(-0.3f * (float)l);
    const bf16* Vb = (const bf16*)(ws + OFF_VC) + (size_t)bhc * 524288;
    for (int dh = 0; dh < 2; ++dh) {
        for (int mp = 0; mp < 2; ++mp) {
            const int hh = b * 8 + hc * 2 + mp;
            const bf16* Q = (const bf16*)(ws + OFF_QC) + ((size_t)hh * 4096 + t) * 64; const bf16* Kb = (const bf16*)(ws + OFF_KC) + (size_t)hh * 262144;
            float q[64], o[64];
#pragma unroll
            for (int d = 0; d < 64; ++d) { q[d] = bf2f(Q[d]); o[d] = 0.f; }
            float m = -1e30f, ls = 0.f;
            for (int j = 0; j <= tmax; ++j) {
                float s = 0.f;
#pragma unroll
                for (int d = 0; d < 64; ++d) s += q[d] * bf2f(Kb[ktile_off(j, d)]);
                if (j <= t) { const float mn = fmaxf(m, s), al = exp2f(m - mn), p = exp2f(s - mn); ls = ls * al + p; m = mn;
#pragma unroll
                    for (int d = 0; d < 64; ++d) o[d] = o[d] * al + p * bf2f(Vb[v128_off(j, dh * 64 + d)]); }
            }
            const float il = 1.f / ls;
#pragma unroll
            for (int d = 0; d < 64; ++d) { if (mp == 0) res[vt][dh * 64 + d] = o[d] * il; else res[vt][dh * 64 + d] -= lam * o[d] * il; }
        }
    }
    float ss = 0.f;
    for (int d = 0; d < 128; ++d) { const float v = res[vt][d]; ss += v * v; }
    const float rs = rsqrtf(ss * (1.f / 128.f) + EPS) * (1.f - lam_init);
    bf16* Y = (bf16*)(ws + OFF_ZC) + (size_t)(b * 4096 + t) * 512 + hc * 128;
    for (int d = 0; d < 128; ++d) Y[d] = f2bf(res[vt][d] * rs * subg[d] * bf2f(Y[d]));
}
__device__ __forceinline__ void d_nsa_topk(int vb, int vt, float (*imp)[65], unsigned char* ws) {
    const int bg = (vb & 7), b = bg >> 1, g = bg & 1, tb = (vb >> 3), t = tb * 64 + vt;
    for (int j = 0; j < 64; ++j) imp[vt][j] = 0.f;
    const int nv = (t >= 31) ? ((t - 31) >> 4) + 1 : 0, nvmax = ((tb * 64 + 63 - 31) >> 4) + 1;
    const bf16* Kc = (const bf16*)(ws + OFF_KCMP) + (size_t)bg * 16384;
    for (int hq = 0; hq < 4; ++hq) {
        const int h = g * 4 + hq;
        const bf16* Q = (const bf16*)(ws + OFF_QB) + ((size_t)(b * 8 + h) * 4096 + t) * 64;
        float q[64];
#pragma unroll
        for (int d = 0; d < 64; ++d) q[d] = bf2f(Q[d]);
        float m = -1e30f, ls = 0.f;
        for (int c = 0; c < nvmax; ++c) { float s = 0.f;
#pragma unroll
            for (int d = 0; d < 64; ++d) s += q[d] * bf2f(Kc[ktile_off(c, d)]);
            if (c < nv) { const float mn = fmaxf(m, s); ls = ls * exp2f(m - mn) + exp2f(s - mn); m = mn; } }
        const float il = nv > 0 ? 1.f / ls : 0.f;
        for (int c = 0; c < nvmax; ++c) { float s = 0.f;
#pragma unroll
            for (int d = 0; d < 64; ++d) s += q[d] * bf2f(Kc[ktile_off(c, d)]);
            if (c < nv) { const float p = exp2f(s - m) * il; imp[vt][c >> 2] += p; if ((c & 3) == 3 && (c >> 2) + 1 < 64) imp[vt][(c >> 2) + 1] += p; } }
    }
    for (int j = 0; j < 64; ++j) { const bool forced = (j == 0) || (j == tb) || (j == tb - 1), valid = j <= tb; const float v = imp[vt][j];
        imp[vt][j] = forced ? 1e30f : (valid ? v : -1e30f); }
    unsigned long long mask = 0ull;
    for (int j = 0; j < 64; ++j) { const float sj = imp[vt][j]; int rank = 0;
        for (int k = 0; k < 64; ++k) { const float sk = imp[vt][k]; rank += (sk > sj || (sk == sj && k < j)) ? 1 : 0; }
        if (rank < 16) mask |= (1ull << j); }
    ((unsigned long long*)(ws + OFF_SELM))[(size_t)bg * 4096 + t] = mask;
}
__device__ __forceinline__ void d_nsa_attn(int vb, int vt, float (*yl)[65], unsigned char* ws) {
    const int bh = (vb & 31), b = bh >> 3, h = bh & 7, g = h >> 2, bg = b * 2 + g, tb = (vb >> 5), t = tb * 64 + vt, row = b * 4096 + t;
    const bf16* Q = (const bf16*)(ws + OFF_QB) + ((size_t)bh * 4096 + t) * 64;
    float q[64], o[64];
#pragma unroll
    for (int d = 0; d < 64; ++d) { q[d] = bf2f(Q[d]); yl[vt][d] = 0.f; }
    const float* gt = (const float*)(ws + OFF_GATES) + (size_t)row * 24 + h * 3;
    const float g0 = gt[0], g1 = gt[1], g2 = gt[2];
    { const int nv = (t >= 31) ? ((t - 31) >> 4) + 1 : 0, nvmax = ((tb * 64 + 63 - 31) >> 4) + 1;
      const bf16* Kc = (const bf16*)(ws + OFF_KCMP) + (size_t)bg * 16384; const bf16* Vc = (const bf16*)(ws + OFF_VCMP) + (size_t)bg * 16384;
      float m = -1e30f, ls = 0.f;
#pragma unroll
      for (int d = 0; d < 64; ++d) o[d] = 0.f;
      for (int c = 0; c < nvmax; ++c) { float s = 0.f;
#pragma unroll
          for (int d = 0; d < 64; ++d) s += q[d] * bf2f(Kc[ktile_off(c, d)]);
          if (c < nv) { const float mn = fmaxf(m, s), al = exp2f(m - mn), p = exp2f(s - mn); ls = ls * al + p; m = mn;
#pragma unroll
              for (int d = 0; d < 64; ++d) o[d] = o[d] * al + p * bf2f(Vc[vtile_off(c, d)]); } }
      const float il = nv > 0 ? g0 / ls : 0.f;
#pragma unroll
      for (int d = 0; d < 64; ++d) yl[vt][d] += o[d] * il; }
    { const float* cs = (const float*)(ws + OFF_COS) + (size_t)row * 32; const float* sn = (const float*)(ws + OFF_SIN) + (size_t)row * 32;
#pragma unroll
      for (int i = 0; i < 32; ++i) { const float c = cs[i], s = sn[i], x1 = q[2 * i], x2 = q[2 * i + 1]; q[2 * i] = bf2f(f2bf(x1 * c - x2 * s)); q[2 * i + 1] = bf2f(f2bf(x2 * c + x1 * s)); } }
    { const unsigned long long mask = ((const unsigned long long*)(ws + OFF_SELM))[(size_t)bg * 4096 + t];
      const bf16* Kb = (const bf16*)(ws + OFF_KSEL) + (size_t)bg * 262144; const bf16* Vb = (const bf16*)(ws + OFF_VSEL) + (size_t)bg * 262144;
      float m = -1e30f, ls = 0.f;
#pragma unroll
      for (int d = 0; d < 64; ++d) o[d] = 0.f;
      for (int j = 0; j <= tb; ++j) { const bool sel = (mask >> j) & 1ull;
          for (int kk = 0; kk < 64; ++kk) { const int kp = j * 64 + kk; float s = 0.f;
#pragma unroll
              for (int d = 0; d < 64; ++d) s += q[d] * bf2f(Kb[ktile_off(kp, d)]);
              if (sel && kp <= t) { const float mn = fmaxf(m, s), al = exp2f(m - mn), p = exp2f(s - mn); ls = ls * al + p; m = mn;
#pragma unroll
                  for (int d = 0; d < 64; ++d) o[d] = o[d] * al + p * bf2f(Vb[vtile_off(kp, d)]); } } }
      const float il = g1 / ls;
#pragma unroll
      for (int d = 0; d < 64; ++d) yl[vt][d] += o[d] * il; }
    { const bf16* Kb = (const bf16*)(ws + OFF_KWIN) + (size_t)bg * 262144; const bf16* Vb = (const bf16*)(ws + OFF_VWIN) + (size_t)bg * 262144;
      float m = -1e30f, ls = 0.f;
#pragma unroll
      for (int d = 0; d < 64; ++d) o[d] = 0.f;
      const int k_lo = max(0, tb * 64 - 511), k_hi = tb * 64 + 63;
      for (int kp = k_lo; kp <= k_hi; ++kp) { float s = 0.f;
#pragma unroll
          for (int d = 0; d < 64; ++d) s += q[d] * bf2f(Kb[ktile_off(kp, d)]);
          if (kp <= t && kp > t - 512) { const float mn = fmaxf(m, s), al = exp2f(m - mn), p = exp2f(s - mn); ls = ls * al + p; m = mn;
#pragma unroll
              for (int d = 0; d < 64; ++d) o[d] = o[d] * al + p * bf2f(Vb[vtile_off(kp, d)]); } }
      const float il = g2 / ls;
#pragma unroll
      for (int d = 0; d < 64; ++d) yl[vt][d] += o[d] * il; }
    bf16* Y = (bf16*)(ws + OFF_ZB) + (size_t)row * 512 + h * 64;
#pragma unroll
    for (int d = 0; d < 64; ++d) Y[d] = f2bf(yl[vt][d] * bf2f(Y[d]));
}
__device__ __forceinline__ void d_final(int vb, int vt, float* X, const float* g) {
    const int row = vb * 4 + (vt >> 6), lane = vt & 63;
    f32x4* xr = (f32x4*)(X + (size_t)row * 1024) + lane; f32x4 v[4]; float ss = 0.f;
#pragma unroll
    for (int j = 0; j < 4; ++j) { v[j] = xr[64 * j]; ss += (v[j][0] * v[j][0] + v[j][1] * v[j][1]) + (v[j][2] * v[j][2] + v[j][3] * v[j][3]); }
#pragma unroll
    for (int of = 1; of < 64; of <<= 1) ss += __shfl_xor(ss, of);
    const float rs = rsqrtf(ss * (1.f / 1024.f) + EPS);
#pragma unroll
    for (int j = 0; j < 4; ++j) { const f32x4 gg = *((const f32x4*)g + 64 * j + lane); xr[64 * j] = v[j] * rs * gg; }
}


namespace cg = cooperative_groups;
constexpr int NT = 512;
constexpr int LDS_BYTES = 147456;
struct KArgs { const void* in[23]; float* out; unsigned char* ws; };

#define OPAQUE_TID() int tid = threadIdx.x; asm volatile("" : "+v"(tid))
#define VRUN(VT, NVB, CALL) do { OPAQUE_TID(); constexpr int per_ = NT / (VT); for (int vb = blockIdx.x * per_ + tid / (VT); vb < (NVB); vb += gridDim.x * per_) { const int vt = tid % (VT); CALL; } } while (0)
#define VRUN_BAR(NVB, CALL) do { OPAQUE_TID(); float (*tile)[65] = (float (*)[65])(lds + (tid >> 8) * 64 * 65 * 4); (void)tile; const int nvb_ = (NVB); for (int it_ = 0; it_ * (int)gridDim.x * 2 < nvb_; ++it_) { const int vb = (it_ * (int)gridDim.x + (int)blockIdx.x) * 2 + (tid >> 8); const int vt = tid & 255; const bool active = vb < nvb_; CALL; } } while (0)

__global__ void __launch_bounds__(NT) mega(KArgs a) {
    extern __shared__ __attribute__((aligned(16))) unsigned char lds[];
    cg::grid_group grid = cg::this_grid();
    unsigned char* ws = a.ws; float* X = a.out;
    const float* x = (const float*)a.in[0]; const float* p = (const float*)a.in[1]; const int* pos = (const int*)a.in[2];
    const float *norm_g = (const float*)a.in[3], *w_in = (const float*)a.in[4], *b_forget = (const float*)a.in[5];
    const float *pe_k = (const float*)a.in[6], *w1_k = (const float*)a.in[7], *b1_k = (const float*)a.in[8], *w2_k = (const float*)a.in[9];
    const float *pe_v = (const float*)a.in[10], *w1_v = (const float*)a.in[11], *b1_v = (const float*)a.in[12], *w2_v = (const float*)a.in[13];
    const float *diff_lam = (const float*)a.in[14], *subln = (const float*)a.in[15];
    const float *w_out = (const float*)a.in[19], *w_ple = (const float*)a.in[20], *w_pg = (const float*)a.in[21], *final_g = (const float*)a.in[22];
    VRUN(256, M / 4, d_xprep(vb, vt, x, ws));
    VRUN(256, M * 32 / 256, d_rope_table(vb, vt, pos, ws));
    VRUN(256, (2 * M * 256 / 4) / 256, d_pconv(vb, vt, p, ws));
    for (int l = 0; l < DEPTH; ++l) {
        VRUN_BAR(256, d_convT<0>(active, vb % 16, vb / 16, vt, tile, w_out + (size_t)l * 1024 * 1024, 1024, 1024, (bf16*)(ws + OFF_WOUT) + (size_t)l * 1024 * 1024, nullptr));
        VRUN_BAR(256, d_convT<0>(active, vb % 16, vb / 16, vt, tile, w_pg + (size_t)l * 1024 * 1024, 1024, 1024, (bf16*)(ws + OFF_WPG) + (size_t)l * 1024 * 1024, nullptr));
        VRUN_BAR(64, d_convT<0>(active, vb % 16, vb / 16, vt, tile, w_ple + (size_t)l * 256 * 1024, 1024, 256, (bf16*)(ws + OFF_WPL) + (size_t)l * 1024 * 256, nullptr));
        { OPAQUE_TID(); if (blockIdx.x == 0 && tid < 64) d_lam(tid, diff_lam + l * 256, ws, l); }
    }
    for (int l = 0; l < DEPTH; ++l) {
        const float* wl = w_in + (size_t)l * 1024 * NIN; const float* ng = norm_g + l * 1024;
        VRUN_BAR(96 * 16, d_convT<1>(active, vb % 96, vb / 96, vt, tile, wl, NIN, 1024, (bf16*)(ws + OFF_WIN), ng));
        VRUN_BAR(48 * 16, d_convT<0>(active, vb % 48, vb / 48, vt, tile, wl + 5920, NIN, 1024, (bf16*)(ws + OFF_WMG), ng));
        for (int i = 0; i < 3; ++i) { const float* wb = (const float*)a.in[16 + i] + (size_t)l * 512 * 1024;
            VRUN_BAR(16 * 8, d_convT<0>(active, vb % 16, vb / 16, vt, tile, wb, 1024, 512, (bf16*)(ws + OFF_WBR) + (size_t)i * 1024 * 512, nullptr)); }
        VRUN_BAR(4 * 32, d_convT<0>(active, vb % 4, vb / 4, vt, tile, w1_k + (size_t)l * 2048 * 256, 256, 2048, (bf16*)(ws + OFF_CW1), nullptr));
        VRUN_BAR(4 * 32, d_convT<0>(active, vb % 4, vb / 4, vt, tile, w1_v + (size_t)l * 2048 * 256, 256, 2048, (bf16*)(ws + OFF_CW1) + 256 * 2048, nullptr));
        VRUN_BAR(4, d_convT<2>(active, 0, vb, vt, tile, w2_k + (size_t)l * 256 * 64, 64, 256, (bf16*)(ws + OFF_CW2), nullptr));
        VRUN_BAR(4, d_convT<0>(active, 0, vb, vt, tile, w2_v + (size_t)l * 256 * 64, 64, 256, (bf16*)(ws + OFF_CW2) + 64 * 256, nullptr));
        { OPAQUE_TID(); if (blockIdx.x == 1 && tid < 256) d_cb1(tid, pe_k + l * 2048, w1_k + (size_t)l * 2048 * 256, b1_k + l * 256, (float*)(ws + OFF_CB1));
          if (blockIdx.x == 2 && tid < 256) d_cb1(tid, pe_v + l * 2048, w1_v + (size_t)l * 2048 * 256, b1_v + l * 256, (float*)(ws + OFF_CB1) + 256); }
        grid.sync();
        EpiCtx E{ws, b_forget + l * 8, l == 0 ? x : X, X, 0};
        VRUN(256, (NP / 128) * (M / 128), d_gemm<EPI_INPROJ>(vb, vt, NP / 128, (const bf16*)(ws + OFF_XB), (const bf16*)(ws + OFF_WIN), 1024, E));
        grid.sync();
        VRUN(64, 32, d_cumsum(vb, vt, ws));
        VRUN_BAR(256 * 8 * 2, d_compress(active, vb, vt, (float*)lds + (tid >> 8) * 256, ws));
        grid.sync();
        VRUN(64, 32 * 64, d_fox(vb, vt, ws));
        { OPAQUE_TID(); if ((tid >> 6) < 4) { for (int vb = blockIdx.x * 4 + (tid >> 6); vb < 16 * 64; vb += gridDim.x * 4) d_diff(vb, tid & 63, (float (*)[129])(lds + (tid >> 6) * 64 * 129 * 4), ws, subln + l * 128, l); } }
        __syncthreads();
        VRUN(64, 8 * 64, d_nsa_topk(vb, vt, (float (*)[65])(lds + (tid >> 6) * 64 * 65 * 4), ws));
        grid.sync();
        VRUN(64, 32 * 64, d_nsa_attn(vb, vt, (float (*)[65])(lds + (tid >> 6) * 64 * 65 * 4), ws));
        grid.sync();
        VRUN(256, 8 * 128, d_gemm<EPI_GATE>(vb, vt, 8, (const bf16*)(ws + OFF_XB), (const bf16*)(ws + OFF_WMG), 1024, E));
        VRUN(256, 8 * 128, d_gemm<EPI_BR0>(vb, vt, 8, (const bf16*)(ws + OFF_ZA), (const bf16*)(ws + OFF_WBR), 512, E));
        VRUN(256, 8 * 128, d_gemm<EPI_GATE>(vb, vt, 8, (const bf16*)(ws + OFF_XB), (const bf16*)(ws + OFF_WMG) + (size_t)1024 * 1024, 1024, E));
        VRUN(256, 8 * 128, d_gemm<EPI_BR1>(vb, vt, 8, (const bf16*)(ws + OFF_ZB), (const bf16*)(ws + OFF_WBR) + (size_t)1024 * 512, 512, E));
        VRUN(256, 8 * 128, d_gemm<EPI_GATE>(vb, vt, 8, (const bf16*)(ws + OFF_XB), (const bf16*)(ws + OFF_WMG) + (size_t)2 * 1024 * 1024, 1024, E));
        VRUN(256, 8 * 128, d_gemm<EPI_BR2>(vb, vt, 8, (const bf16*)(ws + OFF_ZC), (const bf16*)(ws + OFF_WBR) + (size_t)2 * 1024 * 512, 512, E));
        grid.sync();
        VRUN(256, 8 * 128, d_gemm<EPI_OUT>(vb, vt, 8, (const bf16*)(ws + OFF_MERGED), (const bf16*)(ws + OFF_WOUT) + (size_t)l * 1024 * 1024, 1024, E));
        grid.sync();
        VRUN(256, 8 * 128, d_gemm<EPI_U>(vb, vt, 8, (const bf16*)(ws + OFF_PB) + (size_t)l * M * 256, (const bf16*)(ws + OFF_WPL) + (size_t)l * 1024 * 256, 256, E));
        VRUN(256, 8 * 128, d_gemm<EPI_PLE>(vb, vt, 8, (const bf16*)(ws + OFF_X1B), (const bf16*)(ws + OFF_WPG) + (size_t)l * 1024 * 1024, 1024, E));
        grid.sync();
        if (l + 1 < DEPTH) VRUN(256, M / 4, d_sumsq(vb, vt, X, ws));
    }
    VRUN(256, M / 4, d_final(vb, vt, X, final_g));
}

extern "C" void kernel_launch(void* const* d_in, const int* in_sizes, int n_in, void* d_out, int out_size, void* d_ws, size_t ws_size, hipStream_t stream) {
    static int grid_blocks = 0;
    if (grid_blocks == 0) {
        if (n_in != 23 || ws_size < WS_NEED || out_size != M * DM) { fprintf(stderr, "kernel_launch: unexpected sizes (n_in %d ws %zu out %d)\n", n_in, ws_size, out_size); grid_blocks = -1; return; }
        int dev = 0, cus = 0, per_cu = 0;
        (void)hipGetDevice(&dev); (void)hipDeviceGetAttribute(&cus, hipDeviceAttributeMultiprocessorCount, dev);
        (void)hipFuncSetAttribute((const void*)mega, hipFuncAttributeMaxDynamicSharedMemorySize, LDS_BYTES);
        (void)hipOccupancyMaxActiveBlocksPerMultiprocessor(&per_cu, (const void*)mega, NT, LDS_BYTES);
        if (per_cu < 1) { fprintf(stderr, "kernel_launch: occupancy query says %d blocks per CU\n", per_cu); grid_blocks = -1; return; }
        grid_blocks = cus * 1;
    }
    if (grid_blocks < 0) return;
    (void)hipMemsetAsync((char*)d_ws + OFF_CTL, 0, 4096, stream);
    KArgs a{};
    for (int i = 0; i < 23; ++i) a.in[i] = d_in[i];
    a.out = (float*)d_out; a.ws = (unsigned char*)d_ws;
    void* args[] = {&a};
    hipError_t e = hipLaunchCooperativeKernel((const void*)mega, dim3(grid_blocks), dim3(NT), args, LDS_BYTES, stream);
    if (e != hipSuccess) fprintf(stderr, "cooperative launch failed: %s (grid %d)\n", hipGetErrorString(e), grid_blocks);
}
```

```cpp
#include <hip/hip_runtime.h>
#include <hip/hip_cooperative_groups.h>
#include <cstdio>
#include <cstdint>

typedef unsigned short bf16;
typedef short bf16x8 __attribute__((ext_vector_type(8)));
typedef float f32x4 __attribute__((ext_vector_type(4)));
typedef float f32x16 __attribute__((ext_vector_type(16)));
typedef unsigned u32x4 __attribute__((ext_vector_type(4)));
typedef unsigned u32x2 __attribute__((ext_vector_type(2)));

constexpr int BATCH = 4, SEQ = 4096, DM = 1024, M = BATCH * SEQ, DEPTH = 2, NIN = 8992, NP = 6144;
constexpr float EPS = 1e-6f;
constexpr float LOG2E = 1.4426950408889634f;
constexpr float C2 = 0.125f * LOG2E;
constexpr size_t MiB = 1u << 20;
constexpr size_t OFF_CTL = 0;
constexpr size_t OFF_WIN = 1 * MiB, OFF_WMG = 13 * MiB, OFF_WBR = 19 * MiB, OFF_CW1 = 22 * MiB, OFF_CW2 = 24 * MiB, OFF_CB1 = 24 * MiB + 128 * 1024;
constexpr size_t OFF_WOUT = 25 * MiB, OFF_WPG = 29 * MiB, OFF_WPL = 33 * MiB;
constexpr size_t OFF_XB = 34 * MiB, OFF_ZA = 66 * MiB, OFF_ZB = 82 * MiB, OFF_ZC = 98 * MiB;
constexpr size_t OFF_COS = 114 * MiB, OFF_SIN = 116 * MiB, OFF_PB = 118 * MiB;
constexpr size_t OFF_LOGF = 134 * MiB, OFF_CF = 134 * MiB + 512 * 1024, OFF_GATES = 135 * MiB, OFF_SSP = 136 * MiB + 512 * 1024;
constexpr size_t OFF_KCMP = 136 * MiB + 768 * 1024, OFF_VCMP = 137 * MiB, OFF_SELM = 137 * MiB + 256 * 1024;
constexpr size_t OFF_QA = 139 * MiB, OFF_KA = 155 * MiB, OFF_VA = 171 * MiB, OFF_QB = 187 * MiB, OFF_QC = 203 * MiB, OFF_KC = 219 * MiB, OFF_VC = 235 * MiB;
constexpr size_t OFF_KCB = 251 * MiB, OFF_VCB = 255 * MiB, OFF_KSEL = 259 * MiB, OFF_KWIN = 263 * MiB, OFF_VSEL = 267 * MiB, OFF_VWIN = 271 * MiB;
constexpr size_t WS_NEED = 275 * MiB;
constexpr size_t OFF_G = 139 * MiB, OFF_MERGED = 171 * MiB, OFF_T = 203 * MiB, OFF_X1B = 203 * MiB, OFF_U = 139 * MiB;
constexpr int CTL_LAM = 64;

__device__ __forceinline__ bf16 f2bf(float f) { unsigned u = __float_as_uint(f); return (bf16)((u + 0x7fffu + ((u >> 16) & 1u)) >> 16); }
__device__ __forceinline__ float bf2f(bf16 h) { return __uint_as_float(((unsigned)h) << 16); }
__device__ __forceinline__ unsigned pk2(float lo, float hi) { return (unsigned)f2bf(lo) | ((unsigned)f2bf(hi) << 16); }
__device__ __forceinline__ float sigmoidf_(float x) { return 1.f / (1.f + __expf(-x)); }
__device__ __forceinline__ float siluf_(float x) { return x / (1.f + __expf(-x)); }
__device__ __forceinline__ float logsigmoidf_(float x) { return x >= 0.f ? -log1pf(expf(-x)) : x - log1pf(expf(x)); }

__device__ __forceinline__ int ktile_off(int s, int d) { return (s >> 6) * 4096 + (d >> 3) * 512 + (s & 63) * 8 + (d & 7); }
__device__ __forceinline__ int vtile_off(int s, int d) { return (s >> 6) * 4096 + (d >> 5) * 2048 + ((s & 63) >> 4) * 512 + (s & 15) * 32 + (d & 31); }
__device__ __forceinline__ int v128_off(int s, int d) { return (s >> 6) * 8192 + (d >> 5) * 2048 + ((s & 63) >> 4) * 512 + (s & 15) * 32 + (d & 31); }

template <int W> __device__ __forceinline__ void store_bf(bf16* dst, const float* v) {
    if constexpr (W == 4) { u32x2 o; o.x = pk2(v[0], v[1]); o.y = pk2(v[2], v[3]); *(u32x2*)dst = o; }
    else { u32x4 o; o.x = pk2(v[0], v[1]); o.y = pk2(v[2], v[3]); o.z = pk2(v[4], v[5]); o.w = pk2(v[6], v[7]); *(u32x4*)dst = o; }
}

__device__ __forceinline__ int win_srccol(int n) {
    const int seg = n >> 6, j = n & 63; const int il = ((j & 1) << 5) + (j >> 1);
    if (seg < 8) return 0 + n;
    if (seg < 16) return 512 + (n - 512);
    if (seg < 24) return 1024 + (n - 1024);
    if (seg < 32) return 1544 + (n - 1536);
    if (seg < 40) return 2056 + (seg - 32) * 64 + il;
    if (seg < 42) return 2568 + (n - 2560);
    if (seg < 44) return 2696 + (n - 2688);
    if (seg < 46) return 2824 + (seg - 44) * 64 + il;
    if (seg < 48) return 3080 + (seg - 46) * 64 + il;
    if (seg < 50) return 2952 + (n - 3072);
    if (seg < 52) return 3208 + (n - 3200);
    if (seg < 60) return 3360 + (n - 3328);
    if (seg < 68) return 3872 + (seg - 60) * 64 + il;
    if (seg < 76) return 4384 + (seg - 68) * 64 + il;
    if (seg < 84) return 4896 + (n - 4864);
    if (seg < 92) return 5408 + (n - 5376);
    if (seg == 92) { if (j < 8) return 1536 + j; if (j < 32) return 3336 + (j - 8); return -1; }
    return -1;
}

enum { EPI_INPROJ = 0, EPI_GATE = 1, EPI_BR0 = 2, EPI_BR1 = 3, EPI_BR2 = 4, EPI_OUT = 5, EPI_U = 6, EPI_PLE = 7 };
struct EpiCtx { unsigned char* ws; const float* bfg; const float* xin; float* X; int gi; };

__device__ __forceinline__ float row_rstd(const unsigned char* ws, int row) {
    const f32x4 sp = *(const f32x4*)(ws + OFF_SSP + (size_t)row * 16);
    return rsqrtf(((sp[0] + sp[1]) + (sp[2] + sp[3])) * (1.f / 1024.f) + EPS);
}
template <int W> __device__ __forceinline__ void rope_apply(const unsigned char* ws, int row, int d, float* v) {
    const float* cs = (const float*)(ws + OFF_COS) + (size_t)row * 32 + (d >> 1);
    const float* sn = (const float*)(ws + OFF_SIN) + (size_t)row * 32 + (d >> 1);
#pragma unroll
    for (int j = 0; j < W / 2; ++j) { const float c = cs[j], s = sn[j], x1 = v[2 * j], x2 = v[2 * j + 1]; v[2 * j] = x1 * c - x2 * s; v[2 * j + 1] = x2 * c + x1 * s; }
}

enum { T_QA = 0, T_KA, T_VA, T_ZA, T_QB, T_CB, T_KROPE, T_VSW, T_ZB, T_QC, T_KC, T_VC, T_ZC, T_SPECIAL };
__device__ __forceinline__ int inproj_type(int t) {
    return t < 2 ? T_QA : t < 4 ? T_KA : t < 6 ? T_VA : t < 8 ? T_ZA : t < 10 ? T_QB : t == 10 ? T_CB : t == 11 ? T_KROPE : t == 12 ? T_VSW : t < 15 ? T_ZB : t < 17 ? T_QC : t < 19 ? T_KC : t < 21 ? T_VC : t < 23 ? T_ZC : T_SPECIAL;
}
template <int T, int W> __device__ __forceinline__ void emit_inproj(const EpiCtx& E, int row, int col, const float* a) {
    unsigned char* ws = E.ws;
    const float rs = row_rstd(ws, row);
    float v[W];
#pragma unroll
    for (int i = 0; i < W; ++i) v[i] = a[i] * rs;
    const int b = row >> 12, s = row & 4095;
    if constexpr (T == T_QA) { const int cc = col, h = cc >> 6, d = cc & 63;
#pragma unroll
        for (int i = 0; i < W; ++i) v[i] *= C2;
        store_bf<W>((bf16*)(ws + OFF_QA) + ((size_t)(b * 8 + h) * 4096 + s) * 64 + d, v);
    } else if constexpr (T == T_KA) { const int cc = col - 512, h = cc >> 6, d = cc & 63;
        store_bf<W>((bf16*)(ws + OFF_KA) + (size_t)(b * 8 + h) * 262144 + ktile_off(s, d), v);
    } else if constexpr (T == T_VA) { const int cc = col - 1024, h = cc >> 6, d = cc & 63;
        store_bf<W>((bf16*)(ws + OFF_VA) + (size_t)(b * 8 + h) * 262144 + vtile_off(s, d), v);
    } else if constexpr (T == T_ZA || T == T_ZB || T == T_ZC) { const int cc = col - (T == T_ZA ? 1536 : T == T_ZB ? 3328 : 5376);
#pragma unroll
        for (int i = 0; i < W; ++i) v[i] = siluf_(v[i]);
        store_bf<W>((bf16*)(ws + (T == T_ZA ? OFF_ZA : T == T_ZB ? OFF_ZB : OFF_ZC)) + (size_t)row * 512 + cc, v);
    } else if constexpr (T == T_QB) { const int cc = col - 2048, h = cc >> 6, d = cc & 63;
#pragma unroll
        for (int i = 0; i < W; ++i) v[i] *= C2;
        store_bf<W>((bf16*)(ws + OFF_QB) + ((size_t)(b * 8 + h) * 4096 + s) * 64 + d, v);
    } else if constexpr (T == T_CB) { const int cc = col - 2560, g = (cc >> 6) & 1, d = cc & 63;
        store_bf<W>((bf16*)(ws + (cc < 128 ? OFF_KCB : OFF_VCB)) + ((size_t)(b * 2 + g) * 4096 + s) * 64 + d, v);
    } else if constexpr (T == T_KROPE) { const int cc = col - 2816, g = (cc >> 6) & 1, d = cc & 63;
        rope_apply<W>(ws, row, d, v);
        store_bf<W>((bf16*)(ws + (cc < 128 ? OFF_KSEL : OFF_KWIN)) + (size_t)(b * 2 + g) * 262144 + ktile_off(s, d), v);
    } else if constexpr (T == T_VSW) { const int cc = col - 3072, g = (cc >> 6) & 1, d = cc & 63;
        store_bf<W>((bf16*)(ws + (cc < 128 ? OFF_VSEL : OFF_VWIN)) + (size_t)(b * 2 + g) * 262144 + vtile_off(s, d), v);
    } else if constexpr (T == T_QC) { const int cc = col - 3840, h = cc >> 6, d = cc & 63;
        rope_apply<W>(ws, row, d, v);
#pragma unroll
        for (int i = 0; i < W; ++i) v[i] *= C2;
        store_bf<W>((bf16*)(ws + OFF_QC) + ((size_t)(b * 8 + h) * 4096 + s) * 64 + d, v);
    } else if constexpr (T == T_KC) { const int cc = col - 4352, h = cc >> 6, d = cc & 63;
        rope_apply<W>(ws, row, d, v);
        store_bf<W>((bf16*)(ws + OFF_KC) + (size_t)(b * 8 + h) * 262144 + ktile_off(s, d), v);
    } else if constexpr (T == T_VC) { const int cc = col - 4864, hc = cc >> 7, d = cc & 127;
        store_bf<W>((bf16*)(ws + OFF_VC) + (size_t)(b * 4 + hc) * 524288 + v128_off(s, d), v);
    } else { const int cc = col - 5888;
        if (cc < 8) { float* o = (float*)(ws + OFF_LOGF) + (size_t)row * 8 + cc;
#pragma unroll
            for (int i = 0; i < W; ++i) o[i] = logsigmoidf_(v[i] + E.bfg[cc + i]) * LOG2E;
        } else if (cc < 32) { float* o = (float*)(ws + OFF_GATES) + (size_t)row * 24 + (cc - 8);
#pragma unroll
            for (int i = 0; i < W; ++i) o[i] = sigmoidf_(v[i]);
        }
    }
}

template <int KIND, int W> __device__ __forceinline__ void emit(const EpiCtx& E, int row, int col, const float* a) {
    unsigned char* ws = E.ws;
    const size_t idx = (size_t)row * 1024 + col;
    if constexpr (KIND == EPI_GATE) {
        const float rs = row_rstd(ws, row); float v[W];
#pragma unroll
        for (int i = 0; i < W; ++i) v[i] = sigmoidf_(a[i] * rs);
        store_bf<W>((bf16*)(ws + OFF_G) + idx, v);
    } else if constexpr (KIND == EPI_BR0 || KIND == EPI_BR1 || KIND == EPI_BR2) {
        const bf16* g = (const bf16*)(ws + OFF_G) + idx; float* T = (float*)(ws + OFF_T) + idx; float v[W];
#pragma unroll
        for (int i = 0; i < W; ++i) { v[i] = bf2f(g[i]) * a[i]; if (KIND != EPI_BR0) v[i] += T[i]; }
        if constexpr (KIND == EPI_BR2) store_bf<W>((bf16*)(ws + OFF_MERGED) + idx, v);
        else {
#pragma unroll
            for (int i = 0; i < W; ++i) T[i] = v[i]; }
    } else if constexpr (KIND == EPI_OUT) {
        float v[W];
#pragma unroll
        for (int i = 0; i < W; ++i) { v[i] = E.xin[idx + i] + a[i]; E.X[idx + i] = v[i]; }
        store_bf<W>((bf16*)(ws + OFF_X1B) + idx, v);
    } else if constexpr (KIND == EPI_U) {
        float* U = (float*)(ws + OFF_U) + idx;
#pragma unroll
        for (int i = 0; i < W; ++i) U[i] = a[i];
    } else if constexpr (KIND == EPI_PLE) {
        const float* U = (const float*)(ws + OFF_U) + idx; float v[W];
#pragma unroll
        for (int i = 0; i < W; ++i) { v[i] = E.X[idx + i] + sigmoidf_(a[i]) * U[i]; E.X[idx + i] = v[i]; }
        store_bf<W>((bf16*)(ws + OFF_XB) + idx, v);
    }
}

template <int KIND> __device__ __forceinline__ void d_gemm(int vb, int vt, int nbx, const bf16* A, const bf16* Bt, int K, const EpiCtx& E) {
    const int lane = vt & 63, wid = vt >> 6, r32 = lane & 31, hi = lane >> 5;
    const int m0 = (vb / nbx) * 128 + (wid >> 1) * 64, n0 = (vb % nbx) * 128 + (wid & 1) * 64;
    f32x16 acc[2][2];
#pragma unroll
    for (int i = 0; i < 2; ++i)
#pragma unroll
        for (int j = 0; j < 2; ++j)
#pragma unroll
            for (int r = 0; r < 16; ++r) acc[i][j][r] = 0.f;
    const bf16* Ap = A + (size_t)(m0 + r32) * K + 8 * hi;
    const bf16* Bp = Bt + (size_t)(n0 + r32) * K + 8 * hi;
    for (int k = 0; k < K; k += 16) {
        const bf16x8 a0 = *(const bf16x8*)(Ap + k), a1 = *(const bf16x8*)(Ap + (size_t)32 * K + k);
        const bf16x8 b0 = *(const bf16x8*)(Bp + k), b1 = *(const bf16x8*)(Bp + (size_t)32 * K + k);
        acc[0][0] = __builtin_amdgcn_mfma_f32_32x32x16_bf16(b0, a0, acc[0][0], 0, 0, 0);
        acc[0][1] = __builtin_amdgcn_mfma_f32_32x32x16_bf16(b0, a1, acc[0][1], 0, 0, 0);
        acc[1][0] = __builtin_amdgcn_mfma_f32_32x32x16_bf16(b1, a0, acc[1][0], 0, 0, 0);
        acc[1][1] = __builtin_amdgcn_mfma_f32_32x32x16_bf16(b1, a1, acc[1][1], 0, 0, 0);
    }
#define KG_LOOP(CALL) _Pragma("unroll") for (int jn = 0; jn < 2; ++jn) _Pragma("unroll") for (int im = 0; im < 2; ++im) _Pragma("unroll") for (int rq = 0; rq < 4; ++rq) { \
        float v[4] = {acc[jn][im][4 * rq], acc[jn][im][4 * rq + 1], acc[jn][im][4 * rq + 2], acc[jn][im][4 * rq + 3]}; \
        const int row = m0 + 32 * im + r32, col = n0 + 32 * jn + 8 * rq + 4 * hi; CALL; }
    if constexpr (KIND == EPI_INPROJ) {
        switch (inproj_type(n0 >> 8)) {
            case T_QA: KG_LOOP((emit_inproj<T_QA, 4>(E, row, col, v))) break;
            case T_KA: KG_LOOP((emit_inproj<T_KA, 4>(E, row, col, v))) break;
            case T_VA: KG_LOOP((emit_inproj<T_VA, 4>(E, row, col, v))) break;
            case T_ZA: KG_LOOP((emit_inproj<T_ZA, 4>(E, row, col, v))) break;
            case T_QB: KG_LOOP((emit_inproj<T_QB, 4>(E, row, col, v))) break;
            case T_CB: KG_LOOP((emit_inproj<T_CB, 4>(E, row, col, v))) break;
            case T_KROPE: KG_LOOP((emit_inproj<T_KROPE, 4>(E, row, col, v))) break;
            case T_VSW: KG_LOOP((emit_inproj<T_VSW, 4>(E, row, col, v))) break;
            case T_ZB: KG_LOOP((emit_inproj<T_ZB, 4>(E, row, col, v))) break;
            case T_QC: KG_LOOP((emit_inproj<T_QC, 4>(E, row, col, v))) break;
            case T_KC: KG_LOOP((emit_inproj<T_KC, 4>(E, row, col, v))) break;
            case T_VC: KG_LOOP((emit_inproj<T_VC, 4>(E, row, col, v))) break;
            case T_ZC: KG_LOOP((emit_inproj<T_ZC, 4>(E, row, col, v))) break;
            default: KG_LOOP((emit_inproj<T_SPECIAL, 4>(E, row, col, v))) break;
        }
    } else { KG_LOOP((emit<KIND, 4>(E, row, col, v))) }
#undef KG_LOOP
}

template <int MODE> __device__ __forceinline__ void d_convT(bool active, int bx, int by, int vt, float (*tile)[65], const float* src, int ld, int K, bf16* dst, const float* kscale) {
    const int n0 = bx * 64, k0 = by * 64, tx = vt & 63, ty = vt >> 6;
    const int n = n0 + tx;
    int sc;
    if (MODE == 0) sc = n; else if (MODE == 1) sc = win_srccol(n); else sc = (n & ~63) + ((n & 1) << 5) + ((n & 63) >> 1);
    if (active) {
#pragma unroll 4
        for (int i = 0; i < 16; ++i) { const int kk = 4 * i + ty; float v = 0.f; if (sc >= 0) { v = src[(size_t)(k0 + kk) * ld + sc]; if (kscale) v *= kscale[k0 + kk]; } tile[tx][kk] = v; }
    }
    __syncthreads();
    if (active) {
#pragma unroll
        for (int p = 0; p < 2; ++p) { const int it = vt + 256 * p, r = it >> 3, c = it & 7; const float* t = &tile[r][8 * c];
            u32x4 o; o.x = pk2(t[0], t[1]); o.y = pk2(t[2], t[3]); o.z = pk2(t[4], t[5]); o.w = pk2(t[6], t[7]);
            *(u32x4*)(dst + (size_t)(n0 + r) * K + k0 + 8 * c) = o; }
    }
    __syncthreads();
}
__device__ __forceinline__ void d_xprep(int vb, int vt, const float* x, unsigned char* ws) {
    const int row = vb * 4 + (vt >> 6), lane = vt & 63;
    const f32x4* xr = (const f32x4*)(x + (size_t)row * 1024) + lane; float ss = 0.f;
    bf16* o = (bf16*)(ws + OFF_XB) + (size_t)row * 1024;
#pragma unroll
    for (int j = 0; j < 4; ++j) { const f32x4 v = xr[64 * j]; ss += (v[0] * v[0] + v[1] * v[1]) + (v[2] * v[2] + v[3] * v[3]); float t[4] = {v[0], v[1], v[2], v[3]}; store_bf<4>(o + 256 * j + 4 * lane, t); }
#pragma unroll
    for (int of = 1; of < 64; of <<= 1) ss += __shfl_xor(ss, of);
    if (lane == 0) { f32x4 s = {ss, 0.f, 0.f, 0.f}; *(f32x4*)(ws + OFF_SSP + (size_t)row * 16) = s; }
}
__device__ __forceinline__ void d_sumsq(int vb, int vt, const float* x, unsigned char* ws) {
    const int row = vb * 4 + (vt >> 6), lane = vt & 63;
    const f32x4* xr = (const f32x4*)(x + (size_t)row * 1024) + lane; float ss = 0.f;
#pragma unroll
    for (int j = 0; j < 4; ++j) { const f32x4 v = xr[64 * j]; ss += (v[0] * v[0] + v[1] * v[1]) + (v[2] * v[2] + v[3] * v[3]); }
#pragma unroll
    for (int of = 1; of < 64; of <<= 1) ss += __shfl_xor(ss, of);
    if (lane == 0) { f32x4 s = {ss, 0.f, 0.f, 0.f}; *(f32x4*)(ws + OFF_SSP + (size_t)row * 16) = s; }
}
__device__ __forceinline__ void d_rope_table(int vb, int vt, const int* pos, unsigned char* ws) {
    const int idx = vb * 256 + vt, row = idx >> 5, i = idx & 31;
    const float inv = exp2f(-(float)i * (13.287712379549449f / 32.f));
    const float ang = (float)pos[row] * inv;
    float s, c; sincosf(ang, &s, &c);
    ((float*)(ws + OFF_COS))[idx] = c; ((float*)(ws + OFF_SIN))[idx] = s;
}
__device__ __forceinline__ void d_pconv(int vb, int vt, const float* p, unsigned char* ws) {
    const size_t i = ((size_t)vb * 256 + vt) * 4;
    const f32x4 v = *(const f32x4*)(p + i); float t[4] = {v[0], v[1], v[2], v[3]}; store_bf<4>((bf16*)(ws + OFF_PB) + i, t);
}
__device__ __forceinline__ void d_cb1(int vt, const float* pe, const float* w1, const float* b1, float* o) {
    const int j = vt; float acc = b1[j];
    for (int k = 0; k < 2048; ++k) acc += pe[k] * w1[(size_t)k * 256 + j];
    o[j] = acc;
}
__device__ __forceinline__ void d_lam(int vt, const float* dl, unsigned char* ws, int l) {
    if (vt == 0) { float s1 = 0.f, s2 = 0.f; for (int i = 0; i < 64; ++i) { s1 += dl[i] * dl[64 + i]; s2 += dl[128 + i] * dl[192 + i]; }
        const float li = 0.8f - 0.6f * expf(-0.3f * (float)l); ((float*)(ws + OFF_CTL))[CTL_LAM + l] = expf(s1) - expf(s2) + li; }
}
__device__ __forceinline__ void d_cumsum(int vb, int vt, unsigned char* ws) {
    const int bh = vb, b = bh >> 3, h = bh & 7, lane = vt;
    const float* lf = (const float*)(ws + OFF_LOGF) + ((size_t)(b * 4096 + 64 * lane)) * 8 + h;
    float s = 0.f;
    for (int i = 0; i < 64; ++i) s += lf[i * 8];
    float incl = s;
#pragma unroll
    for (int of = 1; of < 64; of <<= 1) { const float t = __shfl_up(incl, of); if (lane >= of) incl += t; }
    float run = incl - s;
    float* cf = (float*)(ws + OFF_CF) + (size_t)bh * 4096 + 64 * lane;
    for (int i = 0; i < 64; ++i) { run += lf[i * 8]; cf[i] = run; }
}
__device__ __forceinline__ void d_compress(bool active, int vb, int vt, float* hid, unsigned char* ws) {
    const int c = vb & 255, bg = (vb >> 8) & 7, kv = vb >> 11, j = vt;
    bf16* dstK = (bf16*)(ws + OFF_KCMP) + (size_t)bg * 16384; bf16* dstV = (bf16*)(ws + OFF_VCMP) + (size_t)bg * 16384;
    const bool pad = (c == 255);
    if (active && pad) { if (j < 64) { if (kv == 0) dstK[ktile_off(c, j)] = 0; else dstV[vtile_off(c, j)] = 0; } }
    if (active && !pad) {
        const bf16* src = (const bf16*)(ws + (kv ? OFF_VCB : OFF_KCB)) + ((size_t)bg * 4096 + 16 * c) * 64;
        const bf16* w = (const bf16*)(ws + OFF_CW1) + (size_t)(kv * 256 + j) * 2048;
        float acc = ((const float*)(ws + OFF_CB1))[kv * 256 + j];
        for (int k = 0; k < 2048; k += 8) { const bf16x8 a = *(const bf16x8*)(src + k), bb = *(const bf16x8*)(w + k);
#pragma unroll
            for (int i = 0; i < 8; ++i) acc += bf2f((bf16)a[i]) * bf2f((bf16)bb[i]); }
        hid[j] = bf2f(f2bf(siluf_(acc)));
    }
    __syncthreads();
    if (active && !pad && j < 64) { const bf16* w2 = (const bf16*)(ws + OFF_CW2) + (size_t)(kv * 64 + j) * 256; float o = 0.f;
        for (int k = 0; k < 256; ++k) o += hid[k] * bf2f(w2[k]);
        if (kv == 0) dstK[ktile_off(c, j)] = f2bf(o); else dstV[vtile_off(c, j)] = f2bf(o); }
    __syncthreads();
}
__device__ __forceinline__ void d_fox(int vb, int vt, unsigned char* ws) {
    const int bh = (vb & 31), b = bh >> 3, h = bh & 7, t = (vb >> 5) * 64 + vt, tmax = (vb >> 5) * 64 + 63;
    const bf16* Q = (const bf16*)(ws + OFF_QA) + ((size_t)bh * 4096 + t) * 64;
    const bf16* Kb = (const bf16*)(ws + OFF_KA) + (size_t)bh * 262144; const bf16* Vb = (const bf16*)(ws + OFF_VA) + (size_t)bh * 262144;
    const float* cf = (const float*)(ws + OFF_CF) + (size_t)bh * 4096;
    float q[64], o[64];
#pragma unroll
    for (int d = 0; d < 64; ++d) { q[d] = bf2f(Q[d]); o[d] = 0.f; }
    const float ci = cf[t]; float m = -1e30f, l = 0.f;
    for (int j = 0; j <= tmax; ++j) {
        float s = 0.f;
#pragma unroll
        for (int d = 0; d < 64; ++d) s += q[d] * bf2f(Kb[ktile_off(j, d)]);
        s += ci - cf[j];
        if (j <= t) { const float mn = fmaxf(m, s), al = exp2f(m - mn), p = exp2f(s - mn); l = l * al + p; m = mn;
#pragma unroll
            for (int d = 0; d < 64; ++d) o[d] = o[d] * al + p * bf2f(Vb[vtile_off(j, d)]); }
    }
    const float il = 1.f / l; bf16* Y = (bf16*)(ws + OFF_ZA) + (size_t)(b * 4096 + t) * 512 + h * 64;
#pragma unroll
    for (int d = 0; d < 64; ++d) Y[d] = f2bf(o[d] * il * bf2f(Y[d]));
}
__device__ __forceinline__ void d_diff(int vb, int vt, float (*res)[129], unsigned char* ws, const float* subg, int l) {
    const int bhc = (vb & 15), b = bhc >> 2, hc = bhc & 3, t = (vb >> 4) * 64 + vt, tmax = (vb >> 4) * 64 + 63;
    const float lam = ((const float*)(ws + OFF_CTL))[CTL_LAM + l], lam_init = 0.8f - 0.6f * expf(-0.3f * (float)l);
    const bf16* Vb = (const bf16*)(ws + OFF_VC) + (size_t)bhc * 524288;
    for (int dh = 0; dh < 2; ++dh) {
        for (int mp = 0; mp < 2; ++mp) {
            const int hh = b * 8 + hc * 2 + mp;
            const bf16* Q = (const bf16*)(ws + OFF_QC) + ((size_t)hh * 4096 + t) * 64; const bf16* Kb = (const bf16*)(ws + OFF_KC) + (size_t)hh * 262144;
            float q[64], o[64];
#pragma unroll
            for (int d = 0; d < 64; ++d) { q[d] = bf2f(Q[d]); o[d] = 0.f; }
            float m = -1e30f, ls = 0.f;
            for (int j = 0; j <= tmax; ++j) {
                float s = 0.f;
#pragma unroll
                for (int d = 0; d < 64; ++d) s += q[d] * bf2f(Kb[ktile_off(j, d)]);
                if (j <= t) { const float mn = fmaxf(m, s), al = exp2f(m - mn), p = exp2f(s - mn); ls = ls * al + p; m = mn;
#pragma unroll
                    for (int d = 0; d < 64; ++d) o[d] = o[d] * al + p * bf2f(Vb[v128_off(j, dh * 64 + d)]); }
            }
            const float il = 1.f / ls;
#pragma unroll
            for (int d = 0; d < 64; ++d) { if (mp == 0) res[vt][dh * 64 + d] = o[d] * il; else res[vt][dh * 64 + d] -= lam * o[d] * il; }
        }
    }
    float ss = 0.f;
    for (int d = 0; d < 128; ++d) { const float v = res[vt][d]; ss += v * v; }
    const float rs = rsqrtf(ss * (1.f / 128.f) + EPS) * (1.f - lam_init);
    bf16* Y = (bf16*)(ws + OFF_ZC) + (size_t)(b * 4096 + t) * 512 + hc * 128;
    for (int d = 0; d < 128; ++d) Y[d] = f2bf(res[vt][d] * rs * subg[d] * bf2f(Y[d]));
}
__device__ __forceinline__ void d_nsa_topk(int vb, int vt, float (*imp)[65], unsigned char* ws) {
    const int bg = (vb & 7), b = bg >> 1, g = bg & 1, tb = (vb >> 3), t = tb * 64 + vt;
    for (int j = 0; j < 64; ++j) imp[vt][j] = 0.f;
    const int nv = (t >= 31) ? ((t - 31) >> 4) + 1 : 0, nvmax = ((tb * 64 + 63 - 31) >> 4) + 1;
    const bf16* Kc = (const bf16*)(ws + OFF_KCMP) + (size_t)bg * 16384;
    for (int hq = 0; hq < 4; ++hq) {
        const int h = g * 4 + hq;
        const bf16* Q = (const bf16*)(ws + OFF_QB) + ((size_t)(b * 8 + h) * 4096 + t) * 64;
        float q[64];
#pragma unroll
        for (int d = 0; d < 64; ++d) q[d] = bf2f(Q[d]);
        float m = -1e30f, ls = 0.f;
        for (int c = 0; c < nvmax; ++c) { float s = 0.f;
#pragma unroll
            for (int d = 0; d < 64; ++d) s += q[d] * bf2f(Kc[ktile_off(c, d)]);
            if (c < nv) { const float mn = fmaxf(m, s); ls = ls * exp2f(m - mn) + exp2f(s - mn); m = mn; } }
        const float il = nv > 0 ? 1.f / ls : 0.f;
        for (int c = 0; c < nvmax; ++c) { float s = 0.f;
#pragma unroll
            for (int d = 0; d < 64; ++d) s += q[d] * bf2f(Kc[ktile_off(c, d)]);
            if (c < nv) { const float p = exp2f(s - m) * il; imp[vt][c >> 2] += p; if ((c & 3) == 3 && (c >> 2) + 1 < 64) imp[vt][(c >> 2) + 1] += p; } }
    }
    for (int j = 0; j < 64; ++j) { const bool forced = (j == 0) || (j == tb) || (j == tb - 1), valid = j <= tb; const float v = imp[vt][j];
        imp[vt][j] = forced ? 1e30f : (valid ? v : -1e30f); }
    unsigned long long mask = 0ull;
    for (int j = 0; j < 64; ++j) { const float sj = imp[vt][j]; int rank = 0;
        for (int k = 0; k < 64; ++k) { const float sk = imp[vt][k]; rank += (sk > sj || (sk == sj && k < j)) ? 1 : 0; }
        if (rank < 16) mask |= (1ull << j); }
    ((unsigned long long*)(ws + OFF_SELM))[(size_t)bg * 4096 + t] = mask;
}
__device__ __forceinline__ void d_nsa_attn(int vb, int vt, float (*yl)[65], unsigned char* ws) {
    const int bh = (vb & 31), b = bh >> 3, h = bh & 7, g = h >> 2, bg = b * 2 + g, tb = (vb >> 5), t = tb * 64 + vt, row = b * 4096 + t;
    const bf16* Q = (const bf16*)(ws + OFF_QB) + ((size_t)bh * 4096 + t) * 64;
    float q[64], o[64];
#pragma unroll
    for (int d = 0; d < 64; ++d) { q[d] = bf2f(Q[d]); yl[vt][d] = 0.f; }
    const float* gt = (const float*)(ws + OFF_GATES) + (size_t)row * 24 + h * 3;
    const float g0 = gt[0], g1 = gt[1], g2 = gt[2];
    { const int nv = (t >= 31) ? ((t - 31) >> 4) + 1 : 0, nvmax = ((tb * 64 + 63 - 31) >> 4) + 1;
      const bf16* Kc = (const bf16*)(ws + OFF_KCMP) + (size_t)bg * 16384; const bf16* Vc = (const bf16*)(ws + OFF_VCMP) + (size_t)bg * 16384;
      float m = -1e30f, ls = 0.f;
#pragma unroll
      for (int d = 0; d < 64; ++d) o[d] = 0.f;
      for (int c = 0; c < nvmax; ++c) { float s = 0.f;
#pragma unroll
          for (int d = 0; d < 64; ++d) s += q[d] * bf2f(Kc[ktile_off(c, d)]);
          if (c < nv) { const float mn = fmaxf(m, s), al = exp2f(m - mn), p = exp2f(s - mn); ls = ls * al + p; m = mn;
#pragma unroll
              for (int d = 0; d < 64; ++d) o[d] = o[d] * al + p * bf2f(Vc[vtile_off(c, d)]); } }
      const float il = nv > 0 ? g0 / ls : 0.f;
#pragma unroll
      for (int d = 0; d < 64; ++d) yl[vt][d] += o[d] * il; }
    { const float* cs = (const float*)(ws + OFF_COS) + (size_t)row * 32; const float* sn = (const float*)(ws + OFF_SIN) + (size_t)row * 32;
#pragma unroll
      for (int i = 0; i < 32; ++i) { const float c = cs[i], s = sn[i], x1 = q[2 * i], x2 = q[2 * i + 1]; q[2 * i] = bf2f(f2bf(x1 * c - x2 * s)); q[2 * i + 1] = bf2f(f2bf(x2 * c + x1 * s)); } }
    { const unsigned long long mask = ((const unsigned long long*)(ws + OFF_SELM))[(size_t)bg * 4096 + t];
      const bf16* Kb = (const bf16*)(ws + OFF_KSEL) + (size_t)bg * 262144; const bf16* Vb = (const bf16*)(ws + OFF_VSEL) + (size_t)bg * 262144;
      float m = -1e30f, ls = 0.f;
#pragma unroll
      for (int d = 0; d < 64; ++d) o[d] = 0.f;
      for (int j = 0; j <= tb; ++j) { const bool sel = (mask >> j) & 1ull;
          for (int kk = 0; kk < 64; ++kk) { const int kp = j * 64 + kk; float s = 0.f;
#pragma unroll
              for (int d = 0; d < 64; ++d) s += q[d] * bf2f(Kb[ktile_off(kp, d)]);
              if (sel && kp <= t) { const float mn = fmaxf(m, s), al = exp2f(m - mn), p = exp2f(s - mn); ls = ls * al + p; m = mn;
#pragma unroll
                  for (int d = 0; d < 64; ++d) o[d] = o[d] * al + p * bf2f(Vb[vtile_off(kp, d)]); } } }
      const float il = g1 / ls;
#pragma unroll
      for (int d = 0; d < 64; ++d) yl[vt][d] += o[d] * il; }
    { const bf16* Kb = (const bf16*)(ws + OFF_KWIN) + (size_t)bg * 262144; const bf16* Vb = (const bf16*)(ws + OFF_VWIN) + (size_t)bg * 262144;
      float m = -1e30f, ls = 0.f;
#pragma unroll
      for (int d = 0; d < 64; ++d) o[d] = 0.f;
      const int k_lo = max(0, tb * 64 - 511), k_hi = tb * 64 + 63;
      for (int kp = k_lo; kp <= k_hi; ++kp) { float s = 0.f;
#pragma unroll
          for (int d = 0; d < 64; ++d) s += q[d] * bf2f(Kb[ktile_off(kp, d)]);
          if (kp <= t && kp > t - 512) { const float mn = fmaxf(m, s), al = exp2f(m - mn), p = exp2f(s - mn); ls = ls * al + p; m = mn;
#pragma unroll
              for (int d = 0; d < 64; ++d) o[d] = o[d] * al + p * bf2f(Vb[vtile_off(kp, d)]); } }
      const float il = g2 / ls;
#pragma unroll
      for (int d = 0; d < 64; ++d) yl[vt][d] += o[d] * il; }
    bf16* Y = (bf16*)(ws + OFF_ZB) + (size_t)row * 512 + h * 64;
#pragma unroll
    for (int d = 0; d < 64; ++d) Y[d] = f2bf(yl[vt][d] * bf2f(Y[d]));
}
__device__ __forceinline__ void d_final(int vb, int vt, float* X, const float* g) {
    const int row = vb * 4 + (vt >> 6), lane = vt & 63;
    f32x4* xr = (f32x4*)(X + (size_t)row * 1024) + lane; f32x4 v[4]; float ss = 0.f;
#pragma unroll
    for (int j = 0; j < 4; ++j) { v[j] = xr[64 * j]; ss += (v[j][0] * v[j][0] + v[j][1] * v[j][1]) + (v[j][2] * v[j][2] + v[j][3] * v[j][3]); }
#pragma unroll
    for (int of = 1; of < 64; of <<= 1) ss += __shfl_xor(ss, of);
    const float rs = rsqrtf(ss * (1.f / 1024.f) + EPS);
#pragma unroll
    for (int j = 0; j < 4; ++j) { const f32x4 gg = *((const f32x4*)g + 64 * j + lane); xr[64 * j] = v[j] * rs * gg; }
}


namespace pg8 {
#define PG8_LAS __attribute__((address_space(3)))
typedef unsigned short bf16_t;
typedef short bf16x8 __attribute__((ext_vector_type(8)));
typedef float f32x4 __attribute__((ext_vector_type(4)));
typedef unsigned u32x4 __attribute__((ext_vector_type(4)));
constexpr int BM = 256, BK = 64, HALF = 128, HTB = HALF * BK * 2  , STAGE_BYTES = 8 * HTB, NXCD = 8, WGM = 8;

__host__ __device__ __forceinline__ int lds_byte(int r, int c) { const int st = (r >> 4) * 2 + (c >> 5), rr = r & 15, cc = c & 31, ob = rr * 64 + cc * 2; return st * 1024 + (ob ^ (((ob >> 9) & 1) << 5)); }
__host__ __device__ __forceinline__ void stage_rc(int b, int& R, int& C) { const int st = b / 1024, sb = b % 1024, swz = sb ^ (((sb >> 9) & 1) << 5); R = (st >> 1) * 16 + swz / 64; C = (st & 1) * 32 + (swz % 64) / 2; }
__host__ __device__ __forceinline__ int perm32(int rho) { const int n = rho >> 4, i = rho & 15; return 8 * (i >> 2) + 4 * n + (i & 3); }

struct Unit { int pm, pn; };
struct Gemm { const bf16_t* A; const bf16_t* Bt; int M, N, K; };

struct StaticOrder {
    int nM, nN, nwg, G, c;
    __host__ __device__ void init(int M, int N, int G_, int c_) { nM = M / BM; nN = N / BM; nwg = nM * nN; G = G_; c = c_; }
    __host__ __device__ bool next(int i, Unit& u) const {
        const long L = (long)i * G + c; if (L >= nwg) return false;
        int wgid = (int)L; { const int q = nwg / NXCD, r = nwg % NXCD, xcd = wgid % NXCD, off = wgid / NXCD; wgid = (xcd < r ? xcd * (q + 1) : r * (q + 1) + (xcd - r) * q) + off; }
        const int nig = WGM * nN, gid = wgid / nig, fm = gid * WGM, gsz = (nM - fm) < WGM ? (nM - fm) : WGM;
        u.pm = fm + ((wgid % nig) % gsz); u.pn = (wgid % nig) / gsz; return true;
    }
    __device__ __forceinline__ void a_ready(const Unit&) const {}
    __device__ __forceinline__ void done(const Unit&) const {}
};

__device__ __forceinline__ unsigned cvt_pk_bf16(float lo, float hi) { unsigned r; asm volatile("v_cvt_pk_bf16_f32 %0, %1, %2" : "=v"(r) : "v"(lo), "v"(hi)); return r; }
typedef float f32x2 __attribute__((ext_vector_type(2)));
template <class Epi, class Sched, bool ALIGN_EPI = false, bool SP2 = false>
__device__ __forceinline__ void gemm_phase(PG8_LAS unsigned char* lds, const Gemm g, const Sched& S, const Epi& E) {
    int tid_o = threadIdx.x; asm volatile("" : "+v"(tid_o));
    const int tid = tid_o, wid = __builtin_amdgcn_readfirstlane(tid >> 6), lane = tid & 63, wr = wid >> 2, wc = wid & 3, fr = lane & 15, fq = lane >> 4;
    const int K = g.K, nt = K / BK;
    unsigned voffA[2], voffB[2];
#pragma unroll
    for (int i = 0; i < 2; ++i) { int R, C; stage_rc(tid * 16 + i * 8192, R, C); const int Rb = Epi::PERM ? ((R & ~31) + perm32(R & 31)) : R;
        voffA[i] = (unsigned)(R * K + C) * 2u; voffB[i] = (unsigned)(Rb * K + C) * 2u; }
    const size_t kstep = (size_t)(BK * 2);
    const size_t hstep = (size_t)HALF * K * 2;
    const size_t tstep = 2 * hstep;
    const unsigned ldsw = (unsigned)wid * 1024u;
    const int aoff = lds_byte(wr * 64 + fr, fq * 8), boff = lds_byte(wc * 32 + fr, fq * 8);
#define PG8_SA(b, h) (((b) * 2 + (h)) * HTB)
#define PG8_SB(b, h) ((4 + (b) * 2 + (h)) * HTB)
#define PG8_STAGE(bufoff, gbase, voff) do { _Pragma("unroll") for (int _i = 0; _i < 2; ++_i) \
        __builtin_amdgcn_global_load_lds((const unsigned*)((const char*)(gbase) + (voff)[_i]), (PG8_LAS unsigned*)(lds + (bufoff) + ldsw + _i * 8192), 16, 0, 0); } while (0)
#define PG8_LDA(dst, b, h) do { _Pragma("unroll") for (int m = 0; m < 4; ++m) _Pragma("unroll") for (int k = 0; k < 2; ++k) dst[m][k] = *(const PG8_LAS bf16x8*)(lds + PG8_SA(b, h) + aoff + m * 2048 + k * 1024); } while (0)
#define PG8_LDB(dst, b, h) do { _Pragma("unroll") for (int n = 0; n < 2; ++n) _Pragma("unroll") for (int k = 0; k < 2; ++k) dst[n][k] = *(const PG8_LAS bf16x8*)(lds + PG8_SB(b, h) + boff + n * 2048 + k * 1024); } while (0)
#define PG8_MMA(ai, bj, At, Bt) do { __builtin_amdgcn_s_setprio(1); _Pragma("unroll") for (int m = 0; m < 4; ++m) _Pragma("unroll") for (int n = 0; n < 2; ++n) _Pragma("unroll") for (int k = 0; k < 2; ++k) \
        acc[ai][bj][m][n] = __builtin_amdgcn_mfma_f32_16x16x32_bf16(Bt[n][k], At[m][k], acc[ai][bj][m][n], 0, 0, 0); __builtin_amdgcn_s_setprio(0); } while (0)
#define PG8_WAIT_V(n) asm volatile("s_waitcnt vmcnt(" #n ")" ::: "memory")
#define PG8_WAIT_L(n) asm volatile("s_waitcnt lgkmcnt(" #n ")" ::: "memory")
#define PG8_BAR __builtin_amdgcn_s_barrier()
#define PG8_SCHED __builtin_amdgcn_sched_barrier(0)
    Unit cur, nxt; int ui = 0;
    if (!S.next(0, cur)) return;
    f32x4 acc[2][2][4][2];
#pragma unroll
    for (int a = 0; a < 2; ++a)
#pragma unroll
        for (int b = 0; b < 2; ++b)
#pragma unroll
            for (int m = 0; m < 4; ++m)
#pragma unroll
                for (int n = 0; n < 2; ++n) acc[a][b][m][n] = (f32x4){0.f, 0.f, 0.f, 0.f};
    bf16x8 At[4][2], B0[2][2], B1[2][2];
    const char* cA = (const char*)g.A + (size_t)cur.pm * tstep; const char* cB = (const char*)g.Bt + (size_t)cur.pn * tstep;
    S.a_ready(cur);
    if constexpr (SP2) {
        PG8_STAGE(PG8_SB(0, 0), cB, voffB); PG8_STAGE(PG8_SB(0, 1), cB + hstep, voffB); PG8_STAGE(PG8_SA(0, 0), cA, voffA); PG8_STAGE(PG8_SA(0, 1), cA + hstep, voffA);
        if (wr == 1) PG8_BAR;
        PG8_WAIT_V(2); PG8_BAR;
        PG8_STAGE(PG8_SB(1, 0), cB + kstep, voffB); PG8_STAGE(PG8_SA(1, 0), cA + kstep, voffA); PG8_STAGE(PG8_SB(1, 1), cB + hstep + kstep, voffB);
        PG8_WAIT_V(6); PG8_BAR;
    } else {
        PG8_STAGE(PG8_SB(0, 0), cB, voffB); PG8_STAGE(PG8_SA(0, 0), cA, voffA); PG8_STAGE(PG8_SB(0, 1), cB + hstep, voffB); PG8_STAGE(PG8_SA(0, 1), cA + hstep, voffA);
        if (wr == 1) PG8_BAR;
        PG8_WAIT_V(4); PG8_BAR;
        PG8_STAGE(PG8_SB(1, 0), cB + kstep, voffB); PG8_STAGE(PG8_SA(1, 0), cA + kstep, voffA); PG8_STAGE(PG8_SB(1, 1), cB + hstep + kstep, voffB);
        PG8_WAIT_V(6); PG8_BAR;
    }
    for (;;) {
        const bool has_next = S.next(ui + 1, nxt);
        const char* nA = has_next ? (const char*)g.A + (size_t)nxt.pm * tstep : cA; const char* nB = has_next ? (const char*)g.Bt + (size_t)nxt.pn * tstep : cB;
        for (int t = 0; t < nt; t += 2) {
            const bool last = (t == nt - 2);
            const char* a1 = cA + (size_t)(t + 1) * kstep;
            const char* a2 = last ? nA : cA + (size_t)(t + 2) * kstep; const char* b2 = last ? nB : cB + (size_t)(t + 2) * kstep;
            const char* a3 = a2 + kstep; const char* b3 = b2 + kstep;
            if (last && has_next) S.a_ready(nxt);
            if constexpr (SP2) {
            PG8_LDB(B0, 0, 0); PG8_LDB(B1, 0, 1); PG8_SCHED; PG8_LDA(At, 0, 0); PG8_STAGE(PG8_SA(1, 1), a1 + hstep, voffA);
            PG8_WAIT_V(8); PG8_WAIT_L(0); PG8_BAR; PG8_MMA(0, 0, At, B0); PG8_MMA(0, 1, At, B1); PG8_BAR; PG8_SCHED;
            PG8_LDA(At, 0, 1); PG8_STAGE(PG8_SB(0, 0), b2, voffB); PG8_STAGE(PG8_SB(0, 1), b2 + hstep, voffB); PG8_STAGE(PG8_SA(0, 0), a2, voffA);
            PG8_WAIT_V(8); PG8_WAIT_L(0); PG8_BAR; PG8_MMA(1, 0, At, B0); PG8_MMA(1, 1, At, B1); PG8_BAR; PG8_SCHED;
            PG8_LDB(B0, 1, 0); PG8_LDB(B1, 1, 1); PG8_SCHED; PG8_LDA(At, 1, 0); PG8_STAGE(PG8_SA(0, 1), a2 + hstep, voffA);
            PG8_WAIT_V(8); PG8_WAIT_L(0); PG8_BAR; PG8_MMA(0, 0, At, B0); PG8_MMA(0, 1, At, B1); PG8_BAR; PG8_SCHED;
            PG8_LDA(At, 1, 1); PG8_STAGE(PG8_SB(1, 0), b3, voffB); PG8_STAGE(PG8_SB(1, 1), b3 + hstep, voffB); PG8_STAGE(PG8_SA(1, 0), a3, voffA);
            PG8_WAIT_V(8); PG8_WAIT_L(0); PG8_BAR; PG8_MMA(1, 0, At, B0); PG8_MMA(1, 1, At, B1); PG8_BAR; PG8_SCHED;
            } else {
            PG8_LDB(B0, 0, 0); PG8_SCHED; PG8_LDA(At, 0, 0); PG8_STAGE(PG8_SA(1, 1), a1 + hstep, voffA);
            PG8_WAIT_L(8); PG8_BAR; PG8_WAIT_L(0); PG8_MMA(0, 0, At, B0); PG8_BAR; PG8_SCHED;
            PG8_LDB(B1, 0, 1); PG8_STAGE(PG8_SB(0, 0), b2, voffB);
            PG8_BAR; PG8_WAIT_L(0); PG8_MMA(0, 1, At, B1); PG8_BAR;
            PG8_LDA(At, 0, 1); PG8_STAGE(PG8_SA(0, 0), a2, voffA);
            PG8_BAR; PG8_WAIT_L(0); PG8_MMA(1, 0, At, B0); PG8_BAR; PG8_SCHED;
            PG8_STAGE(PG8_SB(0, 1), b2 + hstep, voffB);
            PG8_WAIT_V(6); PG8_BAR; PG8_MMA(1, 1, At, B1); PG8_BAR;
            PG8_LDB(B0, 1, 0); PG8_SCHED; PG8_LDA(At, 1, 0); PG8_STAGE(PG8_SA(0, 1), a2 + hstep, voffA);
            PG8_WAIT_L(8); PG8_BAR; PG8_WAIT_L(0); PG8_MMA(0, 0, At, B0); PG8_BAR; PG8_SCHED;
            PG8_LDB(B1, 1, 1); PG8_STAGE(PG8_SB(1, 0), b3, voffB);
            PG8_BAR; PG8_WAIT_L(0); PG8_MMA(0, 1, At, B1); PG8_BAR;
            PG8_LDA(At, 1, 1); PG8_STAGE(PG8_SA(1, 0), a3, voffA);
            PG8_BAR; PG8_WAIT_L(0); PG8_MMA(1, 0, At, B0); PG8_BAR; PG8_SCHED;
            PG8_STAGE(PG8_SB(1, 1), b3 + hstep, voffB);
            PG8_WAIT_V(6); PG8_BAR; PG8_MMA(1, 1, At, B1); PG8_BAR;
            }
        }
        if constexpr (ALIGN_EPI) { if (wr == 0) PG8_BAR; }
        if constexpr (!Epi::AFTER_DRAIN) { E(acc, cur, wr, wc, fr, fq); S.done(cur); }
        if (!has_next) break;
#pragma unroll
        for (int a = 0; a < 2; ++a)
#pragma unroll
            for (int b = 0; b < 2; ++b)
#pragma unroll
                for (int m = 0; m < 4; ++m)
#pragma unroll
                    for (int n = 0; n < 2; ++n) acc[a][b][m][n] = (f32x4){0.f, 0.f, 0.f, 0.f};
        cur = nxt; cA = nA; cB = nB; ++ui;
        if constexpr (ALIGN_EPI) { if (wr == 1) PG8_BAR; }
    }
    PG8_WAIT_V(0);
    if constexpr (!ALIGN_EPI) { if (wr == 0) PG8_BAR; }
    PG8_BAR;
    if constexpr (Epi::AFTER_DRAIN) { E.fused(acc, cur, wr, wc, fr, fq, lds, wid, lane); S.done(cur); }
#undef PG8_SA
#undef PG8_SB
#undef PG8_STAGE
#undef PG8_LDA
#undef PG8_LDB
#undef PG8_MMA
#undef PG8_WAIT_V
#undef PG8_WAIT_L
#undef PG8_BAR
#undef PG8_SCHED
}
}

template <int KIND> struct EpiFast {
    static constexpr bool PERM = true, AFTER_DRAIN = false;
    EpiCtx E;
    __device__ __forceinline__ void operator()(const pg8::f32x4 (&acc)[2][2][4][2], const pg8::Unit& u, int wr, int wc, int fr, int fq) const {
        const int row0 = u.pm * 256 + wr * 64 + fr, col0 = u.pn * 256 + wc * 32 + 8 * fq;
#define EF_LOOP(CALL) _Pragma("unroll") for (int ai = 0; ai < 2; ++ai) _Pragma("unroll") for (int m = 0; m < 4; ++m) _Pragma("unroll") for (int bj = 0; bj < 2; ++bj) { \
            const pg8::f32x4 v0 = acc[ai][bj][m][0], v1 = acc[ai][bj][m][1]; float v[8] = {v0[0], v0[1], v0[2], v0[3], v1[0], v1[1], v1[2], v1[3]}; \
            const int row = row0 + ai * 128 + m * 16, col = col0 + bj * 128; CALL; asm volatile("" ::: "memory"); }
        if constexpr (KIND == EPI_INPROJ) {
            switch (inproj_type(u.pn)) {
                case T_QA: EF_LOOP((emit_inproj<T_QA, 8>(E, row, col, v))) break;
                case T_KA: EF_LOOP((emit_inproj<T_KA, 8>(E, row, col, v))) break;
                case T_VA: EF_LOOP((emit_inproj<T_VA, 8>(E, row, col, v))) break;
                case T_ZA: EF_LOOP((emit_inproj<T_ZA, 8>(E, row, col, v))) break;
                case T_QB: EF_LOOP((emit_inproj<T_QB, 8>(E, row, col, v))) break;
                case T_CB: EF_LOOP((emit_inproj<T_CB, 8>(E, row, col, v))) break;
                case T_KROPE: EF_LOOP((emit_inproj<T_KROPE, 8>(E, row, col, v))) break;
                case T_VSW: EF_LOOP((emit_inproj<T_VSW, 8>(E, row, col, v))) break;
                case T_ZB: EF_LOOP((emit_inproj<T_ZB, 8>(E, row, col, v))) break;
                case T_QC: EF_LOOP((emit_inproj<T_QC, 8>(E, row, col, v))) break;
                case T_KC: EF_LOOP((emit_inproj<T_KC, 8>(E, row, col, v))) break;
                case T_VC: EF_LOOP((emit_inproj<T_VC, 8>(E, row, col, v))) break;
                case T_ZC: EF_LOOP((emit_inproj<T_ZC, 8>(E, row, col, v))) break;
                default: EF_LOOP((emit_inproj<T_SPECIAL, 8>(E, row, col, v))) break;
            }
        } else { EF_LOOP((emit<KIND, 8>(E, row, col, v))) }
#undef EF_LOOP
    }
};
#define FAST_GEMM(KIND, Aptr, Bptr, N_, K_, ALIGN) do { pg8::Gemm g_{(const pg8::bf16_t*)(Aptr), (const pg8::bf16_t*)(Bptr), M, (N_), (K_)}; pg8::StaticOrder S_; S_.init(M, (N_), (int)gridDim.x, (int)blockIdx.x); \
        EpiFast<KIND> Ep_{E}; pg8::gemm_phase<EpiFast<KIND>, pg8::StaticOrder, ALIGN, true>((PG8_LAS unsigned char*)lds, g_, S_, Ep_); } while (0)

#define LAS __attribute__((address_space(3)))
typedef short s16x4 __attribute__((ext_vector_type(4)));
typedef short v4i16_t __attribute__((ext_vector_type(4)));
typedef LAS const char* lds_cptr;
constexpr int A_KRING = 0, A_VRING = 49152, A_CFRING = 98304, A_MISC = 104448;
constexpr int A_SLOT = 16384;
constexpr int A_IMP = A_MISC, A_SELM = A_MISC + 16384, A_UMASK = A_SELM + 512, A_SEQ = A_UMASK + 16, A_WQ = A_SEQ + 80;
__device__ __forceinline__ void glds16(const void* gsrc, unsigned lds_dst) { unsigned keep;
    asm volatile("s_mov_b32 %0, m0\n\ts_mov_b32 m0, %2\n\ts_nop 0\n\tglobal_load_lds_dwordx4 %1, off\n\ts_mov_b32 m0, %0" : "=&s"(keep) : "v"(gsrc), "s"(lds_dst) : "memory"); }
__device__ __forceinline__ void glds4(const void* gsrc, unsigned lds_dst) { unsigned keep;
    asm volatile("s_mov_b32 %0, m0\n\ts_mov_b32 m0, %2\n\ts_nop 0\n\tglobal_load_lds_dword %1, off\n\ts_mov_b32 m0, %0" : "=&s"(keep) : "v"(gsrc), "s"(lds_dst) : "memory"); }
#define A_WAIT_BAR(N) asm volatile("s_waitcnt vmcnt(" #N ") lgkmcnt(0)\n\ts_barrier" ::: "memory")
__device__ __forceinline__ s16x4 vtr(lds_cptr p) { return __builtin_bit_cast(s16x4, __builtin_amdgcn_ds_read_tr16_b64_v4i16((LAS v4i16_t*)p)); }
__device__ __forceinline__ unsigned cvtpk(float lo, float hi) { typedef float f2 __attribute__((ext_vector_type(2))); typedef __bf16 b2 __attribute__((ext_vector_type(2))); f2 v = {lo, hi}; b2 b = __builtin_convertvector(v, b2); return __builtin_bit_cast(unsigned, b); }
__device__ __forceinline__ int crow(int r, int hi) { return (r & 3) + 8 * (r >> 2) + 4 * hi; }

template <int NDB> struct FlashSt { f32x16 o[NDB]; float m, l; };
template <int NDB> __device__ __forceinline__ void flash_init(FlashSt<NDB>& st) {
#pragma unroll
    for (int i = 0; i < NDB; ++i)
#pragma unroll
        for (int r = 0; r < 16; ++r) st.o[i][r] = 0.f;
    st.m = -1e30f; st.l = 0.f;
}
__device__ __forceinline__ void qk_tile(f32x16& p0, f32x16& p1, lds_cptr kslot, const bf16x8 (&qf)[4], int r32, int hi) {
    const lds_cptr kb = kslot + hi * 1024 + r32 * 16;
#pragma unroll
    for (int d0 = 0; d0 < 4; ++d0) {
        const bf16x8 a = *(const LAS bf16x8*)(kb + d0 * 2048), b = *(const LAS bf16x8*)(kb + d0 * 2048 + 512);
        p0 = __builtin_amdgcn_mfma_f32_32x32x16_bf16(a, qf[d0], p0, 0, 0, 0);
        p1 = __builtin_amdgcn_mfma_f32_32x32x16_bf16(b, qf[d0], p1, 0, 0, 0);
    }
}
__device__ __forceinline__ float rowmax32(const f32x16& p0, const f32x16& p1) {
    float a = fmaxf(p0[0], p1[0]);
#pragma unroll
    for (int r = 1; r < 16; ++r) a = fmaxf(a, fmaxf(p0[r], p1[r]));
    return fmaxf(a, __shfl_xor(a, 32));
}
template <int NDB> __device__ __forceinline__ void pv_tile(f32x16 (&o)[NDB], lds_cptr vslot_l, const f32x16& p0, const f32x16& p1) {
    bf16x8 pf[4];
    { u32x4 w;
      w.x = cvtpk(p0[0], p0[1]); w.y = cvtpk(p0[2], p0[3]); w.z = cvtpk(p0[4], p0[5]); w.w = cvtpk(p0[6], p0[7]); pf[0] = __builtin_bit_cast(bf16x8, w);
      w.x = cvtpk(p0[8], p0[9]); w.y = cvtpk(p0[10], p0[11]); w.z = cvtpk(p0[12], p0[13]); w.w = cvtpk(p0[14], p0[15]); pf[1] = __builtin_bit_cast(bf16x8, w);
      w.x = cvtpk(p1[0], p1[1]); w.y = cvtpk(p1[2], p1[3]); w.z = cvtpk(p1[4], p1[5]); w.w = cvtpk(p1[6], p1[7]); pf[2] = __builtin_bit_cast(bf16x8, w);
      w.x = cvtpk(p1[8], p1[9]); w.y = cvtpk(p1[10], p1[11]); w.z = cvtpk(p1[12], p1[13]); w.w = cvtpk(p1[14], p1[15]); pf[3] = __builtin_bit_cast(bf16x8, w); }
#pragma unroll
    for (int db = 0; db < NDB; ++db)
#pragma unroll
        for (int ks = 0; ks < 4; ++ks) {
            const s16x4 lo = vtr(vslot_l + db * 4096 + ks * 1024), hh = vtr(vslot_l + db * 4096 + ks * 1024 + 512);
            const bf16x8 vf = {lo[0], lo[1], lo[2], lo[3], hh[0], hh[1], hh[2], hh[3]};
            o[db] = __builtin_amdgcn_mfma_f32_32x32x16_bf16(vf, pf[ks], o[db], 0, 0, 0);
        }
}
template <int NDB> __device__ __forceinline__ void flash_update(FlashSt<NDB>& st, f32x16& p0, f32x16& p1, lds_cptr vslot_l) {
    const float rm = rowmax32(p0, p1);
    const float mn = fmaxf(st.m, rm), alpha = __builtin_amdgcn_exp2f(st.m - mn);
    st.m = mn;
    float ls = 0.f;
#pragma unroll
    for (int r = 0; r < 16; ++r) { p0[r] = __builtin_amdgcn_exp2f(p0[r] - mn); p1[r] = __builtin_amdgcn_exp2f(p1[r] - mn); ls += p0[r] + p1[r]; }
    st.l = st.l * alpha + ls;
#pragma unroll
    for (int db = 0; db < NDB; ++db)
#pragma unroll
        for (int r = 0; r < 16; ++r) st.o[db][r] *= alpha;
    pv_tile<NDB>(st.o, vslot_l, p0, p1);
}
__device__ __forceinline__ int lane_vbase(int lane) { return ((lane >> 4) & 1) * 32 + (lane & 3) * 8 + (4 * (lane >> 5) + ((lane & 15) >> 2)) * 64; }

__device__ __forceinline__ void fox_unit(unsigned char* lds, unsigned char* ws, int bh, int qb) {
    int tid_o = threadIdx.x; asm volatile("" : "+v"(tid_o));
    const int tid = tid_o, lane = tid & 63, wid = __builtin_amdgcn_readfirstlane(tid >> 6), r32 = lane & 31, hi = lane >> 5;
    const unsigned lds0 = (unsigned)(uintptr_t)lds;
    const lds_cptr L = (lds_cptr)lds;
    const int qrow = 256 * qb + 32 * wid + r32, wrow0 = 256 * qb + 32 * wid;
    const int NTl = 4 * (qb + 1);
    const char* Kg = (const char*)(ws + OFF_KA) + (size_t)bh * 524288 + wid * 1024 + lane * 16;
    const char* Vg = (const char*)(ws + OFF_VA) + (size_t)bh * 524288 + wid * 1024 + lane * 16;
    const char* Cg = (const char*)(ws + OFF_CF) + (size_t)bh * 16384 + lane * 4;
    const unsigned kdst = (unsigned)__builtin_amdgcn_readfirstlane(lds0 + A_KRING + wid * 1024), vdst = (unsigned)__builtin_amdgcn_readfirstlane(lds0 + A_VRING + wid * 1024),
                   cdst = (unsigned)__builtin_amdgcn_readfirstlane(lds0 + A_CFRING + wid * 256);
#define FOX_DMA(t, slot) do { glds16(Kg + (size_t)(t) * 8192, kdst + (slot) * A_SLOT); glds16(Vg + (size_t)(t) * 8192, vdst + (slot) * A_SLOT); glds4(Cg + (size_t)(t) * 256, cdst + (slot) * 2048); } while (0)
    asm volatile("s_waitcnt vmcnt(0)" ::: "memory");
    FOX_DMA(0, 0); FOX_DMA(1, 1);
    bf16x8 qf[4];
    { const bf16* Q = (const bf16*)(ws + OFF_QA) + ((size_t)bh * 4096 + qrow) * 64 + 8 * hi;
#pragma unroll
      for (int d0 = 0; d0 < 4; ++d0) qf[d0] = *(const bf16x8*)(Q + 16 * d0); }
    const float ci = ((const float*)(ws + OFF_CF))[(size_t)bh * 4096 + qrow];
    FlashSt<2> st; flash_init<2>(st);
    const int vb = lane_vbase(lane);
    asm volatile("s_waitcnt vmcnt(0)" ::: "memory");
    asm volatile("s_barrier" ::: "memory");
    int slot = 0;
    for (int t = 0; t < NTl; ++t) {
        const int s2 = (slot >= 1) ? slot - 1 : 2;
        if (t + 2 < NTl) FOX_DMA(t + 2, s2);
        if (64 * t <= wrow0 + 31) {
            f32x16 p0, p1;
            { const LAS float* cf = (const LAS float*)(L + A_CFRING + slot * 2048 + wid * 256) + 4 * hi;
#pragma unroll
              for (int rq = 0; rq < 4; ++rq) { const f32x4 c0 = *(const LAS f32x4*)(cf + 8 * rq), c1 = *(const LAS f32x4*)(cf + 32 + 8 * rq);
#pragma unroll
                  for (int e = 0; e < 4; ++e) { p0[4 * rq + e] = ci - c0[e]; p1[4 * rq + e] = ci - c1[e]; } } }
            qk_tile(p0, p1, L + A_KRING + slot * A_SLOT, qf, r32, hi);
            if (64 * t + 63 > wrow0) {
                const int kb = 64 * t + 4 * hi;
#pragma unroll
                for (int r = 0; r < 16; ++r) { const int kv = kb + (r & 3) + 8 * (r >> 2); if (kv > qrow) p0[r] = -INFINITY; if (kv + 32 > qrow) p1[r] = -INFINITY; }
            }
            flash_update<2>(st, p0, p1, L + A_VRING + slot * A_SLOT + vb);
        }
        if (t + 2 < NTl) { A_WAIT_BAR(3); } else { A_WAIT_BAR(0); }
        slot = (slot == 2) ? 0 : slot + 1;
    }
#undef FOX_DMA
    const float lt = st.l + __shfl_xor(st.l, 32), il = 1.f / lt;
    const int b = bh >> 3, h = bh & 7;
    bf16* Y = (bf16*)(ws + OFF_ZA) + (size_t)(b * 4096 + qrow) * 512 + h * 64;
#pragma unroll
    for (int db = 0; db < 2; ++db)
#pragma unroll
        for (int rq = 0; rq < 4; ++rq) { bf16* yp = Y + 32 * db + 8 * rq + 4 * hi; const u32x2 z = *(const u32x2*)yp;
            const float z0 = __uint_as_float(z.x << 16), z1 = __uint_as_float(z.x & 0xffff0000u), z2 = __uint_as_float(z.y << 16), z3 = __uint_as_float(z.y & 0xffff0000u);
            u32x2 o; o.x = pk2(st.o[db][4 * rq] * il * z0, st.o[db][4 * rq + 1] * il * z1); o.y = pk2(st.o[db][4 * rq + 2] * il * z2, st.o[db][4 * rq + 3] * il * z3);
            *(u32x2*)yp = o; }
}

__device__ __forceinline__ void diff_unit(unsigned char* lds, unsigned char* ws, int bhc, int qb, const float* subg, float lam, float lam_init) {
    int tid_o = threadIdx.x; asm volatile("" : "+v"(tid_o));
    const int tid = tid_o, lane = tid & 63, wid = __builtin_amdgcn_readfirstlane(tid >> 6), r32 = lane & 31, hi = lane >> 5;
    const int map = wid >> 2, wl = wid & 3;
    const unsigned lds0 = (unsigned)(uintptr_t)lds;
    const lds_cptr L = (lds_cptr)lds;
    const int b = bhc >> 2, hc = bhc & 3;
    const int qrow = 128 * qb + 32 * wl + r32, wrow0 = 128 * qb + 32 * wl;
    const int NTl = 2 * (qb + 1);
    const char* Kg = (const char*)(ws + OFF_KC) + (size_t)(b * 8 + hc * 2) * 524288 + wid * 1024 + lane * 16;
    const char* Vg = (const char*)(ws + OFF_VC) + (size_t)bhc * 1048576 + wid * 1024 + lane * 16;
    const unsigned kdst = (unsigned)__builtin_amdgcn_readfirstlane(lds0 + A_KRING + wid * 1024), vdst = (unsigned)__builtin_amdgcn_readfirstlane(lds0 + A_VRING + wid * 1024);
#define DIFF_DMA(t, slot) do { glds16(Kg + (size_t)(t) * 8192, kdst + (slot) * A_SLOT); glds16(Kg + 524288 + (size_t)(t) * 8192, kdst + (slot) * A_SLOT + 8192); \
        glds16(Vg + (size_t)(t) * 16384, vdst + (slot) * A_SLOT); glds16(Vg + (size_t)(t) * 16384 + 8192, vdst + (slot) * A_SLOT + 8192); } while (0)
    asm volatile("s_waitcnt vmcnt(0)" ::: "memory");
    DIFF_DMA(0, 0); DIFF_DMA(1, 1);
    bf16x8 qf[4];
    { const bf16* Q = (const bf16*)(ws + OFF_QC) + ((size_t)(b * 8 + hc * 2 + map) * 4096 + qrow) * 64 + 8 * hi;
#pragma unroll
      for (int d0 = 0; d0 < 4; ++d0) qf[d0] = *(const bf16x8*)(Q + 16 * d0); }
    FlashSt<4> st; flash_init<4>(st);
    const int vb = lane_vbase(lane);
    asm volatile("s_waitcnt vmcnt(0)" ::: "memory");
    asm volatile("s_barrier" ::: "memory");
    int slot = 0;
    for (int t = 0; t < NTl; ++t) {
        const int s2 = (slot >= 1) ? slot - 1 : 2;
        if (t + 2 < NTl) DIFF_DMA(t + 2, s2);
        if (64 * t <= wrow0 + 31) {
            f32x16 p0, p1;
#pragma unroll
            for (int r = 0; r < 16; ++r) { p0[r] = 0.f; p1[r] = 0.f; }
            qk_tile(p0, p1, L + A_KRING + slot * A_SLOT + map * 8192, qf, r32, hi);
            if (64 * t + 63 > wrow0) {
                const int kb = 64 * t + 4 * hi;
#pragma unroll
                for (int r = 0; r < 16; ++r) { const int kv = kb + (r & 3) + 8 * (r >> 2); if (kv > qrow) p0[r] = -INFINITY; if (kv + 32 > qrow) p1[r] = -INFINITY; }
            }
            flash_update<4>(st, p0, p1, L + A_VRING + slot * A_SLOT + vb);
        }
        if (t + 2 < NTl) { A_WAIT_BAR(4); } else { A_WAIT_BAR(0); }
        slot = (slot == 2) ? 0 : slot + 1;
    }
#undef DIFF_DMA
    const float lt = st.l + __shfl_xor(st.l, 32), il = 1.f / lt;
    LAS float* stage = (LAS float*)lds + wl * 4096 + r32;
    if (map == 1) {
#pragma unroll
        for (int db = 0; db < 4; ++db)
#pragma unroll
            for (int r = 0; r < 16; ++r) stage[(32 * db + crow(r, hi)) * 32] = st.o[db][r] * il;
    }
    asm volatile("s_waitcnt lgkmcnt(0)\n\ts_barrier" ::: "memory");
    if (map == 0) {
        float ss = 0.f;
#pragma unroll
        for (int db = 0; db < 4; ++db)
#pragma unroll
            for (int r = 0; r < 16; ++r) { const float v = st.o[db][r] * il - lam * stage[(32 * db + crow(r, hi)) * 32]; st.o[db][r] = v; ss += v * v; }
        ss += __shfl_xor(ss, 32);
        const float rs = rsqrtf(ss * (1.f / 128.f) + EPS) * (1.f - lam_init);
        bf16* Y = (bf16*)(ws + OFF_ZC) + (size_t)(b * 4096 + qrow) * 512 + hc * 128;
#pragma unroll
        for (int db = 0; db < 4; ++db)
#pragma unroll
            for (int rq = 0; rq < 4; ++rq) { const int d = 32 * db + 8 * rq + 4 * hi; bf16* yp = Y + d; const u32x2 z = *(const u32x2*)yp; const f32x4 g = *(const f32x4*)(subg + d);
                const float z0 = __uint_as_float(z.x << 16), z1 = __uint_as_float(z.x & 0xffff0000u), z2 = __uint_as_float(z.y << 16), z3 = __uint_as_float(z.y & 0xffff0000u);
                u32x2 o; o.x = pk2(st.o[db][4 * rq] * rs * g[0] * z0, st.o[db][4 * rq + 1] * rs * g[1] * z1); o.y = pk2(st.o[db][4 * rq + 2] * rs * g[2] * z2, st.o[db][4 * rq + 3] * rs * g[3] * z3);
                *(u32x2*)yp = o; }
    }
    asm volatile("s_waitcnt lgkmcnt(0)\n\ts_barrier" ::: "memory");
}

constexpr int N_IMP = A_MISC, N_SELM = N_IMP + 64 * 65 * 4, N_UMASK = N_SELM + 512, N_SEQC = N_UMASK + 16, N_SEQD = N_SEQC + 80, N_CNT = N_SEQD + 16;
template <int MODE> __device__ __forceinline__ void nsa_ring(FlashSt<2>& st, unsigned char* lds, const char* Kg, const char* Vg, unsigned kdst, unsigned vdst, int n, int seqoff,
                                                             const bf16x8 (&qf)[4], int tb, int qloc, unsigned selLo, unsigned selHi, int r32, int hi, int vb) {
    const lds_cptr L = (lds_cptr)lds;
    const LAS unsigned char* seq = (const LAS unsigned char*)(L + seqoff);
#define NSA_DMA(j, slot) do { glds16(Kg + (size_t)(j) * 8192, kdst + (slot) * A_SLOT); glds16(Vg + (size_t)(j) * 8192, vdst + (slot) * A_SLOT); } while (0)
    asm volatile("s_waitcnt vmcnt(0)" ::: "memory");
    { const int j0 = __builtin_amdgcn_readfirstlane((int)seq[0]); NSA_DMA(j0, 0); if (n > 1) { const int j1 = __builtin_amdgcn_readfirstlane((int)seq[1]); NSA_DMA(j1, 1); } }
    A_WAIT_BAR(0);
    int slot = 0;
    for (int i = 0; i < n; ++i) {
        const int s2 = (slot >= 1) ? slot - 1 : 2;
        if (i + 2 < n) { const int j2 = __builtin_amdgcn_readfirstlane((int)seq[i + 2]); NSA_DMA(j2, s2); }
        const int j = __builtin_amdgcn_readfirstlane((int)seq[i]);
        f32x16 p0, p1;
#pragma unroll
        for (int r = 0; r < 16; ++r) { p0[r] = 0.f; p1[r] = 0.f; }
        qk_tile(p0, p1, L + A_KRING + slot * A_SLOT, qf, r32, hi);
        if (j == tb) {
#pragma unroll
            for (int r = 0; r < 16; ++r) { const int kv = 4 * hi + (r & 3) + 8 * (r >> 2); if (kv > qloc) p0[r] = -INFINITY; if (kv + 32 > qloc) p1[r] = -INFINITY; }
        } else if (MODE == 0) {
            const bool sel = (((j < 32) ? (selLo >> j) : (selHi >> (j - 32))) & 1u) != 0u;
            if (!sel) {
#pragma unroll
                for (int r = 0; r < 16; ++r) { p0[r] = -INFINITY; p1[r] = -INFINITY; } }
        } else if (j == tb - 8) {
#pragma unroll
            for (int r = 0; r < 16; ++r) { const int kv = 4 * hi + (r & 3) + 8 * (r >> 2); if (kv <= qloc) p0[r] = -INFINITY; if (kv + 32 <= qloc) p1[r] = -INFINITY; }
        }
        flash_update<2>(st, p0, p1, L + A_VRING + slot * A_SLOT + vb);
        if (i + 2 < n) { A_WAIT_BAR(2); } else { A_WAIT_BAR(0); }
        slot = (slot == 2) ? 0 : slot + 1;
    }
#undef NSA_DMA
}
__device__ __forceinline__ void nsa_unit(unsigned char* lds, unsigned char* ws, int bg, int tb) {
    int tid_o = threadIdx.x; asm volatile("" : "+v"(tid_o));
    const int tid = tid_o, lane = tid & 63, wid = __builtin_amdgcn_readfirstlane(tid >> 6), r32 = lane & 31, hi = lane >> 5;
    const unsigned lds0 = (unsigned)(uintptr_t)lds;
    const lds_cptr L = (lds_cptr)lds;
    const int b = bg >> 1, g = bg & 1, h = 4 * g + (wid >> 1), qloc = 32 * (wid & 1) + r32, t = 64 * tb + qloc, row = b * 4096 + t;
    const unsigned kdst = (unsigned)__builtin_amdgcn_readfirstlane(lds0 + A_KRING + wid * 1024), vdst = (unsigned)__builtin_amdgcn_readfirstlane(lds0 + A_VRING + wid * 1024);
    const int vb = lane_vbase(lane);
    LAS float* imp = (LAS float*)(L + N_IMP);
    LAS unsigned* selm = (LAS unsigned*)(L + N_SELM);
    LAS unsigned* umask = (LAS unsigned*)(L + N_UMASK);
    const int nvmax = 4 * tb + 3, nct = (nvmax + 63) >> 6;
    for (int i = tid; i < 64 * 65; i += 512) imp[i] = 0.f;
    if (tid < 128) selm[tid] = 0u;
    if (tid < 2) umask[tid] = 0u;
    asm volatile("s_waitcnt vmcnt(0)" ::: "memory");
    { const char* Kc = (const char*)(ws + OFF_KCMP) + (size_t)bg * 32768 + wid * 1024 + lane * 16; const char* Vc = (const char*)(ws + OFF_VCMP) + (size_t)bg * 32768 + wid * 1024 + lane * 16;
      for (int ct = 0; ct < nct; ++ct) { glds16(Kc + ct * 8192, kdst + ct * 8192); glds16(Vc + ct * 8192, vdst + ct * 8192); } }
    bf16x8 qf[4];
    const bf16* Qp = (const bf16*)(ws + OFF_QB) + ((size_t)(b * 8 + h) * 4096 + t) * 64 + 8 * hi;
#pragma unroll
    for (int d0 = 0; d0 < 4; ++d0) qf[d0] = *(const bf16x8*)(Qp + 16 * d0);
    const float* gt = (const float*)(ws + OFF_GATES) + (size_t)row * 24 + (h & 7) * 3;
    const float g0 = gt[0], g1 = gt[1], g2 = gt[2];
    A_WAIT_BAR(0);
    const int nv = (t >= 31) ? ((t - 31) >> 4) + 1 : 0;
    f32x16 y[2];
    {
        float m = -1e30f, l = 0.f;
        for (int ct = 0; ct < nct; ++ct) {
            f32x16 p0, p1;
#pragma unroll
            for (int r = 0; r < 16; ++r) { p0[r] = 0.f; p1[r] = 0.f; }
            qk_tile(p0, p1, L + A_KRING + ct * 8192, qf, r32, hi);
            const int cb = 64 * ct + 4 * hi;
#pragma unroll
            for (int r = 0; r < 16; ++r) { const int c = cb + (r & 3) + 8 * (r >> 2); if (c >= nv) p0[r] = -INFINITY; if (c + 32 >= nv) p1[r] = -INFINITY; }
            const float rm = rowmax32(p0, p1), mn = fmaxf(m, rm);
            float ls = 0.f;
#pragma unroll
            for (int r = 0; r < 16; ++r) ls += __builtin_amdgcn_exp2f(p0[r] - mn) + __builtin_amdgcn_exp2f(p1[r] - mn);
            l = l * __builtin_amdgcn_exp2f(m - mn) + ls; m = mn;
        }
        const float lt = l + __shfl_xor(l, 32), il = lt > 0.f ? 1.f / lt : 0.f;
        f32x16 oc[2];
#pragma unroll
        for (int r = 0; r < 16; ++r) { oc[0][r] = 0.f; oc[1][r] = 0.f; }
        for (int ct = 0; ct < nct; ++ct) {
            f32x16 p0, p1;
#pragma unroll
            for (int r = 0; r < 16; ++r) { p0[r] = 0.f; p1[r] = 0.f; }
            qk_tile(p0, p1, L + A_KRING + ct * 8192, qf, r32, hi);
            const int cb = 64 * ct + 4 * hi;
#pragma unroll
            for (int r = 0; r < 16; ++r) { const int c = cb + (r & 3) + 8 * (r >> 2);
                p0[r] = (c >= nv) ? 0.f : __builtin_amdgcn_exp2f(p0[r] - m) * il; p1[r] = (c + 32 >= nv) ? 0.f : __builtin_amdgcn_exp2f(p1[r] - m) * il; }
            LAS float* ir = imp + qloc * 65 + 16 * ct + hi;
#pragma unroll
            for (int rq = 0; rq < 4; ++rq) {
                const float q0 = (p0[4 * rq] + p0[4 * rq + 1]) + (p0[4 * rq + 2] + p0[4 * rq + 3]), q1 = (p1[4 * rq] + p1[4 * rq + 1]) + (p1[4 * rq + 2] + p1[4 * rq + 3]);
                __hip_atomic_fetch_add(ir + 2 * rq, q0, __ATOMIC_RELAXED, __HIP_MEMORY_SCOPE_WORKGROUP);
                __hip_atomic_fetch_add(ir + 2 * rq + 1, p0[4 * rq + 3], __ATOMIC_RELAXED, __HIP_MEMORY_SCOPE_WORKGROUP);
                __hip_atomic_fetch_add(ir + 8 + 2 * rq, q1, __ATOMIC_RELAXED, __HIP_MEMORY_SCOPE_WORKGROUP);
                if (16 * ct + 8 + 2 * rq + hi + 1 < 64) __hip_atomic_fetch_add(ir + 8 + 2 * rq + 1, p1[4 * rq + 3], __ATOMIC_RELAXED, __HIP_MEMORY_SCOPE_WORKGROUP);
            }
            pv_tile<2>(oc, L + A_VRING + ct * 8192 + vb, p0, p1);
        }
#pragma unroll
        for (int r = 0; r < 16; ++r) { y[0][r] = g0 * oc[0][r]; y[1][r] = g0 * oc[1][r]; }
    }
    asm volatile("s_waitcnt lgkmcnt(0)\n\ts_barrier" ::: "memory");
    {
        const int q = tid >> 3, part = tid & 7;
        float sc[8];
#pragma unroll
        for (int i = 0; i < 8; ++i) { const int j = 8 * part + i; const bool forced = (j == 0) || (j == tb) || (j == tb - 1);
            sc[i] = forced ? 1e30f : (j <= tb ? imp[q * 65 + j] : -1e30f); }
#pragma unroll
        for (int i = 0; i < 8; ++i) imp[q * 65 + 8 * part + i] = sc[i];
        asm volatile("s_waitcnt lgkmcnt(0)\n\ts_barrier" ::: "memory");
        int rank[8];
#pragma unroll
        for (int i = 0; i < 8; ++i) rank[i] = 0;
        for (int k = 0; k < 64; ++k) { const float sk = imp[q * 65 + k];
#pragma unroll
            for (int i = 0; i < 8; ++i) rank[i] += (sk > sc[i] || (sk == sc[i] && k < 8 * part + i)) ? 1 : 0; }
        unsigned bits = 0u;
#pragma unroll
        for (int i = 0; i < 8; ++i) bits |= (rank[i] < 16) ? (1u << i) : 0u;
        bits <<= 8 * (part & 3);
        __hip_atomic_fetch_or(selm + q * 2 + (part >> 2), bits, __ATOMIC_RELAXED, __HIP_MEMORY_SCOPE_WORKGROUP);
        __hip_atomic_fetch_or(umask + (part >> 2), bits, __ATOMIC_RELAXED, __HIP_MEMORY_SCOPE_WORKGROUP);
        asm volatile("s_waitcnt lgkmcnt(0)\n\ts_barrier" ::: "memory");
        if (tid == 0) {
            LAS unsigned char* sq = (LAS unsigned char*)(L + N_SEQC); LAS unsigned char* sd = (LAS unsigned char*)(L + N_SEQD); LAS int* cnt = (LAS int*)(L + N_CNT);
            const unsigned long long um = ((unsigned long long)umask[1] << 32) | umask[0];
            int n = 0; sq[n++] = (unsigned char)tb;
            for (int j = 0; j < tb; ++j) if ((um >> j) & 1ull) sq[n++] = (unsigned char)j;
            cnt[0] = n;
            int n2 = 0; sd[n2++] = (unsigned char)tb;
            for (int j = (tb >= 8 ? tb - 8 : 0); j < tb; ++j) sd[n2++] = (unsigned char)j;
            cnt[1] = n2;
        }
        asm volatile("s_waitcnt lgkmcnt(0)\n\ts_barrier" ::: "memory");
    }
    const unsigned selLo = selm[qloc * 2], selHi = selm[qloc * 2 + 1];
    const int nC = __builtin_amdgcn_readfirstlane(((const LAS int*)(L + N_CNT))[0]), nD = __builtin_amdgcn_readfirstlane(((const LAS int*)(L + N_CNT))[1]);
    { const float* cs = (const float*)(ws + OFF_COS) + (size_t)row * 32 + 4 * hi; const float* sn = (const float*)(ws + OFF_SIN) + (size_t)row * 32 + 4 * hi;
#pragma unroll
      for (int d0 = 0; d0 < 4; ++d0) { const f32x4 c = *(const f32x4*)(cs + 8 * d0), s = *(const f32x4*)(sn + 8 * d0); u32x4 w = __builtin_bit_cast(u32x4, qf[d0]); u32x4 o;
#pragma unroll
          for (int e = 0; e < 4; ++e) { const float x1 = __uint_as_float(w[e] << 16), x2 = __uint_as_float(w[e] & 0xffff0000u); o[e] = pk2(x1 * c[e] - x2 * s[e], x2 * c[e] + x1 * s[e]); }
          qf[d0] = __builtin_bit_cast(bf16x8, o); } }
    {
        FlashSt<2> st; flash_init<2>(st);
        const char* Kg = (const char*)(ws + OFF_KSEL) + (size_t)bg * 524288 + wid * 1024 + lane * 16; const char* Vg = (const char*)(ws + OFF_VSEL) + (size_t)bg * 524288 + wid * 1024 + lane * 16;
        nsa_ring<0>(st, lds, Kg, Vg, kdst, vdst, nC, N_SEQC, qf, tb, qloc, selLo, selHi, r32, hi, vb);
        const float lt = st.l + __shfl_xor(st.l, 32), sc = g1 / lt;
#pragma unroll
        for (int r = 0; r < 16; ++r) { y[0][r] += sc * st.o[0][r]; y[1][r] += sc * st.o[1][r]; }
    }
    {
        FlashSt<2> st; flash_init<2>(st);
        const char* Kg = (const char*)(ws + OFF_KWIN) + (size_t)bg * 524288 + wid * 1024 + lane * 16; const char* Vg = (const char*)(ws + OFF_VWIN) + (size_t)bg * 524288 + wid * 1024 + lane * 16;
        nsa_ring<1>(st, lds, Kg, Vg, kdst, vdst, nD, N_SEQD, qf, tb, qloc, selLo, selHi, r32, hi, vb);
        const float lt = st.l + __shfl_xor(st.l, 32), sc = g2 / lt;
#pragma unroll
        for (int r = 0; r < 16; ++r) { y[0][r] += sc * st.o[0][r]; y[1][r] += sc * st.o[1][r]; }
    }
    bf16* Y = (bf16*)(ws + OFF_ZB) + (size_t)row * 512 + h * 64;
#pragma unroll
    for (int db = 0; db < 2; ++db)
#pragma unroll
        for (int rq = 0; rq < 4; ++rq) { bf16* yp = Y + 32 * db + 8 * rq + 4 * hi; const u32x2 z = *(const u32x2*)yp;
            const float z0 = __uint_as_float(z.x << 16), z1 = __uint_as_float(z.x & 0xffff0000u), z2 = __uint_as_float(z.y << 16), z3 = __uint_as_float(z.y & 0xffff0000u);
            u32x2 o; o.x = pk2(y[db][4 * rq] * z0, y[db][4 * rq + 1] * z1); o.y = pk2(y[db][4 * rq + 2] * z2, y[db][4 * rq + 3] * z3);
            *(u32x2*)yp = o; }
}

namespace cg = cooperative_groups;
constexpr int NT = 512;
constexpr int LDS_BYTES = 147456;
struct KArgs { const void* in[23]; float* out; unsigned char* ws; };

#define OPAQUE_TID() int tid = threadIdx.x; asm volatile("" : "+v"(tid))
#define VRUN(VT, NVB, CALL) do { OPAQUE_TID(); constexpr int per_ = NT / (VT); for (int vb = blockIdx.x * per_ + tid / (VT); vb < (NVB); vb += gridDim.x * per_) { const int vt = tid % (VT); CALL; } } while (0)
#define VRUN_BAR(NVB, CALL) do { OPAQUE_TID(); float (*tile)[65] = (float (*)[65])(lds + (tid >> 8) * 64 * 65 * 4); (void)tile; const int nvb_ = (NVB); for (int it_ = 0; it_ * (int)gridDim.x * 2 < nvb_; ++it_) { const int vb = (it_ * (int)gridDim.x + (int)blockIdx.x) * 2 + (tid >> 8); const int vt = tid & 255; const bool active = vb < nvb_; CALL; } } while (0)

#ifndef FAST_FOX
#define FAST_FOX 1
#endif
#ifndef FAST_DIFF
#define FAST_DIFF 1
#endif
#ifndef FAST_NSA
#define FAST_NSA 1
#endif
#ifndef DO_ALL
#define DO_ALL 1
#endif
#ifndef DO_PRO
#define DO_PRO DO_ALL
#endif
#ifndef DO_INPROJ
#define DO_INPROJ DO_ALL
#endif
#ifndef DO_P2
#define DO_P2 DO_ALL
#endif
#ifndef DO_ATTN
#define DO_ATTN DO_ALL
#endif
#ifndef DO_GATEBR
#define DO_GATEBR DO_ALL
#endif
#ifndef DO_OUT
#define DO_OUT DO_ALL
#endif
#ifndef DO_PLE
#define DO_PLE DO_ALL
#endif
#ifndef DO_TAIL
#define DO_TAIL DO_ALL
#endif
__global__ void __launch_bounds__(NT) mega(KArgs a) {
    extern __shared__ __attribute__((aligned(16))) unsigned char lds[];
    cg::grid_group grid = cg::this_grid();
    unsigned char* ws = a.ws; float* X = a.out;
    const float* x = (const float*)a.in[0]; const float* p = (const float*)a.in[1]; const int* pos = (const int*)a.in[2];
    const float *norm_g = (const float*)a.in[3], *w_in = (const float*)a.in[4], *b_forget = (const float*)a.in[5];
    const float *pe_k = (const float*)a.in[6], *w1_k = (const float*)a.in[7], *b1_k = (const float*)a.in[8], *w2_k = (const float*)a.in[9];
    const float *pe_v = (const float*)a.in[10], *w1_v = (const float*)a.in[11], *b1_v = (const float*)a.in[12], *w2_v = (const float*)a.in[13];
    const float *diff_lam = (const float*)a.in[14], *subln = (const float*)a.in[15];
    const float *w_out = (const float*)a.in[19], *w_ple = (const float*)a.in[20], *w_pg = (const float*)a.in[21], *final_g = (const float*)a.in[22];
#if DO_PRO
    VRUN(256, M / 4, d_xprep(vb, vt, x, ws));
    VRUN(256, M * 32 / 256, d_rope_table(vb, vt, pos, ws));
    VRUN(256, (2 * M * 256 / 4) / 256, d_pconv(vb, vt, p, ws));
    for (int l = 0; l < DEPTH; ++l) {
        VRUN_BAR(256, d_convT<0>(active, vb % 16, vb / 16, vt, tile, w_out + (size_t)l * 1024 * 1024, 1024, 1024, (bf16*)(ws + OFF_WOUT) + (size_t)l * 1024 * 1024, nullptr));
        VRUN_BAR(256, d_convT<0>(active, vb % 16, vb / 16, vt, tile, w_pg + (size_t)l * 1024 * 1024, 1024, 1024, (bf16*)(ws + OFF_WPG) + (size_t)l * 1024 * 1024, nullptr));
        VRUN_BAR(64, d_convT<0>(active, vb % 16, vb / 16, vt, tile, w_ple + (size_t)l * 256 * 1024, 1024, 256, (bf16*)(ws + OFF_WPL) + (size_t)l * 1024 * 256, nullptr));
        { OPAQUE_TID(); if (blockIdx.x == 0 && tid < 64) d_lam(tid, diff_lam + l * 256, ws, l); }
    }
#endif
    for (int l = 0; l < DEPTH; ++l) {
        const float* wl = w_in + (size_t)l * 1024 * NIN; const float* ng = norm_g + l * 1024;
#if DO_PRO
        VRUN_BAR(96 * 16, d_convT<1>(active, vb % 96, vb / 96, vt, tile, wl, NIN, 1024, (bf16*)(ws + OFF_WIN), ng));
        VRUN_BAR(48 * 16, d_convT<0>(active, vb % 48, vb / 48, vt, tile, wl + 5920, NIN, 1024, (bf16*)(ws + OFF_WMG), ng));
        for (int i = 0; i < 3; ++i) { const float* wb = (const float*)a.in[16 + i] + (size_t)l * 512 * 1024;
            VRUN_BAR(16 * 8, d_convT<0>(active, vb % 16, vb / 16, vt, tile, wb, 1024, 512, (bf16*)(ws + OFF_WBR) + (size_t)i * 1024 * 512, nullptr)); }
        VRUN_BAR(4 * 32, d_convT<0>(active, vb % 4, vb / 4, vt, tile, w1_k + (size_t)l * 2048 * 256, 256, 2048, (bf16*)(ws + OFF_CW1), nullptr));
        VRUN_BAR(4 * 32, d_convT<0>(active, vb % 4, vb / 4, vt, tile, w1_v + (size_t)l * 2048 * 256, 256, 2048, (bf16*)(ws + OFF_CW1) + 256 * 2048, nullptr));
        VRUN_BAR(4, d_convT<2>(active, 0, vb, vt, tile, w2_k + (size_t)l * 256 * 64, 64, 256, (bf16*)(ws + OFF_CW2), nullptr));
        VRUN_BAR(4, d_convT<0>(active, 0, vb, vt, tile, w2_v + (size_t)l * 256 * 64, 64, 256, (bf16*)(ws + OFF_CW2) + 64 * 256, nullptr));
        { OPAQUE_TID(); if (blockIdx.x == 1 && tid < 256) d_cb1(tid, pe_k + l * 2048, w1_k + (size_t)l * 2048 * 256, b1_k + l * 256, (float*)(ws + OFF_CB1));
          if (blockIdx.x == 2 && tid < 256) d_cb1(tid, pe_v + l * 2048, w1_v + (size_t)l * 2048 * 256, b1_v + l * 256, (float*)(ws + OFF_CB1) + 256); }
#endif
        grid.sync();
        EpiCtx E{ws, b_forget + l * 8, l == 0 ? x : X, X, 0};
#if DO_INPROJ
        FAST_GEMM(EPI_INPROJ, ws + OFF_XB, ws + OFF_WIN, NP, 1024, true);
#endif
        grid.sync();
#if DO_P2
        VRUN(64, 32, d_cumsum(vb, vt, ws));
        VRUN_BAR(256 * 8 * 2, d_compress(active, vb, vt, (float*)lds + (tid >> 8) * 256, ws));
#endif
        grid.sync();
#if DO_ATTN
#if FAST_FOX
        for (int u = blockIdx.x; u < 512; u += gridDim.x) fox_unit(lds, ws, u & 31, u < 256 ? 15 - (u >> 5) : (u >> 5) - 8);
        __syncthreads();
#else
        VRUN(64, 32 * 64, d_fox(vb, vt, ws));
#endif
#if FAST_DIFF
        { const float lam = ((const float*)(ws + OFF_CTL))[CTL_LAM + l], lam_init = 0.8f - 0.6f * expf(-0.3f * (float)l);
          for (int u = blockIdx.x; u < 512; u += gridDim.x) diff_unit(lds, ws, u & 15, u < 256 ? 31 - (u >> 4) : (u >> 4) - 16, subln + l * 128, lam, lam_init); }
#else
        { OPAQUE_TID(); if ((tid >> 6) < 4) { for (int vb = blockIdx.x * 4 + (tid >> 6); vb < 16 * 64; vb += gridDim.x * 4) d_diff(vb, tid & 63, (float (*)[129])(lds + (tid >> 6) * 64 * 129 * 4), ws, subln + l * 128, l); } }
#endif
#if FAST_NSA
        __syncthreads();
        for (int u = blockIdx.x; u < 512; u += gridDim.x) nsa_unit(lds, ws, u & 7, u < 256 ? 63 - (u >> 3) : (u >> 3) - 32);
#else
        __syncthreads();
        VRUN(64, 8 * 64, d_nsa_topk(vb, vt, (float (*)[65])(lds + (tid >> 6) * 64 * 65 * 4), ws));
        grid.sync();
        VRUN(64, 32 * 64, d_nsa_attn(vb, vt, (float (*)[65])(lds + (tid >> 6) * 64 * 65 * 4), ws));
#endif
#endif
        grid.sync();
#if DO_GATEBR
        FAST_GEMM(EPI_GATE, (const bf16*)(ws + OFF_XB), (const bf16*)(ws + OFF_WMG), 1024, 1024, false);
        FAST_GEMM(EPI_BR0, (const bf16*)(ws + OFF_ZA), (const bf16*)(ws + OFF_WBR), 1024, 512, false);
        FAST_GEMM(EPI_GATE, (const bf16*)(ws + OFF_XB), (const bf16*)(ws + OFF_WMG) + (size_t)1024 * 1024, 1024, 1024, false);
        FAST_GEMM(EPI_BR1, (const bf16*)(ws + OFF_ZB), (const bf16*)(ws + OFF_WBR) + (size_t)1024 * 512, 1024, 512, false);
        FAST_GEMM(EPI_GATE, (const bf16*)(ws + OFF_XB), (const bf16*)(ws + OFF_WMG) + (size_t)2 * 1024 * 1024, 1024, 1024, false);
        FAST_GEMM(EPI_BR2, (const bf16*)(ws + OFF_ZC), (const bf16*)(ws + OFF_WBR) + (size_t)2 * 1024 * 512, 1024, 512, false);
#endif
        grid.sync();
#if DO_OUT
        FAST_GEMM(EPI_OUT, (const bf16*)(ws + OFF_MERGED), (const bf16*)(ws + OFF_WOUT) + (size_t)l * 1024 * 1024, 1024, 1024, false);
#endif
        grid.sync();
#if DO_PLE
        FAST_GEMM(EPI_U, (const bf16*)(ws + OFF_PB) + (size_t)l * M * 256, (const bf16*)(ws + OFF_WPL) + (size_t)l * 1024 * 256, 1024, 256, false);
        FAST_GEMM(EPI_PLE, (const bf16*)(ws + OFF_X1B), (const bf16*)(ws + OFF_WPG) + (size_t)l * 1024 * 1024, 1024, 1024, false);
#endif
        grid.sync();
#if DO_TAIL
        if (l + 1 < DEPTH) VRUN(256, M / 4, d_sumsq(vb, vt, X, ws));
#endif
    }
#if DO_TAIL
    VRUN(256, M / 4, d_final(vb, vt, X, final_g));
#endif
}

extern "C" void kernel_launch(void* const* d_in, const int* in_sizes, int n_in, void* d_out, int out_size, void* d_ws, size_t ws_size, hipStream_t stream) {
    static int grid_blocks = 0;
    if (grid_blocks == 0) {
        if (n_in != 23 || ws_size < WS_NEED || out_size != M * DM) { fprintf(stderr, "kernel_launch: unexpected sizes (n_in %d ws %zu out %d)\n", n_in, ws_size, out_size); grid_blocks = -1; return; }
        int dev = 0, cus = 0, per_cu = 0;
        (void)hipGetDevice(&dev); (void)hipDeviceGetAttribute(&cus, hipDeviceAttributeMultiprocessorCount, dev);
        (void)hipFuncSetAttribute((const void*)mega, hipFuncAttributeMaxDynamicSharedMemorySize, LDS_BYTES);
        (void)hipOccupancyMaxActiveBlocksPerMultiprocessor(&per_cu, (const void*)mega, NT, LDS_BYTES);
        if (per_cu < 1) { fprintf(stderr, "kernel_launch: occupancy query says %d blocks per CU\n", per_cu); grid_blocks = -1; return; }
        grid_blocks = cus * 1;
    }
    if (grid_blocks < 0) return;
    (void)hipMemsetAsync((char*)d_ws + OFF_CTL, 0, 4096, stream);
    KArgs a{};
    for (int i = 0; i < 23; ++i) a.in[i] = d_in[i];
    a.out = (float*)d_out; a.ws = (unsigned char*)d_ws;
    void* args[] = {&a};
    hipError_t e = hipLaunchCooperativeKernel((const void*)mega, dim3(grid_blocks), dim3(NT), args, LDS_BYTES, stream);
    if (e != hipSuccess) fprintf(stderr, "cooperative launch failed: %s (grid %d)\n", hipGetErrorString(e), grid_blocks);
}
```

```cpp
#include <hip/hip_runtime.h>
#include <hip/hip_cooperative_groups.h>
#include <cstdio>
#include <cstdint>

typedef unsigned short bf16;
typedef short bf16x8 __attribute__((ext_vector_type(8)));
typedef float f32x4 __attribute__((ext_vector_type(4)));
typedef float f32x16 __attribute__((ext_vector_type(16)));
typedef unsigned u32x4 __attribute__((ext_vector_type(4)));
typedef unsigned u32x2 __attribute__((ext_vector_type(2)));

constexpr int BATCH = 4, SEQ = 4096, DM = 1024, M = BATCH * SEQ, DEPTH = 2, NIN = 8992, NP = 6144;
constexpr float EPS = 1e-6f;
constexpr float LOG2E = 1.4426950408889634f;
constexpr float C2 = 0.125f * LOG2E;
constexpr size_t MiB = 1u << 20;
constexpr size_t OFF_CTL = 0;
constexpr size_t OFF_WIN = 1 * MiB, OFF_WMG = 13 * MiB, OFF_WBR = 19 * MiB, OFF_CW1 = 22 * MiB, OFF_CW2 = 24 * MiB, OFF_CB1 = 24 * MiB + 128 * 1024;
constexpr size_t OFF_WOUT = 25 * MiB, OFF_WPG = 29 * MiB, OFF_WPL = 33 * MiB;
constexpr size_t OFF_XB = 34 * MiB, OFF_ZA = 66 * MiB, OFF_ZB = 82 * MiB, OFF_ZC = 98 * MiB;
constexpr size_t OFF_COS = 114 * MiB, OFF_SIN = 116 * MiB, OFF_PB = 118 * MiB;
constexpr size_t OFF_LOGF = 134 * MiB, OFF_CF = 134 * MiB + 512 * 1024, OFF_GATES = 135 * MiB, OFF_SSP = 136 * MiB + 512 * 1024;
constexpr size_t OFF_KCMP = 136 * MiB + 768 * 1024, OFF_VCMP = 137 * MiB, OFF_SELM = 137 * MiB + 256 * 1024;
constexpr size_t OFF_QA = 139 * MiB, OFF_KA = 155 * MiB, OFF_VA = 171 * MiB, OFF_QB = 187 * MiB, OFF_QC = 203 * MiB, OFF_KC = 219 * MiB, OFF_VC = 235 * MiB;
constexpr size_t OFF_KCB = 251 * MiB, OFF_VCB = 255 * MiB, OFF_KSEL = 259 * MiB, OFF_KWIN = 263 * MiB, OFF_VSEL = 267 * MiB, OFF_VWIN = 271 * MiB;
constexpr size_t WS_NEED = 275 * MiB;
constexpr size_t OFF_G = 139 * MiB, OFF_MERGED = 171 * MiB, OFF_T = 203 * MiB, OFF_X1B = 203 * MiB, OFF_U = 139 * MiB;
constexpr int CTL_LAM = 64;

__device__ __forceinline__ bf16 f2bf(float f) { unsigned u = __float_as_uint(f); return (bf16)((u + 0x7fffu + ((u >> 16) & 1u)) >> 16); }
__device__ __forceinline__ float bf2f(bf16 h) { return __uint_as_float(((unsigned)h) << 16); }
__device__ __forceinline__ unsigned pk2(float lo, float hi) { return (unsigned)f2bf(lo) | ((unsigned)f2bf(hi) << 16); }
__device__ __forceinline__ float sigmoidf_(float x) { return 1.f / (1.f + __expf(-x)); }
__device__ __forceinline__ float siluf_(float x) { return x / (1.f + __expf(-x)); }
__device__ __forceinline__ float logsigmoidf_(float x) { return x >= 0.f ? -log1pf(expf(-x)) : x - log1pf(expf(x)); }

__device__ __forceinline__ int ktile_off(int s, int d) { return (s >> 6) * 4096 + (d >> 3) * 512 + (s & 63) * 8 + (d & 7); }
__device__ __forceinline__ int vtile_off(int s, int d) { return (s >> 6) * 4096 + (d >> 5) * 2048 + ((s & 63) >> 4) * 512 + (s & 15) * 32 + (d & 31); }
__device__ __forceinline__ int v128_off(int s, int d) { return (s >> 6) * 8192 + (d >> 5) * 2048 + ((s & 63) >> 4) * 512 + (s & 15) * 32 + (d & 31); }

template <int W> __device__ __forceinline__ void store_bf(bf16* dst, const float* v) {
    if constexpr (W == 4) { u32x2 o; o.x = pk2(v[0], v[1]); o.y = pk2(v[2], v[3]); *(u32x2*)dst = o; }
    else { u32x4 o; o.x = pk2(v[0], v[1]); o.y = pk2(v[2], v[3]); o.z = pk2(v[4], v[5]); o.w = pk2(v[6], v[7]); *(u32x4*)dst = o; }
}

__device__ __forceinline__ int win_srccol(int n) {
    const int seg = n >> 6, j = n & 63; const int il = ((j & 1) << 5) + (j >> 1);
    if (seg < 8) return 0 + n;
    if (seg < 16) return 512 + (n - 512);
    if (seg < 24) return 1024 + (n - 1024);
    if (seg < 32) return 1544 + (n - 1536);
    if (seg < 40) return 2056 + (seg - 32) * 64 + il;
    if (seg < 42) return 2568 + (n - 2560);
    if (seg < 44) return 2696 + (n - 2688);
    if (seg < 46) return 2824 + (seg - 44) * 64 + il;
    if (seg < 48) return 3080 + (seg - 46) * 64 + il;
    if (seg < 50) return 2952 + (n - 3072);
    if (seg < 52) return 3208 + (n - 3200);
    if (seg < 60) return 3360 + (n - 3328);
    if (seg < 68) return 3872 + (seg - 60) * 64 + il;
    if (seg < 76) return 4384 + (seg - 68) * 64 + il;
    if (seg < 84) return 4896 + (n - 4864);
    if (seg < 92) return 5408 + (n - 5376);
    if (seg == 92) { if (j < 8) return 1536 + j; if (j < 32) return 3336 + (j - 8); return -1; }
    return -1;
}

enum { EPI_INPROJ = 0, EPI_GATE = 1, EPI_BR0 = 2, EPI_BR1 = 3, EPI_BR2 = 4, EPI_OUT = 5, EPI_U = 6, EPI_PLE = 7 };
struct EpiCtx { unsigned char* ws; const float* bfg; const float* xin; float* X; int gi; };

__device__ __forceinline__ float row_rstd(const unsigned char* ws, int row) {
    const f32x4 sp = *(const f32x4*)(ws + OFF_SSP + (size_t)row * 16);
    return rsqrtf(((sp[0] + sp[1]) + (sp[2] + sp[3])) * (1.f / 1024.f) + EPS);
}
template <int W> __device__ __forceinline__ void rope_apply(const unsigned char* ws, int row, int d, float* v) {
    const float* cs = (const float*)(ws + OFF_COS) + (size_t)row * 32 + (d >> 1);
    const float* sn = (const float*)(ws + OFF_SIN) + (size_t)row * 32 + (d >> 1);
#pragma unroll
    for (int j = 0; j < W / 2; ++j) { const float c = cs[j], s = sn[j], x1 = v[2 * j], x2 = v[2 * j + 1]; v[2 * j] = x1 * c - x2 * s; v[2 * j + 1] = x2 * c + x1 * s; }
}

enum { T_QA = 0, T_KA, T_VA, T_ZA, T_QB, T_CB, T_KROPE, T_VSW, T_ZB, T_QC, T_KC, T_VC, T_ZC, T_SPECIAL };
__device__ __forceinline__ int inproj_type(int t) {
    return t < 2 ? T_QA : t < 4 ? T_KA : t < 6 ? T_VA : t < 8 ? T_ZA : t < 10 ? T_QB : t == 10 ? T_CB : t == 11 ? T_KROPE : t == 12 ? T_VSW : t < 15 ? T_ZB : t < 17 ? T_QC : t < 19 ? T_KC : t < 21 ? T_VC : t < 23 ? T_ZC : T_SPECIAL;
}
struct Pre { float rs; float a[8]; float b[8]; };
template <int KIND, int T> __device__ __forceinline__ void pre_load(const EpiCtx& E, int row, int col, Pre& p) {
    unsigned char* ws = E.ws; const size_t idx = (size_t)row * 1024 + col;
    if constexpr (KIND == EPI_INPROJ) {
        p.rs = row_rstd(ws, row);
        if constexpr (T == T_KROPE || T == T_QC || T == T_KC) { const int d = col & 63;
            const f32x4 c = *(const f32x4*)((const float*)(ws + OFF_COS) + (size_t)row * 32 + (d >> 1)), s = *(const f32x4*)((const float*)(ws + OFF_SIN) + (size_t)row * 32 + (d >> 1));
#pragma unroll
            for (int i = 0; i < 4; ++i) { p.a[i] = c[i]; p.b[i] = s[i]; } }
    } else if constexpr (KIND == EPI_GATE) { p.rs = row_rstd(ws, row);
    } else if constexpr (KIND == EPI_BR0 || KIND == EPI_BR1 || KIND == EPI_BR2) {
        const u32x4 g = *(const u32x4*)((const bf16*)(ws + OFF_G) + idx);
#pragma unroll
        for (int i = 0; i < 4; ++i) { p.a[2 * i] = __uint_as_float(g[i] << 16); p.a[2 * i + 1] = __uint_as_float(g[i] & 0xffff0000u); }
        if constexpr (KIND != EPI_BR0) { const float* T_ = (const float*)(ws + OFF_T) + idx; const f32x4 t0 = *(const f32x4*)T_, t1 = *(const f32x4*)(T_ + 4);
#pragma unroll
            for (int i = 0; i < 4; ++i) { p.b[i] = t0[i]; p.b[4 + i] = t1[i]; } }
    } else if constexpr (KIND == EPI_OUT) { const f32x4 t0 = *(const f32x4*)(E.xin + idx), t1 = *(const f32x4*)(E.xin + idx + 4);
#pragma unroll
        for (int i = 0; i < 4; ++i) { p.a[i] = t0[i]; p.a[4 + i] = t1[i]; }
    } else if constexpr (KIND == EPI_PLE) { const f32x4 t0 = *(const f32x4*)(E.X + idx), t1 = *(const f32x4*)(E.X + idx + 4); const float* U = (const float*)(ws + OFF_U) + idx; const f32x4 u0 = *(const f32x4*)U, u1 = *(const f32x4*)(U + 4);
#pragma unroll
        for (int i = 0; i < 4; ++i) { p.a[i] = t0[i]; p.a[4 + i] = t1[i]; p.b[i] = u0[i]; p.b[4 + i] = u1[i]; }
    }
}
__device__ __forceinline__ void st_f32x8(float* dst, const float* v) { f32x4 a = {v[0], v[1], v[2], v[3]}, b = {v[4], v[5], v[6], v[7]}; *(f32x4*)dst = a; *(f32x4*)(dst + 4) = b; }
template <int KIND, int T> __device__ __forceinline__ void emit_fin(const EpiCtx& E, int row, int col, const float* a, const Pre& p) {
    constexpr int W = 8;
    unsigned char* ws = E.ws; const size_t idx = (size_t)row * 1024 + col;
    float v[W];
    if constexpr (KIND == EPI_INPROJ) {
        const float rs = p.rs;
#pragma unroll
        for (int i = 0; i < W; ++i) v[i] = a[i] * rs;
        const int b = row >> 12, s = row & 4095;
        if constexpr (T == T_KROPE || T == T_QC || T == T_KC) {
#pragma unroll
            for (int j = 0; j < 4; ++j) { const float c = p.a[j], sn = p.b[j], x1 = v[2 * j], x2 = v[2 * j + 1]; v[2 * j] = x1 * c - x2 * sn; v[2 * j + 1] = x2 * c + x1 * sn; } }
        if constexpr (T == T_QA) { const int cc = col, h = cc >> 6, d = cc & 63;
#pragma unroll
            for (int i = 0; i < W; ++i) v[i] *= C2;
            store_bf<W>((bf16*)(ws + OFF_QA) + ((size_t)(b * 8 + h) * 4096 + s) * 64 + d, v);
        } else if constexpr (T == T_KA) { const int cc = col - 512, h = cc >> 6, d = cc & 63;
            store_bf<W>((bf16*)(ws + OFF_KA) + (size_t)(b * 8 + h) * 262144 + ktile_off(s, d), v);
        } else if constexpr (T == T_VA) { const int cc = col - 1024, h = cc >> 6, d = cc & 63;
            store_bf<W>((bf16*)(ws + OFF_VA) + (size_t)(b * 8 + h) * 262144 + vtile_off(s, d), v);
        } else if constexpr (T == T_ZA || T == T_ZB || T == T_ZC) { const int cc = col - (T == T_ZA ? 1536 : T == T_ZB ? 3328 : 5376);
#pragma unroll
            for (int i = 0; i < W; ++i) v[i] = siluf_(v[i]);
            store_bf<W>((bf16*)(ws + (T == T_ZA ? OFF_ZA : T == T_ZB ? OFF_ZB : OFF_ZC)) + (size_t)row * 512 + cc, v);
        } else if constexpr (T == T_QB) { const int cc = col - 2048, h = cc >> 6, d = cc & 63;
#pragma unroll
            for (int i = 0; i < W; ++i) v[i] *= C2;
            store_bf<W>((bf16*)(ws + OFF_QB) + ((size_t)(b * 8 + h) * 4096 + s) * 64 + d, v);
        } else if constexpr (T == T_CB) { const int cc = col - 2560, g = (cc >> 6) & 1, d = cc & 63;
            store_bf<W>((bf16*)(ws + (cc < 128 ? OFF_KCB : OFF_VCB)) + ((size_t)(b * 2 + g) * 4096 + s) * 64 + d, v);
        } else if constexpr (T == T_KROPE) { const int cc = col - 2816, g = (cc >> 6) & 1, d = cc & 63;
            store_bf<W>((bf16*)(ws + (cc < 128 ? OFF_KSEL : OFF_KWIN)) + (size_t)(b * 2 + g) * 262144 + ktile_off(s, d), v);
        } else if constexpr (T == T_VSW) { const int cc = col - 3072, g = (cc >> 6) & 1, d = cc & 63;
            store_bf<W>((bf16*)(ws + (cc < 128 ? OFF_VSEL : OFF_VWIN)) + (size_t)(b * 2 + g) * 262144 + vtile_off(s, d), v);
        } else if constexpr (T == T_QC) { const int cc = col - 3840, h = cc >> 6, d = cc & 63;
#pragma unroll
            for (int i = 0; i < W; ++i) v[i] *= C2;
            store_bf<W>((bf16*)(ws + OFF_QC) + ((size_t)(b * 8 + h) * 4096 + s) * 64 + d, v);
        } else if constexpr (T == T_KC) { const int cc = col - 4352, h = cc >> 6, d = cc & 63;
            store_bf<W>((bf16*)(ws + OFF_KC) + (size_t)(b * 8 + h) * 262144 + ktile_off(s, d), v);
        } else if constexpr (T == T_VC) { const int cc = col - 4864, hc = cc >> 7, d = cc & 127;
            store_bf<W>((bf16*)(ws + OFF_VC) + (size_t)(b * 4 + hc) * 524288 + v128_off(s, d), v);
        } else { const int cc = col - 5888;
            if (cc < 8) { float* o = (float*)(ws + OFF_LOGF) + (size_t)row * 8 + cc;
#pragma unroll
                for (int i = 0; i < W; ++i) o[i] = logsigmoidf_(v[i] + E.bfg[cc + i]) * LOG2E;
            } else if (cc < 32) { float* o = (float*)(ws + OFF_GATES) + (size_t)row * 24 + (cc - 8);
#pragma unroll
                for (int i = 0; i < W; ++i) o[i] = sigmoidf_(v[i]);
            }
        }
    } else if constexpr (KIND == EPI_GATE) {
#pragma unroll
        for (int i = 0; i < W; ++i) v[i] = sigmoidf_(a[i] * p.rs);
        store_bf<W>((bf16*)(ws + OFF_G) + idx, v);
    } else if constexpr (KIND == EPI_BR0 || KIND == EPI_BR1 || KIND == EPI_BR2) {
#pragma unroll
        for (int i = 0; i < W; ++i) { v[i] = p.a[i] * a[i]; if (KIND != EPI_BR0) v[i] += p.b[i]; }
        if constexpr (KIND == EPI_BR2) store_bf<W>((bf16*)(ws + OFF_MERGED) + idx, v);
        else st_f32x8((float*)(ws + OFF_T) + idx, v);
    } else if constexpr (KIND == EPI_OUT) {
#pragma unroll
        for (int i = 0; i < W; ++i) v[i] = p.a[i] + a[i];
        st_f32x8(E.X + idx, v);
        store_bf<W>((bf16*)(ws + OFF_X1B) + idx, v);
    } else if constexpr (KIND == EPI_U) {
        st_f32x8((float*)(ws + OFF_U) + idx, a);
    } else if constexpr (KIND == EPI_PLE) {
#pragma unroll
        for (int i = 0; i < W; ++i) v[i] = p.a[i] + sigmoidf_(a[i]) * p.b[i];
        st_f32x8(E.X + idx, v);
        store_bf<W>((bf16*)(ws + OFF_XB) + idx, v);
    }
}

template <int MODE> __device__ __forceinline__ void d_convT(bool active, int bx, int by, int vt, float (*tile)[65], const float* src, int ld, int K, bf16* dst, const float* kscale) {
    const int n0 = bx * 64, k0 = by * 64, tx = vt & 63, ty = vt >> 6;
    const int n = n0 + tx;
    int sc;
    if (MODE == 0) sc = n; else if (MODE == 1) sc = win_srccol(n); else sc = (n & ~63) + ((n & 1) << 5) + ((n & 63) >> 1);
    if (active) {
#pragma unroll 4
        for (int i = 0; i < 16; ++i) { const int kk = 4 * i + ty; float v = 0.f; if (sc >= 0) { v = src[(size_t)(k0 + kk) * ld + sc]; if (kscale) v *= kscale[k0 + kk]; } tile[tx][kk] = v; }
    }
    __syncthreads();
    if (active) {
#pragma unroll
        for (int p = 0; p < 2; ++p) { const int it = vt + 256 * p, r = it >> 3, c = it & 7; const float* t = &tile[r][8 * c];
            u32x4 o; o.x = pk2(t[0], t[1]); o.y = pk2(t[2], t[3]); o.z = pk2(t[4], t[5]); o.w = pk2(t[6], t[7]);
            *(u32x4*)(dst + (size_t)(n0 + r) * K + k0 + 8 * c) = o; }
    }
    __syncthreads();
}
__device__ __forceinline__ void d_xprep(int vb, int vt, const float* x, unsigned char* ws) {
    const int row = vb * 4 + (vt >> 6), lane = vt & 63;
    const f32x4* xr = (const f32x4*)(x + (size_t)row * 1024) + lane; float ss = 0.f;
    bf16* o = (bf16*)(ws + OFF_XB) + (size_t)row * 1024;
#pragma unroll
    for (int j = 0; j < 4; ++j) { const f32x4 v = xr[64 * j]; ss += (v[0] * v[0] + v[1] * v[1]) + (v[2] * v[2] + v[3] * v[3]); float t[4] = {v[0], v[1], v[2], v[3]}; store_bf<4>(o + 256 * j + 4 * lane, t); }
#pragma unroll
    for (int of = 1; of < 64; of <<= 1) ss += __shfl_xor(ss, of);
    if (lane == 0) { f32x4 s = {ss, 0.f, 0.f, 0.f}; *(f32x4*)(ws + OFF_SSP + (size_t)row * 16) = s; }
}
__device__ __forceinline__ void d_sumsq(int vb, int vt, const float* x, unsigned char* ws) {
    const int row = vb * 4 + (vt >> 6), lane = vt & 63;
    const f32x4* xr = (const f32x4*)(x + (size_t)row * 1024) + lane; float ss = 0.f;
#pragma unroll
    for (int j = 0; j < 4; ++j) { const f32x4 v = xr[64 * j]; ss += (v[0] * v[0] + v[1] * v[1]) + (v[2] * v[2] + v[3] * v[3]); }
#pragma unroll
    for (int of = 1; of < 64; of <<= 1) ss += __shfl_xor(ss, of);
    if (lane == 0) { f32x4 s = {ss, 0.f, 0.f, 0.f}; *(f32x4*)(ws + OFF_SSP + (size_t)row * 16) = s; }
}
__device__ __forceinline__ void d_rope_table(int vb, int vt, const int* pos, unsigned char* ws) {
    const int idx = vb * 256 + vt, row = idx >> 5, i = idx & 31;
    const float inv = exp2f(-(float)i * (13.287712379549449f / 32.f));
    const float ang = (float)pos[row] * inv;
    float s, c; sincosf(ang, &s, &c);
    ((float*)(ws + OFF_COS))[idx] = c; ((float*)(ws + OFF_SIN))[idx] = s;
}
__device__ __forceinline__ void d_pconv(int vb, int vt, const float* p, unsigned char* ws) {
    const size_t i = ((size_t)vb * 256 + vt) * 4;
    const f32x4 v = *(const f32x4*)(p + i); float t[4] = {v[0], v[1], v[2], v[3]}; store_bf<4>((bf16*)(ws + OFF_PB) + i, t);
}
constexpr size_t OFF_CBPART = OFF_CTL + 65536;
__device__ __forceinline__ void d_cb1_part(int u, int vt, const float* pe_k, const float* w1_k, const float* pe_v, const float* w1_v, unsigned char* ws) {
    const int kv = u >> 4, kc = u & 15, j = vt;
    const float* pe = (kv ? pe_v : pe_k) + 128 * kc; const float* w1 = (kv ? w1_v : w1_k) + (size_t)(128 * kc) * 256 + j;
    float acc = 0.f;
#pragma unroll 16
    for (int k = 0; k < 128; ++k) acc += pe[k] * w1[(size_t)k * 256];
    ((float*)(ws + OFF_CBPART))[(kv * 16 + kc) * 256 + j] = acc;
}
__device__ __forceinline__ void d_cb1_sum(int vt, const float* b1_k, const float* b1_v, unsigned char* ws) {
    const int kv = vt >> 8, j = vt & 255; float acc = (kv ? b1_v : b1_k)[j];
#pragma unroll
    for (int kc = 0; kc < 16; ++kc) acc += ((const float*)(ws + OFF_CBPART))[(kv * 16 + kc) * 256 + j];
    ((float*)(ws + OFF_CB1))[kv * 256 + j] = acc;
}
__device__ __forceinline__ void d_lam(int vt, const float* dl, unsigned char* ws, int l) {
    if (vt == 0) { float s1 = 0.f, s2 = 0.f; for (int i = 0; i < 64; ++i) { s1 += dl[i] * dl[64 + i]; s2 += dl[128 + i] * dl[192 + i]; }
        const float li = 0.8f - 0.6f * expf(-0.3f * (float)l); ((float*)(ws + OFF_CTL))[CTL_LAM + l] = expf(s1) - expf(s2) + li; }
}
__device__ __forceinline__ void d_cumsum(int vb, int vt, unsigned char* ws) {
    const int bh = vb, b = bh >> 3, h = bh & 7, lane = vt;
    const float* lf = (const float*)(ws + OFF_LOGF) + ((size_t)(b * 4096 + 64 * lane)) * 8 + h;
    float s = 0.f;
    for (int i = 0; i < 64; ++i) s += lf[i * 8];
    float incl = s;
#pragma unroll
    for (int of = 1; of < 64; of <<= 1) { const float t = __shfl_up(incl, of); if (lane >= of) incl += t; }
    float run = incl - s;
    float* cf = (float*)(ws + OFF_CF) + (size_t)bh * 4096 + 64 * lane;
    for (int i = 0; i < 64; ++i) { run += lf[i * 8]; cf[i] = run; }
}
__device__ __forceinline__ void d_compress(bool active, int vb, int vt, float* hid, unsigned char* ws) {
    const int c = vb & 255, bg = (vb >> 8) & 7, kv = vb >> 11, j = vt;
    bf16* dstK = (bf16*)(ws + OFF_KCMP) + (size_t)bg * 16384; bf16* dstV = (bf16*)(ws + OFF_VCMP) + (size_t)bg * 16384;
    const bool pad = (c == 255);
    if (active && pad) { if (j < 64) { if (kv == 0) dstK[ktile_off(c, j)] = 0; else dstV[vtile_off(c, j)] = 0; } }
    if (active && !pad) {
        const bf16* src = (const bf16*)(ws + (kv ? OFF_VCB : OFF_KCB)) + ((size_t)bg * 4096 + 16 * c) * 64;
        const bf16* w = (const bf16*)(ws + OFF_CW1) + (size_t)(kv * 256 + j) * 2048;
        float acc = ((const float*)(ws + OFF_CB1))[kv * 256 + j];
        for (int k = 0; k < 2048; k += 8) { const bf16x8 a = *(const bf16x8*)(src + k), bb = *(const bf16x8*)(w + k);
#pragma unroll
            for (int i = 0; i < 8; ++i) acc += bf2f((bf16)a[i]) * bf2f((bf16)bb[i]); }
        hid[j] = bf2f(f2bf(siluf_(acc)));
    }
    __syncthreads();
    if (active && !pad && j < 64) { const bf16* w2 = (const bf16*)(ws + OFF_CW2) + (size_t)(kv * 64 + j) * 256; float o = 0.f;
        for (int k = 0; k < 256; ++k) o += hid[k] * bf2f(w2[k]);
        if (kv == 0) dstK[ktile_off(c, j)] = f2bf(o); else dstV[vtile_off(c, j)] = f2bf(o); }
    __syncthreads();
}
__device__ __forceinline__ void d_fox(int vb, int vt, unsigned char* ws) {
    const int bh = (vb & 31), b = bh >> 3, h = bh & 7, t = (vb >> 5) * 64 + vt, tmax = (vb >> 5) * 64 + 63;
    const bf16* Q = (const bf16*)(ws + OFF_QA) + ((size_t)bh * 4096 + t) * 64;
    const bf16* Kb = (const bf16*)(ws + OFF_KA) + (size_t)bh * 262144; const bf16* Vb = (const bf16*)(ws + OFF_VA) + (size_t)bh * 262144;
    const float* cf = (const float*)(ws + OFF_CF) + (size_t)bh * 4096;
    float q[64], o[64];
#pragma unroll
    for (int d = 0; d < 64; ++d) { q[d] = bf2f(Q[d]); o[d] = 0.f; }
    const float ci = cf[t]; float m = -1e30f, l = 0.f;
    for (int j = 0; j <= tmax; ++j) {
        float s = 0.f;
#pragma unroll
        for (int d = 0; d < 64; ++d) s += q[d] * bf2f(Kb[ktile_off(j, d)]);
        s += ci - cf[j];
        if (j <= t) { const float mn = fmaxf(m, s), al = exp2f(m - mn), p = exp2f(s - mn); l = l * al + p; m = mn;
#pragma unroll
            for (int d = 0; d < 64; ++d) o[d] = o[d] * al + p * bf2f(Vb[vtile_off(j, d)]); }
    }
    const float il = 1.f / l; bf16* Y = (bf16*)(ws + OFF_ZA) + (size_t)(b * 4096 + t) * 512 + h * 64;
#pragma unroll
    for (int d = 0; d < 64; ++d) Y[d] = f2bf(o[d] * il * bf2f(Y[d]));
}
__device__ __forceinline__ void d_diff(int vb, int vt, float (*res)[129], unsigned char* ws, const float* subg, int l) {
    const int bhc = (vb & 15), b = bhc >> 2, hc = bhc & 3, t = (vb >> 4) * 64 + vt, tmax = (vb >> 4) * 64 + 63;
    const float lam = ((const float*)(ws + OFF_CTL))[CTL_LAM + l], lam_init = 0.8f - 0.6f * expf(-0.3f * (float)l);
    const bf16* Vb = (const bf16*)(ws + OFF_VC) + (size_t)bhc * 524288;
    for (int dh = 0; dh < 2; ++dh) {
        for (int mp = 0; mp < 2; ++mp) {
            const int hh = b * 8 + hc * 2 + mp;
            const bf16* Q = (const bf16*)(ws + OFF_QC) + ((size_t)hh * 4096 + t) * 64; const bf16* Kb = (const bf16*)(ws + OFF_KC) + (size_t)hh * 262144;
            float q[64], o[64];
#pragma unroll
            for (int d = 0; d < 64; ++d) { q[d] = bf2f(Q[d]); o[d] = 0.f; }
            float m = -1e30f, ls = 0.f;
            for (int j = 0; j <= tmax; ++j) {
                float s = 0.f;
#pragma unroll
                for (int d = 0; d < 64; ++d) s += q[d] * bf2f(Kb[ktile_off(j, d)]);
                if (j <= t) { const float mn = fmaxf(m, s), al = exp2f(m - mn), p = exp2f(s - mn); ls = ls * al + p; m = mn;
#pragma unroll
                    for (int d = 0; d < 64; ++d) o[d] = o[d] * al + p * bf2f(Vb[v128_off(j, dh * 64 + d)]); }
            }
            const float il = 1.f / ls;
#pragma unroll
            for (int d = 0; d < 64; ++d) { if (mp == 0) res[vt][dh * 64 + d] = o[d] * il; else res[vt][dh * 64 + d] -= lam * o[d] * il; }
        }
    }
    float ss = 0.f;
    for (int d = 0; d < 128; ++d) { const float v = res[vt][d]; ss += v * v; }
    const float rs = rsqrtf(ss * (1.f / 128.f) + EPS) * (1.f - lam_init);
    bf16* Y = (bf16*)(ws + OFF_ZC) + (size_t)(b * 4096 + t) * 512 + hc * 128;
    for (int d = 0; d < 128; ++d) Y[d] = f2bf(res[vt][d] * rs * subg[d] * bf2f(Y[d]));
}
__device__ __forceinline__ void d_nsa_topk(int vb, int vt, float (*imp)[65], unsigned char* ws) {
    const int bg = (vb & 7), b = bg >> 1, g = bg & 1, tb = (vb >> 3), t = tb * 64 + vt;
    for (int j = 0; j < 64; ++j) imp[vt][j] = 0.f;
    const int nv = (t >= 31) ? ((t - 31) >> 4) + 1 : 0, nvmax = ((tb * 64 + 63 - 31) >> 4) + 1;
    const bf16* Kc = (const bf16*)(ws + OFF_KCMP) + (size_t)bg * 16384;
    for (int hq = 0; hq < 4; ++hq) {
        const int h = g * 4 + hq;
        const bf16* Q = (const bf16*)(ws + OFF_QB) + ((size_t)(b * 8 + h) * 4096 + t) * 64;
        float q[64];
#pragma unroll
        for (int d = 0; d < 64; ++d) q[d] = bf2f(Q[d]);
        float m = -1e30f, ls = 0.f;
        for (int c = 0; c < nvmax; ++c) { float s = 0.f;
#pragma unroll
            for (int d = 0; d < 64; ++d) s += q[d] * bf2f(Kc[ktile_off(c, d)]);
            if (c < nv) { const float mn = fmaxf(m, s); ls = ls * exp2f(m - mn) + exp2f(s - mn); m = mn; } }
        const float il = nv > 0 ? 1.f / ls : 0.f;
        for (int c = 0; c < nvmax; ++c) { float s = 0.f;
#pragma unroll
            for (int d = 0; d < 64; ++d) s += q[d] * bf2f(Kc[ktile_off(c, d)]);
            if (c < nv) { const float p = exp2f(s - m) * il; imp[vt][c >> 2] += p; if ((c & 3) == 3 && (c >> 2) + 1 < 64) imp[vt][(c >> 2) + 1] += p; } }
    }
    for (int j = 0; j < 64; ++j) { const bool forced = (j == 0) || (j == tb) || (j == tb - 1), valid = j <= tb; const float v = imp[vt][j];
        imp[vt][j] = forced ? 1e30f : (valid ? v : -1e30f); }
    unsigned long long mask = 0ull;
    for (int j = 0; j < 64; ++j) { const float sj = imp[vt][j]; int rank = 0;
        for (int k = 0; k < 64; ++k) { const float sk = imp[vt][k]; rank += (sk > sj || (sk == sj && k < j)) ? 1 : 0; }
        if (rank < 16) mask |= (1ull << j); }
    ((unsigned long long*)(ws + OFF_SELM))[(size_t)bg * 4096 + t] = mask;
}
__device__ __forceinline__ void d_nsa_attn(int vb, int vt, float (*yl)[65], unsigned char* ws) {
    const int bh = (vb & 31), b = bh >> 3, h = bh & 7, g = h >> 2, bg = b * 2 + g, tb = (vb >> 5), t = tb * 64 + vt, row = b * 4096 + t;
    const bf16* Q = (const bf16*)(ws + OFF_QB) + ((size_t)bh * 4096 + t) * 64;
    float q[64], o[64];
#pragma unroll
    for (int d = 0; d < 64; ++d) { q[d] = bf2f(Q[d]); yl[vt][d] = 0.f; }
    const float* gt = (const float*)(ws + OFF_GATES) + (size_t)row * 24 + h * 3;
    const float g0 = gt[0], g1 = gt[1], g2 = gt[2];
    { const int nv = (t >= 31) ? ((t - 31) >> 4) + 1 : 0, nvmax = ((tb * 64 + 63 - 31) >> 4) + 1;
      const bf16* Kc = (const bf16*)(ws + OFF_KCMP) + (size_t)bg * 16384; const bf16* Vc = (const bf16*)(ws + OFF_VCMP) + (size_t)bg * 16384;
      float m = -1e30f, ls = 0.f;
#pragma unroll
      for (int d = 0; d < 64; ++d) o[d] = 0.f;
      for (int c = 0; c < nvmax; ++c) { float s = 0.f;
#pragma unroll
          for (int d = 0; d < 64; ++d) s += q[d] * bf2f(Kc[ktile_off(c, d)]);
          if (c < nv) { const float mn = fmaxf(m, s), al = exp2f(m - mn), p = exp2f(s - mn); ls = ls * al + p; m = mn;
#pragma unroll
              for (int d = 0; d < 64; ++d) o[d] = o[d] * al + p * bf2f(Vc[vtile_off(c, d)]); } }
      const float il = nv > 0 ? g0 / ls : 0.f;
#pragma unroll
      for (int d = 0; d < 64; ++d) yl[vt][d] += o[d] * il; }
    { const float* cs = (const float*)(ws + OFF_COS) + (size_t)row * 32; const float* sn = (const float*)(ws + OFF_SIN) + (size_t)row * 32;
#pragma unroll
      for (int i = 0; i < 32; ++i) { const float c = cs[i], s = sn[i], x1 = q[2 * i], x2 = q[2 * i + 1]; q[2 * i] = bf2f(f2bf(x1 * c - x2 * s)); q[2 * i + 1] = bf2f(f2bf(x2 * c + x1 * s)); } }
    { const unsigned long long mask = ((const unsigned long long*)(ws + OFF_SELM))[(size_t)bg * 4096 + t];
      const bf16* Kb = (const bf16*)(ws + OFF_KSEL) + (size_t)bg * 262144; const bf16* Vb = (const bf16*)(ws + OFF_VSEL) + (size_t)bg * 262144;
      float m = -1e30f, ls = 0.f;
#pragma unroll
      for (int d = 0; d < 64; ++d) o[d] = 0.f;
      for (int j = 0; j <= tb; ++j) { const bool sel = (mask >> j) & 1ull;
          for (int kk = 0; kk < 64; ++kk) { const int kp = j * 64 + kk; float s = 0.f;
#pragma unroll
              for (int d = 0; d < 64; ++d) s += q[d] * bf2f(Kb[ktile_off(kp, d)]);
              if (sel && kp <= t) { const float mn = fmaxf(m, s), al = exp2f(m - mn), p = exp2f(s - mn); ls = ls * al + p; m = mn;
#pragma unroll
                  for (int d = 0; d < 64; ++d) o[d] = o[d] * al + p * bf2f(Vb[vtile_off(kp, d)]); } } }
      const float il = g1 / ls;
#pragma unroll
      for (int d = 0; d < 64; ++d) yl[vt][d] += o[d] * il; }
    { const bf16* Kb = (const bf16*)(ws + OFF_KWIN) + (size_t)bg * 262144; const bf16* Vb = (const bf16*)(ws + OFF_VWIN) + (size_t)bg * 262144;
      float m = -1e30f, ls = 0.f;
#pragma unroll
      for (int d = 0; d < 64; ++d) o[d] = 0.f;
      const int k_lo = max(0, tb * 64 - 511), k_hi = tb * 64 + 63;
      for (int kp = k_lo; kp <= k_hi; ++kp) { float s = 0.f;
#pragma unroll
          for (int d = 0; d < 64; ++d) s += q[d] * bf2f(Kb[ktile_off(kp, d)]);
          if (kp <= t && kp > t - 512) { const float mn = fmaxf(m, s), al = exp2f(m - mn), p = exp2f(s - mn); ls = ls * al + p; m = mn;
#pragma unroll
              for (int d = 0; d < 64; ++d) o[d] = o[d] * al + p * bf2f(Vb[vtile_off(kp, d)]); } }
      const float il = g2 / ls;
#pragma unroll
      for (int d = 0; d < 64; ++d) yl[vt][d] += o[d] * il; }
    bf16* Y = (bf16*)(ws + OFF_ZB) + (size_t)row * 512 + h * 64;
#pragma unroll
    for (int d = 0; d < 64; ++d) Y[d] = f2bf(yl[vt][d] * bf2f(Y[d]));
}
__device__ __forceinline__ void d_final(int vb, int vt, float* X, const float* g) {
    const int row = vb * 4 + (vt >> 6), lane = vt & 63;
    f32x4* xr = (f32x4*)(X + (size_t)row * 1024) + lane; f32x4 v[4]; float ss = 0.f;
#pragma unroll
    for (int j = 0; j < 4; ++j) { v[j] = xr[64 * j]; ss += (v[j][0] * v[j][0] + v[j][1] * v[j][1]) + (v[j][2] * v[j][2] + v[j][3] * v[j][3]); }
#pragma unroll
    for (int of = 1; of < 64; of <<= 1) ss += __shfl_xor(ss, of);
    const float rs = rsqrtf(ss * (1.f / 1024.f) + EPS);
#pragma unroll
    for (int j = 0; j < 4; ++j) { const f32x4 gg = *((const f32x4*)g + 64 * j + lane); xr[64 * j] = v[j] * rs * gg; }
}


namespace pg8 {
#define PG8_LAS __attribute__((address_space(3)))
typedef unsigned short bf16_t;
typedef short bf16x8 __attribute__((ext_vector_type(8)));
typedef float f32x4 __attribute__((ext_vector_type(4)));
typedef unsigned u32x4 __attribute__((ext_vector_type(4)));
constexpr int BM = 256, BK = 64, HALF = 128, HTB = HALF * BK * 2  , STAGE_BYTES = 8 * HTB, NXCD = 8, WGM = 8;

__host__ __device__ __forceinline__ int lds_byte(int r, int c) { const int st = (r >> 4) * 2 + (c >> 5), rr = r & 15, cc = c & 31, ob = rr * 64 + cc * 2; return st * 1024 + (ob ^ (((ob >> 9) & 1) << 5)); }
__host__ __device__ __forceinline__ void stage_rc(int b, int& R, int& C) { const int st = b / 1024, sb = b % 1024, swz = sb ^ (((sb >> 9) & 1) << 5); R = (st >> 1) * 16 + swz / 64; C = (st & 1) * 32 + (swz % 64) / 2; }
__host__ __device__ __forceinline__ int perm32(int rho) { const int n = rho >> 4, i = rho & 15; return 8 * (i >> 2) + 4 * n + (i & 3); }

struct Unit { int pm, pn; };
struct Gemm { const bf16_t* A; const bf16_t* Bt; int M, N, K; };

struct StaticOrder {
    int nM, nN, nwg, G, c;
    __host__ __device__ void init(int M, int N, int G_, int c_) { nM = M / BM; nN = N / BM; nwg = nM * nN; G = G_; c = c_; }
    __host__ __device__ bool next(int i, Unit& u) const {
        const long L = (long)i * G + c; if (L >= nwg) return false;
        int wgid = (int)L; { const int q = nwg / NXCD, r = nwg % NXCD, xcd = wgid % NXCD, off = wgid / NXCD; wgid = (xcd < r ? xcd * (q + 1) : r * (q + 1) + (xcd - r) * q) + off; }
        const int nig = WGM * nN, gid = wgid / nig, fm = gid * WGM, gsz = (nM - fm) < WGM ? (nM - fm) : WGM;
        u.pm = fm + ((wgid % nig) % gsz); u.pn = (wgid % nig) / gsz; return true;
    }
    __device__ __forceinline__ void a_ready(const Unit&) const {}
    __device__ __forceinline__ void done(const Unit&) const {}
};

__device__ __forceinline__ unsigned cvt_pk_bf16(float lo, float hi) { unsigned r; asm volatile("v_cvt_pk_bf16_f32 %0, %1, %2" : "=v"(r) : "v"(lo), "v"(hi)); return r; }
typedef float f32x2 __attribute__((ext_vector_type(2)));
template <class Epi, class Sched, bool ALIGN_EPI = false, bool SP2 = false>
__device__ __forceinline__ void gemm_phase(PG8_LAS unsigned char* lds, const Gemm g, const Sched& S, const Epi& E) {
    int tid_o = threadIdx.x; asm volatile("" : "+v"(tid_o));
    const int tid = tid_o, wid = __builtin_amdgcn_readfirstlane(tid >> 6), lane = tid & 63, wr = wid >> 2, wc = wid & 3, fr = lane & 15, fq = lane >> 4;
    const int K = g.K, nt = K / BK;
    unsigned voffA[2], voffB[2];
#pragma unroll
    for (int i = 0; i < 2; ++i) { int R, C; stage_rc(tid * 16 + i * 8192, R, C); const int Rb = Epi::PERM ? ((R & ~31) + perm32(R & 31)) : R;
        voffA[i] = (unsigned)(R * K + C) * 2u; voffB[i] = (unsigned)(Rb * K + C) * 2u; }
    const size_t kstep = (size_t)(BK * 2);
    const size_t hstep = (size_t)HALF * K * 2;
    const size_t tstep = 2 * hstep;
    const unsigned ldsw = (unsigned)wid * 1024u;
    const int aoff = lds_byte(wr * 64 + fr, fq * 8), boff = lds_byte(wc * 32 + fr, fq * 8);
#define PG8_SA(b, h) (((b) * 2 + (h)) * HTB)
#define PG8_SB(b, h) ((4 + (b) * 2 + (h)) * HTB)
#define PG8_STAGE(bufoff, gbase, voff) do { _Pragma("unroll") for (int _i = 0; _i < 2; ++_i) \
        __builtin_amdgcn_global_load_lds((const unsigned*)((const char*)(gbase) + (voff)[_i]), (PG8_LAS unsigned*)(lds + (bufoff) + ldsw + _i * 8192), 16, 0, 0); } while (0)
#define PG8_LDA(dst, b, h) do { _Pragma("unroll") for (int m = 0; m < 4; ++m) _Pragma("unroll") for (int k = 0; k < 2; ++k) dst[m][k] = *(const PG8_LAS bf16x8*)(lds + PG8_SA(b, h) + aoff + m * 2048 + k * 1024); } while (0)
#define PG8_LDB(dst, b, h) do { _Pragma("unroll") for (int n = 0; n < 2; ++n) _Pragma("unroll") for (int k = 0; k < 2; ++k) dst[n][k] = *(const PG8_LAS bf16x8*)(lds + PG8_SB(b, h) + boff + n * 2048 + k * 1024); } while (0)
#define PG8_MMA(ai, bj, At, Bt) do { __builtin_amdgcn_s_setprio(1); _Pragma("unroll") for (int m = 0; m < 4; ++m) _Pragma("unroll") for (int n = 0; n < 2; ++n) _Pragma("unroll") for (int k = 0; k < 2; ++k) \
        acc[ai][bj][m][n] = __builtin_amdgcn_mfma_f32_16x16x32_bf16(Bt[n][k], At[m][k], acc[ai][bj][m][n], 0, 0, 0); __builtin_amdgcn_s_setprio(0); } while (0)
#define PG8_WAIT_V(n) asm volatile("s_waitcnt vmcnt(" #n ")" ::: "memory")
#define PG8_WAIT_L(n) asm volatile("s_waitcnt lgkmcnt(" #n ")" ::: "memory")
#define PG8_BAR __builtin_amdgcn_s_barrier()
#define PG8_SCHED __builtin_amdgcn_sched_barrier(0)
    Unit cur, nxt; int ui = 0;
    if (!S.next(0, cur)) return;
    f32x4 acc[2][2][4][2];
#pragma unroll
    for (int a = 0; a < 2; ++a)
#pragma unroll
        for (int b = 0; b < 2; ++b)
#pragma unroll
            for (int m = 0; m < 4; ++m)
#pragma unroll
                for (int n = 0; n < 2; ++n) acc[a][b][m][n] = (f32x4){0.f, 0.f, 0.f, 0.f};
    bf16x8 At[4][2], B0[2][2], B1[2][2];
    const char* cA = (const char*)g.A + (size_t)cur.pm * tstep; const char* cB = (const char*)g.Bt + (size_t)cur.pn * tstep;
    S.a_ready(cur);
    if constexpr (SP2) {
        PG8_STAGE(PG8_SB(0, 0), cB, voffB); PG8_STAGE(PG8_SB(0, 1), cB + hstep, voffB); PG8_STAGE(PG8_SA(0, 0), cA, voffA); PG8_STAGE(PG8_SA(0, 1), cA + hstep, voffA);
        if (wr == 1) PG8_BAR;
        PG8_WAIT_V(2); PG8_BAR;
        PG8_STAGE(PG8_SB(1, 0), cB + kstep, voffB); PG8_STAGE(PG8_SA(1, 0), cA + kstep, voffA); PG8_STAGE(PG8_SB(1, 1), cB + hstep + kstep, voffB);
        PG8_WAIT_V(6); PG8_BAR;
    } else {
        PG8_STAGE(PG8_SB(0, 0), cB, voffB); PG8_STAGE(PG8_SA(0, 0), cA, voffA); PG8_STAGE(PG8_SB(0, 1), cB + hstep, voffB); PG8_STAGE(PG8_SA(0, 1), cA + hstep, voffA);
        if (wr == 1) PG8_BAR;
        PG8_WAIT_V(4); PG8_BAR;
        PG8_STAGE(PG8_SB(1, 0), cB + kstep, voffB); PG8_STAGE(PG8_SA(1, 0), cA + kstep, voffA); PG8_STAGE(PG8_SB(1, 1), cB + hstep + kstep, voffB);
        PG8_WAIT_V(6); PG8_BAR;
    }
    for (;;) {
        const bool has_next = S.next(ui + 1, nxt);
        const char* nA = has_next ? (const char*)g.A + (size_t)nxt.pm * tstep : cA; const char* nB = has_next ? (const char*)g.Bt + (size_t)nxt.pn * tstep : cB;
        for (int t = 0; t < nt; t += 2) {
            const bool last = (t == nt - 2);
            const char* a1 = cA + (size_t)(t + 1) * kstep;
            const char* a2 = last ? nA : cA + (size_t)(t + 2) * kstep; const char* b2 = last ? nB : cB + (size_t)(t + 2) * kstep;
            const char* a3 = a2 + kstep; const char* b3 = b2 + kstep;
            if (last && has_next) S.a_ready(nxt);
            if constexpr (SP2) {
            PG8_LDB(B0, 0, 0); PG8_LDB(B1, 0, 1); PG8_SCHED; PG8_LDA(At, 0, 0); PG8_STAGE(PG8_SA(1, 1), a1 + hstep, voffA);
            PG8_WAIT_V(8); PG8_WAIT_L(0); PG8_BAR; PG8_MMA(0, 0, At, B0); PG8_MMA(0, 1, At, B1); PG8_BAR; PG8_SCHED;
            PG8_LDA(At, 0, 1); PG8_STAGE(PG8_SB(0, 0), b2, voffB); PG8_STAGE(PG8_SB(0, 1), b2 + hstep, voffB); PG8_STAGE(PG8_SA(0, 0), a2, voffA);
            PG8_WAIT_V(8); PG8_WAIT_L(0); PG8_BAR; PG8_MMA(1, 0, At, B0); PG8_MMA(1, 1, At, B1); PG8_BAR; PG8_SCHED;
            PG8_LDB(B0, 1, 0); PG8_LDB(B1, 1, 1); PG8_SCHED; PG8_LDA(At, 1, 0); PG8_STAGE(PG8_SA(0, 1), a2 + hstep, voffA);
            PG8_WAIT_V(8); PG8_WAIT_L(0); PG8_BAR; PG8_MMA(0, 0, At, B0); PG8_MMA(0, 1, At, B1); PG8_BAR; PG8_SCHED;
            PG8_LDA(At, 1, 1); PG8_STAGE(PG8_SB(1, 0), b3, voffB); PG8_STAGE(PG8_SB(1, 1), b3 + hstep, voffB); PG8_STAGE(PG8_SA(1, 0), a3, voffA);
            PG8_WAIT_V(8); PG8_WAIT_L(0); PG8_BAR; PG8_MMA(1, 0, At, B0); PG8_MMA(1, 1, At, B1); PG8_BAR; PG8_SCHED;
            } else {
            PG8_LDB(B0, 0, 0); PG8_SCHED; PG8_LDA(At, 0, 0); PG8_STAGE(PG8_SA(1, 1), a1 + hstep, voffA);
            PG8_WAIT_L(8); PG8_BAR; PG8_WAIT_L(0); PG8_MMA(0, 0, At, B0); PG8_BAR; PG8_SCHED;
            PG8_LDB(B1, 0, 1); PG8_STAGE(PG8_SB(0, 0), b2, voffB);
            PG8_BAR; PG8_WAIT_L(0); PG8_MMA(0, 1, At, B1); PG8_BAR;
            PG8_LDA(At, 0, 1); PG8_STAGE(PG8_SA(0, 0), a2, voffA);
            PG8_BAR; PG8_WAIT_L(0); PG8_MMA(1, 0, At, B0); PG8_BAR; PG8_SCHED;
            PG8_STAGE(PG8_SB(0, 1), b2 + hstep, voffB);
            PG8_WAIT_V(6); PG8_BAR; PG8_MMA(1, 1, At, B1); PG8_BAR;
            PG8_LDB(B0, 1, 0); PG8_SCHED; PG8_LDA(At, 1, 0); PG8_STAGE(PG8_SA(0, 1), a2 + hstep, voffA);
            PG8_WAIT_L(8); PG8_BAR; PG8_WAIT_L(0); PG8_MMA(0, 0, At, B0); PG8_BAR; PG8_SCHED;
            PG8_LDB(B1, 1, 1); PG8_STAGE(PG8_SB(1, 0), b3, voffB);
            PG8_BAR; PG8_WAIT_L(0); PG8_MMA(0, 1, At, B1); PG8_BAR;
            PG8_LDA(At, 1, 1); PG8_STAGE(PG8_SA(1, 0), a3, voffA);
            PG8_BAR; PG8_WAIT_L(0); PG8_MMA(1, 0, At, B0); PG8_BAR; PG8_SCHED;
            PG8_STAGE(PG8_SB(1, 1), b3 + hstep, voffB);
            PG8_WAIT_V(6); PG8_BAR; PG8_MMA(1, 1, At, B1); PG8_BAR;
            }
        }
        if constexpr (ALIGN_EPI) { if (wr == 0) PG8_BAR; }
        if constexpr (!Epi::AFTER_DRAIN) { E(acc, cur, wr, wc, fr, fq); S.done(cur); }
        if (!has_next) break;
#pragma unroll
        for (int a = 0; a < 2; ++a)
#pragma unroll
            for (int b = 0; b < 2; ++b)
#pragma unroll
                for (int m = 0; m < 4; ++m)
#pragma unroll
                    for (int n = 0; n < 2; ++n) acc[a][b][m][n] = (f32x4){0.f, 0.f, 0.f, 0.f};
        cur = nxt; cA = nA; cB = nB; ++ui;
        if constexpr (ALIGN_EPI) { if (wr == 1) PG8_BAR; }
    }
    PG8_WAIT_V(0);
    if constexpr (!ALIGN_EPI) { if (wr == 0) PG8_BAR; }
    PG8_BAR;
    if constexpr (Epi::AFTER_DRAIN) { E.fused(acc, cur, wr, wc, fr, fq, lds, wid, lane); S.done(cur); }
#undef PG8_SA
#undef PG8_SB
#undef PG8_STAGE
#undef PG8_LDA
#undef PG8_LDB
#undef PG8_MMA
#undef PG8_WAIT_V
#undef PG8_WAIT_L
#undef PG8_BAR
#undef PG8_SCHED
}
}

template <int KIND> struct EpiFast {
    static constexpr bool PERM = true, AFTER_DRAIN = false;
    EpiCtx E;
    template <int T, int AI, int MH> __device__ __forceinline__ void grp(const pg8::f32x4 (&acc)[2][2][4][2], int row0, int col0) const {
        Pre p00, p01, p10, p11;
        const int r0 = row0 + AI * 128 + (2 * MH) * 16, r1 = r0 + 16;
        pre_load<KIND, T>(E, r0, col0, p00); pre_load<KIND, T>(E, r0, col0 + 128, p01); pre_load<KIND, T>(E, r1, col0, p10); pre_load<KIND, T>(E, r1, col0 + 128, p11);
        { const pg8::f32x4 v0 = acc[AI][0][2 * MH][0], v1 = acc[AI][0][2 * MH][1]; float v[8] = {v0[0], v0[1], v0[2], v0[3], v1[0], v1[1], v1[2], v1[3]}; emit_fin<KIND, T>(E, r0, col0, v, p00); }
        { const pg8::f32x4 v0 = acc[AI][1][2 * MH][0], v1 = acc[AI][1][2 * MH][1]; float v[8] = {v0[0], v0[1], v0[2], v0[3], v1[0], v1[1], v1[2], v1[3]}; emit_fin<KIND, T>(E, r0, col0 + 128, v, p01); }
        { const pg8::f32x4 v0 = acc[AI][0][2 * MH + 1][0], v1 = acc[AI][0][2 * MH + 1][1]; float v[8] = {v0[0], v0[1], v0[2], v0[3], v1[0], v1[1], v1[2], v1[3]}; emit_fin<KIND, T>(E, r1, col0, v, p10); }
        { const pg8::f32x4 v0 = acc[AI][1][2 * MH + 1][0], v1 = acc[AI][1][2 * MH + 1][1]; float v[8] = {v0[0], v0[1], v0[2], v0[3], v1[0], v1[1], v1[2], v1[3]}; emit_fin<KIND, T>(E, r1, col0 + 128, v, p11); }
        asm volatile("" ::: "memory");
    }
    template <int T> __device__ __forceinline__ void run(const pg8::f32x4 (&acc)[2][2][4][2], int row0, int col0) const {
        grp<T, 0, 0>(acc, row0, col0); grp<T, 0, 1>(acc, row0, col0); grp<T, 1, 0>(acc, row0, col0); grp<T, 1, 1>(acc, row0, col0);
    }
    __device__ __forceinline__ void operator()(const pg8::f32x4 (&acc)[2][2][4][2], const pg8::Unit& u, int wr, int wc, int fr, int fq) const {
        const int row0 = u.pm * 256 + wr * 64 + fr, col0 = u.pn * 256 + wc * 32 + 8 * fq;
        if constexpr (KIND == EPI_INPROJ) {
            switch (inproj_type(u.pn)) {
                case T_QA: run<T_QA>(acc, row0, col0); break;
                case T_KA: run<T_KA>(acc, row0, col0); break;
                case T_VA: run<T_VA>(acc, row0, col0); break;
                case T_ZA: run<T_ZA>(acc, row0, col0); break;
                case T_QB: run<T_QB>(acc, row0, col0); break;
                case T_CB: run<T_CB>(acc, row0, col0); break;
                case T_KROPE: run<T_KROPE>(acc, row0, col0); break;
                case T_VSW: run<T_VSW>(acc, row0, col0); break;
                case T_ZB: run<T_ZB>(acc, row0, col0); break;
                case T_QC: run<T_QC>(acc, row0, col0); break;
                case T_KC: run<T_KC>(acc, row0, col0); break;
                case T_VC: run<T_VC>(acc, row0, col0); break;
                case T_ZC: run<T_ZC>(acc, row0, col0); break;
                default: run<T_SPECIAL>(acc, row0, col0); break;
            }
        } else run<0>(acc, row0, col0);
    }
};
#define FAST_GEMM(KIND, Aptr, Bptr, N_, K_, ALIGN) do { pg8::Gemm g_{(const pg8::bf16_t*)(Aptr), (const pg8::bf16_t*)(Bptr), M, (N_), (K_)}; pg8::StaticOrder S_; S_.init(M, (N_), (int)gridDim.x, (int)blockIdx.x); \
        EpiFast<KIND> Ep_{E}; pg8::gemm_phase<EpiFast<KIND>, pg8::StaticOrder, ALIGN, true>((PG8_LAS unsigned char*)lds, g_, S_, Ep_); } while (0)

#define LAS __attribute__((address_space(3)))
typedef short s16x4 __attribute__((ext_vector_type(4)));
typedef short v4i16_t __attribute__((ext_vector_type(4)));
typedef LAS const char* lds_cptr;
constexpr int A_KRING = 0, A_VRING = 49152, A_CFRING = 98304, A_MISC = 104448;
constexpr int A_SLOT = 16384;
constexpr int A_IMP = A_MISC, A_SELM = A_MISC + 16384, A_UMASK = A_SELM + 512, A_SEQ = A_UMASK + 16, A_WQ = A_SEQ + 80;
__device__ __forceinline__ void glds16(const void* gsrc, unsigned lds_dst) { unsigned keep;
    asm volatile("s_mov_b32 %0, m0\n\ts_mov_b32 m0, %2\n\ts_nop 0\n\tglobal_load_lds_dwordx4 %1, off\n\ts_mov_b32 m0, %0" : "=&s"(keep) : "v"(gsrc), "s"(lds_dst) : "memory"); }
__device__ __forceinline__ void glds4(const void* gsrc, unsigned lds_dst) { unsigned keep;
    asm volatile("s_mov_b32 %0, m0\n\ts_mov_b32 m0, %2\n\ts_nop 0\n\tglobal_load_lds_dword %1, off\n\ts_mov_b32 m0, %0" : "=&s"(keep) : "v"(gsrc), "s"(lds_dst) : "memory"); }
#define A_WAIT_BAR(N) asm volatile("s_waitcnt vmcnt(" #N ") lgkmcnt(0)\n\ts_barrier" ::: "memory")
__device__ __forceinline__ s16x4 vtr(lds_cptr p) { return __builtin_bit_cast(s16x4, __builtin_amdgcn_ds_read_tr16_b64_v4i16((LAS v4i16_t*)p)); }
__device__ __forceinline__ unsigned cvtpk(float lo, float hi) { typedef float f2 __attribute__((ext_vector_type(2))); typedef __bf16 b2 __attribute__((ext_vector_type(2))); f2 v = {lo, hi}; b2 b = __builtin_convertvector(v, b2); return __builtin_bit_cast(unsigned, b); }
__device__ __forceinline__ int crow(int r, int hi) { return (r & 3) + 8 * (r >> 2) + 4 * hi; }

template <int NDB> struct FlashSt { f32x16 o[NDB]; float m, l; };
template <int NDB> __device__ __forceinline__ void flash_init(FlashSt<NDB>& st) {
#pragma unroll
    for (int i = 0; i < NDB; ++i)
#pragma unroll
        for (int r = 0; r < 16; ++r) st.o[i][r] = 0.f;
    st.m = -1e30f; st.l = 0.f;
}
__device__ __forceinline__ void qk_tile(f32x16& p0, f32x16& p1, lds_cptr kslot, const bf16x8 (&qf)[4], int r32, int hi) {
    const lds_cptr kb = kslot + hi * 1024 + r32 * 16;
#pragma unroll
    for (int d0 = 0; d0 < 4; ++d0) {
        const bf16x8 a = *(const LAS bf16x8*)(kb + d0 * 2048), b = *(const LAS bf16x8*)(kb + d0 * 2048 + 512);
        p0 = __builtin_amdgcn_mfma_f32_32x32x16_bf16(a, qf[d0], p0, 0, 0, 0);
        p1 = __builtin_amdgcn_mfma_f32_32x32x16_bf16(b, qf[d0], p1, 0, 0, 0);
    }
}
__device__ __forceinline__ float rowmax32(const f32x16& p0, const f32x16& p1) {
    float a = fmaxf(p0[0], p1[0]);
#pragma unroll
    for (int r = 1; r < 16; ++r) a = fmaxf(a, fmaxf(p0[r], p1[r]));
    return fmaxf(a, __shfl_xor(a, 32));
}
template <int NDB> __device__ __forceinline__ void pv_tile(f32x16 (&o)[NDB], lds_cptr vslot_l, const f32x16& p0, const f32x16& p1) {
    bf16x8 pf[4];
    { u32x4 w;
      w.x = cvtpk(p0[0], p0[1]); w.y = cvtpk(p0[2], p0[3]); w.z = cvtpk(p0[4], p0[5]); w.w = cvtpk(p0[6], p0[7]); pf[0] = __builtin_bit_cast(bf16x8, w);
      w.x = cvtpk(p0[8], p0[9]); w.y = cvtpk(p0[10], p0[11]); w.z = cvtpk(p0[12], p0[13]); w.w = cvtpk(p0[14], p0[15]); pf[1] = __builtin_bit_cast(bf16x8, w);
      w.x = cvtpk(p1[0], p1[1]); w.y = cvtpk(p1[2], p1[3]); w.z = cvtpk(p1[4], p1[5]); w.w = cvtpk(p1[6], p1[7]); pf[2] = __builtin_bit_cast(bf16x8, w);
      w.x = cvtpk(p1[8], p1[9]); w.y = cvtpk(p1[10], p1[11]); w.z = cvtpk(p1[12], p1[13]); w.w = cvtpk(p1[14], p1[15]); pf[3] = __builtin_bit_cast(bf16x8, w); }
#pragma unroll
    for (int db = 0; db < NDB; ++db)
#pragma unroll
        for (int ks = 0; ks < 4; ++ks) {
            const s16x4 lo = vtr(vslot_l + db * 4096 + ks * 1024), hh = vtr(vslot_l + db * 4096 + ks * 1024 + 512);
            const bf16x8 vf = {lo[0], lo[1], lo[2], lo[3], hh[0], hh[1], hh[2], hh[3]};
            o[db] = __builtin_amdgcn_mfma_f32_32x32x16_bf16(vf, pf[ks], o[db], 0, 0, 0);
        }
}
template <int NDB> __device__ __forceinline__ void flash_update(FlashSt<NDB>& st, f32x16& p0, f32x16& p1, lds_cptr vslot_l) {
    const float rm = rowmax32(p0, p1);
    const float mn = fmaxf(st.m, rm), alpha = __builtin_amdgcn_exp2f(st.m - mn);
    st.m = mn;
    float ls = 0.f;
#pragma unroll
    for (int r = 0; r < 16; ++r) { p0[r] = __builtin_amdgcn_exp2f(p0[r] - mn); p1[r] = __builtin_amdgcn_exp2f(p1[r] - mn); ls += p0[r] + p1[r]; }
    st.l = st.l * alpha + ls;
#pragma unroll
    for (int db = 0; db < NDB; ++db)
#pragma unroll
        for (int r = 0; r < 16; ++r) st.o[db][r] *= alpha;
    pv_tile<NDB>(st.o, vslot_l, p0, p1);
}
__device__ __forceinline__ int lane_vbase(int lane) { return ((lane >> 4) & 1) * 32 + (lane & 3) * 8 + (4 * (lane >> 5) + ((lane & 15) >> 2)) * 64; }

__device__ __forceinline__ void fox_unit(unsigned char* lds, unsigned char* ws, int bh, int qb, bool dry = false) {
    int tid_o = threadIdx.x; asm volatile("" : "+v"(tid_o));
    const int tid = tid_o, lane = tid & 63, wid = __builtin_amdgcn_readfirstlane(tid >> 6), r32 = lane & 31, hi = lane >> 5;
    const unsigned lds0 = (unsigned)(uintptr_t)lds;
    const lds_cptr L = (lds_cptr)lds;
    const int qrow = 256 * qb + 32 * wid + r32, wrow0 = 256 * qb + 32 * wid;
    const int NTl = 4 * (qb + 1);
    const char* Kg = (const char*)(ws + OFF_KA) + (size_t)bh * 524288 + wid * 1024 + lane * 16;
    const char* Vg = (const char*)(ws + OFF_VA) + (size_t)bh * 524288 + wid * 1024 + lane * 16;
    const char* Cg = (const char*)(ws + OFF_CF) + (size_t)bh * 16384 + lane * 4;
    const unsigned kdst = (unsigned)__builtin_amdgcn_readfirstlane(lds0 + A_KRING + wid * 1024), vdst = (unsigned)__builtin_amdgcn_readfirstlane(lds0 + A_VRING + wid * 1024),
                   cdst = (unsigned)__builtin_amdgcn_readfirstlane(lds0 + A_CFRING + wid * 256);
#define FOX_DMA(t, slot) do { glds16(Kg + (size_t)(t) * 8192, kdst + (slot) * A_SLOT); glds16(Vg + (size_t)(t) * 8192, vdst + (slot) * A_SLOT); glds4(Cg + (size_t)(t) * 256, cdst + (slot) * 2048); } while (0)
    asm volatile("s_waitcnt vmcnt(0)" ::: "memory");
    FOX_DMA(0, 0); FOX_DMA(1, 1);
    bf16x8 qf[4];
    { const bf16* Q = (const bf16*)(ws + OFF_QA) + ((size_t)bh * 4096 + qrow) * 64 + 8 * hi;
#pragma unroll
      for (int d0 = 0; d0 < 4; ++d0) qf[d0] = *(const bf16x8*)(Q + 16 * d0); }
    const float ci = ((const float*)(ws + OFF_CF))[(size_t)bh * 4096 + qrow];
    FlashSt<2> st; flash_init<2>(st);
    const int vb = lane_vbase(lane);
    asm volatile("s_waitcnt vmcnt(0)" ::: "memory");
    asm volatile("s_barrier" ::: "memory");
    int slot = 0;
    for (int t = 0; t < NTl; ++t) {
        const int s2 = (slot >= 1) ? slot - 1 : 2;
        if (t + 2 < NTl) FOX_DMA(t + 2, s2);
        if (64 * t <= wrow0 + 31) {
            f32x16 p0, p1;
            { const LAS float* cf = (const LAS float*)(L + A_CFRING + slot * 2048 + wid * 256) + 4 * hi;
#pragma unroll
              for (int rq = 0; rq < 4; ++rq) { const f32x4 c0 = *(const LAS f32x4*)(cf + 8 * rq), c1 = *(const LAS f32x4*)(cf + 32 + 8 * rq);
#pragma unroll
                  for (int e = 0; e < 4; ++e) { p0[4 * rq + e] = ci - c0[e]; p1[4 * rq + e] = ci - c1[e]; } } }
            qk_tile(p0, p1, L + A_KRING + slot * A_SLOT, qf, r32, hi);
            if (64 * t + 63 > wrow0) {
                const int kb = 64 * t + 4 * hi;
#pragma unroll
                for (int r = 0; r < 16; ++r) { const int kv = kb + (r & 3) + 8 * (r >> 2); if (kv > qrow) p0[r] = -INFINITY; if (kv + 32 > qrow) p1[r] = -INFINITY; }
            }
            flash_update<2>(st, p0, p1, L + A_VRING + slot * A_SLOT + vb);
        }
        if (t + 2 < NTl) { A_WAIT_BAR(3); } else { A_WAIT_BAR(0); }
        slot = (slot == 2) ? 0 : slot + 1;
    }
#undef FOX_DMA
    const float lt = st.l + __shfl_xor(st.l, 32), il = 1.f / lt;
    const int b = bh >> 3, h = bh & 7;
    bf16* Y = (bf16*)(ws + OFF_ZA) + (size_t)(b * 4096 + qrow) * 512 + h * 64;
    bf16* Yd = dry ? (bf16*)(ws + OFF_SELM) + (tid * 64) : Y;
#pragma unroll
    for (int db = 0; db < 2; ++db)
#pragma unroll
        for (int rq = 0; rq < 4; ++rq) { bf16* yp = Y + 32 * db + 8 * rq + 4 * hi; bf16* yo = Yd + 32 * db + 8 * rq + 4 * hi; const u32x2 z = *(const u32x2*)yp;
            const float z0 = __uint_as_float(z.x << 16), z1 = __uint_as_float(z.x & 0xffff0000u), z2 = __uint_as_float(z.y << 16), z3 = __uint_as_float(z.y & 0xffff0000u);
            u32x2 o; o.x = pk2(st.o[db][4 * rq] * il * z0, st.o[db][4 * rq + 1] * il * z1); o.y = pk2(st.o[db][4 * rq + 2] * il * z2, st.o[db][4 * rq + 3] * il * z3);
            *(u32x2*)yo = o; }
}

__device__ __forceinline__ void diff_unit(unsigned char* lds, unsigned char* ws, int bhc, int qb, const float* subg, float lam, float lam_init, bool dry = false) {
    int tid_o = threadIdx.x; asm volatile("" : "+v"(tid_o));
    const int tid = tid_o, lane = tid & 63, wid = __builtin_amdgcn_readfirstlane(tid >> 6), r32 = lane & 31, hi = lane >> 5;
    const int map = wid >> 2, wl = wid & 3;
    const unsigned lds0 = (unsigned)(uintptr_t)lds;
    const lds_cptr L = (lds_cptr)lds;
    const int b = bhc >> 2, hc = bhc & 3;
    const int qrow = 128 * qb + 32 * wl + r32, wrow0 = 128 * qb + 32 * wl;
    const int NTl = 2 * (qb + 1);
    const char* Kg = (const char*)(ws + OFF_KC) + (size_t)(b * 8 + hc * 2) * 524288 + wid * 1024 + lane * 16;
    const char* Vg = (const char*)(ws + OFF_VC) + (size_t)bhc * 1048576 + wid * 1024 + lane * 16;
    const unsigned kdst = (unsigned)__builtin_amdgcn_readfirstlane(lds0 + A_KRING + wid * 1024), vdst = (unsigned)__builtin_amdgcn_readfirstlane(lds0 + A_VRING + wid * 1024);
#define DIFF_DMA(t, slot) do { glds16(Kg + (size_t)(t) * 8192, kdst + (slot) * A_SLOT); glds16(Kg + 524288 + (size_t)(t) * 8192, kdst + (slot) * A_SLOT + 8192); \
        glds16(Vg + (size_t)(t) * 16384, vdst + (slot) * A_SLOT); glds16(Vg + (size_t)(t) * 16384 + 8192, vdst + (slot) * A_SLOT + 8192); } while (0)
    asm volatile("s_waitcnt vmcnt(0)" ::: "memory");
    DIFF_DMA(0, 0); DIFF_DMA(1, 1);
    bf16x8 qf[4];
    { const bf16* Q = (const bf16*)(ws + OFF_QC) + ((size_t)(b * 8 + hc * 2 + map) * 4096 + qrow) * 64 + 8 * hi;
#pragma unroll
      for (int d0 = 0; d0 < 4; ++d0) qf[d0] = *(const bf16x8*)(Q + 16 * d0); }
    FlashSt<4> st; flash_init<4>(st);
    const int vb = lane_vbase(lane);
    asm volatile("s_waitcnt vmcnt(0)" ::: "memory");
    asm volatile("s_barrier" ::: "memory");
    int slot = 0;
    for (int t = 0; t < NTl; ++t) {
        const int s2 = (slot >= 1) ? slot - 1 : 2;
        if (t + 2 < NTl) DIFF_DMA(t + 2, s2);
        if (64 * t <= wrow0 + 31) {
            f32x16 p0, p1;
#pragma unroll
            for (int r = 0; r < 16; ++r) { p0[r] = 0.f; p1[r] = 0.f; }
            qk_tile(p0, p1, L + A_KRING + slot * A_SLOT + map * 8192, qf, r32, hi);
            if (64 * t + 63 > wrow0) {
                const int kb = 64 * t + 4 * hi;
#pragma unroll
                for (int r = 0; r < 16; ++r) { const int kv = kb + (r & 3) + 8 * (r >> 2); if (kv > qrow) p0[r] = -INFINITY; if (kv + 32 > qrow) p1[r] = -INFINITY; }
            }
            flash_update<4>(st, p0, p1, L + A_VRING + slot * A_SLOT + vb);
        }
        if (t + 2 < NTl) { A_WAIT_BAR(4); } else { A_WAIT_BAR(0); }
        slot = (slot == 2) ? 0 : slot + 1;
    }
#undef DIFF_DMA
    const float lt = st.l + __shfl_xor(st.l, 32), il = 1.f / lt;
    LAS float* stage = (LAS float*)lds + wl * 4096 + r32;
    if (map == 1) {
#pragma unroll
        for (int db = 0; db < 4; ++db)
#pragma unroll
            for (int r = 0; r < 16; ++r) stage[(32 * db + crow(r, hi)) * 32] = st.o[db][r] * il;
    }
    asm volatile("s_waitcnt lgkmcnt(0)\n\ts_barrier" ::: "memory");
    if (map == 0) {
        float ss = 0.f;
#pragma unroll
        for (int db = 0; db < 4; ++db)
#pragma unroll
            for (int r = 0; r < 16; ++r) { const float v = st.o[db][r] * il - lam * stage[(32 * db + crow(r, hi)) * 32]; st.o[db][r] = v; ss += v * v; }
        ss += __shfl_xor(ss, 32);
        const float rs = rsqrtf(ss * (1.f / 128.f) + EPS) * (1.f - lam_init);
        bf16* Y = (bf16*)(ws + OFF_ZC) + (size_t)(b * 4096 + qrow) * 512 + hc * 128;
        bf16* Yd = dry ? (bf16*)(ws + OFF_SELM) + (tid * 128) : Y;
#pragma unroll
        for (int db = 0; db < 4; ++db)
#pragma unroll
            for (int rq = 0; rq < 4; ++rq) { const int d = 32 * db + 8 * rq + 4 * hi; bf16* yp = Y + d; bf16* yo = Yd + d; const u32x2 z = *(const u32x2*)yp; const f32x4 g = *(const f32x4*)(subg + d);
                const float z0 = __uint_as_float(z.x << 16), z1 = __uint_as_float(z.x & 0xffff0000u), z2 = __uint_as_float(z.y << 16), z3 = __uint_as_float(z.y & 0xffff0000u);
                u32x2 o; o.x = pk2(st.o[db][4 * rq] * rs * g[0] * z0, st.o[db][4 * rq + 1] * rs * g[1] * z1); o.y = pk2(st.o[db][4 * rq + 2] * rs * g[2] * z2, st.o[db][4 * rq + 3] * rs * g[3] * z3);
                *(u32x2*)yo = o; }
    }
    asm volatile("s_waitcnt lgkmcnt(0)\n\ts_barrier" ::: "memory");
}

constexpr int N_IMP = A_MISC, N_SELM = N_IMP + 64 * 65 * 4, N_UMASK = N_SELM + 512, N_SEQC = N_UMASK + 16, N_SEQD = N_SEQC + 80, N_CNT = N_SEQD + 16;
template <int MODE> __device__ __forceinline__ void nsa_ring(FlashSt<2>& st, unsigned char* lds, const char* Kg, const char* Vg, unsigned kdst, unsigned vdst, int n, int seqoff,
                                                             const bf16x8 (&qf)[4], int tb, int qloc, unsigned selLo, unsigned selHi, int r32, int hi, int vb) {
    const lds_cptr L = (lds_cptr)lds;
    const LAS unsigned char* seq = (const LAS unsigned char*)(L + seqoff);
#define NSA_DMA(j, slot) do { glds16(Kg + (size_t)(j) * 8192, kdst + (slot) * A_SLOT); glds16(Vg + (size_t)(j) * 8192, vdst + (slot) * A_SLOT); } while (0)
    asm volatile("s_waitcnt vmcnt(0)" ::: "memory");
    { const int j0 = __builtin_amdgcn_readfirstlane((int)seq[0]); NSA_DMA(j0, 0); if (n > 1) { const int j1 = __builtin_amdgcn_readfirstlane((int)seq[1]); NSA_DMA(j1, 1); } }
    A_WAIT_BAR(0);
    int slot = 0;
    for (int i = 0; i < n; ++i) {
        const int s2 = (slot >= 1) ? slot - 1 : 2;
        if (i + 2 < n) { const int j2 = __builtin_amdgcn_readfirstlane((int)seq[i + 2]); NSA_DMA(j2, s2); }
        const int j = __builtin_amdgcn_readfirstlane((int)seq[i]);
        f32x16 p0, p1;
#pragma unroll
        for (int r = 0; r < 16; ++r) { p0[r] = 0.f; p1[r] = 0.f; }
        qk_tile(p0, p1, L + A_KRING + slot * A_SLOT, qf, r32, hi);
        if (j == tb) {
#pragma unroll
            for (int r = 0; r < 16; ++r) { const int kv = 4 * hi + (r & 3) + 8 * (r >> 2); if (kv > qloc) p0[r] = -INFINITY; if (kv + 32 > qloc) p1[r] = -INFINITY; }
        } else if (MODE == 0) {
            const bool sel = (((j < 32) ? (selLo >> j) : (selHi >> (j - 32))) & 1u) != 0u;
            if (!sel) {
#pragma unroll
                for (int r = 0; r < 16; ++r) { p0[r] = -INFINITY; p1[r] = -INFINITY; } }
        } else if (j == tb - 8) {
#pragma unroll
            for (int r = 0; r < 16; ++r) { const int kv = 4 * hi + (r & 3) + 8 * (r >> 2); if (kv <= qloc) p0[r] = -INFINITY; if (kv + 32 <= qloc) p1[r] = -INFINITY; }
        }
        flash_update<2>(st, p0, p1, L + A_VRING + slot * A_SLOT + vb);
        if (i + 2 < n) { A_WAIT_BAR(2); } else { A_WAIT_BAR(0); }
        slot = (slot == 2) ? 0 : slot + 1;
    }
#undef NSA_DMA
}
__device__ __forceinline__ void nsa_unit(unsigned char* lds, unsigned char* ws, int bg, int tb, bool dry = false) {
    int tid_o = threadIdx.x; asm volatile("" : "+v"(tid_o));
    const int tid = tid_o, lane = tid & 63, wid = __builtin_amdgcn_readfirstlane(tid >> 6), r32 = lane & 31, hi = lane >> 5;
    const unsigned lds0 = (unsigned)(uintptr_t)lds;
    const lds_cptr L = (lds_cptr)lds;
    const int b = bg >> 1, g = bg & 1, h = 4 * g + (wid >> 1), qloc = 32 * (wid & 1) + r32, t = 64 * tb + qloc, row = b * 4096 + t;
    const unsigned kdst = (unsigned)__builtin_amdgcn_readfirstlane(lds0 + A_KRING + wid * 1024), vdst = (unsigned)__builtin_amdgcn_readfirstlane(lds0 + A_VRING + wid * 1024);
    const int vb = lane_vbase(lane);
    LAS float* imp = (LAS float*)(L + N_IMP);
    LAS unsigned* selm = (LAS unsigned*)(L + N_SELM);
    LAS unsigned* umask = (LAS unsigned*)(L + N_UMASK);
    const int nvmax = 4 * tb + 3, nct = (nvmax + 63) >> 6;
    for (int i = tid; i < 64 * 65; i += 512) imp[i] = 0.f;
    if (tid < 128) selm[tid] = 0u;
    if (tid < 2) umask[tid] = 0u;
    asm volatile("s_waitcnt vmcnt(0)" ::: "memory");
    { const char* Kc = (const char*)(ws + OFF_KCMP) + (size_t)bg * 32768 + wid * 1024 + lane * 16; const char* Vc = (const char*)(ws + OFF_VCMP) + (size_t)bg * 32768 + wid * 1024 + lane * 16;
      for (int ct = 0; ct < nct; ++ct) { glds16(Kc + ct * 8192, kdst + ct * 8192); glds16(Vc + ct * 8192, vdst + ct * 8192); } }
    bf16x8 qf[4];
    const bf16* Qp = (const bf16*)(ws + OFF_QB) + ((size_t)(b * 8 + h) * 4096 + t) * 64 + 8 * hi;
#pragma unroll
    for (int d0 = 0; d0 < 4; ++d0) qf[d0] = *(const bf16x8*)(Qp + 16 * d0);
    const float* gt = (const float*)(ws + OFF_GATES) + (size_t)row * 24 + (h & 7) * 3;
    const float g0 = gt[0], g1 = gt[1], g2 = gt[2];
    A_WAIT_BAR(0);
    const int nv = (t >= 31) ? ((t - 31) >> 4) + 1 : 0;
    f32x16 y[2];
    {
        float m = -1e30f, l = 0.f;
        for (int ct = 0; ct < nct; ++ct) {
            f32x16 p0, p1;
#pragma unroll
            for (int r = 0; r < 16; ++r) { p0[r] = 0.f; p1[r] = 0.f; }
            qk_tile(p0, p1, L + A_KRING + ct * 8192, qf, r32, hi);
            const int cb = 64 * ct + 4 * hi;
#pragma unroll
            for (int r = 0; r < 16; ++r) { const int c = cb + (r & 3) + 8 * (r >> 2); if (c >= nv) p0[r] = -INFINITY; if (c + 32 >= nv) p1[r] = -INFINITY; }
            const float rm = rowmax32(p0, p1), mn = fmaxf(m, rm);
            float ls = 0.f;
#pragma unroll
            for (int r = 0; r < 16; ++r) ls += __builtin_amdgcn_exp2f(p0[r] - mn) + __builtin_amdgcn_exp2f(p1[r] - mn);
            l = l * __builtin_amdgcn_exp2f(m - mn) + ls; m = mn;
        }
        const float lt = l + __shfl_xor(l, 32), il = lt > 0.f ? 1.f / lt : 0.f;
        f32x16 oc[2];
#pragma unroll
        for (int r = 0; r < 16; ++r) { oc[0][r] = 0.f; oc[1][r] = 0.f; }
        for (int ct = 0; ct < nct; ++ct) {
            f32x16 p0, p1;
#pragma unroll
            for (int r = 0; r < 16; ++r) { p0[r] = 0.f; p1[r] = 0.f; }
            qk_tile(p0, p1, L + A_KRING + ct * 8192, qf, r32, hi);
            const int cb = 64 * ct + 4 * hi;
#pragma unroll
            for (int r = 0; r < 16; ++r) { const int c = cb + (r & 3) + 8 * (r >> 2);
                p0[r] = (c >= nv) ? 0.f : __builtin_amdgcn_exp2f(p0[r] - m) * il; p1[r] = (c + 32 >= nv) ? 0.f : __builtin_amdgcn_exp2f(p1[r] - m) * il; }
            LAS float* ir = imp + qloc * 65 + 16 * ct + hi;
#pragma unroll
            for (int rq = 0; rq < 4; ++rq) {
                const float q0 = (p0[4 * rq] + p0[4 * rq + 1]) + (p0[4 * rq + 2] + p0[4 * rq + 3]), q1 = (p1[4 * rq] + p1[4 * rq + 1]) + (p1[4 * rq + 2] + p1[4 * rq + 3]);
                __hip_atomic_fetch_add(ir + 2 * rq, q0, __ATOMIC_RELAXED, __HIP_MEMORY_SCOPE_WORKGROUP);
                __hip_atomic_fetch_add(ir + 2 * rq + 1, p0[4 * rq + 3], __ATOMIC_RELAXED, __HIP_MEMORY_SCOPE_WORKGROUP);
                __hip_atomic_fetch_add(ir + 8 + 2 * rq, q1, __ATOMIC_RELAXED, __HIP_MEMORY_SCOPE_WORKGROUP);
                if (16 * ct + 8 + 2 * rq + hi + 1 < 64) __hip_atomic_fetch_add(ir + 8 + 2 * rq + 1, p1[4 * rq + 3], __ATOMIC_RELAXED, __HIP_MEMORY_SCOPE_WORKGROUP);
            }
            pv_tile<2>(oc, L + A_VRING + ct * 8192 + vb, p0, p1);
        }
#pragma unroll
        for (int r = 0; r < 16; ++r) { y[0][r] = g0 * oc[0][r]; y[1][r] = g0 * oc[1][r]; }
    }
    asm volatile("s_waitcnt lgkmcnt(0)\n\ts_barrier" ::: "memory");
    {
        const int q = tid >> 3, part = tid & 7;
        float sc[8];
#pragma unroll
        for (int i = 0; i < 8; ++i) { const int j = 8 * part + i; const bool forced = (j == 0) || (j == tb) || (j == tb - 1);
            sc[i] = forced ? 1e30f : (j <= tb ? imp[q * 65 + j] : -1e30f); }
#pragma unroll
        for (int i = 0; i < 8; ++i) imp[q * 65 + 8 * part + i] = sc[i];
        asm volatile("s_waitcnt lgkmcnt(0)\n\ts_barrier" ::: "memory");
        int rank[8];
#pragma unroll
        for (int i = 0; i < 8; ++i) rank[i] = 0;
        for (int k = 0; k < 64; ++k) { const float sk = imp[q * 65 + k];
#pragma unroll
            for (int i = 0; i < 8; ++i) rank[i] += (sk > sc[i] || (sk == sc[i] && k < 8 * part + i)) ? 1 : 0; }
        unsigned bits = 0u;
#pragma unroll
        for (int i = 0; i < 8; ++i) bits |= (rank[i] < 16) ? (1u << i) : 0u;
        bits <<= 8 * (part & 3);
        __hip_atomic_fetch_or(selm + q * 2 + (part >> 2), bits, __ATOMIC_RELAXED, __HIP_MEMORY_SCOPE_WORKGROUP);
        __hip_atomic_fetch_or(umask + (part >> 2), bits, __ATOMIC_RELAXED, __HIP_MEMORY_SCOPE_WORKGROUP);
        asm volatile("s_waitcnt lgkmcnt(0)\n\ts_barrier" ::: "memory");
        if (tid == 0) {
            LAS unsigned char* sq = (LAS unsigned char*)(L + N_SEQC); LAS unsigned char* sd = (LAS unsigned char*)(L + N_SEQD); LAS int* cnt = (LAS int*)(L + N_CNT);
            const unsigned long long um = ((unsigned long long)umask[1] << 32) | umask[0];
            int n = 0; sq[n++] = (unsigned char)tb;
            for (int j = 0; j < tb; ++j) if ((um >> j) & 1ull) sq[n++] = (unsigned char)j;
            cnt[0] = n;
            int n2 = 0; sd[n2++] = (unsigned char)tb;
            for (int j = (tb >= 8 ? tb - 8 : 0); j < tb; ++j) sd[n2++] = (unsigned char)j;
            cnt[1] = n2;
        }
        asm volatile("s_waitcnt lgkmcnt(0)\n\ts_barrier" ::: "memory");
    }
    const unsigned selLo = selm[qloc * 2], selHi = selm[qloc * 2 + 1];
    const int nC = __builtin_amdgcn_readfirstlane(((const LAS int*)(L + N_CNT))[0]), nD = __builtin_amdgcn_readfirstlane(((const LAS int*)(L + N_CNT))[1]);
    { const float* cs = (const float*)(ws + OFF_COS) + (size_t)row * 32 + 4 * hi; const float* sn = (const float*)(ws + OFF_SIN) + (size_t)row * 32 + 4 * hi;
#pragma unroll
      for (int d0 = 0; d0 < 4; ++d0) { const f32x4 c = *(const f32x4*)(cs + 8 * d0), s = *(const f32x4*)(sn + 8 * d0); u32x4 w = __builtin_bit_cast(u32x4, qf[d0]); u32x4 o;
#pragma unroll
          for (int e = 0; e < 4; ++e) { const float x1 = __uint_as_float(w[e] << 16), x2 = __uint_as_float(w[e] & 0xffff0000u); o[e] = pk2(x1 * c[e] - x2 * s[e], x2 * c[e] + x1 * s[e]); }
          qf[d0] = __builtin_bit_cast(bf16x8, o); } }
    {
        FlashSt<2> st; flash_init<2>(st);
        const char* Kg = (const char*)(ws + OFF_KSEL) + (size_t)bg * 524288 + wid * 1024 + lane * 16; const char* Vg = (const char*)(ws + OFF_VSEL) + (size_t)bg * 524288 + wid * 1024 + lane * 16;
        nsa_ring<0>(st, lds, Kg, Vg, kdst, vdst, nC, N_SEQC, qf, tb, qloc, selLo, selHi, r32, hi, vb);
        const float lt = st.l + __shfl_xor(st.l, 32), sc = g1 / lt;
#pragma unroll
        for (int r = 0; r < 16; ++r) { y[0][r] += sc * st.o[0][r]; y[1][r] += sc * st.o[1][r]; }
    }
    {
        FlashSt<2> st; flash_init<2>(st);
        const char* Kg = (const char*)(ws + OFF_KWIN) + (size_t)bg * 524288 + wid * 1024 + lane * 16; const char* Vg = (const char*)(ws + OFF_VWIN) + (size_t)bg * 524288 + wid * 1024 + lane * 16;
        nsa_ring<1>(st, lds, Kg, Vg, kdst, vdst, nD, N_SEQD, qf, tb, qloc, selLo, selHi, r32, hi, vb);
        const float lt = st.l + __shfl_xor(st.l, 32), sc = g2 / lt;
#pragma unroll
        for (int r = 0; r < 16; ++r) { y[0][r] += sc * st.o[0][r]; y[1][r] += sc * st.o[1][r]; }
    }
    bf16* Y = (bf16*)(ws + OFF_ZB) + (size_t)row * 512 + h * 64;
    bf16* Yd = dry ? (bf16*)(ws + OFF_SELM) + (tid * 64) : Y;
#pragma unroll
    for (int db = 0; db < 2; ++db)
#pragma unroll
        for (int rq = 0; rq < 4; ++rq) { bf16* yp = Y + 32 * db + 8 * rq + 4 * hi; bf16* yo = Yd + 32 * db + 8 * rq + 4 * hi; const u32x2 z = *(const u32x2*)yp;
            const float z0 = __uint_as_float(z.x << 16), z1 = __uint_as_float(z.x & 0xffff0000u), z2 = __uint_as_float(z.y << 16), z3 = __uint_as_float(z.y & 0xffff0000u);
            u32x2 o; o.x = pk2(y[db][4 * rq] * z0, y[db][4 * rq + 1] * z1); o.y = pk2(y[db][4 * rq + 2] * z2, y[db][4 * rq + 3] * z3);
            *(u32x2*)yo = o; }
}

__device__ __forceinline__ void compress_unit(unsigned char* lds, unsigned char* ws, int kv, int bg, int rc) {
    int tid_o = threadIdx.x; asm volatile("" : "+v"(tid_o));
    const int tid = tid_o, lane = tid & 63, wid = __builtin_amdgcn_readfirstlane(tid >> 6), r32 = lane & 31, hi = lane >> 5;
    const int c = 32 * rc + r32;
    const int cl = c < 255 ? c : 254;
    const bf16* Ap = (const bf16*)(ws + (kv ? OFF_VCB : OFF_KCB)) + ((size_t)bg * 4096 + 16 * cl) * 64 + 8 * hi;
    const bf16* Bp = (const bf16*)(ws + OFF_CW1) + (size_t)(kv * 256 + 32 * wid + r32) * 2048 + 8 * hi;
    f32x16 acc;
#pragma unroll
    for (int r = 0; r < 16; ++r) acc[r] = 0.f;
#pragma unroll 8
    for (int k = 0; k < 2048; k += 16) {
        const bf16x8 a = *(const bf16x8*)(Ap + k), w = *(const bf16x8*)(Bp + k);
        acc = __builtin_amdgcn_mfma_f32_32x32x16_bf16(w, a, acc, 0, 0, 0);
    }
    const float* cb = (const float*)(ws + OFF_CB1) + kv * 256 + 32 * wid + 4 * hi;
    bf16x8 hf[2];
    { float hv[16];
#pragma unroll
      for (int rq = 0; rq < 4; ++rq) { const f32x4 bb = *(const f32x4*)(cb + 8 * rq);
#pragma unroll
          for (int e = 0; e < 4; ++e) hv[4 * rq + e] = siluf_(acc[4 * rq + e] + bb[e]); }
      u32x4 w0, w1;
      w0.x = pk2(hv[0], hv[1]); w0.y = pk2(hv[2], hv[3]); w0.z = pk2(hv[4], hv[5]); w0.w = pk2(hv[6], hv[7]);
      w1.x = pk2(hv[8], hv[9]); w1.y = pk2(hv[10], hv[11]); w1.z = pk2(hv[12], hv[13]); w1.w = pk2(hv[14], hv[15]);
      hf[0] = __builtin_bit_cast(bf16x8, w0); hf[1] = __builtin_bit_cast(bf16x8, w1); }
    const bf16* W2 = (const bf16*)(ws + OFF_CW2) + (size_t)kv * 64 * 256 + 32 * wid + 4 * hi;
    f32x16 po[2];
#pragma unroll
    for (int dbk = 0; dbk < 2; ++dbk) {
#pragma unroll
        for (int r = 0; r < 16; ++r) po[dbk][r] = 0.f;
#pragma unroll
        for (int s = 0; s < 2; ++s) {
            const bf16* wr = W2 + (size_t)(32 * dbk + r32) * 256 + 16 * s;
            const u32x2 lo = *(const u32x2*)wr, hh = *(const u32x2*)(wr + 8);
            u32x4 wv; wv.x = lo.x; wv.y = lo.y; wv.z = hh.x; wv.w = hh.y;
            po[dbk] = __builtin_amdgcn_mfma_f32_32x32x16_bf16(__builtin_bit_cast(bf16x8, wv), hf[s], po[dbk], 0, 0, 0);
        }
    }
    LAS float* part = (LAS float*)lds;
    __syncthreads();
#pragma unroll
    for (int dbk = 0; dbk < 2; ++dbk)
#pragma unroll
        for (int r = 0; r < 16; ++r) part[(wid * 64 + 32 * dbk + crow(r, hi)) * 32 + r32] = po[dbk][r];
    __syncthreads();
    {
        const int row = tid & 31, d4 = tid >> 5, cc = 32 * rc + row;
        float o[4];
#pragma unroll
        for (int e = 0; e < 4; ++e) { float sum = 0.f;
#pragma unroll
            for (int w = 0; w < 8; ++w) sum += part[(w * 64 + 4 * d4 + e) * 32 + row];
            o[e] = (cc < 255) ? sum : 0.f; }
        bf16* dst = (bf16*)(ws + (kv ? OFF_VCMP : OFF_KCMP)) + (size_t)bg * 16384 + (kv ? vtile_off(cc, 4 * d4) : ktile_off(cc, 4 * d4));
        store_bf<4>(dst, o);
    }
    __syncthreads();
}
__device__ __forceinline__ void cumsum_unit(unsigned char* lds, unsigned char* ws, int bh) {
    int tid_o = threadIdx.x; asm volatile("" : "+v"(tid_o));
    const int tid = tid_o, lane = tid & 63, wid = tid >> 6, b = bh >> 3, h = bh & 7;
    const float* lf = (const float*)(ws + OFF_LOGF) + ((size_t)(b * 4096 + 8 * tid)) * 8 + h;
    float v[8]; float s = 0.f;
#pragma unroll
    for (int i = 0; i < 8; ++i) { s += lf[i * 8]; v[i] = s; }
    float incl = s;
#pragma unroll
    for (int of = 1; of < 64; of <<= 1) { const float t = __shfl_up(incl, of); if (lane >= of) incl += t; }
    LAS float* wsum = (LAS float*)lds;
    __syncthreads();
    if (lane == 63) wsum[wid] = incl;
    __syncthreads();
    float base = incl - s;
    for (int w = 0; w < wid; ++w) base += wsum[w];
    float* cf = (float*)(ws + OFF_CF) + (size_t)bh * 4096 + 8 * tid;
    f32x4 o0 = {base + v[0], base + v[1], base + v[2], base + v[3]}, o1 = {base + v[4], base + v[5], base + v[6], base + v[7]};
    *(f32x4*)cf = o0; *(f32x4*)(cf + 4) = o1;
    __syncthreads();
}

constexpr size_t OFF_BAR = OFF_CTL + 131072;
constexpr int LDS_BARST = 131072 + 64;
#define XB_TMO      128
#define XB_XCNT(j)  (256  + 64 * (j))
#define XB_XSUB(j)  (1280 + 64 * (j))
#define XB_XGEN(j)  (2304 + 64 * (j))
#define XB_TOP      3328
#define XB_TOPGEN   3392
#define XCD_BAR_WORDS 3456
#define XB_SPIN_CAP (1u << 18)

__device__ __forceinline__ unsigned xb_ld(unsigned* p)              { return __hip_atomic_load(p, __ATOMIC_RELAXED, __HIP_MEMORY_SCOPE_AGENT); }
__device__ __forceinline__ unsigned xb_add(unsigned* p, unsigned v) { return __hip_atomic_fetch_add(p, v, __ATOMIC_RELAXED, __HIP_MEMORY_SCOPE_AGENT); }
__device__ __forceinline__ unsigned xb_xcc_id() { return (unsigned)__builtin_amdgcn_s_getreg((3 << 11) | 20) & 0xFu; }
#define XB_SPIN(cond, bar) do { unsigned _sp = 0; while (cond) { __builtin_amdgcn_s_sleep(1); \
    if ((++_sp & 255u) == 0u) { if (xb_ld(&(bar)[XB_TMO])) break; if (_sp > XB_SPIN_CAP) { atomicAdd(&(bar)[XB_TMO], 1u); break; } } } } while (0)

struct XcdBarrier {
    unsigned* bar; unsigned x;
    volatile LAS unsigned* st;
};

__device__ __forceinline__ XcdBarrier xcd_barrier_post(unsigned* bar, volatile LAS unsigned* st) {
    XcdBarrier b; b.bar = bar; b.x = xb_xcc_id(); b.st = st;
    if (threadIdx.x == 0) (void)xb_add(&bar[XB_XCNT(b.x)], 1u);
    return b;
}
__device__ __forceinline__ void xcd_barrier_complete(unsigned* bar, unsigned x, unsigned& nloc, unsigned& nx) {
    const unsigned G = gridDim.x * gridDim.y * gridDim.z;
    unsigned sum, cnt, mine, sp = 0u;
    for (;;) {
        sum = 0u; cnt = 0u; mine = 0u;
#pragma unroll
        for (unsigned j = 0; j < 16; ++j) { const unsigned c = xb_ld(&bar[XB_XCNT(j)]); sum += c; cnt += (c > 0u) ? 1u : 0u; mine = (j == x) ? c : mine; }
        if (sum == G) break;
        __builtin_amdgcn_s_sleep(1);
        if ((++sp & 255u) == 0u) { if (xb_ld(&bar[XB_TMO])) break; if (sp > XB_SPIN_CAP) { atomicAdd(&bar[XB_TMO], 1u); break; } }
    }
    nloc = mine > 0u ? mine : 1u; nx = cnt > 0u ? cnt : 1u;
}

__device__ __forceinline__ void xcd_barrier(const XcdBarrier& b) {
    asm volatile("s_waitcnt vmcnt(0)" ::: "memory");
    __syncthreads();
    if (threadIdx.x == 0) {
        unsigned* bar = b.bar;
        __builtin_amdgcn_s_waitcnt(0);
        unsigned nloc = b.st[0], nx = b.st[1];
        if (nloc == 0u) { xcd_barrier_complete(bar, b.x, nloc, nx); b.st[0] = nloc; b.st[1] = nx; }
        const unsigned old = xb_add(&bar[XB_XSUB(b.x)], 1u);
        const unsigned gen = old / nloc;
        if (old + 1u == (gen + 1u) * nloc) {
            __builtin_amdgcn_fence(__ATOMIC_RELEASE, "agent");
            asm volatile("s_waitcnt vmcnt(0)" ::: "memory");
            const unsigned og = xb_add(&bar[XB_TOP], 1u);
            const unsigned tg = og / nx;
            if (og + 1u == (tg + 1u) * nx) xb_add(&bar[XB_TOPGEN], 1u);
            else XB_SPIN(xb_ld(&bar[XB_TOPGEN]) == tg, bar);
            __builtin_amdgcn_fence(__ATOMIC_ACQUIRE, "agent");
            xb_add(&bar[XB_XGEN(b.x)], 1u);
            asm volatile("s_waitcnt vmcnt(0)" ::: "memory");
        } else {
            XB_SPIN(xb_ld(&bar[XB_XGEN(b.x)]) == gen, bar);
            __builtin_amdgcn_fence(__ATOMIC_ACQUIRE, "agent");
            asm volatile("s_waitcnt vmcnt(0)" ::: "memory");
        }
    }
    __syncthreads();
}

namespace cg = cooperative_groups;
constexpr int NT = 512;
constexpr int LDS_BYTES = 147456;
struct KArgs { const void* in[23]; float* out; unsigned char* ws; };

#define OPAQUE_TID() int tid = threadIdx.x; asm volatile("" : "+v"(tid))
#define VRUN(VT, NVB, CALL) do { OPAQUE_TID(); constexpr int per_ = NT / (VT); for (int vb = blockIdx.x * per_ + tid / (VT); vb < (NVB); vb += gridDim.x * per_) { const int vt = tid % (VT); CALL; } } while (0)
#define VRUN_BAR(NVB, CALL) do { OPAQUE_TID(); float (*tile)[65] = (float (*)[65])(lds + (tid >> 8) * 64 * 65 * 4); (void)tile; const int nvb_ = (NVB); for (int it_ = 0; it_ * (int)gridDim.x * 2 < nvb_; ++it_) { const int vb = (it_ * (int)gridDim.x + (int)blockIdx.x) * 2 + (tid >> 8); const int vt = tid & 255; const bool active = vb < nvb_; CALL; } } while (0)

#ifndef FAST_FOX
#define FAST_FOX 1
#endif
#ifndef FAST_DIFF
#define FAST_DIFF 1
#endif
#ifndef FAST_NSA
#define FAST_NSA 1
#endif
#ifndef REP_U
#define REP_U 0
#endif
#ifndef REP_SYNC
#define REP_SYNC 0
#endif
#ifndef REP_SUMSQ
#define REP_SUMSQ 0
#endif
#ifndef REP_P0
#define REP_P0 0
#endif
#ifndef REP_PRO
#define REP_PRO 0
#endif
#ifndef REP_INPROJ
#define REP_INPROJ 0
#endif
#ifndef REP_P2
#define REP_P2 0
#endif
#ifndef REP_FOX
#define REP_FOX 0
#endif
#ifndef REP_DIFF
#define REP_DIFF 0
#endif
#ifndef REP_NSA
#define REP_NSA 0
#endif
#ifndef REP_GATEBR
#define REP_GATEBR 0
#endif
#ifndef REP_OUT
#define REP_OUT 0
#endif
#ifndef FAST_P2
#define FAST_P2 1
#endif
#ifndef DO_ALL
#define DO_ALL 1
#endif
#ifndef DO_PRO
#define DO_PRO DO_ALL
#endif
#ifndef DO_INPROJ
#define DO_INPROJ DO_ALL
#endif
#ifndef DO_P2
#define DO_P2 DO_ALL
#endif
#ifndef DO_ATTN
#define DO_ATTN DO_ALL
#endif
#ifndef DO_GATEBR
#define DO_GATEBR DO_ALL
#endif
#ifndef DO_OUT
#define DO_OUT DO_ALL
#endif
#ifndef DO_PLE
#define DO_PLE DO_ALL
#endif
#ifndef DO_TAIL
#define DO_TAIL DO_ALL
#endif
__global__ void __launch_bounds__(NT) mega(KArgs a) {
    extern __shared__ __attribute__((aligned(16))) unsigned char lds[];
    cg::grid_group grid = cg::this_grid();
    { volatile LAS unsigned* st0 = (volatile LAS unsigned*)((LAS unsigned char*)lds + LDS_BARST); if (threadIdx.x < 2) st0[threadIdx.x] = 0u; }
    __syncthreads();
    const XcdBarrier xbar = xcd_barrier_post((unsigned*)(a.ws + OFF_BAR), (volatile LAS unsigned*)((LAS unsigned char*)lds + LDS_BARST));
#define GSYNC() xcd_barrier(xbar)
    unsigned char* ws = a.ws; float* X = a.out;
    const float* x = (const float*)a.in[0]; const float* p = (const float*)a.in[1]; const int* pos = (const int*)a.in[2];
    const float *norm_g = (const float*)a.in[3], *w_in = (const float*)a.in[4], *b_forget = (const float*)a.in[5];
    const float *pe_k = (const float*)a.in[6], *w1_k = (const float*)a.in[7], *b1_k = (const float*)a.in[8], *w2_k = (const float*)a.in[9];
    const float *pe_v = (const float*)a.in[10], *w1_v = (const float*)a.in[11], *b1_v = (const float*)a.in[12], *w2_v = (const float*)a.in[13];
    const float *diff_lam = (const float*)a.in[14], *subln = (const float*)a.in[15];
    const float *w_out = (const float*)a.in[19], *w_ple = (const float*)a.in[20], *w_pg = (const float*)a.in[21], *final_g = (const float*)a.in[22];
#if DO_PRO
    for (int rep0_ = 0; rep0_ <= REP_P0; ++rep0_) {
    VRUN(256, M / 4, d_xprep(vb, vt, x, ws));
    VRUN(256, M * 32 / 256, d_rope_table(vb, vt, pos, ws));
    VRUN(256, (2 * M * 256 / 4) / 256, d_pconv(vb, vt, p, ws));
    for (int l = 0; l < DEPTH; ++l) {
        VRUN_BAR(256, d_convT<0>(active, vb % 16, vb / 16, vt, tile, w_out + (size_t)l * 1024 * 1024, 1024, 1024, (bf16*)(ws + OFF_WOUT) + (size_t)l * 1024 * 1024, nullptr));
        VRUN_BAR(256, d_convT<0>(active, vb % 16, vb / 16, vt, tile, w_pg + (size_t)l * 1024 * 1024, 1024, 1024, (bf16*)(ws + OFF_WPG) + (size_t)l * 1024 * 1024, nullptr));
        VRUN_BAR(64, d_convT<0>(active, vb % 16, vb / 16, vt, tile, w_ple + (size_t)l * 256 * 1024, 1024, 256, (bf16*)(ws + OFF_WPL) + (size_t)l * 1024 * 256, nullptr));
        { OPAQUE_TID(); if (blockIdx.x == 0 && tid < 64) d_lam(tid, diff_lam + l * 256, ws, l); }
    }
    }
#endif
    for (int l = 0; l < DEPTH; ++l) {
        const float* wl = w_in + (size_t)l * 1024 * NIN; const float* ng = norm_g + l * 1024;
#if DO_PRO
        for (int rep_ = 0; rep_ <= REP_PRO; ++rep_) {
        VRUN_BAR(96 * 16, d_convT<1>(active, vb % 96, vb / 96, vt, tile, wl, NIN, 1024, (bf16*)(ws + OFF_WIN), ng));
        VRUN_BAR(48 * 16, d_convT<0>(active, vb % 48, vb / 48, vt, tile, wl + 5920, NIN, 1024, (bf16*)(ws + OFF_WMG), ng));
        for (int i = 0; i < 3; ++i) { const float* wb = (const float*)a.in[16 + i] + (size_t)l * 512 * 1024;
            VRUN_BAR(16 * 8, d_convT<0>(active, vb % 16, vb / 16, vt, tile, wb, 1024, 512, (bf16*)(ws + OFF_WBR) + (size_t)i * 1024 * 512, nullptr)); }
        VRUN_BAR(4 * 32, d_convT<0>(active, vb % 4, vb / 4, vt, tile, w1_k + (size_t)l * 2048 * 256, 256, 2048, (bf16*)(ws + OFF_CW1), nullptr));
        VRUN_BAR(4 * 32, d_convT<0>(active, vb % 4, vb / 4, vt, tile, w1_v + (size_t)l * 2048 * 256, 256, 2048, (bf16*)(ws + OFF_CW1) + 256 * 2048, nullptr));
        VRUN_BAR(4, d_convT<2>(active, 0, vb, vt, tile, w2_k + (size_t)l * 256 * 64, 64, 256, (bf16*)(ws + OFF_CW2), nullptr));
        VRUN_BAR(4, d_convT<0>(active, 0, vb, vt, tile, w2_v + (size_t)l * 256 * 64, 64, 256, (bf16*)(ws + OFF_CW2) + 64 * 256, nullptr));
        { OPAQUE_TID(); if (blockIdx.x >= 64 && blockIdx.x < 96 && tid < 256) d_cb1_part(blockIdx.x - 64, tid, pe_k + l * 2048, w1_k + (size_t)l * 2048 * 256, pe_v + l * 2048, w1_v + (size_t)l * 2048 * 256, ws); }
        }
#endif
        if (l == 0) grid.sync(); else GSYNC();
        EpiCtx E{ws, b_forget + l * 8, l == 0 ? x : X, X, 0};
#if DO_INPROJ
        { OPAQUE_TID(); if (blockIdx.x == 0) d_cb1_sum(tid, b1_k + l * 256, b1_v + l * 256, ws); }
        for (int rep_ = 0; rep_ <= REP_INPROJ; ++rep_) { FAST_GEMM(EPI_INPROJ, ws + OFF_XB, ws + OFF_WIN, NP, 1024, true); }
#endif
        GSYNC();
#if DO_P2
        for (int rep_ = 0; rep_ <= REP_P2; ++rep_) {
#if FAST_P2
        for (int u = blockIdx.x; u < 160; u += gridDim.x) { if (u < 128) compress_unit(lds, ws, u >> 6, (u >> 3) & 7, u & 7); else cumsum_unit(lds, ws, u - 128); }
#else
        VRUN(64, 32, d_cumsum(vb, vt, ws));
        VRUN_BAR(256 * 8 * 2, d_compress(active, vb, vt, (float*)lds + (tid >> 8) * 256, ws));
#endif
        }
#endif
        GSYNC();
#if DO_ATTN
#if FAST_FOX
        for (int rep_ = REP_FOX; rep_ >= 0; --rep_) for (int u = blockIdx.x; u < 512; u += gridDim.x) fox_unit(lds, ws, u & 31, u < 256 ? 15 - (u >> 5) : (u >> 5) - 8, rep_ > 0);
        __syncthreads();
#else
        VRUN(64, 32 * 64, d_fox(vb, vt, ws));
#endif
#if FAST_DIFF
        { const float lam = ((const float*)(ws + OFF_CTL))[CTL_LAM + l], lam_init = 0.8f - 0.6f * expf(-0.3f * (float)l);
          for (int rep_ = REP_DIFF; rep_ >= 0; --rep_) for (int u = blockIdx.x; u < 512; u += gridDim.x) diff_unit(lds, ws, u & 15, u < 256 ? 31 - (u >> 4) : (u >> 4) - 16, subln + l * 128, lam, lam_init, rep_ > 0); }
#else
        { OPAQUE_TID(); if ((tid >> 6) < 4) { for (int vb = blockIdx.x * 4 + (tid >> 6); vb < 16 * 64; vb += gridDim.x * 4) d_diff(vb, tid & 63, (float (*)[129])(lds + (tid >> 6) * 64 * 129 * 4), ws, subln + l * 128, l); } }
#endif
#if FAST_NSA
        __syncthreads();
        for (int rep_ = REP_NSA; rep_ >= 0; --rep_) for (int u = blockIdx.x; u < 512; u += gridDim.x) nsa_unit(lds, ws, u & 7, u < 256 ? 63 - (u >> 3) : (u >> 3) - 32, rep_ > 0);
#else
        __syncthreads();
        VRUN(64, 8 * 64, d_nsa_topk(vb, vt, (float (*)[65])(lds + (tid >> 6) * 64 * 65 * 4), ws));
        GSYNC();
        VRUN(64, 32 * 64, d_nsa_attn(vb, vt, (float (*)[65])(lds + (tid >> 6) * 64 * 65 * 4), ws));
#endif
#endif
        GSYNC();
#if DO_GATEBR
        for (int rep_ = 0; rep_ <= REP_GATEBR; ++rep_) {
        FAST_GEMM(EPI_GATE, (const bf16*)(ws + OFF_XB), (const bf16*)(ws + OFF_WMG), 1024, 1024, false);
        FAST_GEMM(EPI_BR0, (const bf16*)(ws + OFF_ZA), (const bf16*)(ws + OFF_WBR), 1024, 512, false);
        FAST_GEMM(EPI_GATE, (const bf16*)(ws + OFF_XB), (const bf16*)(ws + OFF_WMG) + (size_t)1024 * 1024, 1024, 1024, false);
        FAST_GEMM(EPI_BR1, (const bf16*)(ws + OFF_ZB), (const bf16*)(ws + OFF_WBR) + (size_t)1024 * 512, 1024, 512, false);
        FAST_GEMM(EPI_GATE, (const bf16*)(ws + OFF_XB), (const bf16*)(ws + OFF_WMG) + (size_t)2 * 1024 * 1024, 1024, 1024, false);
        FAST_GEMM(EPI_BR2, (const bf16*)(ws + OFF_ZC), (const bf16*)(ws + OFF_WBR) + (size_t)2 * 1024 * 512, 1024, 512, false);
        }
#endif
        GSYNC();
#if DO_OUT
        for (int rep_ = 0; rep_ <= (l == 0 ? REP_OUT : 0); ++rep_) FAST_GEMM(EPI_OUT, (const bf16*)(ws + OFF_MERGED), (const bf16*)(ws + OFF_WOUT) + (size_t)l * 1024 * 1024, 1024, 1024, false);
#endif
        GSYNC();
#if DO_PLE
        for (int rep_ = 0; rep_ <= REP_U; ++rep_) FAST_GEMM(EPI_U, (const bf16*)(ws + OFF_PB) + (size_t)l * M * 256, (const bf16*)(ws + OFF_WPL) + (size_t)l * 1024 * 256, 1024, 256, false);
        FAST_GEMM(EPI_PLE, (const bf16*)(ws + OFF_X1B), (const bf16*)(ws + OFF_WPG) + (size_t)l * 1024 * 1024, 1024, 1024, false);
#endif
        GSYNC();
#if DO_TAIL
        for (int rep_ = 0; rep_ < 10 * REP_SYNC; ++rep_) GSYNC();
        for (int rep_ = 0; rep_ <= REP_SUMSQ; ++rep_) { if (l + 1 < DEPTH) VRUN(256, M / 4, d_sumsq(vb, vt, X, ws)); }
#endif
    }
#if DO_TAIL
    VRUN(256, M / 4, d_final(vb, vt, X, final_g));
#endif
}

extern "C" void kernel_launch(void* const* d_in, const int* in_sizes, int n_in, void* d_out, int out_size, void* d_ws, size_t ws_size, hipStream_t stream) {
    static int grid_blocks = 0;
    if (grid_blocks == 0) {
        if (n_in != 23 || ws_size < WS_NEED || out_size != M * DM) { fprintf(stderr, "kernel_launch: unexpected sizes (n_in %d ws %zu out %d)\n", n_in, ws_size, out_size); grid_blocks = -1; return; }
        int dev = 0, cus = 0, per_cu = 0;
        (void)hipGetDevice(&dev); (void)hipDeviceGetAttribute(&cus, hipDeviceAttributeMultiprocessorCount, dev);
        (void)hipFuncSetAttribute((const void*)mega, hipFuncAttributeMaxDynamicSharedMemorySize, LDS_BYTES);
        (void)hipOccupancyMaxActiveBlocksPerMultiprocessor(&per_cu, (const void*)mega, NT, LDS_BYTES);
        if (per_cu < 1) { fprintf(stderr, "kernel_launch: occupancy query says %d blocks per CU\n", per_cu); grid_blocks = -1; return; }
        grid_blocks = cus * 1;
    }
    if (grid_blocks < 0) return;
    (void)hipMemsetAsync((char*)d_ws + OFF_CTL, 0, 262144, stream);
    KArgs a{};
    for (int i = 0; i < 23; ++i) a.in[i] = d_in[i];
    a.out = (float*)d_out; a.ws = (unsigned char*)d_ws;
    void* args[] = {&a};
    hipError_t e = hipLaunchCooperativeKernel((const void*)mega, dim3(grid_blocks), dim3(NT), args, LDS_BYTES, stream);
    if (e != hipSuccess) fprintf(stderr, "cooperative launch failed: %s (grid %d)\n", hipGetErrorString(e), grid_blocks);
}
```

```cpp
#include <hip/hip_runtime.h>
#include <hip/hip_cooperative_groups.h>
#include <cstdio>
#include <cstdint>

typedef unsigned short bf16;
typedef short bf16x8 __attribute__((ext_vector_type(8)));
typedef float f32x4 __attribute__((ext_vector_type(4)));
typedef float f32x16 __attribute__((ext_vector_type(16)));
typedef unsigned u32x4 __attribute__((ext_vector_type(4)));
typedef unsigned u32x2 __attribute__((ext_vector_type(2)));

constexpr int BATCH = 4, SEQ = 4096, DM = 1024, M = BATCH * SEQ, DEPTH = 2, NIN = 8992, NP = 6144;
constexpr float EPS = 1e-6f;
constexpr float LOG2E = 1.4426950408889634f;
constexpr float C2 = 0.125f * LOG2E;
constexpr size_t MiB = 1u << 20;
constexpr size_t OFF_CTL = 0;
constexpr size_t OFF_WIN = 1 * MiB, OFF_WMG = 13 * MiB, OFF_WBR = 19 * MiB, OFF_CW1 = 22 * MiB, OFF_CW2 = 24 * MiB, OFF_CB1 = 24 * MiB + 128 * 1024;
constexpr size_t OFF_WOUT = 25 * MiB, OFF_WPG = 29 * MiB, OFF_WPL = 33 * MiB;
constexpr size_t OFF_XB = 34 * MiB, OFF_ZA = 66 * MiB, OFF_ZB = 82 * MiB, OFF_ZC = 98 * MiB;
constexpr size_t OFF_COS = 114 * MiB, OFF_SIN = 116 * MiB, OFF_PB = 118 * MiB;
constexpr size_t OFF_LOGF = 134 * MiB, OFF_CF = 134 * MiB + 512 * 1024, OFF_GATES = 135 * MiB, OFF_SSP = 136 * MiB + 512 * 1024;
constexpr size_t OFF_KCMP = 136 * MiB + 768 * 1024, OFF_VCMP = 137 * MiB, OFF_SELM = 137 * MiB + 256 * 1024;
constexpr size_t OFF_QA = 139 * MiB, OFF_KA = 155 * MiB, OFF_VA = 171 * MiB, OFF_QB = 187 * MiB, OFF_QC = 203 * MiB, OFF_KC = 219 * MiB, OFF_VC = 235 * MiB;
constexpr size_t OFF_KCB = 251 * MiB, OFF_VCB = 255 * MiB, OFF_KSEL = 259 * MiB, OFF_KWIN = 263 * MiB, OFF_VSEL = 267 * MiB, OFF_VWIN = 271 * MiB;
constexpr size_t WS_NEED = 275 * MiB;
constexpr size_t OFF_G = 139 * MiB, OFF_MERGED = 171 * MiB, OFF_T = 203 * MiB, OFF_X1B = 203 * MiB, OFF_U = 139 * MiB;
constexpr int CTL_LAM = 64;

__device__ __forceinline__ bf16 f2bf(float f) { unsigned u = __float_as_uint(f); return (bf16)((u + 0x7fffu + ((u >> 16) & 1u)) >> 16); }
__device__ __forceinline__ float bf2f(bf16 h) { return __uint_as_float(((unsigned)h) << 16); }
__device__ __forceinline__ unsigned pk2(float lo, float hi) { return (unsigned)f2bf(lo) | ((unsigned)f2bf(hi) << 16); }
__device__ __forceinline__ float sigmoidf_(float x) { return 1.f / (1.f + __expf(-x)); }
__device__ __forceinline__ float siluf_(float x) { return x / (1.f + __expf(-x)); }
__device__ __forceinline__ float logsigmoidf_(float x) { return x >= 0.f ? -log1pf(expf(-x)) : x - log1pf(expf(x)); }

__device__ __forceinline__ int ktile_off(int s, int d) { return (s >> 6) * 4096 + (d >> 3) * 512 + (s & 63) * 8 + (d & 7); }
__device__ __forceinline__ int vtile_off(int s, int d) { return (s >> 6) * 4096 + (d >> 5) * 2048 + ((s & 63) >> 4) * 512 + (s & 15) * 32 + (d & 31); }
__device__ __forceinline__ int v128_off(int s, int d) { return (s >> 6) * 8192 + (d >> 5) * 2048 + ((s & 63) >> 4) * 512 + (s & 15) * 32 + (d & 31); }

template <int W> __device__ __forceinline__ void store_bf(bf16* dst, const float* v) {
    if constexpr (W == 4) { u32x2 o; o.x = pk2(v[0], v[1]); o.y = pk2(v[2], v[3]); *(u32x2*)dst = o; }
    else { u32x4 o; o.x = pk2(v[0], v[1]); o.y = pk2(v[2], v[3]); o.z = pk2(v[4], v[5]); o.w = pk2(v[6], v[7]); *(u32x4*)dst = o; }
}

__device__ __forceinline__ int win_srccol(int n) {
    const int seg = n >> 6, j = n & 63; const int il = ((j & 1) << 5) + (j >> 1);
    if (seg < 8) return 0 + n;
    if (seg < 16) return 512 + (n - 512);
    if (seg < 24) return 1024 + (n - 1024);
    if (seg < 32) return 1544 + (n - 1536);
    if (seg < 40) return 2056 + (seg - 32) * 64 + il;
    if (seg < 42) return 2568 + (n - 2560);
    if (seg < 44) return 2696 + (n - 2688);
    if (seg < 46) return 2824 + (seg - 44) * 64 + il;
    if (seg < 48) return 3080 + (seg - 46) * 64 + il;
    if (seg < 50) return 2952 + (n - 3072);
    if (seg < 52) return 3208 + (n - 3200);
    if (seg < 60) return 3360 + (n - 3328);
    if (seg < 68) return 3872 + (seg - 60) * 64 + il;
    if (seg < 76) return 4384 + (seg - 68) * 64 + il;
    if (seg < 84) return 4896 + (n - 4864);
    if (seg < 92) return 5408 + (n - 5376);
    if (seg == 92) { if (j < 8) return 1536 + j; if (j < 32) return 3336 + (j - 8); return -1; }
    return -1;
}

enum { EPI_INPROJ = 0, EPI_GATE = 1, EPI_BR0 = 2, EPI_BR1 = 3, EPI_BR2 = 4, EPI_OUT = 5, EPI_U = 6, EPI_PLE = 7 };
struct EpiCtx { unsigned char* ws; const float* bfg; const float* xin; float* X; int gi; };

__device__ __forceinline__ float row_rstd(const unsigned char* ws, int row) {
    const f32x4 sp = *(const f32x4*)(ws + OFF_SSP + (size_t)row * 16);
    return rsqrtf(((sp[0] + sp[1]) + (sp[2] + sp[3])) * (1.f / 1024.f) + EPS);
}
template <int W> __device__ __forceinline__ void rope_apply(const unsigned char* ws, int row, int d, float* v) {
    const float* cs = (const float*)(ws + OFF_COS) + (size_t)row * 32 + (d >> 1);
    const float* sn = (const float*)(ws + OFF_SIN) + (size_t)row * 32 + (d >> 1);
#pragma unroll
    for (int j = 0; j < W / 2; ++j) { const float c = cs[j], s = sn[j], x1 = v[2 * j], x2 = v[2 * j + 1]; v[2 * j] = x1 * c - x2 * s; v[2 * j + 1] = x2 * c + x1 * s; }
}

enum { T_QA = 0, T_KA, T_VA, T_ZA, T_QB, T_CB, T_KROPE, T_VSW, T_ZB, T_QC, T_KC, T_VC, T_ZC, T_SPECIAL };
__device__ __forceinline__ int inproj_type(int t) {
    return t < 2 ? T_QA : t < 4 ? T_KA : t < 6 ? T_VA : t < 8 ? T_ZA : t < 10 ? T_QB : t == 10 ? T_CB : t == 11 ? T_KROPE : t == 12 ? T_VSW : t < 15 ? T_ZB : t < 17 ? T_QC : t < 19 ? T_KC : t < 21 ? T_VC : t < 23 ? T_ZC : T_SPECIAL;
}
struct Pre { float rs; float a[8]; float b[8]; };
template <int KIND, int T> __device__ __forceinline__ void pre_load(const EpiCtx& E, int row, int col, Pre& p) {
    unsigned char* ws = E.ws; const size_t idx = (size_t)row * 1024 + col;
    if constexpr (KIND == EPI_INPROJ) {
        p.rs = row_rstd(ws, row);
        if constexpr (T == T_KROPE || T == T_QC || T == T_KC) { const int d = col & 63;
            const f32x4 c = *(const f32x4*)((const float*)(ws + OFF_COS) + (size_t)row * 32 + (d >> 1)), s = *(const f32x4*)((const float*)(ws + OFF_SIN) + (size_t)row * 32 + (d >> 1));
#pragma unroll
            for (int i = 0; i < 4; ++i) { p.a[i] = c[i]; p.b[i] = s[i]; } }
    } else if constexpr (KIND == EPI_GATE) { p.rs = row_rstd(ws, row);
    } else if constexpr (KIND == EPI_BR0 || KIND == EPI_BR1 || KIND == EPI_BR2) {
        const u32x4 g = *(const u32x4*)((const bf16*)(ws + OFF_G) + idx);
#pragma unroll
        for (int i = 0; i < 4; ++i) { p.a[2 * i] = __uint_as_float(g[i] << 16); p.a[2 * i + 1] = __uint_as_float(g[i] & 0xffff0000u); }
        if constexpr (KIND != EPI_BR0) { const float* T_ = (const float*)(ws + OFF_T) + idx; const f32x4 t0 = *(const f32x4*)T_, t1 = *(const f32x4*)(T_ + 4);
#pragma unroll
            for (int i = 0; i < 4; ++i) { p.b[i] = t0[i]; p.b[4 + i] = t1[i]; } }
    } else if constexpr (KIND == EPI_OUT) { const f32x4 t0 = *(const f32x4*)(E.xin + idx), t1 = *(const f32x4*)(E.xin + idx + 4);
#pragma unroll
        for (int i = 0; i < 4; ++i) { p.a[i] = t0[i]; p.a[4 + i] = t1[i]; }
    } else if constexpr (KIND == EPI_PLE) { const f32x4 t0 = *(const f32x4*)(E.X + idx), t1 = *(const f32x4*)(E.X + idx + 4); const float* U = (const float*)(ws + OFF_U) + idx; const f32x4 u0 = *(const f32x4*)U, u1 = *(const f32x4*)(U + 4);
#pragma unroll
        for (int i = 0; i < 4; ++i) { p.a[i] = t0[i]; p.a[4 + i] = t1[i]; p.b[i] = u0[i]; p.b[4 + i] = u1[i]; }
    }
}
__device__ __forceinline__ void st_f32x8(float* dst, const float* v) { f32x4 a = {v[0], v[1], v[2], v[3]}, b = {v[4], v[5], v[6], v[7]}; *(f32x4*)dst = a; *(f32x4*)(dst + 4) = b; }
template <int KIND, int T> __device__ __forceinline__ void emit_fin(const EpiCtx& E, int row, int col, const float* a, const Pre& p) {
    constexpr int W = 8;
    unsigned char* ws = E.ws; const size_t idx = (size_t)row * 1024 + col;
    float v[W];
    if constexpr (KIND == EPI_INPROJ) {
        const float rs = p.rs;
#pragma unroll
        for (int i = 0; i < W; ++i) v[i] = a[i] * rs;
        const int b = row >> 12, s = row & 4095;
        if constexpr (T == T_KROPE || T == T_QC || T == T_KC) {
#pragma unroll
            for (int j = 0; j < 4; ++j) { const float c = p.a[j], sn = p.b[j], x1 = v[2 * j], x2 = v[2 * j + 1]; v[2 * j] = x1 * c - x2 * sn; v[2 * j + 1] = x2 * c + x1 * sn; } }
        if constexpr (T == T_QA) { const int cc = col, h = cc >> 6, d = cc & 63;
#pragma unroll
            for (int i = 0; i < W; ++i) v[i] *= C2;
            store_bf<W>((bf16*)(ws + OFF_QA) + ((size_t)(b * 8 + h) * 4096 + s) * 64 + d, v);
        } else if constexpr (T == T_KA) { const int cc = col - 512, h = cc >> 6, d = cc & 63;
            store_bf<W>((bf16*)(ws + OFF_KA) + (size_t)(b * 8 + h) * 262144 + ktile_off(s, d), v);
        } else if constexpr (T == T_VA) { const int cc = col - 1024, h = cc >> 6, d = cc & 63;
            store_bf<W>((bf16*)(ws + OFF_VA) + (size_t)(b * 8 + h) * 262144 + vtile_off(s, d), v);
        } else if constexpr (T == T_ZA || T == T_ZB || T == T_ZC) { const int cc = col - (T == T_ZA ? 1536 : T == T_ZB ? 3328 : 5376);
#pragma unroll
            for (int i = 0; i < W; ++i) v[i] = siluf_(v[i]);
            store_bf<W>((bf16*)(ws + (T == T_ZA ? OFF_ZA : T == T_ZB ? OFF_ZB : OFF_ZC)) + (size_t)row * 512 + cc, v);
        } else if constexpr (T == T_QB) { const int cc = col - 2048, h = cc >> 6, d = cc & 63;
#pragma unroll
            for (int i = 0; i < W; ++i) v[i] *= C2;
            store_bf<W>((bf16*)(ws + OFF_QB) + ((size_t)(b * 8 + h) * 4096 + s) * 64 + d, v);
        } else if constexpr (T == T_CB) { const int cc = col - 2560, g = (cc >> 6) & 1, d = cc & 63;
            store_bf<W>((bf16*)(ws + (cc < 128 ? OFF_KCB : OFF_VCB)) + ((size_t)(b * 2 + g) * 4096 + s) * 64 + d, v);
        } else if constexpr (T == T_KROPE) { const int cc = col - 2816, g = (cc >> 6) & 1, d = cc & 63;
            store_bf<W>((bf16*)(ws + (cc < 128 ? OFF_KSEL : OFF_KWIN)) + (size_t)(b * 2 + g) * 262144 + ktile_off(s, d), v);
        } else if constexpr (T == T_VSW) { const int cc = col - 3072, g = (cc >> 6) & 1, d = cc & 63;
            store_bf<W>((bf16*)(ws + (cc < 128 ? OFF_VSEL : OFF_VWIN)) + (size_t)(b * 2 + g) * 262144 + vtile_off(s, d), v);
        } else if constexpr (T == T_QC) { const int cc = col - 3840, h = cc >> 6, d = cc & 63;
#pragma unroll
            for (int i = 0; i < W; ++i) v[i] *= C2;
            store_bf<W>((bf16*)(ws + OFF_QC) + ((size_t)(b * 8 + h) * 4096 + s) * 64 + d, v);
        } else if constexpr (T == T_KC) { const int cc = col - 4352, h = cc >> 6, d = cc & 63;
            store_bf<W>((bf16*)(ws + OFF_KC) + (size_t)(b * 8 + h) * 262144 + ktile_off(s, d), v);
        } else if constexpr (T == T_VC) { const int cc = col - 4864, hc = cc >> 7, d = cc & 127;
            store_bf<W>((bf16*)(ws + OFF_VC) + (size_t)(b * 4 + hc) * 524288 + v128_off(s, d), v);
        } else { const int cc = col - 5888;
            if (cc < 8) { float* o = (float*)(ws + OFF_LOGF) + (size_t)row * 8 + cc;
#pragma unroll
                for (int i = 0; i < W; ++i) o[i] = logsigmoidf_(v[i] + E.bfg[cc + i]) * LOG2E;
            } else if (cc < 32) { float* o = (float*)(ws + OFF_GATES) + (size_t)row * 24 + (cc - 8);
#pragma unroll
                for (int i = 0; i < W; ++i) o[i] = sigmoidf_(v[i]);
            }
        }
    } else if constexpr (KIND == EPI_GATE) {
#pragma unroll
        for (int i = 0; i < W; ++i) v[i] = sigmoidf_(a[i] * p.rs);
        store_bf<W>((bf16*)(ws + OFF_G) + idx, v);
    } else if constexpr (KIND == EPI_BR0 || KIND == EPI_BR1 || KIND == EPI_BR2) {
#pragma unroll
        for (int i = 0; i < W; ++i) { v[i] = p.a[i] * a[i]; if (KIND != EPI_BR0) v[i] += p.b[i]; }
        if constexpr (KIND == EPI_BR2) store_bf<W>((bf16*)(ws + OFF_MERGED) + idx, v);
        else st_f32x8((float*)(ws + OFF_T) + idx, v);
    } else if constexpr (KIND == EPI_OUT) {
#pragma unroll
        for (int i = 0; i < W; ++i) v[i] = p.a[i] + a[i];
        st_f32x8(E.X + idx, v);
        store_bf<W>((bf16*)(ws + OFF_X1B) + idx, v);
    } else if constexpr (KIND == EPI_U) {
        st_f32x8((float*)(ws + OFF_U) + idx, a);
    } else if constexpr (KIND == EPI_PLE) {
#pragma unroll
        for (int i = 0; i < W; ++i) v[i] = p.a[i] + sigmoidf_(a[i]) * p.b[i];
        st_f32x8(E.X + idx, v);
        store_bf<W>((bf16*)(ws + OFF_XB) + idx, v);
    }
}

template <int MODE> __device__ __forceinline__ void d_convT(bool active, int bx, int by, int vt, float (*tile)[65], const float* src, int ld, int K, bf16* dst, const float* kscale) {
    const int n0 = bx * 64, k0 = by * 64, tx = vt & 63, ty = vt >> 6;
    const int n = n0 + tx;
    int sc;
    if (MODE == 0) sc = n; else if (MODE == 1) sc = win_srccol(n); else sc = (n & ~63) + ((n & 1) << 5) + ((n & 63) >> 1);
    if (active) {
#pragma unroll 4
        for (int i = 0; i < 16; ++i) { const int kk = 4 * i + ty; float v = 0.f; if (sc >= 0) { v = src[(size_t)(k0 + kk) * ld + sc]; if (kscale) v *= kscale[k0 + kk]; } tile[tx][kk] = v; }
    }
    __syncthreads();
    if (active) {
#pragma unroll
        for (int p = 0; p < 2; ++p) { const int it = vt + 256 * p, r = it >> 3, c = it & 7; const float* t = &tile[r][8 * c];
            u32x4 o; o.x = pk2(t[0], t[1]); o.y = pk2(t[2], t[3]); o.z = pk2(t[4], t[5]); o.w = pk2(t[6], t[7]);
            *(u32x4*)(dst + (size_t)(n0 + r) * K + k0 + 8 * c) = o; }
    }
    __syncthreads();
}
__device__ __forceinline__ void d_xprep(int vb, int vt, const float* x, unsigned char* ws) {
    const int row = vb * 4 + (vt >> 6), lane = vt & 63;
    const f32x4* xr = (const f32x4*)(x + (size_t)row * 1024) + lane; float ss = 0.f;
    bf16* o = (bf16*)(ws + OFF_XB) + (size_t)row * 1024;
#pragma unroll
    for (int j = 0; j < 4; ++j) { const f32x4 v = xr[64 * j]; ss += (v[0] * v[0] + v[1] * v[1]) + (v[2] * v[2] + v[3] * v[3]); float t[4] = {v[0], v[1], v[2], v[3]}; store_bf<4>(o + 256 * j + 4 * lane, t); }
#pragma unroll
    for (int of = 1; of < 64; of <<= 1) ss += __shfl_xor(ss, of);
    if (lane == 0) { f32x4 s = {ss, 0.f, 0.f, 0.f}; *(f32x4*)(ws + OFF_SSP + (size_t)row * 16) = s; }
}
__device__ __forceinline__ void d_sumsq(int vb, int vt, const float* x, unsigned char* ws) {
    const int row = vb * 4 + (vt >> 6), lane = vt & 63;
    const f32x4* xr = (const f32x4*)(x + (size_t)row * 1024) + lane; float ss = 0.f;
#pragma unroll
    for (int j = 0; j < 4; ++j) { const f32x4 v = xr[64 * j]; ss += (v[0] * v[0] + v[1] * v[1]) + (v[2] * v[2] + v[3] * v[3]); }
#pragma unroll
    for (int of = 1; of < 64; of <<= 1) ss += __shfl_xor(ss, of);
    if (lane == 0) { f32x4 s = {ss, 0.f, 0.f, 0.f}; *(f32x4*)(ws + OFF_SSP + (size_t)row * 16) = s; }
}
__device__ __forceinline__ void d_rope_table(int vb, int vt, const int* pos, unsigned char* ws) {
    const int idx = vb * 256 + vt, row = idx >> 5, i = idx & 31;
    const float inv = exp2f(-(float)i * (13.287712379549449f / 32.f));
    const float ang = (float)pos[row] * inv;
    float s, c; sincosf(ang, &s, &c);
    ((float*)(ws + OFF_COS))[idx] = c; ((float*)(ws + OFF_SIN))[idx] = s;
}
__device__ __forceinline__ void d_pconv(int vb, int vt, const float* p, unsigned char* ws) {
    const size_t i = ((size_t)vb * 256 + vt) * 4;
    const f32x4 v = *(const f32x4*)(p + i); float t[4] = {v[0], v[1], v[2], v[3]}; store_bf<4>((bf16*)(ws + OFF_PB) + i, t);
}
constexpr size_t OFF_CBPART = OFF_CTL + 65536;
__device__ __forceinline__ void d_cb1_part(int u, int vt, const float* pe_k, const float* w1_k, const float* pe_v, const float* w1_v, unsigned char* ws) {
    const int kv = u >> 4, kc = u & 15, j = vt;
    const float* pe = (kv ? pe_v : pe_k) + 128 * kc; const float* w1 = (kv ? w1_v : w1_k) + (size_t)(128 * kc) * 256 + j;
    float acc = 0.f;
#pragma unroll 16
    for (int k = 0; k < 128; ++k) acc += pe[k] * w1[(size_t)k * 256];
    ((float*)(ws + OFF_CBPART))[(kv * 16 + kc) * 256 + j] = acc;
}
__device__ __forceinline__ void d_cb1_sum(int vt, const float* b1_k, const float* b1_v, unsigned char* ws) {
    const int kv = vt >> 8, j = vt & 255; float acc = (kv ? b1_v : b1_k)[j];
#pragma unroll
    for (int kc = 0; kc < 16; ++kc) acc += ((const float*)(ws + OFF_CBPART))[(kv * 16 + kc) * 256 + j];
    ((float*)(ws + OFF_CB1))[kv * 256 + j] = acc;
}
__device__ __forceinline__ void d_lam(int vt, const float* dl, unsigned char* ws, int l) {
    if (vt == 0) { float s1 = 0.f, s2 = 0.f; for (int i = 0; i < 64; ++i) { s1 += dl[i] * dl[64 + i]; s2 += dl[128 + i] * dl[192 + i]; }
        const float li = 0.8f - 0.6f * expf(-0.3f * (float)l); ((float*)(ws + OFF_CTL))[CTL_LAM + l] = expf(s1) - expf(s2) + li; }
}
__device__ __forceinline__ void d_cumsum(int vb, int vt, unsigned char* ws) {
    const int bh = vb, b = bh >> 3, h = bh & 7, lane = vt;
    const float* lf = (const float*)(ws + OFF_LOGF) + ((size_t)(b * 4096 + 64 * lane)) * 8 + h;
    float s = 0.f;
    for (int i = 0; i < 64; ++i) s += lf[i * 8];
    float incl = s;
#pragma unroll
    for (int of = 1; of < 64; of <<= 1) { const float t = __shfl_up(incl, of); if (lane >= of) incl += t; }
    float run = incl - s;
    float* cf = (float*)(ws + OFF_CF) + (size_t)bh * 4096 + 64 * lane;
    for (int i = 0; i < 64; ++i) { run += lf[i * 8]; cf[i] = run; }
}
__device__ __forceinline__ void d_compress(bool active, int vb, int vt, float* hid, unsigned char* ws) {
    const int c = vb & 255, bg = (vb >> 8) & 7, kv = vb >> 11, j = vt;
    bf16* dstK = (bf16*)(ws + OFF_KCMP) + (size_t)bg * 16384; bf16* dstV = (bf16*)(ws + OFF_VCMP) + (size_t)bg * 16384;
    const bool pad = (c == 255);
    if (active && pad) { if (j < 64) { if (kv == 0) dstK[ktile_off(c, j)] = 0; else dstV[vtile_off(c, j)] = 0; } }
    if (active && !pad) {
        const bf16* src = (const bf16*)(ws + (kv ? OFF_VCB : OFF_KCB)) + ((size_t)bg * 4096 + 16 * c) * 64;
        const bf16* w = (const bf16*)(ws + OFF_CW1) + (size_t)(kv * 256 + j) * 2048;
        float acc = ((const float*)(ws + OFF_CB1))[kv * 256 + j];
        for (int k = 0; k < 2048; k += 8) { const bf16x8 a = *(const bf16x8*)(src + k), bb = *(const bf16x8*)(w + k);
#pragma unroll
            for (int i = 0; i < 8; ++i) acc += bf2f((bf16)a[i]) * bf2f((bf16)bb[i]); }
        hid[j] = bf2f(f2bf(siluf_(acc)));
    }
    __syncthreads();
    if (active && !pad && j < 64) { const bf16* w2 = (const bf16*)(ws + OFF_CW2) + (size_t)(kv * 64 + j) * 256; float o = 0.f;
        for (int k = 0; k < 256; ++k) o += hid[k] * bf2f(w2[k]);
        if (kv == 0) dstK[ktile_off(c, j)] = f2bf(o); else dstV[vtile_off(c, j)] = f2bf(o); }
    __syncthreads();
}
__device__ __forceinline__ void d_fox(int vb, int vt, unsigned char* ws) {
    const int bh = (vb & 31), b = bh >> 3, h = bh & 7, t = (vb >> 5) * 64 + vt, tmax = (vb >> 5) * 64 + 63;
    const bf16* Q = (const bf16*)(ws + OFF_QA) + ((size_t)bh * 4096 + t) * 64;
    const bf16* Kb = (const bf16*)(ws + OFF_KA) + (size_t)bh * 262144; const bf16* Vb = (const bf16*)(ws + OFF_VA) + (size_t)bh * 262144;
    const float* cf = (const float*)(ws + OFF_CF) + (size_t)bh * 4096;
    float q[64], o[64];
#pragma unroll
    for (int d = 0; d < 64; ++d) { q[d] = bf2f(Q[d]); o[d] = 0.f; }
    const float ci = cf[t]; float m = -1e30f, l = 0.f;
    for (int j = 0; j <= tmax; ++j) {
        float s = 0.f;
#pragma unroll
        for (int d = 0; d < 64; ++d) s += q[d] * bf2f(Kb[ktile_off(j, d)]);
        s += ci - cf[j];
        if (j <= t) { const float mn = fmaxf(m, s), al = exp2f(m - mn), p = exp2f(s - mn); l = l * al + p; m = mn;
#pragma unroll
            for (int d = 0; d < 64; ++d) o[d] = o[d] * al + p * bf2f(Vb[vtile_off(j, d)]); }
    }
    const float il = 1.f / l; bf16* Y = (bf16*)(ws + OFF_ZA) + (size_t)(b * 4096 + t) * 512 + h * 64;
#pragma unroll
    for (int d = 0; d < 64; ++d) Y[d] = f2bf(o[d] * il * bf2f(Y[d]));
}
__device__ __forceinline__ void d_diff(int vb, int vt, float (*res)[129], unsigned char* ws, const float* subg, int l) {
    const int bhc = (vb & 15), b = bhc >> 2, hc = bhc & 3, t = (vb >> 4) * 64 + vt, tmax = (vb >> 4) * 64 + 63;
    const float lam = ((const float*)(ws + OFF_CTL))[CTL_LAM + l], lam_init = 0.8f - 0.6f * expf(-0.3f * (float)l);
    const bf16* Vb = (const bf16*)(ws + OFF_VC) + (size_t)bhc * 524288;
    for (int dh = 0; dh < 2; ++dh) {
        for (int mp = 0; mp < 2; ++mp) {
            const int hh = b * 8 + hc * 2 + mp;
            const bf16* Q = (const bf16*)(ws + OFF_QC) + ((size_t)hh * 4096 + t) * 64; const bf16* Kb = (const bf16*)(ws + OFF_KC) + (size_t)hh * 262144;
            float q[64], o[64];
#pragma unroll
            for (int d = 0; d < 64; ++d) { q[d] = bf2f(Q[d]); o[d] = 0.f; }
            float m = -1e30f, ls = 0.f;
            for (int j = 0; j <= tmax; ++j) {
                float s = 0.f;
#pragma unroll
                for (int d = 0; d < 64; ++d) s += q[d] * bf2f(Kb[ktile_off(j, d)]);
                if (j <= t) { const float mn = fmaxf(m, s), al = exp2f(m - mn), p = exp2f(s - mn); ls = ls * al + p; m = mn;
#pragma unroll
                    for (int d = 0; d < 64; ++d) o[d] = o[d] * al + p * bf2f(Vb[v128_off(j, dh * 64 + d)]); }
            }
            const float il = 1.f / ls;
#pragma unroll
            for (int d = 0; d < 64; ++d) { if (mp == 0) res[vt][dh * 64 + d] = o[d] * il; else res[vt][dh * 64 + d] -= lam * o[d] * il; }
        }
    }
    float ss = 0.f;
    for (int d = 0; d < 128; ++d) { const float v = res[vt][d]; ss += v * v; }
    const float rs = rsqrtf(ss * (1.f / 128.f) + EPS) * (1.f - lam_init);
    bf16* Y = (bf16*)(ws + OFF_ZC) + (size_t)(b * 4096 + t) * 512 + hc * 128;
    for (int d = 0; d < 128; ++d) Y[d] = f2bf(res[vt][d] * rs * subg[d] * bf2f(Y[d]));
}
__device__ __forceinline__ void d_nsa_topk(int vb, int vt, float (*imp)[65], unsigned char* ws) {
    const int bg = (vb & 7), b = bg >> 1, g = bg & 1, tb = (vb >> 3), t = tb * 64 + vt;
    for (int j = 0; j < 64; ++j) imp[vt][j] = 0.f;
    const int nv = (t >= 31) ? ((t - 31) >> 4) + 1 : 0, nvmax = ((tb * 64 + 63 - 31) >> 4) + 1;
    const bf16* Kc = (const bf16*)(ws + OFF_KCMP) + (size_t)bg * 16384;
    for (int hq = 0; hq < 4; ++hq) {
        const int h = g * 4 + hq;
        const bf16* Q = (const bf16*)(ws + OFF_QB) + ((size_t)(b * 8 + h) * 4096 + t) * 64;
        float q[64];
#pragma unroll
        for (int d = 0; d < 64; ++d) q[d] = bf2f(Q[d]);
        float m = -1e30f, ls = 0.f;
        for (int c = 0; c < nvmax; ++c) { float s = 0.f;
#pragma unroll
            for (int d = 0; d < 64; ++d) s += q[d] * bf2f(Kc[ktile_off(c, d)]);
            if (c < nv) { const float mn = fmaxf(m, s); ls = ls * exp2f(m - mn) + exp2f(s - mn); m = mn; } }
        const float il = nv > 0 ? 1.f / ls : 0.f;
        for (int c = 0; c < nvmax; ++c) { float s = 0.f;
#pragma unroll
            for (int d = 0; d < 64; ++d) s += q[d] * bf2f(Kc[ktile_off(c, d)]);
            if (c < nv) { const float p = exp2f(s - m) * il; imp[vt][c >> 2] += p; if ((c & 3) == 3 && (c >> 2) + 1 < 64) imp[vt][(c >> 2) + 1] += p; } }
    }
    for (int j = 0; j < 64; ++j) { const bool forced = (j == 0) || (j == tb) || (j == tb - 1), valid = j <= tb; const float v = imp[vt][j];
        imp[vt][j] = forced ? 1e30f : (valid ? v : -1e30f); }
    unsigned long long mask = 0ull;
    for (int j = 0; j < 64; ++j) { const float sj = imp[vt][j]; int rank = 0;
        for (int k = 0; k < 64; ++k) { const float sk = imp[vt][k]; rank += (sk > sj || (sk == sj && k < j)) ? 1 : 0; }
        if (rank < 16) mask |= (1ull << j); }
    ((unsigned long long*)(ws + OFF_SELM))[(size_t)bg * 4096 + t] = mask;
}
__device__ __forceinline__ void d_nsa_attn(int vb, int vt, float (*yl)[65], unsigned char* ws) {
    const int bh = (vb & 31), b = bh >> 3, h = bh & 7, g = h >> 2, bg = b * 2 + g, tb = (vb >> 5), t = tb * 64 + vt, row = b * 4096 + t;
    const bf16* Q = (const bf16*)(ws + OFF_QB) + ((size_t)bh * 4096 + t) * 64;
    float q[64], o[64];
#pragma unroll
    for (int d = 0; d < 64; ++d) { q[d] = bf2f(Q[d]); yl[vt][d] = 0.f; }
    const float* gt = (const float*)(ws + OFF_GATES) + (size_t)row * 24 + h * 3;
    const float g0 = gt[0], g1 = gt[1], g2 = gt[2];
    { const int nv = (t >= 31) ? ((t - 31) >> 4) + 1 : 0, nvmax = ((tb * 64 + 63 - 31) >> 4) + 1;
      const bf16* Kc = (const bf16*)(ws + OFF_KCMP) + (size_t)bg * 16384; const bf16* Vc = (const bf16*)(ws + OFF_VCMP) + (size_t)bg * 16384;
      float m = -1e30f, ls = 0.f;
#pragma unroll
      for (int d = 0; d < 64; ++d) o[d] = 0.f;
      for (int c = 0; c < nvmax; ++c) { float s = 0.f;
#pragma unroll
          for (int d = 0; d < 64; ++d) s += q[d] * bf2f(Kc[ktile_off(c, d)]);
          if (c < nv) { const float mn = fmaxf(m, s), al = exp2f(m - mn), p = exp2f(s - mn); ls = ls * al + p; m = mn;
#pragma unroll
              for (int d = 0; d < 64; ++d) o[d] = o[d] * al + p * bf2f(Vc[vtile_off(c, d)]); } }
      const float il = nv > 0 ? g0 / ls : 0.f;
#pragma unroll
      for (int d = 0; d < 64; ++d) yl[vt][d] += o[d] * il; }
    { const float* cs = (const float*)(ws + OFF_COS) + (size_t)row * 32; const float* sn = (const float*)(ws + OFF_SIN) + (size_t)row * 32;
#pragma unroll
      for (int i = 0; i < 32; ++i) { const float c = cs[i], s = sn[i], x1 = q[2 * i], x2 = q[2 * i + 1]; q[2 * i] = bf2f(f2bf(x1 * c - x2 * s)); q[2 * i + 1] = bf2f(f2bf(x2 * c + x1 * s)); } }
    { const unsigned long long mask = ((const unsigned long long*)(ws + OFF_SELM))[(size_t)bg * 4096 + t];
      const bf16* Kb = (const bf16*)(ws + OFF_KSEL) + (size_t)bg * 262144; const bf16* Vb = (const bf16*)(ws + OFF_VSEL) + (size_t)bg * 262144;
      float m = -1e30f, ls = 0.f;
#pragma unroll
      for (int d = 0; d < 64; ++d) o[d] = 0.f;
      for (int j = 0; j <= tb; ++j) { const bool sel = (mask >> j) & 1ull;
          for (int kk = 0; kk < 64; ++kk) { const int kp = j * 64 + kk; float s = 0.f;
#pragma unroll
              for (int d = 0; d < 64; ++d) s += q[d] * bf2f(Kb[ktile_off(kp, d)]);
              if (sel && kp <= t) { const float mn = fmaxf(m, s), al = exp2f(m - mn), p = exp2f(s - mn); ls = ls * al + p; m = mn;
#pragma unroll
                  for (int d = 0; d < 64; ++d) o[d] = o[d] * al + p * bf2f(Vb[vtile_off(kp, d)]); } } }
      const float il = g1 / ls;
#pragma unroll
      for (int d = 0; d < 64; ++d) yl[vt][d] += o[d] * il; }
    { const bf16* Kb = (const bf16*)(ws + OFF_KWIN) + (size_t)bg * 262144; const bf16* Vb = (const bf16*)(ws + OFF_VWIN) + (size_t)bg * 262144;
      float m = -1e30f, ls = 0.f;
#pragma unroll
      for (int d = 0; d < 64; ++d) o[d] = 0.f;
      const int k_lo = max(0, tb * 64 - 511), k_hi = tb * 64 + 63;
      for (int kp = k_lo; kp <= k_hi; ++kp) { float s = 0.f;
#pragma unroll
          for (int d = 0; d < 64; ++d) s += q[d] * bf2f(Kb[ktile_off(kp, d)]);
          if (kp <= t && kp > t - 512) { const float mn = fmaxf(m, s), al = exp2f(m - mn), p = exp2f(s - mn); ls = ls * al + p; m = mn;
#pragma unroll
              for (int d = 0; d < 64; ++d) o[d] = o[d] * al + p * bf2f(Vb[vtile_off(kp, d)]); } }
      const float il = g2 / ls;
#pragma unroll
      for (int d = 0; d < 64; ++d) yl[vt][d] += o[d] * il; }
    bf16* Y = (bf16*)(ws + OFF_ZB) + (size_t)row * 512 + h * 64;
#pragma unroll
    for (int d = 0; d < 64; ++d) Y[d] = f2bf(yl[vt][d] * bf2f(Y[d]));
}
__device__ __forceinline__ void d_final(int vb, int vt, float* X, const float* g) {
    const int row = vb * 4 + (vt >> 6), lane = vt & 63;
    f32x4* xr = (f32x4*)(X + (size_t)row * 1024) + lane; f32x4 v[4]; float ss = 0.f;
#pragma unroll
    for (int j = 0; j < 4; ++j) { v[j] = xr[64 * j]; ss += (v[j][0] * v[j][0] + v[j][1] * v[j][1]) + (v[j][2] * v[j][2] + v[j][3] * v[j][3]); }
#pragma unroll
    for (int of = 1; of < 64; of <<= 1) ss += __shfl_xor(ss, of);
    const float rs = rsqrtf(ss * (1.f / 1024.f) + EPS);
#pragma unroll
    for (int j = 0; j < 4; ++j) { const f32x4 gg = *((const f32x4*)g + 64 * j + lane); xr[64 * j] = v[j] * rs * gg; }
}


namespace pg8 {
#define PG8_LAS __attribute__((address_space(3)))
typedef unsigned short bf16_t;
typedef short bf16x8 __attribute__((ext_vector_type(8)));
typedef float f32x4 __attribute__((ext_vector_type(4)));
typedef unsigned u32x4 __attribute__((ext_vector_type(4)));
constexpr int BM = 256, BK = 64, HALF = 128, HTB = HALF * BK * 2  , STAGE_BYTES = 8 * HTB, NXCD = 8, WGM = 8;

__host__ __device__ __forceinline__ int lds_byte(int r, int c) { const int st = (r >> 4) * 2 + (c >> 5), rr = r & 15, cc = c & 31, ob = rr * 64 + cc * 2; return st * 1024 + (ob ^ (((ob >> 9) & 1) << 5)); }
__host__ __device__ __forceinline__ void stage_rc(int b, int& R, int& C) { const int st = b / 1024, sb = b % 1024, swz = sb ^ (((sb >> 9) & 1) << 5); R = (st >> 1) * 16 + swz / 64; C = (st & 1) * 32 + (swz % 64) / 2; }
__host__ __device__ __forceinline__ int perm32(int rho) { const int n = rho >> 4, i = rho & 15; return 8 * (i >> 2) + 4 * n + (i & 3); }

struct Unit { int pm, pn; };
struct Gemm { const bf16_t* A; const bf16_t* Bt; int M, N, K; };

struct StaticOrder {
    int nM, nN, nwg, G, c;
    __host__ __device__ void init(int M, int N, int G_, int c_) { nM = M / BM; nN = N / BM; nwg = nM * nN; G = G_; c = c_; }
    __host__ __device__ bool next(int i, Unit& u) const {
        const long L = (long)i * G + c; if (L >= nwg) return false;
        int wgid = (int)L; { const int q = nwg / NXCD, r = nwg % NXCD, xcd = wgid % NXCD, off = wgid / NXCD; wgid = (xcd < r ? xcd * (q + 1) : r * (q + 1) + (xcd - r) * q) + off; }
        const int nig = WGM * nN, gid = wgid / nig, fm = gid * WGM, gsz = (nM - fm) < WGM ? (nM - fm) : WGM;
        u.pm = fm + ((wgid % nig) % gsz); u.pn = (wgid % nig) / gsz; return true;
    }
    __device__ __forceinline__ void a_ready(const Unit&) const {}
    __device__ __forceinline__ void done(const Unit&) const {}
};

__device__ __forceinline__ unsigned cvt_pk_bf16(float lo, float hi) { unsigned r; asm volatile("v_cvt_pk_bf16_f32 %0, %1, %2" : "=v"(r) : "v"(lo), "v"(hi)); return r; }
typedef float f32x2 __attribute__((ext_vector_type(2)));
template <class Epi, class Sched, bool ALIGN_EPI = false, bool SP2 = false>
__device__ __forceinline__ void gemm_phase(PG8_LAS unsigned char* lds, const Gemm g, const Sched& S, const Epi& E) {
    int tid_o = threadIdx.x; asm volatile("" : "+v"(tid_o));
    const int tid = tid_o, wid = __builtin_amdgcn_readfirstlane(tid >> 6), lane = tid & 63, wr = wid >> 2, wc = wid & 3, fr = lane & 15, fq = lane >> 4;
    const int K = g.K, nt = K / BK;
    unsigned voffA[2], voffB[2];
#pragma unroll
    for (int i = 0; i < 2; ++i) { int R, C; stage_rc(tid * 16 + i * 8192, R, C); const int Rb = Epi::PERM ? ((R & ~31) + perm32(R & 31)) : R;
        voffA[i] = (unsigned)(R * K + C) * 2u; voffB[i] = (unsigned)(Rb * K + C) * 2u; }
    const size_t kstep = (size_t)(BK * 2);
    const size_t hstep = (size_t)HALF * K * 2;
    const size_t tstep = 2 * hstep;
    const unsigned ldsw = (unsigned)wid * 1024u;
    const int aoff = lds_byte(wr * 64 + fr, fq * 8), boff = lds_byte(wc * 32 + fr, fq * 8);
#define PG8_SA(b, h) (((b) * 2 + (h)) * HTB)
#define PG8_SB(b, h) ((4 + (b) * 2 + (h)) * HTB)
#define PG8_STAGE(bufoff, gbase, voff) do { _Pragma("unroll") for (int _i = 0; _i < 2; ++_i) \
        __builtin_amdgcn_global_load_lds((const unsigned*)((const char*)(gbase) + (voff)[_i]), (PG8_LAS unsigned*)(lds + (bufoff) + ldsw + _i * 8192), 16, 0, 0); } while (0)
#define PG8_LDA(dst, b, h) do { _Pragma("unroll") for (int m = 0; m < 4; ++m) _Pragma("unroll") for (int k = 0; k < 2; ++k) dst[m][k] = *(const PG8_LAS bf16x8*)(lds + PG8_SA(b, h) + aoff + m * 2048 + k * 1024); } while (0)
#define PG8_LDB(dst, b, h) do { _Pragma("unroll") for (int n = 0; n < 2; ++n) _Pragma("unroll") for (int k = 0; k < 2; ++k) dst[n][k] = *(const PG8_LAS bf16x8*)(lds + PG8_SB(b, h) + boff + n * 2048 + k * 1024); } while (0)
#define PG8_MMA(ai, bj, At, Bt) do { __builtin_amdgcn_s_setprio(1); _Pragma("unroll") for (int m = 0; m < 4; ++m) _Pragma("unroll") for (int n = 0; n < 2; ++n) _Pragma("unroll") for (int k = 0; k < 2; ++k) \
        acc[ai][bj][m][n] = __builtin_amdgcn_mfma_f32_16x16x32_bf16(Bt[n][k], At[m][k], acc[ai][bj][m][n], 0, 0, 0); __builtin_amdgcn_s_setprio(0); } while (0)
#define PG8_WAIT_V(n) asm volatile("s_waitcnt vmcnt(" #n ")" ::: "memory")
#define PG8_WAIT_L(n) asm volatile("s_waitcnt lgkmcnt(" #n ")" ::: "memory")
#define PG8_BAR __builtin_amdgcn_s_barrier()
#define PG8_SCHED __builtin_amdgcn_sched_barrier(0)
    Unit cur, nxt; int ui = 0;
    if (!S.next(0, cur)) return;
    f32x4 acc[2][2][4][2];
#pragma unroll
    for (int a = 0; a < 2; ++a)
#pragma unroll
        for (int b = 0; b < 2; ++b)
#pragma unroll
            for (int m = 0; m < 4; ++m)
#pragma unroll
                for (int n = 0; n < 2; ++n) acc[a][b][m][n] = (f32x4){0.f, 0.f, 0.f, 0.f};
    bf16x8 At[4][2], B0[2][2], B1[2][2];
    const char* cA = (const char*)g.A + (size_t)cur.pm * tstep; const char* cB = (const char*)g.Bt + (size_t)cur.pn * tstep;
    S.a_ready(cur);
    if constexpr (SP2) {
        PG8_STAGE(PG8_SB(0, 0), cB, voffB); PG8_STAGE(PG8_SB(0, 1), cB + hstep, voffB); PG8_STAGE(PG8_SA(0, 0), cA, voffA); PG8_STAGE(PG8_SA(0, 1), cA + hstep, voffA);
        if (wr == 1) PG8_BAR;
        PG8_WAIT_V(2); PG8_BAR;
        PG8_STAGE(PG8_SB(1, 0), cB + kstep, voffB); PG8_STAGE(PG8_SA(1, 0), cA + kstep, voffA); PG8_STAGE(PG8_SB(1, 1), cB + hstep + kstep, voffB);
        PG8_WAIT_V(6); PG8_BAR;
    } else {
        PG8_STAGE(PG8_SB(0, 0), cB, voffB); PG8_STAGE(PG8_SA(0, 0), cA, voffA); PG8_STAGE(PG8_SB(0, 1), cB + hstep, voffB); PG8_STAGE(PG8_SA(0, 1), cA + hstep, voffA);
        if (wr == 1) PG8_BAR;
        PG8_WAIT_V(4); PG8_BAR;
        PG8_STAGE(PG8_SB(1, 0), cB + kstep, voffB); PG8_STAGE(PG8_SA(1, 0), cA + kstep, voffA); PG8_STAGE(PG8_SB(1, 1), cB + hstep + kstep, voffB);
        PG8_WAIT_V(6); PG8_BAR;
    }
    for (;;) {
        const bool has_next = S.next(ui + 1, nxt);
        const char* nA = has_next ? (const char*)g.A + (size_t)nxt.pm * tstep : cA; const char* nB = has_next ? (const char*)g.Bt + (size_t)nxt.pn * tstep : cB;
        for (int t = 0; t < nt; t += 2) {
            const bool last = (t == nt - 2);
            const char* a1 = cA + (size_t)(t + 1) * kstep;
            const char* a2 = last ? nA : cA + (size_t)(t + 2) * kstep; const char* b2 = last ? nB : cB + (size_t)(t + 2) * kstep;
            const char* a3 = a2 + kstep; const char* b3 = b2 + kstep;
            if (last && has_next) S.a_ready(nxt);
            if constexpr (SP2) {
            PG8_LDB(B0, 0, 0); PG8_LDB(B1, 0, 1); PG8_SCHED; PG8_LDA(At, 0, 0); PG8_STAGE(PG8_SA(1, 1), a1 + hstep, voffA);
            PG8_WAIT_V(8); PG8_WAIT_L(0); PG8_BAR; PG8_MMA(0, 0, At, B0); PG8_MMA(0, 1, At, B1); PG8_BAR; PG8_SCHED;
            PG8_LDA(At, 0, 1); PG8_STAGE(PG8_SB(0, 0), b2, voffB); PG8_STAGE(PG8_SB(0, 1), b2 + hstep, voffB); PG8_STAGE(PG8_SA(0, 0), a2, voffA);
            PG8_WAIT_V(8); PG8_WAIT_L(0); PG8_BAR; PG8_MMA(1, 0, At, B0); PG8_MMA(1, 1, At, B1); PG8_BAR; PG8_SCHED;
            PG8_LDB(B0, 1, 0); PG8_LDB(B1, 1, 1); PG8_SCHED; PG8_LDA(At, 1, 0); PG8_STAGE(PG8_SA(0, 1), a2 + hstep, voffA);
            PG8_WAIT_V(8); PG8_WAIT_L(0); PG8_BAR; PG8_MMA(0, 0, At, B0); PG8_MMA(0, 1, At, B1); PG8_BAR; PG8_SCHED;
            PG8_LDA(At, 1, 1); PG8_STAGE(PG8_SB(1, 0), b3, voffB); PG8_STAGE(PG8_SB(1, 1), b3 + hstep, voffB); PG8_STAGE(PG8_SA(1, 0), a3, voffA);
            PG8_WAIT_V(8); PG8_WAIT_L(0); PG8_BAR; PG8_MMA(1, 0, At, B0); PG8_MMA(1, 1, At, B1); PG8_BAR; PG8_SCHED;
            } else {
            PG8_LDB(B0, 0, 0); PG8_SCHED; PG8_LDA(At, 0, 0); PG8_STAGE(PG8_SA(1, 1), a1 + hstep, voffA);
            PG8_WAIT_L(8); PG8_BAR; PG8_WAIT_L(0); PG8_MMA(0, 0, At, B0); PG8_BAR; PG8_SCHED;
            PG8_LDB(B1, 0, 1); PG8_STAGE(PG8_SB(0, 0), b2, voffB);
            PG8_BAR; PG8_WAIT_L(0); PG8_MMA(0, 1, At, B1); PG8_BAR;
            PG8_LDA(At, 0, 1); PG8_STAGE(PG8_SA(0, 0), a2, voffA);
            PG8_BAR; PG8_WAIT_L(0); PG8_MMA(1, 0, At, B0); PG8_BAR; PG8_SCHED;
            PG8_STAGE(PG8_SB(0, 1), b2 + hstep, voffB);
            PG8_WAIT_V(6); PG8_BAR; PG8_MMA(1, 1, At, B1); PG8_BAR;
            PG8_LDB(B0, 1, 0); PG8_SCHED; PG8_LDA(At, 1, 0); PG8_STAGE(PG8_SA(0, 1), a2 + hstep, voffA);
            PG8_WAIT_L(8); PG8_BAR; PG8_WAIT_L(0); PG8_MMA(0, 0, At, B0); PG8_BAR; PG8_SCHED;
            PG8_LDB(B1, 1, 1); PG8_STAGE(PG8_SB(1, 0), b3, voffB);
            PG8_BAR; PG8_WAIT_L(0); PG8_MMA(0, 1, At, B1); PG8_BAR;
            PG8_LDA(At, 1, 1); PG8_STAGE(PG8_SA(1, 0), a3, voffA);
            PG8_BAR; PG8_WAIT_L(0); PG8_MMA(1, 0, At, B0); PG8_BAR; PG8_SCHED;
            PG8_STAGE(PG8_SB(1, 1), b3 + hstep, voffB);
            PG8_WAIT_V(6); PG8_BAR; PG8_MMA(1, 1, At, B1); PG8_BAR;
            }
        }
        if constexpr (ALIGN_EPI) { if (wr == 0) PG8_BAR; }
        if constexpr (!Epi::AFTER_DRAIN) { E(acc, cur, wr, wc, fr, fq); S.done(cur); }
        if (!has_next) break;
#pragma unroll
        for (int a = 0; a < 2; ++a)
#pragma unroll
            for (int b = 0; b < 2; ++b)
#pragma unroll
                for (int m = 0; m < 4; ++m)
#pragma unroll
                    for (int n = 0; n < 2; ++n) acc[a][b][m][n] = (f32x4){0.f, 0.f, 0.f, 0.f};
        cur = nxt; cA = nA; cB = nB; ++ui;
        if constexpr (ALIGN_EPI) { if (wr == 1) PG8_BAR; }
    }
    PG8_WAIT_V(0);
    if constexpr (!ALIGN_EPI) { if (wr == 0) PG8_BAR; }
    PG8_BAR;
    if constexpr (Epi::AFTER_DRAIN) { E.fused(acc, cur, wr, wc, fr, fq, lds, wid, lane); S.done(cur); }
#undef PG8_SA
#undef PG8_SB
#undef PG8_STAGE
#undef PG8_LDA
#undef PG8_LDB
#undef PG8_MMA
#undef PG8_WAIT_V
#undef PG8_WAIT_L
#undef PG8_BAR
#undef PG8_SCHED
}
}

template <int KIND> struct EpiFast {
    static constexpr bool PERM = true, AFTER_DRAIN = false;
    EpiCtx E;
    template <int T, int AI, int MH> __device__ __forceinline__ void grp(const pg8::f32x4 (&acc)[2][2][4][2], int row0, int col0) const {
        Pre p00, p01, p10, p11;
        const int r0 = row0 + AI * 128 + (2 * MH) * 16, r1 = r0 + 16;
        pre_load<KIND, T>(E, r0, col0, p00); pre_load<KIND, T>(E, r0, col0 + 128, p01); pre_load<KIND, T>(E, r1, col0, p10); pre_load<KIND, T>(E, r1, col0 + 128, p11);
        { const pg8::f32x4 v0 = acc[AI][0][2 * MH][0], v1 = acc[AI][0][2 * MH][1]; float v[8] = {v0[0], v0[1], v0[2], v0[3], v1[0], v1[1], v1[2], v1[3]}; emit_fin<KIND, T>(E, r0, col0, v, p00); }
        { const pg8::f32x4 v0 = acc[AI][1][2 * MH][0], v1 = acc[AI][1][2 * MH][1]; float v[8] = {v0[0], v0[1], v0[2], v0[3], v1[0], v1[1], v1[2], v1[3]}; emit_fin<KIND, T>(E, r0, col0 + 128, v, p01); }
        { const pg8::f32x4 v0 = acc[AI][0][2 * MH + 1][0], v1 = acc[AI][0][2 * MH + 1][1]; float v[8] = {v0[0], v0[1], v0[2], v0[3], v1[0], v1[1], v1[2], v1[3]}; emit_fin<KIND, T>(E, r1, col0, v, p10); }
        { const pg8::f32x4 v0 = acc[AI][1][2 * MH + 1][0], v1 = acc[AI][1][2 * MH + 1][1]; float v[8] = {v0[0], v0[1], v0[2], v0[3], v1[0], v1[1], v1[2], v1[3]}; emit_fin<KIND, T>(E, r1, col0 + 128, v, p11); }
        asm volatile("" ::: "memory");
    }
    template <int T> __device__ __forceinline__ void run(const pg8::f32x4 (&acc)[2][2][4][2], int row0, int col0) const {
        grp<T, 0, 0>(acc, row0, col0); grp<T, 0, 1>(acc, row0, col0); grp<T, 1, 0>(acc, row0, col0); grp<T, 1, 1>(acc, row0, col0);
    }
    __device__ __forceinline__ void operator()(const pg8::f32x4 (&acc)[2][2][4][2], const pg8::Unit& u, int wr, int wc, int fr, int fq) const {
        const int row0 = u.pm * 256 + wr * 64 + fr, col0 = u.pn * 256 + wc * 32 + 8 * fq;
        if constexpr (KIND == EPI_INPROJ) {
            switch (inproj_type(u.pn)) {
                case T_QA: run<T_QA>(acc, row0, col0); break;
                case T_KA: run<T_KA>(acc, row0, col0); break;
                case T_VA: run<T_VA>(acc, row0, col0); break;
                case T_ZA: run<T_ZA>(acc, row0, col0); break;
                case T_QB: run<T_QB>(acc, row0, col0); break;
                case T_CB: run<T_CB>(acc, row0, col0); break;
                case T_KROPE: run<T_KROPE>(acc, row0, col0); break;
                case T_VSW: run<T_VSW>(acc, row0, col0); break;
                case T_ZB: run<T_ZB>(acc, row0, col0); break;
                case T_QC: run<T_QC>(acc, row0, col0); break;
                case T_KC: run<T_KC>(acc, row0, col0); break;
                case T_VC: run<T_VC>(acc, row0, col0); break;
                case T_ZC: run<T_ZC>(acc, row0, col0); break;
                default: run<T_SPECIAL>(acc, row0, col0); break;
            }
        } else run<0>(acc, row0, col0);
    }
};
#define FAST_GEMM(KIND, Aptr, Bptr, N_, K_, ALIGN) do { pg8::Gemm g_{(const pg8::bf16_t*)(Aptr), (const pg8::bf16_t*)(Bptr), M, (N_), (K_)}; pg8::StaticOrder S_; S_.init(M, (N_), (int)gridDim.x, (int)blockIdx.x); \
        EpiFast<KIND> Ep_{E}; pg8::gemm_phase<EpiFast<KIND>, pg8::StaticOrder, ALIGN, true>((PG8_LAS unsigned char*)lds, g_, S_, Ep_); } while (0)

#define LAS __attribute__((address_space(3)))
typedef short s16x4 __attribute__((ext_vector_type(4)));
typedef short v4i16_t __attribute__((ext_vector_type(4)));
typedef LAS const char* lds_cptr;
constexpr int A_KRING = 0, A_VRING = 49152, A_CFRING = 98304, A_MISC = 104448;
constexpr int A_SLOT = 16384;
constexpr int A_IMP = A_MISC, A_SELM = A_MISC + 16384, A_UMASK = A_SELM + 512, A_SEQ = A_UMASK + 16, A_WQ = A_SEQ + 80;
__device__ __forceinline__ void glds16(const void* gsrc, unsigned lds_dst) { unsigned keep;
    asm volatile("s_mov_b32 %0, m0\n\ts_mov_b32 m0, %2\n\ts_nop 0\n\tglobal_load_lds_dwordx4 %1, off\n\ts_mov_b32 m0, %0" : "=&s"(keep) : "v"(gsrc), "s"(lds_dst) : "memory"); }
__device__ __forceinline__ void glds4(const void* gsrc, unsigned lds_dst) { unsigned keep;
    asm volatile("s_mov_b32 %0, m0\n\ts_mov_b32 m0, %2\n\ts_nop 0\n\tglobal_load_lds_dword %1, off\n\ts_mov_b32 m0, %0" : "=&s"(keep) : "v"(gsrc), "s"(lds_dst) : "memory"); }
#define A_WAIT_BAR(N) asm volatile("s_waitcnt vmcnt(" #N ") lgkmcnt(0)\n\ts_barrier" ::: "memory")
__device__ __forceinline__ s16x4 vtr(lds_cptr p) { return __builtin_bit_cast(s16x4, __builtin_amdgcn_ds_read_tr16_b64_v4i16((LAS v4i16_t*)p)); }
__device__ __forceinline__ unsigned cvtpk(float lo, float hi) { typedef float f2 __attribute__((ext_vector_type(2))); typedef __bf16 b2 __attribute__((ext_vector_type(2))); f2 v = {lo, hi}; b2 b = __builtin_convertvector(v, b2); return __builtin_bit_cast(unsigned, b); }
__device__ __forceinline__ int crow(int r, int hi) { return (r & 3) + 8 * (r >> 2) + 4 * hi; }

template <int NDB> struct FlashSt { f32x16 o[NDB]; float m, l; };
template <int NDB> __device__ __forceinline__ void flash_init(FlashSt<NDB>& st) {
#pragma unroll
    for (int i = 0; i < NDB; ++i)
#pragma unroll
        for (int r = 0; r < 16; ++r) st.o[i][r] = 0.f;
    st.m = -1e30f; st.l = 0.f;
}
template <int NDB> __device__ __forceinline__ void flash_init3(FlashSt<NDB>& st) { flash_init<NDB>(st); st.m = 0.f; }
__device__ __forceinline__ void qk_tile(f32x16& p0, f32x16& p1, lds_cptr kslot, const bf16x8 (&qf)[4], int r32, int hi) {
    const lds_cptr kb = kslot + hi * 1024 + r32 * 16;
    bf16x8 ka[4], kc[4];
#pragma unroll
    for (int d0 = 0; d0 < 4; ++d0) { ka[d0] = *(const LAS bf16x8*)(kb + d0 * 2048); kc[d0] = *(const LAS bf16x8*)(kb + d0 * 2048 + 512); }
#pragma unroll
    for (int d0 = 0; d0 < 4; ++d0) {
        p0 = __builtin_amdgcn_mfma_f32_32x32x16_bf16(ka[d0], qf[d0], p0, 0, 0, 0);
        p1 = __builtin_amdgcn_mfma_f32_32x32x16_bf16(kc[d0], qf[d0], p1, 0, 0, 0);
    }
}
__device__ __forceinline__ float xhalf_max(float a) {
    auto rr = __builtin_amdgcn_permlane32_swap(__float_as_uint(a), __float_as_uint(a), false, false);
    return fmaxf(__uint_as_float(rr[0]), __uint_as_float(rr[1]));
}
__device__ __forceinline__ float rowmax32(const f32x16& p0, const f32x16& p1) {
    float a = fmaxf(p0[0], p1[0]);
#pragma unroll
    for (int r = 1; r < 16; ++r) a = fmaxf(a, fmaxf(p0[r], p1[r]));
    return xhalf_max(a);
}
template <int NDB> __device__ __forceinline__ void pv_tile(f32x16 (&o)[NDB], lds_cptr vslot_l, const f32x16& p0, const f32x16& p1) {
    bf16x8 pf[4];
    { u32x4 w;
      w.x = cvtpk(p0[0], p0[1]); w.y = cvtpk(p0[2], p0[3]); w.z = cvtpk(p0[4], p0[5]); w.w = cvtpk(p0[6], p0[7]); pf[0] = __builtin_bit_cast(bf16x8, w);
      w.x = cvtpk(p0[8], p0[9]); w.y = cvtpk(p0[10], p0[11]); w.z = cvtpk(p0[12], p0[13]); w.w = cvtpk(p0[14], p0[15]); pf[1] = __builtin_bit_cast(bf16x8, w);
      w.x = cvtpk(p1[0], p1[1]); w.y = cvtpk(p1[2], p1[3]); w.z = cvtpk(p1[4], p1[5]); w.w = cvtpk(p1[6], p1[7]); pf[2] = __builtin_bit_cast(bf16x8, w);
      w.x = cvtpk(p1[8], p1[9]); w.y = cvtpk(p1[10], p1[11]); w.z = cvtpk(p1[12], p1[13]); w.w = cvtpk(p1[14], p1[15]); pf[3] = __builtin_bit_cast(bf16x8, w); }
#pragma unroll
    for (int db = 0; db < NDB; ++db) {
        bf16x8 vf[4];
#pragma unroll
        for (int ks = 0; ks < 4; ++ks) { const s16x4 lo = vtr(vslot_l + db * 4096 + ks * 1024), hh = vtr(vslot_l + db * 4096 + ks * 1024 + 512);
            vf[ks] = (bf16x8){lo[0], lo[1], lo[2], lo[3], hh[0], hh[1], hh[2], hh[3]}; }
#pragma unroll
        for (int ks = 0; ks < 4; ++ks) o[db] = __builtin_amdgcn_mfma_f32_32x32x16_bf16(vf[ks], pf[ks], o[db], 0, 0, 0);
    }
}
template <int NDB> __device__ __forceinline__ void flash_update(FlashSt<NDB>& st, f32x16& p0, f32x16& p1, lds_cptr vslot_l) {
    const float rm = rowmax32(p0, p1);
    const float mn = fmaxf(st.m, rm), alpha = __builtin_amdgcn_exp2f(st.m - mn);
    st.m = mn;
    float ls = 0.f;
#pragma unroll
    for (int r = 0; r < 16; ++r) { p0[r] = __builtin_amdgcn_exp2f(p0[r] - mn); p1[r] = __builtin_amdgcn_exp2f(p1[r] - mn); ls += p0[r] + p1[r]; }
    st.l = st.l * alpha + ls;
#pragma unroll
    for (int db = 0; db < NDB; ++db)
#pragma unroll
        for (int r = 0; r < 16; ++r) st.o[db][r] *= alpha;
    pv_tile<NDB>(st.o, vslot_l, p0, p1);
}
__device__ __forceinline__ int lane_vbase(int lane) { return ((lane >> 4) & 1) * 32 + (lane & 3) * 8 + (4 * (lane >> 5) + ((lane & 15) >> 2)) * 64; }
#define DSR128(dst, addr, off) asm volatile("ds_read_b128 %0, %1 offset:%c2" : "=v"(dst) : "v"(addr), "i"(off) : "memory")
#define DSRTR(dst, addr, off) asm volatile("ds_read_b64_tr_b16 %0, %1 offset:%c2" : "=v"(dst) : "v"(addr), "i"(off) : "memory")
#define LGKM_WAIT0() do { asm volatile("s_waitcnt lgkmcnt(0)" ::: "memory"); __builtin_amdgcn_sched_barrier(0); } while (0)
__device__ __forceinline__ void qk_tile2(f32x16& p0, f32x16& p1, unsigned kaddr, const bf16x8 (&qf)[4]) {
    bf16x8 ka0, ka1, ka2, ka3, kc0, kc1, kc2, kc3;
    DSR128(ka0, kaddr, 0); DSR128(kc0, kaddr, 512); DSR128(ka1, kaddr, 2048); DSR128(kc1, kaddr, 2560);
    DSR128(ka2, kaddr, 4096); DSR128(kc2, kaddr, 4608); DSR128(ka3, kaddr, 6144); DSR128(kc3, kaddr, 6656);
    LGKM_WAIT0();
    p0 = __builtin_amdgcn_mfma_f32_32x32x16_bf16(ka0, qf[0], p0, 0, 0, 0); p1 = __builtin_amdgcn_mfma_f32_32x32x16_bf16(kc0, qf[0], p1, 0, 0, 0);
    p0 = __builtin_amdgcn_mfma_f32_32x32x16_bf16(ka1, qf[1], p0, 0, 0, 0); p1 = __builtin_amdgcn_mfma_f32_32x32x16_bf16(kc1, qf[1], p1, 0, 0, 0);
    p0 = __builtin_amdgcn_mfma_f32_32x32x16_bf16(ka2, qf[2], p0, 0, 0, 0); p1 = __builtin_amdgcn_mfma_f32_32x32x16_bf16(kc2, qf[2], p1, 0, 0, 0);
    p0 = __builtin_amdgcn_mfma_f32_32x32x16_bf16(ka3, qf[3], p0, 0, 0, 0); p1 = __builtin_amdgcn_mfma_f32_32x32x16_bf16(kc3, qf[3], p1, 0, 0, 0);
}
struct VFr { s16x4 lo[8], hi[8]; };
template <int DB0> __device__ __forceinline__ void v_issue(VFr& f, unsigned vaddr) {
    DSRTR(f.lo[0], vaddr, DB0 * 4096 + 0);    DSRTR(f.hi[0], vaddr, DB0 * 4096 + 512);
    DSRTR(f.lo[1], vaddr, DB0 * 4096 + 1024); DSRTR(f.hi[1], vaddr, DB0 * 4096 + 1536);
    DSRTR(f.lo[2], vaddr, DB0 * 4096 + 2048); DSRTR(f.hi[2], vaddr, DB0 * 4096 + 2560);
    DSRTR(f.lo[3], vaddr, DB0 * 4096 + 3072); DSRTR(f.hi[3], vaddr, DB0 * 4096 + 3584);
    DSRTR(f.lo[4], vaddr, DB0 * 4096 + 4096); DSRTR(f.hi[4], vaddr, DB0 * 4096 + 4608);
    DSRTR(f.lo[5], vaddr, DB0 * 4096 + 5120); DSRTR(f.hi[5], vaddr, DB0 * 4096 + 5632);
    DSRTR(f.lo[6], vaddr, DB0 * 4096 + 6144); DSRTR(f.hi[6], vaddr, DB0 * 4096 + 6656);
    DSRTR(f.lo[7], vaddr, DB0 * 4096 + 7168); DSRTR(f.hi[7], vaddr, DB0 * 4096 + 7680);
}
#define VFRAG(f, i) ((bf16x8){(f).lo[i][0], (f).lo[i][1], (f).lo[i][2], (f).lo[i][3], (f).hi[i][0], (f).hi[i][1], (f).hi[i][2], (f).hi[i][3]})
__device__ __forceinline__ void pv2(f32x16& oa, f32x16& ob, const VFr& f, const bf16x8 (&pf)[4]) {
    oa = __builtin_amdgcn_mfma_f32_32x32x16_bf16(VFRAG(f, 0), pf[0], oa, 0, 0, 0); ob = __builtin_amdgcn_mfma_f32_32x32x16_bf16(VFRAG(f, 4), pf[0], ob, 0, 0, 0);
    oa = __builtin_amdgcn_mfma_f32_32x32x16_bf16(VFRAG(f, 1), pf[1], oa, 0, 0, 0); ob = __builtin_amdgcn_mfma_f32_32x32x16_bf16(VFRAG(f, 5), pf[1], ob, 0, 0, 0);
    oa = __builtin_amdgcn_mfma_f32_32x32x16_bf16(VFRAG(f, 2), pf[2], oa, 0, 0, 0); ob = __builtin_amdgcn_mfma_f32_32x32x16_bf16(VFRAG(f, 6), pf[2], ob, 0, 0, 0);
    oa = __builtin_amdgcn_mfma_f32_32x32x16_bf16(VFRAG(f, 3), pf[3], oa, 0, 0, 0); ob = __builtin_amdgcn_mfma_f32_32x32x16_bf16(VFRAG(f, 7), pf[3], ob, 0, 0, 0);
}
__device__ __forceinline__ void pack_p(bf16x8 (&pf)[4], const f32x16& p0, const f32x16& p1) {
    u32x4 w;
    w.x = cvtpk(p0[0], p0[1]); w.y = cvtpk(p0[2], p0[3]); w.z = cvtpk(p0[4], p0[5]); w.w = cvtpk(p0[6], p0[7]); pf[0] = __builtin_bit_cast(bf16x8, w);
    w.x = cvtpk(p0[8], p0[9]); w.y = cvtpk(p0[10], p0[11]); w.z = cvtpk(p0[12], p0[13]); w.w = cvtpk(p0[14], p0[15]); pf[1] = __builtin_bit_cast(bf16x8, w);
    w.x = cvtpk(p1[0], p1[1]); w.y = cvtpk(p1[2], p1[3]); w.z = cvtpk(p1[4], p1[5]); w.w = cvtpk(p1[6], p1[7]); pf[2] = __builtin_bit_cast(bf16x8, w);
    w.x = cvtpk(p1[8], p1[9]); w.y = cvtpk(p1[10], p1[11]); w.z = cvtpk(p1[12], p1[13]); w.w = cvtpk(p1[14], p1[15]); pf[3] = __builtin_bit_cast(bf16x8, w);
}
template <int NDB> __device__ __forceinline__ void flash_update2(FlashSt<NDB>& st, f32x16& p0, f32x16& p1, unsigned vaddr) {
    VFr vf; v_issue<0>(vf, vaddr);
    const float rm = rowmax32(p0, p1);
    const float mn = fmaxf(st.m, rm), alpha = __builtin_amdgcn_exp2f(st.m - mn);
    st.m = mn;
    float ls = 0.f;
#pragma unroll
    for (int r = 0; r < 16; ++r) { p0[r] = __builtin_amdgcn_exp2f(p0[r] - mn); p1[r] = __builtin_amdgcn_exp2f(p1[r] - mn); ls += p0[r] + p1[r]; }
    st.l = st.l * alpha + ls;
#pragma unroll
    for (int db = 0; db < NDB; ++db)
#pragma unroll
        for (int r = 0; r < 16; ++r) st.o[db][r] *= alpha;
    bf16x8 pf[4]; pack_p(pf, p0, p1);
    LGKM_WAIT0();
    pv2(st.o[0], st.o[1], vf, pf);
    if constexpr (NDB == 4) { v_issue<2>(vf, vaddr); LGKM_WAIT0(); pv2(st.o[2], st.o[3], vf, pf); }
}
__device__ __forceinline__ float max3_(float a, float b, float c) { float r; asm("v_max3_f32 %0, %1, %2, %3" : "=v"(r) : "v"(a), "v"(b), "v"(c)); return r; }
__device__ __forceinline__ float rowmax32_asm(const f32x16& p0, const f32x16& p1) {
    float a = max3_(p0[0], p0[1], p1[0]), b = max3_(p0[2], p0[3], p1[1]); a = max3_(a, p1[2], p1[3]);
#pragma unroll
    for (int r = 4; r < 16; r += 4) { a = max3_(a, p0[r], p0[r + 1]); b = max3_(b, p0[r + 2], p0[r + 3]); a = max3_(a, p1[r], p1[r + 1]); b = max3_(b, p1[r + 2], p1[r + 3]); }
    float m; asm("v_max_f32_e32 %0, %1, %2" : "=v"(m) : "v"(a), "v"(b));
    auto rr = __builtin_amdgcn_permlane32_swap(__float_as_uint(m), __float_as_uint(m), false, false);
    float o; asm("v_max_f32_e32 %0, %1, %2" : "=v"(o) : "v"(__uint_as_float(rr[0])), "v"(__uint_as_float(rr[1]))); return o;
}
constexpr float FA_THR = 8.f;
template <int NDB> __device__ __forceinline__ bool flash_update3(FlashSt<NDB>& st, f32x16& p0, f32x16& p1, unsigned vaddr) {
    VFr vf; v_issue<0>(vf, vaddr);
    asm volatile("s_nop 15\n\ts_nop 7" : "+v"(p0), "+v"(p1));
    const float rm = rowmax32_asm(p0, p1);
    bool moved = false;
    if (__builtin_expect(__builtin_amdgcn_ballot_w64(rm > FA_THR) != 0ull, 0)) {
        const float dl = fmaxf(rm, 0.f), f = __builtin_amdgcn_exp2f(-dl);
        st.m += dl; st.l *= f;
#pragma unroll
        for (int r = 0; r < 16; ++r) { p0[r] -= dl; p1[r] -= dl; }
#pragma unroll
        for (int db = 0; db < NDB; ++db)
#pragma unroll
            for (int r = 0; r < 16; ++r) st.o[db][r] *= f;
        moved = true;
    }
    float ls = 0.f;
#pragma unroll
    for (int r = 0; r < 16; ++r) { p0[r] = __builtin_amdgcn_exp2f(p0[r]); p1[r] = __builtin_amdgcn_exp2f(p1[r]); ls += p0[r] + p1[r]; }
    st.l += ls;
    bf16x8 pf[4]; pack_p(pf, p0, p1);
    LGKM_WAIT0();
    pv2(st.o[0], st.o[1], vf, pf);
    if constexpr (NDB == 4) { v_issue<2>(vf, vaddr); LGKM_WAIT0(); pv2(st.o[2], st.o[3], vf, pf); }
    return moved;
}
__device__ __forceinline__ void pv_only2(f32x16 (&o)[2], unsigned vaddr, const f32x16& p0, const f32x16& p1) {
    VFr vf; v_issue<0>(vf, vaddr); bf16x8 pf[4]; pack_p(pf, p0, p1); LGKM_WAIT0(); pv2(o[0], o[1], vf, pf);
}

__device__ __forceinline__ void fox_unit(unsigned char* lds, unsigned char* ws, int bh, int qb, int dry = 0) {
    int tid_o = threadIdx.x; asm volatile("" : "+v"(tid_o));
    const int tid = tid_o, lane = tid & 63, wid = __builtin_amdgcn_readfirstlane(tid >> 6), r32 = lane & 31, hi = lane >> 5;
    const unsigned lds0 = (unsigned)(uintptr_t)lds;
    const lds_cptr L = (lds_cptr)lds;
    const int qrow = 256 * qb + 32 * wid + r32, wrow0 = 256 * qb + 32 * wid;
    const int NTl = 4 * (qb + 1);
    const char* Kg = (const char*)(ws + OFF_KA) + (size_t)bh * 524288 + wid * 1024 + lane * 16;
    const char* Vg = (const char*)(ws + OFF_VA) + (size_t)bh * 524288 + wid * 1024 + lane * 16;
    const char* Cg = (const char*)(ws + OFF_CF) + (size_t)bh * 16384 + lane * 4;
    const unsigned kdst = (unsigned)__builtin_amdgcn_readfirstlane(lds0 + A_KRING + wid * 1024), vdst = (unsigned)__builtin_amdgcn_readfirstlane(lds0 + A_VRING + wid * 1024),
                   cdst = (unsigned)__builtin_amdgcn_readfirstlane(lds0 + A_CFRING + wid * 256);
#define FOX_DMA(t, slot) do { glds16(Kg + (size_t)(t) * 8192, kdst + (slot) * A_SLOT); glds16(Vg + (size_t)(t) * 8192, vdst + (slot) * A_SLOT); glds4(Cg + (size_t)(t) * 256, cdst + (slot) * 2048); } while (0)
    asm volatile("s_waitcnt vmcnt(0)" ::: "memory");
    FOX_DMA(0, 0); FOX_DMA(1, 1);
    bf16x8 qf[4];
    { const bf16* Q = (const bf16*)(ws + OFF_QA) + ((size_t)bh * 4096 + qrow) * 64 + 8 * hi;
#pragma unroll
      for (int d0 = 0; d0 < 4; ++d0) qf[d0] = *(const bf16x8*)(Q + 16 * d0); }
    FlashSt<2> st; flash_init3<2>(st);
    const int vb = lane_vbase(lane);
    const unsigned kaddr0 = lds0 + A_KRING + hi * 1024 + r32 * 16, vaddr0 = lds0 + A_VRING + vb;
    asm volatile("" : "+v"(qf[0]), "+v"(qf[1]), "+v"(qf[2]), "+v"(qf[3]));
    asm volatile("s_waitcnt vmcnt(0)" ::: "memory");
    asm volatile("s_barrier" ::: "memory");
    int slot = 0;
    for (int t = 0; t < NTl; ++t) {
        const int s2 = (slot >= 1) ? slot - 1 : 2;
        if (t + 2 < NTl) FOX_DMA(t + 2, s2);
        if (64 * t <= wrow0 + 31 && dry != 4) {
            f32x16 p0, p1;
            { const unsigned ca = lds0 + A_CFRING + slot * 2048 + wid * 256 + 16 * hi; f32x4 c0, c1, c2, c3, c4, c5, c6, c7;
              DSR128(c0, ca, 0); DSR128(c1, ca, 32); DSR128(c2, ca, 64); DSR128(c3, ca, 96); DSR128(c4, ca, 128); DSR128(c5, ca, 160); DSR128(c6, ca, 192); DSR128(c7, ca, 224);
              LGKM_WAIT0();
              p0 = __builtin_shufflevector(__builtin_shufflevector(c0, c1, 0, 1, 2, 3, 4, 5, 6, 7), __builtin_shufflevector(c2, c3, 0, 1, 2, 3, 4, 5, 6, 7), 0, 1, 2, 3, 4, 5, 6, 7, 8, 9, 10, 11, 12, 13, 14, 15);
              p1 = __builtin_shufflevector(__builtin_shufflevector(c4, c5, 0, 1, 2, 3, 4, 5, 6, 7), __builtin_shufflevector(c6, c7, 0, 1, 2, 3, 4, 5, 6, 7), 0, 1, 2, 3, 4, 5, 6, 7, 8, 9, 10, 11, 12, 13, 14, 15);
              p0 = p0 - st.m; p1 = p1 - st.m; }
            qk_tile2(p0, p1, kaddr0 + slot * A_SLOT, qf);
            if (64 * t + 63 > wrow0) {
                const int kb = 64 * t + 4 * hi;
#pragma unroll
                for (int r = 0; r < 16; ++r) { const int kv = kb + (r & 3) + 8 * (r >> 2); if (kv > qrow) p0[r] = -INFINITY; if (kv + 32 > qrow) p1[r] = -INFINITY; }
            }
            if (dry != 3) (void)flash_update3<2>(st, p0, p1, vaddr0 + slot * A_SLOT); else { st.o[0] += p0; st.o[1] += p1; }
        }
        if (dry == 2) { asm volatile("s_waitcnt lgkmcnt(0)\n\ts_barrier" ::: "memory"); } else if (t + 2 < NTl) { A_WAIT_BAR(3); } else { A_WAIT_BAR(0); }
        slot = (slot == 2) ? 0 : slot + 1;
    }
#undef FOX_DMA
    const float lt = st.l + __shfl_xor(st.l, 32), il = 1.f / lt;
    const int b = bh >> 3, h = bh & 7;
    bf16* Y = (bf16*)(ws + OFF_ZA) + (size_t)(b * 4096 + qrow) * 512 + h * 64;
    bf16* Yd = dry ? (bf16*)(ws + OFF_SELM) + (tid * 64) : Y;
#pragma unroll
    for (int db = 0; db < 2; ++db)
#pragma unroll
        for (int rq = 0; rq < 4; ++rq) { bf16* yp = Y + 32 * db + 8 * rq + 4 * hi; bf16* yo = Yd + 32 * db + 8 * rq + 4 * hi; const u32x2 z = *(const u32x2*)yp;
            const float z0 = __uint_as_float(z.x << 16), z1 = __uint_as_float(z.x & 0xffff0000u), z2 = __uint_as_float(z.y << 16), z3 = __uint_as_float(z.y & 0xffff0000u);
            u32x2 o; o.x = pk2(st.o[db][4 * rq] * il * z0, st.o[db][4 * rq + 1] * il * z1); o.y = pk2(st.o[db][4 * rq + 2] * il * z2, st.o[db][4 * rq + 3] * il * z3);
            *(u32x2*)yo = o; }
}

__device__ __forceinline__ void diff_unit(unsigned char* lds, unsigned char* ws, int bhc, int qb, const float* subg, float lam, float lam_init, bool dry = false) {
    int tid_o = threadIdx.x; asm volatile("" : "+v"(tid_o));
    const int tid = tid_o, lane = tid & 63, wid = __builtin_amdgcn_readfirstlane(tid >> 6), r32 = lane & 31, hi = lane >> 5;
    const int map = wid >> 2, wl = wid & 3;
    const unsigned lds0 = (unsigned)(uintptr_t)lds;
    const lds_cptr L = (lds_cptr)lds;
    const int b = bhc >> 2, hc = bhc & 3;
    const int qrow = 128 * qb + 32 * wl + r32, wrow0 = 128 * qb + 32 * wl;
    const int NTl = 2 * (qb + 1);
    const char* Kg = (const char*)(ws + OFF_KC) + (size_t)(b * 8 + hc * 2) * 524288 + wid * 1024 + lane * 16;
    const char* Vg = (const char*)(ws + OFF_VC) + (size_t)bhc * 1048576 + wid * 1024 + lane * 16;
    const unsigned kdst = (unsigned)__builtin_amdgcn_readfirstlane(lds0 + A_KRING + wid * 1024), vdst = (unsigned)__builtin_amdgcn_readfirstlane(lds0 + A_VRING + wid * 1024);
#define DIFF_DMA(t, slot) do { glds16(Kg + (size_t)(t) * 8192, kdst + (slot) * A_SLOT); glds16(Kg + 524288 + (size_t)(t) * 8192, kdst + (slot) * A_SLOT + 8192); \
        glds16(Vg + (size_t)(t) * 16384, vdst + (slot) * A_SLOT); glds16(Vg + (size_t)(t) * 16384 + 8192, vdst + (slot) * A_SLOT + 8192); } while (0)
    asm volatile("s_waitcnt vmcnt(0)" ::: "memory");
    DIFF_DMA(0, 0); DIFF_DMA(1, 1);
    bf16x8 qf[4];
    { const bf16* Q = (const bf16*)(ws + OFF_QC) + ((size_t)(b * 8 + hc * 2 + map) * 4096 + qrow) * 64 + 8 * hi;
#pragma unroll
      for (int d0 = 0; d0 < 4; ++d0) qf[d0] = *(const bf16x8*)(Q + 16 * d0); }
    FlashSt<4> st; flash_init3<4>(st);
    f32x16 negm;
#pragma unroll
    for (int r = 0; r < 16; ++r) negm[r] = 0.f;
    const int vb = lane_vbase(lane);
    const unsigned kaddr0 = lds0 + A_KRING + map * 8192 + hi * 1024 + r32 * 16, vaddr0 = lds0 + A_VRING + vb;
    asm volatile("" : "+v"(qf[0]), "+v"(qf[1]), "+v"(qf[2]), "+v"(qf[3]));
    asm volatile("s_waitcnt vmcnt(0)" ::: "memory");
    asm volatile("s_barrier" ::: "memory");
    int slot = 0;
    for (int t = 0; t < NTl; ++t) {
        const int s2 = (slot >= 1) ? slot - 1 : 2;
        if (t + 2 < NTl) DIFF_DMA(t + 2, s2);
        if (64 * t <= wrow0 + 31) {
            f32x16 p0 = negm, p1 = negm;
            qk_tile2(p0, p1, kaddr0 + slot * A_SLOT, qf);
            if (64 * t + 63 > wrow0) {
                const int kb = 64 * t + 4 * hi;
#pragma unroll
                for (int r = 0; r < 16; ++r) { const int kv = kb + (r & 3) + 8 * (r >> 2); if (kv > qrow) p0[r] = -INFINITY; if (kv + 32 > qrow) p1[r] = -INFINITY; }
            }
            if (flash_update3<4>(st, p0, p1, vaddr0 + slot * A_SLOT)) {
#pragma unroll
                for (int r = 0; r < 16; ++r) negm[r] = -st.m; }
        }
        if (t + 2 < NTl) { A_WAIT_BAR(4); } else { A_WAIT_BAR(0); }
        slot = (slot == 2) ? 0 : slot + 1;
    }
#undef DIFF_DMA
    const float lt = st.l + __shfl_xor(st.l, 32), il = 1.f / lt;
    LAS float* stage = (LAS float*)lds + wl * 4096 + r32;
    if (map == 1) {
#pragma unroll
        for (int db = 0; db < 4; ++db)
#pragma unroll
            for (int r = 0; r < 16; ++r) stage[(32 * db + crow(r, hi)) * 32] = st.o[db][r] * il;
    }
    asm volatile("s_waitcnt lgkmcnt(0)\n\ts_barrier" ::: "memory");
    if (map == 0) {
        float ss = 0.f;
#pragma unroll
        for (int db = 0; db < 4; ++db)
#pragma unroll
            for (int r = 0; r < 16; ++r) { const float v = st.o[db][r] * il - lam * stage[(32 * db + crow(r, hi)) * 32]; st.o[db][r] = v; ss += v * v; }
        ss += __shfl_xor(ss, 32);
        const float rs = rsqrtf(ss * (1.f / 128.f) + EPS) * (1.f - lam_init);
        bf16* Y = (bf16*)(ws + OFF_ZC) + (size_t)(b * 4096 + qrow) * 512 + hc * 128;
        bf16* Yd = dry ? (bf16*)(ws + OFF_SELM) + (tid * 128) : Y;
#pragma unroll
        for (int db = 0; db < 4; ++db)
#pragma unroll
            for (int rq = 0; rq < 4; ++rq) { const int d = 32 * db + 8 * rq + 4 * hi; bf16* yp = Y + d; bf16* yo = Yd + d; const u32x2 z = *(const u32x2*)yp; const f32x4 g = *(const f32x4*)(subg + d);
                const float z0 = __uint_as_float(z.x << 16), z1 = __uint_as_float(z.x & 0xffff0000u), z2 = __uint_as_float(z.y << 16), z3 = __uint_as_float(z.y & 0xffff0000u);
                u32x2 o; o.x = pk2(st.o[db][4 * rq] * rs * g[0] * z0, st.o[db][4 * rq + 1] * rs * g[1] * z1); o.y = pk2(st.o[db][4 * rq + 2] * rs * g[2] * z2, st.o[db][4 * rq + 3] * rs * g[3] * z3);
                *(u32x2*)yo = o; }
    }
    asm volatile("s_waitcnt lgkmcnt(0)\n\ts_barrier" ::: "memory");
}

constexpr int N_IMP = A_MISC, N_SELM = N_IMP + 64 * 65 * 4, N_UMASK = N_SELM + 512, N_SEQC = N_UMASK + 16, N_SEQD = N_SEQC + 80, N_CNT = N_SEQD + 16;
template <int MODE> __device__ __forceinline__ void nsa_ring(FlashSt<2>& st, unsigned char* lds, const char* Kg, const char* Vg, unsigned kdst, unsigned vdst, int n, int seqoff,
                                                             const bf16x8 (&qf)[4], int tb, int qloc, unsigned selLo, unsigned selHi, int r32, int hi, int vb) {
    const lds_cptr L = (lds_cptr)lds;
    const LAS unsigned char* seq = (const LAS unsigned char*)(L + seqoff);
    const unsigned lds0r = (unsigned)(uintptr_t)lds;
#define NSA_DMA(j, slot) do { glds16(Kg + (size_t)(j) * 8192, kdst + (slot) * A_SLOT); glds16(Vg + (size_t)(j) * 8192, vdst + (slot) * A_SLOT); } while (0)
    asm volatile("s_waitcnt vmcnt(0)" ::: "memory");
    { const int j0 = __builtin_amdgcn_readfirstlane((int)seq[0]); NSA_DMA(j0, 0); if (n > 1) { const int j1 = __builtin_amdgcn_readfirstlane((int)seq[1]); NSA_DMA(j1, 1); } }
    A_WAIT_BAR(0);
    int slot = 0;
    f32x16 negm;
#pragma unroll
    for (int r = 0; r < 16; ++r) negm[r] = 0.f;
    for (int i = 0; i < n; ++i) {
        const int s2 = (slot >= 1) ? slot - 1 : 2;
        if (i + 2 < n) { const int j2 = __builtin_amdgcn_readfirstlane((int)seq[i + 2]); NSA_DMA(j2, s2); }
        const int j = __builtin_amdgcn_readfirstlane((int)seq[i]);
        f32x16 p0 = negm, p1 = negm;
        qk_tile2(p0, p1, lds0r + A_KRING + hi * 1024 + r32 * 16 + slot * A_SLOT, qf);
        if (j == tb) {
#pragma unroll
            for (int r = 0; r < 16; ++r) { const int kv = 4 * hi + (r & 3) + 8 * (r >> 2); if (kv > qloc) p0[r] = -INFINITY; if (kv + 32 > qloc) p1[r] = -INFINITY; }
        } else if (MODE == 0) {
            const bool sel = (((j < 32) ? (selLo >> j) : (selHi >> (j - 32))) & 1u) != 0u;
            if (!sel) {
#pragma unroll
                for (int r = 0; r < 16; ++r) { p0[r] = -INFINITY; p1[r] = -INFINITY; } }
        } else if (j == tb - 8) {
#pragma unroll
            for (int r = 0; r < 16; ++r) { const int kv = 4 * hi + (r & 3) + 8 * (r >> 2); if (kv <= qloc) p0[r] = -INFINITY; if (kv + 32 <= qloc) p1[r] = -INFINITY; }
        }
        if (flash_update3<2>(st, p0, p1, lds0r + A_VRING + vb + slot * A_SLOT)) {
#pragma unroll
            for (int r = 0; r < 16; ++r) negm[r] = -st.m; }
        if (i + 2 < n) { A_WAIT_BAR(2); } else { A_WAIT_BAR(0); }
        slot = (slot == 2) ? 0 : slot + 1;
    }
#undef NSA_DMA
}
__device__ __forceinline__ void nsa_unit(unsigned char* lds, unsigned char* ws, int bg, int tb, bool dry = false) {
    int tid_o = threadIdx.x; asm volatile("" : "+v"(tid_o));
    const int tid = tid_o, lane = tid & 63, wid = __builtin_amdgcn_readfirstlane(tid >> 6), r32 = lane & 31, hi = lane >> 5;
    const unsigned lds0 = (unsigned)(uintptr_t)lds;
    const lds_cptr L = (lds_cptr)lds;
    const int b = bg >> 1, g = bg & 1, h = 4 * g + (wid >> 1), qloc = 32 * (wid & 1) + r32, t = 64 * tb + qloc, row = b * 4096 + t;
    const unsigned kdst = (unsigned)__builtin_amdgcn_readfirstlane(lds0 + A_KRING + wid * 1024), vdst = (unsigned)__builtin_amdgcn_readfirstlane(lds0 + A_VRING + wid * 1024);
    const int vb = lane_vbase(lane);
    LAS float* imp = (LAS float*)(L + N_IMP);
    LAS unsigned* selm = (LAS unsigned*)(L + N_SELM);
    LAS unsigned* umask = (LAS unsigned*)(L + N_UMASK);
    const int nvmax = 4 * tb + 3, nct = (nvmax + 63) >> 6;
    for (int i = tid; i < 64 * 65; i += 512) imp[i] = 0.f;
    if (tid < 128) selm[tid] = 0u;
    if (tid < 2) umask[tid] = 0u;
    asm volatile("s_waitcnt vmcnt(0)" ::: "memory");
    { const char* Kc = (const char*)(ws + OFF_KCMP) + (size_t)bg * 32768 + wid * 1024 + lane * 16; const char* Vc = (const char*)(ws + OFF_VCMP) + (size_t)bg * 32768 + wid * 1024 + lane * 16;
      for (int ct = 0; ct < nct; ++ct) { glds16(Kc + ct * 8192, kdst + ct * 8192); glds16(Vc + ct * 8192, vdst + ct * 8192); } }
    bf16x8 qf[4];
    const bf16* Qp = (const bf16*)(ws + OFF_QB) + ((size_t)(b * 8 + h) * 4096 + t) * 64 + 8 * hi;
#pragma unroll
    for (int d0 = 0; d0 < 4; ++d0) qf[d0] = *(const bf16x8*)(Qp + 16 * d0);
    const float* gt = (const float*)(ws + OFF_GATES) + (size_t)row * 24 + (h & 7) * 3;
    float g0 = gt[0], g1 = gt[1], g2 = gt[2];
    asm volatile("" : "+v"(qf[0]), "+v"(qf[1]), "+v"(qf[2]), "+v"(qf[3]), "+v"(g0), "+v"(g1), "+v"(g2));
    A_WAIT_BAR(0);
    const int nv = (t >= 31) ? ((t - 31) >> 4) + 1 : 0;
    f32x16 y[2];
    {
        float m = -1e30f, l = 0.f;
        for (int ct = 0; ct < nct; ++ct) {
            f32x16 p0, p1;
#pragma unroll
            for (int r = 0; r < 16; ++r) { p0[r] = 0.f; p1[r] = 0.f; }
            qk_tile2(p0, p1, lds0 + A_KRING + hi * 1024 + r32 * 16 + ct * 8192, qf);
            const int cb = 64 * ct + 4 * hi;
#pragma unroll
            for (int r = 0; r < 16; ++r) { const int c = cb + (r & 3) + 8 * (r >> 2); if (c >= nv) p0[r] = -INFINITY; if (c + 32 >= nv) p1[r] = -INFINITY; }
            const float rm = rowmax32(p0, p1), mn = fmaxf(m, rm);
            float ls = 0.f;
#pragma unroll
            for (int r = 0; r < 16; ++r) ls += __builtin_amdgcn_exp2f(p0[r] - mn) + __builtin_amdgcn_exp2f(p1[r] - mn);
            l = l * __builtin_amdgcn_exp2f(m - mn) + ls; m = mn;
        }
        const float lt = l + __shfl_xor(l, 32), il = lt > 0.f ? 1.f / lt : 0.f;
        f32x16 oc[2];
#pragma unroll
        for (int r = 0; r < 16; ++r) { oc[0][r] = 0.f; oc[1][r] = 0.f; }
        for (int ct = 0; ct < nct; ++ct) {
            f32x16 p0, p1;
#pragma unroll
            for (int r = 0; r < 16; ++r) { p0[r] = 0.f; p1[r] = 0.f; }
            qk_tile2(p0, p1, lds0 + A_KRING + hi * 1024 + r32 * 16 + ct * 8192, qf);
            const int cb = 64 * ct + 4 * hi;
#pragma unroll
            for (int r = 0; r < 16; ++r) { const int c = cb + (r & 3) + 8 * (r >> 2);
                p0[r] = (c >= nv) ? 0.f : __builtin_amdgcn_exp2f(p0[r] - m) * il; p1[r] = (c + 32 >= nv) ? 0.f : __builtin_amdgcn_exp2f(p1[r] - m) * il; }
            LAS float* ir = imp + qloc * 65 + 16 * ct + hi;
#pragma unroll
            for (int rq = 0; rq < 4; ++rq) {
                const float q0 = (p0[4 * rq] + p0[4 * rq + 1]) + (p0[4 * rq + 2] + p0[4 * rq + 3]), q1 = (p1[4 * rq] + p1[4 * rq + 1]) + (p1[4 * rq + 2] + p1[4 * rq + 3]);
                __hip_atomic_fetch_add(ir + 2 * rq, q0, __ATOMIC_RELAXED, __HIP_MEMORY_SCOPE_WORKGROUP);
                __hip_atomic_fetch_add(ir + 2 * rq + 1, p0[4 * rq + 3], __ATOMIC_RELAXED, __HIP_MEMORY_SCOPE_WORKGROUP);
                __hip_atomic_fetch_add(ir + 8 + 2 * rq, q1, __ATOMIC_RELAXED, __HIP_MEMORY_SCOPE_WORKGROUP);
                if (16 * ct + 8 + 2 * rq + hi + 1 < 64) __hip_atomic_fetch_add(ir + 8 + 2 * rq + 1, p1[4 * rq + 3], __ATOMIC_RELAXED, __HIP_MEMORY_SCOPE_WORKGROUP);
            }
            pv_only2(oc, lds0 + A_VRING + vb + ct * 8192, p0, p1);
        }
#pragma unroll
        for (int r = 0; r < 16; ++r) { y[0][r] = g0 * oc[0][r]; y[1][r] = g0 * oc[1][r]; }
    }
    asm volatile("s_waitcnt lgkmcnt(0)\n\ts_barrier" ::: "memory");
    {
        const int q = tid >> 3, part = tid & 7;
        float sc[8];
#pragma unroll
        for (int i = 0; i < 8; ++i) { const int j = 8 * part + i; const bool forced = (j == 0) || (j == tb) || (j == tb - 1);
            sc[i] = forced ? 1e30f : (j <= tb ? imp[q * 65 + j] : -1e30f); }
#pragma unroll
        for (int i = 0; i < 8; ++i) imp[q * 65 + 8 * part + i] = sc[i];
        asm volatile("s_waitcnt lgkmcnt(0)\n\ts_barrier" ::: "memory");
        int rank[8];
#pragma unroll
        for (int i = 0; i < 8; ++i) rank[i] = 0;
        for (int k = 0; k < 64; ++k) { const float sk = imp[q * 65 + k];
#pragma unroll
            for (int i = 0; i < 8; ++i) rank[i] += (sk > sc[i] || (sk == sc[i] && k < 8 * part + i)) ? 1 : 0; }
        unsigned bits = 0u;
#pragma unroll
        for (int i = 0; i < 8; ++i) bits |= (rank[i] < 16) ? (1u << i) : 0u;
        bits <<= 8 * (part & 3);
        __hip_atomic_fetch_or(selm + q * 2 + (part >> 2), bits, __ATOMIC_RELAXED, __HIP_MEMORY_SCOPE_WORKGROUP);
        __hip_atomic_fetch_or(umask + (part >> 2), bits, __ATOMIC_RELAXED, __HIP_MEMORY_SCOPE_WORKGROUP);
        asm volatile("s_waitcnt lgkmcnt(0)\n\ts_barrier" ::: "memory");
        if (tid == 0) {
            LAS unsigned char* sq = (LAS unsigned char*)(L + N_SEQC); LAS unsigned char* sd = (LAS unsigned char*)(L + N_SEQD); LAS int* cnt = (LAS int*)(L + N_CNT);
            const unsigned long long um = ((unsigned long long)umask[1] << 32) | umask[0];
            int n = 0; sq[n++] = (unsigned char)tb;
            for (int j = 0; j < tb; ++j) if ((um >> j) & 1ull) sq[n++] = (unsigned char)j;
            cnt[0] = n;
            int n2 = 0; sd[n2++] = (unsigned char)tb;
            for (int j = (tb >= 8 ? tb - 8 : 0); j < tb; ++j) sd[n2++] = (unsigned char)j;
            cnt[1] = n2;
        }
        asm volatile("s_waitcnt lgkmcnt(0)\n\ts_barrier" ::: "memory");
    }
    const unsigned selLo = selm[qloc * 2], selHi = selm[qloc * 2 + 1];
    const int nC = __builtin_amdgcn_readfirstlane(((const LAS int*)(L + N_CNT))[0]), nD = __builtin_amdgcn_readfirstlane(((const LAS int*)(L + N_CNT))[1]);
    { const float* cs = (const float*)(ws + OFF_COS) + (size_t)row * 32 + 4 * hi; const float* sn = (const float*)(ws + OFF_SIN) + (size_t)row * 32 + 4 * hi;
#pragma unroll
      for (int d0 = 0; d0 < 4; ++d0) { const f32x4 c = *(const f32x4*)(cs + 8 * d0), s = *(const f32x4*)(sn + 8 * d0); u32x4 w = __builtin_bit_cast(u32x4, qf[d0]); u32x4 o;
#pragma unroll
          for (int e = 0; e < 4; ++e) { const float x1 = __uint_as_float(w[e] << 16), x2 = __uint_as_float(w[e] & 0xffff0000u); o[e] = pk2(x1 * c[e] - x2 * s[e], x2 * c[e] + x1 * s[e]); }
          qf[d0] = __builtin_bit_cast(bf16x8, o); } }
    asm volatile("" : "+v"(qf[0]), "+v"(qf[1]), "+v"(qf[2]), "+v"(qf[3]));
    {
        FlashSt<2> st; flash_init3<2>(st);
        const char* Kg = (const char*)(ws + OFF_KSEL) + (size_t)bg * 524288 + wid * 1024 + lane * 16; const char* Vg = (const char*)(ws + OFF_VSEL) + (size_t)bg * 524288 + wid * 1024 + lane * 16;
        nsa_ring<0>(st, lds, Kg, Vg, kdst, vdst, nC, N_SEQC, qf, tb, qloc, selLo, selHi, r32, hi, vb);
        const float lt = st.l + __shfl_xor(st.l, 32), sc = g1 / lt;
#pragma unroll
        for (int r = 0; r < 16; ++r) { y[0][r] += sc * st.o[0][r]; y[1][r] += sc * st.o[1][r]; }
    }
    {
        FlashSt<2> st; flash_init3<2>(st);
        const char* Kg = (const char*)(ws + OFF_KWIN) + (size_t)bg * 524288 + wid * 1024 + lane * 16; const char* Vg = (const char*)(ws + OFF_VWIN) + (size_t)bg * 524288 + wid * 1024 + lane * 16;
        nsa_ring<1>(st, lds, Kg, Vg, kdst, vdst, nD, N_SEQD, qf, tb, qloc, selLo, selHi, r32, hi, vb);
        const float lt = st.l + __shfl_xor(st.l, 32), sc = g2 / lt;
#pragma unroll
        for (int r = 0; r < 16; ++r) { y[0][r] += sc * st.o[0][r]; y[1][r] += sc * st.o[1][r]; }
    }
    bf16* Y = (bf16*)(ws + OFF_ZB) + (size_t)row * 512 + h * 64;
    bf16* Yd = dry ? (bf16*)(ws + OFF_SELM) + (tid * 64) : Y;
#pragma unroll
    for (int db = 0; db < 2; ++db)
#pragma unroll
        for (int rq = 0; rq < 4; ++rq) { bf16* yp = Y + 32 * db + 8 * rq + 4 * hi; bf16* yo = Yd + 32 * db + 8 * rq + 4 * hi; const u32x2 z = *(const u32x2*)yp;
            const float z0 = __uint_as_float(z.x << 16), z1 = __uint_as_float(z.x & 0xffff0000u), z2 = __uint_as_float(z.y << 16), z3 = __uint_as_float(z.y & 0xffff0000u);
            u32x2 o; o.x = pk2(y[db][4 * rq] * z0, y[db][4 * rq + 1] * z1); o.y = pk2(y[db][4 * rq + 2] * z2, y[db][4 * rq + 3] * z3);
            *(u32x2*)yo = o; }
}

__device__ __forceinline__ void compress_unit(unsigned char* lds, unsigned char* ws, int kv, int bg, int rc) {
    int tid_o = threadIdx.x; asm volatile("" : "+v"(tid_o));
    const int tid = tid_o, lane = tid & 63, wid = __builtin_amdgcn_readfirstlane(tid >> 6), r32 = lane & 31, hi = lane >> 5;
    const int c = 32 * rc + r32;
    const int cl = c < 255 ? c : 254;
    const bf16* Ap = (const bf16*)(ws + (kv ? OFF_VCB : OFF_KCB)) + ((size_t)bg * 4096 + 16 * cl) * 64 + 8 * hi;
    const bf16* Bp = (const bf16*)(ws + OFF_CW1) + (size_t)(kv * 256 + 32 * wid + r32) * 2048 + 8 * hi;
    f32x16 acc;
#pragma unroll
    for (int r = 0; r < 16; ++r) acc[r] = 0.f;
#pragma unroll 8
    for (int k = 0; k < 2048; k += 16) {
        const bf16x8 a = *(const bf16x8*)(Ap + k), w = *(const bf16x8*)(Bp + k);
        acc = __builtin_amdgcn_mfma_f32_32x32x16_bf16(w, a, acc, 0, 0, 0);
    }
    const float* cb = (const float*)(ws + OFF_CB1) + kv * 256 + 32 * wid + 4 * hi;
    bf16x8 hf[2];
    { float hv[16];
#pragma unroll
      for (int rq = 0; rq < 4; ++rq) { const f32x4 bb = *(const f32x4*)(cb + 8 * rq);
#pragma unroll
          for (int e = 0; e < 4; ++e) hv[4 * rq + e] = siluf_(acc[4 * rq + e] + bb[e]); }
      u32x4 w0, w1;
      w0.x = pk2(hv[0], hv[1]); w0.y = pk2(hv[2], hv[3]); w0.z = pk2(hv[4], hv[5]); w0.w = pk2(hv[6], hv[7]);
      w1.x = pk2(hv[8], hv[9]); w1.y = pk2(hv[10], hv[11]); w1.z = pk2(hv[12], hv[13]); w1.w = pk2(hv[14], hv[15]);
      hf[0] = __builtin_bit_cast(bf16x8, w0); hf[1] = __builtin_bit_cast(bf16x8, w1); }
    const bf16* W2 = (const bf16*)(ws + OFF_CW2) + (size_t)kv * 64 * 256 + 32 * wid + 4 * hi;
    f32x16 po[2];
#pragma unroll
    for (int dbk = 0; dbk < 2; ++dbk) {
#pragma unroll
        for (int r = 0; r < 16; ++r) po[dbk][r] = 0.f;
#pragma unroll
        for (int s = 0; s < 2; ++s) {
            const bf16* wr = W2 + (size_t)(32 * dbk + r32) * 256 + 16 * s;
            const u32x2 lo = *(const u32x2*)wr, hh = *(const u32x2*)(wr + 8);
            u32x4 wv; wv.x = lo.x; wv.y = lo.y; wv.z = hh.x; wv.w = hh.y;
            po[dbk] = __builtin_amdgcn_mfma_f32_32x32x16_bf16(__builtin_bit_cast(bf16x8, wv), hf[s], po[dbk], 0, 0, 0);
        }
    }
    LAS float* part = (LAS float*)lds;
    __syncthreads();
#pragma unroll
    for (int dbk = 0; dbk < 2; ++dbk)
#pragma unroll
        for (int r = 0; r < 16; ++r) part[(wid * 64 + 32 * dbk + crow(r, hi)) * 32 + r32] = po[dbk][r];
    __syncthreads();
    {
        const int row = tid & 31, d4 = tid >> 5, cc = 32 * rc + row;
        float o[4];
#pragma unroll
        for (int e = 0; e < 4; ++e) { float sum = 0.f;
#pragma unroll
            for (int w = 0; w < 8; ++w) sum += part[(w * 64 + 4 * d4 + e) * 32 + row];
            o[e] = (cc < 255) ? sum : 0.f; }
        bf16* dst = (bf16*)(ws + (kv ? OFF_VCMP : OFF_KCMP)) + (size_t)bg * 16384 + (kv ? vtile_off(cc, 4 * d4) : ktile_off(cc, 4 * d4));
        store_bf<4>(dst, o);
    }
    __syncthreads();
}
__device__ __forceinline__ void cumsum_unit(unsigned char* lds, unsigned char* ws, int bh) {
    int tid_o = threadIdx.x; asm volatile("" : "+v"(tid_o));
    const int tid = tid_o, lane = tid & 63, wid = tid >> 6, b = bh >> 3, h = bh & 7;
    const float* lf = (const float*)(ws + OFF_LOGF) + ((size_t)(b * 4096 + 8 * tid)) * 8 + h;
    float v[8]; float s = 0.f;
#pragma unroll
    for (int i = 0; i < 8; ++i) { s += lf[i * 8]; v[i] = s; }
    float incl = s;
#pragma unroll
    for (int of = 1; of < 64; of <<= 1) { const float t = __shfl_up(incl, of); if (lane >= of) incl += t; }
    LAS float* wsum = (LAS float*)lds;
    __syncthreads();
    if (lane == 63) wsum[wid] = incl;
    __syncthreads();
    float base = incl - s;
    for (int w = 0; w < wid; ++w) base += wsum[w];
    float* cf = (float*)(ws + OFF_CF) + (size_t)bh * 4096 + 8 * tid;
    f32x4 o0 = {-(base + v[0]), -(base + v[1]), -(base + v[2]), -(base + v[3])}, o1 = {-(base + v[4]), -(base + v[5]), -(base + v[6]), -(base + v[7])};
    *(f32x4*)cf = o0; *(f32x4*)(cf + 4) = o1;
    __syncthreads();
}

constexpr size_t OFF_BAR = OFF_CTL + 131072;
constexpr int LDS_BARST = 131072 + 64;
#define XB_TMO      128
#define XB_XCNT(j)  (256  + 64 * (j))
#define XB_XSUB(j)  (1280 + 64 * (j))
#define XB_XGEN(j)  (2304 + 64 * (j))
#define XB_TOP      3328
#define XB_TOPGEN   3392
#define XCD_BAR_WORDS 3456
#define XB_SPIN_CAP (1u << 18)

__device__ __forceinline__ unsigned xb_ld(unsigned* p)              { return __hip_atomic_load(p, __ATOMIC_RELAXED, __HIP_MEMORY_SCOPE_AGENT); }
__device__ __forceinline__ unsigned xb_add(unsigned* p, unsigned v) { return __hip_atomic_fetch_add(p, v, __ATOMIC_RELAXED, __HIP_MEMORY_SCOPE_AGENT); }
__device__ __forceinline__ unsigned xb_xcc_id() { return (unsigned)__builtin_amdgcn_s_getreg((3 << 11) | 20) & 0xFu; }
#define XB_SPIN(cond, bar) do { unsigned _sp = 0; while (cond) { __builtin_amdgcn_s_sleep(1); \
    if ((++_sp & 255u) == 0u) { if (xb_ld(&(bar)[XB_TMO])) break; if (_sp > XB_SPIN_CAP) { atomicAdd(&(bar)[XB_TMO], 1u); break; } } } } while (0)

struct XcdBarrier {
    unsigned* bar; unsigned x;
    volatile LAS unsigned* st;
};

__device__ __forceinline__ XcdBarrier xcd_barrier_post(unsigned* bar, volatile LAS unsigned* st) {
    XcdBarrier b; b.bar = bar; b.x = xb_xcc_id(); b.st = st;
    if (threadIdx.x == 0) (void)xb_add(&bar[XB_XCNT(b.x)], 1u);
    return b;
}
__device__ __forceinline__ void xcd_barrier_complete(unsigned* bar, unsigned x, unsigned& nloc, unsigned& nx) {
    const unsigned G = gridDim.x * gridDim.y * gridDim.z;
    unsigned sum, cnt, mine, sp = 0u;
    for (;;) {
        sum = 0u; cnt = 0u; mine = 0u;
#pragma unroll
        for (unsigned j = 0; j < 16; ++j) { const unsigned c = xb_ld(&bar[XB_XCNT(j)]); sum += c; cnt += (c > 0u) ? 1u : 0u; mine = (j == x) ? c : mine; }
        if (sum == G) break;
        __builtin_amdgcn_s_sleep(1);
        if ((++sp & 255u) == 0u) { if (xb_ld(&bar[XB_TMO])) break; if (sp > XB_SPIN_CAP) { atomicAdd(&bar[XB_TMO], 1u); break; } }
    }
    nloc = mine > 0u ? mine : 1u; nx = cnt > 0u ? cnt : 1u;
}

__device__ __forceinline__ void xcd_barrier(const XcdBarrier& b) {
    asm volatile("s_waitcnt vmcnt(0)" ::: "memory");
    __syncthreads();
    if (threadIdx.x == 0) {
        unsigned* bar = b.bar;
        __builtin_amdgcn_s_waitcnt(0);
        unsigned nloc = b.st[0], nx = b.st[1];
        if (nloc == 0u) { xcd_barrier_complete(bar, b.x, nloc, nx); b.st[0] = nloc; b.st[1] = nx; }
        const unsigned old = xb_add(&bar[XB_XSUB(b.x)], 1u);
        const unsigned gen = old / nloc;
        if (old + 1u == (gen + 1u) * nloc) {
            __builtin_amdgcn_fence(__ATOMIC_RELEASE, "agent");
            asm volatile("s_waitcnt vmcnt(0)" ::: "memory");
            const unsigned og = xb_add(&bar[XB_TOP], 1u);
            const unsigned tg = og / nx;
            if (og + 1u == (tg + 1u) * nx) xb_add(&bar[XB_TOPGEN], 1u);
            else XB_SPIN(xb_ld(&bar[XB_TOPGEN]) == tg, bar);
            __builtin_amdgcn_fence(__ATOMIC_ACQUIRE, "agent");
            xb_add(&bar[XB_XGEN(b.x)], 1u);
            asm volatile("s_waitcnt vmcnt(0)" ::: "memory");
        } else {
            XB_SPIN(xb_ld(&bar[XB_XGEN(b.x)]) == gen, bar);
            __builtin_amdgcn_fence(__ATOMIC_ACQUIRE, "agent");
            asm volatile("s_waitcnt vmcnt(0)" ::: "memory");
        }
    }
    __syncthreads();
}

struct KArgs;
__device__ __forceinline__ void conv_tile(bool active, float (*tile)[65], int vt, const float* src, int ld, int K, bf16* dst, const float* kscale, int mode, int bx, int by) {
    const int n0 = bx * 64, k0 = by * 64, tx = vt & 63, ty = vt >> 6;
    const int n = n0 + tx;
    const int sc = mode == 0 ? n : mode == 1 ? win_srccol(n) : (n & ~63) + ((n & 1) << 5) + ((n & 63) >> 1);
    if (active) {
        float v[16];
#pragma unroll
        for (int i = 0; i < 16; ++i) v[i] = (sc >= 0) ? src[(size_t)(k0 + 4 * i + ty) * ld + sc] : 0.f;
        if (kscale) {
#pragma unroll
            for (int i = 0; i < 16; ++i) v[i] *= kscale[k0 + 4 * i + ty]; }
#pragma unroll
        for (int i = 0; i < 16; ++i) tile[tx][4 * i + ty] = v[i];
    }
    __syncthreads();
    if (active) {
#pragma unroll
        for (int p = 0; p < 2; ++p) { const int it = vt + 256 * p, r = it >> 3, c = it & 7; const float* t = &tile[r][8 * c];
            u32x4 o; o.x = pk2(t[0], t[1]); o.y = pk2(t[2], t[3]); o.z = pk2(t[4], t[5]); o.w = pk2(t[6], t[7]);
            *(u32x4*)(dst + (size_t)(n0 + r) * K + k0 + 8 * c) = o; }
    }
    __syncthreads();
}
namespace cg = cooperative_groups;
constexpr int NT = 512;
constexpr int LDS_BYTES = 147456;
struct KArgs { const void* in[23]; float* out; unsigned char* ws; };

#define OPAQUE_TID() int tid = threadIdx.x; asm volatile("" : "+v"(tid))
#define VRUN(VT, NVB, CALL) do { OPAQUE_TID(); constexpr int per_ = NT / (VT); for (int vb = blockIdx.x * per_ + tid / (VT); vb < (NVB); vb += gridDim.x * per_) { const int vt = tid % (VT); CALL; } } while (0)
#define VRUN_BAR(NVB, CALL) do { OPAQUE_TID(); float (*tile)[65] = (float (*)[65])(lds + (tid >> 8) * 64 * 65 * 4); (void)tile; const int nvb_ = (NVB); for (int it_ = 0; it_ * (int)gridDim.x * 2 < nvb_; ++it_) { const int vb = (it_ * (int)gridDim.x + (int)blockIdx.x) * 2 + (tid >> 8); const int vt = tid & 255; const bool active = vb < nvb_; CALL; } } while (0)

#ifndef FAST_FOX
#define FAST_FOX 1
#endif
#ifndef FAST_DIFF
#define FAST_DIFF 1
#endif
#ifndef FAST_NSA
#define FAST_NSA 1
#endif
#ifndef REP_U
#define REP_U 0
#endif
#ifndef REP_SYNC
#define REP_SYNC 0
#endif
#ifndef REP_SUMSQ
#define REP_SUMSQ 0
#endif
#ifndef REP_P0
#define REP_P0 0
#endif
#ifndef REP_PRO
#define REP_PRO 0
#endif
#ifndef REP_INPROJ
#define REP_INPROJ 0
#endif
#ifndef REP_P2
#define REP_P2 0
#endif
#ifndef REP_FOX
#define REP_FOX 0
#endif
#ifndef REP_DIFF
#define REP_DIFF 0
#endif
#ifndef REP_NSA
#define REP_NSA 0
#endif
#ifndef REP_GATEBR
#define REP_GATEBR 0
#endif
#ifndef REP_OUT
#define REP_OUT 0
#endif
#ifndef FAST_P2
#define FAST_P2 1
#endif
#ifndef DO_ALL
#define DO_ALL 1
#endif
#ifndef DO_PRO
#define DO_PRO DO_ALL
#endif
#ifndef DO_INPROJ
#define DO_INPROJ DO_ALL
#endif
#ifndef DO_P2
#define DO_P2 DO_ALL
#endif
#ifndef DO_ATTN
#define DO_ATTN DO_ALL
#endif
#ifndef DO_GATEBR
#define DO_GATEBR DO_ALL
#endif
#ifndef DO_OUT
#define DO_OUT DO_ALL
#endif
#ifndef DO_PLE
#define DO_PLE DO_ALL
#endif
#ifndef DO_TAIL
#define DO_TAIL DO_ALL
#endif
__global__ void __launch_bounds__(NT) __attribute__((amdgpu_waves_per_eu(2, 2))) mega(KArgs a) {
    extern __shared__ __attribute__((aligned(16))) unsigned char lds[];
    cg::grid_group grid = cg::this_grid();
    { volatile LAS unsigned* st0 = (volatile LAS unsigned*)((LAS unsigned char*)lds + LDS_BARST); if (threadIdx.x < 2) st0[threadIdx.x] = 0u; }
    __syncthreads();
    const XcdBarrier xbar = xcd_barrier_post((unsigned*)(a.ws + OFF_BAR), (volatile LAS unsigned*)((LAS unsigned char*)lds + LDS_BARST));
#define GSYNC() xcd_barrier(xbar)
    unsigned char* ws = a.ws; float* X = a.out;
    const float* x = (const float*)a.in[0]; const float* p = (const float*)a.in[1]; const int* pos = (const int*)a.in[2];
    const float *norm_g = (const float*)a.in[3], *w_in = (const float*)a.in[4], *b_forget = (const float*)a.in[5];
    const float *pe_k = (const float*)a.in[6], *w1_k = (const float*)a.in[7], *b1_k = (const float*)a.in[8], *w2_k = (const float*)a.in[9];
    const float *pe_v = (const float*)a.in[10], *w1_v = (const float*)a.in[11], *b1_v = (const float*)a.in[12], *w2_v = (const float*)a.in[13];
    const float *diff_lam = (const float*)a.in[14], *subln = (const float*)a.in[15];
    const float *w_out = (const float*)a.in[19], *w_ple = (const float*)a.in[20], *w_pg = (const float*)a.in[21], *final_g = (const float*)a.in[22];
#if DO_PRO
    for (int rep0_ = 0; rep0_ <= REP_P0; ++rep0_) {
    VRUN(256, M / 4, d_xprep(vb, vt, x, ws));
    VRUN(256, M * 32 / 256, d_rope_table(vb, vt, pos, ws));
    VRUN(256, (2 * M * 256 / 4) / 256, d_pconv(vb, vt, p, ws));
    for (int l = 0; l < DEPTH; ++l) {
        { OPAQUE_TID(); if (blockIdx.x == 0 && tid < 64) d_lam(tid, diff_lam + l * 256, ws, l); }
    }
    }
#endif
    for (int l = 0; l < DEPTH; ++l) {
        const float* wl = w_in + (size_t)l * 1024 * NIN; const float* ng = norm_g + l * 1024;
#if DO_PRO
        for (int rep_ = 0; rep_ <= REP_PRO; ++rep_) {
        { OPAQUE_TID(); float (*tile)[65] = (float (*)[65])(lds + (tid >> 8) * 64 * 65 * 4);
          const int njobs = 2952 + (l == 0 ? 1152 : 0);
          for (int it_ = 0; it_ * (int)gridDim.x * 2 < njobs; ++it_) {
              int j = (it_ * (int)gridDim.x + (int)blockIdx.x) * 2 + (tid >> 8); const bool active = j < njobs;
              const float* src = wl; int ld = NIN, K = 1024, mode = 1, bx = 0, by = 0; bf16* dst = (bf16*)(ws + OFF_WIN); const float* ks = ng;
              if (j < 1536) { bx = j % 96; by = j / 96; }
              else if (j < 2304) { j -= 1536; bx = j % 48; by = j / 48; src = wl + 5920; mode = 0; dst = (bf16*)(ws + OFF_WMG); }
              else if (j < 2688) { j -= 2304; const int i = j >> 7, r = j & 127; bx = r & 15; by = r >> 4; src = (const float*)a.in[16 + i] + (size_t)l * 512 * 1024; ld = 1024; K = 512; mode = 0; dst = (bf16*)(ws + OFF_WBR) + (size_t)i * 1024 * 512; ks = nullptr; }
              else if (j < 2944) { j -= 2688; const int kv = j >> 7, r = j & 127; bx = r & 3; by = r >> 2; src = (kv ? w1_v : w1_k) + (size_t)l * 2048 * 256; ld = 256; K = 2048; mode = 0; dst = (bf16*)(ws + OFF_CW1) + (size_t)kv * 256 * 2048; ks = nullptr; }
              else if (j < 2952) { j -= 2944; const int kv = j >> 2; by = j & 3; src = (kv ? w2_v : w2_k) + (size_t)l * 256 * 64; ld = 64; K = 256; mode = kv ? 0 : 2; dst = (bf16*)(ws + OFF_CW2) + (size_t)kv * 64 * 256; ks = nullptr; }
              else { j -= 2952; const int ll = j / 576, r = j % 576; ld = 1024; mode = 0; ks = nullptr;
                  if (r < 256) { bx = r & 15; by = r >> 4; src = w_out + (size_t)ll * 1024 * 1024; dst = (bf16*)(ws + OFF_WOUT) + (size_t)ll * 1024 * 1024; }
                  else if (r < 512) { const int r2 = r - 256; bx = r2 & 15; by = r2 >> 4; src = w_pg + (size_t)ll * 1024 * 1024; dst = (bf16*)(ws + OFF_WPG) + (size_t)ll * 1024 * 1024; }
                  else { const int r2 = r - 512; bx = r2 & 15; by = r2 >> 4; src = w_ple + (size_t)ll * 256 * 1024; K = 256; dst = (bf16*)(ws + OFF_WPL) + (size_t)ll * 1024 * 256; } }
              conv_tile(active, tile, tid & 255, src, ld, K, dst, ks, mode, bx, by);
          } }
        { OPAQUE_TID(); if (blockIdx.x >= 64 && blockIdx.x < 96 && tid < 256) d_cb1_part(blockIdx.x - 64, tid, pe_k + l * 2048, w1_k + (size_t)l * 2048 * 256, pe_v + l * 2048, w1_v + (size_t)l * 2048 * 256, ws); }
        }
#endif
        if (l == 0) grid.sync(); else GSYNC();
        EpiCtx E{ws, b_forget + l * 8, l == 0 ? x : X, X, 0};
#if DO_INPROJ
        { OPAQUE_TID(); if (blockIdx.x == 0) d_cb1_sum(tid, b1_k + l * 256, b1_v + l * 256, ws); }
        for (int rep_ = 0; rep_ <= REP_INPROJ; ++rep_) { FAST_GEMM(EPI_INPROJ, ws + OFF_XB, ws + OFF_WIN, NP, 1024, true); }
#endif
        GSYNC();
#if DO_P2
        for (int rep_ = 0; rep_ <= REP_P2; ++rep_) {
#if FAST_P2
        for (int u = blockIdx.x; u < 160; u += gridDim.x) { if (u < 128) compress_unit(lds, ws, u >> 6, (u >> 3) & 7, u & 7); else cumsum_unit(lds, ws, u - 128); }
#else
        VRUN(64, 32, d_cumsum(vb, vt, ws));
        VRUN_BAR(256 * 8 * 2, d_compress(active, vb, vt, (float*)lds + (tid >> 8) * 256, ws));
#endif
        }
#endif
        GSYNC();
#if DO_ATTN
#if FAST_FOX
        for (int rep_ = (REP_FOX ? 1 : 0); rep_ >= 0; --rep_) for (int u = blockIdx.x; u < 512; u += gridDim.x) fox_unit(lds, ws, u & 31, u < 256 ? 15 - (u >> 5) : (u >> 5) - 8, rep_ > 0 ? REP_FOX : 0);
        __syncthreads();
#else
        VRUN(64, 32 * 64, d_fox(vb, vt, ws));
#endif
#if FAST_DIFF
        { const float lam = ((const float*)(ws + OFF_CTL))[CTL_LAM + l], lam_init = 0.8f - 0.6f * expf(-0.3f * (float)l);
          for (int rep_ = REP_DIFF; rep_ >= 0; --rep_) for (int u = blockIdx.x; u < 512; u += gridDim.x) diff_unit(lds, ws, u & 15, u < 256 ? 31 - (u >> 4) : (u >> 4) - 16, subln + l * 128, lam, lam_init, rep_ > 0); }
#else
        { OPAQUE_TID(); if ((tid >> 6) < 4) { for (int vb = blockIdx.x * 4 + (tid >> 6); vb < 16 * 64; vb += gridDim.x * 4) d_diff(vb, tid & 63, (float (*)[129])(lds + (tid >> 6) * 64 * 129 * 4), ws, subln + l * 128, l); } }
#endif
#if FAST_NSA
        __syncthreads();
        for (int rep_ = REP_NSA; rep_ >= 0; --rep_) for (int u = blockIdx.x; u < 512; u += gridDim.x) nsa_unit(lds, ws, u & 7, u < 256 ? 63 - (u >> 3) : (u >> 3) - 32, rep_ > 0);
#else
        __syncthreads();
        VRUN(64, 8 * 64, d_nsa_topk(vb, vt, (float (*)[65])(lds + (tid >> 6) * 64 * 65 * 4), ws));
        GSYNC();
        VRUN(64, 32 * 64, d_nsa_attn(vb, vt, (float (*)[65])(lds + (tid >> 6) * 64 * 65 * 4), ws));
#endif
#endif
        GSYNC();
#if DO_GATEBR
        for (int rep_ = 0; rep_ <= REP_GATEBR; ++rep_) {
        FAST_GEMM(EPI_GATE, (const bf16*)(ws + OFF_XB), (const bf16*)(ws + OFF_WMG), 1024, 1024, false);
        FAST_GEMM(EPI_BR0, (const bf16*)(ws + OFF_ZA), (const bf16*)(ws + OFF_WBR), 1024, 512, false);
        FAST_GEMM(EPI_GATE, (const bf16*)(ws + OFF_XB), (const bf16*)(ws + OFF_WMG) + (size_t)1024 * 1024, 1024, 1024, false);
        FAST_GEMM(EPI_BR1, (const bf16*)(ws + OFF_ZB), (const bf16*)(ws + OFF_WBR) + (size_t)1024 * 512, 1024, 512, false);
        FAST_GEMM(EPI_GATE, (const bf16*)(ws + OFF_XB), (const bf16*)(ws + OFF_WMG) + (size_t)2 * 1024 * 1024, 1024, 1024, false);
        FAST_GEMM(EPI_BR2, (const bf16*)(ws + OFF_ZC), (const bf16*)(ws + OFF_WBR) + (size_t)2 * 1024 * 512, 1024, 512, false);
        }
#endif
        GSYNC();
#if DO_OUT
        for (int rep_ = 0; rep_ <= (l == 0 ? REP_OUT : 0); ++rep_) FAST_GEMM(EPI_OUT, (const bf16*)(ws + OFF_MERGED), (const bf16*)(ws + OFF_WOUT) + (size_t)l * 1024 * 1024, 1024, 1024, false);
#endif
        GSYNC();
#if DO_PLE
        for (int rep_ = 0; rep_ <= REP_U; ++rep_) FAST_GEMM(EPI_U, (const bf16*)(ws + OFF_PB) + (size_t)l * M * 256, (const bf16*)(ws + OFF_WPL) + (size_t)l * 1024 * 256, 1024, 256, false);
        FAST_GEMM(EPI_PLE, (const bf16*)(ws + OFF_X1B), (const bf16*)(ws + OFF_WPG) + (size_t)l * 1024 * 1024, 1024, 1024, false);
#endif
        GSYNC();
#if DO_TAIL
        for (int rep_ = 0; rep_ < 10 * REP_SYNC; ++rep_) GSYNC();
        for (int rep_ = 0; rep_ <= REP_SUMSQ; ++rep_) { if (l + 1 < DEPTH) VRUN(256, M / 4, d_sumsq(vb, vt, X, ws)); }
#endif
    }
#if DO_TAIL
    VRUN(256, M / 4, d_final(vb, vt, X, final_g));
#endif
}

extern "C" void kernel_launch(void* const* d_in, const int* in_sizes, int n_in, void* d_out, int out_size, void* d_ws, size_t ws_size, hipStream_t stream) {
    static int grid_blocks = 0;
    if (grid_blocks == 0) {
        if (n_in != 23 || ws_size < WS_NEED || out_size != M * DM) { fprintf(stderr, "kernel_launch: unexpected sizes (n_in %d ws %zu out %d)\n", n_in, ws_size, out_size); grid_blocks = -1; return; }
        int dev = 0, cus = 0, per_cu = 0;
        (void)hipGetDevice(&dev); (void)hipDeviceGetAttribute(&cus, hipDeviceAttributeMultiprocessorCount, dev);
        (void)hipFuncSetAttribute((const void*)mega, hipFuncAttributeMaxDynamicSharedMemorySize, LDS_BYTES);
        (void)hipOccupancyMaxActiveBlocksPerMultiprocessor(&per_cu, (const void*)mega, NT, LDS_BYTES);
        if (per_cu < 1) { fprintf(stderr, "kernel_launch: occupancy query says %d blocks per CU\n", per_cu); grid_blocks = -1; return; }
        grid_blocks = cus * 1;
    }
    if (grid_blocks < 0) return;
    (void)hipMemsetAsync((char*)d_ws + OFF_CTL, 0, 262144, stream);
    KArgs a{};
    for (int i = 0; i < 23; ++i) a.in[i] = d_in[i];
    a.out = (float*)d_out; a.ws = (unsigned char*)d_ws;
    void* args[] = {&a};
    hipError_t e = hipLaunchCooperativeKernel((const void*)mega, dim3(grid_blocks), dim3(NT), args, LDS_BYTES, stream);
    if (e != hipSuccess) fprintf(stderr, "cooperative launch failed: %s (grid %d)\n", hipGetErrorString(e), grid_blocks);
}
```

```cpp
#include <hip/hip_runtime.h>
#include <hip/hip_cooperative_groups.h>
#include <cstdio>
#include <cstdint>

typedef unsigned short bf16;
typedef short bf16x8 __attribute__((ext_vector_type(8)));
typedef float f32x4 __attribute__((ext_vector_type(4)));
typedef float f32x16 __attribute__((ext_vector_type(16)));
typedef unsigned u32x4 __attribute__((ext_vector_type(4)));
typedef unsigned u32x2 __attribute__((ext_vector_type(2)));

constexpr int BATCH = 4, SEQ = 4096, DM = 1024, M = BATCH * SEQ, DEPTH = 2, NIN = 8992, NP = 6144;
constexpr float EPS = 1e-6f;
constexpr float LOG2E = 1.4426950408889634f;
constexpr float C2 = 0.125f * LOG2E;
constexpr size_t MiB = 1u << 20;
constexpr size_t OFF_CTL = 0;
constexpr size_t OFF_WIN = 1 * MiB, OFF_WMG = 13 * MiB, OFF_WBR = 19 * MiB, OFF_CW1 = 22 * MiB, OFF_CW2 = 24 * MiB, OFF_CB1 = 24 * MiB + 128 * 1024;
constexpr size_t OFF_WOUT = 25 * MiB, OFF_WPG = 29 * MiB, OFF_WPL = 33 * MiB;
constexpr size_t OFF_XB = 34 * MiB, OFF_ZA = 66 * MiB, OFF_ZB = 82 * MiB, OFF_ZC = 98 * MiB;
constexpr size_t OFF_COS = 114 * MiB, OFF_SIN = 116 * MiB, OFF_PB = 118 * MiB;
constexpr size_t OFF_LOGF = 134 * MiB, OFF_CF = 134 * MiB + 512 * 1024, OFF_GATES = 135 * MiB, OFF_SSP = 136 * MiB + 512 * 1024;
constexpr size_t OFF_KCMP = 136 * MiB + 768 * 1024, OFF_VCMP = 137 * MiB, OFF_SELM = 137 * MiB + 256 * 1024;
constexpr size_t OFF_QA = 139 * MiB, OFF_KA = 155 * MiB, OFF_VA = 171 * MiB, OFF_QB = 187 * MiB, OFF_QC = 203 * MiB, OFF_KC = 219 * MiB, OFF_VC = 235 * MiB;
constexpr size_t OFF_KCB = 251 * MiB, OFF_VCB = 255 * MiB, OFF_KSEL = 259 * MiB, OFF_KWIN = 263 * MiB, OFF_VSEL = 267 * MiB, OFF_VWIN = 271 * MiB;
constexpr size_t WS_NEED = 275 * MiB;
constexpr size_t OFF_G = 139 * MiB  , OFF_T = 235 * MiB  , OFF_MERGED = OFF_T, OFF_X1B = 203 * MiB, OFF_U = 139 * MiB;
constexpr int CTL_LAM = 64;

__device__ __forceinline__ bf16 f2bf(float f) { unsigned u = __float_as_uint(f); return (bf16)((u + 0x7fffu + ((u >> 16) & 1u)) >> 16); }
__device__ __forceinline__ float bf2f(bf16 h) { return __uint_as_float(((unsigned)h) << 16); }
__device__ __forceinline__ unsigned pk2(float lo, float hi) { typedef float f2_ __attribute__((ext_vector_type(2))); typedef __bf16 b2_ __attribute__((ext_vector_type(2))); f2_ v = {lo, hi}; b2_ b = __builtin_convertvector(v, b2_); return __builtin_bit_cast(unsigned, b); }
__device__ __forceinline__ float sigmoidf_(float x) { return 1.f / (1.f + __expf(-x)); }
__device__ __forceinline__ float siluf_(float x) { return x / (1.f + __expf(-x)); }
__device__ __forceinline__ float logsigmoidf_(float x) { return x >= 0.f ? -log1pf(expf(-x)) : x - log1pf(expf(x)); }

__device__ __forceinline__ int ktile_off(int s, int d) { return (s >> 6) * 4096 + (d >> 3) * 512 + (s & 63) * 8 + (d & 7); }
__device__ __forceinline__ int vtile_off(int s, int d) { return (s >> 6) * 4096 + (d >> 5) * 2048 + ((s & 63) >> 4) * 512 + (s & 15) * 32 + (d & 31); }
__device__ __forceinline__ int v128_off(int s, int d) { return (s >> 6) * 8192 + (d >> 5) * 2048 + ((s & 63) >> 4) * 512 + (s & 15) * 32 + (d & 31); }

template <int W> __device__ __forceinline__ void store_bf(bf16* dst, const float* v) {
    if constexpr (W == 4) { u32x2 o; o.x = pk2(v[0], v[1]); o.y = pk2(v[2], v[3]); *(u32x2*)dst = o; }
    else { u32x4 o; o.x = pk2(v[0], v[1]); o.y = pk2(v[2], v[3]); o.z = pk2(v[4], v[5]); o.w = pk2(v[6], v[7]); *(u32x4*)dst = o; }
}

__device__ __forceinline__ int win_srccol(int n) {
    const int seg = n >> 6, j = n & 63; const int il = ((j & 1) << 5) + (j >> 1);
    if (seg < 8) return 0 + n;
    if (seg < 16) return 512 + (n - 512);
    if (seg < 24) return 1024 + (n - 1024);
    if (seg < 32) return 1544 + (n - 1536);
    if (seg < 40) return 2056 + (seg - 32) * 64 + il;
    if (seg < 42) return 2568 + (n - 2560);
    if (seg < 44) return 2696 + (n - 2688);
    if (seg < 46) return 2824 + (seg - 44) * 64 + il;
    if (seg < 48) return 3080 + (seg - 46) * 64 + il;
    if (seg < 50) return 2952 + (n - 3072);
    if (seg < 52) return 3208 + (n - 3200);
    if (seg < 60) return 3360 + (n - 3328);
    if (seg < 68) return 3872 + (seg - 60) * 64 + il;
    if (seg < 76) return 4384 + (seg - 68) * 64 + il;
    if (seg < 84) return 4896 + (n - 4864);
    if (seg < 92) return 5408 + (n - 5376);
    if (seg == 92) { if (j < 8) return 1536 + j; if (j < 32) return 3336 + (j - 8); return -1; }
    return -1;
}

enum { EPI_INPROJ = 0, EPI_GATE = 1, EPI_BR0 = 2, EPI_BR1 = 3, EPI_BR2 = 4, EPI_OUT = 5, EPI_U = 6, EPI_PLE = 7, EPI_GATE3 = 9, EPI_BR3 = 10 };
struct EpiCtx { unsigned char* ws; const float* bfg; const float* xin; float* X; int gi; };

__device__ __forceinline__ float row_rstd(const unsigned char* ws, int row) {
    const f32x4 sp = *(const f32x4*)(ws + OFF_SSP + (size_t)row * 16);
    return rsqrtf(((sp[0] + sp[1]) + (sp[2] + sp[3])) * (1.f / 1024.f) + EPS);
}
template <int W> __device__ __forceinline__ void rope_apply(const unsigned char* ws, int row, int d, float* v) {
    const float* cs = (const float*)(ws + OFF_COS) + (size_t)row * 32 + (d >> 1);
    const float* sn = (const float*)(ws + OFF_SIN) + (size_t)row * 32 + (d >> 1);
#pragma unroll
    for (int j = 0; j < W / 2; ++j) { const float c = cs[j], s = sn[j], x1 = v[2 * j], x2 = v[2 * j + 1]; v[2 * j] = x1 * c - x2 * s; v[2 * j + 1] = x2 * c + x1 * s; }
}

enum { T_QA = 0, T_KA, T_VA, T_ZA, T_QB, T_CB, T_KROPE, T_VSW, T_ZB, T_QC, T_KC, T_VC, T_ZC, T_SPECIAL };
__device__ __forceinline__ int inproj_type(int t) {
    return t < 2 ? T_QA : t < 4 ? T_KA : t < 6 ? T_VA : t < 8 ? T_ZA : t < 10 ? T_QB : t == 10 ? T_CB : t == 11 ? T_KROPE : t == 12 ? T_VSW : t < 15 ? T_ZB : t < 17 ? T_QC : t < 19 ? T_KC : t < 21 ? T_VC : t < 23 ? T_ZC : T_SPECIAL;
}
struct Pre { float rs; float a[8]; float b[8]; };
template <int KIND, int T> __device__ __forceinline__ void pre_load(const EpiCtx& E, int row, int col, Pre& p) {
    unsigned char* ws = E.ws; const size_t idx = (size_t)row * 1024 + col;
    if constexpr (KIND == EPI_INPROJ) {
        if constexpr (T == T_KROPE || T == T_QC || T == T_KC) { const int d = col & 63;
            const f32x4 c = *(const f32x4*)((const float*)(ws + OFF_COS) + (size_t)row * 32 + (d >> 1)), s = *(const f32x4*)((const float*)(ws + OFF_SIN) + (size_t)row * 32 + (d >> 1));
#pragma unroll
            for (int i = 0; i < 4; ++i) { p.a[i] = c[i]; p.b[i] = s[i]; } }
    } else if constexpr (KIND == EPI_GATE || KIND == EPI_GATE3) {
    } else if constexpr (KIND == EPI_BR3) {
        const u32x4 g = *(const u32x4*)((const bf16*)(ws + OFF_G) + (size_t)E.gi * M * 1024 + idx);
#pragma unroll
        for (int i = 0; i < 4; ++i) { p.a[2 * i] = __uint_as_float(g[i] << 16); p.a[2 * i + 1] = __uint_as_float(g[i] & 0xffff0000u); }
        if (E.gi > 0) { const u32x4 t = *(const u32x4*)((const bf16*)(ws + OFF_T) + idx);
#pragma unroll
            for (int i = 0; i < 4; ++i) { p.b[2 * i] = __uint_as_float(t[i] << 16); p.b[2 * i + 1] = __uint_as_float(t[i] & 0xffff0000u); } }
        else {
#pragma unroll
            for (int i = 0; i < 8; ++i) p.b[i] = 0.f; }
    } else if constexpr (KIND == EPI_BR0 || KIND == EPI_BR1 || KIND == EPI_BR2) {
        const u32x4 g = *(const u32x4*)((const bf16*)(ws + OFF_G) + idx);
#pragma unroll
        for (int i = 0; i < 4; ++i) { p.a[2 * i] = __uint_as_float(g[i] << 16); p.a[2 * i + 1] = __uint_as_float(g[i] & 0xffff0000u); }
        if constexpr (KIND != EPI_BR0) { const u32x4 t = *(const u32x4*)((const bf16*)(ws + OFF_T) + idx);
#pragma unroll
            for (int i = 0; i < 4; ++i) { p.b[2 * i] = __uint_as_float(t[i] << 16); p.b[2 * i + 1] = __uint_as_float(t[i] & 0xffff0000u); } }
    } else if constexpr (KIND == EPI_OUT) { const f32x4 t0 = *(const f32x4*)(E.xin + idx), t1 = *(const f32x4*)(E.xin + idx + 4);
#pragma unroll
        for (int i = 0; i < 4; ++i) { p.a[i] = t0[i]; p.a[4 + i] = t1[i]; }
    } else if constexpr (KIND == EPI_PLE) { const f32x4 t0 = *(const f32x4*)(E.X + idx), t1 = *(const f32x4*)(E.X + idx + 4); const u32x4 u = *(const u32x4*)((const bf16*)(ws + OFF_U) + idx);
#pragma unroll
        for (int i = 0; i < 4; ++i) { p.a[i] = t0[i]; p.a[4 + i] = t1[i]; p.b[2 * i] = __uint_as_float(u[i] << 16); p.b[2 * i + 1] = __uint_as_float(u[i] & 0xffff0000u); }
    }
}
__device__ __forceinline__ void st_f32x8(float* dst, const float* v) { f32x4 a = {v[0], v[1], v[2], v[3]}, b = {v[4], v[5], v[6], v[7]}; *(f32x4*)dst = a; *(f32x4*)(dst + 4) = b; }
template <int KIND, int T> __device__ __forceinline__ void emit_fin(const EpiCtx& E, int row, int col, const float* a, const Pre& p) {
    constexpr int W = 8;
    unsigned char* ws = E.ws; const size_t idx = (size_t)row * 1024 + col;
    float v[W];
    if constexpr (KIND == EPI_INPROJ) {
        const float rs = p.rs;
#pragma unroll
        for (int i = 0; i < W; ++i) v[i] = a[i] * rs;
        const int b = row >> 12, s = row & 4095;
        if constexpr (T == T_KROPE || T == T_QC || T == T_KC) {
#pragma unroll
            for (int j = 0; j < 4; ++j) { const float c = p.a[j], sn = p.b[j], x1 = v[2 * j], x2 = v[2 * j + 1]; v[2 * j] = x1 * c - x2 * sn; v[2 * j + 1] = x2 * c + x1 * sn; } }
        if constexpr (T == T_QA) { const int cc = col, h = cc >> 6, d = cc & 63;
#pragma unroll
            for (int i = 0; i < W; ++i) v[i] *= C2;
            store_bf<W>((bf16*)(ws + OFF_QA) + ((size_t)(b * 8 + h) * 4096 + s) * 64 + d, v);
        } else if constexpr (T == T_KA) { const int cc = col - 512, h = cc >> 6, d = cc & 63;
            store_bf<W>((bf16*)(ws + OFF_KA) + (size_t)(b * 8 + h) * 262144 + ktile_off(s, d), v);
        } else if constexpr (T == T_VA) { const int cc = col - 1024, h = cc >> 6, d = cc & 63;
            store_bf<W>((bf16*)(ws + OFF_VA) + (size_t)(b * 8 + h) * 262144 + vtile_off(s, d), v);
        } else if constexpr (T == T_ZA || T == T_ZB || T == T_ZC) { const int cc = col - (T == T_ZA ? 1536 : T == T_ZB ? 3328 : 5376);
#pragma unroll
            for (int i = 0; i < W; ++i) v[i] = siluf_(v[i]);
            store_bf<W>((bf16*)(ws + (T == T_ZA ? OFF_ZA : T == T_ZB ? OFF_ZB : OFF_ZC)) + (size_t)row * 512 + cc, v);
        } else if constexpr (T == T_QB) { const int cc = col - 2048, h = cc >> 6, d = cc & 63;
#pragma unroll
            for (int i = 0; i < W; ++i) v[i] *= C2;
            store_bf<W>((bf16*)(ws + OFF_QB) + ((size_t)(b * 8 + h) * 4096 + s) * 64 + d, v);
        } else if constexpr (T == T_CB) { const int cc = col - 2560, g = (cc >> 6) & 1, d = cc & 63;
            store_bf<W>((bf16*)(ws + (cc < 128 ? OFF_KCB : OFF_VCB)) + ((size_t)(b * 2 + g) * 4096 + s) * 64 + d, v);
        } else if constexpr (T == T_KROPE) { const int cc = col - 2816, g = (cc >> 6) & 1, d = cc & 63;
            store_bf<W>((bf16*)(ws + (cc < 128 ? OFF_KSEL : OFF_KWIN)) + (size_t)(b * 2 + g) * 262144 + ktile_off(s, d), v);
        } else if constexpr (T == T_VSW) { const int cc = col - 3072, g = (cc >> 6) & 1, d = cc & 63;
            store_bf<W>((bf16*)(ws + (cc < 128 ? OFF_VSEL : OFF_VWIN)) + (size_t)(b * 2 + g) * 262144 + vtile_off(s, d), v);
        } else if constexpr (T == T_QC) { const int cc = col - 3840, h = cc >> 6, d = cc & 63;
#pragma unroll
            for (int i = 0; i < W; ++i) v[i] *= C2;
            store_bf<W>((bf16*)(ws + OFF_QC) + ((size_t)(b * 8 + h) * 4096 + s) * 64 + d, v);
        } else if constexpr (T == T_KC) { const int cc = col - 4352, h = cc >> 6, d = cc & 63;
            store_bf<W>((bf16*)(ws + OFF_KC) + (size_t)(b * 8 + h) * 262144 + ktile_off(s, d), v);
        } else if constexpr (T == T_VC) { const int cc = col - 4864, hc = cc >> 7, d = cc & 127;
            store_bf<W>((bf16*)(ws + OFF_VC) + (size_t)(b * 4 + hc) * 524288 + v128_off(s, d), v);
        } else { const int cc = col - 5888;
            if (cc < 8) { float* o = (float*)(ws + OFF_LOGF) + (size_t)row * 8 + cc;
#pragma unroll
                for (int i = 0; i < W; ++i) o[i] = logsigmoidf_(v[i] + E.bfg[cc + i]) * LOG2E;
            } else if (cc < 32) { float* o = (float*)(ws + OFF_GATES) + (size_t)row * 24 + (cc - 8);
#pragma unroll
                for (int i = 0; i < W; ++i) o[i] = sigmoidf_(v[i]);
            }
        }
    } else if constexpr (KIND == EPI_GATE3) {
#pragma unroll
        for (int i = 0; i < W; ++i) v[i] = sigmoidf_(a[i] * p.rs);
        store_bf<W>((bf16*)(ws + OFF_G) + (size_t)E.gi * M * 1024 + idx, v);
    } else if constexpr (KIND == EPI_BR3) {
#pragma unroll
        for (int i = 0; i < W; ++i) v[i] = p.a[i] * a[i] + p.b[i];
        store_bf<W>((bf16*)(ws + OFF_T) + idx, v);
    } else if constexpr (KIND == EPI_GATE) {
#pragma unroll
        for (int i = 0; i < W; ++i) v[i] = sigmoidf_(a[i] * p.rs);
        store_bf<W>((bf16*)(ws + OFF_G) + idx, v);
    } else if constexpr (KIND == EPI_BR0 || KIND == EPI_BR1 || KIND == EPI_BR2) {
#pragma unroll
        for (int i = 0; i < W; ++i) { v[i] = p.a[i] * a[i]; if (KIND != EPI_BR0) v[i] += p.b[i]; }
        if constexpr (KIND == EPI_BR2) store_bf<W>((bf16*)(ws + OFF_MERGED) + idx, v);
        else store_bf<W>((bf16*)(ws + OFF_T) + idx, v);
    } else if constexpr (KIND == EPI_OUT) {
#pragma unroll
        for (int i = 0; i < W; ++i) v[i] = p.a[i] + a[i];
        st_f32x8(E.X + idx, v);
        store_bf<W>((bf16*)(ws + OFF_X1B) + idx, v);
    } else if constexpr (KIND == EPI_U) {
        store_bf<W>((bf16*)(ws + OFF_U) + idx, a);
    } else if constexpr (KIND == EPI_PLE) {
#pragma unroll
        for (int i = 0; i < W; ++i) v[i] = p.a[i] + sigmoidf_(a[i]) * p.b[i];
        st_f32x8(E.X + idx, v);
        store_bf<W>((bf16*)(ws + OFF_XB) + idx, v);
    }
}

__device__ __forceinline__ void d_xprep(int vb, int vt, const float* x, unsigned char* ws) {
    const int row = vb * 4 + (vt >> 6), lane = vt & 63;
    const f32x4* xr = (const f32x4*)(x + (size_t)row * 1024) + lane; float ss = 0.f;
    bf16* o = (bf16*)(ws + OFF_XB) + (size_t)row * 1024;
#pragma unroll
    for (int j = 0; j < 4; ++j) { const f32x4 v = xr[64 * j]; ss += (v[0] * v[0] + v[1] * v[1]) + (v[2] * v[2] + v[3] * v[3]); float t[4] = {v[0], v[1], v[2], v[3]}; store_bf<4>(o + 256 * j + 4 * lane, t); }
#pragma unroll
    for (int of = 1; of < 64; of <<= 1) ss += __shfl_xor(ss, of);
    if (lane == 0) { f32x4 s = {ss, 0.f, 0.f, 0.f}; *(f32x4*)(ws + OFF_SSP + (size_t)row * 16) = s; }
}
__device__ __forceinline__ void d_sumsq(int vb, int vt, const float* x, unsigned char* ws) {
    const int row = vb * 4 + (vt >> 6), lane = vt & 63;
    const f32x4* xr = (const f32x4*)(x + (size_t)row * 1024) + lane; float ss = 0.f;
#pragma unroll
    for (int j = 0; j < 4; ++j) { const f32x4 v = xr[64 * j]; ss += (v[0] * v[0] + v[1] * v[1]) + (v[2] * v[2] + v[3] * v[3]); }
#pragma unroll
    for (int of = 1; of < 64; of <<= 1) ss += __shfl_xor(ss, of);
    if (lane == 0) { f32x4 s = {ss, 0.f, 0.f, 0.f}; *(f32x4*)(ws + OFF_SSP + (size_t)row * 16) = s; }
}
__device__ __forceinline__ void d_rope_table(int vb, int vt, const int* pos, unsigned char* ws) {
    const int idx = vb * 256 + vt, row = idx >> 5, i = idx & 31;
    const float inv = exp2f(-(float)i * (13.287712379549449f / 32.f));
    const float ang = (float)pos[row] * inv;
    float s, c; sincosf(ang, &s, &c);
    ((float*)(ws + OFF_COS))[idx] = c; ((float*)(ws + OFF_SIN))[idx] = s;
}
__device__ __forceinline__ void d_pconv(int vb, int vt, const float* p, unsigned char* ws) {
    const size_t i = ((size_t)vb * 256 + vt) * 4;
    const f32x4 v = *(const f32x4*)(p + i); float t[4] = {v[0], v[1], v[2], v[3]}; store_bf<4>((bf16*)(ws + OFF_PB) + i, t);
}
constexpr size_t OFF_CBPART = OFF_CTL + 65536;
__device__ __forceinline__ void d_cb1_part(int u, int vt, const float* pe_k, const float* w1_k, const float* pe_v, const float* w1_v, unsigned char* ws) {
    const int kv = u >> 4, kc = u & 15, j = vt;
    const float* pe = (kv ? pe_v : pe_k) + 128 * kc; const float* w1 = (kv ? w1_v : w1_k) + (size_t)(128 * kc) * 256 + j;
    float acc = 0.f;
#pragma unroll 16
    for (int k = 0; k < 128; ++k) acc += pe[k] * w1[(size_t)k * 256];
    ((float*)(ws + OFF_CBPART))[(kv * 16 + kc) * 256 + j] = acc;
}
__device__ __forceinline__ void d_cb1_sum(int vt, const float* b1_k, const float* b1_v, unsigned char* ws) {
    const int kv = vt >> 8, j = vt & 255; float acc = (kv ? b1_v : b1_k)[j];
#pragma unroll
    for (int kc = 0; kc < 16; ++kc) acc += ((const float*)(ws + OFF_CBPART))[(kv * 16 + kc) * 256 + j];
    ((float*)(ws + OFF_CB1))[kv * 256 + j] = acc;
}
__device__ __forceinline__ void d_lam(int vt, const float* dl, unsigned char* ws, int l) {
    if (vt == 0) { float s1 = 0.f, s2 = 0.f; for (int i = 0; i < 64; ++i) { s1 += dl[i] * dl[64 + i]; s2 += dl[128 + i] * dl[192 + i]; }
        const float li = 0.8f - 0.6f * expf(-0.3f * (float)l); ((float*)(ws + OFF_CTL))[CTL_LAM + l] = expf(s1) - expf(s2) + li; }
}
__device__ __forceinline__ void d_cumsum(int vb, int vt, unsigned char* ws) {
    const int bh = vb, b = bh >> 3, h = bh & 7, lane = vt;
    const float* lf = (const float*)(ws + OFF_LOGF) + ((size_t)(b * 4096 + 64 * lane)) * 8 + h;
    float s = 0.f;
    for (int i = 0; i < 64; ++i) s += lf[i * 8];
    float incl = s;
#pragma unroll
    for (int of = 1; of < 64; of <<= 1) { const float t = __shfl_up(incl, of); if (lane >= of) incl += t; }
    float run = incl - s;
    float* cf = (float*)(ws + OFF_CF) + (size_t)bh * 4096 + 64 * lane;
    for (int i = 0; i < 64; ++i) { run += lf[i * 8]; cf[i] = run; }
}
__device__ __forceinline__ void d_compress(bool active, int vb, int vt, float* hid, unsigned char* ws) {
    const int c = vb & 255, bg = (vb >> 8) & 7, kv = vb >> 11, j = vt;
    bf16* dstK = (bf16*)(ws + OFF_KCMP) + (size_t)bg * 16384; bf16* dstV = (bf16*)(ws + OFF_VCMP) + (size_t)bg * 16384;
    const bool pad = (c == 255);
    if (active && pad) { if (j < 64) { if (kv == 0) dstK[ktile_off(c, j)] = 0; else dstV[vtile_off(c, j)] = 0; } }
    if (active && !pad) {
        const bf16* src = (const bf16*)(ws + (kv ? OFF_VCB : OFF_KCB)) + ((size_t)bg * 4096 + 16 * c) * 64;
        const bf16* w = (const bf16*)(ws + OFF_CW1) + (size_t)(kv * 256 + j) * 2048;
        float acc = ((const float*)(ws + OFF_CB1))[kv * 256 + j];
        for (int k = 0; k < 2048; k += 8) { const bf16x8 a = *(const bf16x8*)(src + k), bb = *(const bf16x8*)(w + k);
#pragma unroll
            for (int i = 0; i < 8; ++i) acc += bf2f((bf16)a[i]) * bf2f((bf16)bb[i]); }
        hid[j] = bf2f(f2bf(siluf_(acc)));
    }
    __syncthreads();
    if (active && !pad && j < 64) { const bf16* w2 = (const bf16*)(ws + OFF_CW2) + (size_t)(kv * 64 + j) * 256; float o = 0.f;
        for (int k = 0; k < 256; ++k) o += hid[k] * bf2f(w2[k]);
        if (kv == 0) dstK[ktile_off(c, j)] = f2bf(o); else dstV[vtile_off(c, j)] = f2bf(o); }
    __syncthreads();
}
__device__ __forceinline__ void d_fox(int vb, int vt, unsigned char* ws) {
    const int bh = (vb & 31), b = bh >> 3, h = bh & 7, t = (vb >> 5) * 64 + vt, tmax = (vb >> 5) * 64 + 63;
    const bf16* Q = (const bf16*)(ws + OFF_QA) + ((size_t)bh * 4096 + t) * 64;
    const bf16* Kb = (const bf16*)(ws + OFF_KA) + (size_t)bh * 262144; const bf16* Vb = (const bf16*)(ws + OFF_VA) + (size_t)bh * 262144;
    const float* cf = (const float*)(ws + OFF_CF) + (size_t)bh * 4096;
    float q[64], o[64];
#pragma unroll
    for (int d = 0; d < 64; ++d) { q[d] = bf2f(Q[d]); o[d] = 0.f; }
    const float ci = cf[t]; float m = -1e30f, l = 0.f;
    for (int j = 0; j <= tmax; ++j) {
        float s = 0.f;
#pragma unroll
        for (int d = 0; d < 64; ++d) s += q[d] * bf2f(Kb[ktile_off(j, d)]);
        s += ci - cf[j];
        if (j <= t) { const float mn = fmaxf(m, s), al = exp2f(m - mn), p = exp2f(s - mn); l = l * al + p; m = mn;
#pragma unroll
            for (int d = 0; d < 64; ++d) o[d] = o[d] * al + p * bf2f(Vb[vtile_off(j, d)]); }
    }
    const float il = 1.f / l; bf16* Y = (bf16*)(ws + OFF_ZA) + (size_t)(b * 4096 + t) * 512 + h * 64;
#pragma unroll
    for (int d = 0; d < 64; ++d) Y[d] = f2bf(o[d] * il * bf2f(Y[d]));
}
__device__ __forceinline__ void d_diff(int vb, int vt, float (*res)[129], unsigned char* ws, const float* subg, int l) {
    const int bhc = (vb & 15), b = bhc >> 2, hc = bhc & 3, t = (vb >> 4) * 64 + vt, tmax = (vb >> 4) * 64 + 63;
    const float lam = ((const float*)(ws + OFF_CTL))[CTL_LAM + l], lam_init = 0.8f - 0.6f * expf(-0.3f * (float)l);
    const bf16* Vb = (const bf16*)(ws + OFF_VC) + (size_t)bhc * 524288;
    for (int dh = 0; dh < 2; ++dh) {
        for (int mp = 0; mp < 2; ++mp) {
            const int hh = b * 8 + hc * 2 + mp;
            const bf16* Q = (const bf16*)(ws + OFF_QC) + ((size_t)hh * 4096 + t) * 64; const bf16* Kb = (const bf16*)(ws + OFF_KC) + (size_t)hh * 262144;
            float q[64], o[64];
#pragma unroll
            for (int d = 0; d < 64; ++d) { q[d] = bf2f(Q[d]); o[d] = 0.f; }
            float m = -1e30f, ls = 0.f;
            for (int j = 0; j <= tmax; ++j) {
                float s = 0.f;
#pragma unroll
                for (int d = 0; d < 64; ++d) s += q[d] * bf2f(Kb[ktile_off(j, d)]);
                if (j <= t) { const float mn = fmaxf(m, s), al = exp2f(m - mn), p = exp2f(s - mn); ls = ls * al + p; m = mn;
#pragma unroll
                    for (int d = 0; d < 64; ++d) o[d] = o[d] * al + p * bf2f(Vb[v128_off(j, dh * 64 + d)]); }
            }
            const float il = 1.f / ls;
#pragma unroll
            for (int d = 0; d < 64; ++d) { if (mp == 0) res[vt][dh * 64 + d] = o[d] * il; else res[vt][dh * 64 + d] -= lam * o[d] * il; }
        }
    }
    float ss = 0.f;
    for (int d = 0; d < 128; ++d) { const float v = res[vt][d]; ss += v * v; }
    const float rs = rsqrtf(ss * (1.f / 128.f) + EPS) * (1.f - lam_init);
    bf16* Y = (bf16*)(ws + OFF_ZC) + (size_t)(b * 4096 + t) * 512 + hc * 128;
    for (int d = 0; d < 128; ++d) Y[d] = f2bf(res[vt][d] * rs * subg[d] * bf2f(Y[d]));
}
__device__ __forceinline__ void d_nsa_topk(int vb, int vt, float (*imp)[65], unsigned char* ws) {
    const int bg = (vb & 7), b = bg >> 1, g = bg & 1, tb = (vb >> 3), t = tb * 64 + vt;
    for (int j = 0; j < 64; ++j) imp[vt][j] = 0.f;
    const int nv = (t >= 31) ? ((t - 31) >> 4) + 1 : 0, nvmax = ((tb * 64 + 63 - 31) >> 4) + 1;
    const bf16* Kc = (const bf16*)(ws + OFF_KCMP) + (size_t)bg * 16384;
    for (int hq = 0; hq < 4; ++hq) {
        const int h = g * 4 + hq;
        const bf16* Q = (const bf16*)(ws + OFF_QB) + ((size_t)(b * 8 + h) * 4096 + t) * 64;
        float q[64];
#pragma unroll
        for (int d = 0; d < 64; ++d) q[d] = bf2f(Q[d]);
        float m = -1e30f, ls = 0.f;
        for (int c = 0; c < nvmax; ++c) { float s = 0.f;
#pragma unroll
            for (int d = 0; d < 64; ++d) s += q[d] * bf2f(Kc[ktile_off(c, d)]);
            if (c < nv) { const float mn = fmaxf(m, s); ls = ls * exp2f(m - mn) + exp2f(s - mn); m = mn; } }
        const float il = nv > 0 ? 1.f / ls : 0.f;
        for (int c = 0; c < nvmax; ++c) { float s = 0.f;
#pragma unroll
            for (int d = 0; d < 64; ++d) s += q[d] * bf2f(Kc[ktile_off(c, d)]);
            if (c < nv) { const float p = exp2f(s - m) * il; imp[vt][c >> 2] += p; if ((c & 3) == 3 && (c >> 2) + 1 < 64) imp[vt][(c >> 2) + 1] += p; } }
    }
    for (int j = 0; j < 64; ++j) { const bool forced = (j == 0) || (j == tb) || (j == tb - 1), valid = j <= tb; const float v = imp[vt][j];
        imp[vt][j] = forced ? 1e30f : (valid ? v : -1e30f); }
    unsigned long long mask = 0ull;
    for (int j = 0; j < 64; ++j) { const float sj = imp[vt][j]; int rank = 0;
        for (int k = 0; k < 64; ++k) { const float sk = imp[vt][k]; rank += (sk > sj || (sk == sj && k < j)) ? 1 : 0; }
        if (rank < 16) mask |= (1ull << j); }
    ((unsigned long long*)(ws + OFF_SELM))[(size_t)bg * 4096 + t] = mask;
}
__device__ __forceinline__ void d_nsa_attn(int vb, int vt, float (*yl)[65], unsigned char* ws) {
    const int bh = (vb & 31), b = bh >> 3, h = bh & 7, g = h >> 2, bg = b * 2 + g, tb = (vb >> 5), t = tb * 64 + vt, row = b * 4096 + t;
    const bf16* Q = (const bf16*)(ws + OFF_QB) + ((size_t)bh * 4096 + t) * 64;
    float q[64], o[64];
#pragma unroll
    for (int d = 0; d < 64; ++d) { q[d] = bf2f(Q[d]); yl[vt][d] = 0.f; }
    const float* gt = (const float*)(ws + OFF_GATES) + (size_t)row * 24 + h * 3;
    const float g0 = gt[0], g1 = gt[1], g2 = gt[2];
    { const int nv = (t >= 31) ? ((t - 31) >> 4) + 1 : 0, nvmax = ((tb * 64 + 63 - 31) >> 4) + 1;
      const bf16* Kc = (const bf16*)(ws + OFF_KCMP) + (size_t)bg * 16384; const bf16* Vc = (const bf16*)(ws + OFF_VCMP) + (size_t)bg * 16384;
      float m = -1e30f, ls = 0.f;
#pragma unroll
      for (int d = 0; d < 64; ++d) o[d] = 0.f;
      for (int c = 0; c < nvmax; ++c) { float s = 0.f;
#pragma unroll
          for (int d = 0; d < 64; ++d) s += q[d] * bf2f(Kc[ktile_off(c, d)]);
          if (c < nv) { const float mn = fmaxf(m, s), al = exp2f(m - mn), p = exp2f(s - mn); ls = ls * al + p; m = mn;
#pragma unroll
              for (int d = 0; d < 64; ++d) o[d] = o[d] * al + p * bf2f(Vc[vtile_off(c, d)]); } }
      const float il = nv > 0 ? g0 / ls : 0.f;
#pragma unroll
      for (int d = 0; d < 64; ++d) yl[vt][d] += o[d] * il; }
    { const float* cs = (const float*)(ws + OFF_COS) + (size_t)row * 32; const float* sn = (const float*)(ws + OFF_SIN) + (size_t)row * 32;
#pragma unroll
      for (int i = 0; i < 32; ++i) { const float c = cs[i], s = sn[i], x1 = q[2 * i], x2 = q[2 * i + 1]; q[2 * i] = bf2f(f2bf(x1 * c - x2 * s)); q[2 * i + 1] = bf2f(f2bf(x2 * c + x1 * s)); } }
    { const unsigned long long mask = ((const unsigned long long*)(ws + OFF_SELM))[(size_t)bg * 4096 + t];
      const bf16* Kb = (const bf16*)(ws + OFF_KSEL) + (size_t)bg * 262144; const bf16* Vb = (const bf16*)(ws + OFF_VSEL) + (size_t)bg * 262144;
      float m = -1e30f, ls = 0.f;
#pragma unroll
      for (int d = 0; d < 64; ++d) o[d] = 0.f;
      for (int j = 0; j <= tb; ++j) { const bool sel = (mask >> j) & 1ull;
          for (int kk = 0; kk < 64; ++kk) { const int kp = j * 64 + kk; float s = 0.f;
#pragma unroll
              for (int d = 0; d < 64; ++d) s += q[d] * bf2f(Kb[ktile_off(kp, d)]);
              if (sel && kp <= t) { const float mn = fmaxf(m, s), al = exp2f(m - mn), p = exp2f(s - mn); ls = ls * al + p; m = mn;
#pragma unroll
                  for (int d = 0; d < 64; ++d) o[d] = o[d] * al + p * bf2f(Vb[vtile_off(kp, d)]); } } }
      const float il = g1 / ls;
#pragma unroll
      for (int d = 0; d < 64; ++d) yl[vt][d] += o[d] * il; }
    { const bf16* Kb = (const bf16*)(ws + OFF_KWIN) + (size_t)bg * 262144; const bf16* Vb = (const bf16*)(ws + OFF_VWIN) + (size_t)bg * 262144;
      float m = -1e30f, ls = 0.f;
#pragma unroll
      for (int d = 0; d < 64; ++d) o[d] = 0.f;
      const int k_lo = max(0, tb * 64 - 511), k_hi = tb * 64 + 63;
      for (int kp = k_lo; kp <= k_hi; ++kp) { float s = 0.f;
#pragma unroll
          for (int d = 0; d < 64; ++d) s += q[d] * bf2f(Kb[ktile_off(kp, d)]);
          if (kp <= t && kp > t - 512) { const float mn = fmaxf(m, s), al = exp2f(m - mn), p = exp2f(s - mn); ls = ls * al + p; m = mn;
#pragma unroll
              for (int d = 0; d < 64; ++d) o[d] = o[d] * al + p * bf2f(Vb[vtile_off(kp, d)]); } }
      const float il = g2 / ls;
#pragma unroll
      for (int d = 0; d < 64; ++d) yl[vt][d] += o[d] * il; }
    bf16* Y = (bf16*)(ws + OFF_ZB) + (size_t)row * 512 + h * 64;
#pragma unroll
    for (int d = 0; d < 64; ++d) Y[d] = f2bf(yl[vt][d] * bf2f(Y[d]));
}
__device__ __forceinline__ void d_final(int vb, int vt, float* X, const float* g) {
    const int row = vb * 4 + (vt >> 6), lane = vt & 63;
    f32x4* xr = (f32x4*)(X + (size_t)row * 1024) + lane; f32x4 v[4]; float ss = 0.f;
#pragma unroll
    for (int j = 0; j < 4; ++j) { v[j] = xr[64 * j]; ss += (v[j][0] * v[j][0] + v[j][1] * v[j][1]) + (v[j][2] * v[j][2] + v[j][3] * v[j][3]); }
#pragma unroll
    for (int of = 1; of < 64; of <<= 1) ss += __shfl_xor(ss, of);
    const float rs = rsqrtf(ss * (1.f / 1024.f) + EPS);
#pragma unroll
    for (int j = 0; j < 4; ++j) { const f32x4 gg = *((const f32x4*)g + 64 * j + lane); xr[64 * j] = v[j] * rs * gg; }
}


namespace pg8 {
#define PG8_LAS __attribute__((address_space(3)))
typedef unsigned short bf16_t;
typedef short bf16x8 __attribute__((ext_vector_type(8)));
typedef float f32x4 __attribute__((ext_vector_type(4)));
typedef unsigned u32x4 __attribute__((ext_vector_type(4)));
constexpr int BM = 256, BK = 64, HALF = 128, HTB = HALF * BK * 2  , STAGE_BYTES = 8 * HTB, NXCD = 8, WGM = 8;

__host__ __device__ __forceinline__ int lds_byte(int r, int c) { const int st = (r >> 4) * 2 + (c >> 5), rr = r & 15, cc = c & 31, ob = rr * 64 + cc * 2; return st * 1024 + (ob ^ (((ob >> 9) & 1) << 5)); }
__host__ __device__ __forceinline__ void stage_rc(int b, int& R, int& C) { const int st = b / 1024, sb = b % 1024, swz = sb ^ (((sb >> 9) & 1) << 5); R = (st >> 1) * 16 + swz / 64; C = (st & 1) * 32 + (swz % 64) / 2; }
__host__ __device__ __forceinline__ int perm32(int rho) { const int n = rho >> 4, i = rho & 15; return 8 * (i >> 2) + 4 * n + (i & 3); }

struct Unit { int pm, pn; };
struct Gemm { const bf16_t* A; const bf16_t* Bt; int M, N, K; };

struct StaticOrder {
    int nM, nN, nwg, G, c;
    __host__ __device__ void init(int M, int N, int G_, int c_) { nM = M / BM; nN = N / BM; nwg = nM * nN; G = G_; c = c_; }
    __host__ __device__ bool next(int i, Unit& u) const {
        const long L = (long)i * G + c; if (L >= nwg) return false;
        int wgid = (int)L; { const int q = nwg / NXCD, r = nwg % NXCD, xcd = wgid % NXCD, off = wgid / NXCD; wgid = (xcd < r ? xcd * (q + 1) : r * (q + 1) + (xcd - r) * q) + off; }
        const int nig = WGM * nN, gid = wgid / nig, fm = gid * WGM, gsz = (nM - fm) < WGM ? (nM - fm) : WGM;
        u.pm = fm + ((wgid % nig) % gsz); u.pn = (wgid % nig) / gsz; return true;
    }
    __device__ __forceinline__ void a_ready(const Unit&) const {}
    __device__ __forceinline__ void done(const Unit&) const {}
};

__device__ __forceinline__ unsigned cvt_pk_bf16(float lo, float hi) { unsigned r; asm volatile("v_cvt_pk_bf16_f32 %0, %1, %2" : "=v"(r) : "v"(lo), "v"(hi)); return r; }
typedef float f32x2 __attribute__((ext_vector_type(2)));
template <class Epi, class Sched, bool ALIGN_EPI = false, bool SP2 = false>
__device__ __forceinline__ void gemm_phase(PG8_LAS unsigned char* lds, const Gemm g, const Sched& S, const Epi& E) {
    int tid_o = threadIdx.x; asm volatile("" : "+v"(tid_o));
    const int tid = tid_o, wid = __builtin_amdgcn_readfirstlane(tid >> 6), lane = tid & 63, wr = wid >> 2, wc = wid & 3, fr = lane & 15, fq = lane >> 4;
    const int K = g.K, nt = K / BK;
    unsigned voffA[2], voffB[2];
#pragma unroll
    for (int i = 0; i < 2; ++i) { int R, C; stage_rc(tid * 16 + i * 8192, R, C); const int Rb = Epi::PERM ? ((R & ~31) + perm32(R & 31)) : R;
        voffA[i] = (unsigned)(R * K + C) * 2u; voffB[i] = (unsigned)(Rb * K + C) * 2u; }
    const size_t kstep = (size_t)(BK * 2);
    const size_t hstep = (size_t)HALF * K * 2;
    const size_t tstep = 2 * hstep;
    const unsigned ldsw = (unsigned)wid * 1024u;
    const int aoff = lds_byte(wr * 64 + fr, fq * 8), boff = lds_byte(wc * 32 + fr, fq * 8);
#define PG8_SA(b, h) (((b) * 2 + (h)) * HTB)
#define PG8_SB(b, h) ((4 + (b) * 2 + (h)) * HTB)
#define PG8_STAGE(bufoff, gbase, voff) do { _Pragma("unroll") for (int _i = 0; _i < 2; ++_i) \
        __builtin_amdgcn_global_load_lds((const unsigned*)((const char*)(gbase) + (voff)[_i]), (PG8_LAS unsigned*)(lds + (bufoff) + ldsw + _i * 8192), 16, 0, 0); } while (0)
#define PG8_LDA(dst, b, h) do { _Pragma("unroll") for (int m = 0; m < 4; ++m) _Pragma("unroll") for (int k = 0; k < 2; ++k) dst[m][k] = *(const PG8_LAS bf16x8*)(lds + PG8_SA(b, h) + aoff + m * 2048 + k * 1024); } while (0)
#define PG8_LDB(dst, b, h) do { _Pragma("unroll") for (int n = 0; n < 2; ++n) _Pragma("unroll") for (int k = 0; k < 2; ++k) dst[n][k] = *(const PG8_LAS bf16x8*)(lds + PG8_SB(b, h) + boff + n * 2048 + k * 1024); } while (0)
#define PG8_MMA(ai, bj, At, Bt) do { __builtin_amdgcn_s_setprio(1); _Pragma("unroll") for (int m = 0; m < 4; ++m) _Pragma("unroll") for (int n = 0; n < 2; ++n) _Pragma("unroll") for (int k = 0; k < 2; ++k) \
        acc[ai][bj][m][n] = __builtin_amdgcn_mfma_f32_16x16x32_bf16(Bt[n][k], At[m][k], acc[ai][bj][m][n], 0, 0, 0); __builtin_amdgcn_s_setprio(0); } while (0)
#define PG8_WAIT_V(n) asm volatile("s_waitcnt vmcnt(" #n ")" ::: "memory")
#define PG8_WAIT_L(n) asm volatile("s_waitcnt lgkmcnt(" #n ")" ::: "memory")
#define PG8_BAR __builtin_amdgcn_s_barrier()
#define PG8_SCHED __builtin_amdgcn_sched_barrier(0)
    Unit cur, nxt; int ui = 0;
    if (!S.next(0, cur)) return;
    f32x4 acc[2][2][4][2];
#pragma unroll
    for (int a = 0; a < 2; ++a)
#pragma unroll
        for (int b = 0; b < 2; ++b)
#pragma unroll
            for (int m = 0; m < 4; ++m)
#pragma unroll
                for (int n = 0; n < 2; ++n) acc[a][b][m][n] = (f32x4){0.f, 0.f, 0.f, 0.f};
    bf16x8 At[4][2], B0[2][2], B1[2][2];
    const char* cA = (const char*)g.A + (size_t)cur.pm * tstep; const char* cB = (const char*)g.Bt + (size_t)cur.pn * tstep;
    S.a_ready(cur);
    if constexpr (SP2) {
        PG8_STAGE(PG8_SB(0, 0), cB, voffB); PG8_STAGE(PG8_SB(0, 1), cB + hstep, voffB); PG8_STAGE(PG8_SA(0, 0), cA, voffA); PG8_STAGE(PG8_SA(0, 1), cA + hstep, voffA);
        if (wr == 1) PG8_BAR;
        PG8_WAIT_V(2); PG8_BAR;
        PG8_STAGE(PG8_SB(1, 0), cB + kstep, voffB); PG8_STAGE(PG8_SA(1, 0), cA + kstep, voffA); PG8_STAGE(PG8_SB(1, 1), cB + hstep + kstep, voffB);
        PG8_WAIT_V(6); PG8_BAR;
    } else {
        PG8_STAGE(PG8_SB(0, 0), cB, voffB); PG8_STAGE(PG8_SA(0, 0), cA, voffA); PG8_STAGE(PG8_SB(0, 1), cB + hstep, voffB); PG8_STAGE(PG8_SA(0, 1), cA + hstep, voffA);
        if (wr == 1) PG8_BAR;
        PG8_WAIT_V(4); PG8_BAR;
        PG8_STAGE(PG8_SB(1, 0), cB + kstep, voffB); PG8_STAGE(PG8_SA(1, 0), cA + kstep, voffA); PG8_STAGE(PG8_SB(1, 1), cB + hstep + kstep, voffB);
        PG8_WAIT_V(6); PG8_BAR;
    }
    for (;;) {
        const bool has_next = S.next(ui + 1, nxt);
        const char* nA = has_next ? (const char*)g.A + (size_t)nxt.pm * tstep : cA; const char* nB = has_next ? (const char*)g.Bt + (size_t)nxt.pn * tstep : cB;
        for (int t = 0; t < nt; t += 2) {
            const bool last = (t == nt - 2);
            const char* a1 = cA + (size_t)(t + 1) * kstep;
            const char* a2 = last ? nA : cA + (size_t)(t + 2) * kstep; const char* b2 = last ? nB : cB + (size_t)(t + 2) * kstep;
            const char* a3 = a2 + kstep; const char* b3 = b2 + kstep;
            if (last && has_next) S.a_ready(nxt);
            if constexpr (SP2) {
            PG8_LDB(B0, 0, 0); PG8_LDB(B1, 0, 1); PG8_SCHED; PG8_LDA(At, 0, 0); PG8_STAGE(PG8_SA(1, 1), a1 + hstep, voffA);
            PG8_WAIT_V(8); PG8_WAIT_L(0); PG8_BAR; PG8_MMA(0, 0, At, B0); PG8_MMA(0, 1, At, B1); PG8_BAR; PG8_SCHED;
            PG8_LDA(At, 0, 1); PG8_STAGE(PG8_SB(0, 0), b2, voffB); PG8_STAGE(PG8_SB(0, 1), b2 + hstep, voffB); PG8_STAGE(PG8_SA(0, 0), a2, voffA);
            PG8_WAIT_V(8); PG8_WAIT_L(0); PG8_BAR; PG8_MMA(1, 0, At, B0); PG8_MMA(1, 1, At, B1); PG8_BAR; PG8_SCHED;
            PG8_LDB(B0, 1, 0); PG8_LDB(B1, 1, 1); PG8_SCHED; PG8_LDA(At, 1, 0); PG8_STAGE(PG8_SA(0, 1), a2 + hstep, voffA);
            PG8_WAIT_V(8); PG8_WAIT_L(0); PG8_BAR; PG8_MMA(0, 0, At, B0); PG8_MMA(0, 1, At, B1); PG8_BAR; PG8_SCHED;
            PG8_LDA(At, 1, 1); PG8_STAGE(PG8_SB(1, 0), b3, voffB); PG8_STAGE(PG8_SB(1, 1), b3 + hstep, voffB); PG8_STAGE(PG8_SA(1, 0), a3, voffA);
            PG8_WAIT_V(8); PG8_WAIT_L(0); PG8_BAR; PG8_MMA(1, 0, At, B0); PG8_MMA(1, 1, At, B1); PG8_BAR; PG8_SCHED;
            } else {
            PG8_LDB(B0, 0, 0); PG8_SCHED; PG8_LDA(At, 0, 0); PG8_STAGE(PG8_SA(1, 1), a1 + hstep, voffA);
            PG8_WAIT_L(8); PG8_BAR; PG8_WAIT_L(0); PG8_MMA(0, 0, At, B0); PG8_BAR; PG8_SCHED;
            PG8_LDB(B1, 0, 1); PG8_STAGE(PG8_SB(0, 0), b2, voffB);
            PG8_BAR; PG8_WAIT_L(0); PG8_MMA(0, 1, At, B1); PG8_BAR;
            PG8_LDA(At, 0, 1); PG8_STAGE(PG8_SA(0, 0), a2, voffA);
            PG8_BAR; PG8_WAIT_L(0); PG8_MMA(1, 0, At, B0); PG8_BAR; PG8_SCHED;
            PG8_STAGE(PG8_SB(0, 1), b2 + hstep, voffB);
            PG8_WAIT_V(6); PG8_BAR; PG8_MMA(1, 1, At, B1); PG8_BAR;
            PG8_LDB(B0, 1, 0); PG8_SCHED; PG8_LDA(At, 1, 0); PG8_STAGE(PG8_SA(0, 1), a2 + hstep, voffA);
            PG8_WAIT_L(8); PG8_BAR; PG8_WAIT_L(0); PG8_MMA(0, 0, At, B0); PG8_BAR; PG8_SCHED;
            PG8_LDB(B1, 1, 1); PG8_STAGE(PG8_SB(1, 0), b3, voffB);
            PG8_BAR; PG8_WAIT_L(0); PG8_MMA(0, 1, At, B1); PG8_BAR;
            PG8_LDA(At, 1, 1); PG8_STAGE(PG8_SA(1, 0), a3, voffA);
            PG8_BAR; PG8_WAIT_L(0); PG8_MMA(1, 0, At, B0); PG8_BAR; PG8_SCHED;
            PG8_STAGE(PG8_SB(1, 1), b3 + hstep, voffB);
            PG8_WAIT_V(6); PG8_BAR; PG8_MMA(1, 1, At, B1); PG8_BAR;
            }
        }
        if constexpr (ALIGN_EPI) { if (wr == 0) PG8_BAR; }
        if constexpr (!Epi::AFTER_DRAIN) { E(acc, cur, wr, wc, fr, fq); S.done(cur); }
        if (!has_next) break;
#pragma unroll
        for (int a = 0; a < 2; ++a)
#pragma unroll
            for (int b = 0; b < 2; ++b)
#pragma unroll
                for (int m = 0; m < 4; ++m)
#pragma unroll
                    for (int n = 0; n < 2; ++n) acc[a][b][m][n] = (f32x4){0.f, 0.f, 0.f, 0.f};
        cur = nxt; cA = nA; cB = nB; ++ui;
        if constexpr (ALIGN_EPI) { if (wr == 1) PG8_BAR; }
    }
    PG8_WAIT_V(0);
    if constexpr (!ALIGN_EPI) { if (wr == 0) PG8_BAR; }
    PG8_BAR;
    if constexpr (Epi::AFTER_DRAIN) { E.fused(acc, cur, wr, wc, fr, fq, lds, wid, lane); S.done(cur); }
#undef PG8_SA
#undef PG8_SB
#undef PG8_STAGE
#undef PG8_LDA
#undef PG8_LDB
#undef PG8_MMA
#undef PG8_WAIT_V
#undef PG8_WAIT_L
#undef PG8_BAR
#undef PG8_SCHED
}
}

template <int KIND> struct EpiFast {
    static constexpr bool PERM = true, AFTER_DRAIN = false;
    EpiCtx E;
    template <int T, int AI, int MH> __device__ __forceinline__ void grp(const pg8::f32x4 (&acc)[2][2][4][2], int row0, int col0, const float (&rs)[2][4]) const {
        Pre p00, p01, p10, p11;
        p00.rs = p01.rs = rs[AI][2 * MH]; p10.rs = p11.rs = rs[AI][2 * MH + 1];
        const int r0 = row0 + AI * 128 + (2 * MH) * 16, r1 = r0 + 16;
        if constexpr (KIND == EPI_PLE) {
            pre_load<KIND, T>(E, r0, col0, p00); pre_load<KIND, T>(E, r0, col0 + 128, p01);
            { const pg8::f32x4 v0 = acc[AI][0][2 * MH][0], v1 = acc[AI][0][2 * MH][1]; float v[8] = {v0[0], v0[1], v0[2], v0[3], v1[0], v1[1], v1[2], v1[3]}; emit_fin<KIND, T>(E, r0, col0, v, p00); }
            { const pg8::f32x4 v0 = acc[AI][1][2 * MH][0], v1 = acc[AI][1][2 * MH][1]; float v[8] = {v0[0], v0[1], v0[2], v0[3], v1[0], v1[1], v1[2], v1[3]}; emit_fin<KIND, T>(E, r0, col0 + 128, v, p01); }
            asm volatile("" ::: "memory");
            pre_load<KIND, T>(E, r1, col0, p10); pre_load<KIND, T>(E, r1, col0 + 128, p11);
            { const pg8::f32x4 v0 = acc[AI][0][2 * MH + 1][0], v1 = acc[AI][0][2 * MH + 1][1]; float v[8] = {v0[0], v0[1], v0[2], v0[3], v1[0], v1[1], v1[2], v1[3]}; emit_fin<KIND, T>(E, r1, col0, v, p10); }
            { const pg8::f32x4 v0 = acc[AI][1][2 * MH + 1][0], v1 = acc[AI][1][2 * MH + 1][1]; float v[8] = {v0[0], v0[1], v0[2], v0[3], v1[0], v1[1], v1[2], v1[3]}; emit_fin<KIND, T>(E, r1, col0 + 128, v, p11); }
            asm volatile("" ::: "memory");
            return;
        }
        pre_load<KIND, T>(E, r0, col0, p00); pre_load<KIND, T>(E, r0, col0 + 128, p01); pre_load<KIND, T>(E, r1, col0, p10); pre_load<KIND, T>(E, r1, col0 + 128, p11);
        { const pg8::f32x4 v0 = acc[AI][0][2 * MH][0], v1 = acc[AI][0][2 * MH][1]; float v[8] = {v0[0], v0[1], v0[2], v0[3], v1[0], v1[1], v1[2], v1[3]}; emit_fin<KIND, T>(E, r0, col0, v, p00); }
        { const pg8::f32x4 v0 = acc[AI][1][2 * MH][0], v1 = acc[AI][1][2 * MH][1]; float v[8] = {v0[0], v0[1], v0[2], v0[3], v1[0], v1[1], v1[2], v1[3]}; emit_fin<KIND, T>(E, r0, col0 + 128, v, p01); }
        { const pg8::f32x4 v0 = acc[AI][0][2 * MH + 1][0], v1 = acc[AI][0][2 * MH + 1][1]; float v[8] = {v0[0], v0[1], v0[2], v0[3], v1[0], v1[1], v1[2], v1[3]}; emit_fin<KIND, T>(E, r1, col0, v, p10); }
        { const pg8::f32x4 v0 = acc[AI][1][2 * MH + 1][0], v1 = acc[AI][1][2 * MH + 1][1]; float v[8] = {v0[0], v0[1], v0[2], v0[3], v1[0], v1[1], v1[2], v1[3]}; emit_fin<KIND, T>(E, r1, col0 + 128, v, p11); }
        asm volatile("" ::: "memory");
    }
    template <int T> __device__ __forceinline__ void run(const pg8::f32x4 (&acc)[2][2][4][2], int row0, int col0) const {
        float rs[2][4];
        if constexpr (KIND == EPI_INPROJ || KIND == EPI_GATE || KIND == EPI_GATE3) {
#pragma unroll
            for (int ai = 0; ai < 2; ++ai)
#pragma unroll
                for (int m = 0; m < 4; ++m) rs[ai][m] = row_rstd(E.ws, row0 + ai * 128 + m * 16);
        } else {
#pragma unroll
            for (int ai = 0; ai < 2; ++ai)
#pragma unroll
                for (int m = 0; m < 4; ++m) rs[ai][m] = 1.f; }
        grp<T, 0, 0>(acc, row0, col0, rs); grp<T, 0, 1>(acc, row0, col0, rs); grp<T, 1, 0>(acc, row0, col0, rs); grp<T, 1, 1>(acc, row0, col0, rs);
    }
    __device__ __forceinline__ void operator()(const pg8::f32x4 (&acc)[2][2][4][2], const pg8::Unit& u, int wr, int wc, int fr, int fq) const {
        const int row0 = u.pm * 256 + wr * 64 + fr, col0 = u.pn * 256 + wc * 32 + 8 * fq;
        if constexpr (KIND == EPI_INPROJ) {
            switch (inproj_type(u.pn)) {
                case T_QA: run<T_QA>(acc, row0, col0); break;
                case T_KA: run<T_KA>(acc, row0, col0); break;
                case T_VA: run<T_VA>(acc, row0, col0); break;
                case T_ZA: run<T_ZA>(acc, row0, col0); break;
                case T_QB: run<T_QB>(acc, row0, col0); break;
                case T_CB: run<T_CB>(acc, row0, col0); break;
                case T_KROPE: run<T_KROPE>(acc, row0, col0); break;
                case T_VSW: run<T_VSW>(acc, row0, col0); break;
                case T_ZB: run<T_ZB>(acc, row0, col0); break;
                case T_QC: run<T_QC>(acc, row0, col0); break;
                case T_KC: run<T_KC>(acc, row0, col0); break;
                case T_VC: run<T_VC>(acc, row0, col0); break;
                case T_ZC: run<T_ZC>(acc, row0, col0); break;
                default: run<T_SPECIAL>(acc, row0, col0); break;
            }
        } else if constexpr (KIND == EPI_GATE3 || KIND == EPI_BR3) {
            EpiFast<KIND> t = *this; t.E.gi = u.pn >> 2;
            t.template run<0>(acc, (u.pm & 63) * 256 + wr * 64 + fr, (u.pn & 3) * 256 + wc * 32 + 8 * fq);
        } else run<0>(acc, row0, col0);
    }
};
struct ChainOrder {
    int pm, pn4, rowmul;
    __device__ __forceinline__ void init(int G, int c, int rowmul_) { pg8::StaticOrder S0; S0.init(M, 1024, G, c); pg8::Unit u0; S0.next(0, u0); pm = u0.pm; pn4 = u0.pn; rowmul = rowmul_; }
    __device__ __forceinline__ bool next(int i, pg8::Unit& u) const { if (i >= 3) return false; u.pm = pm + 64 * i * rowmul; u.pn = 4 * i + pn4; return true; }
    __device__ __forceinline__ void a_ready(const pg8::Unit&) const {}
    __device__ __forceinline__ void done(const pg8::Unit&) const {}
};
#define FAST_GEMM(KIND, Aptr, Bptr, N_, K_, ALIGN) do { pg8::Gemm g_{(const pg8::bf16_t*)(Aptr), (const pg8::bf16_t*)(Bptr), M, (N_), (K_)}; pg8::StaticOrder S_; S_.init(M, (N_), (int)gridDim.x, (int)blockIdx.x); \
        EpiFast<KIND> Ep_{E}; pg8::gemm_phase<EpiFast<KIND>, pg8::StaticOrder, ALIGN, true>((PG8_LAS unsigned char*)lds, g_, S_, Ep_); } while (0)

#define LAS __attribute__((address_space(3)))
typedef short s16x4 __attribute__((ext_vector_type(4)));
typedef short v4i16_t __attribute__((ext_vector_type(4)));
typedef LAS const char* lds_cptr;
constexpr int A_KRING = 0, A_VRING = 49152, A_CFRING = 98304, A_MISC = 104448;
constexpr int A_SLOT = 16384;
constexpr int A_IMP = A_MISC, A_SELM = A_MISC + 16384, A_UMASK = A_SELM + 512, A_SEQ = A_UMASK + 16, A_WQ = A_SEQ + 80;
__device__ __forceinline__ void glds16(const void* gsrc, unsigned lds_dst) { unsigned keep;
    asm volatile("s_mov_b32 %0, m0\n\ts_mov_b32 m0, %2\n\ts_nop 0\n\tglobal_load_lds_dwordx4 %1, off\n\ts_mov_b32 m0, %0" : "=&s"(keep) : "v"(gsrc), "s"(lds_dst) : "memory"); }
__device__ __forceinline__ void glds4(const void* gsrc, unsigned lds_dst) { unsigned keep;
    asm volatile("s_mov_b32 %0, m0\n\ts_mov_b32 m0, %2\n\ts_nop 0\n\tglobal_load_lds_dword %1, off\n\ts_mov_b32 m0, %0" : "=&s"(keep) : "v"(gsrc), "s"(lds_dst) : "memory"); }
#define A_WAIT_BAR(N) asm volatile("s_waitcnt vmcnt(" #N ") lgkmcnt(0)\n\ts_barrier" ::: "memory")
__device__ __forceinline__ s16x4 vtr(lds_cptr p) { return __builtin_bit_cast(s16x4, __builtin_amdgcn_ds_read_tr16_b64_v4i16((LAS v4i16_t*)p)); }
__device__ __forceinline__ unsigned cvtpk(float lo, float hi) { typedef float f2 __attribute__((ext_vector_type(2))); typedef __bf16 b2 __attribute__((ext_vector_type(2))); f2 v = {lo, hi}; b2 b = __builtin_convertvector(v, b2); return __builtin_bit_cast(unsigned, b); }
__device__ __forceinline__ int crow(int r, int hi) { return (r & 3) + 8 * (r >> 2) + 4 * hi; }

template <int NDB> struct FlashSt { f32x16 o[NDB]; float m, l; };
template <int NDB> __device__ __forceinline__ void flash_init(FlashSt<NDB>& st) {
#pragma unroll
    for (int i = 0; i < NDB; ++i)
#pragma unroll
        for (int r = 0; r < 16; ++r) st.o[i][r] = 0.f;
    st.m = -1e30f; st.l = 0.f;
}
template <int NDB> __device__ __forceinline__ void flash_init3(FlashSt<NDB>& st) { flash_init<NDB>(st); st.m = 0.f; }
__device__ __forceinline__ void qk_tile(f32x16& p0, f32x16& p1, lds_cptr kslot, const bf16x8 (&qf)[4], int r32, int hi) {
    const lds_cptr kb = kslot + hi * 1024 + r32 * 16;
    bf16x8 ka[4], kc[4];
#pragma unroll
    for (int d0 = 0; d0 < 4; ++d0) { ka[d0] = *(const LAS bf16x8*)(kb + d0 * 2048); kc[d0] = *(const LAS bf16x8*)(kb + d0 * 2048 + 512); }
#pragma unroll
    for (int d0 = 0; d0 < 4; ++d0) {
        p0 = __builtin_amdgcn_mfma_f32_32x32x16_bf16(ka[d0], qf[d0], p0, 0, 0, 0);
        p1 = __builtin_amdgcn_mfma_f32_32x32x16_bf16(kc[d0], qf[d0], p1, 0, 0, 0);
    }
}
__device__ __forceinline__ float xhalf_max(float a) {
    auto rr = __builtin_amdgcn_permlane32_swap(__float_as_uint(a), __float_as_uint(a), false, false);
    return fmaxf(__uint_as_float(rr[0]), __uint_as_float(rr[1]));
}
__device__ __forceinline__ float rowmax32(const f32x16& p0, const f32x16& p1) {
    float a = fmaxf(p0[0], p1[0]);
#pragma unroll
    for (int r = 1; r < 16; ++r) a = fmaxf(a, fmaxf(p0[r], p1[r]));
    return xhalf_max(a);
}
template <int NDB> __device__ __forceinline__ void pv_tile(f32x16 (&o)[NDB], lds_cptr vslot_l, const f32x16& p0, const f32x16& p1) {
    bf16x8 pf[4];
    { u32x4 w;
      w.x = cvtpk(p0[0], p0[1]); w.y = cvtpk(p0[2], p0[3]); w.z = cvtpk(p0[4], p0[5]); w.w = cvtpk(p0[6], p0[7]); pf[0] = __builtin_bit_cast(bf16x8, w);
      w.x = cvtpk(p0[8], p0[9]); w.y = cvtpk(p0[10], p0[11]); w.z = cvtpk(p0[12], p0[13]); w.w = cvtpk(p0[14], p0[15]); pf[1] = __builtin_bit_cast(bf16x8, w);
      w.x = cvtpk(p1[0], p1[1]); w.y = cvtpk(p1[2], p1[3]); w.z = cvtpk(p1[4], p1[5]); w.w = cvtpk(p1[6], p1[7]); pf[2] = __builtin_bit_cast(bf16x8, w);
      w.x = cvtpk(p1[8], p1[9]); w.y = cvtpk(p1[10], p1[11]); w.z = cvtpk(p1[12], p1[13]); w.w = cvtpk(p1[14], p1[15]); pf[3] = __builtin_bit_cast(bf16x8, w); }
#pragma unroll
    for (int db = 0; db < NDB; ++db) {
        bf16x8 vf[4];
#pragma unroll
        for (int ks = 0; ks < 4; ++ks) { const s16x4 lo = vtr(vslot_l + db * 4096 + ks * 1024), hh = vtr(vslot_l + db * 4096 + ks * 1024 + 512);
            vf[ks] = (bf16x8){lo[0], lo[1], lo[2], lo[3], hh[0], hh[1], hh[2], hh[3]}; }
#pragma unroll
        for (int ks = 0; ks < 4; ++ks) o[db] = __builtin_amdgcn_mfma_f32_32x32x16_bf16(vf[ks], pf[ks], o[db], 0, 0, 0);
    }
}
template <int NDB> __device__ __forceinline__ void flash_update(FlashSt<NDB>& st, f32x16& p0, f32x16& p1, lds_cptr vslot_l) {
    const float rm = rowmax32(p0, p1);
    const float mn = fmaxf(st.m, rm), alpha = __builtin_amdgcn_exp2f(st.m - mn);
    st.m = mn;
    float ls = 0.f;
#pragma unroll
    for (int r = 0; r < 16; ++r) { p0[r] = __builtin_amdgcn_exp2f(p0[r] - mn); p1[r] = __builtin_amdgcn_exp2f(p1[r] - mn); ls += p0[r] + p1[r]; }
    st.l = st.l * alpha + ls;
#pragma unroll
    for (int db = 0; db < NDB; ++db)
#pragma unroll
        for (int r = 0; r < 16; ++r) st.o[db][r] *= alpha;
    pv_tile<NDB>(st.o, vslot_l, p0, p1);
}
__device__ __forceinline__ int lane_vbase(int lane) { return ((lane >> 4) & 1) * 32 + (lane & 3) * 8 + (4 * (lane >> 5) + ((lane & 15) >> 2)) * 64; }
#define DSR128(dst, addr, off) asm volatile("ds_read_b128 %0, %1 offset:%c2" : "=v"(dst) : "v"(addr), "i"(off) : "memory")
#define DSRTR(dst, addr, off) asm volatile("ds_read_b64_tr_b16 %0, %1 offset:%c2" : "=v"(dst) : "v"(addr), "i"(off) : "memory")
#define LGKM_WAIT0() do { asm volatile("s_waitcnt lgkmcnt(0)" ::: "memory"); __builtin_amdgcn_sched_barrier(0); } while (0)
__device__ __forceinline__ void qk_tile2(f32x16& p0, f32x16& p1, unsigned kaddr, const bf16x8 (&qf)[4]) {
    bf16x8 ka0, ka1, ka2, ka3, kc0, kc1, kc2, kc3;
    DSR128(ka0, kaddr, 0); DSR128(kc0, kaddr, 512); DSR128(ka1, kaddr, 2048); DSR128(kc1, kaddr, 2560);
    DSR128(ka2, kaddr, 4096); DSR128(kc2, kaddr, 4608); DSR128(ka3, kaddr, 6144); DSR128(kc3, kaddr, 6656);
    LGKM_WAIT0();
    p0 = __builtin_amdgcn_mfma_f32_32x32x16_bf16(ka0, qf[0], p0, 0, 0, 0); p1 = __builtin_amdgcn_mfma_f32_32x32x16_bf16(kc0, qf[0], p1, 0, 0, 0);
    p0 = __builtin_amdgcn_mfma_f32_32x32x16_bf16(ka1, qf[1], p0, 0, 0, 0); p1 = __builtin_amdgcn_mfma_f32_32x32x16_bf16(kc1, qf[1], p1, 0, 0, 0);
    p0 = __builtin_amdgcn_mfma_f32_32x32x16_bf16(ka2, qf[2], p0, 0, 0, 0); p1 = __builtin_amdgcn_mfma_f32_32x32x16_bf16(kc2, qf[2], p1, 0, 0, 0);
    p0 = __builtin_amdgcn_mfma_f32_32x32x16_bf16(ka3, qf[3], p0, 0, 0, 0); p1 = __builtin_amdgcn_mfma_f32_32x32x16_bf16(kc3, qf[3], p1, 0, 0, 0);
}
struct VFr { s16x4 lo[8], hi[8]; };
template <int DB0> __device__ __forceinline__ void v_issue(VFr& f, unsigned vaddr) {
    DSRTR(f.lo[0], vaddr, DB0 * 4096 + 0);    DSRTR(f.hi[0], vaddr, DB0 * 4096 + 512);
    DSRTR(f.lo[1], vaddr, DB0 * 4096 + 1024); DSRTR(f.hi[1], vaddr, DB0 * 4096 + 1536);
    DSRTR(f.lo[2], vaddr, DB0 * 4096 + 2048); DSRTR(f.hi[2], vaddr, DB0 * 4096 + 2560);
    DSRTR(f.lo[3], vaddr, DB0 * 4096 + 3072); DSRTR(f.hi[3], vaddr, DB0 * 4096 + 3584);
    DSRTR(f.lo[4], vaddr, DB0 * 4096 + 4096); DSRTR(f.hi[4], vaddr, DB0 * 4096 + 4608);
    DSRTR(f.lo[5], vaddr, DB0 * 4096 + 5120); DSRTR(f.hi[5], vaddr, DB0 * 4096 + 5632);
    DSRTR(f.lo[6], vaddr, DB0 * 4096 + 6144); DSRTR(f.hi[6], vaddr, DB0 * 4096 + 6656);
    DSRTR(f.lo[7], vaddr, DB0 * 4096 + 7168); DSRTR(f.hi[7], vaddr, DB0 * 4096 + 7680);
}
#define VFRAG(f, i) ((bf16x8){(f).lo[i][0], (f).lo[i][1], (f).lo[i][2], (f).lo[i][3], (f).hi[i][0], (f).hi[i][1], (f).hi[i][2], (f).hi[i][3]})
__device__ __forceinline__ void pv2(f32x16& oa, f32x16& ob, const VFr& f, const bf16x8 (&pf)[4]) {
    oa = __builtin_amdgcn_mfma_f32_32x32x16_bf16(VFRAG(f, 0), pf[0], oa, 0, 0, 0); ob = __builtin_amdgcn_mfma_f32_32x32x16_bf16(VFRAG(f, 4), pf[0], ob, 0, 0, 0);
    oa = __builtin_amdgcn_mfma_f32_32x32x16_bf16(VFRAG(f, 1), pf[1], oa, 0, 0, 0); ob = __builtin_amdgcn_mfma_f32_32x32x16_bf16(VFRAG(f, 5), pf[1], ob, 0, 0, 0);
    oa = __builtin_amdgcn_mfma_f32_32x32x16_bf16(VFRAG(f, 2), pf[2], oa, 0, 0, 0); ob = __builtin_amdgcn_mfma_f32_32x32x16_bf16(VFRAG(f, 6), pf[2], ob, 0, 0, 0);
    oa = __builtin_amdgcn_mfma_f32_32x32x16_bf16(VFRAG(f, 3), pf[3], oa, 0, 0, 0); ob = __builtin_amdgcn_mfma_f32_32x32x16_bf16(VFRAG(f, 7), pf[3], ob, 0, 0, 0);
}
__device__ __forceinline__ void pack_p(bf16x8 (&pf)[4], const f32x16& p0, const f32x16& p1) {
    u32x4 w;
    w.x = cvtpk(p0[0], p0[1]); w.y = cvtpk(p0[2], p0[3]); w.z = cvtpk(p0[4], p0[5]); w.w = cvtpk(p0[6], p0[7]); pf[0] = __builtin_bit_cast(bf16x8, w);
    w.x = cvtpk(p0[8], p0[9]); w.y = cvtpk(p0[10], p0[11]); w.z = cvtpk(p0[12], p0[13]); w.w = cvtpk(p0[14], p0[15]); pf[1] = __builtin_bit_cast(bf16x8, w);
    w.x = cvtpk(p1[0], p1[1]); w.y = cvtpk(p1[2], p1[3]); w.z = cvtpk(p1[4], p1[5]); w.w = cvtpk(p1[6], p1[7]); pf[2] = __builtin_bit_cast(bf16x8, w);
    w.x = cvtpk(p1[8], p1[9]); w.y = cvtpk(p1[10], p1[11]); w.z = cvtpk(p1[12], p1[13]); w.w = cvtpk(p1[14], p1[15]); pf[3] = __builtin_bit_cast(bf16x8, w);
}
template <int NDB> __device__ __forceinline__ void flash_update2(FlashSt<NDB>& st, f32x16& p0, f32x16& p1, unsigned vaddr) {
    VFr vf; v_issue<0>(vf, vaddr);
    const float rm = rowmax32(p0, p1);
    const float mn = fmaxf(st.m, rm), alpha = __builtin_amdgcn_exp2f(st.m - mn);
    st.m = mn;
    float ls = 0.f;
#pragma unroll
    for (int r = 0; r < 16; ++r) { p0[r] = __builtin_amdgcn_exp2f(p0[r] - mn); p1[r] = __builtin_amdgcn_exp2f(p1[r] - mn); ls += p0[r] + p1[r]; }
    st.l = st.l * alpha + ls;
#pragma unroll
    for (int db = 0; db < NDB; ++db)
#pragma unroll
        for (int r = 0; r < 16; ++r) st.o[db][r] *= alpha;
    bf16x8 pf[4]; pack_p(pf, p0, p1);
    LGKM_WAIT0();
    pv2(st.o[0], st.o[1], vf, pf);
    if constexpr (NDB == 4) { v_issue<2>(vf, vaddr); LGKM_WAIT0(); pv2(st.o[2], st.o[3], vf, pf); }
}
__device__ __forceinline__ float max3_(float a, float b, float c) { float r; asm("v_max3_f32 %0, %1, %2, %3" : "=v"(r) : "v"(a), "v"(b), "v"(c)); return r; }
__device__ __forceinline__ float rowmax32_asm(const f32x16& p0, const f32x16& p1) {
    float a = max3_(p0[0], p0[1], p1[0]), b = max3_(p0[2], p0[3], p1[1]); a = max3_(a, p1[2], p1[3]);
#pragma unroll
    for (int r = 4; r < 16; r += 4) { a = max3_(a, p0[r], p0[r + 1]); b = max3_(b, p0[r + 2], p0[r + 3]); a = max3_(a, p1[r], p1[r + 1]); b = max3_(b, p1[r + 2], p1[r + 3]); }
    float m; asm("v_max_f32_e32 %0, %1, %2" : "=v"(m) : "v"(a), "v"(b));
    auto rr = __builtin_amdgcn_permlane32_swap(__float_as_uint(m), __float_as_uint(m), false, false);
    float o; asm("v_max_f32_e32 %0, %1, %2" : "=v"(o) : "v"(__uint_as_float(rr[0])), "v"(__uint_as_float(rr[1]))); return o;
}
constexpr float FA_THR = 8.f;
template <int NDB> __device__ __forceinline__ bool flash_update3(FlashSt<NDB>& st, f32x16& p0, f32x16& p1, unsigned vaddr) {
    VFr vf; v_issue<0>(vf, vaddr);
    asm volatile("s_nop 15\n\ts_nop 7" : "+v"(p0), "+v"(p1));
    const float rm = rowmax32_asm(p0, p1);
    bool moved = false;
    if (__builtin_expect(__builtin_amdgcn_ballot_w64(rm > FA_THR) != 0ull, 0)) {
        const float dl = fmaxf(rm, 0.f), f = __builtin_amdgcn_exp2f(-dl);
        st.m += dl; st.l *= f;
#pragma unroll
        for (int r = 0; r < 16; ++r) { p0[r] -= dl; p1[r] -= dl; }
#pragma unroll
        for (int db = 0; db < NDB; ++db)
#pragma unroll
            for (int r = 0; r < 16; ++r) st.o[db][r] *= f;
        moved = true;
    }
    float ls = 0.f;
#pragma unroll
    for (int r = 0; r < 16; ++r) { p0[r] = __builtin_amdgcn_exp2f(p0[r]); p1[r] = __builtin_amdgcn_exp2f(p1[r]); ls += p0[r] + p1[r]; }
    st.l += ls;
    bf16x8 pf[4]; pack_p(pf, p0, p1);
    LGKM_WAIT0();
    pv2(st.o[0], st.o[1], vf, pf);
    if constexpr (NDB == 4) { v_issue<2>(vf, vaddr); LGKM_WAIT0(); pv2(st.o[2], st.o[3], vf, pf); }
    return moved;
}
__device__ __forceinline__ void pv_only2(f32x16 (&o)[2], unsigned vaddr, const f32x16& p0, const f32x16& p1) {
    VFr vf; v_issue<0>(vf, vaddr); bf16x8 pf[4]; pack_p(pf, p0, p1); LGKM_WAIT0(); pv2(o[0], o[1], vf, pf);
}

__device__ __forceinline__ void fox_unit(unsigned char* lds, unsigned char* ws, int bh, int qb, int dry = 0) {
    int tid_o = threadIdx.x; asm volatile("" : "+v"(tid_o));
    const int tid = tid_o, lane = tid & 63, wid = __builtin_amdgcn_readfirstlane(tid >> 6), r32 = lane & 31, hi = lane >> 5;
    const unsigned lds0 = (unsigned)(uintptr_t)lds;
    const lds_cptr L = (lds_cptr)lds;
    const int qrow = 256 * qb + 32 * wid + r32, wrow0 = 256 * qb + 32 * wid;
    const int NTl = 4 * (qb + 1);
    const char* Kg = (const char*)(ws + OFF_KA) + (size_t)bh * 524288 + wid * 1024 + lane * 16;
    const char* Vg = (const char*)(ws + OFF_VA) + (size_t)bh * 524288 + wid * 1024 + lane * 16;
    const char* Cg = (const char*)(ws + OFF_CF) + (size_t)bh * 16384 + lane * 4;
    const unsigned kdst = (unsigned)__builtin_amdgcn_readfirstlane(lds0 + A_KRING + wid * 1024), vdst = (unsigned)__builtin_amdgcn_readfirstlane(lds0 + A_VRING + wid * 1024),
                   cdst = (unsigned)__builtin_amdgcn_readfirstlane(lds0 + A_CFRING + wid * 256);
#define FOX_DMA(t, slot) do { glds16(Kg + (size_t)(t) * 8192, kdst + (slot) * A_SLOT); glds16(Vg + (size_t)(t) * 8192, vdst + (slot) * A_SLOT); glds4(Cg + (size_t)(t) * 256, cdst + (slot) * 2048); } while (0)
    asm volatile("s_waitcnt vmcnt(0)" ::: "memory");
    FOX_DMA(0, 0); FOX_DMA(1, 1);
    bf16x8 qf[4];
    { const bf16* Q = (const bf16*)(ws + OFF_QA) + ((size_t)bh * 4096 + qrow) * 64 + 8 * hi;
#pragma unroll
      for (int d0 = 0; d0 < 4; ++d0) qf[d0] = *(const bf16x8*)(Q + 16 * d0); }
    FlashSt<2> st; flash_init3<2>(st);
    const int vb = lane_vbase(lane);
    const unsigned kaddr0 = lds0 + A_KRING + hi * 1024 + r32 * 16, vaddr0 = lds0 + A_VRING + vb;
    asm volatile("" : "+v"(qf[0]), "+v"(qf[1]), "+v"(qf[2]), "+v"(qf[3]));
    asm volatile("s_waitcnt vmcnt(0)" ::: "memory");
    asm volatile("s_barrier" ::: "memory");
    int slot = 0;
    for (int t = 0; t < NTl; ++t) {
        const int s2 = (slot >= 1) ? slot - 1 : 2;
        if (t + 2 < NTl) FOX_DMA(t + 2, s2);
        if (64 * t <= wrow0 + 31 && dry != 4) {
            f32x16 p0, p1;
            { const unsigned ca = lds0 + A_CFRING + slot * 2048 + wid * 256 + 16 * hi; f32x4 c0, c1, c2, c3, c4, c5, c6, c7;
              DSR128(c0, ca, 0); DSR128(c1, ca, 32); DSR128(c2, ca, 64); DSR128(c3, ca, 96); DSR128(c4, ca, 128); DSR128(c5, ca, 160); DSR128(c6, ca, 192); DSR128(c7, ca, 224);
              LGKM_WAIT0();
              p0 = __builtin_shufflevector(__builtin_shufflevector(c0, c1, 0, 1, 2, 3, 4, 5, 6, 7), __builtin_shufflevector(c2, c3, 0, 1, 2, 3, 4, 5, 6, 7), 0, 1, 2, 3, 4, 5, 6, 7, 8, 9, 10, 11, 12, 13, 14, 15);
              p1 = __builtin_shufflevector(__builtin_shufflevector(c4, c5, 0, 1, 2, 3, 4, 5, 6, 7), __builtin_shufflevector(c6, c7, 0, 1, 2, 3, 4, 5, 6, 7), 0, 1, 2, 3, 4, 5, 6, 7, 8, 9, 10, 11, 12, 13, 14, 15);
              p0 = p0 - st.m; p1 = p1 - st.m; }
            qk_tile2(p0, p1, kaddr0 + slot * A_SLOT, qf);
            if (64 * t + 63 > wrow0) {
                const int kb = 64 * t + 4 * hi;
#pragma unroll
                for (int r = 0; r < 16; ++r) { const int kv = kb + (r & 3) + 8 * (r >> 2); if (kv > qrow) p0[r] = -INFINITY; if (kv + 32 > qrow) p1[r] = -INFINITY; }
            }
            if (dry != 3) (void)flash_update3<2>(st, p0, p1, vaddr0 + slot * A_SLOT); else { st.o[0] += p0; st.o[1] += p1; }
        }
        if (dry == 2) { asm volatile("s_waitcnt lgkmcnt(0)\n\ts_barrier" ::: "memory"); } else if (t + 2 < NTl) { A_WAIT_BAR(3); } else { A_WAIT_BAR(0); }
        slot = (slot == 2) ? 0 : slot + 1;
    }
#undef FOX_DMA
    const float lt = st.l + __shfl_xor(st.l, 32), il = 1.f / lt;
    const int b = bh >> 3, h = bh & 7;
    bf16* Y = (bf16*)(ws + OFF_ZA) + (size_t)(b * 4096 + qrow) * 512 + h * 64;
    bf16* Yd = dry ? (bf16*)(ws + OFF_SELM) + (tid * 64) : Y;
#pragma unroll
    for (int db = 0; db < 2; ++db)
#pragma unroll
        for (int rq = 0; rq < 4; ++rq) { bf16* yp = Y + 32 * db + 8 * rq + 4 * hi; bf16* yo = Yd + 32 * db + 8 * rq + 4 * hi; const u32x2 z = *(const u32x2*)yp;
            const float z0 = __uint_as_float(z.x << 16), z1 = __uint_as_float(z.x & 0xffff0000u), z2 = __uint_as_float(z.y << 16), z3 = __uint_as_float(z.y & 0xffff0000u);
            u32x2 o; o.x = pk2(st.o[db][4 * rq] * il * z0, st.o[db][4 * rq + 1] * il * z1); o.y = pk2(st.o[db][4 * rq + 2] * il * z2, st.o[db][4 * rq + 3] * il * z3);
            *(u32x2*)yo = o; }
}

__device__ __forceinline__ void diff_unit(unsigned char* lds, unsigned char* ws, int bhc, int qb, const float* subg, float lam, float lam_init, bool dry = false) {
    int tid_o = threadIdx.x; asm volatile("" : "+v"(tid_o));
    const int tid = tid_o, lane = tid & 63, wid = __builtin_amdgcn_readfirstlane(tid >> 6), r32 = lane & 31, hi = lane >> 5;
    const int map = wid >> 2, wl = wid & 3;
    const unsigned lds0 = (unsigned)(uintptr_t)lds;
    const lds_cptr L = (lds_cptr)lds;
    const int b = bhc >> 2, hc = bhc & 3;
    const int qrow = 128 * qb + 32 * wl + r32, wrow0 = 128 * qb + 32 * wl;
    const int NTl = 2 * (qb + 1);
    const char* Kg = (const char*)(ws + OFF_KC) + (size_t)(b * 8 + hc * 2) * 524288 + wid * 1024 + lane * 16;
    const char* Vg = (const char*)(ws + OFF_VC) + (size_t)bhc * 1048576 + wid * 1024 + lane * 16;
    const unsigned kdst = (unsigned)__builtin_amdgcn_readfirstlane(lds0 + A_KRING + wid * 1024), vdst = (unsigned)__builtin_amdgcn_readfirstlane(lds0 + A_VRING + wid * 1024);
#define DIFF_DMA(t, slot) do { glds16(Kg + (size_t)(t) * 8192, kdst + (slot) * A_SLOT); glds16(Kg + 524288 + (size_t)(t) * 8192, kdst + (slot) * A_SLOT + 8192); \
        glds16(Vg + (size_t)(t) * 16384, vdst + (slot) * A_SLOT); glds16(Vg + (size_t)(t) * 16384 + 8192, vdst + (slot) * A_SLOT + 8192); } while (0)
    asm volatile("s_waitcnt vmcnt(0)" ::: "memory");
    DIFF_DMA(0, 0); DIFF_DMA(1, 1);
    bf16x8 qf[4];
    { const bf16* Q = (const bf16*)(ws + OFF_QC) + ((size_t)(b * 8 + hc * 2 + map) * 4096 + qrow) * 64 + 8 * hi;
#pragma unroll
      for (int d0 = 0; d0 < 4; ++d0) qf[d0] = *(const bf16x8*)(Q + 16 * d0); }
    FlashSt<4> st; flash_init3<4>(st);
    f32x16 negm;
#pragma unroll
    for (int r = 0; r < 16; ++r) negm[r] = 0.f;
    const int vb = lane_vbase(lane);
    const unsigned kaddr0 = lds0 + A_KRING + map * 8192 + hi * 1024 + r32 * 16, vaddr0 = lds0 + A_VRING + vb;
    asm volatile("" : "+v"(qf[0]), "+v"(qf[1]), "+v"(qf[2]), "+v"(qf[3]));
    asm volatile("s_waitcnt vmcnt(0)" ::: "memory");
    asm volatile("s_barrier" ::: "memory");
    int slot = 0;
    for (int t = 0; t < NTl; ++t) {
        const int s2 = (slot >= 1) ? slot - 1 : 2;
        if (t + 2 < NTl) DIFF_DMA(t + 2, s2);
        if (64 * t <= wrow0 + 31) {
            f32x16 p0 = negm, p1 = negm;
            qk_tile2(p0, p1, kaddr0 + slot * A_SLOT, qf);
            if (64 * t + 63 > wrow0) {
                const int kb = 64 * t + 4 * hi;
#pragma unroll
                for (int r = 0; r < 16; ++r) { const int kv = kb + (r & 3) + 8 * (r >> 2); if (kv > qrow) p0[r] = -INFINITY; if (kv + 32 > qrow) p1[r] = -INFINITY; }
            }
            if (flash_update3<4>(st, p0, p1, vaddr0 + slot * A_SLOT)) {
#pragma unroll
                for (int r = 0; r < 16; ++r) negm[r] = -st.m; }
        }
        if (t + 2 < NTl) { A_WAIT_BAR(4); } else { A_WAIT_BAR(0); }
        slot = (slot == 2) ? 0 : slot + 1;
    }
#undef DIFF_DMA
    const float lt = st.l + __shfl_xor(st.l, 32), il = 1.f / lt;
    LAS float* stage = (LAS float*)lds + wl * 4096 + r32;
    if (map == 1) {
#pragma unroll
        for (int db = 0; db < 4; ++db)
#pragma unroll
            for (int r = 0; r < 16; ++r) stage[(32 * db + crow(r, hi)) * 32] = st.o[db][r] * il;
    }
    asm volatile("s_waitcnt lgkmcnt(0)\n\ts_barrier" ::: "memory");
    if (map == 0) {
        float ss = 0.f;
#pragma unroll
        for (int db = 0; db < 4; ++db)
#pragma unroll
            for (int r = 0; r < 16; ++r) { const float v = st.o[db][r] * il - lam * stage[(32 * db + crow(r, hi)) * 32]; st.o[db][r] = v; ss += v * v; }
        ss += __shfl_xor(ss, 32);
        const float rs = rsqrtf(ss * (1.f / 128.f) + EPS) * (1.f - lam_init);
        bf16* Y = (bf16*)(ws + OFF_ZC) + (size_t)(b * 4096 + qrow) * 512 + hc * 128;
        bf16* Yd = dry ? (bf16*)(ws + OFF_SELM) + (tid * 128) : Y;
#pragma unroll
        for (int db = 0; db < 4; ++db)
#pragma unroll
            for (int rq = 0; rq < 4; ++rq) { const int d = 32 * db + 8 * rq + 4 * hi; bf16* yp = Y + d; bf16* yo = Yd + d; const u32x2 z = *(const u32x2*)yp; const f32x4 g = *(const f32x4*)(subg + d);
                const float z0 = __uint_as_float(z.x << 16), z1 = __uint_as_float(z.x & 0xffff0000u), z2 = __uint_as_float(z.y << 16), z3 = __uint_as_float(z.y & 0xffff0000u);
                u32x2 o; o.x = pk2(st.o[db][4 * rq] * rs * g[0] * z0, st.o[db][4 * rq + 1] * rs * g[1] * z1); o.y = pk2(st.o[db][4 * rq + 2] * rs * g[2] * z2, st.o[db][4 * rq + 3] * rs * g[3] * z3);
                *(u32x2*)yo = o; }
    }
    asm volatile("s_waitcnt lgkmcnt(0)\n\ts_barrier" ::: "memory");
}

constexpr int N_IMP = A_MISC, N_SELM = N_IMP + 64 * 65 * 4, N_UMASK = N_SELM + 512, N_SEQC = N_UMASK + 16, N_SEQD = N_SEQC + 80, N_CNT = N_SEQD + 16;
template <int MODE> __device__ __forceinline__ void nsa_ring(FlashSt<2>& st, unsigned char* lds, const char* Kg, const char* Vg, unsigned kdst, unsigned vdst, int n, int seqoff,
                                                             const bf16x8 (&qf)[4], int tb, int qloc, unsigned selLo, unsigned selHi, int r32, int hi, int vb) {
    const lds_cptr L = (lds_cptr)lds;
    const LAS unsigned char* seq = (const LAS unsigned char*)(L + seqoff);
    const unsigned lds0r = (unsigned)(uintptr_t)lds;
#define NSA_DMA(j, slot) do { glds16(Kg + (size_t)(j) * 8192, kdst + (slot) * A_SLOT); glds16(Vg + (size_t)(j) * 8192, vdst + (slot) * A_SLOT); } while (0)
    asm volatile("s_waitcnt vmcnt(0)" ::: "memory");
    { const int j0 = __builtin_amdgcn_readfirstlane((int)seq[0]); NSA_DMA(j0, 0); if (n > 1) { const int j1 = __builtin_amdgcn_readfirstlane((int)seq[1]); NSA_DMA(j1, 1); } }
    A_WAIT_BAR(0);
    int slot = 0;
    f32x16 negm;
#pragma unroll
    for (int r = 0; r < 16; ++r) negm[r] = 0.f;
    for (int i = 0; i < n; ++i) {
        const int s2 = (slot >= 1) ? slot - 1 : 2;
        if (i + 2 < n) { const int j2 = __builtin_amdgcn_readfirstlane((int)seq[i + 2]); NSA_DMA(j2, s2); }
        const int j = __builtin_amdgcn_readfirstlane((int)seq[i]);
        f32x16 p0 = negm, p1 = negm;
        qk_tile2(p0, p1, lds0r + A_KRING + hi * 1024 + r32 * 16 + slot * A_SLOT, qf);
        if (j == tb) {
#pragma unroll
            for (int r = 0; r < 16; ++r) { const int kv = 4 * hi + (r & 3) + 8 * (r >> 2); if (kv > qloc) p0[r] = -INFINITY; if (kv + 32 > qloc) p1[r] = -INFINITY; }
        } else if (MODE == 0) {
            const bool sel = (((j < 32) ? (selLo >> j) : (selHi >> (j - 32))) & 1u) != 0u;
            if (!sel) {
#pragma unroll
                for (int r = 0; r < 16; ++r) { p0[r] = -INFINITY; p1[r] = -INFINITY; } }
        } else if (j == tb - 8) {
#pragma unroll
            for (int r = 0; r < 16; ++r) { const int kv = 4 * hi + (r & 3) + 8 * (r >> 2); if (kv <= qloc) p0[r] = -INFINITY; if (kv + 32 <= qloc) p1[r] = -INFINITY; }
        }
        if (flash_update3<2>(st, p0, p1, lds0r + A_VRING + vb + slot * A_SLOT)) {
#pragma unroll
            for (int r = 0; r < 16; ++r) negm[r] = -st.m; }
        if (i + 2 < n) { A_WAIT_BAR(2); } else { A_WAIT_BAR(0); }
        slot = (slot == 2) ? 0 : slot + 1;
    }
#undef NSA_DMA
}
__device__ __forceinline__ void nsa_unit(unsigned char* lds, unsigned char* ws, int bg, int tb, bool dry = false) {
    int tid_o = threadIdx.x; asm volatile("" : "+v"(tid_o));
    const int tid = tid_o, lane = tid & 63, wid = __builtin_amdgcn_readfirstlane(tid >> 6), r32 = lane & 31, hi = lane >> 5;
    const unsigned lds0 = (unsigned)(uintptr_t)lds;
    const lds_cptr L = (lds_cptr)lds;
    const int b = bg >> 1, g = bg & 1, h = 4 * g + (wid >> 1), qloc = 32 * (wid & 1) + r32, t = 64 * tb + qloc, row = b * 4096 + t;
    const unsigned kdst = (unsigned)__builtin_amdgcn_readfirstlane(lds0 + A_KRING + wid * 1024), vdst = (unsigned)__builtin_amdgcn_readfirstlane(lds0 + A_VRING + wid * 1024);
    const int vb = lane_vbase(lane);
    LAS float* imp = (LAS float*)(L + N_IMP);
    LAS unsigned* selm = (LAS unsigned*)(L + N_SELM);
    LAS unsigned* umask = (LAS unsigned*)(L + N_UMASK);
    const int nvmax = 4 * tb + 3, nct = (nvmax + 63) >> 6;
    for (int i = tid; i < 64 * 65; i += 512) imp[i] = 0.f;
    if (tid < 128) selm[tid] = 0u;
    if (tid < 2) umask[tid] = 0u;
    asm volatile("s_waitcnt vmcnt(0)" ::: "memory");
    { const char* Kc = (const char*)(ws + OFF_KCMP) + (size_t)bg * 32768 + wid * 1024 + lane * 16; const char* Vc = (const char*)(ws + OFF_VCMP) + (size_t)bg * 32768 + wid * 1024 + lane * 16;
      for (int ct = 0; ct < nct; ++ct) { glds16(Kc + ct * 8192, kdst + ct * 8192); glds16(Vc + ct * 8192, vdst + ct * 8192); } }
    bf16x8 qf[4];
    const bf16* Qp = (const bf16*)(ws + OFF_QB) + ((size_t)(b * 8 + h) * 4096 + t) * 64 + 8 * hi;
#pragma unroll
    for (int d0 = 0; d0 < 4; ++d0) qf[d0] = *(const bf16x8*)(Qp + 16 * d0);
    const float* gt = (const float*)(ws + OFF_GATES) + (size_t)row * 24 + (h & 7) * 3;
    float g0 = gt[0], g1 = gt[1], g2 = gt[2];
    asm volatile("" : "+v"(qf[0]), "+v"(qf[1]), "+v"(qf[2]), "+v"(qf[3]), "+v"(g0), "+v"(g1), "+v"(g2));
    A_WAIT_BAR(0);
    const int nv = (t >= 31) ? ((t - 31) >> 4) + 1 : 0;
    f32x16 y[2];
    {
        float m = -1e30f, l = 0.f;
        for (int ct = 0; ct < nct; ++ct) {
            f32x16 p0, p1;
#pragma unroll
            for (int r = 0; r < 16; ++r) { p0[r] = 0.f; p1[r] = 0.f; }
            qk_tile2(p0, p1, lds0 + A_KRING + hi * 1024 + r32 * 16 + ct * 8192, qf);
            const int cb = 64 * ct + 4 * hi;
#pragma unroll
            for (int r = 0; r < 16; ++r) { const int c = cb + (r & 3) + 8 * (r >> 2); if (c >= nv) p0[r] = -INFINITY; if (c + 32 >= nv) p1[r] = -INFINITY; }
            const float rm = rowmax32(p0, p1), mn = fmaxf(m, rm);
            float ls = 0.f;
#pragma unroll
            for (int r = 0; r < 16; ++r) ls += __builtin_amdgcn_exp2f(p0[r] - mn) + __builtin_amdgcn_exp2f(p1[r] - mn);
            l = l * __builtin_amdgcn_exp2f(m - mn) + ls; m = mn;
        }
        const float lt = l + __shfl_xor(l, 32), il = lt > 0.f ? 1.f / lt : 0.f;
        f32x16 oc[2];
#pragma unroll
        for (int r = 0; r < 16; ++r) { oc[0][r] = 0.f; oc[1][r] = 0.f; }
        for (int ct = 0; ct < nct; ++ct) {
            f32x16 p0, p1;
#pragma unroll
            for (int r = 0; r < 16; ++r) { p0[r] = 0.f; p1[r] = 0.f; }
            qk_tile2(p0, p1, lds0 + A_KRING + hi * 1024 + r32 * 16 + ct * 8192, qf);
            const int cb = 64 * ct + 4 * hi;
#pragma unroll
            for (int r = 0; r < 16; ++r) { const int c = cb + (r & 3) + 8 * (r >> 2);
                p0[r] = (c >= nv) ? 0.f : __builtin_amdgcn_exp2f(p0[r] - m) * il; p1[r] = (c + 32 >= nv) ? 0.f : __builtin_amdgcn_exp2f(p1[r] - m) * il; }
            LAS float* ir = imp + qloc * 65 + 16 * ct + hi;
#pragma unroll
            for (int rq = 0; rq < 4; ++rq) {
                const float q0 = (p0[4 * rq] + p0[4 * rq + 1]) + (p0[4 * rq + 2] + p0[4 * rq + 3]), q1 = (p1[4 * rq] + p1[4 * rq + 1]) + (p1[4 * rq + 2] + p1[4 * rq + 3]);
                __hip_atomic_fetch_add(ir + 2 * rq, q0, __ATOMIC_RELAXED, __HIP_MEMORY_SCOPE_WORKGROUP);
                __hip_atomic_fetch_add(ir + 2 * rq + 1, p0[4 * rq + 3], __ATOMIC_RELAXED, __HIP_MEMORY_SCOPE_WORKGROUP);
                __hip_atomic_fetch_add(ir + 8 + 2 * rq, q1, __ATOMIC_RELAXED, __HIP_MEMORY_SCOPE_WORKGROUP);
                if (16 * ct + 8 + 2 * rq + hi + 1 < 64) __hip_atomic_fetch_add(ir + 8 + 2 * rq + 1, p1[4 * rq + 3], __ATOMIC_RELAXED, __HIP_MEMORY_SCOPE_WORKGROUP);
            }
            pv_only2(oc, lds0 + A_VRING + vb + ct * 8192, p0, p1);
        }
#pragma unroll
        for (int r = 0; r < 16; ++r) { y[0][r] = g0 * oc[0][r]; y[1][r] = g0 * oc[1][r]; }
    }
    asm volatile("s_waitcnt lgkmcnt(0)\n\ts_barrier" ::: "memory");
    {
        const int q = tid >> 3, part = tid & 7;
        float sc[8];
#pragma unroll
        for (int i = 0; i < 8; ++i) { const int j = 8 * part + i; const bool forced = (j == 0) || (j == tb) || (j == tb - 1);
            sc[i] = forced ? 1e30f : (j <= tb ? imp[q * 65 + j] : -1e30f); }
#pragma unroll
        for (int i = 0; i < 8; ++i) imp[q * 65 + 8 * part + i] = sc[i];
        asm volatile("s_waitcnt lgkmcnt(0)\n\ts_barrier" ::: "memory");
        int rank[8];
#pragma unroll
        for (int i = 0; i < 8; ++i) rank[i] = 0;
        for (int k = 0; k < 64; ++k) { const float sk = imp[q * 65 + k];
#pragma unroll
            for (int i = 0; i < 8; ++i) rank[i] += (sk > sc[i] || (sk == sc[i] && k < 8 * part + i)) ? 1 : 0; }
        unsigned bits = 0u;
#pragma unroll
        for (int i = 0; i < 8; ++i) bits |= (rank[i] < 16) ? (1u << i) : 0u;
        bits <<= 8 * (part & 3);
        __hip_atomic_fetch_or(selm + q * 2 + (part >> 2), bits, __ATOMIC_RELAXED, __HIP_MEMORY_SCOPE_WORKGROUP);
        __hip_atomic_fetch_or(umask + (part >> 2), bits, __ATOMIC_RELAXED, __HIP_MEMORY_SCOPE_WORKGROUP);
        asm volatile("s_waitcnt lgkmcnt(0)\n\ts_barrier" ::: "memory");
        if (tid == 0) {
            LAS unsigned char* sq = (LAS unsigned char*)(L + N_SEQC); LAS unsigned char* sd = (LAS unsigned char*)(L + N_SEQD); LAS int* cnt = (LAS int*)(L + N_CNT);
            const unsigned long long um = ((unsigned long long)umask[1] << 32) | umask[0];
            int n = 0; sq[n++] = (unsigned char)tb;
            for (int j = 0; j < tb; ++j) if ((um >> j) & 1ull) sq[n++] = (unsigned char)j;
            cnt[0] = n;
            int n2 = 0; sd[n2++] = (unsigned char)tb;
            for (int j = (tb >= 8 ? tb - 8 : 0); j < tb; ++j) sd[n2++] = (unsigned char)j;
            cnt[1] = n2;
        }
        asm volatile("s_waitcnt lgkmcnt(0)\n\ts_barrier" ::: "memory");
    }
    const unsigned selLo = selm[qloc * 2], selHi = selm[qloc * 2 + 1];
    const int nC = __builtin_amdgcn_readfirstlane(((const LAS int*)(L + N_CNT))[0]), nD = __builtin_amdgcn_readfirstlane(((const LAS int*)(L + N_CNT))[1]);
    { const float* cs = (const float*)(ws + OFF_COS) + (size_t)row * 32 + 4 * hi; const float* sn = (const float*)(ws + OFF_SIN) + (size_t)row * 32 + 4 * hi;
#pragma unroll
      for (int d0 = 0; d0 < 4; ++d0) { const f32x4 c = *(const f32x4*)(cs + 8 * d0), s = *(const f32x4*)(sn + 8 * d0); u32x4 w = __builtin_bit_cast(u32x4, qf[d0]); u32x4 o;
#pragma unroll
          for (int e = 0; e < 4; ++e) { const float x1 = __uint_as_float(w[e] << 16), x2 = __uint_as_float(w[e] & 0xffff0000u); o[e] = pk2(x1 * c[e] - x2 * s[e], x2 * c[e] + x1 * s[e]); }
          qf[d0] = __builtin_bit_cast(bf16x8, o); } }
    asm volatile("" : "+v"(qf[0]), "+v"(qf[1]), "+v"(qf[2]), "+v"(qf[3]));
    {
        FlashSt<2> st; flash_init3<2>(st);
        const char* Kg = (const char*)(ws + OFF_KSEL) + (size_t)bg * 524288 + wid * 1024 + lane * 16; const char* Vg = (const char*)(ws + OFF_VSEL) + (size_t)bg * 524288 + wid * 1024 + lane * 16;
        nsa_ring<0>(st, lds, Kg, Vg, kdst, vdst, nC, N_SEQC, qf, tb, qloc, selLo, selHi, r32, hi, vb);
        const float lt = st.l + __shfl_xor(st.l, 32), sc = g1 / lt;
#pragma unroll
        for (int r = 0; r < 16; ++r) { y[0][r] += sc * st.o[0][r]; y[1][r] += sc * st.o[1][r]; }
    }
    {
        FlashSt<2> st; flash_init3<2>(st);
        const char* Kg = (const char*)(ws + OFF_KWIN) + (size_t)bg * 524288 + wid * 1024 + lane * 16; const char* Vg = (const char*)(ws + OFF_VWIN) + (size_t)bg * 524288 + wid * 1024 + lane * 16;
        nsa_ring<1>(st, lds, Kg, Vg, kdst, vdst, nD, N_SEQD, qf, tb, qloc, selLo, selHi, r32, hi, vb);
        const float lt = st.l + __shfl_xor(st.l, 32), sc = g2 / lt;
#pragma unroll
        for (int r = 0; r < 16; ++r) { y[0][r] += sc * st.o[0][r]; y[1][r] += sc * st.o[1][r]; }
    }
    bf16* Y = (bf16*)(ws + OFF_ZB) + (size_t)row * 512 + h * 64;
    bf16* Yd = dry ? (bf16*)(ws + OFF_SELM) + (tid * 64) : Y;
#pragma unroll
    for (int db = 0; db < 2; ++db)
#pragma unroll
        for (int rq = 0; rq < 4; ++rq) { bf16* yp = Y + 32 * db + 8 * rq + 4 * hi; bf16* yo = Yd + 32 * db + 8 * rq + 4 * hi; const u32x2 z = *(const u32x2*)yp;
            const float z0 = __uint_as_float(z.x << 16), z1 = __uint_as_float(z.x & 0xffff0000u), z2 = __uint_as_float(z.y << 16), z3 = __uint_as_float(z.y & 0xffff0000u);
            u32x2 o; o.x = pk2(y[db][4 * rq] * z0, y[db][4 * rq + 1] * z1); o.y = pk2(y[db][4 * rq + 2] * z2, y[db][4 * rq + 3] * z3);
            *(u32x2*)yo = o; }
}

__device__ __forceinline__ void compress_unit(unsigned char* lds, unsigned char* ws, int kv, int bg, int rc) {
    int tid_o = threadIdx.x; asm volatile("" : "+v"(tid_o));
    const int tid = tid_o, lane = tid & 63, wid = __builtin_amdgcn_readfirstlane(tid >> 6), r32 = lane & 31, hi = lane >> 5;
    const unsigned lds0 = (unsigned)(uintptr_t)lds;
    { const char* Ab = (const char*)(ws + (kv ? OFF_VCB : OFF_KCB)) + ((size_t)bg * 4096 + 512 * rc) * 128;
      asm volatile("s_waitcnt vmcnt(0)" ::: "memory");
#pragma unroll
      for (int i = 0; i < 9; ++i) { const int q = (i * 8 + wid) * 64 + lane, blk = q / 129, qq = q - blk * 129; const int sg = blk * 128 + (qq < 128 ? qq : 127);
          glds16(Ab + (size_t)sg * 16, (unsigned)__builtin_amdgcn_readfirstlane(lds0 + (i * 8 + wid) * 1024)); }
      asm volatile("s_waitcnt vmcnt(0)\n\ts_barrier" ::: "memory"); }
    const bf16* Bp = (const bf16*)(ws + OFF_CW1) + (size_t)kv * 256 * 2048 + ((size_t)wid * 128 * 64 + lane) * 8;
    const lds_cptr Al = (lds_cptr)lds + 2064 * r32 + 16 * hi;
    f32x16 acc;
#pragma unroll
    for (int r = 0; r < 16; ++r) acc[r] = 0.f;
#pragma unroll 8
    for (int l = 0; l < 32; ++l) {
        const lds_cptr ap = Al + l * 128 + (l >> 4) * 16;
#pragma unroll
        for (int q = 0; q < 4; ++q) {
            const bf16x8 a = *(const LAS bf16x8*)(ap + q * 32), w = *(const bf16x8*)(Bp + (size_t)(4 * l + q) * 512);
            acc = __builtin_amdgcn_mfma_f32_32x32x16_bf16(w, a, acc, 0, 0, 0);
        }
    }
    const float* cb = (const float*)(ws + OFF_CB1) + kv * 256 + 32 * wid + 4 * hi;
    bf16x8 hf[2];
    { float hv[16];
#pragma unroll
      for (int rq = 0; rq < 4; ++rq) { const f32x4 bb = *(const f32x4*)(cb + 8 * rq);
#pragma unroll
          for (int e = 0; e < 4; ++e) hv[4 * rq + e] = siluf_(acc[4 * rq + e] + bb[e]); }
      u32x4 w0, w1;
      w0.x = pk2(hv[0], hv[1]); w0.y = pk2(hv[2], hv[3]); w0.z = pk2(hv[4], hv[5]); w0.w = pk2(hv[6], hv[7]);
      w1.x = pk2(hv[8], hv[9]); w1.y = pk2(hv[10], hv[11]); w1.z = pk2(hv[12], hv[13]); w1.w = pk2(hv[14], hv[15]);
      hf[0] = __builtin_bit_cast(bf16x8, w0); hf[1] = __builtin_bit_cast(bf16x8, w1); }
    const bf16* W2 = (const bf16*)(ws + OFF_CW2) + (size_t)kv * 64 * 256 + 32 * wid + 4 * hi;
    f32x16 po[2];
#pragma unroll
    for (int dbk = 0; dbk < 2; ++dbk) {
#pragma unroll
        for (int r = 0; r < 16; ++r) po[dbk][r] = 0.f;
#pragma unroll
        for (int s = 0; s < 2; ++s) {
            const bf16* wr = W2 + (size_t)(32 * dbk + r32) * 256 + 16 * s;
            const u32x2 lo = *(const u32x2*)wr, hh = *(const u32x2*)(wr + 8);
            u32x4 wv; wv.x = lo.x; wv.y = lo.y; wv.z = hh.x; wv.w = hh.y;
            po[dbk] = __builtin_amdgcn_mfma_f32_32x32x16_bf16(__builtin_bit_cast(bf16x8, wv), hf[s], po[dbk], 0, 0, 0);
        }
    }
    LAS float* part = (LAS float*)lds;
    __syncthreads();
#pragma unroll
    for (int dbk = 0; dbk < 2; ++dbk)
#pragma unroll
        for (int r = 0; r < 16; ++r) part[(wid * 64 + 32 * dbk + crow(r, hi)) * 32 + r32] = po[dbk][r];
    __syncthreads();
    {
        const int row = tid & 31, d4 = tid >> 5, cc = 32 * rc + row;
        float o[4];
#pragma unroll
        for (int e = 0; e < 4; ++e) { float sum = 0.f;
#pragma unroll
            for (int w = 0; w < 8; ++w) sum += part[(w * 64 + 4 * d4 + e) * 32 + row];
            o[e] = (cc < 255) ? sum : 0.f; }
        bf16* dst = (bf16*)(ws + (kv ? OFF_VCMP : OFF_KCMP)) + (size_t)bg * 16384 + (kv ? vtile_off(cc, 4 * d4) : ktile_off(cc, 4 * d4));
        store_bf<4>(dst, o);
    }
    __syncthreads();
}
__device__ __forceinline__ void cumsum_unit(unsigned char* lds, unsigned char* ws, int bh) {
    int tid_o = threadIdx.x; asm volatile("" : "+v"(tid_o));
    const int tid = tid_o, lane = tid & 63, wid = tid >> 6, b = bh >> 3, h = bh & 7;
    const float* lf = (const float*)(ws + OFF_LOGF) + ((size_t)(b * 4096 + 8 * tid)) * 8 + h;
    float v[8]; float s = 0.f;
#pragma unroll
    for (int i = 0; i < 8; ++i) { s += lf[i * 8]; v[i] = s; }
    float incl = s;
#pragma unroll
    for (int of = 1; of < 64; of <<= 1) { const float t = __shfl_up(incl, of); if (lane >= of) incl += t; }
    LAS float* wsum = (LAS float*)lds;
    __syncthreads();
    if (lane == 63) wsum[wid] = incl;
    __syncthreads();
    float base = incl - s;
    for (int w = 0; w < wid; ++w) base += wsum[w];
    float* cf = (float*)(ws + OFF_CF) + (size_t)bh * 4096 + 8 * tid;
    f32x4 o0 = {-(base + v[0]), -(base + v[1]), -(base + v[2]), -(base + v[3])}, o1 = {-(base + v[4]), -(base + v[5]), -(base + v[6]), -(base + v[7])};
    *(f32x4*)cf = o0; *(f32x4*)(cf + 4) = o1;
    __syncthreads();
}

constexpr size_t OFF_BAR = OFF_CTL + 131072;
constexpr int LDS_BARST = 131072 + 64;
#define XB_TMO      128
#define XB_XCNT(j)  (256  + 64 * (j))
#define XB_XSUB(j)  (1280 + 64 * (j))
#define XB_XGEN(j)  (2304 + 64 * (j))
#define XB_TOP      3328
#define XB_TOPGEN   3392
#define XCD_BAR_WORDS 3456
#define XB_SPIN_CAP (1u << 18)

__device__ __forceinline__ unsigned xb_ld(unsigned* p)              { return __hip_atomic_load(p, __ATOMIC_RELAXED, __HIP_MEMORY_SCOPE_AGENT); }
__device__ __forceinline__ unsigned xb_add(unsigned* p, unsigned v) { return __hip_atomic_fetch_add(p, v, __ATOMIC_RELAXED, __HIP_MEMORY_SCOPE_AGENT); }
__device__ __forceinline__ unsigned xb_xcc_id() { return (unsigned)__builtin_amdgcn_s_getreg((3 << 11) | 20) & 0xFu; }
#define XB_SPIN(cond, bar) do { unsigned _sp = 0; while (cond) { __builtin_amdgcn_s_sleep(1); \
    if ((++_sp & 255u) == 0u) { if (xb_ld(&(bar)[XB_TMO])) break; if (_sp > XB_SPIN_CAP) { atomicAdd(&(bar)[XB_TMO], 1u); break; } } } } while (0)

struct XcdBarrier {
    unsigned* bar; unsigned x;
    volatile LAS unsigned* st;
};

__device__ __forceinline__ XcdBarrier xcd_barrier_post(unsigned* bar, volatile LAS unsigned* st) {
    XcdBarrier b; b.bar = bar; b.x = xb_xcc_id(); b.st = st;
    if (threadIdx.x == 0) (void)xb_add(&bar[XB_XCNT(b.x)], 1u);
    return b;
}
__device__ __forceinline__ void xcd_barrier_complete(unsigned* bar, unsigned x, unsigned& nloc, unsigned& nx) {
    const unsigned G = gridDim.x * gridDim.y * gridDim.z;
    unsigned sum, cnt, mine, sp = 0u;
    for (;;) {
        sum = 0u; cnt = 0u; mine = 0u;
#pragma unroll
        for (unsigned j = 0; j < 16; ++j) { const unsigned c = xb_ld(&bar[XB_XCNT(j)]); sum += c; cnt += (c > 0u) ? 1u : 0u; mine = (j == x) ? c : mine; }
        if (sum == G) break;
        __builtin_amdgcn_s_sleep(1);
        if ((++sp & 255u) == 0u) { if (xb_ld(&bar[XB_TMO])) break; if (sp > XB_SPIN_CAP) { atomicAdd(&bar[XB_TMO], 1u); break; } }
    }
    nloc = mine > 0u ? mine : 1u; nx = cnt > 0u ? cnt : 1u;
}

__device__ __forceinline__ void xcd_barrier(const XcdBarrier& b) {
    asm volatile("s_waitcnt vmcnt(0)" ::: "memory");
    __syncthreads();
    if (threadIdx.x == 0) {
        unsigned* bar = b.bar;
        __builtin_amdgcn_s_waitcnt(0);
        unsigned nloc = b.st[0], nx = b.st[1];
        if (nloc == 0u) { xcd_barrier_complete(bar, b.x, nloc, nx); b.st[0] = nloc; b.st[1] = nx; }
        const unsigned old = xb_add(&bar[XB_XSUB(b.x)], 1u);
        const unsigned gen = old / nloc;
        if (old + 1u == (gen + 1u) * nloc) {
            __builtin_amdgcn_fence(__ATOMIC_RELEASE, "agent");
            asm volatile("s_waitcnt vmcnt(0)" ::: "memory");
            const unsigned og = xb_add(&bar[XB_TOP], 1u);
            const unsigned tg = og / nx;
            if (og + 1u == (tg + 1u) * nx) xb_add(&bar[XB_TOPGEN], 1u);
            else XB_SPIN(xb_ld(&bar[XB_TOPGEN]) == tg, bar);
            __builtin_amdgcn_fence(__ATOMIC_ACQUIRE, "agent");
            xb_add(&bar[XB_XGEN(b.x)], 1u);
            asm volatile("s_waitcnt vmcnt(0)" ::: "memory");
        } else {
            XB_SPIN(xb_ld(&bar[XB_XGEN(b.x)]) == gen, bar);
            __builtin_amdgcn_fence(__ATOMIC_ACQUIRE, "agent");
            asm volatile("s_waitcnt vmcnt(0)" ::: "memory");
        }
    }
    __syncthreads();
}

struct KArgs;
__device__ __forceinline__ void conv_tile(bool active, float (*tile)[65], int vt, const float* src, int ld, int K, bf16* dst, const float* kscale, int mode, int bx, int by) {
    const int n0 = bx * 64, k0 = by * 64, tx = vt & 63, ty = vt >> 6;
    const int n = n0 + tx;
    const int sc = (mode == 0 || mode == 3) ? n : mode == 1 ? win_srccol(n) : (n & ~63) + ((n & 1) << 5) + ((n & 63) >> 1);
    if (active) {
        float v[16];
#pragma unroll
        for (int i = 0; i < 16; ++i) v[i] = (sc >= 0) ? src[(size_t)(k0 + 4 * i + ty) * ld + sc] : 0.f;
        if (kscale) {
#pragma unroll
            for (int i = 0; i < 16; ++i) v[i] *= kscale[k0 + 4 * i + ty]; }
#pragma unroll
        for (int i = 0; i < 16; ++i) tile[tx][4 * i + ty] = v[i];
    }
    __syncthreads();
    if (active) {
#pragma unroll
        for (int p = 0; p < 2; ++p) { const int it = vt + 256 * p, r = it >> 3, c = it & 7; const float* t = &tile[r][8 * c];
            u32x4 o; o.x = pk2(t[0], t[1]); o.y = pk2(t[2], t[3]); o.z = pk2(t[4], t[5]); o.w = pk2(t[6], t[7]);
            const int nn = n0 + r, kk = k0 + 8 * c;
            if (mode == 3) *(u32x4*)(dst + ((size_t)((nn >> 5) * (K >> 4) + (kk >> 4)) * 64 + (nn & 31) + 32 * ((kk & 15) >> 3)) * 8) = o;
            else *(u32x4*)(dst + (size_t)nn * K + kk) = o; }
    }
    __syncthreads();
}
namespace cg = cooperative_groups;
constexpr int NT = 512;
constexpr int LDS_BYTES = 147456;
struct KArgs { const void* in[23]; float* out; unsigned char* ws; };

#define OPAQUE_TID() int tid = threadIdx.x; asm volatile("" : "+v"(tid))
#define VRUN(VT, NVB, CALL) do { OPAQUE_TID(); constexpr int per_ = NT / (VT); for (int vb = blockIdx.x * per_ + tid / (VT); vb < (NVB); vb += gridDim.x * per_) { const int vt = tid % (VT); CALL; } } while (0)
#define VRUN_BAR(NVB, CALL) do { OPAQUE_TID(); float (*tile)[65] = (float (*)[65])(lds + (tid >> 8) * 64 * 65 * 4); (void)tile; const int nvb_ = (NVB); for (int it_ = 0; it_ * (int)gridDim.x * 2 < nvb_; ++it_) { const int vb = (it_ * (int)gridDim.x + (int)blockIdx.x) * 2 + (tid >> 8); const int vt = tid & 255; const bool active = vb < nvb_; CALL; } } while (0)

#ifndef FAST_FOX
#define FAST_FOX 1
#endif
#ifndef FAST_DIFF
#define FAST_DIFF 1
#endif
#ifndef FAST_NSA
#define FAST_NSA 1
#endif
#ifndef REP_U
#define REP_U 0
#endif
#ifndef REP_SYNC
#define REP_SYNC 0
#endif
#ifndef REP_SUMSQ
#define REP_SUMSQ 0
#endif
#ifndef REP_P0
#define REP_P0 0
#endif
#ifndef REP_PRO
#define REP_PRO 0
#endif
#ifndef REP_INPROJ
#define REP_INPROJ 0
#endif
#ifndef REP_P2
#define REP_P2 0
#endif
#ifndef REP_FOX
#define REP_FOX 0
#endif
#ifndef REP_DIFF
#define REP_DIFF 0
#endif
#ifndef REP_NSA
#define REP_NSA 0
#endif
#ifndef REP_GATEBR
#define REP_GATEBR 0
#endif
#ifndef REP_OUT
#define REP_OUT 0
#endif
#ifndef FAST_P2
#define FAST_P2 1
#endif
#ifndef DO_ALL
#define DO_ALL 1
#endif
#ifndef DO_PRO
#define DO_PRO DO_ALL
#endif
#ifndef DO_INPROJ
#define DO_INPROJ DO_ALL
#endif
#ifndef DO_P2
#define DO_P2 DO_ALL
#endif
#ifndef DO_ATTN
#define DO_ATTN DO_ALL
#endif
#ifndef DO_GATEBR
#define DO_GATEBR DO_ALL
#endif
#ifndef DO_OUT
#define DO_OUT DO_ALL
#endif
#ifndef DO_PLE
#define DO_PLE DO_ALL
#endif
#ifndef DO_TAIL
#define DO_TAIL DO_ALL
#endif
__global__ void __launch_bounds__(NT) mega(KArgs a) {
    extern __shared__ __attribute__((aligned(16))) unsigned char lds[];
    cg::grid_group grid = cg::this_grid();
    { volatile LAS unsigned* st0 = (volatile LAS unsigned*)((LAS unsigned char*)lds + LDS_BARST); if (threadIdx.x < 2) st0[threadIdx.x] = 0u; }
    __syncthreads();
    const XcdBarrier xbar = xcd_barrier_post((unsigned*)(a.ws + OFF_BAR), (volatile LAS unsigned*)((LAS unsigned char*)lds + LDS_BARST));
#define GSYNC() xcd_barrier(xbar)
    unsigned char* ws = a.ws; float* X = a.out;
    typedef const KArgs __attribute__((address_space(4)))* kargp_t;
#define KIN(i) ([&]() { kargp_t kp_ = (kargp_t)__builtin_amdgcn_kernarg_segment_ptr(); asm volatile("" : "+s"(kp_)); return kp_->in[i]; }())
#define I_x ((const float*)KIN(0))
#define I_p ((const float*)KIN(1))
#define I_pos ((const int*)KIN(2))
#define I_norm_g ((const float*)KIN(3))
#define I_w_in ((const float*)KIN(4))
#define I_b_forget ((const float*)KIN(5))
#define I_pe_k ((const float*)KIN(6))
#define I_w1_k ((const float*)KIN(7))
#define I_b1_k ((const float*)KIN(8))
#define I_w2_k ((const float*)KIN(9))
#define I_pe_v ((const float*)KIN(10))
#define I_w1_v ((const float*)KIN(11))
#define I_b1_v ((const float*)KIN(12))
#define I_w2_v ((const float*)KIN(13))
#define I_diff_lam ((const float*)KIN(14))
#define I_subln ((const float*)KIN(15))
#define I_w_out ((const float*)KIN(19))
#define I_w_ple ((const float*)KIN(20))
#define I_w_pg ((const float*)KIN(21))
#define I_final_g ((const float*)KIN(22))
#if DO_PRO
    for (int rep0_ = 0; rep0_ <= REP_P0; ++rep0_) {
    VRUN(256, M / 4, d_xprep(vb, vt, I_x, ws));
    VRUN(256, M * 32 / 256, d_rope_table(vb, vt, I_pos, ws));
    VRUN(256, (2 * M * 256 / 4) / 256, d_pconv(vb, vt, I_p, ws));
    for (int l = 0; l < DEPTH; ++l) {
        { OPAQUE_TID(); if (blockIdx.x == 0 && tid < 64) d_lam(tid, I_diff_lam + l * 256, ws, l); }
    }
    }
#endif
    for (int l = 0; l < DEPTH; ++l) {
        const float* wl = I_w_in + (size_t)l * 1024 * NIN; const float* ng = I_norm_g + l * 1024;
#if DO_PRO
        for (int rep_ = 0; rep_ <= REP_PRO; ++rep_) {
        { OPAQUE_TID(); float (*tile)[65] = (float (*)[65])(lds + (tid >> 8) * 64 * 65 * 4);
          const int njobs = 2952 + (l == 0 ? 1152 : 0);
          for (int it_ = 0; it_ * (int)gridDim.x * 2 < njobs; ++it_) {
              int j = (it_ * (int)gridDim.x + (int)blockIdx.x) * 2 + (tid >> 8); const bool active = j < njobs;
              const float* src = wl; int ld = NIN, K = 1024, mode = 1, bx = 0, by = 0; bf16* dst = (bf16*)(ws + OFF_WIN); const float* ks = ng;
              if (j < 1536) { bx = j % 96; by = j / 96; }
              else if (j < 2304) { j -= 1536; bx = j % 48; by = j / 48; src = wl + 5920; mode = 0; dst = (bf16*)(ws + OFF_WMG); }
              else if (j < 2688) { j -= 2304; const int i = j >> 7, r = j & 127; bx = r & 15; by = r >> 4; src = (const float*)KIN(16 + i) + (size_t)l * 512 * 1024; ld = 1024; K = 512; mode = 0; dst = (bf16*)(ws + OFF_WBR) + (size_t)i * 1024 * 512; ks = nullptr; }
              else if (j < 2944) { j -= 2688; const int kv = j >> 7, r = j & 127; bx = r & 3; by = r >> 2; src = (kv ? I_w1_v : I_w1_k) + (size_t)l * 2048 * 256; ld = 256; K = 2048; mode = 3; dst = (bf16*)(ws + OFF_CW1) + (size_t)kv * 256 * 2048; ks = nullptr; }
              else if (j < 2952) { j -= 2944; const int kv = j >> 2; by = j & 3; src = (kv ? I_w2_v : I_w2_k) + (size_t)l * 256 * 64; ld = 64; K = 256; mode = kv ? 0 : 2; dst = (bf16*)(ws + OFF_CW2) + (size_t)kv * 64 * 256; ks = nullptr; }
              else { j -= 2952; const int ll = j / 576, r = j % 576; ld = 1024; mode = 0; ks = nullptr;
                  if (r < 256) { bx = r & 15; by = r >> 4; src = I_w_out + (size_t)ll * 1024 * 1024; dst = (bf16*)(ws + OFF_WOUT) + (size_t)ll * 1024 * 1024; }
                  else if (r < 512) { const int r2 = r - 256; bx = r2 & 15; by = r2 >> 4; src = I_w_pg + (size_t)ll * 1024 * 1024; dst = (bf16*)(ws + OFF_WPG) + (size_t)ll * 1024 * 1024; }
                  else { const int r2 = r - 512; bx = r2 & 15; by = r2 >> 4; src = I_w_ple + (size_t)ll * 256 * 1024; K = 256; dst = (bf16*)(ws + OFF_WPL) + (size_t)ll * 1024 * 256; } }
              conv_tile(active, tile, tid & 255, src, ld, K, dst, ks, mode, bx, by);
          } }
        { OPAQUE_TID(); if (blockIdx.x >= 64 && blockIdx.x < 96 && tid < 256) d_cb1_part(blockIdx.x - 64, tid, I_pe_k + l * 2048, I_w1_k + (size_t)l * 2048 * 256, I_pe_v + l * 2048, I_w1_v + (size_t)l * 2048 * 256, ws); }
        }
#endif
        if (l == 0) grid.sync(); else GSYNC();
        EpiCtx E{ws, I_b_forget + l * 8, l == 0 ? I_x : X, X, 0};
#if DO_INPROJ
        { OPAQUE_TID(); if (blockIdx.x == 0) d_cb1_sum(tid, I_b1_k + l * 256, I_b1_v + l * 256, ws); }
        for (int rep_ = 0; rep_ <= REP_INPROJ; ++rep_) { FAST_GEMM(EPI_INPROJ, ws + OFF_XB, ws + OFF_WIN, NP, 1024, true); }
#endif
        GSYNC();
#if DO_P2
        for (int rep_ = 0; rep_ <= REP_P2; ++rep_) {
#if FAST_P2
        for (int u = blockIdx.x; u < 160; u += gridDim.x) { if (u < 128) compress_unit(lds, ws, u >> 6, (u >> 3) & 7, u & 7); else cumsum_unit(lds, ws, u - 128); }
#else
        VRUN(64, 32, d_cumsum(vb, vt, ws));
        VRUN_BAR(256 * 8 * 2, d_compress(active, vb, vt, (float*)lds + (tid >> 8) * 256, ws));
#endif
        }
#endif
        GSYNC();
#if DO_ATTN
#if FAST_FOX
        for (int rep_ = (REP_FOX ? 1 : 0); rep_ >= 0; --rep_) for (int u = blockIdx.x; u < 512; u += gridDim.x) fox_unit(lds, ws, u & 31, u < 256 ? 15 - (u >> 5) : (u >> 5) - 8, rep_ > 0 ? REP_FOX : 0);
        __syncthreads();
#else
        VRUN(64, 32 * 64, d_fox(vb, vt, ws));
#endif
#if FAST_DIFF
        { const float lam = ((const float*)(ws + OFF_CTL))[CTL_LAM + l], lam_init = 0.8f - 0.6f * expf(-0.3f * (float)l);
          for (int rep_ = REP_DIFF; rep_ >= 0; --rep_) for (int u = blockIdx.x; u < 512; u += gridDim.x) diff_unit(lds, ws, u & 15, u < 256 ? 31 - (u >> 4) : (u >> 4) - 16, I_subln + l * 128, lam, lam_init, rep_ > 0); }
#else
        { OPAQUE_TID(); if ((tid >> 6) < 4) { for (int vb = blockIdx.x * 4 + (tid >> 6); vb < 16 * 64; vb += gridDim.x * 4) d_diff(vb, tid & 63, (float (*)[129])(lds + (tid >> 6) * 64 * 129 * 4), ws, I_subln + l * 128, l); } }
#endif
#if FAST_NSA
        __syncthreads();
        for (int rep_ = REP_NSA; rep_ >= 0; --rep_) for (int u = blockIdx.x; u < 512; u += gridDim.x) nsa_unit(lds, ws, u & 7, u < 256 ? 63 - (u >> 3) : (u >> 3) - 32, rep_ > 0);
#else
        __syncthreads();
        VRUN(64, 8 * 64, d_nsa_topk(vb, vt, (float (*)[65])(lds + (tid >> 6) * 64 * 65 * 4), ws));
        GSYNC();
        VRUN(64, 32 * 64, d_nsa_attn(vb, vt, (float (*)[65])(lds + (tid >> 6) * 64 * 65 * 4), ws));
#endif
#endif
        GSYNC();
#if DO_GATEBR
        for (int rep_ = 0; rep_ <= REP_GATEBR; ++rep_) {
        { pg8::Gemm g_{(const pg8::bf16_t*)(ws + OFF_XB), (const pg8::bf16_t*)(ws + OFF_WMG), M, 3072, 1024}; ChainOrder S_; S_.init((int)gridDim.x, (int)blockIdx.x, 0);
          EpiFast<EPI_GATE3> Ep_{E}; pg8::gemm_phase<EpiFast<EPI_GATE3>, ChainOrder, true, true>((PG8_LAS unsigned char*)lds, g_, S_, Ep_); }
        { pg8::Gemm g_{(const pg8::bf16_t*)(ws + OFF_ZA), (const pg8::bf16_t*)(ws + OFF_WBR), 3 * M, 3072, 512}; ChainOrder S_; S_.init((int)gridDim.x, (int)blockIdx.x, 1);
          EpiFast<EPI_BR3> Ep_{E}; pg8::gemm_phase<EpiFast<EPI_BR3>, ChainOrder, true, true>((PG8_LAS unsigned char*)lds, g_, S_, Ep_); }
        }
#endif
        GSYNC();
#if DO_OUT
        for (int rep_ = 0; rep_ <= (l == 0 ? REP_OUT : 0); ++rep_) FAST_GEMM(EPI_OUT, (const bf16*)(ws + OFF_MERGED), (const bf16*)(ws + OFF_WOUT) + (size_t)l * 1024 * 1024, 1024, 1024, false);
#endif
        GSYNC();
#if DO_PLE
        for (int rep_ = 0; rep_ <= REP_U; ++rep_) FAST_GEMM(EPI_U, (const bf16*)(ws + OFF_PB) + (size_t)l * M * 256, (const bf16*)(ws + OFF_WPL) + (size_t)l * 1024 * 256, 1024, 256, false);
        FAST_GEMM(EPI_PLE, (const bf16*)(ws + OFF_X1B), (const bf16*)(ws + OFF_WPG) + (size_t)l * 1024 * 1024, 1024, 1024, false);
#endif
        GSYNC();
#if DO_TAIL
        for (int rep_ = 0; rep_ < 10 * REP_SYNC; ++rep_) GSYNC();
        for (int rep_ = 0; rep_ <= REP_SUMSQ; ++rep_) { if (l + 1 < DEPTH) VRUN(256, M / 4, d_sumsq(vb, vt, X, ws)); }
#endif
    }
#if DO_TAIL
    VRUN(256, M / 4, d_final(vb, vt, X, I_final_g));
#endif
}
#undef I_x
#undef I_p
#undef I_pos
#undef I_norm_g
#undef I_w_in
#undef I_b_forget
#undef I_pe_k
#undef I_w1_k
#undef I_b1_k
#undef I_w2_k
#undef I_pe_v
#undef I_w1_v
#undef I_b1_v
#undef I_w2_v
#undef I_diff_lam
#undef I_subln
#undef I_w_out
#undef I_w_ple
#undef I_w_pg
#undef I_final_g
#undef KIN

extern "C" void kernel_launch(void* const* d_in, const int* in_sizes, int n_in, void* d_out, int out_size, void* d_ws, size_t ws_size, hipStream_t stream) {
    static int grid_blocks = 0;
    if (grid_blocks == 0) {
        if (n_in != 23 || ws_size < WS_NEED || out_size != M * DM) { fprintf(stderr, "kernel_launch: unexpected sizes (n_in %d ws %zu out %d)\n", n_in, ws_size, out_size); grid_blocks = -1; return; }
        int dev = 0, cus = 0, per_cu = 0;
        (void)hipGetDevice(&dev); (void)hipDeviceGetAttribute(&cus, hipDeviceAttributeMultiprocessorCount, dev);
        (void)hipFuncSetAttribute((const void*)mega, hipFuncAttributeMaxDynamicSharedMemorySize, LDS_BYTES);
        (void)hipOccupancyMaxActiveBlocksPerMultiprocessor(&per_cu, (const void*)mega, NT, LDS_BYTES);
        if (per_cu < 1) { fprintf(stderr, "kernel_launch: occupancy query says %d blocks per CU\n", per_cu); grid_blocks = -1; return; }
        grid_blocks = cus * 1;
        if (grid_blocks != 256) { fprintf(stderr, "kernel_launch: built for a 256-CU device (got %d)\n", cus); grid_blocks = -1; return; }
    }
    if (grid_blocks < 0) return;
    (void)hipMemsetAsync((char*)d_ws + OFF_CTL, 0, 262144, stream);
    KArgs a{};
    for (int i = 0; i < 23; ++i) a.in[i] = d_in[i];
    a.out = (float*)d_out; a.ws = (unsigned char*)d_ws;
    void* args[] = {&a};
    hipError_t e = hipLaunchCooperativeKernel((const void*)mega, dim3(grid_blocks), dim3(NT), args, LDS_BYTES, stream);
    if (e != hipSuccess) fprintf(stderr, "cooperative launch failed: %s (grid %d)\n", hipGetErrorString(e), grid_blocks);
}
```

```cpp
#include <hip/hip_runtime.h>
#include <hip/hip_cooperative_groups.h>
#include <cstdio>
#include <cstdint>

typedef unsigned short bf16;
typedef short bf16x8 __attribute__((ext_vector_type(8)));
typedef float f32x4 __attribute__((ext_vector_type(4)));
typedef float f32x16 __attribute__((ext_vector_type(16)));
typedef unsigned u32x4 __attribute__((ext_vector_type(4)));
typedef unsigned u32x2 __attribute__((ext_vector_type(2)));

constexpr int BATCH = 4, SEQ = 4096, DM = 1024, M = BATCH * SEQ, DEPTH = 2, NIN = 8992, NP = 6144;
constexpr float EPS = 1e-6f;
constexpr float LOG2E = 1.4426950408889634f;
constexpr float C2 = 0.125f * LOG2E;
constexpr size_t MiB = 1u << 20;
constexpr size_t OFF_CTL = 0;
constexpr size_t OFF_WIN = 1 * MiB, OFF_WMG = 13 * MiB, OFF_WBR = 19 * MiB, OFF_CW1 = 22 * MiB, OFF_CW2 = 24 * MiB, OFF_CB1 = 24 * MiB + 128 * 1024;
constexpr size_t OFF_WOUT = 25 * MiB, OFF_WPG = 29 * MiB, OFF_WPL = 33 * MiB;
constexpr size_t OFF_XB = 34 * MiB, OFF_ZA = 66 * MiB, OFF_ZB = 82 * MiB, OFF_ZC = 98 * MiB;
constexpr size_t OFF_COS = 114 * MiB, OFF_SIN = 116 * MiB, OFF_PB = 118 * MiB;
constexpr size_t OFF_LOGF = 134 * MiB, OFF_CF = 134 * MiB + 512 * 1024, OFF_GATES = 135 * MiB, OFF_SSP = 136 * MiB + 512 * 1024;
constexpr size_t OFF_KCMP = 136 * MiB + 768 * 1024, OFF_VCMP = 137 * MiB, OFF_SELM = 137 * MiB + 256 * 1024;
constexpr size_t OFF_QA = 139 * MiB, OFF_KA = 155 * MiB, OFF_VA = 171 * MiB, OFF_QB = 187 * MiB, OFF_QC = 203 * MiB, OFF_KC = 219 * MiB, OFF_VC = 235 * MiB;
constexpr size_t OFF_KCB = 251 * MiB, OFF_VCB = 255 * MiB, OFF_KSEL = 259 * MiB, OFF_KWIN = 263 * MiB, OFF_VSEL = 267 * MiB, OFF_VWIN = 271 * MiB;
constexpr size_t WS_NEED = 275 * MiB;
constexpr size_t OFF_G = 139 * MiB  , OFF_T = 235 * MiB  , OFF_MERGED = OFF_T, OFF_X1B = 203 * MiB, OFF_U = 139 * MiB;
constexpr int CTL_LAM = 64;

__device__ __forceinline__ bf16 f2bf(float f) { unsigned u = __float_as_uint(f); return (bf16)((u + 0x7fffu + ((u >> 16) & 1u)) >> 16); }
__device__ __forceinline__ float bf2f(bf16 h) { return __uint_as_float(((unsigned)h) << 16); }
__device__ __forceinline__ unsigned pk2(float lo, float hi) { typedef float f2_ __attribute__((ext_vector_type(2))); typedef __bf16 b2_ __attribute__((ext_vector_type(2))); f2_ v = {lo, hi}; b2_ b = __builtin_convertvector(v, b2_); return __builtin_bit_cast(unsigned, b); }
__device__ __forceinline__ float sigmoidf_(float x) { return 1.f / (1.f + __expf(-x)); }
__device__ __forceinline__ float siluf_(float x) { return x / (1.f + __expf(-x)); }
__device__ __forceinline__ float logsigmoidf_(float x) { return x >= 0.f ? -log1pf(expf(-x)) : x - log1pf(expf(x)); }

__device__ __forceinline__ int ktile_off(int s, int d) { return (s >> 6) * 4096 + (d >> 3) * 512 + (s & 63) * 8 + (d & 7); }
__device__ __forceinline__ int vtile_off(int s, int d) { return (s >> 6) * 4096 + (d >> 5) * 2048 + ((s & 63) >> 4) * 512 + (s & 15) * 32 + (d & 31); }
__device__ __forceinline__ int v128_off(int s, int d) { return (s >> 6) * 8192 + (d >> 5) * 2048 + ((s & 63) >> 4) * 512 + (s & 15) * 32 + (d & 31); }

template <int W> __device__ __forceinline__ void store_bf(bf16* dst, const float* v) {
    if constexpr (W == 4) { u32x2 o; o.x = pk2(v[0], v[1]); o.y = pk2(v[2], v[3]); *(u32x2*)dst = o; }
    else { u32x4 o; o.x = pk2(v[0], v[1]); o.y = pk2(v[2], v[3]); o.z = pk2(v[4], v[5]); o.w = pk2(v[6], v[7]); *(u32x4*)dst = o; }
}

__device__ __forceinline__ int win_srccol(int n) {
    const int seg = n >> 6, j = n & 63; const int il = ((j & 1) << 5) + (j >> 1);
    if (seg < 8) return 0 + n;
    if (seg < 16) return 512 + (n - 512);
    if (seg < 24) return 1024 + (n - 1024);
    if (seg < 32) return 1544 + (n - 1536);
    if (seg < 40) return 2056 + (seg - 32) * 64 + il;
    if (seg < 42) return 2568 + (n - 2560);
    if (seg < 44) return 2696 + (n - 2688);
    if (seg < 46) return 2824 + (seg - 44) * 64 + il;
    if (seg < 48) return 3080 + (seg - 46) * 64 + il;
    if (seg < 50) return 2952 + (n - 3072);
    if (seg < 52) return 3208 + (n - 3200);
    if (seg < 60) return 3360 + (n - 3328);
    if (seg < 68) return 3872 + (seg - 60) * 64 + il;
    if (seg < 76) return 4384 + (seg - 68) * 64 + il;
    if (seg < 84) return 4896 + (n - 4864);
    if (seg < 92) return 5408 + (n - 5376);
    if (seg == 92) { if (j < 8) return 1536 + j; if (j < 32) return 3336 + (j - 8); return -1; }
    return -1;
}

enum { EPI_INPROJ = 0, EPI_GATE = 1, EPI_BR0 = 2, EPI_BR1 = 3, EPI_BR2 = 4, EPI_OUT = 5, EPI_U = 6, EPI_PLE = 7, EPI_GATE3 = 9, EPI_BR3 = 10 };
struct EpiCtx { unsigned char* ws; const float* bfg; const float* xin; float* X; int gi; };

__device__ __forceinline__ float row_rstd(const unsigned char* ws, int row) {
    const f32x4 sp = *(const f32x4*)(ws + OFF_SSP + (size_t)row * 16);
    return rsqrtf(((sp[0] + sp[1]) + (sp[2] + sp[3])) * (1.f / 1024.f) + EPS);
}

enum { T_QA = 0, T_KA, T_VA, T_ZA, T_QB, T_CB, T_KROPE, T_VSW, T_ZB, T_QC, T_KC, T_VC, T_ZC, T_SPECIAL };
__device__ __forceinline__ int inproj_type(int t) {
    return t < 2 ? T_QA : t < 4 ? T_KA : t < 6 ? T_VA : t < 8 ? T_ZA : t < 10 ? T_QB : t == 10 ? T_CB : t == 11 ? T_KROPE : t == 12 ? T_VSW : t < 15 ? T_ZB : t < 17 ? T_QC : t < 19 ? T_KC : t < 21 ? T_VC : t < 23 ? T_ZC : T_SPECIAL;
}
struct Pre { float rs; float a[8]; float b[8]; };
template <int KIND, int T> __device__ __forceinline__ void pre_load(const EpiCtx& E, int row, int col, Pre& p) {
    unsigned char* ws = E.ws; const size_t idx = (size_t)row * 1024 + col;
    if constexpr (KIND == EPI_INPROJ) {
        if constexpr (T == T_KROPE || T == T_QC || T == T_KC) { const int d = col & 63;
            const f32x4 c = *(const f32x4*)((const float*)(ws + OFF_COS) + (size_t)row * 32 + (d >> 1)), s = *(const f32x4*)((const float*)(ws + OFF_SIN) + (size_t)row * 32 + (d >> 1));
#pragma unroll
            for (int i = 0; i < 4; ++i) { p.a[i] = c[i]; p.b[i] = s[i]; } }
    } else if constexpr (KIND == EPI_GATE || KIND == EPI_GATE3) {
    } else if constexpr (KIND == EPI_BR3) {
        const u32x4 g = *(const u32x4*)((const bf16*)(ws + OFF_G) + (size_t)E.gi * M * 1024 + idx);
#pragma unroll
        for (int i = 0; i < 4; ++i) { p.a[2 * i] = __uint_as_float(g[i] << 16); p.a[2 * i + 1] = __uint_as_float(g[i] & 0xffff0000u); }
        if (E.gi > 0) { const u32x4 t = *(const u32x4*)((const bf16*)(ws + OFF_T) + idx);
#pragma unroll
            for (int i = 0; i < 4; ++i) { p.b[2 * i] = __uint_as_float(t[i] << 16); p.b[2 * i + 1] = __uint_as_float(t[i] & 0xffff0000u); } }
        else {
#pragma unroll
            for (int i = 0; i < 8; ++i) p.b[i] = 0.f; }
    } else if constexpr (KIND == EPI_BR0 || KIND == EPI_BR1 || KIND == EPI_BR2) {
        const u32x4 g = *(const u32x4*)((const bf16*)(ws + OFF_G) + idx);
#pragma unroll
        for (int i = 0; i < 4; ++i) { p.a[2 * i] = __uint_as_float(g[i] << 16); p.a[2 * i + 1] = __uint_as_float(g[i] & 0xffff0000u); }
        if constexpr (KIND != EPI_BR0) { const u32x4 t = *(const u32x4*)((const bf16*)(ws + OFF_T) + idx);
#pragma unroll
            for (int i = 0; i < 4; ++i) { p.b[2 * i] = __uint_as_float(t[i] << 16); p.b[2 * i + 1] = __uint_as_float(t[i] & 0xffff0000u); } }
    } else if constexpr (KIND == EPI_OUT) { const f32x4 t0 = *(const f32x4*)(E.xin + idx), t1 = *(const f32x4*)(E.xin + idx + 4);
#pragma unroll
        for (int i = 0; i < 4; ++i) { p.a[i] = t0[i]; p.a[4 + i] = t1[i]; }
    } else if constexpr (KIND == EPI_PLE) { const f32x4 t0 = *(const f32x4*)(E.X + idx), t1 = *(const f32x4*)(E.X + idx + 4); const u32x4 u = *(const u32x4*)((const bf16*)(ws + OFF_U) + idx);
#pragma unroll
        for (int i = 0; i < 4; ++i) { p.a[i] = t0[i]; p.a[4 + i] = t1[i]; p.b[2 * i] = __uint_as_float(u[i] << 16); p.b[2 * i + 1] = __uint_as_float(u[i] & 0xffff0000u); }
    }
}
__device__ __forceinline__ void st_f32x8(float* dst, const float* v) { f32x4 a = {v[0], v[1], v[2], v[3]}, b = {v[4], v[5], v[6], v[7]}; *(f32x4*)dst = a; *(f32x4*)(dst + 4) = b; }
template <int KIND, int T> __device__ __forceinline__ void emit_fin(const EpiCtx& E, int row, int col, const float* a, const Pre& p) {
    constexpr int W = 8;
    unsigned char* ws = E.ws; const size_t idx = (size_t)row * 1024 + col;
    float v[W];
    if constexpr (KIND == EPI_INPROJ) {
        const float rs = p.rs;
#pragma unroll
        for (int i = 0; i < W; ++i) v[i] = a[i] * rs;
        const int b = row >> 12, s = row & 4095;
        if constexpr (T == T_KROPE || T == T_QC || T == T_KC) {
#pragma unroll
            for (int j = 0; j < 4; ++j) { const float c = p.a[j], sn = p.b[j], x1 = v[2 * j], x2 = v[2 * j + 1]; v[2 * j] = x1 * c - x2 * sn; v[2 * j + 1] = x2 * c + x1 * sn; } }
        if constexpr (T == T_QA) { const int cc = col, h = cc >> 6, d = cc & 63;
#pragma unroll
            for (int i = 0; i < W; ++i) v[i] *= C2;
            store_bf<W>((bf16*)(ws + OFF_QA) + ((size_t)(b * 8 + h) * 4096 + s) * 64 + d, v);
        } else if constexpr (T == T_KA) { const int cc = col - 512, h = cc >> 6, d = cc & 63;
            store_bf<W>((bf16*)(ws + OFF_KA) + (size_t)(b * 8 + h) * 262144 + ktile_off(s, d), v);
        } else if constexpr (T == T_VA) { const int cc = col - 1024, h = cc >> 6, d = cc & 63;
            store_bf<W>((bf16*)(ws + OFF_VA) + (size_t)(b * 8 + h) * 262144 + vtile_off(s, d), v);
        } else if constexpr (T == T_ZA || T == T_ZB || T == T_ZC) { const int cc = col - (T == T_ZA ? 1536 : T == T_ZB ? 3328 : 5376);
#pragma unroll
            for (int i = 0; i < W; ++i) v[i] = siluf_(v[i]);
            store_bf<W>((bf16*)(ws + (T == T_ZA ? OFF_ZA : T == T_ZB ? OFF_ZB : OFF_ZC)) + (size_t)row * 512 + cc, v);
        } else if constexpr (T == T_QB) { const int cc = col - 2048, h = cc >> 6, d = cc & 63;
#pragma unroll
            for (int i = 0; i < W; ++i) v[i] *= C2;
            store_bf<W>((bf16*)(ws + OFF_QB) + ((size_t)(b * 8 + h) * 4096 + s) * 64 + d, v);
        } else if constexpr (T == T_CB) { const int cc = col - 2560, g = (cc >> 6) & 1, d = cc & 63;
            store_bf<W>((bf16*)(ws + (cc < 128 ? OFF_KCB : OFF_VCB)) + ((size_t)(b * 2 + g) * 4096 + s) * 64 + d, v);
        } else if constexpr (T == T_KROPE) { const int cc = col - 2816, g = (cc >> 6) & 1, d = cc & 63;
            store_bf<W>((bf16*)(ws + (cc < 128 ? OFF_KSEL : OFF_KWIN)) + (size_t)(b * 2 + g) * 262144 + ktile_off(s, d), v);
        } else if constexpr (T == T_VSW) { const int cc = col - 3072, g = (cc >> 6) & 1, d = cc & 63;
            store_bf<W>((bf16*)(ws + (cc < 128 ? OFF_VSEL : OFF_VWIN)) + (size_t)(b * 2 + g) * 262144 + vtile_off(s, d), v);
        } else if constexpr (T == T_QC) { const int cc = col - 3840, h = cc >> 6, d = cc & 63;
#pragma unroll
            for (int i = 0; i < W; ++i) v[i] *= C2;
            store_bf<W>((bf16*)(ws + OFF_QC) + ((size_t)(b * 8 + h) * 4096 + s) * 64 + d, v);
        } else if constexpr (T == T_KC) { const int cc = col - 4352, h = cc >> 6, d = cc & 63;
            store_bf<W>((bf16*)(ws + OFF_KC) + (size_t)(b * 8 + h) * 262144 + ktile_off(s, d), v);
        } else if constexpr (T == T_VC) { const int cc = col - 4864, hc = cc >> 7, d = cc & 127;
            store_bf<W>((bf16*)(ws + OFF_VC) + (size_t)(b * 4 + hc) * 524288 + v128_off(s, d), v);
        } else { const int cc = col - 5888;
            if (cc < 8) { float* o = (float*)(ws + OFF_LOGF) + (size_t)row * 8 + cc;
#pragma unroll
                for (int i = 0; i < W; ++i) o[i] = logsigmoidf_(v[i] + E.bfg[cc + i]) * LOG2E;
            } else if (cc < 32) { float* o = (float*)(ws + OFF_GATES) + (size_t)row * 24 + (cc - 8);
#pragma unroll
                for (int i = 0; i < W; ++i) o[i] = sigmoidf_(v[i]);
            }
        }
    } else if constexpr (KIND == EPI_GATE3) {
#pragma unroll
        for (int i = 0; i < W; ++i) v[i] = sigmoidf_(a[i] * p.rs);
        store_bf<W>((bf16*)(ws + OFF_G) + (size_t)E.gi * M * 1024 + idx, v);
    } else if constexpr (KIND == EPI_BR3) {
#pragma unroll
        for (int i = 0; i < W; ++i) v[i] = p.a[i] * a[i] + p.b[i];
        store_bf<W>((bf16*)(ws + OFF_T) + idx, v);
    } else if constexpr (KIND == EPI_GATE) {
#pragma unroll
        for (int i = 0; i < W; ++i) v[i] = sigmoidf_(a[i] * p.rs);
        store_bf<W>((bf16*)(ws + OFF_G) + idx, v);
    } else if constexpr (KIND == EPI_BR0 || KIND == EPI_BR1 || KIND == EPI_BR2) {
#pragma unroll
        for (int i = 0; i < W; ++i) { v[i] = p.a[i] * a[i]; if (KIND != EPI_BR0) v[i] += p.b[i]; }
        if constexpr (KIND == EPI_BR2) store_bf<W>((bf16*)(ws + OFF_MERGED) + idx, v);
        else store_bf<W>((bf16*)(ws + OFF_T) + idx, v);
    } else if constexpr (KIND == EPI_OUT) {
#pragma unroll
        for (int i = 0; i < W; ++i) v[i] = p.a[i] + a[i];
        st_f32x8(E.X + idx, v);
        store_bf<W>((bf16*)(ws + OFF_X1B) + idx, v);
    } else if constexpr (KIND == EPI_U) {
        store_bf<W>((bf16*)(ws + OFF_U) + idx, a);
    } else if constexpr (KIND == EPI_PLE) {
#pragma unroll
        for (int i = 0; i < W; ++i) v[i] = p.a[i] + sigmoidf_(a[i]) * p.b[i];
        st_f32x8(E.X + idx, v);
        store_bf<W>((bf16*)(ws + OFF_XB) + idx, v);
    }
}

__device__ __forceinline__ void d_xprep(int vb, int vt, const float* x, unsigned char* ws) {
    const int row = vb * 4 + (vt >> 6), lane = vt & 63;
    const f32x4* xr = (const f32x4*)(x + (size_t)row * 1024) + lane; float ss = 0.f;
    bf16* o = (bf16*)(ws + OFF_XB) + (size_t)row * 1024;
#pragma unroll
    for (int j = 0; j < 4; ++j) { const f32x4 v = xr[64 * j]; ss += (v[0] * v[0] + v[1] * v[1]) + (v[2] * v[2] + v[3] * v[3]); float t[4] = {v[0], v[1], v[2], v[3]}; store_bf<4>(o + 256 * j + 4 * lane, t); }
#pragma unroll
    for (int of = 1; of < 64; of <<= 1) ss += __shfl_xor(ss, of);
    if (lane == 0) { f32x4 s = {ss, 0.f, 0.f, 0.f}; *(f32x4*)(ws + OFF_SSP + (size_t)row * 16) = s; }
}
__device__ __forceinline__ void d_sumsq(int vb, int vt, const float* x, unsigned char* ws) {
    const int row = vb * 4 + (vt >> 6), lane = vt & 63;
    const f32x4* xr = (const f32x4*)(x + (size_t)row * 1024) + lane; float ss = 0.f;
#pragma unroll
    for (int j = 0; j < 4; ++j) { const f32x4 v = xr[64 * j]; ss += (v[0] * v[0] + v[1] * v[1]) + (v[2] * v[2] + v[3] * v[3]); }
#pragma unroll
    for (int of = 1; of < 64; of <<= 1) ss += __shfl_xor(ss, of);
    if (lane == 0) { f32x4 s = {ss, 0.f, 0.f, 0.f}; *(f32x4*)(ws + OFF_SSP + (size_t)row * 16) = s; }
}
__device__ __forceinline__ void d_rope_table(int vb, int vt, const int* pos, unsigned char* ws) {
    const int idx = vb * 256 + vt, row = idx >> 5, i = idx & 31;
    const float inv = exp2f(-(float)i * (13.287712379549449f / 32.f));
    const float ang = (float)pos[row] * inv;
    float s, c; sincosf(ang, &s, &c);
    ((float*)(ws + OFF_COS))[idx] = c; ((float*)(ws + OFF_SIN))[idx] = s;
}
__device__ __forceinline__ void d_pconv(int vb, int vt, const float* p, unsigned char* ws) {
    const size_t i = ((size_t)vb * 256 + vt) * 4;
    const f32x4 v = *(const f32x4*)(p + i); float t[4] = {v[0], v[1], v[2], v[3]}; store_bf<4>((bf16*)(ws + OFF_PB) + i, t);
}
constexpr size_t OFF_CBPART = OFF_CTL + 65536;
__device__ __forceinline__ void d_cb1_part(int u, int vt, const float* pe_k, const float* w1_k, const float* pe_v, const float* w1_v, unsigned char* ws) {
    const int kv = u >> 4, kc = u & 15, j = vt;
    const float* pe = (kv ? pe_v : pe_k) + 128 * kc; const float* w1 = (kv ? w1_v : w1_k) + (size_t)(128 * kc) * 256 + j;
    float acc = 0.f;
#pragma unroll 16
    for (int k = 0; k < 128; ++k) acc += pe[k] * w1[(size_t)k * 256];
    ((float*)(ws + OFF_CBPART))[(kv * 16 + kc) * 256 + j] = acc;
}
__device__ __forceinline__ void d_cb1_sum(int vt, const float* b1_k, const float* b1_v, unsigned char* ws) {
    const int kv = vt >> 8, j = vt & 255; float acc = (kv ? b1_v : b1_k)[j];
#pragma unroll
    for (int kc = 0; kc < 16; ++kc) acc += ((const float*)(ws + OFF_CBPART))[(kv * 16 + kc) * 256 + j];
    ((float*)(ws + OFF_CB1))[kv * 256 + j] = acc;
}
__device__ __forceinline__ void d_lam(int vt, const float* dl, unsigned char* ws, int l) {
    if (vt == 0) { float s1 = 0.f, s2 = 0.f; for (int i = 0; i < 64; ++i) { s1 += dl[i] * dl[64 + i]; s2 += dl[128 + i] * dl[192 + i]; }
        const float li = 0.8f - 0.6f * expf(-0.3f * (float)l); ((float*)(ws + OFF_CTL))[CTL_LAM + l] = expf(s1) - expf(s2) + li; }
}
__device__ __forceinline__ void d_final(int vb, int vt, float* X, const float* g) {
    const int row = vb * 4 + (vt >> 6), lane = vt & 63;
    f32x4* xr = (f32x4*)(X + (size_t)row * 1024) + lane; f32x4 v[4]; float ss = 0.f;
#pragma unroll
    for (int j = 0; j < 4; ++j) { v[j] = xr[64 * j]; ss += (v[j][0] * v[j][0] + v[j][1] * v[j][1]) + (v[j][2] * v[j][2] + v[j][3] * v[j][3]); }
#pragma unroll
    for (int of = 1; of < 64; of <<= 1) ss += __shfl_xor(ss, of);
    const float rs = rsqrtf(ss * (1.f / 1024.f) + EPS);
#pragma unroll
    for (int j = 0; j < 4; ++j) { const f32x4 gg = *((const f32x4*)g + 64 * j + lane); xr[64 * j] = v[j] * rs * gg; }
}


namespace pg8 {
#define PG8_LAS __attribute__((address_space(3)))
typedef unsigned short bf16_t;
typedef short bf16x8 __attribute__((ext_vector_type(8)));
typedef float f32x4 __attribute__((ext_vector_type(4)));
typedef unsigned u32x4 __attribute__((ext_vector_type(4)));
constexpr int BM = 256, BK = 64, HALF = 128, HTB = HALF * BK * 2  , STAGE_BYTES = 8 * HTB, NXCD = 8, WGM = 8;

__host__ __device__ __forceinline__ int lds_byte(int r, int c) { const int st = (r >> 4) * 2 + (c >> 5), rr = r & 15, cc = c & 31, ob = rr * 64 + cc * 2; return st * 1024 + (ob ^ (((ob >> 9) & 1) << 5)); }
__host__ __device__ __forceinline__ void stage_rc(int b, int& R, int& C) { const int st = b / 1024, sb = b % 1024, swz = sb ^ (((sb >> 9) & 1) << 5); R = (st >> 1) * 16 + swz / 64; C = (st & 1) * 32 + (swz % 64) / 2; }
__host__ __device__ __forceinline__ int perm32(int rho) { const int n = rho >> 4, i = rho & 15; return 8 * (i >> 2) + 4 * n + (i & 3); }

struct Unit { int pm, pn; };
struct Gemm { const bf16_t* A; const bf16_t* Bt; int M, N, K; };

struct StaticOrder {
    int nM, nN, nwg, G, c;
    __host__ __device__ void init(int M, int N, int G_, int c_) { nM = M / BM; nN = N / BM; nwg = nM * nN; G = G_; c = c_; }
    __host__ __device__ bool next(int i, Unit& u) const {
        const long L = (long)i * G + c; if (L >= nwg) return false;
        int wgid = (int)L; { const int q = nwg / NXCD, r = nwg % NXCD, xcd = wgid % NXCD, off = wgid / NXCD; wgid = (xcd < r ? xcd * (q + 1) : r * (q + 1) + (xcd - r) * q) + off; }
        const int nig = WGM * nN, gid = wgid / nig, fm = gid * WGM, gsz = (nM - fm) < WGM ? (nM - fm) : WGM;
        u.pm = fm + ((wgid % nig) % gsz); u.pn = (wgid % nig) / gsz; return true;
    }
    __device__ __forceinline__ void a_ready(const Unit&) const {}
    __device__ __forceinline__ void done(const Unit&) const {}
};

__device__ __forceinline__ unsigned cvt_pk_bf16(float lo, float hi) { unsigned r; asm volatile("v_cvt_pk_bf16_f32 %0, %1, %2" : "=v"(r) : "v"(lo), "v"(hi)); return r; }
typedef float f32x2 __attribute__((ext_vector_type(2)));
template <class Epi, class Sched, bool ALIGN_EPI = false, bool SP2 = false>
__device__ __forceinline__ void gemm_phase(PG8_LAS unsigned char* lds, const Gemm g, const Sched& S, const Epi& E) {
    int tid_o = threadIdx.x; asm volatile("" : "+v"(tid_o));
    const int tid = tid_o, wid = __builtin_amdgcn_readfirstlane(tid >> 6), lane = tid & 63, wr = wid >> 2, wc = wid & 3, fr = lane & 15, fq = lane >> 4;
    const int K = g.K, nt = K / BK;
    unsigned voffA[2], voffB[2];
#pragma unroll
    for (int i = 0; i < 2; ++i) { int R, C; stage_rc(tid * 16 + i * 8192, R, C); const int Rb = Epi::PERM ? ((R & ~31) + perm32(R & 31)) : R;
        voffA[i] = (unsigned)(R * K + C) * 2u; voffB[i] = (unsigned)(Rb * K + C) * 2u; }
    const size_t kstep = (size_t)(BK * 2);
    const size_t hstep = (size_t)HALF * K * 2;
    const size_t tstep = 2 * hstep;
    const unsigned ldsw = (unsigned)wid * 1024u;
    const int aoff = lds_byte(wr * 64 + fr, fq * 8), boff = lds_byte(wc * 32 + fr, fq * 8);
#define PG8_SA(b, h) (((b) * 2 + (h)) * HTB)
#define PG8_SB(b, h) ((4 + (b) * 2 + (h)) * HTB)
#define PG8_STAGE(bufoff, gbase, voff) do { _Pragma("unroll") for (int _i = 0; _i < 2; ++_i) \
        __builtin_amdgcn_global_load_lds((const unsigned*)((const char*)(gbase) + (voff)[_i]), (PG8_LAS unsigned*)(lds + (bufoff) + ldsw + _i * 8192), 16, 0, 0); } while (0)
#define PG8_LDA(dst, b, h) do { _Pragma("unroll") for (int m = 0; m < 4; ++m) _Pragma("unroll") for (int k = 0; k < 2; ++k) dst[m][k] = *(const PG8_LAS bf16x8*)(lds + PG8_SA(b, h) + aoff + m * 2048 + k * 1024); } while (0)
#define PG8_LDB(dst, b, h) do { _Pragma("unroll") for (int n = 0; n < 2; ++n) _Pragma("unroll") for (int k = 0; k < 2; ++k) dst[n][k] = *(const PG8_LAS bf16x8*)(lds + PG8_SB(b, h) + boff + n * 2048 + k * 1024); } while (0)
#define PG8_MMA(ai, bj, At, Bt) do { __builtin_amdgcn_s_setprio(1); _Pragma("unroll") for (int m = 0; m < 4; ++m) _Pragma("unroll") for (int n = 0; n < 2; ++n) _Pragma("unroll") for (int k = 0; k < 2; ++k) \
        acc[ai][bj][m][n] = __builtin_amdgcn_mfma_f32_16x16x32_bf16(Bt[n][k], At[m][k], acc[ai][bj][m][n], 0, 0, 0); __builtin_amdgcn_s_setprio(0); } while (0)
#define PG8_WAIT_V(n) asm volatile("s_waitcnt vmcnt(" #n ")" ::: "memory")
#define PG8_WAIT_L(n) asm volatile("s_waitcnt lgkmcnt(" #n ")" ::: "memory")
#define PG8_BAR __builtin_amdgcn_s_barrier()
#define PG8_SCHED __builtin_amdgcn_sched_barrier(0)
    Unit cur, nxt; int ui = 0;
    if (!S.next(0, cur)) return;
    f32x4 acc[2][2][4][2];
#pragma unroll
    for (int a = 0; a < 2; ++a)
#pragma unroll
        for (int b = 0; b < 2; ++b)
#pragma unroll
            for (int m = 0; m < 4; ++m)
#pragma unroll
                for (int n = 0; n < 2; ++n) acc[a][b][m][n] = (f32x4){0.f, 0.f, 0.f, 0.f};
    bf16x8 At[4][2], B0[2][2], B1[2][2];
    const char* cA = (const char*)g.A + (size_t)cur.pm * tstep; const char* cB = (const char*)g.Bt + (size_t)cur.pn * tstep;
    S.a_ready(cur);
    if constexpr (SP2) {
        PG8_STAGE(PG8_SB(0, 0), cB, voffB); PG8_STAGE(PG8_SB(0, 1), cB + hstep, voffB); PG8_STAGE(PG8_SA(0, 0), cA, voffA); PG8_STAGE(PG8_SA(0, 1), cA + hstep, voffA);
        if (wr == 1) PG8_BAR;
        PG8_WAIT_V(2); PG8_BAR;
        PG8_STAGE(PG8_SB(1, 0), cB + kstep, voffB); PG8_STAGE(PG8_SA(1, 0), cA + kstep, voffA); PG8_STAGE(PG8_SB(1, 1), cB + hstep + kstep, voffB);
        PG8_WAIT_V(6); PG8_BAR;
    } else {
        PG8_STAGE(PG8_SB(0, 0), cB, voffB); PG8_STAGE(PG8_SA(0, 0), cA, voffA); PG8_STAGE(PG8_SB(0, 1), cB + hstep, voffB); PG8_STAGE(PG8_SA(0, 1), cA + hstep, voffA);
        if (wr == 1) PG8_BAR;
        PG8_WAIT_V(4); PG8_BAR;
        PG8_STAGE(PG8_SB(1, 0), cB + kstep, voffB); PG8_STAGE(PG8_SA(1, 0), cA + kstep, voffA); PG8_STAGE(PG8_SB(1, 1), cB + hstep + kstep, voffB);
        PG8_WAIT_V(6); PG8_BAR;
    }
    for (;;) {
        const bool has_next = S.next(ui + 1, nxt);
        const char* nA = has_next ? (const char*)g.A + (size_t)nxt.pm * tstep : cA; const char* nB = has_next ? (const char*)g.Bt + (size_t)nxt.pn * tstep : cB;
        for (int t = 0; t < nt; t += 2) {
            const bool last = (t == nt - 2);
            const char* a1 = cA + (size_t)(t + 1) * kstep;
            const char* a2 = last ? nA : cA + (size_t)(t + 2) * kstep; const char* b2 = last ? nB : cB + (size_t)(t + 2) * kstep;
            const char* a3 = a2 + kstep; const char* b3 = b2 + kstep;
            if (last && has_next) S.a_ready(nxt);
            if constexpr (SP2) {
            PG8_LDB(B0, 0, 0); PG8_LDB(B1, 0, 1); PG8_SCHED; PG8_LDA(At, 0, 0); PG8_STAGE(PG8_SA(1, 1), a1 + hstep, voffA);
            PG8_WAIT_V(8); PG8_WAIT_L(0); PG8_BAR; PG8_MMA(0, 0, At, B0); PG8_MMA(0, 1, At, B1); PG8_BAR; PG8_SCHED;
            PG8_LDA(At, 0, 1); PG8_STAGE(PG8_SB(0, 0), b2, voffB); PG8_STAGE(PG8_SB(0, 1), b2 + hstep, voffB); PG8_STAGE(PG8_SA(0, 0), a2, voffA);
            PG8_WAIT_V(8); PG8_WAIT_L(0); PG8_BAR; PG8_MMA(1, 0, At, B0); PG8_MMA(1, 1, At, B1); PG8_BAR; PG8_SCHED;
            PG8_LDB(B0, 1, 0); PG8_LDB(B1, 1, 1); PG8_SCHED; PG8_LDA(At, 1, 0); PG8_STAGE(PG8_SA(0, 1), a2 + hstep, voffA);
            PG8_WAIT_V(8); PG8_WAIT_L(0); PG8_BAR; PG8_MMA(0, 0, At, B0); PG8_MMA(0, 1, At, B1); PG8_BAR; PG8_SCHED;
            PG8_LDA(At, 1, 1); PG8_STAGE(PG8_SB(1, 0), b3, voffB); PG8_STAGE(PG8_SB(1, 1), b3 + hstep, voffB); PG8_STAGE(PG8_SA(1, 0), a3, voffA);
            PG8_WAIT_V(8); PG8_WAIT_L(0); PG8_BAR; PG8_MMA(1, 0, At, B0); PG8_MMA(1, 1, At, B1); PG8_BAR; PG8_SCHED;
            } else {
            PG8_LDB(B0, 0, 0); PG8_SCHED; PG8_LDA(At, 0, 0); PG8_STAGE(PG8_SA(1, 1), a1 + hstep, voffA);
            PG8_WAIT_L(8); PG8_BAR; PG8_WAIT_L(0); PG8_MMA(0, 0, At, B0); PG8_BAR; PG8_SCHED;
            PG8_LDB(B1, 0, 1); PG8_STAGE(PG8_SB(0, 0), b2, voffB);
            PG8_BAR; PG8_WAIT_L(0); PG8_MMA(0, 1, At, B1); PG8_BAR;
            PG8_LDA(At, 0, 1); PG8_STAGE(PG8_SA(0, 0), a2, voffA);
            PG8_BAR; PG8_WAIT_L(0); PG8_MMA(1, 0, At, B0); PG8_BAR; PG8_SCHED;
            PG8_STAGE(PG8_SB(0, 1), b2 + hstep, voffB);
            PG8_WAIT_V(6); PG8_BAR; PG8_MMA(1, 1, At, B1); PG8_BAR;
            PG8_LDB(B0, 1, 0); PG8_SCHED; PG8_LDA(At, 1, 0); PG8_STAGE(PG8_SA(0, 1), a2 + hstep, voffA);
            PG8_WAIT_L(8); PG8_BAR; PG8_WAIT_L(0); PG8_MMA(0, 0, At, B0); PG8_BAR; PG8_SCHED;
            PG8_LDB(B1, 1, 1); PG8_STAGE(PG8_SB(1, 0), b3, voffB);
            PG8_BAR; PG8_WAIT_L(0); PG8_MMA(0, 1, At, B1); PG8_BAR;
            PG8_LDA(At, 1, 1); PG8_STAGE(PG8_SA(1, 0), a3, voffA);
            PG8_BAR; PG8_WAIT_L(0); PG8_MMA(1, 0, At, B0); PG8_BAR; PG8_SCHED;
            PG8_STAGE(PG8_SB(1, 1), b3 + hstep, voffB);
            PG8_WAIT_V(6); PG8_BAR; PG8_MMA(1, 1, At, B1); PG8_BAR;
            }
        }
        if constexpr (ALIGN_EPI) { if (wr == 0) PG8_BAR; }
        if constexpr (!Epi::AFTER_DRAIN) { E(acc, cur, wr, wc, fr, fq); S.done(cur); }
        if (!has_next) break;
#pragma unroll
        for (int a = 0; a < 2; ++a)
#pragma unroll
            for (int b = 0; b < 2; ++b)
#pragma unroll
                for (int m = 0; m < 4; ++m)
#pragma unroll
                    for (int n = 0; n < 2; ++n) acc[a][b][m][n] = (f32x4){0.f, 0.f, 0.f, 0.f};
        cur = nxt; cA = nA; cB = nB; ++ui;
        if constexpr (ALIGN_EPI) { if (wr == 1) PG8_BAR; }
    }
    PG8_WAIT_V(0);
    if constexpr (!ALIGN_EPI) { if (wr == 0) PG8_BAR; }
    PG8_BAR;
    if constexpr (Epi::AFTER_DRAIN) { E.fused(acc, cur, wr, wc, fr, fq, lds, wid, lane); S.done(cur); }
#undef PG8_SA
#undef PG8_SB
#undef PG8_STAGE
#undef PG8_LDA
#undef PG8_LDB
#undef PG8_MMA
#undef PG8_WAIT_V
#undef PG8_WAIT_L
#undef PG8_BAR
#undef PG8_SCHED
}
}

template <int KIND> struct EpiFast {
    static constexpr bool PERM = true, AFTER_DRAIN = false;
    EpiCtx E;
    template <int T, int AI, int MH> __device__ __forceinline__ void grp(const pg8::f32x4 (&acc)[2][2][4][2], int row0, int col0, const float (&rs)[2][4]) const {
        Pre p00, p01, p10, p11;
        p00.rs = p01.rs = rs[AI][2 * MH]; p10.rs = p11.rs = rs[AI][2 * MH + 1];
        const int r0 = row0 + AI * 128 + (2 * MH) * 16, r1 = r0 + 16;
        if constexpr (KIND == EPI_PLE) {
            pre_load<KIND, T>(E, r0, col0, p00); pre_load<KIND, T>(E, r0, col0 + 128, p01);
            { const pg8::f32x4 v0 = acc[AI][0][2 * MH][0], v1 = acc[AI][0][2 * MH][1]; float v[8] = {v0[0], v0[1], v0[2], v0[3], v1[0], v1[1], v1[2], v1[3]}; emit_fin<KIND, T>(E, r0, col0, v, p00); }
            { const pg8::f32x4 v0 = acc[AI][1][2 * MH][0], v1 = acc[AI][1][2 * MH][1]; float v[8] = {v0[0], v0[1], v0[2], v0[3], v1[0], v1[1], v1[2], v1[3]}; emit_fin<KIND, T>(E, r0, col0 + 128, v, p01); }
            asm volatile("" ::: "memory");
            pre_load<KIND, T>(E, r1, col0, p10); pre_load<KIND, T>(E, r1, col0 + 128, p11);
            { const pg8::f32x4 v0 = acc[AI][0][2 * MH + 1][0], v1 = acc[AI][0][2 * MH + 1][1]; float v[8] = {v0[0], v0[1], v0[2], v0[3], v1[0], v1[1], v1[2], v1[3]}; emit_fin<KIND, T>(E, r1, col0, v, p10); }
            { const pg8::f32x4 v0 = acc[AI][1][2 * MH + 1][0], v1 = acc[AI][1][2 * MH + 1][1]; float v[8] = {v0[0], v0[1], v0[2], v0[3], v1[0], v1[1], v1[2], v1[3]}; emit_fin<KIND, T>(E, r1, col0 + 128, v, p11); }
            asm volatile("" ::: "memory");
            return;
        }
        pre_load<KIND, T>(E, r0, col0, p00); pre_load<KIND, T>(E, r0, col0 + 128, p01); pre_load<KIND, T>(E, r1, col0, p10); pre_load<KIND, T>(E, r1, col0 + 128, p11);
        { const pg8::f32x4 v0 = acc[AI][0][2 * MH][0], v1 = acc[AI][0][2 * MH][1]; float v[8] = {v0[0], v0[1], v0[2], v0[3], v1[0], v1[1], v1[2], v1[3]}; emit_fin<KIND, T>(E, r0, col0, v, p00); }
        { const pg8::f32x4 v0 = acc[AI][1][2 * MH][0], v1 = acc[AI][1][2 * MH][1]; float v[8] = {v0[0], v0[1], v0[2], v0[3], v1[0], v1[1], v1[2], v1[3]}; emit_fin<KIND, T>(E, r0, col0 + 128, v, p01); }
        { const pg8::f32x4 v0 = acc[AI][0][2 * MH + 1][0], v1 = acc[AI][0][2 * MH + 1][1]; float v[8] = {v0[0], v0[1], v0[2], v0[3], v1[0], v1[1], v1[2], v1[3]}; emit_fin<KIND, T>(E, r1, col0, v, p10); }
        { const pg8::f32x4 v0 = acc[AI][1][2 * MH + 1][0], v1 = acc[AI][1][2 * MH + 1][1]; float v[8] = {v0[0], v0[1], v0[2], v0[3], v1[0], v1[1], v1[2], v1[3]}; emit_fin<KIND, T>(E, r1, col0 + 128, v, p11); }
        asm volatile("" ::: "memory");
    }
    template <int T> __device__ __forceinline__ void run(const pg8::f32x4 (&acc)[2][2][4][2], int row0, int col0) const {
        float rs[2][4];
        if constexpr (KIND == EPI_INPROJ || KIND == EPI_GATE || KIND == EPI_GATE3) {
#pragma unroll
            for (int ai = 0; ai < 2; ++ai)
#pragma unroll
                for (int m = 0; m < 4; ++m) rs[ai][m] = row_rstd(E.ws, row0 + ai * 128 + m * 16);
        } else {
#pragma unroll
            for (int ai = 0; ai < 2; ++ai)
#pragma unroll
                for (int m = 0; m < 4; ++m) rs[ai][m] = 1.f; }
        grp<T, 0, 0>(acc, row0, col0, rs); grp<T, 0, 1>(acc, row0, col0, rs); grp<T, 1, 0>(acc, row0, col0, rs); grp<T, 1, 1>(acc, row0, col0, rs);
    }
    __device__ __forceinline__ void operator()(const pg8::f32x4 (&acc)[2][2][4][2], const pg8::Unit& u, int wr, int wc, int fr, int fq) const {
        const int row0 = u.pm * 256 + wr * 64 + fr, col0 = u.pn * 256 + wc * 32 + 8 * fq;
        if constexpr (KIND == EPI_INPROJ) {
            switch (inproj_type(u.pn)) {
                case T_QA: run<T_QA>(acc, row0, col0); break;
                case T_KA: run<T_KA>(acc, row0, col0); break;
                case T_VA: run<T_VA>(acc, row0, col0); break;
                case T_ZA: run<T_ZA>(acc, row0, col0); break;
                case T_QB: run<T_QB>(acc, row0, col0); break;
                case T_CB: run<T_CB>(acc, row0, col0); break;
                case T_KROPE: run<T_KROPE>(acc, row0, col0); break;
                case T_VSW: run<T_VSW>(acc, row0, col0); break;
                case T_ZB: run<T_ZB>(acc, row0, col0); break;
                case T_QC: run<T_QC>(acc, row0, col0); break;
                case T_KC: run<T_KC>(acc, row0, col0); break;
                case T_VC: run<T_VC>(acc, row0, col0); break;
                case T_ZC: run<T_ZC>(acc, row0, col0); break;
                default: run<T_SPECIAL>(acc, row0, col0); break;
            }
        } else if constexpr (KIND == EPI_GATE3 || KIND == EPI_BR3) {
            EpiFast<KIND> t = *this; t.E.gi = u.pn >> 2;
            t.template run<0>(acc, (u.pm & 63) * 256 + wr * 64 + fr, (u.pn & 3) * 256 + wc * 32 + 8 * fq);
        } else run<0>(acc, row0, col0);
    }
};
struct ChainOrder {
    int pm, pn4, rowmul;
    __device__ __forceinline__ void init(int G, int c, int rowmul_) { pg8::StaticOrder S0; S0.init(M, 1024, G, c); pg8::Unit u0; S0.next(0, u0); pm = u0.pm; pn4 = u0.pn; rowmul = rowmul_; }
    __device__ __forceinline__ bool next(int i, pg8::Unit& u) const { if (i >= 3) return false; u.pm = pm + 64 * i * rowmul; u.pn = 4 * i + pn4; return true; }
    __device__ __forceinline__ void a_ready(const pg8::Unit&) const {}
    __device__ __forceinline__ void done(const pg8::Unit&) const {}
};
#define FAST_GEMM(KIND, Aptr, Bptr, N_, K_, ALIGN) do { pg8::Gemm g_{(const pg8::bf16_t*)(Aptr), (const pg8::bf16_t*)(Bptr), M, (N_), (K_)}; pg8::StaticOrder S_; S_.init(M, (N_), (int)gridDim.x, (int)blockIdx.x); \
        EpiFast<KIND> Ep_{E}; pg8::gemm_phase<EpiFast<KIND>, pg8::StaticOrder, ALIGN, true>((PG8_LAS unsigned char*)lds, g_, S_, Ep_); } while (0)

#define LAS __attribute__((address_space(3)))
typedef short s16x4 __attribute__((ext_vector_type(4)));
typedef short v4i16_t __attribute__((ext_vector_type(4)));
typedef LAS const char* lds_cptr;
constexpr int A_KRING = 0, A_VRING = 49152, A_CFRING = 98304, A_MISC = 104448;
constexpr int A_SLOT = 16384;
constexpr int A_IMP = A_MISC, A_SELM = A_MISC + 16384, A_UMASK = A_SELM + 512, A_SEQ = A_UMASK + 16, A_WQ = A_SEQ + 80;
__device__ __forceinline__ void glds16(const void* gsrc, unsigned lds_dst) { unsigned keep;
    asm volatile("s_mov_b32 %0, m0\n\ts_mov_b32 m0, %2\n\ts_nop 0\n\tglobal_load_lds_dwordx4 %1, off\n\ts_mov_b32 m0, %0" : "=&s"(keep) : "v"(gsrc), "s"(lds_dst) : "memory"); }
__device__ __forceinline__ void glds4(const void* gsrc, unsigned lds_dst) { unsigned keep;
    asm volatile("s_mov_b32 %0, m0\n\ts_mov_b32 m0, %2\n\ts_nop 0\n\tglobal_load_lds_dword %1, off\n\ts_mov_b32 m0, %0" : "=&s"(keep) : "v"(gsrc), "s"(lds_dst) : "memory"); }
#define A_WAIT_BAR(N) asm volatile("s_waitcnt vmcnt(" #N ") lgkmcnt(0)\n\ts_barrier" ::: "memory")
__device__ __forceinline__ s16x4 vtr(lds_cptr p) { return __builtin_bit_cast(s16x4, __builtin_amdgcn_ds_read_tr16_b64_v4i16((LAS v4i16_t*)p)); }
__device__ __forceinline__ unsigned cvtpk(float lo, float hi) { typedef float f2 __attribute__((ext_vector_type(2))); typedef __bf16 b2 __attribute__((ext_vector_type(2))); f2 v = {lo, hi}; b2 b = __builtin_convertvector(v, b2); return __builtin_bit_cast(unsigned, b); }
__device__ __forceinline__ int crow(int r, int hi) { return (r & 3) + 8 * (r >> 2) + 4 * hi; }

template <int NDB> struct FlashSt { f32x16 o[NDB]; float m, l; };
template <int NDB> __device__ __forceinline__ void flash_init(FlashSt<NDB>& st) {
#pragma unroll
    for (int i = 0; i < NDB; ++i)
#pragma unroll
        for (int r = 0; r < 16; ++r) st.o[i][r] = 0.f;
    st.m = -1e30f; st.l = 0.f;
}
template <int NDB> __device__ __forceinline__ void flash_init3(FlashSt<NDB>& st) { flash_init<NDB>(st); st.m = 0.f; }
__device__ __forceinline__ void qk_tile(f32x16& p0, f32x16& p1, lds_cptr kslot, const bf16x8 (&qf)[4], int r32, int hi) {
    const lds_cptr kb = kslot + hi * 1024 + r32 * 16;
    bf16x8 ka[4], kc[4];
#pragma unroll
    for (int d0 = 0; d0 < 4; ++d0) { ka[d0] = *(const LAS bf16x8*)(kb + d0 * 2048); kc[d0] = *(const LAS bf16x8*)(kb + d0 * 2048 + 512); }
#pragma unroll
    for (int d0 = 0; d0 < 4; ++d0) {
        p0 = __builtin_amdgcn_mfma_f32_32x32x16_bf16(ka[d0], qf[d0], p0, 0, 0, 0);
        p1 = __builtin_amdgcn_mfma_f32_32x32x16_bf16(kc[d0], qf[d0], p1, 0, 0, 0);
    }
}
__device__ __forceinline__ float xhalf_max(float a) {
    auto rr = __builtin_amdgcn_permlane32_swap(__float_as_uint(a), __float_as_uint(a), false, false);
    return fmaxf(__uint_as_float(rr[0]), __uint_as_float(rr[1]));
}
__device__ __forceinline__ float rowmax32(const f32x16& p0, const f32x16& p1) {
    float a = fmaxf(p0[0], p1[0]);
#pragma unroll
    for (int r = 1; r < 16; ++r) a = fmaxf(a, fmaxf(p0[r], p1[r]));
    return xhalf_max(a);
}
template <int NDB> __device__ __forceinline__ void pv_tile(f32x16 (&o)[NDB], lds_cptr vslot_l, const f32x16& p0, const f32x16& p1) {
    bf16x8 pf[4];
    { u32x4 w;
      w.x = cvtpk(p0[0], p0[1]); w.y = cvtpk(p0[2], p0[3]); w.z = cvtpk(p0[4], p0[5]); w.w = cvtpk(p0[6], p0[7]); pf[0] = __builtin_bit_cast(bf16x8, w);
      w.x = cvtpk(p0[8], p0[9]); w.y = cvtpk(p0[10], p0[11]); w.z = cvtpk(p0[12], p0[13]); w.w = cvtpk(p0[14], p0[15]); pf[1] = __builtin_bit_cast(bf16x8, w);
      w.x = cvtpk(p1[0], p1[1]); w.y = cvtpk(p1[2], p1[3]); w.z = cvtpk(p1[4], p1[5]); w.w = cvtpk(p1[6], p1[7]); pf[2] = __builtin_bit_cast(bf16x8, w);
      w.x = cvtpk(p1[8], p1[9]); w.y = cvtpk(p1[10], p1[11]); w.z = cvtpk(p1[12], p1[13]); w.w = cvtpk(p1[14], p1[15]); pf[3] = __builtin_bit_cast(bf16x8, w); }
#pragma unroll
    for (int db = 0; db < NDB; ++db) {
        bf16x8 vf[4];
#pragma unroll
        for (int ks = 0; ks < 4; ++ks) { const s16x4 lo = vtr(vslot_l + db * 4096 + ks * 1024), hh = vtr(vslot_l + db * 4096 + ks * 1024 + 512);
            vf[ks] = (bf16x8){lo[0], lo[1], lo[2], lo[3], hh[0], hh[1], hh[2], hh[3]}; }
#pragma unroll
        for (int ks = 0; ks < 4; ++ks) o[db] = __builtin_amdgcn_mfma_f32_32x32x16_bf16(vf[ks], pf[ks], o[db], 0, 0, 0);
    }
}
template <int NDB> __device__ __forceinline__ void flash_update(FlashSt<NDB>& st, f32x16& p0, f32x16& p1, lds_cptr vslot_l) {
    const float rm = rowmax32(p0, p1);
    const float mn = fmaxf(st.m, rm), alpha = __builtin_amdgcn_exp2f(st.m - mn);
    st.m = mn;
    float ls = 0.f;
#pragma unroll
    for (int r = 0; r < 16; ++r) { p0[r] = __builtin_amdgcn_exp2f(p0[r] - mn); p1[r] = __builtin_amdgcn_exp2f(p1[r] - mn); ls += p0[r] + p1[r]; }
    st.l = st.l * alpha + ls;
#pragma unroll
    for (int db = 0; db < NDB; ++db)
#pragma unroll
        for (int r = 0; r < 16; ++r) st.o[db][r] *= alpha;
    pv_tile<NDB>(st.o, vslot_l, p0, p1);
}
__device__ __forceinline__ int lane_vbase(int lane) { return ((lane >> 4) & 1) * 32 + (lane & 3) * 8 + (4 * (lane >> 5) + ((lane & 15) >> 2)) * 64; }
#define DSR128(dst, addr, off) asm volatile("ds_read_b128 %0, %1 offset:%c2" : "=v"(dst) : "v"(addr), "i"(off) : "memory")
#define DSRTR(dst, addr, off) asm volatile("ds_read_b64_tr_b16 %0, %1 offset:%c2" : "=v"(dst) : "v"(addr), "i"(off) : "memory")
#define LGKM_WAIT0() do { asm volatile("s_waitcnt lgkmcnt(0)" ::: "memory"); __builtin_amdgcn_sched_barrier(0); } while (0)
__device__ __forceinline__ void qk_tile2(f32x16& p0, f32x16& p1, unsigned kaddr, const bf16x8 (&qf)[4]) {
    bf16x8 ka0, ka1, ka2, ka3, kc0, kc1, kc2, kc3;
    DSR128(ka0, kaddr, 0); DSR128(kc0, kaddr, 512); DSR128(ka1, kaddr, 2048); DSR128(kc1, kaddr, 2560);
    DSR128(ka2, kaddr, 4096); DSR128(kc2, kaddr, 4608); DSR128(ka3, kaddr, 6144); DSR128(kc3, kaddr, 6656);
    LGKM_WAIT0();
    __builtin_amdgcn_s_setprio(1);
    p0 = __builtin_amdgcn_mfma_f32_32x32x16_bf16(ka0, qf[0], p0, 0, 0, 0); p1 = __builtin_amdgcn_mfma_f32_32x32x16_bf16(kc0, qf[0], p1, 0, 0, 0);
    p0 = __builtin_amdgcn_mfma_f32_32x32x16_bf16(ka1, qf[1], p0, 0, 0, 0); p1 = __builtin_amdgcn_mfma_f32_32x32x16_bf16(kc1, qf[1], p1, 0, 0, 0);
    p0 = __builtin_amdgcn_mfma_f32_32x32x16_bf16(ka2, qf[2], p0, 0, 0, 0); p1 = __builtin_amdgcn_mfma_f32_32x32x16_bf16(kc2, qf[2], p1, 0, 0, 0);
    p0 = __builtin_amdgcn_mfma_f32_32x32x16_bf16(ka3, qf[3], p0, 0, 0, 0); p1 = __builtin_amdgcn_mfma_f32_32x32x16_bf16(kc3, qf[3], p1, 0, 0, 0);
    __builtin_amdgcn_s_setprio(0);
}
struct VFr { s16x4 lo[8], hi[8]; };
template <int DB0> __device__ __forceinline__ void v_issue(VFr& f, unsigned vaddr) {
    DSRTR(f.lo[0], vaddr, DB0 * 4096 + 0);    DSRTR(f.hi[0], vaddr, DB0 * 4096 + 512);
    DSRTR(f.lo[1], vaddr, DB0 * 4096 + 1024); DSRTR(f.hi[1], vaddr, DB0 * 4096 + 1536);
    DSRTR(f.lo[2], vaddr, DB0 * 4096 + 2048); DSRTR(f.hi[2], vaddr, DB0 * 4096 + 2560);
    DSRTR(f.lo[3], vaddr, DB0 * 4096 + 3072); DSRTR(f.hi[3], vaddr, DB0 * 4096 + 3584);
    DSRTR(f.lo[4], vaddr, DB0 * 4096 + 4096); DSRTR(f.hi[4], vaddr, DB0 * 4096 + 4608);
    DSRTR(f.lo[5], vaddr, DB0 * 4096 + 5120); DSRTR(f.hi[5], vaddr, DB0 * 4096 + 5632);
    DSRTR(f.lo[6], vaddr, DB0 * 4096 + 6144); DSRTR(f.hi[6], vaddr, DB0 * 4096 + 6656);
    DSRTR(f.lo[7], vaddr, DB0 * 4096 + 7168); DSRTR(f.hi[7], vaddr, DB0 * 4096 + 7680);
}
#define VFRAG(f, i) ((bf16x8){(f).lo[i][0], (f).lo[i][1], (f).lo[i][2], (f).lo[i][3], (f).hi[i][0], (f).hi[i][1], (f).hi[i][2], (f).hi[i][3]})
__device__ __forceinline__ void pv2(f32x16& oa, f32x16& ob, const VFr& f, const bf16x8 (&pf)[4]) {
    __builtin_amdgcn_s_setprio(1);
    oa = __builtin_amdgcn_mfma_f32_32x32x16_bf16(VFRAG(f, 0), pf[0], oa, 0, 0, 0); ob = __builtin_amdgcn_mfma_f32_32x32x16_bf16(VFRAG(f, 4), pf[0], ob, 0, 0, 0);
    oa = __builtin_amdgcn_mfma_f32_32x32x16_bf16(VFRAG(f, 1), pf[1], oa, 0, 0, 0); ob = __builtin_amdgcn_mfma_f32_32x32x16_bf16(VFRAG(f, 5), pf[1], ob, 0, 0, 0);
    oa = __builtin_amdgcn_mfma_f32_32x32x16_bf16(VFRAG(f, 2), pf[2], oa, 0, 0, 0); ob = __builtin_amdgcn_mfma_f32_32x32x16_bf16(VFRAG(f, 6), pf[2], ob, 0, 0, 0);
    oa = __builtin_amdgcn_mfma_f32_32x32x16_bf16(VFRAG(f, 3), pf[3], oa, 0, 0, 0); ob = __builtin_amdgcn_mfma_f32_32x32x16_bf16(VFRAG(f, 7), pf[3], ob, 0, 0, 0);
    __builtin_amdgcn_s_setprio(0);
}
__device__ __forceinline__ void pack_p(bf16x8 (&pf)[4], const f32x16& p0, const f32x16& p1) {
    u32x4 w;
    w.x = cvtpk(p0[0], p0[1]); w.y = cvtpk(p0[2], p0[3]); w.z = cvtpk(p0[4], p0[5]); w.w = cvtpk(p0[6], p0[7]); pf[0] = __builtin_bit_cast(bf16x8, w);
    w.x = cvtpk(p0[8], p0[9]); w.y = cvtpk(p0[10], p0[11]); w.z = cvtpk(p0[12], p0[13]); w.w = cvtpk(p0[14], p0[15]); pf[1] = __builtin_bit_cast(bf16x8, w);
    w.x = cvtpk(p1[0], p1[1]); w.y = cvtpk(p1[2], p1[3]); w.z = cvtpk(p1[4], p1[5]); w.w = cvtpk(p1[6], p1[7]); pf[2] = __builtin_bit_cast(bf16x8, w);
    w.x = cvtpk(p1[8], p1[9]); w.y = cvtpk(p1[10], p1[11]); w.z = cvtpk(p1[12], p1[13]); w.w = cvtpk(p1[14], p1[15]); pf[3] = __builtin_bit_cast(bf16x8, w);
}
template <int NDB> __device__ __forceinline__ void flash_update2(FlashSt<NDB>& st, f32x16& p0, f32x16& p1, unsigned vaddr) {
    VFr vf; v_issue<0>(vf, vaddr);
    const float rm = rowmax32(p0, p1);
    const float mn = fmaxf(st.m, rm), alpha = __builtin_amdgcn_exp2f(st.m - mn);
    st.m = mn;
    float ls = 0.f;
#pragma unroll
    for (int r = 0; r < 16; ++r) { p0[r] = __builtin_amdgcn_exp2f(p0[r] - mn); p1[r] = __builtin_amdgcn_exp2f(p1[r] - mn); ls += p0[r] + p1[r]; }
    st.l = st.l * alpha + ls;
#pragma unroll
    for (int db = 0; db < NDB; ++db)
#pragma unroll
        for (int r = 0; r < 16; ++r) st.o[db][r] *= alpha;
    bf16x8 pf[4]; pack_p(pf, p0, p1);
    LGKM_WAIT0();
    pv2(st.o[0], st.o[1], vf, pf);
    if constexpr (NDB == 4) { v_issue<2>(vf, vaddr); LGKM_WAIT0(); pv2(st.o[2], st.o[3], vf, pf); }
}
__device__ __forceinline__ float max3_(float a, float b, float c) { float r; asm("v_max3_f32 %0, %1, %2, %3" : "=v"(r) : "v"(a), "v"(b), "v"(c)); return r; }
__device__ __forceinline__ float rowmax32_asm(const f32x16& p0, const f32x16& p1) {
    float a = max3_(p0[0], p0[1], p1[0]), b = max3_(p0[2], p0[3], p1[1]); a = max3_(a, p1[2], p1[3]);
#pragma unroll
    for (int r = 4; r < 16; r += 4) { a = max3_(a, p0[r], p0[r + 1]); b = max3_(b, p0[r + 2], p0[r + 3]); a = max3_(a, p1[r], p1[r + 1]); b = max3_(b, p1[r + 2], p1[r + 3]); }
    float m; asm("v_max_f32_e32 %0, %1, %2" : "=v"(m) : "v"(a), "v"(b));
    auto rr = __builtin_amdgcn_permlane32_swap(__float_as_uint(m), __float_as_uint(m), false, false);
    float o; asm("v_max_f32_e32 %0, %1, %2" : "=v"(o) : "v"(__uint_as_float(rr[0])), "v"(__uint_as_float(rr[1]))); return o;
}
constexpr float FA_THR = 8.f;
template <int NDB> __device__ __forceinline__ bool flash_update3(FlashSt<NDB>& st, f32x16& p0, f32x16& p1, unsigned vaddr) {
    VFr vf; v_issue<0>(vf, vaddr);
    asm volatile("s_nop 15\n\ts_nop 7" : "+v"(p0), "+v"(p1));
    const float rm = rowmax32_asm(p0, p1);
    bool moved = false;
    if (__builtin_expect(__builtin_amdgcn_ballot_w64(rm > FA_THR) != 0ull, 0)) {
        const float dl = fmaxf(rm, 0.f), f = __builtin_amdgcn_exp2f(-dl);
        st.m += dl; st.l *= f;
#pragma unroll
        for (int r = 0; r < 16; ++r) { p0[r] -= dl; p1[r] -= dl; }
#pragma unroll
        for (int db = 0; db < NDB; ++db)
#pragma unroll
            for (int r = 0; r < 16; ++r) st.o[db][r] *= f;
        moved = true;
    }
    float ls = 0.f;
#pragma unroll
    for (int r = 0; r < 16; ++r) { p0[r] = __builtin_amdgcn_exp2f(p0[r]); p1[r] = __builtin_amdgcn_exp2f(p1[r]); ls += p0[r] + p1[r]; }
    st.l += ls;
    bf16x8 pf[4]; pack_p(pf, p0, p1);
    LGKM_WAIT0();
    pv2(st.o[0], st.o[1], vf, pf);
    if constexpr (NDB == 4) { v_issue<2>(vf, vaddr); LGKM_WAIT0(); pv2(st.o[2], st.o[3], vf, pf); }
    return moved;
}
__device__ __forceinline__ void pv_only2(f32x16 (&o)[2], unsigned vaddr, const f32x16& p0, const f32x16& p1) {
    VFr vf; v_issue<0>(vf, vaddr); bf16x8 pf[4]; pack_p(pf, p0, p1); LGKM_WAIT0(); pv2(o[0], o[1], vf, pf);
}

__device__ __forceinline__ void fox_unit(unsigned char* lds, unsigned char* ws, int bh, int qb, int dry = 0) {
    int tid_o = threadIdx.x; asm volatile("" : "+v"(tid_o));
    const int tid = tid_o, lane = tid & 63, wid = __builtin_amdgcn_readfirstlane(tid >> 6), r32 = lane & 31, hi = lane >> 5;
    const unsigned lds0 = (unsigned)(uintptr_t)lds;
    const lds_cptr L = (lds_cptr)lds;
    const int qrow = 256 * qb + 32 * wid + r32, wrow0 = 256 * qb + 32 * wid;
    const int NTl = 4 * (qb + 1);
    const char* Kg = (const char*)(ws + OFF_KA) + (size_t)bh * 524288 + wid * 1024 + lane * 16;
    const char* Vg = (const char*)(ws + OFF_VA) + (size_t)bh * 524288 + wid * 1024 + lane * 16;
    const char* Cg = (const char*)(ws + OFF_CF) + (size_t)bh * 16384 + lane * 4;
    const unsigned kdst = (unsigned)__builtin_amdgcn_readfirstlane(lds0 + A_KRING + wid * 1024), vdst = (unsigned)__builtin_amdgcn_readfirstlane(lds0 + A_VRING + wid * 1024),
                   cdst = (unsigned)__builtin_amdgcn_readfirstlane(lds0 + A_CFRING + wid * 256);
#define FOX_DMA(t, slot) do { glds16(Kg + (size_t)(t) * 8192, kdst + (slot) * A_SLOT); glds16(Vg + (size_t)(t) * 8192, vdst + (slot) * A_SLOT); glds4(Cg + (size_t)(t) * 256, cdst + (slot) * 2048); } while (0)
    asm volatile("s_waitcnt vmcnt(0)" ::: "memory");
    FOX_DMA(0, 0); FOX_DMA(1, 1);
    bf16x8 qf[4];
    { const bf16* Q = (const bf16*)(ws + OFF_QA) + ((size_t)bh * 4096 + qrow) * 64 + 8 * hi;
#pragma unroll
      for (int d0 = 0; d0 < 4; ++d0) qf[d0] = *(const bf16x8*)(Q + 16 * d0); }
    FlashSt<2> st; flash_init3<2>(st);
    const int vb = lane_vbase(lane);
    const unsigned kaddr0 = lds0 + A_KRING + hi * 1024 + r32 * 16, vaddr0 = lds0 + A_VRING + vb;
    asm volatile("" : "+v"(qf[0]), "+v"(qf[1]), "+v"(qf[2]), "+v"(qf[3]));
    asm volatile("s_waitcnt vmcnt(0)" ::: "memory");
    asm volatile("s_barrier" ::: "memory");
    int slot = 0;
    for (int t = 0; t < NTl; ++t) {
        const int s2 = (slot >= 1) ? slot - 1 : 2;
        if (t + 2 < NTl) FOX_DMA(t + 2, s2);
        if (64 * t <= wrow0 + 31 && dry != 4) {
            f32x16 p0, p1;
            { const unsigned ca = lds0 + A_CFRING + slot * 2048 + wid * 256 + 16 * hi; f32x4 c0, c1, c2, c3, c4, c5, c6, c7;
              DSR128(c0, ca, 0); DSR128(c1, ca, 32); DSR128(c2, ca, 64); DSR128(c3, ca, 96); DSR128(c4, ca, 128); DSR128(c5, ca, 160); DSR128(c6, ca, 192); DSR128(c7, ca, 224);
              LGKM_WAIT0();
              p0 = __builtin_shufflevector(__builtin_shufflevector(c0, c1, 0, 1, 2, 3, 4, 5, 6, 7), __builtin_shufflevector(c2, c3, 0, 1, 2, 3, 4, 5, 6, 7), 0, 1, 2, 3, 4, 5, 6, 7, 8, 9, 10, 11, 12, 13, 14, 15);
              p1 = __builtin_shufflevector(__builtin_shufflevector(c4, c5, 0, 1, 2, 3, 4, 5, 6, 7), __builtin_shufflevector(c6, c7, 0, 1, 2, 3, 4, 5, 6, 7), 0, 1, 2, 3, 4, 5, 6, 7, 8, 9, 10, 11, 12, 13, 14, 15);
              p0 = p0 - st.m; p1 = p1 - st.m; }
            qk_tile2(p0, p1, kaddr0 + slot * A_SLOT, qf);
            if (64 * t + 63 > wrow0) {
                const int kb = 64 * t + 4 * hi;
#pragma unroll
                for (int r = 0; r < 16; ++r) { const int kv = kb + (r & 3) + 8 * (r >> 2); if (kv > qrow) p0[r] = -INFINITY; if (kv + 32 > qrow) p1[r] = -INFINITY; }
            }
            if (dry != 3) (void)flash_update3<2>(st, p0, p1, vaddr0 + slot * A_SLOT); else { st.o[0] += p0; st.o[1] += p1; }
        }
        if (dry == 2) { asm volatile("s_waitcnt lgkmcnt(0)\n\ts_barrier" ::: "memory"); } else if (t + 2 < NTl) { A_WAIT_BAR(3); } else { A_WAIT_BAR(0); }
        slot = (slot == 2) ? 0 : slot + 1;
    }
#undef FOX_DMA
    const float lt = st.l + __shfl_xor(st.l, 32), il = 1.f / lt;
    const int b = bh >> 3, h = bh & 7;
    bf16* Y = (bf16*)(ws + OFF_ZA) + (size_t)(b * 4096 + qrow) * 512 + h * 64;
    bf16* Yd = dry ? (bf16*)(ws + OFF_SELM) + (tid * 64) : Y;
#pragma unroll
    for (int db = 0; db < 2; ++db)
#pragma unroll
        for (int rq = 0; rq < 4; ++rq) { bf16* yp = Y + 32 * db + 8 * rq + 4 * hi; bf16* yo = Yd + 32 * db + 8 * rq + 4 * hi; const u32x2 z = *(const u32x2*)yp;
            const float z0 = __uint_as_float(z.x << 16), z1 = __uint_as_float(z.x & 0xffff0000u), z2 = __uint_as_float(z.y << 16), z3 = __uint_as_float(z.y & 0xffff0000u);
            u32x2 o; o.x = pk2(st.o[db][4 * rq] * il * z0, st.o[db][4 * rq + 1] * il * z1); o.y = pk2(st.o[db][4 * rq + 2] * il * z2, st.o[db][4 * rq + 3] * il * z3);
            *(u32x2*)yo = o; }
}

__device__ __forceinline__ void diff_unit(unsigned char* lds, unsigned char* ws, int bhc, int qb, const float* subg, float lam, float lam_init, bool dry = false) {
    int tid_o = threadIdx.x; asm volatile("" : "+v"(tid_o));
    const int tid = tid_o, lane = tid & 63, wid = __builtin_amdgcn_readfirstlane(tid >> 6), r32 = lane & 31, hi = lane >> 5;
    const int map = wid >> 2, wl = wid & 3;
    const unsigned lds0 = (unsigned)(uintptr_t)lds;
    const lds_cptr L = (lds_cptr)lds;
    const int b = bhc >> 2, hc = bhc & 3;
    const int qrow = 128 * qb + 32 * wl + r32, wrow0 = 128 * qb + 32 * wl;
    const int NTl = 2 * (qb + 1);
    const char* Kg = (const char*)(ws + OFF_KC) + (size_t)(b * 8 + hc * 2) * 524288 + wid * 1024 + lane * 16;
    const char* Vg = (const char*)(ws + OFF_VC) + (size_t)bhc * 1048576 + wid * 1024 + lane * 16;
    const unsigned kdst = (unsigned)__builtin_amdgcn_readfirstlane(lds0 + A_KRING + wid * 1024), vdst = (unsigned)__builtin_amdgcn_readfirstlane(lds0 + A_VRING + wid * 1024);
#define DIFF_DMA(t, slot) do { glds16(Kg + (size_t)(t) * 8192, kdst + (slot) * A_SLOT); glds16(Kg + 524288 + (size_t)(t) * 8192, kdst + (slot) * A_SLOT + 8192); \
        glds16(Vg + (size_t)(t) * 16384, vdst + (slot) * A_SLOT); glds16(Vg + (size_t)(t) * 16384 + 8192, vdst + (slot) * A_SLOT + 8192); } while (0)
    asm volatile("s_waitcnt vmcnt(0)" ::: "memory");
    DIFF_DMA(0, 0); DIFF_DMA(1, 1);
    bf16x8 qf[4];
    { const bf16* Q = (const bf16*)(ws + OFF_QC) + ((size_t)(b * 8 + hc * 2 + map) * 4096 + qrow) * 64 + 8 * hi;
#pragma unroll
      for (int d0 = 0; d0 < 4; ++d0) qf[d0] = *(const bf16x8*)(Q + 16 * d0); }
    FlashSt<4> st; flash_init3<4>(st);
    f32x16 negm;
#pragma unroll
    for (int r = 0; r < 16; ++r) negm[r] = 0.f;
    const int vb = lane_vbase(lane);
    const unsigned kaddr0 = lds0 + A_KRING + map * 8192 + hi * 1024 + r32 * 16, vaddr0 = lds0 + A_VRING + vb;
    asm volatile("" : "+v"(qf[0]), "+v"(qf[1]), "+v"(qf[2]), "+v"(qf[3]));
    asm volatile("s_waitcnt vmcnt(0)" ::: "memory");
    asm volatile("s_barrier" ::: "memory");
    int slot = 0;
    for (int t = 0; t < NTl; ++t) {
        const int s2 = (slot >= 1) ? slot - 1 : 2;
        if (t + 2 < NTl) DIFF_DMA(t + 2, s2);
        if (64 * t <= wrow0 + 31) {
            f32x16 p0 = negm, p1 = negm;
            qk_tile2(p0, p1, kaddr0 + slot * A_SLOT, qf);
            if (64 * t + 63 > wrow0) {
                const int kb = 64 * t + 4 * hi;
#pragma unroll
                for (int r = 0; r < 16; ++r) { const int kv = kb + (r & 3) + 8 * (r >> 2); if (kv > qrow) p0[r] = -INFINITY; if (kv + 32 > qrow) p1[r] = -INFINITY; }
            }
            if (flash_update3<4>(st, p0, p1, vaddr0 + slot * A_SLOT)) {
#pragma unroll
                for (int r = 0; r < 16; ++r) negm[r] = -st.m; }
        }
        if (t + 2 < NTl) { A_WAIT_BAR(4); } else { A_WAIT_BAR(0); }
        slot = (slot == 2) ? 0 : slot + 1;
    }
#undef DIFF_DMA
    const float lt = st.l + __shfl_xor(st.l, 32), il = 1.f / lt;
    LAS float* stage = (LAS float*)lds + wl * 4096 + r32;
    if (map == 1) {
#pragma unroll
        for (int db = 0; db < 4; ++db)
#pragma unroll
            for (int r = 0; r < 16; ++r) stage[(32 * db + crow(r, hi)) * 32] = st.o[db][r] * il;
    }
    asm volatile("s_waitcnt lgkmcnt(0)\n\ts_barrier" ::: "memory");
    if (map == 0) {
        float ss = 0.f;
#pragma unroll
        for (int db = 0; db < 4; ++db)
#pragma unroll
            for (int r = 0; r < 16; ++r) { const float v = st.o[db][r] * il - lam * stage[(32 * db + crow(r, hi)) * 32]; st.o[db][r] = v; ss += v * v; }
        ss += __shfl_xor(ss, 32);
        const float rs = rsqrtf(ss * (1.f / 128.f) + EPS) * (1.f - lam_init);
        bf16* Y = (bf16*)(ws + OFF_ZC) + (size_t)(b * 4096 + qrow) * 512 + hc * 128;
        bf16* Yd = dry ? (bf16*)(ws + OFF_SELM) + (tid * 128) : Y;
#pragma unroll
        for (int db = 0; db < 4; ++db)
#pragma unroll
            for (int rq = 0; rq < 4; ++rq) { const int d = 32 * db + 8 * rq + 4 * hi; bf16* yp = Y + d; bf16* yo = Yd + d; const u32x2 z = *(const u32x2*)yp; const f32x4 g = *(const f32x4*)(subg + d);
                const float z0 = __uint_as_float(z.x << 16), z1 = __uint_as_float(z.x & 0xffff0000u), z2 = __uint_as_float(z.y << 16), z3 = __uint_as_float(z.y & 0xffff0000u);
                u32x2 o; o.x = pk2(st.o[db][4 * rq] * rs * g[0] * z0, st.o[db][4 * rq + 1] * rs * g[1] * z1); o.y = pk2(st.o[db][4 * rq + 2] * rs * g[2] * z2, st.o[db][4 * rq + 3] * rs * g[3] * z3);
                *(u32x2*)yo = o; }
    }
    asm volatile("s_waitcnt lgkmcnt(0)\n\ts_barrier" ::: "memory");
}

constexpr int N_IMP = A_MISC, N_SELM = N_IMP + 64 * 65 * 4, N_UMASK = N_SELM + 512, N_SEQC = N_UMASK + 16, N_SEQD = N_SEQC + 80, N_CNT = N_SEQD + 16;
template <int MODE> __device__ __forceinline__ void nsa_ring(FlashSt<2>& st, unsigned char* lds, const char* Kg, const char* Vg, unsigned kdst, unsigned vdst, int n, int seqoff,
                                                             const bf16x8 (&qf)[4], int tb, int qloc, unsigned selLo, unsigned selHi, int r32, int hi, int vb) {
    const lds_cptr L = (lds_cptr)lds;
    const LAS unsigned char* seq = (const LAS unsigned char*)(L + seqoff);
    const unsigned lds0r = (unsigned)(uintptr_t)lds;
#define NSA_DMA(j, slot) do { glds16(Kg + (size_t)(j) * 8192, kdst + (slot) * A_SLOT); glds16(Vg + (size_t)(j) * 8192, vdst + (slot) * A_SLOT); } while (0)
    asm volatile("s_waitcnt vmcnt(0)" ::: "memory");
    { const int j0 = __builtin_amdgcn_readfirstlane((int)seq[0]); NSA_DMA(j0, 0); if (n > 1) { const int j1 = __builtin_amdgcn_readfirstlane((int)seq[1]); NSA_DMA(j1, 1); } }
    A_WAIT_BAR(0);
    int slot = 0;
    f32x16 negm;
#pragma unroll
    for (int r = 0; r < 16; ++r) negm[r] = 0.f;
    for (int i = 0; i < n; ++i) {
        const int s2 = (slot >= 1) ? slot - 1 : 2;
        if (i + 2 < n) { const int j2 = __builtin_amdgcn_readfirstlane((int)seq[i + 2]); NSA_DMA(j2, s2); }
        const int j = __builtin_amdgcn_readfirstlane((int)seq[i]);
        f32x16 p0 = negm, p1 = negm;
        qk_tile2(p0, p1, lds0r + A_KRING + hi * 1024 + r32 * 16 + slot * A_SLOT, qf);
        if (j == tb) {
#pragma unroll
            for (int r = 0; r < 16; ++r) { const int kv = 4 * hi + (r & 3) + 8 * (r >> 2); if (kv > qloc) p0[r] = -INFINITY; if (kv + 32 > qloc) p1[r] = -INFINITY; }
        } else if (MODE == 0) {
            const bool sel = (((j < 32) ? (selLo >> j) : (selHi >> (j - 32))) & 1u) != 0u;
            if (!sel) {
#pragma unroll
                for (int r = 0; r < 16; ++r) { p0[r] = -INFINITY; p1[r] = -INFINITY; } }
        } else if (j == tb - 8) {
#pragma unroll
            for (int r = 0; r < 16; ++r) { const int kv = 4 * hi + (r & 3) + 8 * (r >> 2); if (kv <= qloc) p0[r] = -INFINITY; if (kv + 32 <= qloc) p1[r] = -INFINITY; }
        }
        if (flash_update3<2>(st, p0, p1, lds0r + A_VRING + vb + slot * A_SLOT)) {
#pragma unroll
            for (int r = 0; r < 16; ++r) negm[r] = -st.m; }
        if (i + 2 < n) { A_WAIT_BAR(2); } else { A_WAIT_BAR(0); }
        slot = (slot == 2) ? 0 : slot + 1;
    }
#undef NSA_DMA
}
__device__ __forceinline__ void nsa_unit(unsigned char* lds, unsigned char* ws, int bg, int tb, bool dry = false) {
    int tid_o = threadIdx.x; asm volatile("" : "+v"(tid_o));
    const int tid = tid_o, lane = tid & 63, wid = __builtin_amdgcn_readfirstlane(tid >> 6), r32 = lane & 31, hi = lane >> 5;
    const unsigned lds0 = (unsigned)(uintptr_t)lds;
    const lds_cptr L = (lds_cptr)lds;
    const int b = bg >> 1, g = bg & 1, h = 4 * g + (wid >> 1), qloc = 32 * (wid & 1) + r32, t = 64 * tb + qloc, row = b * 4096 + t;
    const unsigned kdst = (unsigned)__builtin_amdgcn_readfirstlane(lds0 + A_KRING + wid * 1024), vdst = (unsigned)__builtin_amdgcn_readfirstlane(lds0 + A_VRING + wid * 1024);
    const int vb = lane_vbase(lane);
    LAS float* imp = (LAS float*)(L + N_IMP);
    LAS unsigned* selm = (LAS unsigned*)(L + N_SELM);
    LAS unsigned* umask = (LAS unsigned*)(L + N_UMASK);
    const int nvmax = 4 * tb + 3, nct = (nvmax + 63) >> 6;
    for (int i = tid; i < 64 * 65; i += 512) imp[i] = 0.f;
    if (tid < 128) selm[tid] = 0u;
    if (tid < 2) umask[tid] = 0u;
    asm volatile("s_waitcnt vmcnt(0)" ::: "memory");
    { const char* Kc = (const char*)(ws + OFF_KCMP) + (size_t)bg * 32768 + wid * 1024 + lane * 16; const char* Vc = (const char*)(ws + OFF_VCMP) + (size_t)bg * 32768 + wid * 1024 + lane * 16;
      for (int ct = 0; ct < nct; ++ct) { glds16(Kc + ct * 8192, kdst + ct * 8192); glds16(Vc + ct * 8192, vdst + ct * 8192); } }
    bf16x8 qf[4];
    const bf16* Qp = (const bf16*)(ws + OFF_QB) + ((size_t)(b * 8 + h) * 4096 + t) * 64 + 8 * hi;
#pragma unroll
    for (int d0 = 0; d0 < 4; ++d0) qf[d0] = *(const bf16x8*)(Qp + 16 * d0);
    const float* gt = (const float*)(ws + OFF_GATES) + (size_t)row * 24 + (h & 7) * 3;
    float g0 = gt[0], g1 = gt[1], g2 = gt[2];
    asm volatile("" : "+v"(qf[0]), "+v"(qf[1]), "+v"(qf[2]), "+v"(qf[3]), "+v"(g0), "+v"(g1), "+v"(g2));
    A_WAIT_BAR(0);
    const int nv = (t >= 31) ? ((t - 31) >> 4) + 1 : 0;
    f32x16 y[2];
    {
        float m = -1e30f, l = 0.f;
        for (int ct = 0; ct < nct; ++ct) {
            f32x16 p0, p1;
#pragma unroll
            for (int r = 0; r < 16; ++r) { p0[r] = 0.f; p1[r] = 0.f; }
            qk_tile2(p0, p1, lds0 + A_KRING + hi * 1024 + r32 * 16 + ct * 8192, qf);
            const int cb = 64 * ct + 4 * hi;
#pragma unroll
            for (int r = 0; r < 16; ++r) { const int c = cb + (r & 3) + 8 * (r >> 2); if (c >= nv) p0[r] = -INFINITY; if (c + 32 >= nv) p1[r] = -INFINITY; }
            const float rm = rowmax32(p0, p1), mn = fmaxf(m, rm);
            float ls = 0.f;
#pragma unroll
            for (int r = 0; r < 16; ++r) ls += __builtin_amdgcn_exp2f(p0[r] - mn) + __builtin_amdgcn_exp2f(p1[r] - mn);
            l = l * __builtin_amdgcn_exp2f(m - mn) + ls; m = mn;
        }
        const float lt = l + __shfl_xor(l, 32), il = lt > 0.f ? 1.f / lt : 0.f;
        f32x16 oc[2];
#pragma unroll
        for (int r = 0; r < 16; ++r) { oc[0][r] = 0.f; oc[1][r] = 0.f; }
        for (int ct = 0; ct < nct; ++ct) {
            f32x16 p0, p1;
#pragma unroll
            for (int r = 0; r < 16; ++r) { p0[r] = 0.f; p1[r] = 0.f; }
            qk_tile2(p0, p1, lds0 + A_KRING + hi * 1024 + r32 * 16 + ct * 8192, qf);
            const int cb = 64 * ct + 4 * hi;
#pragma unroll
            for (int r = 0; r < 16; ++r) { const int c = cb + (r & 3) + 8 * (r >> 2);
                p0[r] = (c >= nv) ? 0.f : __builtin_amdgcn_exp2f(p0[r] - m) * il; p1[r] = (c + 32 >= nv) ? 0.f : __builtin_amdgcn_exp2f(p1[r] - m) * il; }
            LAS float* ir = imp + qloc * 65 + 16 * ct + hi;
#pragma unroll
            for (int rq = 0; rq < 4; ++rq) {
                const float q0 = (p0[4 * rq] + p0[4 * rq + 1]) + (p0[4 * rq + 2] + p0[4 * rq + 3]), q1 = (p1[4 * rq] + p1[4 * rq + 1]) + (p1[4 * rq + 2] + p1[4 * rq + 3]);
                __hip_atomic_fetch_add(ir + 2 * rq, q0, __ATOMIC_RELAXED, __HIP_MEMORY_SCOPE_WORKGROUP);
                __hip_atomic_fetch_add(ir + 2 * rq + 1, p0[4 * rq + 3], __ATOMIC_RELAXED, __HIP_MEMORY_SCOPE_WORKGROUP);
                __hip_atomic_fetch_add(ir + 8 + 2 * rq, q1, __ATOMIC_RELAXED, __HIP_MEMORY_SCOPE_WORKGROUP);
                if (16 * ct + 8 + 2 * rq + hi + 1 < 64) __hip_atomic_fetch_add(ir + 8 + 2 * rq + 1, p1[4 * rq + 3], __ATOMIC_RELAXED, __HIP_MEMORY_SCOPE_WORKGROUP);
            }
            pv_only2(oc, lds0 + A_VRING + vb + ct * 8192, p0, p1);
        }
#pragma unroll
        for (int r = 0; r < 16; ++r) { y[0][r] = g0 * oc[0][r]; y[1][r] = g0 * oc[1][r]; }
    }
    asm volatile("s_waitcnt lgkmcnt(0)\n\ts_barrier" ::: "memory");
    {
        const int q = tid >> 3, part = tid & 7;
        float sc[8];
#pragma unroll
        for (int i = 0; i < 8; ++i) { const int j = 8 * part + i; const bool forced = (j == 0) || (j == tb) || (j == tb - 1);
            sc[i] = forced ? 1e30f : (j <= tb ? imp[q * 65 + j] : -1e30f); }
#pragma unroll
        for (int i = 0; i < 8; ++i) imp[q * 65 + 8 * part + i] = sc[i];
        asm volatile("s_waitcnt lgkmcnt(0)\n\ts_barrier" ::: "memory");
        int rank[8];
#pragma unroll
        for (int i = 0; i < 8; ++i) rank[i] = 0;
        for (int k = 0; k < 64; ++k) { const float sk = imp[q * 65 + k];
#pragma unroll
            for (int i = 0; i < 8; ++i) rank[i] += (sk > sc[i] || (sk == sc[i] && k < 8 * part + i)) ? 1 : 0; }
        unsigned bits = 0u;
#pragma unroll
        for (int i = 0; i < 8; ++i) bits |= (rank[i] < 16) ? (1u << i) : 0u;
        bits <<= 8 * (part & 3);
        __hip_atomic_fetch_or(selm + q * 2 + (part >> 2), bits, __ATOMIC_RELAXED, __HIP_MEMORY_SCOPE_WORKGROUP);
        __hip_atomic_fetch_or(umask + (part >> 2), bits, __ATOMIC_RELAXED, __HIP_MEMORY_SCOPE_WORKGROUP);
        asm volatile("s_waitcnt lgkmcnt(0)\n\ts_barrier" ::: "memory");
        if (tid == 0) {
            LAS unsigned char* sq = (LAS unsigned char*)(L + N_SEQC); LAS unsigned char* sd = (LAS unsigned char*)(L + N_SEQD); LAS int* cnt = (LAS int*)(L + N_CNT);
            const unsigned long long um = ((unsigned long long)umask[1] << 32) | umask[0];
            int n = 0; sq[n++] = (unsigned char)tb;
            for (int j = 0; j < tb; ++j) if ((um >> j) & 1ull) sq[n++] = (unsigned char)j;
            cnt[0] = n;
            int n2 = 0; sd[n2++] = (unsigned char)tb;
            for (int j = (tb >= 8 ? tb - 8 : 0); j < tb; ++j) sd[n2++] = (unsigned char)j;
            cnt[1] = n2;
        }
        asm volatile("s_waitcnt lgkmcnt(0)\n\ts_barrier" ::: "memory");
    }
    const unsigned selLo = selm[qloc * 2], selHi = selm[qloc * 2 + 1];
    const int nC = __builtin_amdgcn_readfirstlane(((const LAS int*)(L + N_CNT))[0]), nD = __builtin_amdgcn_readfirstlane(((const LAS int*)(L + N_CNT))[1]);
    { const float* cs = (const float*)(ws + OFF_COS) + (size_t)row * 32 + 4 * hi; const float* sn = (const float*)(ws + OFF_SIN) + (size_t)row * 32 + 4 * hi;
#pragma unroll
      for (int d0 = 0; d0 < 4; ++d0) { const f32x4 c = *(const f32x4*)(cs + 8 * d0), s = *(const f32x4*)(sn + 8 * d0); u32x4 w = __builtin_bit_cast(u32x4, qf[d0]); u32x4 o;
#pragma unroll
          for (int e = 0; e < 4; ++e) { const float x1 = __uint_as_float(w[e] << 16), x2 = __uint_as_float(w[e] & 0xffff0000u); o[e] = pk2(x1 * c[e] - x2 * s[e], x2 * c[e] + x1 * s[e]); }
          qf[d0] = __builtin_bit_cast(bf16x8, o); } }
    asm volatile("" : "+v"(qf[0]), "+v"(qf[1]), "+v"(qf[2]), "+v"(qf[3]));
    {
        FlashSt<2> st; flash_init3<2>(st);
        const char* Kg = (const char*)(ws + OFF_KSEL) + (size_t)bg * 524288 + wid * 1024 + lane * 16; const char* Vg = (const char*)(ws + OFF_VSEL) + (size_t)bg * 524288 + wid * 1024 + lane * 16;
        nsa_ring<0>(st, lds, Kg, Vg, kdst, vdst, nC, N_SEQC, qf, tb, qloc, selLo, selHi, r32, hi, vb);
        const float lt = st.l + __shfl_xor(st.l, 32), sc = g1 / lt;
#pragma unroll
        for (int r = 0; r < 16; ++r) { y[0][r] += sc * st.o[0][r]; y[1][r] += sc * st.o[1][r]; }
    }
    {
        FlashSt<2> st; flash_init3<2>(st);
        const char* Kg = (const char*)(ws + OFF_KWIN) + (size_t)bg * 524288 + wid * 1024 + lane * 16; const char* Vg = (const char*)(ws + OFF_VWIN) + (size_t)bg * 524288 + wid * 1024 + lane * 16;
        nsa_ring<1>(st, lds, Kg, Vg, kdst, vdst, nD, N_SEQD, qf, tb, qloc, selLo, selHi, r32, hi, vb);
        const float lt = st.l + __shfl_xor(st.l, 32), sc = g2 / lt;
#pragma unroll
        for (int r = 0; r < 16; ++r) { y[0][r] += sc * st.o[0][r]; y[1][r] += sc * st.o[1][r]; }
    }
    bf16* Y = (bf16*)(ws + OFF_ZB) + (size_t)row * 512 + h * 64;
    bf16* Yd = dry ? (bf16*)(ws + OFF_SELM) + (tid * 64) : Y;
#pragma unroll
    for (int db = 0; db < 2; ++db)
#pragma unroll
        for (int rq = 0; rq < 4; ++rq) { bf16* yp = Y + 32 * db + 8 * rq + 4 * hi; bf16* yo = Yd + 32 * db + 8 * rq + 4 * hi; const u32x2 z = *(const u32x2*)yp;
            const float z0 = __uint_as_float(z.x << 16), z1 = __uint_as_float(z.x & 0xffff0000u), z2 = __uint_as_float(z.y << 16), z3 = __uint_as_float(z.y & 0xffff0000u);
            u32x2 o; o.x = pk2(y[db][4 * rq] * z0, y[db][4 * rq + 1] * z1); o.y = pk2(y[db][4 * rq + 2] * z2, y[db][4 * rq + 3] * z3);
            *(u32x2*)yo = o; }
}

__device__ __forceinline__ void compress_unit(unsigned char* lds, unsigned char* ws, int kv, int bg, int rc) {
    int tid_o = threadIdx.x; asm volatile("" : "+v"(tid_o));
    const int tid = tid_o, lane = tid & 63, wid = __builtin_amdgcn_readfirstlane(tid >> 6), r32 = lane & 31, hi = lane >> 5;
    const unsigned lds0 = (unsigned)(uintptr_t)lds;
    { const char* Ab = (const char*)(ws + (kv ? OFF_VCB : OFF_KCB)) + ((size_t)bg * 4096 + 512 * rc) * 128;
      asm volatile("s_waitcnt vmcnt(0)" ::: "memory");
#pragma unroll
      for (int i = 0; i < 9; ++i) { const int q = (i * 8 + wid) * 64 + lane, blk = q / 129, qq = q - blk * 129; const int sg = blk * 128 + (qq < 128 ? qq : 127);
          glds16(Ab + (size_t)sg * 16, (unsigned)__builtin_amdgcn_readfirstlane(lds0 + (i * 8 + wid) * 1024)); }
      asm volatile("s_waitcnt vmcnt(0)\n\ts_barrier" ::: "memory"); }
    const bf16* Bp = (const bf16*)(ws + OFF_CW1) + (size_t)kv * 256 * 2048 + ((size_t)wid * 128 * 64 + lane) * 8;
    const lds_cptr Al = (lds_cptr)lds + 2064 * r32 + 16 * hi;
    f32x16 acc;
#pragma unroll
    for (int r = 0; r < 16; ++r) acc[r] = 0.f;
#pragma unroll 8
    for (int l = 0; l < 32; ++l) {
        const lds_cptr ap = Al + l * 128 + (l >> 4) * 16;
#pragma unroll
        for (int q = 0; q < 4; ++q) {
            const bf16x8 a = *(const LAS bf16x8*)(ap + q * 32), w = *(const bf16x8*)(Bp + (size_t)(4 * l + q) * 512);
            acc = __builtin_amdgcn_mfma_f32_32x32x16_bf16(w, a, acc, 0, 0, 0);
        }
    }
    const float* cb = (const float*)(ws + OFF_CB1) + kv * 256 + 32 * wid + 4 * hi;
    bf16x8 hf[2];
    { float hv[16];
#pragma unroll
      for (int rq = 0; rq < 4; ++rq) { const f32x4 bb = *(const f32x4*)(cb + 8 * rq);
#pragma unroll
          for (int e = 0; e < 4; ++e) hv[4 * rq + e] = siluf_(acc[4 * rq + e] + bb[e]); }
      u32x4 w0, w1;
      w0.x = pk2(hv[0], hv[1]); w0.y = pk2(hv[2], hv[3]); w0.z = pk2(hv[4], hv[5]); w0.w = pk2(hv[6], hv[7]);
      w1.x = pk2(hv[8], hv[9]); w1.y = pk2(hv[10], hv[11]); w1.z = pk2(hv[12], hv[13]); w1.w = pk2(hv[14], hv[15]);
      hf[0] = __builtin_bit_cast(bf16x8, w0); hf[1] = __builtin_bit_cast(bf16x8, w1); }
    const bf16* W2 = (const bf16*)(ws + OFF_CW2) + (size_t)kv * 64 * 256 + 32 * wid + 4 * hi;
    f32x16 po[2];
#pragma unroll
    for (int dbk = 0; dbk < 2; ++dbk) {
#pragma unroll
        for (int r = 0; r < 16; ++r) po[dbk][r] = 0.f;
#pragma unroll
        for (int s = 0; s < 2; ++s) {
            const bf16* wr = W2 + (size_t)(32 * dbk + r32) * 256 + 16 * s;
            const u32x2 lo = *(const u32x2*)wr, hh = *(const u32x2*)(wr + 8);
            u32x4 wv; wv.x = lo.x; wv.y = lo.y; wv.z = hh.x; wv.w = hh.y;
            po[dbk] = __builtin_amdgcn_mfma_f32_32x32x16_bf16(__builtin_bit_cast(bf16x8, wv), hf[s], po[dbk], 0, 0, 0);
        }
    }
    LAS float* part = (LAS float*)lds;
    __syncthreads();
#pragma unroll
    for (int dbk = 0; dbk < 2; ++dbk)
#pragma unroll
        for (int r = 0; r < 16; ++r) part[(wid * 64 + 32 * dbk + crow(r, hi)) * 32 + r32] = po[dbk][r];
    __syncthreads();
    {
        const int row = tid & 31, d4 = tid >> 5, cc = 32 * rc + row;
        float o[4];
#pragma unroll
        for (int e = 0; e < 4; ++e) { float sum = 0.f;
#pragma unroll
            for (int w = 0; w < 8; ++w) sum += part[(w * 64 + 4 * d4 + e) * 32 + row];
            o[e] = (cc < 255) ? sum : 0.f; }
        bf16* dst = (bf16*)(ws + (kv ? OFF_VCMP : OFF_KCMP)) + (size_t)bg * 16384 + (kv ? vtile_off(cc, 4 * d4) : ktile_off(cc, 4 * d4));
        store_bf<4>(dst, o);
    }
    __syncthreads();
}
__device__ __forceinline__ void cumsum_unit(unsigned char* lds, unsigned char* ws, int bh) {
    int tid_o = threadIdx.x; asm volatile("" : "+v"(tid_o));
    const int tid = tid_o, lane = tid & 63, wid = tid >> 6, b = bh >> 3, h = bh & 7;
    const float* lf = (const float*)(ws + OFF_LOGF) + ((size_t)(b * 4096 + 8 * tid)) * 8 + h;
    float v[8]; float s = 0.f;
#pragma unroll
    for (int i = 0; i < 8; ++i) { s += lf[i * 8]; v[i] = s; }
    float incl = s;
#pragma unroll
    for (int of = 1; of < 64; of <<= 1) { const float t = __shfl_up(incl, of); if (lane >= of) incl += t; }
    LAS float* wsum = (LAS float*)lds;
    __syncthreads();
    if (lane == 63) wsum[wid] = incl;
    __syncthreads();
    float base = incl - s;
    for (int w = 0; w < wid; ++w) base += wsum[w];
    float* cf = (float*)(ws + OFF_CF) + (size_t)bh * 4096 + 8 * tid;
    f32x4 o0 = {-(base + v[0]), -(base + v[1]), -(base + v[2]), -(base + v[3])}, o1 = {-(base + v[4]), -(base + v[5]), -(base + v[6]), -(base + v[7])};
    *(f32x4*)cf = o0; *(f32x4*)(cf + 4) = o1;
    __syncthreads();
}

constexpr size_t OFF_BAR = OFF_CTL + 131072;
constexpr int LDS_BARST = 131072 + 64;
#define XB_TMO      128
#define XB_XCNT(j)  (256  + 64 * (j))
#define XB_XSUB(j)  (1280 + 64 * (j))
#define XB_XGEN(j)  (2304 + 64 * (j))
#define XB_TOP      3328
#define XB_TOPGEN   3392
#define XCD_BAR_WORDS 3456
#define XB_SPIN_CAP (1u << 18)

__device__ __forceinline__ unsigned xb_ld(unsigned* p)              { return __hip_atomic_load(p, __ATOMIC_RELAXED, __HIP_MEMORY_SCOPE_AGENT); }
__device__ __forceinline__ unsigned xb_add(unsigned* p, unsigned v) { return __hip_atomic_fetch_add(p, v, __ATOMIC_RELAXED, __HIP_MEMORY_SCOPE_AGENT); }
__device__ __forceinline__ unsigned xb_xcc_id() { return (unsigned)__builtin_amdgcn_s_getreg((3 << 11) | 20) & 0xFu; }
#define XB_SPIN(cond, bar) do { unsigned _sp = 0; while (cond) { __builtin_amdgcn_s_sleep(1); \
    if ((++_sp & 255u) == 0u) { if (xb_ld(&(bar)[XB_TMO])) break; if (_sp > XB_SPIN_CAP) { atomicAdd(&(bar)[XB_TMO], 1u); break; } } } } while (0)

struct XcdBarrier {
    unsigned* bar; unsigned x;
    volatile LAS unsigned* st;
};

__device__ __forceinline__ XcdBarrier xcd_barrier_post(unsigned* bar, volatile LAS unsigned* st) {
    XcdBarrier b; b.bar = bar; b.x = xb_xcc_id(); b.st = st;
    if (threadIdx.x == 0) (void)xb_add(&bar[XB_XCNT(b.x)], 1u);
    return b;
}
__device__ __forceinline__ void xcd_barrier_complete(unsigned* bar, unsigned x, unsigned& nloc, unsigned& nx) {
    const unsigned G = gridDim.x * gridDim.y * gridDim.z;
    unsigned sum, cnt, mine, sp = 0u;
    for (;;) {
        sum = 0u; cnt = 0u; mine = 0u;
#pragma unroll
        for (unsigned j = 0; j < 16; ++j) { const unsigned c = xb_ld(&bar[XB_XCNT(j)]); sum += c; cnt += (c > 0u) ? 1u : 0u; mine = (j == x) ? c : mine; }
        if (sum == G) break;
        __builtin_amdgcn_s_sleep(1);
        if ((++sp & 255u) == 0u) { if (xb_ld(&bar[XB_TMO])) break; if (sp > XB_SPIN_CAP) { atomicAdd(&bar[XB_TMO], 1u); break; } }
    }
    nloc = mine > 0u ? mine : 1u; nx = cnt > 0u ? cnt : 1u;
}

__device__ __forceinline__ void xcd_barrier(const XcdBarrier& b) {
    asm volatile("s_waitcnt vmcnt(0)" ::: "memory");
    __syncthreads();
    if (threadIdx.x == 0) {
        unsigned* bar = b.bar;
        __builtin_amdgcn_s_waitcnt(0);
        unsigned nloc = b.st[0], nx = b.st[1];
        if (nloc == 0u) { xcd_barrier_complete(bar, b.x, nloc, nx); b.st[0] = nloc; b.st[1] = nx; }
        const unsigned old = xb_add(&bar[XB_XSUB(b.x)], 1u);
        const unsigned gen = old / nloc;
        if (old + 1u == (gen + 1u) * nloc) {
            __builtin_amdgcn_fence(__ATOMIC_RELEASE, "agent");
            asm volatile("s_waitcnt vmcnt(0)" ::: "memory");
            const unsigned og = xb_add(&bar[XB_TOP], 1u);
            const unsigned tg = og / nx;
            if (og + 1u == (tg + 1u) * nx) xb_add(&bar[XB_TOPGEN], 1u);
            else XB_SPIN(xb_ld(&bar[XB_TOPGEN]) == tg, bar);
            __builtin_amdgcn_fence(__ATOMIC_ACQUIRE, "agent");
            xb_add(&bar[XB_XGEN(b.x)], 1u);
            asm volatile("s_waitcnt vmcnt(0)" ::: "memory");
        } else {
            XB_SPIN(xb_ld(&bar[XB_XGEN(b.x)]) == gen, bar);
            __builtin_amdgcn_fence(__ATOMIC_ACQUIRE, "agent");
            asm volatile("s_waitcnt vmcnt(0)" ::: "memory");
        }
    }
    __syncthreads();
}

struct KArgs;
__device__ __forceinline__ void conv_tile(bool active, float (*tile)[65], int vt, const float* src, int ld, int K, bf16* dst, const float* kscale, int mode, int bx, int by) {
    const int n0 = bx * 64, k0 = by * 64, tx = vt & 63, ty = vt >> 6;
    const int n = n0 + tx;
    const int sc = (mode == 0 || mode == 3) ? n : mode == 1 ? win_srccol(n) : (n & ~63) + ((n & 1) << 5) + ((n & 63) >> 1);
    if (active) {
        float v[16];
#pragma unroll
        for (int i = 0; i < 16; ++i) v[i] = (sc >= 0) ? src[(size_t)(k0 + 4 * i + ty) * ld + sc] : 0.f;
        if (kscale) {
#pragma unroll
            for (int i = 0; i < 16; ++i) v[i] *= kscale[k0 + 4 * i + ty]; }
#pragma unroll
        for (int i = 0; i < 16; ++i) tile[tx][4 * i + ty] = v[i];
    }
    __syncthreads();
    if (active) {
#pragma unroll
        for (int p = 0; p < 2; ++p) { const int it = vt + 256 * p, r = it >> 3, c = it & 7; const float* t = &tile[r][8 * c];
            u32x4 o; o.x = pk2(t[0], t[1]); o.y = pk2(t[2], t[3]); o.z = pk2(t[4], t[5]); o.w = pk2(t[6], t[7]);
            const int nn = n0 + r, kk = k0 + 8 * c;
            if (mode == 3) *(u32x4*)(dst + ((size_t)((nn >> 5) * (K >> 4) + (kk >> 4)) * 64 + (nn & 31) + 32 * ((kk & 15) >> 3)) * 8) = o;
            else *(u32x4*)(dst + (size_t)nn * K + kk) = o; }
    }
    __syncthreads();
}
namespace cg = cooperative_groups;
constexpr int NT = 512;
constexpr int LDS_BYTES = 147456;
struct KArgs { const void* in[23]; float* out; unsigned char* ws; };

#define OPAQUE_TID() int tid = threadIdx.x; asm volatile("" : "+v"(tid))
#define VRUN(VT, NVB, CALL) do { OPAQUE_TID(); constexpr int per_ = NT / (VT); for (int vb = blockIdx.x * per_ + tid / (VT); vb < (NVB); vb += gridDim.x * per_) { const int vt = tid % (VT); CALL; } } while (0)
#define VRUN_BAR(NVB, CALL) do { OPAQUE_TID(); float (*tile)[65] = (float (*)[65])(lds + (tid >> 8) * 64 * 65 * 4); (void)tile; const int nvb_ = (NVB); for (int it_ = 0; it_ * (int)gridDim.x * 2 < nvb_; ++it_) { const int vb = (it_ * (int)gridDim.x + (int)blockIdx.x) * 2 + (tid >> 8); const int vt = tid & 255; const bool active = vb < nvb_; CALL; } } while (0)

#ifndef REP_U
#define REP_U 0
#endif
#ifndef REP_SYNC
#define REP_SYNC 0
#endif
#ifndef REP_SUMSQ
#define REP_SUMSQ 0
#endif
#ifndef REP_P0
#define REP_P0 0
#endif
#ifndef REP_PRO
#define REP_PRO 0
#endif
#ifndef REP_INPROJ
#define REP_INPROJ 0
#endif
#ifndef REP_P2
#define REP_P2 0
#endif
#ifndef REP_FOX
#define REP_FOX 0
#endif
#ifndef REP_DIFF
#define REP_DIFF 0
#endif
#ifndef REP_NSA
#define REP_NSA 0
#endif
#ifndef REP_GATEBR
#define REP_GATEBR 0
#endif
#ifndef REP_OUT
#define REP_OUT 0
#endif
#ifndef DO_ALL
#define DO_ALL 1
#endif
#ifndef DO_PRO
#define DO_PRO DO_ALL
#endif
#ifndef DO_INPROJ
#define DO_INPROJ DO_ALL
#endif
#ifndef DO_P2
#define DO_P2 DO_ALL
#endif
#ifndef DO_ATTN
#define DO_ATTN DO_ALL
#endif
#ifndef DO_GATEBR
#define DO_GATEBR DO_ALL
#endif
#ifndef DO_OUT
#define DO_OUT DO_ALL
#endif
#ifndef DO_PLE
#define DO_PLE DO_ALL
#endif
#ifndef DO_TAIL
#define DO_TAIL DO_ALL
#endif
__global__ void __launch_bounds__(NT) mega(KArgs a) {
    extern __shared__ __attribute__((aligned(16))) unsigned char lds[];
    cg::grid_group grid = cg::this_grid();
    { volatile LAS unsigned* st0 = (volatile LAS unsigned*)((LAS unsigned char*)lds + LDS_BARST); if (threadIdx.x < 2) st0[threadIdx.x] = 0u; }
    __syncthreads();
    const XcdBarrier xbar = xcd_barrier_post((unsigned*)(a.ws + OFF_BAR), (volatile LAS unsigned*)((LAS unsigned char*)lds + LDS_BARST));
#define GSYNC() xcd_barrier(xbar)
    unsigned char* ws = a.ws; float* X = a.out;
    typedef const KArgs __attribute__((address_space(4)))* kargp_t;
#define KIN(i) ([&]() { kargp_t kp_ = (kargp_t)__builtin_amdgcn_kernarg_segment_ptr(); asm volatile("" : "+s"(kp_)); return kp_->in[i]; }())
#define I_x ((const float*)KIN(0))
#define I_p ((const float*)KIN(1))
#define I_pos ((const int*)KIN(2))
#define I_norm_g ((const float*)KIN(3))
#define I_w_in ((const float*)KIN(4))
#define I_b_forget ((const float*)KIN(5))
#define I_pe_k ((const float*)KIN(6))
#define I_w1_k ((const float*)KIN(7))
#define I_b1_k ((const float*)KIN(8))
#define I_w2_k ((const float*)KIN(9))
#define I_pe_v ((const float*)KIN(10))
#define I_w1_v ((const float*)KIN(11))
#define I_b1_v ((const float*)KIN(12))
#define I_w2_v ((const float*)KIN(13))
#define I_diff_lam ((const float*)KIN(14))
#define I_subln ((const float*)KIN(15))
#define I_w_out ((const float*)KIN(19))
#define I_w_ple ((const float*)KIN(20))
#define I_w_pg ((const float*)KIN(21))
#define I_final_g ((const float*)KIN(22))
#if DO_PRO
    for (int rep0_ = 0; rep0_ <= REP_P0; ++rep0_) {
    VRUN(256, M / 4, d_xprep(vb, vt, I_x, ws));
    VRUN(256, M * 32 / 256, d_rope_table(vb, vt, I_pos, ws));
    VRUN(256, (2 * M * 256 / 4) / 256, d_pconv(vb, vt, I_p, ws));
    for (int l = 0; l < DEPTH; ++l) {
        { OPAQUE_TID(); if (blockIdx.x == 0 && tid < 64) d_lam(tid, I_diff_lam + l * 256, ws, l); }
    }
    }
#endif
    for (int l = 0; l < DEPTH; ++l) {
        const float* wl = I_w_in + (size_t)l * 1024 * NIN; const float* ng = I_norm_g + l * 1024;
#if DO_PRO
        for (int rep_ = 0; rep_ <= REP_PRO; ++rep_) {
        { OPAQUE_TID(); float (*tile)[65] = (float (*)[65])(lds + (tid >> 8) * 64 * 65 * 4);
          const int njobs = 2952 + (l == 0 ? 1152 : 0);
          for (int it_ = 0; it_ * (int)gridDim.x * 2 < njobs; ++it_) {
              int j = (it_ * (int)gridDim.x + (int)blockIdx.x) * 2 + (tid >> 8); const bool active = j < njobs;
              const float* src = wl; int ld = NIN, K = 1024, mode = 1, bx = 0, by = 0; bf16* dst = (bf16*)(ws + OFF_WIN); const float* ks = ng;
              if (j < 1536) { bx = j % 96; by = j / 96; }
              else if (j < 2304) { j -= 1536; bx = j % 48; by = j / 48; src = wl + 5920; mode = 0; dst = (bf16*)(ws + OFF_WMG); }
              else if (j < 2688) { j -= 2304; const int i = j >> 7, r = j & 127; bx = r & 15; by = r >> 4; src = (const float*)KIN(16 + i) + (size_t)l * 512 * 1024; ld = 1024; K = 512; mode = 0; dst = (bf16*)(ws + OFF_WBR) + (size_t)i * 1024 * 512; ks = nullptr; }
              else if (j < 2944) { j -= 2688; const int kv = j >> 7, r = j & 127; bx = r & 3; by = r >> 2; src = (kv ? I_w1_v : I_w1_k) + (size_t)l * 2048 * 256; ld = 256; K = 2048; mode = 3; dst = (bf16*)(ws + OFF_CW1) + (size_t)kv * 256 * 2048; ks = nullptr; }
              else if (j < 2952) { j -= 2944; const int kv = j >> 2; by = j & 3; src = (kv ? I_w2_v : I_w2_k) + (size_t)l * 256 * 64; ld = 64; K = 256; mode = kv ? 0 : 2; dst = (bf16*)(ws + OFF_CW2) + (size_t)kv * 64 * 256; ks = nullptr; }
              else { j -= 2952; const int ll = j / 576, r = j % 576; ld = 1024; mode = 0; ks = nullptr;
                  if (r < 256) { bx = r & 15; by = r >> 4; src = I_w_out + (size_t)ll * 1024 * 1024; dst = (bf16*)(ws + OFF_WOUT) + (size_t)ll * 1024 * 1024; }
                  else if (r < 512) { const int r2 = r - 256; bx = r2 & 15; by = r2 >> 4; src = I_w_pg + (size_t)ll * 1024 * 1024; dst = (bf16*)(ws + OFF_WPG) + (size_t)ll * 1024 * 1024; }
                  else { const int r2 = r - 512; bx = r2 & 15; by = r2 >> 4; src = I_w_ple + (size_t)ll * 256 * 1024; K = 256; dst = (bf16*)(ws + OFF_WPL) + (size_t)ll * 1024 * 256; } }
              conv_tile(active, tile, tid & 255, src, ld, K, dst, ks, mode, bx, by);
          } }
        { OPAQUE_TID(); if (blockIdx.x >= 64 && blockIdx.x < 96 && tid < 256) d_cb1_part(blockIdx.x - 64, tid, I_pe_k + l * 2048, I_w1_k + (size_t)l * 2048 * 256, I_pe_v + l * 2048, I_w1_v + (size_t)l * 2048 * 256, ws); }
        }
#endif
        if (l == 0) grid.sync(); else GSYNC();
        EpiCtx E{ws, I_b_forget + l * 8, l == 0 ? I_x : X, X, 0};
#if DO_INPROJ
        { OPAQUE_TID(); if (blockIdx.x == 0) d_cb1_sum(tid, I_b1_k + l * 256, I_b1_v + l * 256, ws); }
        for (int rep_ = 0; rep_ <= REP_INPROJ; ++rep_) { FAST_GEMM(EPI_INPROJ, ws + OFF_XB, ws + OFF_WIN, NP, 1024, true); }
#endif
        GSYNC();
#if DO_P2
        for (int rep_ = 0; rep_ <= REP_P2; ++rep_) {
        for (int u = blockIdx.x; u < 160; u += gridDim.x) { if (u < 128) compress_unit(lds, ws, u >> 6, (u >> 3) & 7, u & 7); else cumsum_unit(lds, ws, u - 128); }
        }
#endif
        GSYNC();
#if DO_ATTN
        for (int rep_ = (REP_FOX ? 1 : 0); rep_ >= 0; --rep_) for (int u = blockIdx.x; u < 512; u += gridDim.x) fox_unit(lds, ws, u & 31, u < 256 ? 15 - (u >> 5) : (u >> 5) - 8, rep_ > 0 ? REP_FOX : 0);
        __syncthreads();
        { const float lam = ((const float*)(ws + OFF_CTL))[CTL_LAM + l], lam_init = 0.8f - 0.6f * expf(-0.3f * (float)l);
          for (int rep_ = REP_DIFF; rep_ >= 0; --rep_) for (int u = blockIdx.x; u < 512; u += gridDim.x) diff_unit(lds, ws, u & 15, u < 256 ? 31 - (u >> 4) : (u >> 4) - 16, I_subln + l * 128, lam, lam_init, rep_ > 0); }
        __syncthreads();
        for (int rep_ = REP_NSA; rep_ >= 0; --rep_) for (int u = blockIdx.x; u < 512; u += gridDim.x) nsa_unit(lds, ws, u & 7, u < 256 ? 63 - (u >> 3) : (u >> 3) - 32, rep_ > 0);
#endif
        GSYNC();
#if DO_GATEBR
        for (int rep_ = 0; rep_ <= REP_GATEBR; ++rep_) {
        { pg8::Gemm g_{(const pg8::bf16_t*)(ws + OFF_XB), (const pg8::bf16_t*)(ws + OFF_WMG), M, 3072, 1024}; ChainOrder S_; S_.init((int)gridDim.x, (int)blockIdx.x, 0);
          EpiFast<EPI_GATE3> Ep_{E}; pg8::gemm_phase<EpiFast<EPI_GATE3>, ChainOrder, true, true>((PG8_LAS unsigned char*)lds, g_, S_, Ep_); }
        { pg8::Gemm g_{(const pg8::bf16_t*)(ws + OFF_ZA), (const pg8::bf16_t*)(ws + OFF_WBR), 3 * M, 3072, 512}; ChainOrder S_; S_.init((int)gridDim.x, (int)blockIdx.x, 1);
          EpiFast<EPI_BR3> Ep_{E}; pg8::gemm_phase<EpiFast<EPI_BR3>, ChainOrder, true, true>((PG8_LAS unsigned char*)lds, g_, S_, Ep_); }
        }
#endif
        GSYNC();
#if DO_OUT
        for (int rep_ = 0; rep_ <= (l == 0 ? REP_OUT : 0); ++rep_) FAST_GEMM(EPI_OUT, (const bf16*)(ws + OFF_MERGED), (const bf16*)(ws + OFF_WOUT) + (size_t)l * 1024 * 1024, 1024, 1024, false);
#endif
        GSYNC();
#if DO_PLE
        for (int rep_ = 0; rep_ <= REP_U; ++rep_) FAST_GEMM(EPI_U, (const bf16*)(ws + OFF_PB) + (size_t)l * M * 256, (const bf16*)(ws + OFF_WPL) + (size_t)l * 1024 * 256, 1024, 256, false);
        FAST_GEMM(EPI_PLE, (const bf16*)(ws + OFF_X1B), (const bf16*)(ws + OFF_WPG) + (size_t)l * 1024 * 1024, 1024, 1024, false);
#endif
        GSYNC();
#if DO_TAIL
        for (int rep_ = 0; rep_ < 10 * REP_SYNC; ++rep_) GSYNC();
        for (int rep_ = 0; rep_ <= REP_SUMSQ; ++rep_) { if (l + 1 < DEPTH) VRUN(256, M / 4, d_sumsq(vb, vt, X, ws)); }
#endif
    }
#if DO_TAIL
    VRUN(256, M / 4, d_final(vb, vt, X, I_final_g));
#endif
}
#undef I_x
#undef I_p
#undef I_pos
#undef I_norm_g
#undef I_w_in
#undef I_b_forget
#undef I_pe_k
#undef I_w1_k
#undef I_b1_k
#undef I_w2_k
#undef I_pe_v
#undef I_w1_v
#undef I_b1_v
#undef I_w2_v
#undef I_diff_lam
#undef I_subln
#undef I_w_out
#undef I_w_ple
#undef I_w_pg
#undef I_final_g
#undef KIN

extern "C" void kernel_launch(void* const* d_in, const int* in_sizes, int n_in, void* d_out, int out_size, void* d_ws, size_t ws_size, hipStream_t stream) {
    static int grid_blocks = 0;
    if (grid_blocks == 0) {
        if (n_in != 23 || ws_size < WS_NEED || out_size != M * DM) { fprintf(stderr, "kernel_launch: unexpected sizes (n_in %d ws %zu out %d)\n", n_in, ws_size, out_size); grid_blocks = -1; return; }
        int dev = 0, cus = 0, per_cu = 0;
        (void)hipGetDevice(&dev); (void)hipDeviceGetAttribute(&cus, hipDeviceAttributeMultiprocessorCount, dev);
        (void)hipFuncSetAttribute((const void*)mega, hipFuncAttributeMaxDynamicSharedMemorySize, LDS_BYTES);
        (void)hipOccupancyMaxActiveBlocksPerMultiprocessor(&per_cu, (const void*)mega, NT, LDS_BYTES);
        if (per_cu < 1) { fprintf(stderr, "kernel_launch: occupancy query says %d blocks per CU\n", per_cu); grid_blocks = -1; return; }
        grid_blocks = cus * 1;
        if (grid_blocks != 256) { fprintf(stderr, "kernel_launch: built for a 256-CU device (got %d)\n", cus); grid_blocks = -1; return; }
    }
    if (grid_blocks < 0) return;
    (void)hipMemsetAsync((char*)d_ws + OFF_CTL, 0, 262144, stream);
    KArgs a{};
    for (int i = 0; i < 23; ++i) a.in[i] = d_in[i];
    a.out = (float*)d_out; a.ws = (unsigned char*)d_ws;
    void* args[] = {&a};
    hipError_t e = hipLaunchCooperativeKernel((const void*)mega, dim3(grid_blocks), dim3(NT), args, LDS_BYTES, stream);
    if (e != hipSuccess) fprintf(stderr, "cooperative launch failed: %s (grid %d)\n", hipGetErrorString(e), grid_blocks);
}
```

```cpp
#include <hip/hip_runtime.h>
#include <hip/hip_cooperative_groups.h>
#include <cstdio>
#include <cstdint>

typedef unsigned short bf16;
typedef short bf16x8 __attribute__((ext_vector_type(8)));
typedef float f32x4 __attribute__((ext_vector_type(4)));
typedef float f32x16 __attribute__((ext_vector_type(16)));
typedef unsigned u32x4 __attribute__((ext_vector_type(4)));
typedef unsigned u32x2 __attribute__((ext_vector_type(2)));

constexpr int BATCH = 4, SEQ = 4096, DM = 1024, M = BATCH * SEQ, DEPTH = 2, NIN = 8992, NP = 6144;
constexpr float EPS = 1e-6f;
constexpr float LOG2E = 1.4426950408889634f;
constexpr float C2 = 0.125f * LOG2E;
constexpr size_t MiB = 1u << 20;
constexpr size_t OFF_CTL = 0;
constexpr size_t OFF_WIN = 1 * MiB, OFF_WMG = 13 * MiB, OFF_WBR = 19 * MiB, OFF_CW1 = 22 * MiB, OFF_CW2 = 24 * MiB, OFF_CB1 = 24 * MiB + 128 * 1024;
constexpr size_t OFF_WOUT = 25 * MiB, OFF_WPG = 29 * MiB, OFF_WPL = 33 * MiB;
constexpr size_t OFF_XB = 34 * MiB, OFF_ZA = 66 * MiB, OFF_ZB = 82 * MiB, OFF_ZC = 98 * MiB;
constexpr size_t OFF_COS = 114 * MiB, OFF_SIN = 116 * MiB, OFF_PB = 118 * MiB;
constexpr size_t OFF_LOGF = 134 * MiB, OFF_CF = 134 * MiB + 512 * 1024, OFF_GATES = 135 * MiB, OFF_SSP = 136 * MiB + 512 * 1024;
constexpr size_t OFF_KCMP = 136 * MiB + 768 * 1024, OFF_VCMP = 137 * MiB, OFF_SELM = 137 * MiB + 256 * 1024;
constexpr size_t OFF_QA = 139 * MiB, OFF_KA = 155 * MiB, OFF_VA = 171 * MiB, OFF_QB = 187 * MiB, OFF_QC = 203 * MiB, OFF_KC = 219 * MiB, OFF_VC = 235 * MiB;
constexpr size_t OFF_KCB = 251 * MiB, OFF_VCB = 255 * MiB, OFF_KSEL = 259 * MiB, OFF_KWIN = 263 * MiB, OFF_VSEL = 267 * MiB, OFF_VWIN = 271 * MiB;
constexpr size_t WS_NEED = 275 * MiB;
constexpr size_t OFF_G = 139 * MiB  , OFF_T = 235 * MiB  , OFF_MERGED = OFF_T, OFF_X1B = 203 * MiB, OFF_U = 139 * MiB;
constexpr int CTL_LAM = 64;

__device__ __forceinline__ bf16 f2bf(float f) { unsigned u = __float_as_uint(f); return (bf16)((u + 0x7fffu + ((u >> 16) & 1u)) >> 16); }
__device__ __forceinline__ float bf2f(bf16 h) { return __uint_as_float(((unsigned)h) << 16); }
__device__ __forceinline__ unsigned pk2(float lo, float hi) { typedef float f2_ __attribute__((ext_vector_type(2))); typedef __bf16 b2_ __attribute__((ext_vector_type(2))); f2_ v = {lo, hi}; b2_ b = __builtin_convertvector(v, b2_); return __builtin_bit_cast(unsigned, b); }
__device__ __forceinline__ float sigmoidf_(float x) { return 1.f / (1.f + __expf(-x)); }
__device__ __forceinline__ float siluf_(float x) { return x / (1.f + __expf(-x)); }
__device__ __forceinline__ float logsigmoidf_(float x) { return x >= 0.f ? -log1pf(expf(-x)) : x - log1pf(expf(x)); }

__device__ __forceinline__ int ktile_off(int s, int d) { return (s >> 6) * 4096 + (d >> 3) * 512 + (s & 63) * 8 + (d & 7); }
__device__ __forceinline__ int vtile_off(int s, int d) { return (s >> 6) * 4096 + (d >> 5) * 2048 + ((s & 63) >> 4) * 512 + (s & 15) * 32 + (d & 31); }
__device__ __forceinline__ int v128_off(int s, int d) { return (s >> 6) * 8192 + (d >> 5) * 2048 + ((s & 63) >> 4) * 512 + (s & 15) * 32 + (d & 31); }

template <int W> __device__ __forceinline__ void store_bf(bf16* dst, const float* v) {
    if constexpr (W == 4) { u32x2 o; o.x = pk2(v[0], v[1]); o.y = pk2(v[2], v[3]); *(u32x2*)dst = o; }
    else { u32x4 o; o.x = pk2(v[0], v[1]); o.y = pk2(v[2], v[3]); o.z = pk2(v[4], v[5]); o.w = pk2(v[6], v[7]); *(u32x4*)dst = o; }
}

__device__ __forceinline__ int win_srccol(int n) {
    const int seg = n >> 6, j = n & 63; const int il = ((j & 1) << 5) + (j >> 1);
    if (seg < 8) return 0 + n;
    if (seg < 16) return 512 + (n - 512);
    if (seg < 24) return 1024 + (n - 1024);
    if (seg < 32) return 1544 + (n - 1536);
    if (seg < 40) return 2056 + (seg - 32) * 64 + il;
    if (seg < 42) return 2568 + (n - 2560);
    if (seg < 44) return 2696 + (n - 2688);
    if (seg < 46) return 2824 + (seg - 44) * 64 + il;
    if (seg < 48) return 3080 + (seg - 46) * 64 + il;
    if (seg < 50) return 2952 + (n - 3072);
    if (seg < 52) return 3208 + (n - 3200);
    if (seg < 60) return 3360 + (n - 3328);
    if (seg < 68) return 3872 + (seg - 60) * 64 + il;
    if (seg < 76) return 4384 + (seg - 68) * 64 + il;
    if (seg < 84) return 4896 + (n - 4864);
    if (seg < 92) return 5408 + (n - 5376);
    if (seg == 92) { if (j < 8) return 1536 + j; if (j < 32) return 3336 + (j - 8); return -1; }
    return -1;
}

enum { EPI_INPROJ = 0, EPI_GATE = 1, EPI_BR0 = 2, EPI_BR1 = 3, EPI_BR2 = 4, EPI_OUT = 5, EPI_U = 6, EPI_PLE = 7, EPI_GATE3 = 9, EPI_BR3 = 10 };
struct EpiCtx { unsigned char* ws; const float* bfg; const float* xin; float* X; int gi; };

__device__ __forceinline__ float row_rstd(const unsigned char* ws, int row) {
    const f32x4 sp = *(const f32x4*)(ws + OFF_SSP + (size_t)row * 16);
    return rsqrtf(((sp[0] + sp[1]) + (sp[2] + sp[3])) * (1.f / 1024.f) + EPS);
}

enum { T_QA = 0, T_KA, T_VA, T_ZA, T_QB, T_CB, T_KROPE, T_VSW, T_ZB, T_QC, T_KC, T_VC, T_ZC, T_SPECIAL };
__device__ __forceinline__ int inproj_type(int t) {
    return t < 2 ? T_QA : t < 4 ? T_KA : t < 6 ? T_VA : t < 8 ? T_ZA : t < 10 ? T_QB : t == 10 ? T_CB : t == 11 ? T_KROPE : t == 12 ? T_VSW : t < 15 ? T_ZB : t < 17 ? T_QC : t < 19 ? T_KC : t < 21 ? T_VC : t < 23 ? T_ZC : T_SPECIAL;
}
struct Pre { float rs; float a[8]; float b[8]; };
template <int KIND, int T> __device__ __forceinline__ void pre_load(const EpiCtx& E, int row, int col, Pre& p) {
    unsigned char* ws = E.ws; const size_t idx = (size_t)row * 1024 + col;
    if constexpr (KIND == EPI_INPROJ) {
        if constexpr (T == T_KROPE || T == T_QC || T == T_KC) { const int d = col & 63;
            const f32x4 c = *(const f32x4*)((const float*)(ws + OFF_COS) + (size_t)row * 32 + (d >> 1)), s = *(const f32x4*)((const float*)(ws + OFF_SIN) + (size_t)row * 32 + (d >> 1));
#pragma unroll
            for (int i = 0; i < 4; ++i) { p.a[i] = c[i]; p.b[i] = s[i]; } }
    } else if constexpr (KIND == EPI_GATE || KIND == EPI_GATE3) {
    } else if constexpr (KIND == EPI_BR3) {
        const u32x4 g = *(const u32x4*)((const bf16*)(ws + OFF_G) + (size_t)E.gi * M * 1024 + idx);
#pragma unroll
        for (int i = 0; i < 4; ++i) { p.a[2 * i] = __uint_as_float(g[i] << 16); p.a[2 * i + 1] = __uint_as_float(g[i] & 0xffff0000u); }
        if (E.gi > 0) { const u32x4 t = *(const u32x4*)((const bf16*)(ws + OFF_T) + idx);
#pragma unroll
            for (int i = 0; i < 4; ++i) { p.b[2 * i] = __uint_as_float(t[i] << 16); p.b[2 * i + 1] = __uint_as_float(t[i] & 0xffff0000u); } }
        else {
#pragma unroll
            for (int i = 0; i < 8; ++i) p.b[i] = 0.f; }
    } else if constexpr (KIND == EPI_BR0 || KIND == EPI_BR1 || KIND == EPI_BR2) {
        const u32x4 g = *(const u32x4*)((const bf16*)(ws + OFF_G) + idx);
#pragma unroll
        for (int i = 0; i < 4; ++i) { p.a[2 * i] = __uint_as_float(g[i] << 16); p.a[2 * i + 1] = __uint_as_float(g[i] & 0xffff0000u); }
        if constexpr (KIND != EPI_BR0) { const u32x4 t = *(const u32x4*)((const bf16*)(ws + OFF_T) + idx);
#pragma unroll
            for (int i = 0; i < 4; ++i) { p.b[2 * i] = __uint_as_float(t[i] << 16); p.b[2 * i + 1] = __uint_as_float(t[i] & 0xffff0000u); } }
    } else if constexpr (KIND == EPI_OUT) { const f32x4 t0 = *(const f32x4*)(E.xin + idx), t1 = *(const f32x4*)(E.xin + idx + 4);
#pragma unroll
        for (int i = 0; i < 4; ++i) { p.a[i] = t0[i]; p.a[4 + i] = t1[i]; }
    } else if constexpr (KIND == EPI_PLE) { const f32x4 t0 = *(const f32x4*)(E.X + idx), t1 = *(const f32x4*)(E.X + idx + 4); const u32x4 u = *(const u32x4*)((const bf16*)(ws + OFF_U) + idx);
#pragma unroll
        for (int i = 0; i < 4; ++i) { p.a[i] = t0[i]; p.a[4 + i] = t1[i]; p.b[2 * i] = __uint_as_float(u[i] << 16); p.b[2 * i + 1] = __uint_as_float(u[i] & 0xffff0000u); }
    }
}
__device__ __forceinline__ void st_f32x8(float* dst, const float* v) { f32x4 a = {v[0], v[1], v[2], v[3]}, b = {v[4], v[5], v[6], v[7]}; *(f32x4*)dst = a; *(f32x4*)(dst + 4) = b; }
template <int KIND, int T> __device__ __forceinline__ float emit_fin(const EpiCtx& E, int row, int col, const float* a, const Pre& p) {
    constexpr int W = 8;
    unsigned char* ws = E.ws; const size_t idx = (size_t)row * 1024 + col;
    float v[W];
    if constexpr (KIND == EPI_INPROJ) {
        const float rs = p.rs;
#pragma unroll
        for (int i = 0; i < W; ++i) v[i] = a[i] * rs;
        const int b = row >> 12, s = row & 4095;
        if constexpr (T == T_KROPE || T == T_QC || T == T_KC) {
#pragma unroll
            for (int j = 0; j < 4; ++j) { const float c = p.a[j], sn = p.b[j], x1 = v[2 * j], x2 = v[2 * j + 1]; v[2 * j] = x1 * c - x2 * sn; v[2 * j + 1] = x2 * c + x1 * sn; } }
        if constexpr (T == T_QA) { const int cc = col, h = cc >> 6, d = cc & 63;
#pragma unroll
            for (int i = 0; i < W; ++i) v[i] *= C2;
            store_bf<W>((bf16*)(ws + OFF_QA) + ((size_t)(b * 8 + h) * 4096 + s) * 64 + d, v);
        } else if constexpr (T == T_KA) { const int cc = col - 512, h = cc >> 6, d = cc & 63;
            store_bf<W>((bf16*)(ws + OFF_KA) + (size_t)(b * 8 + h) * 262144 + ktile_off(s, d), v);
        } else if constexpr (T == T_VA) { const int cc = col - 1024, h = cc >> 6, d = cc & 63;
            store_bf<W>((bf16*)(ws + OFF_VA) + (size_t)(b * 8 + h) * 262144 + vtile_off(s, d), v);
        } else if constexpr (T == T_ZA || T == T_ZB || T == T_ZC) { const int cc = col - (T == T_ZA ? 1536 : T == T_ZB ? 3328 : 5376);
#pragma unroll
            for (int i = 0; i < W; ++i) v[i] = siluf_(v[i]);
            store_bf<W>((bf16*)(ws + (T == T_ZA ? OFF_ZA : T == T_ZB ? OFF_ZB : OFF_ZC)) + (size_t)row * 512 + cc, v);
        } else if constexpr (T == T_QB) { const int cc = col - 2048, h = cc >> 6, d = cc & 63;
#pragma unroll
            for (int i = 0; i < W; ++i) v[i] *= C2;
            store_bf<W>((bf16*)(ws + OFF_QB) + ((size_t)(b * 8 + h) * 4096 + s) * 64 + d, v);
        } else if constexpr (T == T_CB) { const int cc = col - 2560, g = (cc >> 6) & 1, d = cc & 63;
            store_bf<W>((bf16*)(ws + (cc < 128 ? OFF_KCB : OFF_VCB)) + ((size_t)(b * 2 + g) * 4096 + s) * 64 + d, v);
        } else if constexpr (T == T_KROPE) { const int cc = col - 2816, g = (cc >> 6) & 1, d = cc & 63;
            store_bf<W>((bf16*)(ws + (cc < 128 ? OFF_KSEL : OFF_KWIN)) + (size_t)(b * 2 + g) * 262144 + ktile_off(s, d), v);
        } else if constexpr (T == T_VSW) { const int cc = col - 3072, g = (cc >> 6) & 1, d = cc & 63;
            store_bf<W>((bf16*)(ws + (cc < 128 ? OFF_VSEL : OFF_VWIN)) + (size_t)(b * 2 + g) * 262144 + vtile_off(s, d), v);
        } else if constexpr (T == T_QC) { const int cc = col - 3840, h = cc >> 6, d = cc & 63;
#pragma unroll
            for (int i = 0; i < W; ++i) v[i] *= C2;
            store_bf<W>((bf16*)(ws + OFF_QC) + ((size_t)(b * 8 + h) * 4096 + s) * 64 + d, v);
        } else if constexpr (T == T_KC) { const int cc = col - 4352, h = cc >> 6, d = cc & 63;
            store_bf<W>((bf16*)(ws + OFF_KC) + (size_t)(b * 8 + h) * 262144 + ktile_off(s, d), v);
        } else if constexpr (T == T_VC) { const int cc = col - 4864, hc = cc >> 7, d = cc & 127;
            store_bf<W>((bf16*)(ws + OFF_VC) + (size_t)(b * 4 + hc) * 524288 + v128_off(s, d), v);
        } else { const int cc = col - 5888;
            if (cc < 8) { float* o = (float*)(ws + OFF_LOGF) + (size_t)row * 8 + cc;
#pragma unroll
                for (int i = 0; i < W; ++i) o[i] = logsigmoidf_(v[i] + E.bfg[cc + i]) * LOG2E;
            } else if (cc < 32) { float* o = (float*)(ws + OFF_GATES) + (size_t)row * 24 + (cc - 8);
#pragma unroll
                for (int i = 0; i < W; ++i) o[i] = sigmoidf_(v[i]);
            }
        }
    } else if constexpr (KIND == EPI_GATE3) {
#pragma unroll
        for (int i = 0; i < W; ++i) v[i] = sigmoidf_(a[i] * p.rs);
        store_bf<W>((bf16*)(ws + OFF_G) + (size_t)E.gi * M * 1024 + idx, v);
    } else if constexpr (KIND == EPI_BR3) {
#pragma unroll
        for (int i = 0; i < W; ++i) v[i] = p.a[i] * a[i] + p.b[i];
        store_bf<W>((bf16*)(ws + OFF_T) + idx, v);
    } else if constexpr (KIND == EPI_GATE) {
#pragma unroll
        for (int i = 0; i < W; ++i) v[i] = sigmoidf_(a[i] * p.rs);
        store_bf<W>((bf16*)(ws + OFF_G) + idx, v);
    } else if constexpr (KIND == EPI_BR0 || KIND == EPI_BR1 || KIND == EPI_BR2) {
#pragma unroll
        for (int i = 0; i < W; ++i) { v[i] = p.a[i] * a[i]; if (KIND != EPI_BR0) v[i] += p.b[i]; }
        if constexpr (KIND == EPI_BR2) store_bf<W>((bf16*)(ws + OFF_MERGED) + idx, v);
        else store_bf<W>((bf16*)(ws + OFF_T) + idx, v);
    } else if constexpr (KIND == EPI_OUT) {
#pragma unroll
        for (int i = 0; i < W; ++i) v[i] = p.a[i] + a[i];
        st_f32x8(E.X + idx, v);
        store_bf<W>((bf16*)(ws + OFF_X1B) + idx, v);
    } else if constexpr (KIND == EPI_U) {
        store_bf<W>((bf16*)(ws + OFF_U) + idx, a);
    } else if constexpr (KIND == EPI_PLE) {
#pragma unroll
        for (int i = 0; i < W; ++i) v[i] = p.a[i] + sigmoidf_(a[i]) * p.b[i];
        st_f32x8(E.X + idx, v);
        store_bf<W>((bf16*)(ws + OFF_XB) + idx, v);
        return ((v[0] * v[0] + v[1] * v[1]) + (v[2] * v[2] + v[3] * v[3])) + ((v[4] * v[4] + v[5] * v[5]) + (v[6] * v[6] + v[7] * v[7]));
    }
    return 0.f;
}

__device__ __forceinline__ void d_xprep(int vb, int vt, const float* x, unsigned char* ws) {
    const int row = vb * 4 + (vt >> 6), lane = vt & 63;
    const f32x4* xr = (const f32x4*)(x + (size_t)row * 1024) + lane; float ss = 0.f;
    bf16* o = (bf16*)(ws + OFF_XB) + (size_t)row * 1024;
#pragma unroll
    for (int j = 0; j < 4; ++j) { const f32x4 v = xr[64 * j]; ss += (v[0] * v[0] + v[1] * v[1]) + (v[2] * v[2] + v[3] * v[3]); float t[4] = {v[0], v[1], v[2], v[3]}; store_bf<4>(o + 256 * j + 4 * lane, t); }
#pragma unroll
    for (int of = 1; of < 64; of <<= 1) ss += __shfl_xor(ss, of);
    if (lane == 0) { f32x4 s = {ss, 0.f, 0.f, 0.f}; *(f32x4*)(ws + OFF_SSP + (size_t)row * 16) = s; }
}
__device__ __forceinline__ void d_sumsq(int vb, int vt, const float* x, unsigned char* ws) {
    const int row = vb * 4 + (vt >> 6), lane = vt & 63;
    const f32x4* xr = (const f32x4*)(x + (size_t)row * 1024) + lane; float ss = 0.f;
#pragma unroll
    for (int j = 0; j < 4; ++j) { const f32x4 v = xr[64 * j]; ss += (v[0] * v[0] + v[1] * v[1]) + (v[2] * v[2] + v[3] * v[3]); }
#pragma unroll
    for (int of = 1; of < 64; of <<= 1) ss += __shfl_xor(ss, of);
    if (lane == 0) { f32x4 s = {ss, 0.f, 0.f, 0.f}; *(f32x4*)(ws + OFF_SSP + (size_t)row * 16) = s; }
}
__device__ __forceinline__ void d_rope_table(int vb, int vt, const int* pos, unsigned char* ws) {
    const int idx = vb * 256 + vt, row = idx >> 5, i = idx & 31;
    const float inv = exp2f(-(float)i * (13.287712379549449f / 32.f));
    const float ang = (float)pos[row] * inv;
    float s, c; sincosf(ang, &s, &c);
    ((float*)(ws + OFF_COS))[idx] = c; ((float*)(ws + OFF_SIN))[idx] = s;
}
__device__ __forceinline__ void d_pconv(int vb, int vt, const float* p, unsigned char* ws) {
    const size_t i = ((size_t)vb * 256 + vt) * 4;
    const f32x4 v = *(const f32x4*)(p + i); float t[4] = {v[0], v[1], v[2], v[3]}; store_bf<4>((bf16*)(ws + OFF_PB) + i, t);
}
constexpr size_t OFF_CBPART = OFF_CTL + 65536;
__device__ __forceinline__ void d_cb1_part(int u, int vt, const float* pe_k, const float* w1_k, const float* pe_v, const float* w1_v, unsigned char* ws) {
    const int kv = u >> 4, kc = u & 15, j = vt;
    const float* pe = (kv ? pe_v : pe_k) + 128 * kc; const float* w1 = (kv ? w1_v : w1_k) + (size_t)(128 * kc) * 256 + j;
    float acc = 0.f;
#pragma unroll 16
    for (int k = 0; k < 128; ++k) acc += pe[k] * w1[(size_t)k * 256];
    ((float*)(ws + OFF_CBPART))[(kv * 16 + kc) * 256 + j] = acc;
}
__device__ __forceinline__ void d_cb1_sum(int vt, const float* b1_k, const float* b1_v, unsigned char* ws) {
    const int kv = vt >> 8, j = vt & 255; float acc = (kv ? b1_v : b1_k)[j];
#pragma unroll
    for (int kc = 0; kc < 16; ++kc) acc += ((const float*)(ws + OFF_CBPART))[(kv * 16 + kc) * 256 + j];
    ((float*)(ws + OFF_CB1))[kv * 256 + j] = acc;
}
__device__ __forceinline__ void d_lam(int vt, const float* dl, unsigned char* ws, int l) {
    if (vt == 0) { float s1 = 0.f, s2 = 0.f; for (int i = 0; i < 64; ++i) { s1 += dl[i] * dl[64 + i]; s2 += dl[128 + i] * dl[192 + i]; }
        const float li = 0.8f - 0.6f * expf(-0.3f * (float)l); ((float*)(ws + OFF_CTL))[CTL_LAM + l] = expf(s1) - expf(s2) + li; }
}
__device__ __forceinline__ void d_final(int vb, int vt, float* X, const float* g) {
    const int row = vb * 4 + (vt >> 6), lane = vt & 63;
    f32x4* xr = (f32x4*)(X + (size_t)row * 1024) + lane; f32x4 v[4]; float ss = 0.f;
#pragma unroll
    for (int j = 0; j < 4; ++j) { v[j] = xr[64 * j]; ss += (v[j][0] * v[j][0] + v[j][1] * v[j][1]) + (v[j][2] * v[j][2] + v[j][3] * v[j][3]); }
#pragma unroll
    for (int of = 1; of < 64; of <<= 1) ss += __shfl_xor(ss, of);
    const float rs = rsqrtf(ss * (1.f / 1024.f) + EPS);
#pragma unroll
    for (int j = 0; j < 4; ++j) { const f32x4 gg = *((const f32x4*)g + 64 * j + lane); xr[64 * j] = v[j] * rs * gg; }
}


namespace pg8 {
#define PG8_LAS __attribute__((address_space(3)))
typedef unsigned short bf16_t;
typedef short bf16x8 __attribute__((ext_vector_type(8)));
typedef float f32x4 __attribute__((ext_vector_type(4)));
typedef unsigned u32x4 __attribute__((ext_vector_type(4)));
constexpr int BM = 256, BK = 64, HALF = 128, HTB = HALF * BK * 2  , STAGE_BYTES = 8 * HTB, NXCD = 8, WGM = 8;

__host__ __device__ __forceinline__ int lds_byte(int r, int c) { const int st = (r >> 4) * 2 + (c >> 5), rr = r & 15, cc = c & 31, ob = rr * 64 + cc * 2; return st * 1024 + (ob ^ (((ob >> 9) & 1) << 5)); }
__host__ __device__ __forceinline__ void stage_rc(int b, int& R, int& C) { const int st = b / 1024, sb = b % 1024, swz = sb ^ (((sb >> 9) & 1) << 5); R = (st >> 1) * 16 + swz / 64; C = (st & 1) * 32 + (swz % 64) / 2; }
__host__ __device__ __forceinline__ int perm32(int rho) { const int n = rho >> 4, i = rho & 15; return 8 * (i >> 2) + 4 * n + (i & 3); }

struct Unit { int pm, pn; };
struct Gemm { const bf16_t* A; const bf16_t* Bt; int M, N, K; };

struct StaticOrder {
    int nM, nN, nwg, G, c;
    __host__ __device__ __forceinline__ void init(int M, int N, int G_, int c_) { nM = M / BM; nN = N / BM; nwg = nM * nN; G = G_; c = c_; }
    __host__ __device__ __forceinline__ bool next(int i, Unit& u) const {
        const long L = (long)i * G + c; if (L >= nwg) return false;
        int wgid = (int)L; { const int q = nwg / NXCD, r = nwg % NXCD, xcd = wgid % NXCD, off = wgid / NXCD; wgid = (xcd < r ? xcd * (q + 1) : r * (q + 1) + (xcd - r) * q) + off; }
        const int nig = WGM * nN, gid = wgid / nig, fm = gid * WGM, gsz = (nM - fm) < WGM ? (nM - fm) : WGM;
        u.pm = fm + ((wgid % nig) % gsz); u.pn = (wgid % nig) / gsz; return true;
    }
    __device__ __forceinline__ void a_ready(const Unit&) const {}
    __device__ __forceinline__ void done(const Unit&) const {}
};

__device__ __forceinline__ unsigned cvt_pk_bf16(float lo, float hi) { unsigned r; asm volatile("v_cvt_pk_bf16_f32 %0, %1, %2" : "=v"(r) : "v"(lo), "v"(hi)); return r; }
typedef float f32x2 __attribute__((ext_vector_type(2)));
template <class Epi, class Sched, bool ALIGN_EPI = false, bool SP2 = false>
__device__ __forceinline__ void gemm_phase(PG8_LAS unsigned char* lds, const Gemm g, const Sched& S, const Epi& E) {
    int tid_o = threadIdx.x; asm volatile("" : "+v"(tid_o));
    const int tid = tid_o, wid = __builtin_amdgcn_readfirstlane(tid >> 6), lane = tid & 63, wr = wid >> 2, wc = wid & 3, fr = lane & 15, fq = lane >> 4;
    const int K = g.K, nt = K / BK;
    unsigned voffA[2], voffB[2];
#pragma unroll
    for (int i = 0; i < 2; ++i) { int R, C; stage_rc(tid * 16 + i * 8192, R, C); const int Rb = Epi::PERM ? ((R & ~31) + perm32(R & 31)) : R;
        voffA[i] = (unsigned)(R * K + C) * 2u; voffB[i] = (unsigned)(Rb * K + C) * 2u; }
    const size_t kstep = (size_t)(BK * 2);
    const size_t hstep = (size_t)HALF * K * 2;
    const size_t tstep = 2 * hstep;
    const unsigned ldsw = (unsigned)wid * 1024u;
    const int aoff = lds_byte(wr * 64 + fr, fq * 8), boff = lds_byte(wc * 32 + fr, fq * 8);
#define PG8_SA(b, h) (((b) * 2 + (h)) * HTB)
#define PG8_SB(b, h) ((4 + (b) * 2 + (h)) * HTB)
#define PG8_STAGE(bufoff, gbase, voff) do { _Pragma("unroll") for (int _i = 0; _i < 2; ++_i) \
        __builtin_amdgcn_global_load_lds((const unsigned*)((const char*)(gbase) + (voff)[_i]), (PG8_LAS unsigned*)(lds + (bufoff) + ldsw + _i * 8192), 16, 0, 0); } while (0)
#define PG8_LDA(dst, b, h) do { _Pragma("unroll") for (int m = 0; m < 4; ++m) _Pragma("unroll") for (int k = 0; k < 2; ++k) dst[m][k] = *(const PG8_LAS bf16x8*)(lds + PG8_SA(b, h) + aoff + m * 2048 + k * 1024); } while (0)
#define PG8_LDB(dst, b, h) do { _Pragma("unroll") for (int n = 0; n < 2; ++n) _Pragma("unroll") for (int k = 0; k < 2; ++k) dst[n][k] = *(const PG8_LAS bf16x8*)(lds + PG8_SB(b, h) + boff + n * 2048 + k * 1024); } while (0)
#define PG8_MMA(ai, bj, At, Bt) do { __builtin_amdgcn_s_setprio(1); _Pragma("unroll") for (int m = 0; m < 4; ++m) _Pragma("unroll") for (int n = 0; n < 2; ++n) _Pragma("unroll") for (int k = 0; k < 2; ++k) \
        acc[ai][bj][m][n] = __builtin_amdgcn_mfma_f32_16x16x32_bf16(Bt[n][k], At[m][k], acc[ai][bj][m][n], 0, 0, 0); __builtin_amdgcn_s_setprio(0); } while (0)
#define PG8_WAIT_V(n) asm volatile("s_waitcnt vmcnt(" #n ")" ::: "memory")
#define PG8_WAIT_L(n) asm volatile("s_waitcnt lgkmcnt(" #n ")" ::: "memory")
#define PG8_BAR __builtin_amdgcn_s_barrier()
#define PG8_SCHED __builtin_amdgcn_sched_barrier(0)
    Unit cur, nxt; int ui = 0;
    if (!S.next(0, cur)) return;
    f32x4 acc[2][2][4][2];
#pragma unroll
    for (int a = 0; a < 2; ++a)
#pragma unroll
        for (int b = 0; b < 2; ++b)
#pragma unroll
            for (int m = 0; m < 4; ++m)
#pragma unroll
                for (int n = 0; n < 2; ++n) acc[a][b][m][n] = (f32x4){0.f, 0.f, 0.f, 0.f};
    bf16x8 At[4][2], B0[2][2], B1[2][2];
    const char* cA = (const char*)g.A + (size_t)cur.pm * tstep; const char* cB = (const char*)g.Bt + (size_t)cur.pn * tstep;
    S.a_ready(cur);
    if constexpr (SP2) {
        PG8_STAGE(PG8_SB(0, 0), cB, voffB); PG8_STAGE(PG8_SB(0, 1), cB + hstep, voffB); PG8_STAGE(PG8_SA(0, 0), cA, voffA); PG8_STAGE(PG8_SA(0, 1), cA + hstep, voffA);
        if (wr == 1) PG8_BAR;
        PG8_WAIT_V(2); PG8_BAR;
        PG8_STAGE(PG8_SB(1, 0), cB + kstep, voffB); PG8_STAGE(PG8_SA(1, 0), cA + kstep, voffA); PG8_STAGE(PG8_SB(1, 1), cB + hstep + kstep, voffB);
        PG8_WAIT_V(6); PG8_BAR;
    } else {
        PG8_STAGE(PG8_SB(0, 0), cB, voffB); PG8_STAGE(PG8_SA(0, 0), cA, voffA); PG8_STAGE(PG8_SB(0, 1), cB + hstep, voffB); PG8_STAGE(PG8_SA(0, 1), cA + hstep, voffA);
        if (wr == 1) PG8_BAR;
        PG8_WAIT_V(4); PG8_BAR;
        PG8_STAGE(PG8_SB(1, 0), cB + kstep, voffB); PG8_STAGE(PG8_SA(1, 0), cA + kstep, voffA); PG8_STAGE(PG8_SB(1, 1), cB + hstep + kstep, voffB);
        PG8_WAIT_V(6); PG8_BAR;
    }
    for (;;) {
        const bool has_next = S.next(ui + 1, nxt);
        const char* nA = has_next ? (const char*)g.A + (size_t)nxt.pm * tstep : cA; const char* nB = has_next ? (const char*)g.Bt + (size_t)nxt.pn * tstep : cB;
        for (int t = 0; t < nt; t += 2) {
            const bool last = (t == nt - 2);
            const char* a1 = cA + (size_t)(t + 1) * kstep;
            const char* a2 = last ? nA : cA + (size_t)(t + 2) * kstep; const char* b2 = last ? nB : cB + (size_t)(t + 2) * kstep;
            const char* a3 = a2 + kstep; const char* b3 = b2 + kstep;
            if (last && has_next) S.a_ready(nxt);
            if constexpr (SP2) {
            PG8_LDB(B0, 0, 0); PG8_LDB(B1, 0, 1); PG8_SCHED; PG8_LDA(At, 0, 0); PG8_STAGE(PG8_SA(1, 1), a1 + hstep, voffA);
            PG8_WAIT_V(8); PG8_WAIT_L(0); PG8_BAR; PG8_MMA(0, 0, At, B0); PG8_MMA(0, 1, At, B1); PG8_BAR; PG8_SCHED;
            PG8_LDA(At, 0, 1); PG8_STAGE(PG8_SB(0, 0), b2, voffB); PG8_STAGE(PG8_SB(0, 1), b2 + hstep, voffB); PG8_STAGE(PG8_SA(0, 0), a2, voffA);
            PG8_WAIT_V(8); PG8_WAIT_L(0); PG8_BAR; PG8_MMA(1, 0, At, B0); PG8_MMA(1, 1, At, B1); PG8_BAR; PG8_SCHED;
            PG8_LDB(B0, 1, 0); PG8_LDB(B1, 1, 1); PG8_SCHED; PG8_LDA(At, 1, 0); PG8_STAGE(PG8_SA(0, 1), a2 + hstep, voffA);
            PG8_WAIT_V(8); PG8_WAIT_L(0); PG8_BAR; PG8_MMA(0, 0, At, B0); PG8_MMA(0, 1, At, B1); PG8_BAR; PG8_SCHED;
            PG8_LDA(At, 1, 1); PG8_STAGE(PG8_SB(1, 0), b3, voffB); PG8_STAGE(PG8_SB(1, 1), b3 + hstep, voffB); PG8_STAGE(PG8_SA(1, 0), a3, voffA);
            PG8_WAIT_V(8); PG8_WAIT_L(0); PG8_BAR; PG8_MMA(1, 0, At, B0); PG8_MMA(1, 1, At, B1); PG8_BAR; PG8_SCHED;
            } else {
            PG8_LDB(B0, 0, 0); PG8_SCHED; PG8_LDA(At, 0, 0); PG8_STAGE(PG8_SA(1, 1), a1 + hstep, voffA);
            PG8_WAIT_L(8); PG8_BAR; PG8_WAIT_L(0); PG8_MMA(0, 0, At, B0); PG8_BAR; PG8_SCHED;
            PG8_LDB(B1, 0, 1); PG8_STAGE(PG8_SB(0, 0), b2, voffB);
            PG8_BAR; PG8_WAIT_L(0); PG8_MMA(0, 1, At, B1); PG8_BAR;
            PG8_LDA(At, 0, 1); PG8_STAGE(PG8_SA(0, 0), a2, voffA);
            PG8_BAR; PG8_WAIT_L(0); PG8_MMA(1, 0, At, B0); PG8_BAR; PG8_SCHED;
            PG8_STAGE(PG8_SB(0, 1), b2 + hstep, voffB);
            PG8_WAIT_V(6); PG8_BAR; PG8_MMA(1, 1, At, B1); PG8_BAR;
            PG8_LDB(B0, 1, 0); PG8_SCHED; PG8_LDA(At, 1, 0); PG8_STAGE(PG8_SA(0, 1), a2 + hstep, voffA);
            PG8_WAIT_L(8); PG8_BAR; PG8_WAIT_L(0); PG8_MMA(0, 0, At, B0); PG8_BAR; PG8_SCHED;
            PG8_LDB(B1, 1, 1); PG8_STAGE(PG8_SB(1, 0), b3, voffB);
            PG8_BAR; PG8_WAIT_L(0); PG8_MMA(0, 1, At, B1); PG8_BAR;
            PG8_LDA(At, 1, 1); PG8_STAGE(PG8_SA(1, 0), a3, voffA);
            PG8_BAR; PG8_WAIT_L(0); PG8_MMA(1, 0, At, B0); PG8_BAR; PG8_SCHED;
            PG8_STAGE(PG8_SB(1, 1), b3 + hstep, voffB);
            PG8_WAIT_V(6); PG8_BAR; PG8_MMA(1, 1, At, B1); PG8_BAR;
            }
        }
        if constexpr (ALIGN_EPI) { if (wr == 0) PG8_BAR; }
        if constexpr (!Epi::AFTER_DRAIN) { E(acc, cur, wr, wc, fr, fq); S.done(cur); }
        if (!has_next) break;
#pragma unroll
        for (int a = 0; a < 2; ++a)
#pragma unroll
            for (int b = 0; b < 2; ++b)
#pragma unroll
                for (int m = 0; m < 4; ++m)
#pragma unroll
                    for (int n = 0; n < 2; ++n) acc[a][b][m][n] = (f32x4){0.f, 0.f, 0.f, 0.f};
        cur = nxt; cA = nA; cB = nB; ++ui;
        if constexpr (ALIGN_EPI) { if (wr == 1) PG8_BAR; }
    }
    PG8_WAIT_V(0);
    if constexpr (!ALIGN_EPI) { if (wr == 0) PG8_BAR; }
    PG8_BAR;
    if constexpr (Epi::AFTER_DRAIN) { E.fused(acc, cur, wr, wc, fr, fq, lds, wid, lane); S.done(cur); }
#undef PG8_SA
#undef PG8_SB
#undef PG8_STAGE
#undef PG8_LDA
#undef PG8_LDB
#undef PG8_MMA
#undef PG8_WAIT_V
#undef PG8_WAIT_L
#undef PG8_BAR
#undef PG8_SCHED
}
}

template <int KIND> struct EpiFast {
    static constexpr bool PERM = true, AFTER_DRAIN = false;
    EpiCtx E;
    template <int T, int AI, int MH> __device__ __forceinline__ void grp(const pg8::f32x4 (&acc)[2][2][4][2], int row0, int col0, const float (&rs)[2][4]) const {
        Pre p00, p01, p10, p11;
        p00.rs = p01.rs = rs[AI][2 * MH]; p10.rs = p11.rs = rs[AI][2 * MH + 1];
        const int r0 = row0 + AI * 128 + (2 * MH) * 16, r1 = r0 + 16;
        if constexpr (KIND == EPI_PLE) {
            float s0, s1;
            pre_load<KIND, T>(E, r0, col0, p00); pre_load<KIND, T>(E, r0, col0 + 128, p01);
            pre_load<KIND, T>(E, r1, col0, p10); pre_load<KIND, T>(E, r1, col0 + 128, p11);
            { const pg8::f32x4 v0 = acc[AI][0][2 * MH][0], v1 = acc[AI][0][2 * MH][1]; float v[8] = {v0[0], v0[1], v0[2], v0[3], v1[0], v1[1], v1[2], v1[3]}; s0 = emit_fin<KIND, T>(E, r0, col0, v, p00); }
            { const pg8::f32x4 v0 = acc[AI][1][2 * MH][0], v1 = acc[AI][1][2 * MH][1]; float v[8] = {v0[0], v0[1], v0[2], v0[3], v1[0], v1[1], v1[2], v1[3]}; s0 += emit_fin<KIND, T>(E, r0, col0 + 128, v, p01); }
            { const pg8::f32x4 v0 = acc[AI][0][2 * MH + 1][0], v1 = acc[AI][0][2 * MH + 1][1]; float v[8] = {v0[0], v0[1], v0[2], v0[3], v1[0], v1[1], v1[2], v1[3]}; s1 = emit_fin<KIND, T>(E, r1, col0, v, p10); }
            { const pg8::f32x4 v0 = acc[AI][1][2 * MH + 1][0], v1 = acc[AI][1][2 * MH + 1][1]; float v[8] = {v0[0], v0[1], v0[2], v0[3], v1[0], v1[1], v1[2], v1[3]}; s1 += emit_fin<KIND, T>(E, r1, col0 + 128, v, p11); }
            s0 += __shfl_xor(s0, 16); s0 += __shfl_xor(s0, 32); s1 += __shfl_xor(s1, 16); s1 += __shfl_xor(s1, 32);
            if ((col0 & 31) == 0) { PG8_LAS float* sp = (PG8_LAS float*)E.xin + ((col0 & 255) >> 5); sp[(r0 & 255) * 4] = s0; sp[(r1 & 255) * 4] = s1; }
            asm volatile("" ::: "memory");
            return;
        }
        pre_load<KIND, T>(E, r0, col0, p00); pre_load<KIND, T>(E, r0, col0 + 128, p01); pre_load<KIND, T>(E, r1, col0, p10); pre_load<KIND, T>(E, r1, col0 + 128, p11);
        { const pg8::f32x4 v0 = acc[AI][0][2 * MH][0], v1 = acc[AI][0][2 * MH][1]; float v[8] = {v0[0], v0[1], v0[2], v0[3], v1[0], v1[1], v1[2], v1[3]}; emit_fin<KIND, T>(E, r0, col0, v, p00); }
        { const pg8::f32x4 v0 = acc[AI][1][2 * MH][0], v1 = acc[AI][1][2 * MH][1]; float v[8] = {v0[0], v0[1], v0[2], v0[3], v1[0], v1[1], v1[2], v1[3]}; emit_fin<KIND, T>(E, r0, col0 + 128, v, p01); }
        { const pg8::f32x4 v0 = acc[AI][0][2 * MH + 1][0], v1 = acc[AI][0][2 * MH + 1][1]; float v[8] = {v0[0], v0[1], v0[2], v0[3], v1[0], v1[1], v1[2], v1[3]}; emit_fin<KIND, T>(E, r1, col0, v, p10); }
        { const pg8::f32x4 v0 = acc[AI][1][2 * MH + 1][0], v1 = acc[AI][1][2 * MH + 1][1]; float v[8] = {v0[0], v0[1], v0[2], v0[3], v1[0], v1[1], v1[2], v1[3]}; emit_fin<KIND, T>(E, r1, col0 + 128, v, p11); }
        asm volatile("" ::: "memory");
    }
    template <int T> __device__ __forceinline__ void run(const pg8::f32x4 (&acc)[2][2][4][2], int row0, int col0) const {
        float rs[2][4];
        if constexpr (KIND == EPI_INPROJ || KIND == EPI_GATE || KIND == EPI_GATE3) {
#pragma unroll
            for (int ai = 0; ai < 2; ++ai)
#pragma unroll
                for (int m = 0; m < 4; ++m) rs[ai][m] = row_rstd(E.ws, row0 + ai * 128 + m * 16);
        } else {
#pragma unroll
            for (int ai = 0; ai < 2; ++ai)
#pragma unroll
                for (int m = 0; m < 4; ++m) rs[ai][m] = 1.f; }
        grp<T, 0, 0>(acc, row0, col0, rs); grp<T, 0, 1>(acc, row0, col0, rs); grp<T, 1, 0>(acc, row0, col0, rs); grp<T, 1, 1>(acc, row0, col0, rs);
    }
    __device__ __forceinline__ void operator()(const pg8::f32x4 (&acc)[2][2][4][2], const pg8::Unit& u, int wr, int wc, int fr, int fq) const {
        const int row0 = u.pm * 256 + wr * 64 + fr, col0 = u.pn * 256 + wc * 32 + 8 * fq;
        if constexpr (KIND == EPI_INPROJ) {
            switch (inproj_type(u.pn)) {
                case T_QA: run<T_QA>(acc, row0, col0); break;
                case T_KA: run<T_KA>(acc, row0, col0); break;
                case T_VA: run<T_VA>(acc, row0, col0); break;
                case T_ZA: run<T_ZA>(acc, row0, col0); break;
                case T_QB: run<T_QB>(acc, row0, col0); break;
                case T_CB: run<T_CB>(acc, row0, col0); break;
                case T_KROPE: run<T_KROPE>(acc, row0, col0); break;
                case T_VSW: run<T_VSW>(acc, row0, col0); break;
                case T_ZB: run<T_ZB>(acc, row0, col0); break;
                case T_QC: run<T_QC>(acc, row0, col0); break;
                case T_KC: run<T_KC>(acc, row0, col0); break;
                case T_VC: run<T_VC>(acc, row0, col0); break;
                case T_ZC: run<T_ZC>(acc, row0, col0); break;
                default: run<T_SPECIAL>(acc, row0, col0); break;
            }
        } else if constexpr (KIND == EPI_GATE3 || KIND == EPI_BR3) {
            EpiFast<KIND> t = *this; t.E.gi = u.pn >> 2;
            t.template run<0>(acc, (u.pm & 63) * 256 + wr * 64 + fr, (u.pn & 3) * 256 + wc * 32 + 8 * fq);
        } else run<0>(acc, row0, col0);
    }
};
struct ChainOrder {
    int pm, pn4, rowmul;
    __device__ __forceinline__ void init(int G, int c, int rowmul_) { pg8::StaticOrder S0; S0.init(M, 1024, G, c); pg8::Unit u0; S0.next(0, u0); pm = u0.pm; pn4 = u0.pn; rowmul = rowmul_; }
    __device__ __forceinline__ bool next(int i, pg8::Unit& u) const { if (i >= 3) return false; u.pm = pm + 64 * i * rowmul; u.pn = 4 * i + pn4; return true; }
    __device__ __forceinline__ void a_ready(const pg8::Unit&) const {}
    __device__ __forceinline__ void done(const pg8::Unit&) const {}
};
#define FAST_GEMM(KIND, Aptr, Bptr, N_, K_, ALIGN) do { asm volatile("" : "+s"(ws)); pg8::Gemm g_{(const pg8::bf16_t*)(Aptr), (const pg8::bf16_t*)(Bptr), M, (N_), (K_)}; pg8::StaticOrder S_; S_.init(M, (N_), (int)gridDim.x, (int)blockIdx.x); \
        EpiFast<KIND> Ep_{E}; pg8::gemm_phase<EpiFast<KIND>, pg8::StaticOrder, ALIGN, true>((PG8_LAS unsigned char*)lds, g_, S_, Ep_); } while (0)

#define LAS __attribute__((address_space(3)))
typedef short s16x4 __attribute__((ext_vector_type(4)));
typedef short v4i16_t __attribute__((ext_vector_type(4)));
typedef LAS const char* lds_cptr;
constexpr int A_KRING = 0, A_VRING = 49152, A_CFRING = 98304, A_MISC = 104448;
constexpr int A_SLOT = 16384;
constexpr int A_IMP = A_MISC, A_SELM = A_MISC + 16384, A_UMASK = A_SELM + 512, A_SEQ = A_UMASK + 16, A_WQ = A_SEQ + 80;
__device__ __forceinline__ void glds16(const void* gsrc, unsigned lds_dst) { unsigned keep;
    asm volatile("s_mov_b32 %0, m0\n\ts_mov_b32 m0, %2\n\ts_nop 0\n\tglobal_load_lds_dwordx4 %1, off\n\ts_mov_b32 m0, %0" : "=&s"(keep) : "v"(gsrc), "s"(lds_dst) : "memory"); }
__device__ __forceinline__ void glds4(const void* gsrc, unsigned lds_dst) { unsigned keep;
    asm volatile("s_mov_b32 %0, m0\n\ts_mov_b32 m0, %2\n\ts_nop 0\n\tglobal_load_lds_dword %1, off\n\ts_mov_b32 m0, %0" : "=&s"(keep) : "v"(gsrc), "s"(lds_dst) : "memory"); }
#define A_WAIT_BAR(N) asm volatile("s_waitcnt vmcnt(" #N ") lgkmcnt(0)\n\ts_barrier" ::: "memory")
__device__ __forceinline__ s16x4 vtr(lds_cptr p) { return __builtin_bit_cast(s16x4, __builtin_amdgcn_ds_read_tr16_b64_v4i16((LAS v4i16_t*)p)); }
__device__ __forceinline__ unsigned cvtpk(float lo, float hi) { typedef float f2 __attribute__((ext_vector_type(2))); typedef __bf16 b2 __attribute__((ext_vector_type(2))); f2 v = {lo, hi}; b2 b = __builtin_convertvector(v, b2); return __builtin_bit_cast(unsigned, b); }
__device__ __forceinline__ int crow(int r, int hi) { return (r & 3) + 8 * (r >> 2) + 4 * hi; }

template <int NDB> struct FlashSt { f32x16 o[NDB]; float m, l; };
template <int NDB> __device__ __forceinline__ void flash_init(FlashSt<NDB>& st) {
#pragma unroll
    for (int i = 0; i < NDB; ++i)
#pragma unroll
        for (int r = 0; r < 16; ++r) st.o[i][r] = 0.f;
    st.m = -1e30f; st.l = 0.f;
}
template <int NDB> __device__ __forceinline__ void flash_init3(FlashSt<NDB>& st) { flash_init<NDB>(st); st.m = 0.f; }
__device__ __forceinline__ void qk_tile(f32x16& p0, f32x16& p1, lds_cptr kslot, const bf16x8 (&qf)[4], int r32, int hi) {
    const lds_cptr kb = kslot + hi * 1024 + r32 * 16;
    bf16x8 ka[4], kc[4];
#pragma unroll
    for (int d0 = 0; d0 < 4; ++d0) { ka[d0] = *(const LAS bf16x8*)(kb + d0 * 2048); kc[d0] = *(const LAS bf16x8*)(kb + d0 * 2048 + 512); }
#pragma unroll
    for (int d0 = 0; d0 < 4; ++d0) {
        p0 = __builtin_amdgcn_mfma_f32_32x32x16_bf16(ka[d0], qf[d0], p0, 0, 0, 0);
        p1 = __builtin_amdgcn_mfma_f32_32x32x16_bf16(kc[d0], qf[d0], p1, 0, 0, 0);
    }
}
__device__ __forceinline__ float xhalf_max(float a) {
    auto rr = __builtin_amdgcn_permlane32_swap(__float_as_uint(a), __float_as_uint(a), false, false);
    return fmaxf(__uint_as_float(rr[0]), __uint_as_float(rr[1]));
}
__device__ __forceinline__ float rowmax32(const f32x16& p0, const f32x16& p1) {
    float a = fmaxf(p0[0], p1[0]);
#pragma unroll
    for (int r = 1; r < 16; ++r) a = fmaxf(a, fmaxf(p0[r], p1[r]));
    return xhalf_max(a);
}
template <int NDB> __device__ __forceinline__ void pv_tile(f32x16 (&o)[NDB], lds_cptr vslot_l, const f32x16& p0, const f32x16& p1) {
    bf16x8 pf[4];
    { u32x4 w;
      w.x = cvtpk(p0[0], p0[1]); w.y = cvtpk(p0[2], p0[3]); w.z = cvtpk(p0[4], p0[5]); w.w = cvtpk(p0[6], p0[7]); pf[0] = __builtin_bit_cast(bf16x8, w);
      w.x = cvtpk(p0[8], p0[9]); w.y = cvtpk(p0[10], p0[11]); w.z = cvtpk(p0[12], p0[13]); w.w = cvtpk(p0[14], p0[15]); pf[1] = __builtin_bit_cast(bf16x8, w);
      w.x = cvtpk(p1[0], p1[1]); w.y = cvtpk(p1[2], p1[3]); w.z = cvtpk(p1[4], p1[5]); w.w = cvtpk(p1[6], p1[7]); pf[2] = __builtin_bit_cast(bf16x8, w);
      w.x = cvtpk(p1[8], p1[9]); w.y = cvtpk(p1[10], p1[11]); w.z = cvtpk(p1[12], p1[13]); w.w = cvtpk(p1[14], p1[15]); pf[3] = __builtin_bit_cast(bf16x8, w); }
#pragma unroll
    for (int db = 0; db < NDB; ++db) {
        bf16x8 vf[4];
#pragma unroll
        for (int ks = 0; ks < 4; ++ks) { const s16x4 lo = vtr(vslot_l + db * 4096 + ks * 1024), hh = vtr(vslot_l + db * 4096 + ks * 1024 + 512);
            vf[ks] = (bf16x8){lo[0], lo[1], lo[2], lo[3], hh[0], hh[1], hh[2], hh[3]}; }
#pragma unroll
        for (int ks = 0; ks < 4; ++ks) o[db] = __builtin_amdgcn_mfma_f32_32x32x16_bf16(vf[ks], pf[ks], o[db], 0, 0, 0);
    }
}
template <int NDB> __device__ __forceinline__ void flash_update(FlashSt<NDB>& st, f32x16& p0, f32x16& p1, lds_cptr vslot_l) {
    const float rm = rowmax32(p0, p1);
    const float mn = fmaxf(st.m, rm), alpha = __builtin_amdgcn_exp2f(st.m - mn);
    st.m = mn;
    float ls = 0.f;
#pragma unroll
    for (int r = 0; r < 16; ++r) { p0[r] = __builtin_amdgcn_exp2f(p0[r] - mn); p1[r] = __builtin_amdgcn_exp2f(p1[r] - mn); ls += p0[r] + p1[r]; }
    st.l = st.l * alpha + ls;
#pragma unroll
    for (int db = 0; db < NDB; ++db)
#pragma unroll
        for (int r = 0; r < 16; ++r) st.o[db][r] *= alpha;
    pv_tile<NDB>(st.o, vslot_l, p0, p1);
}
__device__ __forceinline__ int lane_vbase(int lane) { return ((lane >> 4) & 1) * 32 + (lane & 3) * 8 + (4 * (lane >> 5) + ((lane & 15) >> 2)) * 64; }
#define DSR128(dst, addr, off) asm volatile("ds_read_b128 %0, %1 offset:%c2" : "=v"(dst) : "v"(addr), "i"(off) : "memory")
#define DSRTR(dst, addr, off) asm volatile("ds_read_b64_tr_b16 %0, %1 offset:%c2" : "=v"(dst) : "v"(addr), "i"(off) : "memory")
#define LGKM_WAIT0() do { asm volatile("s_waitcnt lgkmcnt(0)" ::: "memory"); __builtin_amdgcn_sched_barrier(0); } while (0)
__device__ __forceinline__ void qk_tile2(f32x16& p0, f32x16& p1, unsigned kaddr, const bf16x8 (&qf)[4]) {
    bf16x8 ka0, ka1, ka2, ka3, kc0, kc1, kc2, kc3;
    DSR128(ka0, kaddr, 0); DSR128(kc0, kaddr, 512); DSR128(ka1, kaddr, 2048); DSR128(kc1, kaddr, 2560);
    DSR128(ka2, kaddr, 4096); DSR128(kc2, kaddr, 4608); DSR128(ka3, kaddr, 6144); DSR128(kc3, kaddr, 6656);
    LGKM_WAIT0();
    __builtin_amdgcn_s_setprio(1);
    p0 = __builtin_amdgcn_mfma_f32_32x32x16_bf16(ka0, qf[0], p0, 0, 0, 0); p1 = __builtin_amdgcn_mfma_f32_32x32x16_bf16(kc0, qf[0], p1, 0, 0, 0);
    p0 = __builtin_amdgcn_mfma_f32_32x32x16_bf16(ka1, qf[1], p0, 0, 0, 0); p1 = __builtin_amdgcn_mfma_f32_32x32x16_bf16(kc1, qf[1], p1, 0, 0, 0);
    p0 = __builtin_amdgcn_mfma_f32_32x32x16_bf16(ka2, qf[2], p0, 0, 0, 0); p1 = __builtin_amdgcn_mfma_f32_32x32x16_bf16(kc2, qf[2], p1, 0, 0, 0);
    p0 = __builtin_amdgcn_mfma_f32_32x32x16_bf16(ka3, qf[3], p0, 0, 0, 0); p1 = __builtin_amdgcn_mfma_f32_32x32x16_bf16(kc3, qf[3], p1, 0, 0, 0);
    __builtin_amdgcn_s_setprio(0);
}
struct VFr { s16x4 lo[8], hi[8]; };
template <int DB0> __device__ __forceinline__ void v_issue(VFr& f, unsigned vaddr) {
    DSRTR(f.lo[0], vaddr, DB0 * 4096 + 0);    DSRTR(f.hi[0], vaddr, DB0 * 4096 + 512);
    DSRTR(f.lo[1], vaddr, DB0 * 4096 + 1024); DSRTR(f.hi[1], vaddr, DB0 * 4096 + 1536);
    DSRTR(f.lo[2], vaddr, DB0 * 4096 + 2048); DSRTR(f.hi[2], vaddr, DB0 * 4096 + 2560);
    DSRTR(f.lo[3], vaddr, DB0 * 4096 + 3072); DSRTR(f.hi[3], vaddr, DB0 * 4096 + 3584);
    DSRTR(f.lo[4], vaddr, DB0 * 4096 + 4096); DSRTR(f.hi[4], vaddr, DB0 * 4096 + 4608);
    DSRTR(f.lo[5], vaddr, DB0 * 4096 + 5120); DSRTR(f.hi[5], vaddr, DB0 * 4096 + 5632);
    DSRTR(f.lo[6], vaddr, DB0 * 4096 + 6144); DSRTR(f.hi[6], vaddr, DB0 * 4096 + 6656);
    DSRTR(f.lo[7], vaddr, DB0 * 4096 + 7168); DSRTR(f.hi[7], vaddr, DB0 * 4096 + 7680);
}
#define VFRAG(f, i) ((bf16x8){(f).lo[i][0], (f).lo[i][1], (f).lo[i][2], (f).lo[i][3], (f).hi[i][0], (f).hi[i][1], (f).hi[i][2], (f).hi[i][3]})
__device__ __forceinline__ void pv2(f32x16& oa, f32x16& ob, const VFr& f, const bf16x8 (&pf)[4]) {
    __builtin_amdgcn_s_setprio(1);
    oa = __builtin_amdgcn_mfma_f32_32x32x16_bf16(VFRAG(f, 0), pf[0], oa, 0, 0, 0); ob = __builtin_amdgcn_mfma_f32_32x32x16_bf16(VFRAG(f, 4), pf[0], ob, 0, 0, 0);
    oa = __builtin_amdgcn_mfma_f32_32x32x16_bf16(VFRAG(f, 1), pf[1], oa, 0, 0, 0); ob = __builtin_amdgcn_mfma_f32_32x32x16_bf16(VFRAG(f, 5), pf[1], ob, 0, 0, 0);
    oa = __builtin_amdgcn_mfma_f32_32x32x16_bf16(VFRAG(f, 2), pf[2], oa, 0, 0, 0); ob = __builtin_amdgcn_mfma_f32_32x32x16_bf16(VFRAG(f, 6), pf[2], ob, 0, 0, 0);
    oa = __builtin_amdgcn_mfma_f32_32x32x16_bf16(VFRAG(f, 3), pf[3], oa, 0, 0, 0); ob = __builtin_amdgcn_mfma_f32_32x32x16_bf16(VFRAG(f, 7), pf[3], ob, 0, 0, 0);
    __builtin_amdgcn_s_setprio(0);
}
__device__ __forceinline__ void pack_p(bf16x8 (&pf)[4], const f32x16& p0, const f32x16& p1) {
    u32x4 w;
    w.x = cvtpk(p0[0], p0[1]); w.y = cvtpk(p0[2], p0[3]); w.z = cvtpk(p0[4], p0[5]); w.w = cvtpk(p0[6], p0[7]); pf[0] = __builtin_bit_cast(bf16x8, w);
    w.x = cvtpk(p0[8], p0[9]); w.y = cvtpk(p0[10], p0[11]); w.z = cvtpk(p0[12], p0[13]); w.w = cvtpk(p0[14], p0[15]); pf[1] = __builtin_bit_cast(bf16x8, w);
    w.x = cvtpk(p1[0], p1[1]); w.y = cvtpk(p1[2], p1[3]); w.z = cvtpk(p1[4], p1[5]); w.w = cvtpk(p1[6], p1[7]); pf[2] = __builtin_bit_cast(bf16x8, w);
    w.x = cvtpk(p1[8], p1[9]); w.y = cvtpk(p1[10], p1[11]); w.z = cvtpk(p1[12], p1[13]); w.w = cvtpk(p1[14], p1[15]); pf[3] = __builtin_bit_cast(bf16x8, w);
}
template <int NDB> __device__ __forceinline__ void flash_update2(FlashSt<NDB>& st, f32x16& p0, f32x16& p1, unsigned vaddr) {
    VFr vf; v_issue<0>(vf, vaddr);
    const float rm = rowmax32(p0, p1);
    const float mn = fmaxf(st.m, rm), alpha = __builtin_amdgcn_exp2f(st.m - mn);
    st.m = mn;
    float ls = 0.f;
#pragma unroll
    for (int r = 0; r < 16; ++r) { p0[r] = __builtin_amdgcn_exp2f(p0[r] - mn); p1[r] = __builtin_amdgcn_exp2f(p1[r] - mn); ls += p0[r] + p1[r]; }
    st.l = st.l * alpha + ls;
#pragma unroll
    for (int db = 0; db < NDB; ++db)
#pragma unroll
        for (int r = 0; r < 16; ++r) st.o[db][r] *= alpha;
    bf16x8 pf[4]; pack_p(pf, p0, p1);
    LGKM_WAIT0();
    pv2(st.o[0], st.o[1], vf, pf);
    if constexpr (NDB == 4) { v_issue<2>(vf, vaddr); LGKM_WAIT0(); pv2(st.o[2], st.o[3], vf, pf); }
}
__device__ __forceinline__ float max3_(float a, float b, float c) { float r; asm("v_max3_f32 %0, %1, %2, %3" : "=v"(r) : "v"(a), "v"(b), "v"(c)); return r; }
__device__ __forceinline__ float rowmax32_asm(const f32x16& p0, const f32x16& p1) {
    float a = max3_(p0[0], p0[1], p1[0]), b = max3_(p0[2], p0[3], p1[1]); a = max3_(a, p1[2], p1[3]);
#pragma unroll
    for (int r = 4; r < 16; r += 4) { a = max3_(a, p0[r], p0[r + 1]); b = max3_(b, p0[r + 2], p0[r + 3]); a = max3_(a, p1[r], p1[r + 1]); b = max3_(b, p1[r + 2], p1[r + 3]); }
    float m; asm("v_max_f32_e32 %0, %1, %2" : "=v"(m) : "v"(a), "v"(b));
    auto rr = __builtin_amdgcn_permlane32_swap(__float_as_uint(m), __float_as_uint(m), false, false);
    float o; asm("v_max_f32_e32 %0, %1, %2" : "=v"(o) : "v"(__uint_as_float(rr[0])), "v"(__uint_as_float(rr[1]))); return o;
}
constexpr float FA_THR = 8.f;
template <int NDB> __device__ __forceinline__ bool flash_update3(FlashSt<NDB>& st, f32x16& p0, f32x16& p1, unsigned vaddr) {
    VFr vf; v_issue<0>(vf, vaddr);
    asm volatile("s_nop 15\n\ts_nop 7" : "+v"(p0), "+v"(p1));
    const float rm = rowmax32_asm(p0, p1);
    bool moved = false;
    if (__builtin_expect(__builtin_amdgcn_ballot_w64(rm > FA_THR) != 0ull, 0)) {
        const float dl = fmaxf(rm, 0.f), f = __builtin_amdgcn_exp2f(-dl);
        st.m += dl; st.l *= f;
#pragma unroll
        for (int r = 0; r < 16; ++r) { p0[r] -= dl; p1[r] -= dl; }
#pragma unroll
        for (int db = 0; db < NDB; ++db)
#pragma unroll
            for (int r = 0; r < 16; ++r) st.o[db][r] *= f;
        moved = true;
    }
    float ls = 0.f;
#pragma unroll
    for (int r = 0; r < 16; ++r) { p0[r] = __builtin_amdgcn_exp2f(p0[r]); p1[r] = __builtin_amdgcn_exp2f(p1[r]); ls += p0[r] + p1[r]; }
    st.l += ls;
    bf16x8 pf[4]; pack_p(pf, p0, p1);
    LGKM_WAIT0();
    pv2(st.o[0], st.o[1], vf, pf);
    if constexpr (NDB == 4) { v_issue<2>(vf, vaddr); LGKM_WAIT0(); pv2(st.o[2], st.o[3], vf, pf); }
    return moved;
}
__device__ __forceinline__ void pv_only2(f32x16 (&o)[2], unsigned vaddr, const f32x16& p0, const f32x16& p1) {
    VFr vf; v_issue<0>(vf, vaddr); bf16x8 pf[4]; pack_p(pf, p0, p1); LGKM_WAIT0(); pv2(o[0], o[1], vf, pf);
}

__device__ __forceinline__ void fox_unit(unsigned char* lds, unsigned char* ws, int bh, int qb, int dry = 0) {
    asm volatile("" : "+s"(ws));
    int tid_o = threadIdx.x; asm volatile("" : "+v"(tid_o));
    const int tid = tid_o, lane = tid & 63, wid = __builtin_amdgcn_readfirstlane(tid >> 6), r32 = lane & 31, hi = lane >> 5;
    const unsigned lds0 = (unsigned)(uintptr_t)lds;
    const lds_cptr L = (lds_cptr)lds;
    const int qrow = 256 * qb + 32 * wid + r32, wrow0 = 256 * qb + 32 * wid;
    const int NTl = 4 * (qb + 1);
    const char* Kg = (const char*)(ws + OFF_KA) + (size_t)bh * 524288 + wid * 1024 + lane * 16;
    const char* Vg = (const char*)(ws + OFF_VA) + (size_t)bh * 524288 + wid * 1024 + lane * 16;
    const char* Cg = (const char*)(ws + OFF_CF) + (size_t)bh * 16384 + lane * 4;
    const unsigned kdst = (unsigned)__builtin_amdgcn_readfirstlane(lds0 + A_KRING + wid * 1024), vdst = (unsigned)__builtin_amdgcn_readfirstlane(lds0 + A_VRING + wid * 1024),
                   cdst = (unsigned)__builtin_amdgcn_readfirstlane(lds0 + A_CFRING + wid * 256);
#define FOX_DMA(t, slot) do { glds16(Kg + (size_t)(t) * 8192, kdst + (slot) * A_SLOT); glds16(Vg + (size_t)(t) * 8192, vdst + (slot) * A_SLOT); glds4(Cg + (size_t)(t) * 256, cdst + (slot) * 2048); } while (0)
    asm volatile("s_waitcnt vmcnt(0)" ::: "memory");
    FOX_DMA(0, 0); FOX_DMA(1, 1);
    bf16x8 qf[4];
    { const bf16* Q = (const bf16*)(ws + OFF_QA) + ((size_t)bh * 4096 + qrow) * 64 + 8 * hi;
#pragma unroll
      for (int d0 = 0; d0 < 4; ++d0) qf[d0] = *(const bf16x8*)(Q + 16 * d0); }
    FlashSt<2> st; flash_init3<2>(st);
    const int vb = lane_vbase(lane);
    const unsigned kaddr0 = lds0 + A_KRING + hi * 1024 + r32 * 16, vaddr0 = lds0 + A_VRING + vb;
    asm volatile("" : "+v"(qf[0]), "+v"(qf[1]), "+v"(qf[2]), "+v"(qf[3]));
    asm volatile("s_waitcnt vmcnt(0)" ::: "memory");
    asm volatile("s_barrier" ::: "memory");
    int slot = 0;
    for (int t = 0; t < NTl; ++t) {
        const int s2 = (slot >= 1) ? slot - 1 : 2;
        if (t + 2 < NTl) FOX_DMA(t + 2, s2);
        if (64 * t <= wrow0 + 31 && dry != 4) {
            f32x16 p0, p1;
            { const unsigned ca = lds0 + A_CFRING + slot * 2048 + wid * 256 + 16 * hi; f32x4 c0, c1, c2, c3, c4, c5, c6, c7;
              DSR128(c0, ca, 0); DSR128(c1, ca, 32); DSR128(c2, ca, 64); DSR128(c3, ca, 96); DSR128(c4, ca, 128); DSR128(c5, ca, 160); DSR128(c6, ca, 192); DSR128(c7, ca, 224);
              LGKM_WAIT0();
              p0 = __builtin_shufflevector(__builtin_shufflevector(c0, c1, 0, 1, 2, 3, 4, 5, 6, 7), __builtin_shufflevector(c2, c3, 0, 1, 2, 3, 4, 5, 6, 7), 0, 1, 2, 3, 4, 5, 6, 7, 8, 9, 10, 11, 12, 13, 14, 15);
              p1 = __builtin_shufflevector(__builtin_shufflevector(c4, c5, 0, 1, 2, 3, 4, 5, 6, 7), __builtin_shufflevector(c6, c7, 0, 1, 2, 3, 4, 5, 6, 7), 0, 1, 2, 3, 4, 5, 6, 7, 8, 9, 10, 11, 12, 13, 14, 15);
              p0 = p0 - st.m; p1 = p1 - st.m; }
            qk_tile2(p0, p1, kaddr0 + slot * A_SLOT, qf);
            if (64 * t + 63 > wrow0) {
                const int kb = 64 * t + 4 * hi;
#pragma unroll
                for (int r = 0; r < 16; ++r) { const int kv = kb + (r & 3) + 8 * (r >> 2); if (kv > qrow) p0[r] = -INFINITY; if (kv + 32 > qrow) p1[r] = -INFINITY; }
            }
            if (dry != 3) (void)flash_update3<2>(st, p0, p1, vaddr0 + slot * A_SLOT); else { st.o[0] += p0; st.o[1] += p1; }
        }
        if (dry == 2) { asm volatile("s_waitcnt lgkmcnt(0)\n\ts_barrier" ::: "memory"); } else if (t + 2 < NTl) { A_WAIT_BAR(3); } else { A_WAIT_BAR(0); }
        slot = (slot == 2) ? 0 : slot + 1;
    }
#undef FOX_DMA
    const float lt = st.l + __shfl_xor(st.l, 32), il = 1.f / lt;
    const int b = bh >> 3, h = bh & 7;
    bf16* Y = (bf16*)(ws + OFF_ZA) + (size_t)(b * 4096 + qrow) * 512 + h * 64;
    bf16* Yd = dry ? (bf16*)(ws + OFF_SELM) + (tid * 64) : Y;
#pragma unroll
    for (int db = 0; db < 2; ++db)
#pragma unroll
        for (int rq = 0; rq < 4; ++rq) { bf16* yp = Y + 32 * db + 8 * rq + 4 * hi; bf16* yo = Yd + 32 * db + 8 * rq + 4 * hi; const u32x2 z = *(const u32x2*)yp;
            const float z0 = __uint_as_float(z.x << 16), z1 = __uint_as_float(z.x & 0xffff0000u), z2 = __uint_as_float(z.y << 16), z3 = __uint_as_float(z.y & 0xffff0000u);
            u32x2 o; o.x = pk2(st.o[db][4 * rq] * il * z0, st.o[db][4 * rq + 1] * il * z1); o.y = pk2(st.o[db][4 * rq + 2] * il * z2, st.o[db][4 * rq + 3] * il * z3);
            *(u32x2*)yo = o; }
}

__device__ __forceinline__ void diff_unit(unsigned char* lds, unsigned char* ws, int bhc, int qb, const float* subg, float lam, float lam_init, bool dry = false) {
    asm volatile("" : "+s"(ws));
    int tid_o = threadIdx.x; asm volatile("" : "+v"(tid_o));
    const int tid = tid_o, lane = tid & 63, wid = __builtin_amdgcn_readfirstlane(tid >> 6), r32 = lane & 31, hi = lane >> 5;
    const int map = wid >> 2, wl = wid & 3;
    const unsigned lds0 = (unsigned)(uintptr_t)lds;
    const lds_cptr L = (lds_cptr)lds;
    const int b = bhc >> 2, hc = bhc & 3;
    const int qrow = 128 * qb + 32 * wl + r32, wrow0 = 128 * qb + 32 * wl;
    const int NTl = 2 * (qb + 1);
    const char* Kg = (const char*)(ws + OFF_KC) + (size_t)(b * 8 + hc * 2) * 524288 + wid * 1024 + lane * 16;
    const char* Vg = (const char*)(ws + OFF_VC) + (size_t)bhc * 1048576 + wid * 1024 + lane * 16;
    const unsigned kdst = (unsigned)__builtin_amdgcn_readfirstlane(lds0 + A_KRING + wid * 1024), vdst = (unsigned)__builtin_amdgcn_readfirstlane(lds0 + A_VRING + wid * 1024);
#define DIFF_DMA(t, slot) do { glds16(Kg + (size_t)(t) * 8192, kdst + (slot) * A_SLOT); glds16(Kg + 524288 + (size_t)(t) * 8192, kdst + (slot) * A_SLOT + 8192); \
        glds16(Vg + (size_t)(t) * 16384, vdst + (slot) * A_SLOT); glds16(Vg + (size_t)(t) * 16384 + 8192, vdst + (slot) * A_SLOT + 8192); } while (0)
    asm volatile("s_waitcnt vmcnt(0)" ::: "memory");
    DIFF_DMA(0, 0); DIFF_DMA(1, 1);
    bf16x8 qf[4];
    { const bf16* Q = (const bf16*)(ws + OFF_QC) + ((size_t)(b * 8 + hc * 2 + map) * 4096 + qrow) * 64 + 8 * hi;
#pragma unroll
      for (int d0 = 0; d0 < 4; ++d0) qf[d0] = *(const bf16x8*)(Q + 16 * d0); }
    FlashSt<4> st; flash_init3<4>(st);
    f32x16 negm;
#pragma unroll
    for (int r = 0; r < 16; ++r) negm[r] = 0.f;
    const int vb = lane_vbase(lane);
    const unsigned kaddr0 = lds0 + A_KRING + map * 8192 + hi * 1024 + r32 * 16, vaddr0 = lds0 + A_VRING + vb;
    asm volatile("" : "+v"(qf[0]), "+v"(qf[1]), "+v"(qf[2]), "+v"(qf[3]));
    asm volatile("s_waitcnt vmcnt(0)" ::: "memory");
    asm volatile("s_barrier" ::: "memory");
    int slot = 0;
    for (int t = 0; t < NTl; ++t) {
        const int s2 = (slot >= 1) ? slot - 1 : 2;
        if (t + 2 < NTl) DIFF_DMA(t + 2, s2);
        if (64 * t <= wrow0 + 31) {
            f32x16 p0 = negm, p1 = negm;
            qk_tile2(p0, p1, kaddr0 + slot * A_SLOT, qf);
            if (64 * t + 63 > wrow0) {
                const int kb = 64 * t + 4 * hi;
#pragma unroll
                for (int r = 0; r < 16; ++r) { const int kv = kb + (r & 3) + 8 * (r >> 2); if (kv > qrow) p0[r] = -INFINITY; if (kv + 32 > qrow) p1[r] = -INFINITY; }
            }
            if (flash_update3<4>(st, p0, p1, vaddr0 + slot * A_SLOT)) {
#pragma unroll
                for (int r = 0; r < 16; ++r) negm[r] = -st.m; }
        }
        if (t + 2 < NTl) { A_WAIT_BAR(4); } else { A_WAIT_BAR(0); }
        slot = (slot == 2) ? 0 : slot + 1;
    }
#undef DIFF_DMA
    const float lt = st.l + __shfl_xor(st.l, 32), il = 1.f / lt;
    LAS float* stage = (LAS float*)lds + wl * 4096 + r32;
    if (map == 1) {
#pragma unroll
        for (int db = 0; db < 4; ++db)
#pragma unroll
            for (int r = 0; r < 16; ++r) stage[(32 * db + crow(r, hi)) * 32] = st.o[db][r] * il;
    }
    asm volatile("s_waitcnt lgkmcnt(0)\n\ts_barrier" ::: "memory");
    if (map == 0) {
        float ss = 0.f;
#pragma unroll
        for (int db = 0; db < 4; ++db)
#pragma unroll
            for (int r = 0; r < 16; ++r) { const float v = st.o[db][r] * il - lam * stage[(32 * db + crow(r, hi)) * 32]; st.o[db][r] = v; ss += v * v; }
        ss += __shfl_xor(ss, 32);
        const float rs = rsqrtf(ss * (1.f / 128.f) + EPS) * (1.f - lam_init);
        bf16* Y = (bf16*)(ws + OFF_ZC) + (size_t)(b * 4096 + qrow) * 512 + hc * 128;
        bf16* Yd = dry ? (bf16*)(ws + OFF_SELM) + (tid * 128) : Y;
#pragma unroll
        for (int db = 0; db < 4; ++db)
#pragma unroll
            for (int rq = 0; rq < 4; ++rq) { const int d = 32 * db + 8 * rq + 4 * hi; bf16* yp = Y + d; bf16* yo = Yd + d; const u32x2 z = *(const u32x2*)yp; const f32x4 g = *(const f32x4*)(subg + d);
                const float z0 = __uint_as_float(z.x << 16), z1 = __uint_as_float(z.x & 0xffff0000u), z2 = __uint_as_float(z.y << 16), z3 = __uint_as_float(z.y & 0xffff0000u);
                u32x2 o; o.x = pk2(st.o[db][4 * rq] * rs * g[0] * z0, st.o[db][4 * rq + 1] * rs * g[1] * z1); o.y = pk2(st.o[db][4 * rq + 2] * rs * g[2] * z2, st.o[db][4 * rq + 3] * rs * g[3] * z3);
                *(u32x2*)yo = o; }
    }
    asm volatile("s_waitcnt lgkmcnt(0)\n\ts_barrier" ::: "memory");
}

constexpr int N_IMP = A_MISC, N_SELM = N_IMP + 64 * 65 * 4, N_UMASK = N_SELM + 512, N_SEQC = N_UMASK + 16, N_SEQD = N_SEQC + 80, N_CNT = N_SEQD + 16;
template <int MODE> __device__ __forceinline__ void nsa_ring(FlashSt<2>& st, unsigned char* lds, const char* Kg, const char* Vg, unsigned kdst, unsigned vdst, int n, int seqoff,
                                                             const bf16x8 (&qf)[4], int tb, int qloc, unsigned selLo, unsigned selHi, int r32, int hi, int vb) {
    const lds_cptr L = (lds_cptr)lds;
    const LAS unsigned char* seq = (const LAS unsigned char*)(L + seqoff);
    const unsigned lds0r = (unsigned)(uintptr_t)lds;
#define NSA_DMA(j, slot) do { glds16(Kg + (size_t)(j) * 8192, kdst + (slot) * A_SLOT); glds16(Vg + (size_t)(j) * 8192, vdst + (slot) * A_SLOT); } while (0)
    asm volatile("s_waitcnt vmcnt(0)" ::: "memory");
    { const int j0 = __builtin_amdgcn_readfirstlane((int)seq[0]); NSA_DMA(j0, 0); if (n > 1) { const int j1 = __builtin_amdgcn_readfirstlane((int)seq[1]); NSA_DMA(j1, 1); } }
    A_WAIT_BAR(0);
    int slot = 0;
    f32x16 negm;
#pragma unroll
    for (int r = 0; r < 16; ++r) negm[r] = 0.f;
    for (int i = 0; i < n; ++i) {
        const int s2 = (slot >= 1) ? slot - 1 : 2;
        if (i + 2 < n) { const int j2 = __builtin_amdgcn_readfirstlane((int)seq[i + 2]); NSA_DMA(j2, s2); }
        const int j = __builtin_amdgcn_readfirstlane((int)seq[i]);
        f32x16 p0 = negm, p1 = negm;
        qk_tile2(p0, p1, lds0r + A_KRING + hi * 1024 + r32 * 16 + slot * A_SLOT, qf);
        if (j == tb) {
#pragma unroll
            for (int r = 0; r < 16; ++r) { const int kv = 4 * hi + (r & 3) + 8 * (r >> 2); if (kv > qloc) p0[r] = -INFINITY; if (kv + 32 > qloc) p1[r] = -INFINITY; }
        } else if (MODE == 0) {
            const bool sel = (((j < 32) ? (selLo >> j) : (selHi >> (j - 32))) & 1u) != 0u;
            if (!sel) {
#pragma unroll
                for (int r = 0; r < 16; ++r) { p0[r] = -INFINITY; p1[r] = -INFINITY; } }
        } else if (j == tb - 8) {
#pragma unroll
            for (int r = 0; r < 16; ++r) { const int kv = 4 * hi + (r & 3) + 8 * (r >> 2); if (kv <= qloc) p0[r] = -INFINITY; if (kv + 32 <= qloc) p1[r] = -INFINITY; }
        }
        if (flash_update3<2>(st, p0, p1, lds0r + A_VRING + vb + slot * A_SLOT)) {
#pragma unroll
            for (int r = 0; r < 16; ++r) negm[r] = -st.m; }
        if (i + 2 < n) { A_WAIT_BAR(2); } else { A_WAIT_BAR(0); }
        slot = (slot == 2) ? 0 : slot + 1;
    }
#undef NSA_DMA
}
__device__ __forceinline__ void nsa_unit(unsigned char* lds, unsigned char* ws, int bg, int tb, bool dry = false) {
    asm volatile("" : "+s"(ws));
    int tid_o = threadIdx.x; asm volatile("" : "+v"(tid_o));
    const int tid = tid_o, lane = tid & 63, wid = __builtin_amdgcn_readfirstlane(tid >> 6), r32 = lane & 31, hi = lane >> 5;
    const unsigned lds0 = (unsigned)(uintptr_t)lds;
    const lds_cptr L = (lds_cptr)lds;
    const int b = bg >> 1, g = bg & 1, h = 4 * g + (wid >> 1), qloc = 32 * (wid & 1) + r32, t = 64 * tb + qloc, row = b * 4096 + t;
    const unsigned kdst = (unsigned)__builtin_amdgcn_readfirstlane(lds0 + A_KRING + wid * 1024), vdst = (unsigned)__builtin_amdgcn_readfirstlane(lds0 + A_VRING + wid * 1024);
    const int vb = lane_vbase(lane);
    LAS float* imp = (LAS float*)(L + N_IMP);
    LAS unsigned* selm = (LAS unsigned*)(L + N_SELM);
    LAS unsigned* umask = (LAS unsigned*)(L + N_UMASK);
    const int nvmax = 4 * tb + 3, nct = (nvmax + 63) >> 6;
    for (int i = tid; i < 64 * 65; i += 512) imp[i] = 0.f;
    if (tid < 128) selm[tid] = 0u;
    if (tid < 2) umask[tid] = 0u;
    asm volatile("s_waitcnt vmcnt(0)" ::: "memory");
    { const char* Kc = (const char*)(ws + OFF_KCMP) + (size_t)bg * 32768 + wid * 1024 + lane * 16; const char* Vc = (const char*)(ws + OFF_VCMP) + (size_t)bg * 32768 + wid * 1024 + lane * 16;
      for (int ct = 0; ct < nct; ++ct) { glds16(Kc + ct * 8192, kdst + ct * 8192); glds16(Vc + ct * 8192, vdst + ct * 8192); } }
    bf16x8 qf[4];
    const bf16* Qp = (const bf16*)(ws + OFF_QB) + ((size_t)(b * 8 + h) * 4096 + t) * 64 + 8 * hi;
#pragma unroll
    for (int d0 = 0; d0 < 4; ++d0) qf[d0] = *(const bf16x8*)(Qp + 16 * d0);
    const float* gt = (const float*)(ws + OFF_GATES) + (size_t)row * 24 + (h & 7) * 3;
    float g0 = gt[0], g1 = gt[1], g2 = gt[2];
    asm volatile("" : "+v"(qf[0]), "+v"(qf[1]), "+v"(qf[2]), "+v"(qf[3]), "+v"(g0), "+v"(g1), "+v"(g2));
    A_WAIT_BAR(0);
    const int nv = (t >= 31) ? ((t - 31) >> 4) + 1 : 0;
    f32x16 y[2];
    {
        float m = -1e30f, l = 0.f;
        for (int ct = 0; ct < nct; ++ct) {
            f32x16 p0, p1;
#pragma unroll
            for (int r = 0; r < 16; ++r) { p0[r] = 0.f; p1[r] = 0.f; }
            qk_tile2(p0, p1, lds0 + A_KRING + hi * 1024 + r32 * 16 + ct * 8192, qf);
            const int cb = 64 * ct + 4 * hi;
#pragma unroll
            for (int r = 0; r < 16; ++r) { const int c = cb + (r & 3) + 8 * (r >> 2); if (c >= nv) p0[r] = -INFINITY; if (c + 32 >= nv) p1[r] = -INFINITY; }
            const float rm = rowmax32(p0, p1), mn = fmaxf(m, rm);
            float ls = 0.f;
#pragma unroll
            for (int r = 0; r < 16; ++r) ls += __builtin_amdgcn_exp2f(p0[r] - mn) + __builtin_amdgcn_exp2f(p1[r] - mn);
            l = l * __builtin_amdgcn_exp2f(m - mn) + ls; m = mn;
        }
        const float lt = l + __shfl_xor(l, 32), il = lt > 0.f ? 1.f / lt : 0.f;
        f32x16 oc[2];
#pragma unroll
        for (int r = 0; r < 16; ++r) { oc[0][r] = 0.f; oc[1][r] = 0.f; }
        for (int ct = 0; ct < nct; ++ct) {
            f32x16 p0, p1;
#pragma unroll
            for (int r = 0; r < 16; ++r) { p0[r] = 0.f; p1[r] = 0.f; }
            qk_tile2(p0, p1, lds0 + A_KRING + hi * 1024 + r32 * 16 + ct * 8192, qf);
            const int cb = 64 * ct + 4 * hi;
#pragma unroll
            for (int r = 0; r < 16; ++r) { const int c = cb + (r & 3) + 8 * (r >> 2);
                p0[r] = (c >= nv) ? 0.f : __builtin_amdgcn_exp2f(p0[r] - m) * il; p1[r] = (c + 32 >= nv) ? 0.f : __builtin_amdgcn_exp2f(p1[r] - m) * il; }
            LAS float* ir = imp + qloc * 65 + 16 * ct + hi;
#pragma unroll
            for (int rq = 0; rq < 4; ++rq) {
                const float q0 = (p0[4 * rq] + p0[4 * rq + 1]) + (p0[4 * rq + 2] + p0[4 * rq + 3]), q1 = (p1[4 * rq] + p1[4 * rq + 1]) + (p1[4 * rq + 2] + p1[4 * rq + 3]);
                __hip_atomic_fetch_add(ir + 2 * rq, q0, __ATOMIC_RELAXED, __HIP_MEMORY_SCOPE_WORKGROUP);
                __hip_atomic_fetch_add(ir + 2 * rq + 1, p0[4 * rq + 3], __ATOMIC_RELAXED, __HIP_MEMORY_SCOPE_WORKGROUP);
                __hip_atomic_fetch_add(ir + 8 + 2 * rq, q1, __ATOMIC_RELAXED, __HIP_MEMORY_SCOPE_WORKGROUP);
                if (16 * ct + 8 + 2 * rq + hi + 1 < 64) __hip_atomic_fetch_add(ir + 8 + 2 * rq + 1, p1[4 * rq + 3], __ATOMIC_RELAXED, __HIP_MEMORY_SCOPE_WORKGROUP);
            }
            pv_only2(oc, lds0 + A_VRING + vb + ct * 8192, p0, p1);
        }
#pragma unroll
        for (int r = 0; r < 16; ++r) { y[0][r] = g0 * oc[0][r]; y[1][r] = g0 * oc[1][r]; }
    }
    asm volatile("s_waitcnt lgkmcnt(0)\n\ts_barrier" ::: "memory");
    {
        const int q = tid >> 3, part = tid & 7;
        float sc[8];
#pragma unroll
        for (int i = 0; i < 8; ++i) { const int j = 8 * part + i; const bool forced = (j == 0) || (j == tb) || (j == tb - 1);
            sc[i] = forced ? 1e30f : (j <= tb ? imp[q * 65 + j] : -1e30f); }
#pragma unroll
        for (int i = 0; i < 8; ++i) imp[q * 65 + 8 * part + i] = sc[i];
        asm volatile("s_waitcnt lgkmcnt(0)\n\ts_barrier" ::: "memory");
        int rank[8];
#pragma unroll
        for (int i = 0; i < 8; ++i) rank[i] = 0;
        for (int k = 0; k < 64; ++k) { const float sk = imp[q * 65 + k];
#pragma unroll
            for (int i = 0; i < 8; ++i) rank[i] += (sk > sc[i] || (sk == sc[i] && k < 8 * part + i)) ? 1 : 0; }
        unsigned bits = 0u;
#pragma unroll
        for (int i = 0; i < 8; ++i) bits |= (rank[i] < 16) ? (1u << i) : 0u;
        bits <<= 8 * (part & 3);
        __hip_atomic_fetch_or(selm + q * 2 + (part >> 2), bits, __ATOMIC_RELAXED, __HIP_MEMORY_SCOPE_WORKGROUP);
        __hip_atomic_fetch_or(umask + (part >> 2), bits, __ATOMIC_RELAXED, __HIP_MEMORY_SCOPE_WORKGROUP);
        asm volatile("s_waitcnt lgkmcnt(0)\n\ts_barrier" ::: "memory");
        if (tid == 0) {
            LAS unsigned char* sq = (LAS unsigned char*)(L + N_SEQC); LAS unsigned char* sd = (LAS unsigned char*)(L + N_SEQD); LAS int* cnt = (LAS int*)(L + N_CNT);
            const unsigned long long um = ((unsigned long long)umask[1] << 32) | umask[0];
            int n = 0; sq[n++] = (unsigned char)tb;
            for (int j = 0; j < tb; ++j) if ((um >> j) & 1ull) sq[n++] = (unsigned char)j;
            cnt[0] = n;
            int n2 = 0; sd[n2++] = (unsigned char)tb;
            for (int j = (tb >= 8 ? tb - 8 : 0); j < tb; ++j) sd[n2++] = (unsigned char)j;
            cnt[1] = n2;
        }
        asm volatile("s_waitcnt lgkmcnt(0)\n\ts_barrier" ::: "memory");
    }
    const unsigned selLo = selm[qloc * 2], selHi = selm[qloc * 2 + 1];
    const int nC = __builtin_amdgcn_readfirstlane(((const LAS int*)(L + N_CNT))[0]), nD = __builtin_amdgcn_readfirstlane(((const LAS int*)(L + N_CNT))[1]);
    { const float* cs = (const float*)(ws + OFF_COS) + (size_t)row * 32 + 4 * hi; const float* sn = (const float*)(ws + OFF_SIN) + (size_t)row * 32 + 4 * hi;
#pragma unroll
      for (int d0 = 0; d0 < 4; ++d0) { const f32x4 c = *(const f32x4*)(cs + 8 * d0), s = *(const f32x4*)(sn + 8 * d0); u32x4 w = __builtin_bit_cast(u32x4, qf[d0]); u32x4 o;
#pragma unroll
          for (int e = 0; e < 4; ++e) { const float x1 = __uint_as_float(w[e] << 16), x2 = __uint_as_float(w[e] & 0xffff0000u); o[e] = pk2(x1 * c[e] - x2 * s[e], x2 * c[e] + x1 * s[e]); }
          qf[d0] = __builtin_bit_cast(bf16x8, o); } }
    asm volatile("" : "+v"(qf[0]), "+v"(qf[1]), "+v"(qf[2]), "+v"(qf[3]));
    {
        FlashSt<2> st; flash_init3<2>(st);
        const char* Kg = (const char*)(ws + OFF_KSEL) + (size_t)bg * 524288 + wid * 1024 + lane * 16; const char* Vg = (const char*)(ws + OFF_VSEL) + (size_t)bg * 524288 + wid * 1024 + lane * 16;
        nsa_ring<0>(st, lds, Kg, Vg, kdst, vdst, nC, N_SEQC, qf, tb, qloc, selLo, selHi, r32, hi, vb);
        const float lt = st.l + __shfl_xor(st.l, 32), sc = g1 / lt;
#pragma unroll
        for (int r = 0; r < 16; ++r) { y[0][r] += sc * st.o[0][r]; y[1][r] += sc * st.o[1][r]; }
    }
    {
        FlashSt<2> st; flash_init3<2>(st);
        const char* Kg = (const char*)(ws + OFF_KWIN) + (size_t)bg * 524288 + wid * 1024 + lane * 16; const char* Vg = (const char*)(ws + OFF_VWIN) + (size_t)bg * 524288 + wid * 1024 + lane * 16;
        nsa_ring<1>(st, lds, Kg, Vg, kdst, vdst, nD, N_SEQD, qf, tb, qloc, selLo, selHi, r32, hi, vb);
        const float lt = st.l + __shfl_xor(st.l, 32), sc = g2 / lt;
#pragma unroll
        for (int r = 0; r < 16; ++r) { y[0][r] += sc * st.o[0][r]; y[1][r] += sc * st.o[1][r]; }
    }
    bf16* Y = (bf16*)(ws + OFF_ZB) + (size_t)row * 512 + h * 64;
    bf16* Yd = dry ? (bf16*)(ws + OFF_SELM) + (tid * 64) : Y;
#pragma unroll
    for (int db = 0; db < 2; ++db)
#pragma unroll
        for (int rq = 0; rq < 4; ++rq) { bf16* yp = Y + 32 * db + 8 * rq + 4 * hi; bf16* yo = Yd + 32 * db + 8 * rq + 4 * hi; const u32x2 z = *(const u32x2*)yp;
            const float z0 = __uint_as_float(z.x << 16), z1 = __uint_as_float(z.x & 0xffff0000u), z2 = __uint_as_float(z.y << 16), z3 = __uint_as_float(z.y & 0xffff0000u);
            u32x2 o; o.x = pk2(y[db][4 * rq] * z0, y[db][4 * rq + 1] * z1); o.y = pk2(y[db][4 * rq + 2] * z2, y[db][4 * rq + 3] * z3);
            *(u32x2*)yo = o; }
}

__device__ __forceinline__ void compress_unit(unsigned char* lds, unsigned char* ws, int kv, int bg, int rc) {
    asm volatile("" : "+s"(ws));
    int tid_o = threadIdx.x; asm volatile("" : "+v"(tid_o));
    const int tid = tid_o, lane = tid & 63, wid = __builtin_amdgcn_readfirstlane(tid >> 6), r32 = lane & 31, hi = lane >> 5;
    const unsigned lds0 = (unsigned)(uintptr_t)lds;
    { const char* Ab = (const char*)(ws + (kv ? OFF_VCB : OFF_KCB)) + ((size_t)bg * 4096 + 512 * rc) * 128;
      asm volatile("s_waitcnt vmcnt(0)" ::: "memory");
#pragma unroll
      for (int i = 0; i < 9; ++i) { const int q = (i * 8 + wid) * 64 + lane, blk = q / 129, qq = q - blk * 129; const int sg = blk * 128 + (qq < 128 ? qq : 127);
          glds16(Ab + (size_t)sg * 16, (unsigned)__builtin_amdgcn_readfirstlane(lds0 + (i * 8 + wid) * 1024)); }
      asm volatile("s_waitcnt vmcnt(0)\n\ts_barrier" ::: "memory"); }
    const bf16* Bp = (const bf16*)(ws + OFF_CW1) + (size_t)kv * 256 * 2048 + ((size_t)wid * 128 * 64 + lane) * 8;
    const lds_cptr Al = (lds_cptr)lds + 2064 * r32 + 16 * hi;
    f32x16 acc;
#pragma unroll
    for (int r = 0; r < 16; ++r) acc[r] = 0.f;
#pragma unroll 8
    for (int l = 0; l < 32; ++l) {
        const lds_cptr ap = Al + l * 128 + (l >> 4) * 16;
#pragma unroll
        for (int q = 0; q < 4; ++q) {
            const bf16x8 a = *(const LAS bf16x8*)(ap + q * 32), w = *(const bf16x8*)(Bp + (size_t)(4 * l + q) * 512);
            acc = __builtin_amdgcn_mfma_f32_32x32x16_bf16(w, a, acc, 0, 0, 0);
        }
    }
    const float* cb = (const float*)(ws + OFF_CB1) + kv * 256 + 32 * wid + 4 * hi;
    bf16x8 hf[2];
    { float hv[16];
#pragma unroll
      for (int rq = 0; rq < 4; ++rq) { const f32x4 bb = *(const f32x4*)(cb + 8 * rq);
#pragma unroll
          for (int e = 0; e < 4; ++e) hv[4 * rq + e] = siluf_(acc[4 * rq + e] + bb[e]); }
      u32x4 w0, w1;
      w0.x = pk2(hv[0], hv[1]); w0.y = pk2(hv[2], hv[3]); w0.z = pk2(hv[4], hv[5]); w0.w = pk2(hv[6], hv[7]);
      w1.x = pk2(hv[8], hv[9]); w1.y = pk2(hv[10], hv[11]); w1.z = pk2(hv[12], hv[13]); w1.w = pk2(hv[14], hv[15]);
      hf[0] = __builtin_bit_cast(bf16x8, w0); hf[1] = __builtin_bit_cast(bf16x8, w1); }
    const bf16* W2 = (const bf16*)(ws + OFF_CW2) + (size_t)kv * 64 * 256 + 32 * wid + 4 * hi;
    f32x16 po[2];
#pragma unroll
    for (int dbk = 0; dbk < 2; ++dbk) {
#pragma unroll
        for (int r = 0; r < 16; ++r) po[dbk][r] = 0.f;
#pragma unroll
        for (int s = 0; s < 2; ++s) {
            const bf16* wr = W2 + (size_t)(32 * dbk + r32) * 256 + 16 * s;
            const u32x2 lo = *(const u32x2*)wr, hh = *(const u32x2*)(wr + 8);
            u32x4 wv; wv.x = lo.x; wv.y = lo.y; wv.z = hh.x; wv.w = hh.y;
            po[dbk] = __builtin_amdgcn_mfma_f32_32x32x16_bf16(__builtin_bit_cast(bf16x8, wv), hf[s], po[dbk], 0, 0, 0);
        }
    }
    LAS float* part = (LAS float*)lds;
    __syncthreads();
#pragma unroll
    for (int dbk = 0; dbk < 2; ++dbk)
#pragma unroll
        for (int r = 0; r < 16; ++r) part[(wid * 64 + 32 * dbk + crow(r, hi)) * 32 + r32] = po[dbk][r];
    __syncthreads();
    {
        const int row = tid & 31, d4 = tid >> 5, cc = 32 * rc + row;
        float o[4];
#pragma unroll
        for (int e = 0; e < 4; ++e) { float sum = 0.f;
#pragma unroll
            for (int w = 0; w < 8; ++w) sum += part[(w * 64 + 4 * d4 + e) * 32 + row];
            o[e] = (cc < 255) ? sum : 0.f; }
        bf16* dst = (bf16*)(ws + (kv ? OFF_VCMP : OFF_KCMP)) + (size_t)bg * 16384 + (kv ? vtile_off(cc, 4 * d4) : ktile_off(cc, 4 * d4));
        store_bf<4>(dst, o);
    }
    __syncthreads();
}
__device__ __forceinline__ void cumsum_unit(unsigned char* lds, unsigned char* ws, int bh) {
    asm volatile("" : "+s"(ws));
    int tid_o = threadIdx.x; asm volatile("" : "+v"(tid_o));
    const int tid = tid_o, lane = tid & 63, wid = tid >> 6, b = bh >> 3, h = bh & 7;
    const float* lf = (const float*)(ws + OFF_LOGF) + ((size_t)(b * 4096 + 8 * tid)) * 8 + h;
    float v[8]; float s = 0.f;
#pragma unroll
    for (int i = 0; i < 8; ++i) { s += lf[i * 8]; v[i] = s; }
    float incl = s;
#pragma unroll
    for (int of = 1; of < 64; of <<= 1) { const float t = __shfl_up(incl, of); if (lane >= of) incl += t; }
    LAS float* wsum = (LAS float*)lds;
    __syncthreads();
    if (lane == 63) wsum[wid] = incl;
    __syncthreads();
    float base = incl - s;
    for (int w = 0; w < wid; ++w) base += wsum[w];
    float* cf = (float*)(ws + OFF_CF) + (size_t)bh * 4096 + 8 * tid;
    f32x4 o0 = {-(base + v[0]), -(base + v[1]), -(base + v[2]), -(base + v[3])}, o1 = {-(base + v[4]), -(base + v[5]), -(base + v[6]), -(base + v[7])};
    *(f32x4*)cf = o0; *(f32x4*)(cf + 4) = o1;
    __syncthreads();
}

constexpr size_t OFF_BAR = OFF_CTL + 131072;
constexpr int LDS_BARST = 131072 + 64;
#define XB_TMO      128
#define XB_XCNT(j)  (256  + 64 * (j))
#define XB_XSUB(j)  (1280 + 64 * (j))
#define XB_XGEN(j)  (2304 + 64 * (j))
#define XB_TOP      3328
#define XB_TOPGEN   3392
#define XCD_BAR_WORDS 3456
#define XB_SPIN_CAP (1u << 18)

__device__ __forceinline__ unsigned xb_ld(unsigned* p)              { return __hip_atomic_load(p, __ATOMIC_RELAXED, __HIP_MEMORY_SCOPE_AGENT); }
__device__ __forceinline__ unsigned xb_add(unsigned* p, unsigned v) { return __hip_atomic_fetch_add(p, v, __ATOMIC_RELAXED, __HIP_MEMORY_SCOPE_AGENT); }
__device__ __forceinline__ unsigned xb_xcc_id() { return (unsigned)__builtin_amdgcn_s_getreg((3 << 11) | 20) & 0xFu; }
#define XB_SPIN(cond, bar) do { unsigned _sp = 0; while (cond) { __builtin_amdgcn_s_sleep(1); \
    if ((++_sp & 255u) == 0u) { if (xb_ld(&(bar)[XB_TMO])) break; if (_sp > XB_SPIN_CAP) { atomicAdd(&(bar)[XB_TMO], 1u); break; } } } } while (0)

struct XcdBarrier {
    unsigned* bar; unsigned x;
    volatile LAS unsigned* st;
};

__device__ __forceinline__ XcdBarrier xcd_barrier_post(unsigned* bar, volatile LAS unsigned* st) {
    XcdBarrier b; b.bar = bar; b.x = xb_xcc_id(); b.st = st;
    if (threadIdx.x == 0) (void)xb_add(&bar[XB_XCNT(b.x)], 1u);
    return b;
}
__device__ __forceinline__ void xcd_barrier_complete(unsigned* bar, unsigned x, unsigned& nloc, unsigned& nx) {
    const unsigned G = gridDim.x * gridDim.y * gridDim.z;
    unsigned sum, cnt, mine, sp = 0u;
    for (;;) {
        sum = 0u; cnt = 0u; mine = 0u;
#pragma unroll
        for (unsigned j = 0; j < 16; ++j) { const unsigned c = xb_ld(&bar[XB_XCNT(j)]); sum += c; cnt += (c > 0u) ? 1u : 0u; mine = (j == x) ? c : mine; }
        if (sum == G) break;
        __builtin_amdgcn_s_sleep(1);
        if ((++sp & 255u) == 0u) { if (xb_ld(&bar[XB_TMO])) break; if (sp > XB_SPIN_CAP) { atomicAdd(&bar[XB_TMO], 1u); break; } }
    }
    nloc = mine > 0u ? mine : 1u; nx = cnt > 0u ? cnt : 1u;
}

__device__ __forceinline__ void xcd_barrier(const XcdBarrier& b) {
    asm volatile("s_waitcnt vmcnt(0)" ::: "memory");
    __syncthreads();
    if (threadIdx.x == 0) {
        unsigned* bar = b.bar;
        __builtin_amdgcn_s_waitcnt(0);
        unsigned nloc = b.st[0], nx = b.st[1];
        if (nloc == 0u) { xcd_barrier_complete(bar, b.x, nloc, nx); b.st[0] = nloc; b.st[1] = nx; }
        const unsigned old = xb_add(&bar[XB_XSUB(b.x)], 1u);
        const unsigned gen = old / nloc;
        if (old + 1u == (gen + 1u) * nloc) {
            __builtin_amdgcn_fence(__ATOMIC_RELEASE, "agent");
            asm volatile("s_waitcnt vmcnt(0)" ::: "memory");
            const unsigned og = xb_add(&bar[XB_TOP], 1u);
            const unsigned tg = og / nx;
            if (og + 1u == (tg + 1u) * nx) xb_add(&bar[XB_TOPGEN], 1u);
            else XB_SPIN(xb_ld(&bar[XB_TOPGEN]) == tg, bar);
            __builtin_amdgcn_fence(__ATOMIC_ACQUIRE, "agent");
            xb_add(&bar[XB_XGEN(b.x)], 1u);
            asm volatile("s_waitcnt vmcnt(0)" ::: "memory");
        } else {
            XB_SPIN(xb_ld(&bar[XB_XGEN(b.x)]) == gen, bar);
            __builtin_amdgcn_fence(__ATOMIC_ACQUIRE, "agent");
            asm volatile("s_waitcnt vmcnt(0)" ::: "memory");
        }
    }
    __syncthreads();
}

struct KArgs;
__device__ __forceinline__ void conv_tile(bool active, float (*tile)[65], int vt, const float* src, int ld, int K, bf16* dst, const float* kscale, int mode, int bx, int by) {
    const int n0 = bx * 64, k0 = by * 64, tx = vt & 63, ty = vt >> 6;
    const int n = n0 + tx;
    const int sc = (mode == 0 || mode == 3) ? n : mode == 1 ? win_srccol(n) : (n & ~63) + ((n & 1) << 5) + ((n & 63) >> 1);
    if (active) {
        float v[16];
#pragma unroll
        for (int i = 0; i < 16; ++i) v[i] = (sc >= 0) ? src[(size_t)(k0 + 4 * i + ty) * ld + sc] : 0.f;
        if (kscale) {
#pragma unroll
            for (int i = 0; i < 16; ++i) v[i] *= kscale[k0 + 4 * i + ty]; }
#pragma unroll
        for (int i = 0; i < 16; ++i) tile[tx][4 * i + ty] = v[i];
    }
    __syncthreads();
    if (active) {
#pragma unroll
        for (int p = 0; p < 2; ++p) { const int it = vt + 256 * p, r = it >> 3, c = it & 7; const float* t = &tile[r][8 * c];
            u32x4 o; o.x = pk2(t[0], t[1]); o.y = pk2(t[2], t[3]); o.z = pk2(t[4], t[5]); o.w = pk2(t[6], t[7]);
            const int nn = n0 + r, kk = k0 + 8 * c;
            if (mode == 3) *(u32x4*)(dst + ((size_t)((nn >> 5) * (K >> 4) + (kk >> 4)) * 64 + (nn & 31) + 32 * ((kk & 15) >> 3)) * 8) = o;
            else *(u32x4*)(dst + (size_t)nn * K + kk) = o; }
    }
    __syncthreads();
}
namespace cg = cooperative_groups;
constexpr int NT = 512;
constexpr int LDS_BYTES = 147456;
struct KArgs { const void* in[23]; float* out; unsigned char* ws; };

#define OPAQUE_TID() int tid = threadIdx.x; asm volatile("" : "+v"(tid))
#define VRUN(VT, NVB, CALL) do { OPAQUE_TID(); constexpr int per_ = NT / (VT); for (int vb = blockIdx.x * per_ + tid / (VT); vb < (NVB); vb += gridDim.x * per_) { const int vt = tid % (VT); CALL; } } while (0)
#define VRUN_BAR(NVB, CALL) do { OPAQUE_TID(); float (*tile)[65] = (float (*)[65])(lds + (tid >> 8) * 64 * 65 * 4); (void)tile; const int nvb_ = (NVB); for (int it_ = 0; it_ * (int)gridDim.x * 2 < nvb_; ++it_) { const int vb = (it_ * (int)gridDim.x + (int)blockIdx.x) * 2 + (tid >> 8); const int vt = tid & 255; const bool active = vb < nvb_; CALL; } } while (0)

#ifndef REP_U
#define REP_U 0
#endif
#ifndef REP_SYNC
#define REP_SYNC 0
#endif
#ifndef REP_SUMSQ
#define REP_SUMSQ 0
#endif
#ifndef REP_P0
#define REP_P0 0
#endif
#ifndef REP_PRO
#define REP_PRO 0
#endif
#ifndef REP_INPROJ
#define REP_INPROJ 0
#endif
#ifndef REP_P2
#define REP_P2 0
#endif
#ifndef REP_FOX
#define REP_FOX 0
#endif
#ifndef REP_DIFF
#define REP_DIFF 0
#endif
#ifndef REP_NSA
#define REP_NSA 0
#endif
#ifndef REP_GATEBR
#define REP_GATEBR 0
#endif
#ifndef REP_OUT
#define REP_OUT 0
#endif
#ifndef DO_ALL
#define DO_ALL 1
#endif
#ifndef DO_PRO
#define DO_PRO DO_ALL
#endif
#ifndef DO_INPROJ
#define DO_INPROJ DO_ALL
#endif
#ifndef DO_P2
#define DO_P2 DO_ALL
#endif
#ifndef DO_ATTN
#define DO_ATTN DO_ALL
#endif
#ifndef DO_GATEBR
#define DO_GATEBR DO_ALL
#endif
#ifndef DO_OUT
#define DO_OUT DO_ALL
#endif
#ifndef DO_PLE
#define DO_PLE DO_ALL
#endif
#ifndef DO_TAIL
#define DO_TAIL DO_ALL
#endif
__global__ void __launch_bounds__(NT) mega(KArgs a) {
    extern __shared__ __attribute__((aligned(16))) unsigned char lds[];
    cg::grid_group grid = cg::this_grid();
    { volatile LAS unsigned* st0 = (volatile LAS unsigned*)((LAS unsigned char*)lds + LDS_BARST); if (threadIdx.x < 2) st0[threadIdx.x] = 0u; }
    __syncthreads();
    const XcdBarrier xbar = xcd_barrier_post((unsigned*)(a.ws + OFF_BAR), (volatile LAS unsigned*)((LAS unsigned char*)lds + LDS_BARST));
#define GSYNC() do { XcdBarrier xb_ = xbar; asm volatile("" : "+s"(xb_.bar)); xcd_barrier(xb_); } while (0)
    unsigned char* ws = a.ws; float* X = a.out;
    typedef const KArgs __attribute__((address_space(4)))* kargp_t;
#define KIN(i) ([&]() { kargp_t kp_ = (kargp_t)__builtin_amdgcn_kernarg_segment_ptr(); asm volatile("" : "+s"(kp_)); return kp_->in[i]; }())
#define I_x ((const float*)KIN(0))
#define I_p ((const float*)KIN(1))
#define I_pos ((const int*)KIN(2))
#define I_norm_g ((const float*)KIN(3))
#define I_w_in ((const float*)KIN(4))
#define I_b_forget ((const float*)KIN(5))
#define I_pe_k ((const float*)KIN(6))
#define I_w1_k ((const float*)KIN(7))
#define I_b1_k ((const float*)KIN(8))
#define I_w2_k ((const float*)KIN(9))
#define I_pe_v ((const float*)KIN(10))
#define I_w1_v ((const float*)KIN(11))
#define I_b1_v ((const float*)KIN(12))
#define I_w2_v ((const float*)KIN(13))
#define I_diff_lam ((const float*)KIN(14))
#define I_subln ((const float*)KIN(15))
#define I_w_out ((const float*)KIN(19))
#define I_w_ple ((const float*)KIN(20))
#define I_w_pg ((const float*)KIN(21))
#define I_final_g ((const float*)KIN(22))
#define CONV_BLOCK(CL, WITHP0) do { const int cl_ = (CL); const bool withp0_ = (WITHP0); \
        { OPAQUE_TID(); float (*tile)[65] = (float (*)[65])(lds + (tid >> 8) * 64 * 65 * 4); \
          const int njobs = 2952 + ((withp0_) ? 1152 : 0); \
          for (int it_ = 0; it_ * (int)gridDim.x * 2 < njobs; ++it_) { \
              int j = (it_ * (int)gridDim.x + (int)blockIdx.x) * 2 + (tid >> 8); const bool active = j < njobs; \
              const float* src = I_w_in + (size_t)cl_ * 1024 * NIN; int ld = NIN, K = 1024, mode = 1, bx = 0, by = 0; bf16* dst = (bf16*)(ws + OFF_WIN); const float* ks = I_norm_g + cl_ * 1024; \
              if (j < 1536) { bx = j % 96; by = j / 96; } \
              else if (j < 2304) { j -= 1536; bx = j % 48; by = j / 48; src = I_w_in + (size_t)cl_ * 1024 * NIN + 5920; mode = 0; dst = (bf16*)(ws + OFF_WMG); } \
              else if (j < 2688) { j -= 2304; const int i = j >> 7, r = j & 127; bx = r & 15; by = r >> 4; src = (const float*)KIN(16 + i) + (size_t)cl_ * 512 * 1024; ld = 1024; K = 512; mode = 0; dst = (bf16*)(ws + OFF_WBR) + (size_t)i * 1024 * 512; ks = nullptr; } \
              else if (j < 2944) { j -= 2688; const int kv = j >> 7, r = j & 127; bx = r & 3; by = r >> 2; src = (kv ? I_w1_v : I_w1_k) + (size_t)cl_ * 2048 * 256; ld = 256; K = 2048; mode = 3; dst = (bf16*)(ws + OFF_CW1) + (size_t)kv * 256 * 2048; ks = nullptr; } \
              else if (j < 2952) { j -= 2944; const int kv = j >> 2; by = j & 3; src = (kv ? I_w2_v : I_w2_k) + (size_t)cl_ * 256 * 64; ld = 64; K = 256; mode = kv ? 0 : 2; dst = (bf16*)(ws + OFF_CW2) + (size_t)kv * 64 * 256; ks = nullptr; } \
              else { j -= 2952; const int ll = j / 576, r = j % 576; ld = 1024; mode = 0; ks = nullptr; \
                  if (r < 256) { bx = r & 15; by = r >> 4; src = I_w_out + (size_t)ll * 1024 * 1024; dst = (bf16*)(ws + OFF_WOUT) + (size_t)ll * 1024 * 1024; } \
                  else if (r < 512) { const int r2 = r - 256; bx = r2 & 15; by = r2 >> 4; src = I_w_pg + (size_t)ll * 1024 * 1024; dst = (bf16*)(ws + OFF_WPG) + (size_t)ll * 1024 * 1024; } \
                  else { const int r2 = r - 512; bx = r2 & 15; by = r2 >> 4; src = I_w_ple + (size_t)ll * 256 * 1024; K = 256; dst = (bf16*)(ws + OFF_WPL) + (size_t)ll * 1024 * 256; } } \
              conv_tile(active, tile, tid & 255, src, ld, K, dst, ks, mode, bx, by); \
          } } \
        { OPAQUE_TID(); if (blockIdx.x >= 64 && blockIdx.x < 96 && tid < 256) d_cb1_part(blockIdx.x - 64, tid, I_pe_k + cl_ * 2048, I_w1_k + (size_t)cl_ * 2048 * 256, I_pe_v + cl_ * 2048, I_w1_v + (size_t)cl_ * 2048 * 256, ws); } \
    } while (0)
#if DO_PRO
    for (int rep0_ = 0; rep0_ <= REP_P0; ++rep0_) {
    VRUN(256, M / 4, d_xprep(vb, vt, I_x, ws));
    VRUN(256, M * 32 / 256, d_rope_table(vb, vt, I_pos, ws));
    VRUN(256, (2 * M * 256 / 4) / 256, d_pconv(vb, vt, I_p, ws));
    for (int l = 0; l < DEPTH; ++l) {
        { OPAQUE_TID(); if (blockIdx.x == 0 && tid < 64) d_lam(tid, I_diff_lam + l * 256, ws, l); }
    }
    }
#endif
    for (int l = 0; l < DEPTH; ++l) {
#if DO_PRO
        CONV_BLOCK(l, l == 0);
#endif
        if (l == 0) grid.sync(); else GSYNC();
        EpiCtx E{ws, I_b_forget + l * 8, l == 0 ? I_x : X, X, 0};
#if DO_INPROJ
        { OPAQUE_TID(); if (blockIdx.x == 0) d_cb1_sum(tid, I_b1_k + l * 256, I_b1_v + l * 256, ws); }
        for (int rep_ = 0; rep_ <= REP_INPROJ; ++rep_) { FAST_GEMM(EPI_INPROJ, ws + OFF_XB, ws + OFF_WIN, NP, 1024, true); }
#endif
        GSYNC();
#if DO_P2
        for (int rep_ = 0; rep_ <= REP_P2; ++rep_) {
        for (int u = blockIdx.x; u < 160; u += gridDim.x) { if (u < 128) compress_unit(lds, ws, u >> 6, (u >> 3) & 7, u & 7); else cumsum_unit(lds, ws, u - 128); }
        }
#endif
        GSYNC();
#if DO_ATTN
        for (int rep_ = (REP_FOX ? 1 : 0); rep_ >= 0; --rep_) for (int u = blockIdx.x; u < 512; u += gridDim.x) fox_unit(lds, ws, u & 31, u < 256 ? 15 - (u >> 5) : (u >> 5) - 8, rep_ > 0 ? REP_FOX : 0);
        __syncthreads();
        { const float lam = ((const float*)(ws + OFF_CTL))[CTL_LAM + l], lam_init = 0.8f - 0.6f * expf(-0.3f * (float)l);
          for (int rep_ = REP_DIFF; rep_ >= 0; --rep_) for (int u = blockIdx.x; u < 512; u += gridDim.x) diff_unit(lds, ws, u & 15, u < 256 ? 31 - (u >> 4) : (u >> 4) - 16, I_subln + l * 128, lam, lam_init, rep_ > 0); }
        __syncthreads();
        for (int rep_ = REP_NSA; rep_ >= 0; --rep_) for (int u = blockIdx.x; u < 512; u += gridDim.x) nsa_unit(lds, ws, u & 7, u < 256 ? 63 - (u >> 3) : (u >> 3) - 32, rep_ > 0);
#endif
        GSYNC();
#if DO_GATEBR
        for (int rep_ = 0; rep_ <= REP_GATEBR; ++rep_) {
        { pg8::Gemm g_{(const pg8::bf16_t*)(ws + OFF_XB), (const pg8::bf16_t*)(ws + OFF_WMG), M, 3072, 1024}; ChainOrder S_; S_.init((int)gridDim.x, (int)blockIdx.x, 0);
          EpiFast<EPI_GATE3> Ep_{E}; pg8::gemm_phase<EpiFast<EPI_GATE3>, ChainOrder, true, true>((PG8_LAS unsigned char*)lds, g_, S_, Ep_); }
        { pg8::Gemm g_{(const pg8::bf16_t*)(ws + OFF_ZA), (const pg8::bf16_t*)(ws + OFF_WBR), 3 * M, 3072, 512}; ChainOrder S_; S_.init((int)gridDim.x, (int)blockIdx.x, 1);
          EpiFast<EPI_BR3> Ep_{E}; pg8::gemm_phase<EpiFast<EPI_BR3>, ChainOrder, true, true>((PG8_LAS unsigned char*)lds, g_, S_, Ep_); }
        }
#endif
        GSYNC();
#if DO_OUT
        for (int rep_ = 0; rep_ <= (l == 0 ? REP_OUT : 0); ++rep_) FAST_GEMM(EPI_OUT, (const bf16*)(ws + OFF_MERGED), (const bf16*)(ws + OFF_WOUT) + (size_t)l * 1024 * 1024, 1024, 1024, false);
#endif
        GSYNC();
#if DO_PLE
        for (int rep_ = 0; rep_ <= REP_U; ++rep_) FAST_GEMM(EPI_U, (const bf16*)(ws + OFF_PB) + (size_t)l * M * 256, (const bf16*)(ws + OFF_WPL) + (size_t)l * 1024 * 256, 1024, 256, false);
        { asm volatile("" : "+s"(ws)); pg8::Gemm g_{(const pg8::bf16_t*)(ws + OFF_X1B), (const pg8::bf16_t*)((const bf16*)(ws + OFF_WPG) + (size_t)l * 1024 * 1024), M, 1024, 1024}; pg8::StaticOrder S_; S_.init(M, 1024, (int)gridDim.x, (int)blockIdx.x);
          EpiFast<EPI_PLE> Ep_{EpiCtx{ws, nullptr, (const float*)(lds + 135168), X, 0}};
          pg8::gemm_phase<EpiFast<EPI_PLE>, pg8::StaticOrder, false, true>((PG8_LAS unsigned char*)lds, g_, S_, Ep_);
          __syncthreads();
          pg8::Unit u0; S_.next(0, u0);
          { OPAQUE_TID(); if (tid < 256) { const LAS float* pp = (const LAS float*)((LAS unsigned char*)lds + 135168) + tid * 4;
              ((float*)(ws + OFF_SSP))[(size_t)(u0.pm * 256 + tid) * 4 + u0.pn] = (pp[0] + pp[1]) + (pp[2] + pp[3]); } } }
#endif
        GSYNC();
#if DO_TAIL
        for (int rep_ = 0; rep_ < 10 * REP_SYNC; ++rep_) GSYNC();
#endif
    }
#if DO_TAIL
    VRUN(256, M / 4, d_final(vb, vt, X, I_final_g));
#endif
}
#undef I_x
#undef I_p
#undef I_pos
#undef I_norm_g
#undef I_w_in
#undef I_b_forget
#undef I_pe_k
#undef I_w1_k
#undef I_b1_k
#undef I_w2_k
#undef I_pe_v
#undef I_w1_v
#undef I_b1_v
#undef I_w2_v
#undef I_diff_lam
#undef I_subln
#undef I_w_out
#undef I_w_ple
#undef I_w_pg
#undef I_final_g
#undef KIN

extern "C" void kernel_launch(void* const* d_in, const int* in_sizes, int n_in, void* d_out, int out_size, void* d_ws, size_t ws_size, hipStream_t stream) {
    static int grid_blocks = 0;
    if (grid_blocks == 0) {
        if (n_in != 23 || ws_size < WS_NEED || out_size != M * DM) { fprintf(stderr, "kernel_launch: unexpected sizes (n_in %d ws %zu out %d)\n", n_in, ws_size, out_size); grid_blocks = -1; return; }
        int dev = 0, cus = 0, per_cu = 0;
        (void)hipGetDevice(&dev); (void)hipDeviceGetAttribute(&cus, hipDeviceAttributeMultiprocessorCount, dev);
        (void)hipFuncSetAttribute((const void*)mega, hipFuncAttributeMaxDynamicSharedMemorySize, LDS_BYTES);
        (void)hipOccupancyMaxActiveBlocksPerMultiprocessor(&per_cu, (const void*)mega, NT, LDS_BYTES);
        if (per_cu < 1) { fprintf(stderr, "kernel_launch: occupancy query says %d blocks per CU\n", per_cu); grid_blocks = -1; return; }
        grid_blocks = cus * 1;
        if (grid_blocks != 256) { fprintf(stderr, "kernel_launch: built for a 256-CU device (got %d)\n", cus); grid_blocks = -1; return; }
    }
    if (grid_blocks < 0) return;
    (void)hipMemsetAsync((char*)d_ws + OFF_CTL, 0, 262144, stream);
    KArgs a{};
    for (int i = 0; i < 23; ++i) a.in[i] = d_in[i];
    a.out = (float*)d_out; a.ws = (unsigned char*)d_ws;
    void* args[] = {&a};
    hipError_t e = hipLaunchCooperativeKernel((const void*)mega, dim3(grid_blocks), dim3(NT), args, LDS_BYTES, stream);
    if (e != hipSuccess) fprintf(stderr, "cooperative launch failed: %s (grid %d)\n", hipGetErrorString(e), grid_blocks);
}
```

```cpp
#include <hip/hip_runtime.h>
#include <hip/hip_cooperative_groups.h>
#include <cstdio>
#include <cstdint>

typedef unsigned short bf16;
typedef short bf16x8 __attribute__((ext_vector_type(8)));
typedef float f32x4 __attribute__((ext_vector_type(4)));
typedef float f32x16 __attribute__((ext_vector_type(16)));
typedef unsigned u32x4 __attribute__((ext_vector_type(4)));
typedef unsigned u32x2 __attribute__((ext_vector_type(2)));

constexpr int BATCH = 4, SEQ = 4096, DM = 1024, M = BATCH * SEQ, DEPTH = 2, NIN = 8992, NP = 6144;
constexpr float EPS = 1e-6f;
constexpr float LOG2E = 1.4426950408889634f;
constexpr float C2 = 0.125f * LOG2E;
constexpr size_t MiB = 1u << 20;
constexpr size_t OFF_CTL = 0;
constexpr size_t OFF_WIN = 1 * MiB, OFF_WMG = 13 * MiB, OFF_WBR = 19 * MiB, OFF_CW1 = 22 * MiB, OFF_CW2 = 24 * MiB, OFF_CB1 = 24 * MiB + 128 * 1024;
constexpr size_t OFF_WOUT = 25 * MiB, OFF_WPG = 29 * MiB, OFF_WPL = 33 * MiB;
constexpr size_t OFF_XB = 34 * MiB, OFF_ZA = 66 * MiB, OFF_ZB = 82 * MiB, OFF_ZC = 98 * MiB;
constexpr size_t OFF_COS = 114 * MiB, OFF_SIN = 116 * MiB, OFF_PB = 118 * MiB;
constexpr size_t OFF_LOGF = 134 * MiB, OFF_CF = 134 * MiB + 512 * 1024, OFF_GATES = 135 * MiB, OFF_SSP = 136 * MiB + 512 * 1024;
constexpr size_t OFF_KCMP = 136 * MiB + 768 * 1024, OFF_VCMP = 137 * MiB, OFF_SELM = 137 * MiB + 256 * 1024;
constexpr size_t OFF_QA = 139 * MiB, OFF_KA = 155 * MiB, OFF_VA = 171 * MiB, OFF_QB = 187 * MiB, OFF_QC = 203 * MiB, OFF_KC = 219 * MiB, OFF_VC = 235 * MiB;
constexpr size_t OFF_KCB = 251 * MiB, OFF_VCB = 255 * MiB, OFF_KSEL = 259 * MiB, OFF_KWIN = 263 * MiB, OFF_VSEL = 267 * MiB, OFF_VWIN = 271 * MiB;
constexpr size_t WS_NEED = 275 * MiB;
constexpr size_t OFF_G = 139 * MiB  , OFF_T = 235 * MiB  , OFF_MERGED = OFF_T, OFF_X1B = 203 * MiB, OFF_U = 139 * MiB;
constexpr int CTL_LAM = 64;

__device__ __forceinline__ bf16 f2bf(float f) { unsigned u = __float_as_uint(f); return (bf16)((u + 0x7fffu + ((u >> 16) & 1u)) >> 16); }
__device__ __forceinline__ float bf2f(bf16 h) { return __uint_as_float(((unsigned)h) << 16); }
__device__ __forceinline__ unsigned pk2(float lo, float hi) { typedef float f2_ __attribute__((ext_vector_type(2))); typedef __bf16 b2_ __attribute__((ext_vector_type(2))); f2_ v = {lo, hi}; b2_ b = __builtin_convertvector(v, b2_); return __builtin_bit_cast(unsigned, b); }
__device__ __forceinline__ float sigmoidf_(float x) { return 1.f / (1.f + __expf(-x)); }
__device__ __forceinline__ float siluf_(float x) { return x / (1.f + __expf(-x)); }
__device__ __forceinline__ float logsigmoidf_(float x) { return x >= 0.f ? -log1pf(expf(-x)) : x - log1pf(expf(x)); }

__device__ __forceinline__ int ktile_off(int s, int d) { return (s >> 6) * 4096 + (d >> 3) * 512 + (s & 63) * 8 + (d & 7); }
__device__ __forceinline__ int vtile_off(int s, int d) { return (s >> 6) * 4096 + (d >> 5) * 2048 + ((s & 63) >> 4) * 512 + (s & 15) * 32 + (d & 31); }
__device__ __forceinline__ int v128_off(int s, int d) { return (s >> 6) * 8192 + (d >> 5) * 2048 + ((s & 63) >> 4) * 512 + (s & 15) * 32 + (d & 31); }

template <int W> __device__ __forceinline__ void store_bf(bf16* dst, const float* v) {
    if constexpr (W == 4) { u32x2 o; o.x = pk2(v[0], v[1]); o.y = pk2(v[2], v[3]); *(u32x2*)dst = o; }
    else { u32x4 o; o.x = pk2(v[0], v[1]); o.y = pk2(v[2], v[3]); o.z = pk2(v[4], v[5]); o.w = pk2(v[6], v[7]); *(u32x4*)dst = o; }
}

__device__ __forceinline__ int win_srccol(int n) {
    const int seg = n >> 6, j = n & 63; const int il = ((j & 1) << 5) + (j >> 1);
    if (seg < 8) return 0 + n;
    if (seg < 16) return 512 + (n - 512);
    if (seg < 24) return 1024 + (n - 1024);
    if (seg < 32) return 1544 + (n - 1536);
    if (seg < 40) return 2056 + (seg - 32) * 64 + il;
    if (seg < 42) return 2568 + (n - 2560);
    if (seg < 44) return 2696 + (n - 2688);
    if (seg < 46) return 2824 + (seg - 44) * 64 + il;
    if (seg < 48) return 3080 + (seg - 46) * 64 + il;
    if (seg < 50) return 2952 + (n - 3072);
    if (seg < 52) return 3208 + (n - 3200);
    if (seg < 60) return 3360 + (n - 3328);
    if (seg < 68) return 3872 + (seg - 60) * 64 + il;
    if (seg < 76) return 4384 + (seg - 68) * 64 + il;
    if (seg < 84) return 4896 + (n - 4864);
    if (seg < 92) return 5408 + (n - 5376);
    if (seg == 92) { if (j < 8) return 1536 + j; if (j < 32) return 3336 + (j - 8); return -1; }
    return -1;
}

enum { EPI_INPROJ = 0, EPI_GATE = 1, EPI_BR0 = 2, EPI_BR1 = 3, EPI_BR2 = 4, EPI_OUT = 5, EPI_U = 6, EPI_PLE = 7, EPI_GATE3 = 9, EPI_BR3 = 10 };
struct EpiCtx { unsigned char* ws; const float* bfg; const float* xin; float* X; int gi; };

__device__ __forceinline__ float row_rstd(const unsigned char* ws, int row) {
    const f32x4 sp = *(const f32x4*)(ws + OFF_SSP + (size_t)row * 16);
    return rsqrtf(((sp[0] + sp[1]) + (sp[2] + sp[3])) * (1.f / 1024.f) + EPS);
}

enum { T_QA = 0, T_KA, T_VA, T_ZA, T_QB, T_CB, T_KROPE, T_VSW, T_ZB, T_QC, T_KC, T_VC, T_ZC, T_SPECIAL };
__device__ __forceinline__ int inproj_type(int t) {
    return t < 2 ? T_QA : t < 4 ? T_KA : t < 6 ? T_VA : t < 8 ? T_ZA : t < 10 ? T_QB : t == 10 ? T_CB : t == 11 ? T_KROPE : t == 12 ? T_VSW : t < 15 ? T_ZB : t < 17 ? T_QC : t < 19 ? T_KC : t < 21 ? T_VC : t < 23 ? T_ZC : T_SPECIAL;
}
struct Pre { float rs; float a[8]; float b[8]; };
template <int KIND, int T> __device__ __forceinline__ void pre_load(const EpiCtx& E, int row, int col, Pre& p) {
    unsigned char* ws = E.ws; const size_t idx = (size_t)row * 1024 + col;
    if constexpr (KIND == EPI_INPROJ) {
        if constexpr (T == T_KROPE || T == T_QC || T == T_KC) { const int d = col & 63;
            const f32x4 c = *(const f32x4*)((const float*)(ws + OFF_COS) + (size_t)row * 32 + (d >> 1)), s = *(const f32x4*)((const float*)(ws + OFF_SIN) + (size_t)row * 32 + (d >> 1));
#pragma unroll
            for (int i = 0; i < 4; ++i) { p.a[i] = c[i]; p.b[i] = s[i]; } }
    } else if constexpr (KIND == EPI_GATE || KIND == EPI_GATE3) {
    } else if constexpr (KIND == EPI_BR3) {
        const u32x4 g = *(const u32x4*)((const bf16*)(ws + OFF_G) + (size_t)E.gi * M * 1024 + idx);
#pragma unroll
        for (int i = 0; i < 4; ++i) { p.a[2 * i] = __uint_as_float(g[i] << 16); p.a[2 * i + 1] = __uint_as_float(g[i] & 0xffff0000u); }
        if (E.gi > 0) { const u32x4 t = *(const u32x4*)((const bf16*)(ws + OFF_T) + idx);
#pragma unroll
            for (int i = 0; i < 4; ++i) { p.b[2 * i] = __uint_as_float(t[i] << 16); p.b[2 * i + 1] = __uint_as_float(t[i] & 0xffff0000u); } }
        else {
#pragma unroll
            for (int i = 0; i < 8; ++i) p.b[i] = 0.f; }
    } else if constexpr (KIND == EPI_BR0 || KIND == EPI_BR1 || KIND == EPI_BR2) {
        const u32x4 g = *(const u32x4*)((const bf16*)(ws + OFF_G) + idx);
#pragma unroll
        for (int i = 0; i < 4; ++i) { p.a[2 * i] = __uint_as_float(g[i] << 16); p.a[2 * i + 1] = __uint_as_float(g[i] & 0xffff0000u); }
        if constexpr (KIND != EPI_BR0) { const u32x4 t = *(const u32x4*)((const bf16*)(ws + OFF_T) + idx);
#pragma unroll
            for (int i = 0; i < 4; ++i) { p.b[2 * i] = __uint_as_float(t[i] << 16); p.b[2 * i + 1] = __uint_as_float(t[i] & 0xffff0000u); } }
    } else if constexpr (KIND == EPI_OUT) { const f32x4 t0 = *(const f32x4*)(E.xin + idx), t1 = *(const f32x4*)(E.xin + idx + 4);
#pragma unroll
        for (int i = 0; i < 4; ++i) { p.a[i] = t0[i]; p.a[4 + i] = t1[i]; }
    } else if constexpr (KIND == EPI_PLE) { const f32x4 t0 = *(const f32x4*)(E.X + idx), t1 = *(const f32x4*)(E.X + idx + 4); const u32x4 u = *(const u32x4*)((const bf16*)(ws + OFF_U) + idx);
#pragma unroll
        for (int i = 0; i < 4; ++i) { p.a[i] = t0[i]; p.a[4 + i] = t1[i]; p.b[2 * i] = __uint_as_float(u[i] << 16); p.b[2 * i + 1] = __uint_as_float(u[i] & 0xffff0000u); }
    }
}
__device__ __forceinline__ void st_f32x8(float* dst, const float* v) { f32x4 a = {v[0], v[1], v[2], v[3]}, b = {v[4], v[5], v[6], v[7]}; *(f32x4*)dst = a; *(f32x4*)(dst + 4) = b; }
template <int KIND, int T> __device__ __forceinline__ void emit_fin(const EpiCtx& E, int row, int col, const float* a, const Pre& p) {
    constexpr int W = 8;
    unsigned char* ws = E.ws; const size_t idx = (size_t)row * 1024 + col;
    float v[W];
    if constexpr (KIND == EPI_INPROJ) {
        const float rs = p.rs;
#pragma unroll
        for (int i = 0; i < W; ++i) v[i] = a[i] * rs;
        const int b = row >> 12, s = row & 4095;
        if constexpr (T == T_KROPE || T == T_QC || T == T_KC) {
#pragma unroll
            for (int j = 0; j < 4; ++j) { const float c = p.a[j], sn = p.b[j], x1 = v[2 * j], x2 = v[2 * j + 1]; v[2 * j] = x1 * c - x2 * sn; v[2 * j + 1] = x2 * c + x1 * sn; } }
        if constexpr (T == T_QA) { const int cc = col, h = cc >> 6, d = cc & 63;
#pragma unroll
            for (int i = 0; i < W; ++i) v[i] *= C2;
            store_bf<W>((bf16*)(ws + OFF_QA) + ((size_t)(b * 8 + h) * 4096 + s) * 64 + d, v);
        } else if constexpr (T == T_KA) { const int cc = col - 512, h = cc >> 6, d = cc & 63;
            store_bf<W>((bf16*)(ws + OFF_KA) + (size_t)(b * 8 + h) * 262144 + ktile_off(s, d), v);
        } else if constexpr (T == T_VA) { const int cc = col - 1024, h = cc >> 6, d = cc & 63;
            store_bf<W>((bf16*)(ws + OFF_VA) + (size_t)(b * 8 + h) * 262144 + vtile_off(s, d), v);
        } else if constexpr (T == T_ZA || T == T_ZB || T == T_ZC) { const int cc = col - (T == T_ZA ? 1536 : T == T_ZB ? 3328 : 5376);
#pragma unroll
            for (int i = 0; i < W; ++i) v[i] = siluf_(v[i]);
            store_bf<W>((bf16*)(ws + (T == T_ZA ? OFF_ZA : T == T_ZB ? OFF_ZB : OFF_ZC)) + (size_t)row * 512 + cc, v);
        } else if constexpr (T == T_QB) { const int cc = col - 2048, h = cc >> 6, d = cc & 63;
#pragma unroll
            for (int i = 0; i < W; ++i) v[i] *= C2;
            store_bf<W>((bf16*)(ws + OFF_QB) + ((size_t)(b * 8 + h) * 4096 + s) * 64 + d, v);
        } else if constexpr (T == T_CB) { const int cc = col - 2560, g = (cc >> 6) & 1, d = cc & 63;
            store_bf<W>((bf16*)(ws + (cc < 128 ? OFF_KCB : OFF_VCB)) + ((size_t)(b * 2 + g) * 4096 + s) * 64 + d, v);
        } else if constexpr (T == T_KROPE) { const int cc = col - 2816, g = (cc >> 6) & 1, d = cc & 63;
            store_bf<W>((bf16*)(ws + (cc < 128 ? OFF_KSEL : OFF_KWIN)) + (size_t)(b * 2 + g) * 262144 + ktile_off(s, d), v);
        } else if constexpr (T == T_VSW) { const int cc = col - 3072, g = (cc >> 6) & 1, d = cc & 63;
            store_bf<W>((bf16*)(ws + (cc < 128 ? OFF_VSEL : OFF_VWIN)) + (size_t)(b * 2 + g) * 262144 + vtile_off(s, d), v);
        } else if constexpr (T == T_QC) { const int cc = col - 3840, h = cc >> 6, d = cc & 63;
#pragma unroll
            for (int i = 0; i < W; ++i) v[i] *= C2;
            store_bf<W>((bf16*)(ws + OFF_QC) + ((size_t)(b * 8 + h) * 4096 + s) * 64 + d, v);
        } else if constexpr (T == T_KC) { const int cc = col - 4352, h = cc >> 6, d = cc & 63;
            store_bf<W>((bf16*)(ws + OFF_KC) + (size_t)(b * 8 + h) * 262144 + ktile_off(s, d), v);
        } else if constexpr (T == T_VC) { const int cc = col - 4864, hc = cc >> 7, d = cc & 127;
            store_bf<W>((bf16*)(ws + OFF_VC) + (size_t)(b * 4 + hc) * 524288 + v128_off(s, d), v);
        } else { const int cc = col - 5888;
            if (cc < 8) { float* o = (float*)(ws + OFF_LOGF) + (size_t)row * 8 + cc;
#pragma unroll
                for (int i = 0; i < W; ++i) o[i] = logsigmoidf_(v[i] + E.bfg[cc + i]) * LOG2E;
            } else if (cc < 32) { float* o = (float*)(ws + OFF_GATES) + (size_t)row * 24 + (cc - 8);
#pragma unroll
                for (int i = 0; i < W; ++i) o[i] = sigmoidf_(v[i]);
            }
        }
    } else if constexpr (KIND == EPI_GATE3) {
#pragma unroll
        for (int i = 0; i < W; ++i) v[i] = sigmoidf_(a[i] * p.rs);
        store_bf<W>((bf16*)(ws + OFF_G) + (size_t)E.gi * M * 1024 + idx, v);
    } else if constexpr (KIND == EPI_BR3) {
#pragma unroll
        for (int i = 0; i < W; ++i) v[i] = p.a[i] * a[i] + p.b[i];
        store_bf<W>((bf16*)(ws + OFF_T) + idx, v);
    } else if constexpr (KIND == EPI_GATE) {
#pragma unroll
        for (int i = 0; i < W; ++i) v[i] = sigmoidf_(a[i] * p.rs);
        store_bf<W>((bf16*)(ws + OFF_G) + idx, v);
    } else if constexpr (KIND == EPI_BR0 || KIND == EPI_BR1 || KIND == EPI_BR2) {
#pragma unroll
        for (int i = 0; i < W; ++i) { v[i] = p.a[i] * a[i]; if (KIND != EPI_BR0) v[i] += p.b[i]; }
        if constexpr (KIND == EPI_BR2) store_bf<W>((bf16*)(ws + OFF_MERGED) + idx, v);
        else store_bf<W>((bf16*)(ws + OFF_T) + idx, v);
    } else if constexpr (KIND == EPI_OUT) {
#pragma unroll
        for (int i = 0; i < W; ++i) v[i] = p.a[i] + a[i];
        st_f32x8(E.X + idx, v);
        store_bf<W>((bf16*)(ws + OFF_X1B) + idx, v);
    } else if constexpr (KIND == EPI_U) {
        store_bf<W>((bf16*)(ws + OFF_U) + idx, a);
    } else if constexpr (KIND == EPI_PLE) {
#pragma unroll
        for (int i = 0; i < W; ++i) v[i] = p.a[i] + sigmoidf_(a[i]) * p.b[i];
        st_f32x8(E.X + idx, v);
        store_bf<W>((bf16*)(ws + OFF_XB) + idx, v);
    }
}

__device__ __forceinline__ void d_xprep(int vb, int vt, const float* x, unsigned char* ws) {
    const int row = vb * 4 + (vt >> 6), lane = vt & 63;
    const f32x4* xr = (const f32x4*)(x + (size_t)row * 1024) + lane; float ss = 0.f;
    bf16* o = (bf16*)(ws + OFF_XB) + (size_t)row * 1024;
#pragma unroll
    for (int j = 0; j < 4; ++j) { const f32x4 v = xr[64 * j]; ss += (v[0] * v[0] + v[1] * v[1]) + (v[2] * v[2] + v[3] * v[3]); float t[4] = {v[0], v[1], v[2], v[3]}; store_bf<4>(o + 256 * j + 4 * lane, t); }
#pragma unroll
    for (int of = 1; of < 64; of <<= 1) ss += __shfl_xor(ss, of);
    if (lane == 0) { f32x4 s = {ss, 0.f, 0.f, 0.f}; *(f32x4*)(ws + OFF_SSP + (size_t)row * 16) = s; }
}
__device__ __forceinline__ void d_sumsq(int vb, int vt, const float* x, unsigned char* ws) {
    const int row = vb * 4 + (vt >> 6), lane = vt & 63;
    const f32x4* xr = (const f32x4*)(x + (size_t)row * 1024) + lane; float ss = 0.f;
#pragma unroll
    for (int j = 0; j < 4; ++j) { const f32x4 v = xr[64 * j]; ss += (v[0] * v[0] + v[1] * v[1]) + (v[2] * v[2] + v[3] * v[3]); }
#pragma unroll
    for (int of = 1; of < 64; of <<= 1) ss += __shfl_xor(ss, of);
    if (lane == 0) { f32x4 s = {ss, 0.f, 0.f, 0.f}; *(f32x4*)(ws + OFF_SSP + (size_t)row * 16) = s; }
}
__device__ __forceinline__ void d_rope_table(int vb, int vt, const int* pos, unsigned char* ws) {
    const int idx = vb * 256 + vt, row = idx >> 5, i = idx & 31;
    const float inv = exp2f(-(float)i * (13.287712379549449f / 32.f));
    const float ang = (float)pos[row] * inv;
    float s, c; sincosf(ang, &s, &c);
    ((float*)(ws + OFF_COS))[idx] = c; ((float*)(ws + OFF_SIN))[idx] = s;
}
__device__ __forceinline__ void d_pconv(int vb, int vt, const float* p, unsigned char* ws) {
    const size_t i = ((size_t)vb * 256 + vt) * 4;
    const f32x4 v = *(const f32x4*)(p + i); float t[4] = {v[0], v[1], v[2], v[3]}; store_bf<4>((bf16*)(ws + OFF_PB) + i, t);
}
constexpr size_t OFF_CBPART = OFF_CTL + 65536;
__device__ __forceinline__ void d_cb1_part(int u, int vt, const float* pe_k, const float* w1_k, const float* pe_v, const float* w1_v, unsigned char* ws) {
    const int kv = u >> 4, kc = u & 15, j = vt;
    const float* pe = (kv ? pe_v : pe_k) + 128 * kc; const float* w1 = (kv ? w1_v : w1_k) + (size_t)(128 * kc) * 256 + j;
    float acc = 0.f;
#pragma unroll 16
    for (int k = 0; k < 128; ++k) acc += pe[k] * w1[(size_t)k * 256];
    ((float*)(ws + OFF_CBPART))[(kv * 16 + kc) * 256 + j] = acc;
}
__device__ __forceinline__ void d_cb1_sum(int vt, const float* b1_k, const float* b1_v, unsigned char* ws) {
    const int kv = vt >> 8, j = vt & 255; float acc = (kv ? b1_v : b1_k)[j];
#pragma unroll
    for (int kc = 0; kc < 16; ++kc) acc += ((const float*)(ws + OFF_CBPART))[(kv * 16 + kc) * 256 + j];
    ((float*)(ws + OFF_CB1))[kv * 256 + j] = acc;
}
__device__ __forceinline__ void d_lam(int vt, const float* dl, unsigned char* ws, int l) {
    if (vt == 0) { float s1 = 0.f, s2 = 0.f; for (int i = 0; i < 64; ++i) { s1 += dl[i] * dl[64 + i]; s2 += dl[128 + i] * dl[192 + i]; }
        const float li = 0.8f - 0.6f * expf(-0.3f * (float)l); ((float*)(ws + OFF_CTL))[CTL_LAM + l] = expf(s1) - expf(s2) + li; }
}
__device__ __forceinline__ void d_final(int vb, int vt, float* X, const float* g) {
    const int row = vb * 4 + (vt >> 6), lane = vt & 63;
    f32x4* xr = (f32x4*)(X + (size_t)row * 1024) + lane; f32x4 v[4]; float ss = 0.f;
#pragma unroll
    for (int j = 0; j < 4; ++j) { v[j] = xr[64 * j]; ss += (v[j][0] * v[j][0] + v[j][1] * v[j][1]) + (v[j][2] * v[j][2] + v[j][3] * v[j][3]); }
#pragma unroll
    for (int of = 1; of < 64; of <<= 1) ss += __shfl_xor(ss, of);
    const float rs = rsqrtf(ss * (1.f / 1024.f) + EPS);
#pragma unroll
    for (int j = 0; j < 4; ++j) { const f32x4 gg = *((const f32x4*)g + 64 * j + lane); xr[64 * j] = v[j] * rs * gg; }
}


namespace pg8 {
#define PG8_LAS __attribute__((address_space(3)))
typedef unsigned short bf16_t;
typedef short bf16x8 __attribute__((ext_vector_type(8)));
typedef float f32x4 __attribute__((ext_vector_type(4)));
typedef unsigned u32x4 __attribute__((ext_vector_type(4)));
constexpr int BM = 256, BK = 64, HALF = 128, HTB = HALF * BK * 2  , STAGE_BYTES = 8 * HTB, NXCD = 8, WGM = 8;

__host__ __device__ __forceinline__ int lds_byte(int r, int c) { const int st = (r >> 4) * 2 + (c >> 5), rr = r & 15, cc = c & 31, ob = rr * 64 + cc * 2; return st * 1024 + (ob ^ (((ob >> 9) & 1) << 5)); }
__host__ __device__ __forceinline__ void stage_rc(int b, int& R, int& C) { const int st = b / 1024, sb = b % 1024, swz = sb ^ (((sb >> 9) & 1) << 5); R = (st >> 1) * 16 + swz / 64; C = (st & 1) * 32 + (swz % 64) / 2; }
__host__ __device__ __forceinline__ int perm32(int rho) { const int n = rho >> 4, i = rho & 15; return 8 * (i >> 2) + 4 * n + (i & 3); }

struct Unit { int pm, pn; };
struct Gemm { const bf16_t* A; const bf16_t* Bt; int M, N, K; };

struct StaticOrder {
    int nM, nN, nwg, G, c;
    __host__ __device__ void init(int M, int N, int G_, int c_) { nM = M / BM; nN = N / BM; nwg = nM * nN; G = G_; c = c_; }
    __host__ __device__ bool next(int i, Unit& u) const {
        const long L = (long)i * G + c; if (L >= nwg) return false;
        int wgid = (int)L; { const int q = nwg / NXCD, r = nwg % NXCD, xcd = wgid % NXCD, off = wgid / NXCD; wgid = (xcd < r ? xcd * (q + 1) : r * (q + 1) + (xcd - r) * q) + off; }
        const int nig = WGM * nN, gid = wgid / nig, fm = gid * WGM, gsz = (nM - fm) < WGM ? (nM - fm) : WGM;
        u.pm = fm + ((wgid % nig) % gsz); u.pn = (wgid % nig) / gsz; return true;
    }
    __device__ __forceinline__ void a_ready(const Unit&) const {}
    __device__ __forceinline__ void done(const Unit&) const {}
};

__device__ __forceinline__ unsigned cvt_pk_bf16(float lo, float hi) { unsigned r; asm volatile("v_cvt_pk_bf16_f32 %0, %1, %2" : "=v"(r) : "v"(lo), "v"(hi)); return r; }
typedef float f32x2 __attribute__((ext_vector_type(2)));
template <class Epi, class Sched, bool ALIGN_EPI = false, bool SP2 = false>
__device__ __forceinline__ void gemm_phase(PG8_LAS unsigned char* lds, const Gemm g, const Sched& S, const Epi& E) {
    int tid_o = threadIdx.x; asm volatile("" : "+v"(tid_o));
    const int tid = tid_o, wid = __builtin_amdgcn_readfirstlane(tid >> 6), lane = tid & 63, wr = wid >> 2, wc = wid & 3, fr = lane & 15, fq = lane >> 4;
    const int K = g.K, nt = K / BK;
    unsigned voffA[2], voffB[2];
#pragma unroll
    for (int i = 0; i < 2; ++i) { int R, C; stage_rc(tid * 16 + i * 8192, R, C); const int Rb = Epi::PERM ? ((R & ~31) + perm32(R & 31)) : R;
        voffA[i] = (unsigned)(R * K + C) * 2u; voffB[i] = (unsigned)(Rb * K + C) * 2u; }
    const size_t kstep = (size_t)(BK * 2);
    const size_t hstep = (size_t)HALF * K * 2;
    const size_t tstep = 2 * hstep;
    const unsigned ldsw = (unsigned)wid * 1024u;
    const int aoff = lds_byte(wr * 64 + fr, fq * 8), boff = lds_byte(wc * 32 + fr, fq * 8);
#define PG8_SA(b, h) (((b) * 2 + (h)) * HTB)
#define PG8_SB(b, h) ((4 + (b) * 2 + (h)) * HTB)
#define PG8_STAGE(bufoff, gbase, voff) do { _Pragma("unroll") for (int _i = 0; _i < 2; ++_i) \
        __builtin_amdgcn_global_load_lds((const unsigned*)((const char*)(gbase) + (voff)[_i]), (PG8_LAS unsigned*)(lds + (bufoff) + ldsw + _i * 8192), 16, 0, 0); } while (0)
#define PG8_LDA(dst, b, h) do { _Pragma("unroll") for (int m = 0; m < 4; ++m) _Pragma("unroll") for (int k = 0; k < 2; ++k) dst[m][k] = *(const PG8_LAS bf16x8*)(lds + PG8_SA(b, h) + aoff + m * 2048 + k * 1024); } while (0)
#define PG8_LDB(dst, b, h) do { _Pragma("unroll") for (int n = 0; n < 2; ++n) _Pragma("unroll") for (int k = 0; k < 2; ++k) dst[n][k] = *(const PG8_LAS bf16x8*)(lds + PG8_SB(b, h) + boff + n * 2048 + k * 1024); } while (0)
#define PG8_MMA(ai, bj, At, Bt) do { __builtin_amdgcn_s_setprio(1); _Pragma("unroll") for (int m = 0; m < 4; ++m) _Pragma("unroll") for (int n = 0; n < 2; ++n) _Pragma("unroll") for (int k = 0; k < 2; ++k) \
        acc[ai][bj][m][n] = __builtin_amdgcn_mfma_f32_16x16x32_bf16(Bt[n][k], At[m][k], acc[ai][bj][m][n], 0, 0, 0); __builtin_amdgcn_s_setprio(0); } while (0)
#define PG8_WAIT_V(n) asm volatile("s_waitcnt vmcnt(" #n ")" ::: "memory")
#define PG8_WAIT_L(n) asm volatile("s_waitcnt lgkmcnt(" #n ")" ::: "memory")
#define PG8_BAR __builtin_amdgcn_s_barrier()
#define PG8_SCHED __builtin_amdgcn_sched_barrier(0)
    Unit cur, nxt; int ui = 0;
    if (!S.next(0, cur)) return;
    f32x4 acc[2][2][4][2];
#pragma unroll
    for (int a = 0; a < 2; ++a)
#pragma unroll
        for (int b = 0; b < 2; ++b)
#pragma unroll
            for (int m = 0; m < 4; ++m)
#pragma unroll
                for (int n = 0; n < 2; ++n) acc[a][b][m][n] = (f32x4){0.f, 0.f, 0.f, 0.f};
    bf16x8 At[4][2], B0[2][2], B1[2][2];
    const char* cA = (const char*)g.A + (size_t)cur.pm * tstep; const char* cB = (const char*)g.Bt + (size_t)cur.pn * tstep;
    S.a_ready(cur);
    if constexpr (SP2) {
        PG8_STAGE(PG8_SB(0, 0), cB, voffB); PG8_STAGE(PG8_SB(0, 1), cB + hstep, voffB); PG8_STAGE(PG8_SA(0, 0), cA, voffA); PG8_STAGE(PG8_SA(0, 1), cA + hstep, voffA);
        if (wr == 1) PG8_BAR;
        PG8_WAIT_V(2); PG8_BAR;
        PG8_STAGE(PG8_SB(1, 0), cB + kstep, voffB); PG8_STAGE(PG8_SA(1, 0), cA + kstep, voffA); PG8_STAGE(PG8_SB(1, 1), cB + hstep + kstep, voffB);
        PG8_WAIT_V(6); PG8_BAR;
    } else {
        PG8_STAGE(PG8_SB(0, 0), cB, voffB); PG8_STAGE(PG8_SA(0, 0), cA, voffA); PG8_STAGE(PG8_SB(0, 1), cB + hstep, voffB); PG8_STAGE(PG8_SA(0, 1), cA + hstep, voffA);
        if (wr == 1) PG8_BAR;
        PG8_WAIT_V(4); PG8_BAR;
        PG8_STAGE(PG8_SB(1, 0), cB + kstep, voffB); PG8_STAGE(PG8_SA(1, 0), cA + kstep, voffA); PG8_STAGE(PG8_SB(1, 1), cB + hstep + kstep, voffB);
        PG8_WAIT_V(6); PG8_BAR;
    }
    for (;;) {
        const bool has_next = S.next(ui + 1, nxt);
        const char* nA = has_next ? (const char*)g.A + (size_t)nxt.pm * tstep : cA; const char* nB = has_next ? (const char*)g.Bt + (size_t)nxt.pn * tstep : cB;
        for (int t = 0; t < nt; t += 2) {
            const bool last = (t == nt - 2);
            const char* a1 = cA + (size_t)(t + 1) * kstep;
            const char* a2 = last ? nA : cA + (size_t)(t + 2) * kstep; const char* b2 = last ? nB : cB + (size_t)(t + 2) * kstep;
            const char* a3 = a2 + kstep; const char* b3 = b2 + kstep;
            if (last && has_next) S.a_ready(nxt);
            if constexpr (SP2) {
            PG8_LDB(B0, 0, 0); PG8_LDB(B1, 0, 1); PG8_SCHED; PG8_LDA(At, 0, 0); PG8_STAGE(PG8_SA(1, 1), a1 + hstep, voffA);
            PG8_WAIT_V(8); PG8_WAIT_L(0); PG8_BAR; PG8_MMA(0, 0, At, B0); PG8_MMA(0, 1, At, B1); PG8_BAR; PG8_SCHED;
            PG8_LDA(At, 0, 1); PG8_STAGE(PG8_SB(0, 0), b2, voffB); PG8_STAGE(PG8_SB(0, 1), b2 + hstep, voffB); PG8_STAGE(PG8_SA(0, 0), a2, voffA);
            PG8_WAIT_V(8); PG8_WAIT_L(0); PG8_BAR; PG8_MMA(1, 0, At, B0); PG8_MMA(1, 1, At, B1); PG8_BAR; PG8_SCHED;
            PG8_LDB(B0, 1, 0); PG8_LDB(B1, 1, 1); PG8_SCHED; PG8_LDA(At, 1, 0); PG8_STAGE(PG8_SA(0, 1), a2 + hstep, voffA);
            PG8_WAIT_V(8); PG8_WAIT_L(0); PG8_BAR; PG8_MMA(0, 0, At, B0); PG8_MMA(0, 1, At, B1); PG8_BAR; PG8_SCHED;
            PG8_LDA(At, 1, 1); PG8_STAGE(PG8_SB(1, 0), b3, voffB); PG8_STAGE(PG8_SB(1, 1), b3 + hstep, voffB); PG8_STAGE(PG8_SA(1, 0), a3, voffA);
            PG8_WAIT_V(8); PG8_WAIT_L(0); PG8_BAR; PG8_MMA(1, 0, At, B0); PG8_MMA(1, 1, At, B1); PG8_BAR; PG8_SCHED;
            } else {
            PG8_LDB(B0, 0, 0); PG8_SCHED; PG8_LDA(At, 0, 0); PG8_STAGE(PG8_SA(1, 1), a1 + hstep, voffA);
            PG8_WAIT_L(8); PG8_BAR; PG8_WAIT_L(0); PG8_MMA(0, 0, At, B0); PG8_BAR; PG8_SCHED;
            PG8_LDB(B1, 0, 1); PG8_STAGE(PG8_SB(0, 0), b2, voffB);
            PG8_BAR; PG8_WAIT_L(0); PG8_MMA(0, 1, At, B1); PG8_BAR;
            PG8_LDA(At, 0, 1); PG8_STAGE(PG8_SA(0, 0), a2, voffA);
            PG8_BAR; PG8_WAIT_L(0); PG8_MMA(1, 0, At, B0); PG8_BAR; PG8_SCHED;
            PG8_STAGE(PG8_SB(0, 1), b2 + hstep, voffB);
            PG8_WAIT_V(6); PG8_BAR; PG8_MMA(1, 1, At, B1); PG8_BAR;
            PG8_LDB(B0, 1, 0); PG8_SCHED; PG8_LDA(At, 1, 0); PG8_STAGE(PG8_SA(0, 1), a2 + hstep, voffA);
            PG8_WAIT_L(8); PG8_BAR; PG8_WAIT_L(0); PG8_MMA(0, 0, At, B0); PG8_BAR; PG8_SCHED;
            PG8_LDB(B1, 1, 1); PG8_STAGE(PG8_SB(1, 0), b3, voffB);
            PG8_BAR; PG8_WAIT_L(0); PG8_MMA(0, 1, At, B1); PG8_BAR;
            PG8_LDA(At, 1, 1); PG8_STAGE(PG8_SA(1, 0), a3, voffA);
            PG8_BAR; PG8_WAIT_L(0); PG8_MMA(1, 0, At, B0); PG8_BAR; PG8_SCHED;
            PG8_STAGE(PG8_SB(1, 1), b3 + hstep, voffB);
            PG8_WAIT_V(6); PG8_BAR; PG8_MMA(1, 1, At, B1); PG8_BAR;
            }
        }
        if constexpr (ALIGN_EPI) { if (wr == 0) PG8_BAR; }
        if constexpr (!Epi::AFTER_DRAIN) { E(acc, cur, wr, wc, fr, fq); S.done(cur); }
        if (!has_next) break;
#pragma unroll
        for (int a = 0; a < 2; ++a)
#pragma unroll
            for (int b = 0; b < 2; ++b)
#pragma unroll
                for (int m = 0; m < 4; ++m)
#pragma unroll
                    for (int n = 0; n < 2; ++n) acc[a][b][m][n] = (f32x4){0.f, 0.f, 0.f, 0.f};
        cur = nxt; cA = nA; cB = nB; ++ui;
        if constexpr (ALIGN_EPI) { if (wr == 1) PG8_BAR; }
    }
    PG8_WAIT_V(0);
    if constexpr (!ALIGN_EPI) { if (wr == 0) PG8_BAR; }
    PG8_BAR;
    if constexpr (Epi::AFTER_DRAIN) { E.fused(acc, cur, wr, wc, fr, fq, lds, wid, lane); S.done(cur); }
#undef PG8_SA
#undef PG8_SB
#undef PG8_STAGE
#undef PG8_LDA
#undef PG8_LDB
#undef PG8_MMA
#undef PG8_WAIT_V
#undef PG8_WAIT_L
#undef PG8_BAR
#undef PG8_SCHED
}
}

template <int KIND> struct EpiFast {
    static constexpr bool PERM = true, AFTER_DRAIN = false;
    EpiCtx E;
    template <int T, int AI, int MH> __device__ __forceinline__ void grp(const pg8::f32x4 (&acc)[2][2][4][2], int row0, int col0, const float (&rs)[2][4]) const {
        Pre p00, p01, p10, p11;
        p00.rs = p01.rs = rs[AI][2 * MH]; p10.rs = p11.rs = rs[AI][2 * MH + 1];
        const int r0 = row0 + AI * 128 + (2 * MH) * 16, r1 = r0 + 16;
        if constexpr (KIND == EPI_PLE) {
            pre_load<KIND, T>(E, r0, col0, p00); pre_load<KIND, T>(E, r0, col0 + 128, p01);
            { const pg8::f32x4 v0 = acc[AI][0][2 * MH][0], v1 = acc[AI][0][2 * MH][1]; float v[8] = {v0[0], v0[1], v0[2], v0[3], v1[0], v1[1], v1[2], v1[3]}; emit_fin<KIND, T>(E, r0, col0, v, p00); }
            { const pg8::f32x4 v0 = acc[AI][1][2 * MH][0], v1 = acc[AI][1][2 * MH][1]; float v[8] = {v0[0], v0[1], v0[2], v0[3], v1[0], v1[1], v1[2], v1[3]}; emit_fin<KIND, T>(E, r0, col0 + 128, v, p01); }
            asm volatile("" ::: "memory");
            pre_load<KIND, T>(E, r1, col0, p10); pre_load<KIND, T>(E, r1, col0 + 128, p11);
            { const pg8::f32x4 v0 = acc[AI][0][2 * MH + 1][0], v1 = acc[AI][0][2 * MH + 1][1]; float v[8] = {v0[0], v0[1], v0[2], v0[3], v1[0], v1[1], v1[2], v1[3]}; emit_fin<KIND, T>(E, r1, col0, v, p10); }
            { const pg8::f32x4 v0 = acc[AI][1][2 * MH + 1][0], v1 = acc[AI][1][2 * MH + 1][1]; float v[8] = {v0[0], v0[1], v0[2], v0[3], v1[0], v1[1], v1[2], v1[3]}; emit_fin<KIND, T>(E, r1, col0 + 128, v, p11); }
            asm volatile("" ::: "memory");
            return;
        }
        pre_load<KIND, T>(E, r0, col0, p00); pre_load<KIND, T>(E, r0, col0 + 128, p01); pre_load<KIND, T>(E, r1, col0, p10); pre_load<KIND, T>(E, r1, col0 + 128, p11);
        { const pg8::f32x4 v0 = acc[AI][0][2 * MH][0], v1 = acc[AI][0][2 * MH][1]; float v[8] = {v0[0], v0[1], v0[2], v0[3], v1[0], v1[1], v1[2], v1[3]}; emit_fin<KIND, T>(E, r0, col0, v, p00); }
        { const pg8::f32x4 v0 = acc[AI][1][2 * MH][0], v1 = acc[AI][1][2 * MH][1]; float v[8] = {v0[0], v0[1], v0[2], v0[3], v1[0], v1[1], v1[2], v1[3]}; emit_fin<KIND, T>(E, r0, col0 + 128, v, p01); }
        { const pg8::f32x4 v0 = acc[AI][0][2 * MH + 1][0], v1 = acc[AI][0][2 * MH + 1][1]; float v[8] = {v0[0], v0[1], v0[2], v0[3], v1[0], v1[1], v1[2], v1[3]}; emit_fin<KIND, T>(E, r1, col0, v, p10); }
        { const pg8::f32x4 v0 = acc[AI][1][2 * MH + 1][0], v1 = acc[AI][1][2 * MH + 1][1]; float v[8] = {v0[0], v0[1], v0[2], v0[3], v1[0], v1[1], v1[2], v1[3]}; emit_fin<KIND, T>(E, r1, col0 + 128, v, p11); }
        asm volatile("" ::: "memory");
    }
    template <int T> __device__ __forceinline__ void run(const pg8::f32x4 (&acc)[2][2][4][2], int row0, int col0) const {
        float rs[2][4];
        if constexpr (KIND == EPI_INPROJ || KIND == EPI_GATE || KIND == EPI_GATE3) {
#pragma unroll
            for (int ai = 0; ai < 2; ++ai)
#pragma unroll
                for (int m = 0; m < 4; ++m) rs[ai][m] = row_rstd(E.ws, row0 + ai * 128 + m * 16);
        } else {
#pragma unroll
            for (int ai = 0; ai < 2; ++ai)
#pragma unroll
                for (int m = 0; m < 4; ++m) rs[ai][m] = 1.f; }
        grp<T, 0, 0>(acc, row0, col0, rs); grp<T, 0, 1>(acc, row0, col0, rs); grp<T, 1, 0>(acc, row0, col0, rs); grp<T, 1, 1>(acc, row0, col0, rs);
    }
    __device__ __forceinline__ void operator()(const pg8::f32x4 (&acc)[2][2][4][2], const pg8::Unit& u, int wr, int wc, int fr, int fq) const {
        const int row0 = u.pm * 256 + wr * 64 + fr, col0 = u.pn * 256 + wc * 32 + 8 * fq;
        if constexpr (KIND == EPI_INPROJ) {
            switch (inproj_type(u.pn)) {
                case T_QA: run<T_QA>(acc, row0, col0); break;
                case T_KA: run<T_KA>(acc, row0, col0); break;
                case T_VA: run<T_VA>(acc, row0, col0); break;
                case T_ZA: run<T_ZA>(acc, row0, col0); break;
                case T_QB: run<T_QB>(acc, row0, col0); break;
                case T_CB: run<T_CB>(acc, row0, col0); break;
                case T_KROPE: run<T_KROPE>(acc, row0, col0); break;
                case T_VSW: run<T_VSW>(acc, row0, col0); break;
                case T_ZB: run<T_ZB>(acc, row0, col0); break;
                case T_QC: run<T_QC>(acc, row0, col0); break;
                case T_KC: run<T_KC>(acc, row0, col0); break;
                case T_VC: run<T_VC>(acc, row0, col0); break;
                case T_ZC: run<T_ZC>(acc, row0, col0); break;
                default: run<T_SPECIAL>(acc, row0, col0); break;
            }
        } else if constexpr (KIND == EPI_GATE3 || KIND == EPI_BR3) {
            EpiFast<KIND> t = *this; t.E.gi = u.pn >> 2;
            t.template run<0>(acc, (u.pm & 63) * 256 + wr * 64 + fr, (u.pn & 3) * 256 + wc * 32 + 8 * fq);
        } else run<0>(acc, row0, col0);
    }
};
struct ChainOrder {
    int pm, pn4, rowmul;
    __device__ __forceinline__ void init(int G, int c, int rowmul_) { pg8::StaticOrder S0; S0.init(M, 1024, G, c); pg8::Unit u0; S0.next(0, u0); pm = u0.pm; pn4 = u0.pn; rowmul = rowmul_; }
    __device__ __forceinline__ bool next(int i, pg8::Unit& u) const { if (i >= 3) return false; u.pm = pm + 64 * i * rowmul; u.pn = 4 * i + pn4; return true; }
    __device__ __forceinline__ void a_ready(const pg8::Unit&) const {}
    __device__ __forceinline__ void done(const pg8::Unit&) const {}
};
#define FAST_GEMM(KIND, Aptr, Bptr, N_, K_, ALIGN) do { pg8::Gemm g_{(const pg8::bf16_t*)(Aptr), (const pg8::bf16_t*)(Bptr), M, (N_), (K_)}; pg8::StaticOrder S_; S_.init(M, (N_), (int)gridDim.x, (int)blockIdx.x); \
        EpiFast<KIND> Ep_{E}; pg8::gemm_phase<EpiFast<KIND>, pg8::StaticOrder, ALIGN, true>((PG8_LAS unsigned char*)lds, g_, S_, Ep_); } while (0)

#define LAS __attribute__((address_space(3)))
typedef short s16x4 __attribute__((ext_vector_type(4)));
typedef short v4i16_t __attribute__((ext_vector_type(4)));
typedef LAS const char* lds_cptr;
constexpr int A_KRING = 0, A_VRING = 49152, A_CFRING = 98304, A_MISC = 104448;
constexpr int A_SLOT = 16384;
constexpr int A_IMP = A_MISC, A_SELM = A_MISC + 16384, A_UMASK = A_SELM + 512, A_SEQ = A_UMASK + 16, A_WQ = A_SEQ + 80;
__device__ __forceinline__ void glds16(const void* gsrc, unsigned lds_dst) { unsigned keep;
    asm volatile("s_mov_b32 %0, m0\n\ts_mov_b32 m0, %2\n\ts_nop 0\n\tglobal_load_lds_dwordx4 %1, off\n\ts_mov_b32 m0, %0" : "=&s"(keep) : "v"(gsrc), "s"(lds_dst) : "memory"); }
__device__ __forceinline__ void glds4(const void* gsrc, unsigned lds_dst) { unsigned keep;
    asm volatile("s_mov_b32 %0, m0\n\ts_mov_b32 m0, %2\n\ts_nop 0\n\tglobal_load_lds_dword %1, off\n\ts_mov_b32 m0, %0" : "=&s"(keep) : "v"(gsrc), "s"(lds_dst) : "memory"); }
#define A_WAIT_BAR(N) asm volatile("s_waitcnt vmcnt(" #N ") lgkmcnt(0)\n\ts_barrier" ::: "memory")
__device__ __forceinline__ s16x4 vtr(lds_cptr p) { return __builtin_bit_cast(s16x4, __builtin_amdgcn_ds_read_tr16_b64_v4i16((LAS v4i16_t*)p)); }
__device__ __forceinline__ unsigned cvtpk(float lo, float hi) { typedef float f2 __attribute__((ext_vector_type(2))); typedef __bf16 b2 __attribute__((ext_vector_type(2))); f2 v = {lo, hi}; b2 b = __builtin_convertvector(v, b2); return __builtin_bit_cast(unsigned, b); }
__device__ __forceinline__ int crow(int r, int hi) { return (r & 3) + 8 * (r >> 2) + 4 * hi; }

template <int NDB> struct FlashSt { f32x16 o[NDB]; float m, l; };
template <int NDB> __device__ __forceinline__ void flash_init(FlashSt<NDB>& st) {
#pragma unroll
    for (int i = 0; i < NDB; ++i)
#pragma unroll
        for (int r = 0; r < 16; ++r) st.o[i][r] = 0.f;
    st.m = -1e30f; st.l = 0.f;
}
template <int NDB> __device__ __forceinline__ void flash_init3(FlashSt<NDB>& st) { flash_init<NDB>(st); st.m = 0.f; }
__device__ __forceinline__ void qk_tile(f32x16& p0, f32x16& p1, lds_cptr kslot, const bf16x8 (&qf)[4], int r32, int hi) {
    const lds_cptr kb = kslot + hi * 1024 + r32 * 16;
    bf16x8 ka[4], kc[4];
#pragma unroll
    for (int d0 = 0; d0 < 4; ++d0) { ka[d0] = *(const LAS bf16x8*)(kb + d0 * 2048); kc[d0] = *(const LAS bf16x8*)(kb + d0 * 2048 + 512); }
#pragma unroll
    for (int d0 = 0; d0 < 4; ++d0) {
        p0 = __builtin_amdgcn_mfma_f32_32x32x16_bf16(ka[d0], qf[d0], p0, 0, 0, 0);
        p1 = __builtin_amdgcn_mfma_f32_32x32x16_bf16(kc[d0], qf[d0], p1, 0, 0, 0);
    }
}
__device__ __forceinline__ float xhalf_max(float a) {
    auto rr = __builtin_amdgcn_permlane32_swap(__float_as_uint(a), __float_as_uint(a), false, false);
    return fmaxf(__uint_as_float(rr[0]), __uint_as_float(rr[1]));
}
__device__ __forceinline__ float rowmax32(const f32x16& p0, const f32x16& p1) {
    float a = fmaxf(p0[0], p1[0]);
#pragma unroll
    for (int r = 1; r < 16; ++r) a = fmaxf(a, fmaxf(p0[r], p1[r]));
    return xhalf_max(a);
}
template <int NDB> __device__ __forceinline__ void pv_tile(f32x16 (&o)[NDB], lds_cptr vslot_l, const f32x16& p0, const f32x16& p1) {
    bf16x8 pf[4];
    { u32x4 w;
      w.x = cvtpk(p0[0], p0[1]); w.y = cvtpk(p0[2], p0[3]); w.z = cvtpk(p0[4], p0[5]); w.w = cvtpk(p0[6], p0[7]); pf[0] = __builtin_bit_cast(bf16x8, w);
      w.x = cvtpk(p0[8], p0[9]); w.y = cvtpk(p0[10], p0[11]); w.z = cvtpk(p0[12], p0[13]); w.w = cvtpk(p0[14], p0[15]); pf[1] = __builtin_bit_cast(bf16x8, w);
      w.x = cvtpk(p1[0], p1[1]); w.y = cvtpk(p1[2], p1[3]); w.z = cvtpk(p1[4], p1[5]); w.w = cvtpk(p1[6], p1[7]); pf[2] = __builtin_bit_cast(bf16x8, w);
      w.x = cvtpk(p1[8], p1[9]); w.y = cvtpk(p1[10], p1[11]); w.z = cvtpk(p1[12], p1[13]); w.w = cvtpk(p1[14], p1[15]); pf[3] = __builtin_bit_cast(bf16x8, w); }
#pragma unroll
    for (int db = 0; db < NDB; ++db) {
        bf16x8 vf[4];
#pragma unroll
        for (int ks = 0; ks < 4; ++ks) { const s16x4 lo = vtr(vslot_l + db * 4096 + ks * 1024), hh = vtr(vslot_l + db * 4096 + ks * 1024 + 512);
            vf[ks] = (bf16x8){lo[0], lo[1], lo[2], lo[3], hh[0], hh[1], hh[2], hh[3]}; }
#pragma unroll
        for (int ks = 0; ks < 4; ++ks) o[db] = __builtin_amdgcn_mfma_f32_32x32x16_bf16(vf[ks], pf[ks], o[db], 0, 0, 0);
    }
}
template <int NDB> __device__ __forceinline__ void flash_update(FlashSt<NDB>& st, f32x16& p0, f32x16& p1, lds_cptr vslot_l) {
    const float rm = rowmax32(p0, p1);
    const float mn = fmaxf(st.m, rm), alpha = __builtin_amdgcn_exp2f(st.m - mn);
    st.m = mn;
    float ls = 0.f;
#pragma unroll
    for (int r = 0; r < 16; ++r) { p0[r] = __builtin_amdgcn_exp2f(p0[r] - mn); p1[r] = __builtin_amdgcn_exp2f(p1[r] - mn); ls += p0[r] + p1[r]; }
    st.l = st.l * alpha + ls;
#pragma unroll
    for (int db = 0; db < NDB; ++db)
#pragma unroll
        for (int r = 0; r < 16; ++r) st.o[db][r] *= alpha;
    pv_tile<NDB>(st.o, vslot_l, p0, p1);
}
__device__ __forceinline__ int lane_vbase(int lane) { return ((lane >> 4) & 1) * 32 + (lane & 3) * 8 + (4 * (lane >> 5) + ((lane & 15) >> 2)) * 64; }
#define DSR128(dst, addr, off) asm volatile("ds_read_b128 %0, %1 offset:%c2" : "=v"(dst) : "v"(addr), "i"(off) : "memory")
#define DSRTR(dst, addr, off) asm volatile("ds_read_b64_tr_b16 %0, %1 offset:%c2" : "=v"(dst) : "v"(addr), "i"(off) : "memory")
#define LGKM_WAIT0() do { asm volatile("s_waitcnt lgkmcnt(0)" ::: "memory"); __builtin_amdgcn_sched_barrier(0); } while (0)
__device__ __forceinline__ void qk_tile2(f32x16& p0, f32x16& p1, unsigned kaddr, const bf16x8 (&qf)[4]) {
    bf16x8 ka0, ka1, ka2, ka3, kc0, kc1, kc2, kc3;
    DSR128(ka0, kaddr, 0); DSR128(kc0, kaddr, 512); DSR128(ka1, kaddr, 2048); DSR128(kc1, kaddr, 2560);
    DSR128(ka2, kaddr, 4096); DSR128(kc2, kaddr, 4608); DSR128(ka3, kaddr, 6144); DSR128(kc3, kaddr, 6656);
    LGKM_WAIT0();
    __builtin_amdgcn_s_setprio(1);
    p0 = __builtin_amdgcn_mfma_f32_32x32x16_bf16(ka0, qf[0], p0, 0, 0, 0); p1 = __builtin_amdgcn_mfma_f32_32x32x16_bf16(kc0, qf[0], p1, 0, 0, 0);
    p0 = __builtin_amdgcn_mfma_f32_32x32x16_bf16(ka1, qf[1], p0, 0, 0, 0); p1 = __builtin_amdgcn_mfma_f32_32x32x16_bf16(kc1, qf[1], p1, 0, 0, 0);
    p0 = __builtin_amdgcn_mfma_f32_32x32x16_bf16(ka2, qf[2], p0, 0, 0, 0); p1 = __builtin_amdgcn_mfma_f32_32x32x16_bf16(kc2, qf[2], p1, 0, 0, 0);
    p0 = __builtin_amdgcn_mfma_f32_32x32x16_bf16(ka3, qf[3], p0, 0, 0, 0); p1 = __builtin_amdgcn_mfma_f32_32x32x16_bf16(kc3, qf[3], p1, 0, 0, 0);
    __builtin_amdgcn_s_setprio(0);
}
struct VFr { s16x4 lo[8], hi[8]; };
template <int DB0> __device__ __forceinline__ void v_issue(VFr& f, unsigned vaddr) {
    DSRTR(f.lo[0], vaddr, DB0 * 4096 + 0);    DSRTR(f.hi[0], vaddr, DB0 * 4096 + 512);
    DSRTR(f.lo[1], vaddr, DB0 * 4096 + 1024); DSRTR(f.hi[1], vaddr, DB0 * 4096 + 1536);
    DSRTR(f.lo[2], vaddr, DB0 * 4096 + 2048); DSRTR(f.hi[2], vaddr, DB0 * 4096 + 2560);
    DSRTR(f.lo[3], vaddr, DB0 * 4096 + 3072); DSRTR(f.hi[3], vaddr, DB0 * 4096 + 3584);
    DSRTR(f.lo[4], vaddr, DB0 * 4096 + 4096); DSRTR(f.hi[4], vaddr, DB0 * 4096 + 4608);
    DSRTR(f.lo[5], vaddr, DB0 * 4096 + 5120); DSRTR(f.hi[5], vaddr, DB0 * 4096 + 5632);
    DSRTR(f.lo[6], vaddr, DB0 * 4096 + 6144); DSRTR(f.hi[6], vaddr, DB0 * 4096 + 6656);
    DSRTR(f.lo[7], vaddr, DB0 * 4096 + 7168); DSRTR(f.hi[7], vaddr, DB0 * 4096 + 7680);
}
#define VFRAG(f, i) ((bf16x8){(f).lo[i][0], (f).lo[i][1], (f).lo[i][2], (f).lo[i][3], (f).hi[i][0], (f).hi[i][1], (f).hi[i][2], (f).hi[i][3]})
__device__ __forceinline__ void pv2(f32x16& oa, f32x16& ob, const VFr& f, const bf16x8 (&pf)[4]) {
    __builtin_amdgcn_s_setprio(1);
    oa = __builtin_amdgcn_mfma_f32_32x32x16_bf16(VFRAG(f, 0), pf[0], oa, 0, 0, 0); ob = __builtin_amdgcn_mfma_f32_32x32x16_bf16(VFRAG(f, 4), pf[0], ob, 0, 0, 0);
    oa = __builtin_amdgcn_mfma_f32_32x32x16_bf16(VFRAG(f, 1), pf[1], oa, 0, 0, 0); ob = __builtin_amdgcn_mfma_f32_32x32x16_bf16(VFRAG(f, 5), pf[1], ob, 0, 0, 0);
    oa = __builtin_amdgcn_mfma_f32_32x32x16_bf16(VFRAG(f, 2), pf[2], oa, 0, 0, 0); ob = __builtin_amdgcn_mfma_f32_32x32x16_bf16(VFRAG(f, 6), pf[2], ob, 0, 0, 0);
    oa = __builtin_amdgcn_mfma_f32_32x32x16_bf16(VFRAG(f, 3), pf[3], oa, 0, 0, 0); ob = __builtin_amdgcn_mfma_f32_32x32x16_bf16(VFRAG(f, 7), pf[3], ob, 0, 0, 0);
    __builtin_amdgcn_s_setprio(0);
}
__device__ __forceinline__ void pack_p(bf16x8 (&pf)[4], const f32x16& p0, const f32x16& p1) {
    u32x4 w;
    w.x = cvtpk(p0[0], p0[1]); w.y = cvtpk(p0[2], p0[3]); w.z = cvtpk(p0[4], p0[5]); w.w = cvtpk(p0[6], p0[7]); pf[0] = __builtin_bit_cast(bf16x8, w);
    w.x = cvtpk(p0[8], p0[9]); w.y = cvtpk(p0[10], p0[11]); w.z = cvtpk(p0[12], p0[13]); w.w = cvtpk(p0[14], p0[15]); pf[1] = __builtin_bit_cast(bf16x8, w);
    w.x = cvtpk(p1[0], p1[1]); w.y = cvtpk(p1[2], p1[3]); w.z = cvtpk(p1[4], p1[5]); w.w = cvtpk(p1[6], p1[7]); pf[2] = __builtin_bit_cast(bf16x8, w);
    w.x = cvtpk(p1[8], p1[9]); w.y = cvtpk(p1[10], p1[11]); w.z = cvtpk(p1[12], p1[13]); w.w = cvtpk(p1[14], p1[15]); pf[3] = __builtin_bit_cast(bf16x8, w);
}
template <int NDB> __device__ __forceinline__ void flash_update2(FlashSt<NDB>& st, f32x16& p0, f32x16& p1, unsigned vaddr) {
    VFr vf; v_issue<0>(vf, vaddr);
    const float rm = rowmax32(p0, p1);
    const float mn = fmaxf(st.m, rm), alpha = __builtin_amdgcn_exp2f(st.m - mn);
    st.m = mn;
    float ls = 0.f;
#pragma unroll
    for (int r = 0; r < 16; ++r) { p0[r] = __builtin_amdgcn_exp2f(p0[r] - mn); p1[r] = __builtin_amdgcn_exp2f(p1[r] - mn); ls += p0[r] + p1[r]; }
    st.l = st.l * alpha + ls;
#pragma unroll
    for (int db = 0; db < NDB; ++db)
#pragma unroll
        for (int r = 0; r < 16; ++r) st.o[db][r] *= alpha;
    bf16x8 pf[4]; pack_p(pf, p0, p1);
    LGKM_WAIT0();
    pv2(st.o[0], st.o[1], vf, pf);
    if constexpr (NDB == 4) { v_issue<2>(vf, vaddr); LGKM_WAIT0(); pv2(st.o[2], st.o[3], vf, pf); }
}
__device__ __forceinline__ float max3_(float a, float b, float c) { float r; asm("v_max3_f32 %0, %1, %2, %3" : "=v"(r) : "v"(a), "v"(b), "v"(c)); return r; }
__device__ __forceinline__ float rowmax32_asm(const f32x16& p0, const f32x16& p1) {
    float a = max3_(p0[0], p0[1], p1[0]), b = max3_(p0[2], p0[3], p1[1]); a = max3_(a, p1[2], p1[3]);
#pragma unroll
    for (int r = 4; r < 16; r += 4) { a = max3_(a, p0[r], p0[r + 1]); b = max3_(b, p0[r + 2], p0[r + 3]); a = max3_(a, p1[r], p1[r + 1]); b = max3_(b, p1[r + 2], p1[r + 3]); }
    float m; asm("v_max_f32_e32 %0, %1, %2" : "=v"(m) : "v"(a), "v"(b));
    auto rr = __builtin_amdgcn_permlane32_swap(__float_as_uint(m), __float_as_uint(m), false, false);
    float o; asm("v_max_f32_e32 %0, %1, %2" : "=v"(o) : "v"(__uint_as_float(rr[0])), "v"(__uint_as_float(rr[1]))); return o;
}
constexpr float FA_THR = 8.f;
template <int NDB> __device__ __forceinline__ bool flash_update3(FlashSt<NDB>& st, f32x16& p0, f32x16& p1, unsigned vaddr) {
    VFr vf; v_issue<0>(vf, vaddr);
    asm volatile("s_nop 15\n\ts_nop 7" : "+v"(p0), "+v"(p1));
    const float rm = rowmax32_asm(p0, p1);
    bool moved = false;
    if (__builtin_expect(__builtin_amdgcn_ballot_w64(rm > FA_THR) != 0ull, 0)) {
        const float dl = fmaxf(rm, 0.f), f = __builtin_amdgcn_exp2f(-dl);
        st.m += dl; st.l *= f;
#pragma unroll
        for (int r = 0; r < 16; ++r) { p0[r] -= dl; p1[r] -= dl; }
#pragma unroll
        for (int db = 0; db < NDB; ++db)
#pragma unroll
            for (int r = 0; r < 16; ++r) st.o[db][r] *= f;
        moved = true;
    }
    float ls = 0.f;
#pragma unroll
    for (int r = 0; r < 16; ++r) { p0[r] = __builtin_amdgcn_exp2f(p0[r]); p1[r] = __builtin_amdgcn_exp2f(p1[r]); ls += p0[r] + p1[r]; }
    st.l += ls;
    bf16x8 pf[4]; pack_p(pf, p0, p1);
    LGKM_WAIT0();
    pv2(st.o[0], st.o[1], vf, pf);
    if constexpr (NDB == 4) { v_issue<2>(vf, vaddr); LGKM_WAIT0(); pv2(st.o[2], st.o[3], vf, pf); }
    return moved;
}
__device__ __forceinline__ void pv_only2(f32x16 (&o)[2], unsigned vaddr, const f32x16& p0, const f32x16& p1) {
    VFr vf; v_issue<0>(vf, vaddr); bf16x8 pf[4]; pack_p(pf, p0, p1); LGKM_WAIT0(); pv2(o[0], o[1], vf, pf);
}

__device__ __forceinline__ void fox_unit(unsigned char* lds, unsigned char* ws, int bh, int qb, int dry = 0) {
    int tid_o = threadIdx.x; asm volatile("" : "+v"(tid_o));
    const int tid = tid_o, lane = tid & 63, wid = __builtin_amdgcn_readfirstlane(tid >> 6), r32 = lane & 31, hi = lane >> 5;
    const unsigned lds0 = (unsigned)(uintptr_t)lds;
    const lds_cptr L = (lds_cptr)lds;
    const int qrow = 256 * qb + 32 * wid + r32, wrow0 = 256 * qb + 32 * wid;
    const int NTl = 4 * (qb + 1);
    const char* Kg = (const char*)(ws + OFF_KA) + (size_t)bh * 524288 + wid * 1024 + lane * 16;
    const char* Vg = (const char*)(ws + OFF_VA) + (size_t)bh * 524288 + wid * 1024 + lane * 16;
    const char* Cg = (const char*)(ws + OFF_CF) + (size_t)bh * 16384 + lane * 4;
    const unsigned kdst = (unsigned)__builtin_amdgcn_readfirstlane(lds0 + A_KRING + wid * 1024), vdst = (unsigned)__builtin_amdgcn_readfirstlane(lds0 + A_VRING + wid * 1024),
                   cdst = (unsigned)__builtin_amdgcn_readfirstlane(lds0 + A_CFRING + wid * 256);
#define FOX_DMA(t, slot) do { glds16(Kg + (size_t)(t) * 8192, kdst + (slot) * A_SLOT); glds16(Vg + (size_t)(t) * 8192, vdst + (slot) * A_SLOT); glds4(Cg + (size_t)(t) * 256, cdst + (slot) * 2048); } while (0)
    asm volatile("s_waitcnt vmcnt(0)" ::: "memory");
    FOX_DMA(0, 0); FOX_DMA(1, 1);
    bf16x8 qf[4];
    { const bf16* Q = (const bf16*)(ws + OFF_QA) + ((size_t)bh * 4096 + qrow) * 64 + 8 * hi;
#pragma unroll
      for (int d0 = 0; d0 < 4; ++d0) qf[d0] = *(const bf16x8*)(Q + 16 * d0); }
    FlashSt<2> st; flash_init3<2>(st);
    const int vb = lane_vbase(lane);
    const unsigned kaddr0 = lds0 + A_KRING + hi * 1024 + r32 * 16, vaddr0 = lds0 + A_VRING + vb;
    asm volatile("" : "+v"(qf[0]), "+v"(qf[1]), "+v"(qf[2]), "+v"(qf[3]));
    asm volatile("s_waitcnt vmcnt(0)" ::: "memory");
    asm volatile("s_barrier" ::: "memory");
    int slot = 0;
    for (int t = 0; t < NTl; ++t) {
        const int s2 = (slot >= 1) ? slot - 1 : 2;
        if (t + 2 < NTl) FOX_DMA(t + 2, s2);
        if (64 * t <= wrow0 + 31 && dry != 4) {
            f32x16 p0, p1;
            { const unsigned ca = lds0 + A_CFRING + slot * 2048 + wid * 256 + 16 * hi; f32x4 c0, c1, c2, c3, c4, c5, c6, c7;
              DSR128(c0, ca, 0); DSR128(c1, ca, 32); DSR128(c2, ca, 64); DSR128(c3, ca, 96); DSR128(c4, ca, 128); DSR128(c5, ca, 160); DSR128(c6, ca, 192); DSR128(c7, ca, 224);
              LGKM_WAIT0();
              p0 = __builtin_shufflevector(__builtin_shufflevector(c0, c1, 0, 1, 2, 3, 4, 5, 6, 7), __builtin_shufflevector(c2, c3, 0, 1, 2, 3, 4, 5, 6, 7), 0, 1, 2, 3, 4, 5, 6, 7, 8, 9, 10, 11, 12, 13, 14, 15);
              p1 = __builtin_shufflevector(__builtin_shufflevector(c4, c5, 0, 1, 2, 3, 4, 5, 6, 7), __builtin_shufflevector(c6, c7, 0, 1, 2, 3, 4, 5, 6, 7), 0, 1, 2, 3, 4, 5, 6, 7, 8, 9, 10, 11, 12, 13, 14, 15);
              p0 = p0 - st.m; p1 = p1 - st.m; }
            qk_tile2(p0, p1, kaddr0 + slot * A_SLOT, qf);
            if (64 * t + 63 > wrow0) {
                const int kb = 64 * t + 4 * hi;
#pragma unroll
                for (int r = 0; r < 16; ++r) { const int kv = kb + (r & 3) + 8 * (r >> 2); if (kv > qrow) p0[r] = -INFINITY; if (kv + 32 > qrow) p1[r] = -INFINITY; }
            }
            if (dry != 3) (void)flash_update3<2>(st, p0, p1, vaddr0 + slot * A_SLOT); else { st.o[0] += p0; st.o[1] += p1; }
        }
        if (dry == 2) { asm volatile("s_waitcnt lgkmcnt(0)\n\ts_barrier" ::: "memory"); } else if (t + 2 < NTl) { A_WAIT_BAR(3); } else { A_WAIT_BAR(0); }
        slot = (slot == 2) ? 0 : slot + 1;
    }
#undef FOX_DMA
    const float lt = st.l + __shfl_xor(st.l, 32), il = 1.f / lt;
    const int b = bh >> 3, h = bh & 7;
    bf16* Y = (bf16*)(ws + OFF_ZA) + (size_t)(b * 4096 + qrow) * 512 + h * 64;
    bf16* Yd = dry ? (bf16*)(ws + OFF_SELM) + (tid * 64) : Y;
#pragma unroll
    for (int db = 0; db < 2; ++db)
#pragma unroll
        for (int rq = 0; rq < 4; ++rq) { bf16* yp = Y + 32 * db + 8 * rq + 4 * hi; bf16* yo = Yd + 32 * db + 8 * rq + 4 * hi; const u32x2 z = *(const u32x2*)yp;
            const float z0 = __uint_as_float(z.x << 16), z1 = __uint_as_float(z.x & 0xffff0000u), z2 = __uint_as_float(z.y << 16), z3 = __uint_as_float(z.y & 0xffff0000u);
            u32x2 o; o.x = pk2(st.o[db][4 * rq] * il * z0, st.o[db][4 * rq + 1] * il * z1); o.y = pk2(st.o[db][4 * rq + 2] * il * z2, st.o[db][4 * rq + 3] * il * z3);
            *(u32x2*)yo = o; }
}

__device__ __forceinline__ void diff_unit(unsigned char* lds, unsigned char* ws, int bhc, int qb, const float* subg, float lam, float lam_init, bool dry = false) {
    int tid_o = threadIdx.x; asm volatile("" : "+v"(tid_o));
    const int tid = tid_o, lane = tid & 63, wid = __builtin_amdgcn_readfirstlane(tid >> 6), r32 = lane & 31, hi = lane >> 5;
    const int map = wid >> 2, wl = wid & 3;
    const unsigned lds0 = (unsigned)(uintptr_t)lds;
    const lds_cptr L = (lds_cptr)lds;
    const int b = bhc >> 2, hc = bhc & 3;
    const int qrow = 128 * qb + 32 * wl + r32, wrow0 = 128 * qb + 32 * wl;
    const int NTl = 2 * (qb + 1);
    const char* Kg = (const char*)(ws + OFF_KC) + (size_t)(b * 8 + hc * 2) * 524288 + wid * 1024 + lane * 16;
    const char* Vg = (const char*)(ws + OFF_VC) + (size_t)bhc * 1048576 + wid * 1024 + lane * 16;
    const unsigned kdst = (unsigned)__builtin_amdgcn_readfirstlane(lds0 + A_KRING + wid * 1024), vdst = (unsigned)__builtin_amdgcn_readfirstlane(lds0 + A_VRING + wid * 1024);
#define DIFF_DMA(t, slot) do { glds16(Kg + (size_t)(t) * 8192, kdst + (slot) * A_SLOT); glds16(Kg + 524288 + (size_t)(t) * 8192, kdst + (slot) * A_SLOT + 8192); \
        glds16(Vg + (size_t)(t) * 16384, vdst + (slot) * A_SLOT); glds16(Vg + (size_t)(t) * 16384 + 8192, vdst + (slot) * A_SLOT + 8192); } while (0)
    asm volatile("s_waitcnt vmcnt(0)" ::: "memory");
    DIFF_DMA(0, 0); DIFF_DMA(1, 1);
    bf16x8 qf[4];
    { const bf16* Q = (const bf16*)(ws + OFF_QC) + ((size_t)(b * 8 + hc * 2 + map) * 4096 + qrow) * 64 + 8 * hi;
#pragma unroll
      for (int d0 = 0; d0 < 4; ++d0) qf[d0] = *(const bf16x8*)(Q + 16 * d0); }
    FlashSt<4> st; flash_init3<4>(st);
    f32x16 negm;
#pragma unroll
    for (int r = 0; r < 16; ++r) negm[r] = 0.f;
    const int vb = lane_vbase(lane);
    const unsigned kaddr0 = lds0 + A_KRING + map * 8192 + hi * 1024 + r32 * 16, vaddr0 = lds0 + A_VRING + vb;
    asm volatile("" : "+v"(qf[0]), "+v"(qf[1]), "+v"(qf[2]), "+v"(qf[3]));
    asm volatile("s_waitcnt vmcnt(0)" ::: "memory");
    asm volatile("s_barrier" ::: "memory");
    int slot = 0;
    for (int t = 0; t < NTl; ++t) {
        const int s2 = (slot >= 1) ? slot - 1 : 2;
        if (t + 2 < NTl) DIFF_DMA(t + 2, s2);
        if (64 * t <= wrow0 + 31) {
            f32x16 p0 = negm, p1 = negm;
            qk_tile2(p0, p1, kaddr0 + slot * A_SLOT, qf);
            if (64 * t + 63 > wrow0) {
                const int kb = 64 * t + 4 * hi;
#pragma unroll
                for (int r = 0; r < 16; ++r) { const int kv = kb + (r & 3) + 8 * (r >> 2); if (kv > qrow) p0[r] = -INFINITY; if (kv + 32 > qrow) p1[r] = -INFINITY; }
            }
            if (flash_update3<4>(st, p0, p1, vaddr0 + slot * A_SLOT)) {
#pragma unroll
                for (int r = 0; r < 16; ++r) negm[r] = -st.m; }
        }
        if (t + 2 < NTl) { A_WAIT_BAR(4); } else { A_WAIT_BAR(0); }
        slot = (slot == 2) ? 0 : slot + 1;
    }
#undef DIFF_DMA
    const float lt = st.l + __shfl_xor(st.l, 32), il = 1.f / lt;
    LAS float* stage = (LAS float*)lds + wl * 4096 + r32;
    if (map == 1) {
#pragma unroll
        for (int db = 0; db < 4; ++db)
#pragma unroll
            for (int r = 0; r < 16; ++r) stage[(32 * db + crow(r, hi)) * 32] = st.o[db][r] * il;
    }
    asm volatile("s_waitcnt lgkmcnt(0)\n\ts_barrier" ::: "memory");
    if (map == 0) {
        float ss = 0.f;
#pragma unroll
        for (int db = 0; db < 4; ++db)
#pragma unroll
            for (int r = 0; r < 16; ++r) { const float v = st.o[db][r] * il - lam * stage[(32 * db + crow(r, hi)) * 32]; st.o[db][r] = v; ss += v * v; }
        ss += __shfl_xor(ss, 32);
        const float rs = rsqrtf(ss * (1.f / 128.f) + EPS) * (1.f - lam_init);
        bf16* Y = (bf16*)(ws + OFF_ZC) + (size_t)(b * 4096 + qrow) * 512 + hc * 128;
        bf16* Yd = dry ? (bf16*)(ws + OFF_SELM) + (tid * 128) : Y;
#pragma unroll
        for (int db = 0; db < 4; ++db)
#pragma unroll
            for (int rq = 0; rq < 4; ++rq) { const int d = 32 * db + 8 * rq + 4 * hi; bf16* yp = Y + d; bf16* yo = Yd + d; const u32x2 z = *(const u32x2*)yp; const f32x4 g = *(const f32x4*)(subg + d);
                const float z0 = __uint_as_float(z.x << 16), z1 = __uint_as_float(z.x & 0xffff0000u), z2 = __uint_as_float(z.y << 16), z3 = __uint_as_float(z.y & 0xffff0000u);
                u32x2 o; o.x = pk2(st.o[db][4 * rq] * rs * g[0] * z0, st.o[db][4 * rq + 1] * rs * g[1] * z1); o.y = pk2(st.o[db][4 * rq + 2] * rs * g[2] * z2, st.o[db][4 * rq + 3] * rs * g[3] * z3);
                *(u32x2*)yo = o; }
    }
    asm volatile("s_waitcnt lgkmcnt(0)\n\ts_barrier" ::: "memory");
}

constexpr int N_SELM = 131072 + 256, N_UMASK = N_SELM + 512, N_SEQC = N_UMASK + 16, N_SEQD = N_SEQC + 80, N_CNT = N_SEQD + 16;
template <int MODE> __device__ __forceinline__ void nsa_ring(FlashSt<2>& st, unsigned char* lds, const char* Kg, const char* Vg, unsigned kdst, unsigned vdst, int n, int seqoff,
                                                             const bf16x8 (&qf)[4], int tb, int qloc, unsigned selLo, unsigned selHi, int r32, int hi, int vb) {
    const lds_cptr L = (lds_cptr)lds;
    const LAS unsigned char* seq = (const LAS unsigned char*)(L + seqoff);
    const unsigned lds0r = (unsigned)(uintptr_t)lds;
#define NSA_DMA(j, slot) do { glds16(Kg + (size_t)(j) * 8192, kdst + (slot) * A_SLOT); glds16(Vg + (size_t)(j) * 8192, vdst + (slot) * A_SLOT); } while (0)
    asm volatile("s_waitcnt vmcnt(0)" ::: "memory");
    { const int j0 = __builtin_amdgcn_readfirstlane((int)seq[0]); NSA_DMA(j0, 0); if (n > 1) { const int j1 = __builtin_amdgcn_readfirstlane((int)seq[1]); NSA_DMA(j1, 1); } }
    A_WAIT_BAR(0);
    int slot = 0;
    f32x16 negm;
#pragma unroll
    for (int r = 0; r < 16; ++r) negm[r] = 0.f;
    for (int i = 0; i < n; ++i) {
        const int s2 = (slot >= 1) ? slot - 1 : 2;
        if (i + 2 < n) { const int j2 = __builtin_amdgcn_readfirstlane((int)seq[i + 2]); NSA_DMA(j2, s2); }
        const int j = __builtin_amdgcn_readfirstlane((int)seq[i]);
        f32x16 p0 = negm, p1 = negm;
        qk_tile2(p0, p1, lds0r + A_KRING + hi * 1024 + r32 * 16 + slot * A_SLOT, qf);
        if (j == tb) {
#pragma unroll
            for (int r = 0; r < 16; ++r) { const int kv = 4 * hi + (r & 3) + 8 * (r >> 2); if (kv > qloc) p0[r] = -INFINITY; if (kv + 32 > qloc) p1[r] = -INFINITY; }
        } else if (MODE == 0) {
            const bool sel = (((j < 32) ? (selLo >> j) : (selHi >> (j - 32))) & 1u) != 0u;
            if (!sel) {
#pragma unroll
                for (int r = 0; r < 16; ++r) { p0[r] = -INFINITY; p1[r] = -INFINITY; } }
        } else if (j == tb - 8) {
#pragma unroll
            for (int r = 0; r < 16; ++r) { const int kv = 4 * hi + (r & 3) + 8 * (r >> 2); if (kv <= qloc) p0[r] = -INFINITY; if (kv + 32 <= qloc) p1[r] = -INFINITY; }
        }
        if (flash_update3<2>(st, p0, p1, lds0r + A_VRING + vb + slot * A_SLOT)) {
#pragma unroll
            for (int r = 0; r < 16; ++r) negm[r] = -st.m; }
        if (i + 2 < n) { A_WAIT_BAR(2); } else { A_WAIT_BAR(0); }
        slot = (slot == 2) ? 0 : slot + 1;
    }
#undef NSA_DMA
}
__device__ __forceinline__ void nsa_unit(unsigned char* lds, unsigned char* ws, int bg, int tb, bool dry = false) {
    int tid_o = threadIdx.x; asm volatile("" : "+v"(tid_o));
    const int tid = tid_o, lane = tid & 63, wid = __builtin_amdgcn_readfirstlane(tid >> 6), r32 = lane & 31, hi = lane >> 5;
    const unsigned lds0 = (unsigned)(uintptr_t)lds;
    const lds_cptr L = (lds_cptr)lds;
    const int b = bg >> 1, g = bg & 1, h = 4 * g + (wid >> 1), qloc = 32 * (wid & 1) + r32, t = 64 * tb + qloc, row = b * 4096 + t;
    const unsigned kdst = (unsigned)__builtin_amdgcn_readfirstlane(lds0 + A_KRING + wid * 1024), vdst = (unsigned)__builtin_amdgcn_readfirstlane(lds0 + A_VRING + wid * 1024);
    const int vb = lane_vbase(lane);
    LAS float* imp0 = (LAS float*)(L + 32768);
    LAS float* imp1 = (LAS float*)(L + 81920);
    LAS unsigned* selm = (LAS unsigned*)(L + N_SELM);
    LAS unsigned* umask = (LAS unsigned*)(L + N_UMASK);
    const int nvmax = 4 * tb + 3, nct = (nvmax + 63) >> 6;
    asm volatile("s_waitcnt vmcnt(0)" ::: "memory");
    { const char* Kc = (const char*)(ws + OFF_KCMP) + (size_t)bg * 32768 + wid * 1024 + lane * 16; const char* Vc = (const char*)(ws + OFF_VCMP) + (size_t)bg * 32768 + wid * 1024 + lane * 16;
      for (int ct = 0; ct < nct; ++ct) { glds16(Kc + ct * 8192, kdst + ct * 8192); glds16(Vc + ct * 8192, vdst + ct * 8192); } }
    bf16x8 qf[4];
    const bf16* Qp = (const bf16*)(ws + OFF_QB) + ((size_t)(b * 8 + h) * 4096 + t) * 64 + 8 * hi;
#pragma unroll
    for (int d0 = 0; d0 < 4; ++d0) qf[d0] = *(const bf16x8*)(Qp + 16 * d0);
    const float* gt = (const float*)(ws + OFF_GATES) + (size_t)row * 24 + (h & 7) * 3;
    float g0 = gt[0], g1 = gt[1], g2 = gt[2];
    asm volatile("" : "+v"(qf[0]), "+v"(qf[1]), "+v"(qf[2]), "+v"(qf[3]), "+v"(g0), "+v"(g1), "+v"(g2));
    A_WAIT_BAR(0);
    const int nv = (t >= 31) ? ((t - 31) >> 4) + 1 : 0;
    f32x16 y[2];
    {
        float m = -1e30f, l = 0.f;
        for (int ct = 0; ct < nct; ++ct) {
            f32x16 p0, p1;
#pragma unroll
            for (int r = 0; r < 16; ++r) { p0[r] = 0.f; p1[r] = 0.f; }
            qk_tile2(p0, p1, lds0 + A_KRING + hi * 1024 + r32 * 16 + ct * 8192, qf);
            const int cb = 64 * ct + 4 * hi;
#pragma unroll
            for (int r = 0; r < 16; ++r) { const int c = cb + (r & 3) + 8 * (r >> 2); if (c >= nv) p0[r] = -INFINITY; if (c + 32 >= nv) p1[r] = -INFINITY; }
            const float rm = rowmax32(p0, p1), mn = fmaxf(m, rm);
            float ls = 0.f;
#pragma unroll
            for (int r = 0; r < 16; ++r) ls += __builtin_amdgcn_exp2f(p0[r] - mn) + __builtin_amdgcn_exp2f(p1[r] - mn);
            l = l * __builtin_amdgcn_exp2f(m - mn) + ls; m = mn;
        }
        const float lt = l + __shfl_xor(l, 32), il = lt > 0.f ? 1.f / lt : 0.f;
        f32x16 oc[2];
#pragma unroll
        for (int r = 0; r < 16; ++r) { oc[0][r] = 0.f; oc[1][r] = 0.f; }
        float carry = 0.f;
        LAS float* ih = ((wid >> 1) == 0 ? imp0 : imp1 + ((wid >> 1) - 1) * 4096) + qloc * 64;
        const int isw = qloc ^ (hi << 5);
        for (int ct = 0; ct < nct; ++ct) {
            f32x16 p0, p1;
#pragma unroll
            for (int r = 0; r < 16; ++r) { p0[r] = 0.f; p1[r] = 0.f; }
            qk_tile2(p0, p1, lds0 + A_KRING + hi * 1024 + r32 * 16 + ct * 8192, qf);
            const int cb = 64 * ct + 4 * hi;
#pragma unroll
            for (int r = 0; r < 16; ++r) { const int c = cb + (r & 3) + 8 * (r >> 2);
                p0[r] = (c >= nv) ? 0.f : __builtin_amdgcn_exp2f(p0[r] - m) * il; p1[r] = (c + 32 >= nv) ? 0.f : __builtin_amdgcn_exp2f(p1[r] - m) * il; }
            {
                float qs[8], px[8];
#pragma unroll
                for (int k = 0; k < 4; ++k) { qs[k] = (p0[4 * k] + p0[4 * k + 1]) + (p0[4 * k + 2] + p0[4 * k + 3]); qs[4 + k] = (p1[4 * k] + p1[4 * k + 1]) + (p1[4 * k + 2] + p1[4 * k + 3]);
                    px[k] = __shfl_xor(p0[4 * k + 3], 32); px[4 + k] = __shfl_xor(p1[4 * k + 3], 32); }
#pragma unroll
                for (int k = 0; k < 8; ++k) { const float prev = k ? px[k - 1] : carry; ih[(16 * ct + 2 * k + hi) ^ isw] = qs[k] + (hi ? px[k] : prev); }
                carry = px[7];
            }
            pv_only2(oc, lds0 + A_VRING + vb + ct * 8192, p0, p1);
        }
#pragma unroll
        for (int r = 0; r < 16; ++r) { y[0][r] = g0 * oc[0][r]; y[1][r] = g0 * oc[1][r]; }
    }
    asm volatile("s_waitcnt lgkmcnt(0)\n\ts_barrier" ::: "memory");
    {
        const int q = lane, part = wid, j0 = 8 * part;
        LAS float* s0 = imp0 + q * 64;
        float sc[8];
#pragma unroll
        for (int i = 0; i < 8; ++i) { const int j = j0 + i; const bool forced = (j == 0) || (j == tb) || (j == tb - 1);
            const int c = (j ^ ((j & 1) << 5)) ^ q;
            const float sm = (s0[c] + imp1[q * 64 + c]) + (imp1[4096 + q * 64 + c] + imp1[8192 + q * 64 + c]);
            sc[i] = forced ? 1e30f : (j <= tb ? sm : -1e30f); }
#pragma unroll
        for (int i = 0; i < 8; ++i) { const int j = j0 + i; s0[(j ^ ((j & 1) << 5)) ^ q] = sc[i]; }
        asm volatile("s_waitcnt lgkmcnt(0)\n\ts_barrier" ::: "memory");
        int rank[8];
#pragma unroll
        for (int i = 0; i < 8; ++i) rank[i] = 0;
        const int kend = tb + 1, e1 = j0 < kend ? j0 : kend, e2 = j0 + 8 < kend ? j0 + 8 : kend;
#pragma unroll 4
        for (int k = 0; k < e1; ++k) { const float sk = s0[(k ^ ((k & 1) << 5)) ^ q];
#pragma unroll
            for (int i = 0; i < 8; ++i) rank[i] += (sk >= sc[i]) ? 1 : 0; }
        for (int k = e1; k < e2; ++k) { const float sk = s0[(k ^ ((k & 1) << 5)) ^ q];
#pragma unroll
            for (int i = 0; i < 8; ++i) rank[i] += (sk > sc[i] || (sk == sc[i] && k < j0 + i)) ? 1 : 0; }
#pragma unroll 4
        for (int k = e2; k < kend; ++k) { const float sk = s0[(k ^ ((k & 1) << 5)) ^ q];
#pragma unroll
            for (int i = 0; i < 8; ++i) rank[i] += (sk > sc[i]) ? 1 : 0; }
        unsigned bits = 0u, ub = 0u;
#pragma unroll
        for (int i = 0; i < 8; ++i) { const bool in = rank[i] < 16; bits |= in ? (1u << i) : 0u; ub |= (__builtin_amdgcn_ballot_w64(in) != 0ull) ? (1u << i) : 0u; }
        ((LAS unsigned char*)selm)[q * 8 + part] = (unsigned char)bits;
        if (lane == 0) ((LAS unsigned char*)umask)[part] = (unsigned char)ub;
        asm volatile("s_waitcnt lgkmcnt(0)\n\ts_barrier" ::: "memory");
        if (tid == 0) {
            LAS unsigned char* sq = (LAS unsigned char*)(L + N_SEQC); LAS unsigned char* sd = (LAS unsigned char*)(L + N_SEQD); LAS int* cnt = (LAS int*)(L + N_CNT);
            const unsigned long long um = ((unsigned long long)umask[1] << 32) | umask[0];
            int n = 0; sq[n++] = (unsigned char)tb;
            for (int j = 0; j < tb; ++j) if ((um >> j) & 1ull) sq[n++] = (unsigned char)j;
            cnt[0] = n;
            int n2 = 0; sd[n2++] = (unsigned char)tb;
            for (int j = (tb >= 8 ? tb - 8 : 0); j < tb; ++j) sd[n2++] = (unsigned char)j;
            cnt[1] = n2;
        }
        asm volatile("s_waitcnt lgkmcnt(0)\n\ts_barrier" ::: "memory");
    }
    const unsigned selLo = selm[qloc * 2], selHi = selm[qloc * 2 + 1];
    const int nC = __builtin_amdgcn_readfirstlane(((const LAS int*)(L + N_CNT))[0]), nD = __builtin_amdgcn_readfirstlane(((const LAS int*)(L + N_CNT))[1]);
    { const float* cs = (const float*)(ws + OFF_COS) + (size_t)row * 32 + 4 * hi; const float* sn = (const float*)(ws + OFF_SIN) + (size_t)row * 32 + 4 * hi;
#pragma unroll
      for (int d0 = 0; d0 < 4; ++d0) { const f32x4 c = *(const f32x4*)(cs + 8 * d0), s = *(const f32x4*)(sn + 8 * d0); u32x4 w = __builtin_bit_cast(u32x4, qf[d0]); u32x4 o;
#pragma unroll
          for (int e = 0; e < 4; ++e) { const float x1 = __uint_as_float(w[e] << 16), x2 = __uint_as_float(w[e] & 0xffff0000u); o[e] = pk2(x1 * c[e] - x2 * s[e], x2 * c[e] + x1 * s[e]); }
          qf[d0] = __builtin_bit_cast(bf16x8, o); } }
    asm volatile("" : "+v"(qf[0]), "+v"(qf[1]), "+v"(qf[2]), "+v"(qf[3]));
    {
        FlashSt<2> st; flash_init3<2>(st);
        const char* Kg = (const char*)(ws + OFF_KSEL) + (size_t)bg * 524288 + wid * 1024 + lane * 16; const char* Vg = (const char*)(ws + OFF_VSEL) + (size_t)bg * 524288 + wid * 1024 + lane * 16;
        nsa_ring<0>(st, lds, Kg, Vg, kdst, vdst, nC, N_SEQC, qf, tb, qloc, selLo, selHi, r32, hi, vb);
        const float lt = st.l + __shfl_xor(st.l, 32), sc = g1 / lt;
#pragma unroll
        for (int r = 0; r < 16; ++r) { y[0][r] += sc * st.o[0][r]; y[1][r] += sc * st.o[1][r]; }
    }
    {
        FlashSt<2> st; flash_init3<2>(st);
        const char* Kg = (const char*)(ws + OFF_KWIN) + (size_t)bg * 524288 + wid * 1024 + lane * 16; const char* Vg = (const char*)(ws + OFF_VWIN) + (size_t)bg * 524288 + wid * 1024 + lane * 16;
        nsa_ring<1>(st, lds, Kg, Vg, kdst, vdst, nD, N_SEQD, qf, tb, qloc, selLo, selHi, r32, hi, vb);
        const float lt = st.l + __shfl_xor(st.l, 32), sc = g2 / lt;
#pragma unroll
        for (int r = 0; r < 16; ++r) { y[0][r] += sc * st.o[0][r]; y[1][r] += sc * st.o[1][r]; }
    }
    bf16* Y = (bf16*)(ws + OFF_ZB) + (size_t)row * 512 + h * 64;
    bf16* Yd = dry ? (bf16*)(ws + OFF_SELM) + (tid * 64) : Y;
#pragma unroll
    for (int db = 0; db < 2; ++db)
#pragma unroll
        for (int rq = 0; rq < 4; ++rq) { bf16* yp = Y + 32 * db + 8 * rq + 4 * hi; bf16* yo = Yd + 32 * db + 8 * rq + 4 * hi; const u32x2 z = *(const u32x2*)yp;
            const float z0 = __uint_as_float(z.x << 16), z1 = __uint_as_float(z.x & 0xffff0000u), z2 = __uint_as_float(z.y << 16), z3 = __uint_as_float(z.y & 0xffff0000u);
            u32x2 o; o.x = pk2(y[db][4 * rq] * z0, y[db][4 * rq + 1] * z1); o.y = pk2(y[db][4 * rq + 2] * z2, y[db][4 * rq + 3] * z3);
            *(u32x2*)yo = o; }
}

__device__ __forceinline__ void compress_unit(unsigned char* lds, unsigned char* ws, int kv, int bg, int rc) {
    int tid_o = threadIdx.x; asm volatile("" : "+v"(tid_o));
    const int tid = tid_o, lane = tid & 63, wid = __builtin_amdgcn_readfirstlane(tid >> 6), r32 = lane & 31, hi = lane >> 5;
    const unsigned lds0 = (unsigned)(uintptr_t)lds;
    { const char* Ab = (const char*)(ws + (kv ? OFF_VCB : OFF_KCB)) + ((size_t)bg * 4096 + 512 * rc) * 128;
      asm volatile("s_waitcnt vmcnt(0)" ::: "memory");
#pragma unroll
      for (int i = 0; i < 9; ++i) { const int q = (i * 8 + wid) * 64 + lane, blk = q / 129, qq = q - blk * 129; const int sg = blk * 128 + (qq < 128 ? qq : 127);
          glds16(Ab + (size_t)sg * 16, (unsigned)__builtin_amdgcn_readfirstlane(lds0 + (i * 8 + wid) * 1024)); }
      asm volatile("s_waitcnt vmcnt(0)\n\ts_barrier" ::: "memory"); }
    const bf16* Bp = (const bf16*)(ws + OFF_CW1) + (size_t)kv * 256 * 2048 + ((size_t)wid * 128 * 64 + lane) * 8;
    const lds_cptr Al = (lds_cptr)lds + 2064 * r32 + 16 * hi;
    f32x16 acc;
#pragma unroll
    for (int r = 0; r < 16; ++r) acc[r] = 0.f;
#pragma unroll 8
    for (int l = 0; l < 32; ++l) {
        const lds_cptr ap = Al + l * 128 + (l >> 4) * 16;
#pragma unroll
        for (int q = 0; q < 4; ++q) {
            const bf16x8 a = *(const LAS bf16x8*)(ap + q * 32), w = *(const bf16x8*)(Bp + (size_t)(4 * l + q) * 512);
            acc = __builtin_amdgcn_mfma_f32_32x32x16_bf16(w, a, acc, 0, 0, 0);
        }
    }
    const float* cb = (const float*)(ws + OFF_CB1) + kv * 256 + 32 * wid + 4 * hi;
    bf16x8 hf[2];
    { float hv[16];
#pragma unroll
      for (int rq = 0; rq < 4; ++rq) { const f32x4 bb = *(const f32x4*)(cb + 8 * rq);
#pragma unroll
          for (int e = 0; e < 4; ++e) hv[4 * rq + e] = siluf_(acc[4 * rq + e] + bb[e]); }
      u32x4 w0, w1;
      w0.x = pk2(hv[0], hv[1]); w0.y = pk2(hv[2], hv[3]); w0.z = pk2(hv[4], hv[5]); w0.w = pk2(hv[6], hv[7]);
      w1.x = pk2(hv[8], hv[9]); w1.y = pk2(hv[10], hv[11]); w1.z = pk2(hv[12], hv[13]); w1.w = pk2(hv[14], hv[15]);
      hf[0] = __builtin_bit_cast(bf16x8, w0); hf[1] = __builtin_bit_cast(bf16x8, w1); }
    const bf16* W2 = (const bf16*)(ws + OFF_CW2) + (size_t)kv * 64 * 256 + 32 * wid + 4 * hi;
    f32x16 po[2];
#pragma unroll
    for (int dbk = 0; dbk < 2; ++dbk) {
#pragma unroll
        for (int r = 0; r < 16; ++r) po[dbk][r] = 0.f;
#pragma unroll
        for (int s = 0; s < 2; ++s) {
            const bf16* wr = W2 + (size_t)(32 * dbk + r32) * 256 + 16 * s;
            const u32x2 lo = *(const u32x2*)wr, hh = *(const u32x2*)(wr + 8);
            u32x4 wv; wv.x = lo.x; wv.y = lo.y; wv.z = hh.x; wv.w = hh.y;
            po[dbk] = __builtin_amdgcn_mfma_f32_32x32x16_bf16(__builtin_bit_cast(bf16x8, wv), hf[s], po[dbk], 0, 0, 0);
        }
    }
    LAS float* part = (LAS float*)lds;
    __syncthreads();
#pragma unroll
    for (int dbk = 0; dbk < 2; ++dbk)
#pragma unroll
        for (int r = 0; r < 16; ++r) part[(wid * 64 + 32 * dbk + crow(r, hi)) * 32 + r32] = po[dbk][r];
    __syncthreads();
    {
        const int row = tid & 31, d4 = tid >> 5, cc = 32 * rc + row;
        float o[4];
#pragma unroll
        for (int e = 0; e < 4; ++e) { float sum = 0.f;
#pragma unroll
            for (int w = 0; w < 8; ++w) sum += part[(w * 64 + 4 * d4 + e) * 32 + row];
            o[e] = (cc < 255) ? sum : 0.f; }
        bf16* dst = (bf16*)(ws + (kv ? OFF_VCMP : OFF_KCMP)) + (size_t)bg * 16384 + (kv ? vtile_off(cc, 4 * d4) : ktile_off(cc, 4 * d4));
        store_bf<4>(dst, o);
    }
    __syncthreads();
}
__device__ __forceinline__ void cumsum_unit(unsigned char* lds, unsigned char* ws, int bh) {
    int tid_o = threadIdx.x; asm volatile("" : "+v"(tid_o));
    const int tid = tid_o, lane = tid & 63, wid = tid >> 6, b = bh >> 3, h = bh & 7;
    const float* lf = (const float*)(ws + OFF_LOGF) + ((size_t)(b * 4096 + 8 * tid)) * 8 + h;
    float v[8]; float s = 0.f;
#pragma unroll
    for (int i = 0; i < 8; ++i) { s += lf[i * 8]; v[i] = s; }
    float incl = s;
#pragma unroll
    for (int of = 1; of < 64; of <<= 1) { const float t = __shfl_up(incl, of); if (lane >= of) incl += t; }
    LAS float* wsum = (LAS float*)lds;
    __syncthreads();
    if (lane == 63) wsum[wid] = incl;
    __syncthreads();
    float base = incl - s;
    for (int w = 0; w < wid; ++w) base += wsum[w];
    float* cf = (float*)(ws + OFF_CF) + (size_t)bh * 4096 + 8 * tid;
    f32x4 o0 = {-(base + v[0]), -(base + v[1]), -(base + v[2]), -(base + v[3])}, o1 = {-(base + v[4]), -(base + v[5]), -(base + v[6]), -(base + v[7])};
    *(f32x4*)cf = o0; *(f32x4*)(cf + 4) = o1;
    __syncthreads();
}

constexpr size_t OFF_BAR = OFF_CTL + 131072;
constexpr int LDS_BARST = 131072 + 64;
#define XB_TMO      128
#define XB_XCNT(j)  (256  + 64 * (j))
#define XB_XSUB(j)  (1280 + 64 * (j))
#define XB_XGEN(j)  (2304 + 64 * (j))
#define XB_TOP      3328
#define XB_TOPGEN   3392
#define XCD_BAR_WORDS 3456
#define XB_SPIN_CAP (1u << 18)

__device__ __forceinline__ unsigned xb_ld(unsigned* p)              { return __hip_atomic_load(p, __ATOMIC_RELAXED, __HIP_MEMORY_SCOPE_AGENT); }
__device__ __forceinline__ unsigned xb_add(unsigned* p, unsigned v) { return __hip_atomic_fetch_add(p, v, __ATOMIC_RELAXED, __HIP_MEMORY_SCOPE_AGENT); }
__device__ __forceinline__ unsigned xb_xcc_id() { return (unsigned)__builtin_amdgcn_s_getreg((3 << 11) | 20) & 0xFu; }
#define XB_SPIN(cond, bar) do { unsigned _sp = 0; while (cond) { __builtin_amdgcn_s_sleep(1); \
    if ((++_sp & 255u) == 0u) { if (xb_ld(&(bar)[XB_TMO])) break; if (_sp > XB_SPIN_CAP) { atomicAdd(&(bar)[XB_TMO], 1u); break; } } } } while (0)

struct XcdBarrier {
    unsigned* bar; unsigned x;
    volatile LAS unsigned* st;
};

__device__ __forceinline__ XcdBarrier xcd_barrier_post(unsigned* bar, volatile LAS unsigned* st) {
    XcdBarrier b; b.bar = bar; b.x = xb_xcc_id(); b.st = st;
    if (threadIdx.x == 0) (void)xb_add(&bar[XB_XCNT(b.x)], 1u);
    return b;
}
__device__ __forceinline__ void xcd_barrier_complete(unsigned* bar, unsigned x, unsigned& nloc, unsigned& nx) {
    const unsigned G = gridDim.x * gridDim.y * gridDim.z;
    unsigned sum, cnt, mine, sp = 0u;
    for (;;) {
        sum = 0u; cnt = 0u; mine = 0u;
#pragma unroll
        for (unsigned j = 0; j < 16; ++j) { const unsigned c = xb_ld(&bar[XB_XCNT(j)]); sum += c; cnt += (c > 0u) ? 1u : 0u; mine = (j == x) ? c : mine; }
        if (sum == G) break;
        __builtin_amdgcn_s_sleep(1);
        if ((++sp & 255u) == 0u) { if (xb_ld(&bar[XB_TMO])) break; if (sp > XB_SPIN_CAP) { atomicAdd(&bar[XB_TMO], 1u); break; } }
    }
    nloc = mine > 0u ? mine : 1u; nx = cnt > 0u ? cnt : 1u;
}

__device__ __forceinline__ void xcd_barrier(const XcdBarrier& b) {
    asm volatile("s_waitcnt vmcnt(0)" ::: "memory");
    __syncthreads();
    if (threadIdx.x == 0) {
        unsigned* bar = b.bar;
        __builtin_amdgcn_s_waitcnt(0);
        unsigned nloc = b.st[0], nx = b.st[1];
        if (nloc == 0u) { xcd_barrier_complete(bar, b.x, nloc, nx); b.st[0] = nloc; b.st[1] = nx; }
        const unsigned old = xb_add(&bar[XB_XSUB(b.x)], 1u);
        const unsigned gen = old / nloc;
        if (old + 1u == (gen + 1u) * nloc) {
            __builtin_amdgcn_fence(__ATOMIC_RELEASE, "agent");
            asm volatile("s_waitcnt vmcnt(0)" ::: "memory");
            const unsigned og = xb_add(&bar[XB_TOP], 1u);
            const unsigned tg = og / nx;
            if (og + 1u == (tg + 1u) * nx) xb_add(&bar[XB_TOPGEN], 1u);
            else XB_SPIN(xb_ld(&bar[XB_TOPGEN]) == tg, bar);
            __builtin_amdgcn_fence(__ATOMIC_ACQUIRE, "agent");
            xb_add(&bar[XB_XGEN(b.x)], 1u);
            asm volatile("s_waitcnt vmcnt(0)" ::: "memory");
        } else {
            XB_SPIN(xb_ld(&bar[XB_XGEN(b.x)]) == gen, bar);
            __builtin_amdgcn_fence(__ATOMIC_ACQUIRE, "agent");
            asm volatile("s_waitcnt vmcnt(0)" ::: "memory");
        }
    }
    __syncthreads();
}

struct KArgs;
__device__ __forceinline__ void conv_tile(bool active, float (*tile)[65], int vt, const float* src, int ld, int K, bf16* dst, const float* kscale, int mode, int bx, int by) {
    const int n0 = bx * 64, k0 = by * 64, tx = vt & 63, ty = vt >> 6;
    const int n = n0 + tx;
    const int sc = (mode == 0 || mode == 3) ? n : mode == 1 ? win_srccol(n) : (n & ~63) + ((n & 1) << 5) + ((n & 63) >> 1);
    if (active) {
        float v[16];
#pragma unroll
        for (int i = 0; i < 16; ++i) v[i] = (sc >= 0) ? src[(size_t)(k0 + 4 * i + ty) * ld + sc] : 0.f;
        if (kscale) {
#pragma unroll
            for (int i = 0; i < 16; ++i) v[i] *= kscale[k0 + 4 * i + ty]; }
#pragma unroll
        for (int i = 0; i < 16; ++i) tile[tx][4 * i + ty] = v[i];
    }
    __syncthreads();
    if (active) {
#pragma unroll
        for (int p = 0; p < 2; ++p) { const int it = vt + 256 * p, r = it >> 3, c = it & 7; const float* t = &tile[r][8 * c];
            u32x4 o; o.x = pk2(t[0], t[1]); o.y = pk2(t[2], t[3]); o.z = pk2(t[4], t[5]); o.w = pk2(t[6], t[7]);
            const int nn = n0 + r, kk = k0 + 8 * c;
            if (mode == 3) *(u32x4*)(dst + ((size_t)((nn >> 5) * (K >> 4) + (kk >> 4)) * 64 + (nn & 31) + 32 * ((kk & 15) >> 3)) * 8) = o;
            else *(u32x4*)(dst + (size_t)nn * K + kk) = o; }
    }
    __syncthreads();
}
namespace cg = cooperative_groups;
constexpr int NT = 512;
constexpr int LDS_BYTES = 147456;
struct KArgs { const void* in[23]; float* out; unsigned char* ws; };

#define OPAQUE_TID() int tid = threadIdx.x; asm volatile("" : "+v"(tid))
#define VRUN(VT, NVB, CALL) do { OPAQUE_TID(); constexpr int per_ = NT / (VT); for (int vb = blockIdx.x * per_ + tid / (VT); vb < (NVB); vb += gridDim.x * per_) { const int vt = tid % (VT); CALL; } } while (0)
#define VRUN_BAR(NVB, CALL) do { OPAQUE_TID(); float (*tile)[65] = (float (*)[65])(lds + (tid >> 8) * 64 * 65 * 4); (void)tile; const int nvb_ = (NVB); for (int it_ = 0; it_ * (int)gridDim.x * 2 < nvb_; ++it_) { const int vb = (it_ * (int)gridDim.x + (int)blockIdx.x) * 2 + (tid >> 8); const int vt = tid & 255; const bool active = vb < nvb_; CALL; } } while (0)

#ifndef REP_U
#define REP_U 0
#endif
#ifndef REP_SYNC
#define REP_SYNC 0
#endif
#ifndef REP_SUMSQ
#define REP_SUMSQ 0
#endif
#ifndef REP_P0
#define REP_P0 0
#endif
#ifndef REP_PRO
#define REP_PRO 0
#endif
#ifndef REP_INPROJ
#define REP_INPROJ 0
#endif
#ifndef REP_P2
#define REP_P2 0
#endif
#ifndef REP_FOX
#define REP_FOX 0
#endif
#ifndef REP_DIFF
#define REP_DIFF 0
#endif
#ifndef REP_NSA
#define REP_NSA 0
#endif
#ifndef REP_GATEBR
#define REP_GATEBR 0
#endif
#ifndef REP_OUT
#define REP_OUT 0
#endif
#ifndef DO_ALL
#define DO_ALL 1
#endif
#ifndef DO_PRO
#define DO_PRO DO_ALL
#endif
#ifndef DO_INPROJ
#define DO_INPROJ DO_ALL
#endif
#ifndef DO_P2
#define DO_P2 DO_ALL
#endif
#ifndef DO_ATTN
#define DO_ATTN DO_ALL
#endif
#ifndef DO_GATEBR
#define DO_GATEBR DO_ALL
#endif
#ifndef DO_OUT
#define DO_OUT DO_ALL
#endif
#ifndef DO_PLE
#define DO_PLE DO_ALL
#endif
#ifndef DO_TAIL
#define DO_TAIL DO_ALL
#endif
__global__ void __launch_bounds__(NT) mega(KArgs a) {
    extern __shared__ __attribute__((aligned(16))) unsigned char lds[];
    cg::grid_group grid = cg::this_grid();
    { volatile LAS unsigned* st0 = (volatile LAS unsigned*)((LAS unsigned char*)lds + LDS_BARST); if (threadIdx.x < 2) st0[threadIdx.x] = 0u; }
    __syncthreads();
    const XcdBarrier xbar = xcd_barrier_post((unsigned*)(a.ws + OFF_BAR), (volatile LAS unsigned*)((LAS unsigned char*)lds + LDS_BARST));
#define GSYNC() xcd_barrier(xbar)
    unsigned char* ws = a.ws; float* X = a.out;
    typedef const KArgs __attribute__((address_space(4)))* kargp_t;
#define KIN(i) ([&]() { kargp_t kp_ = (kargp_t)__builtin_amdgcn_kernarg_segment_ptr(); asm volatile("" : "+s"(kp_)); return kp_->in[i]; }())
#define I_x ((const float*)KIN(0))
#define I_p ((const float*)KIN(1))
#define I_pos ((const int*)KIN(2))
#define I_norm_g ((const float*)KIN(3))
#define I_w_in ((const float*)KIN(4))
#define I_b_forget ((const float*)KIN(5))
#define I_pe_k ((const float*)KIN(6))
#define I_w1_k ((const float*)KIN(7))
#define I_b1_k ((const float*)KIN(8))
#define I_w2_k ((const float*)KIN(9))
#define I_pe_v ((const float*)KIN(10))
#define I_w1_v ((const float*)KIN(11))
#define I_b1_v ((const float*)KIN(12))
#define I_w2_v ((const float*)KIN(13))
#define I_diff_lam ((const float*)KIN(14))
#define I_subln ((const float*)KIN(15))
#define I_w_out ((const float*)KIN(19))
#define I_w_ple ((const float*)KIN(20))
#define I_w_pg ((const float*)KIN(21))
#define I_final_g ((const float*)KIN(22))
#if DO_PRO
    for (int rep0_ = 0; rep0_ <= REP_P0; ++rep0_) {
    VRUN(256, M / 4, d_xprep(vb, vt, I_x, ws));
    VRUN(256, M * 32 / 256, d_rope_table(vb, vt, I_pos, ws));
    VRUN(256, (2 * M * 256 / 4) / 256, d_pconv(vb, vt, I_p, ws));
    for (int l = 0; l < DEPTH; ++l) {
        { OPAQUE_TID(); if (blockIdx.x == 0 && tid < 64) d_lam(tid, I_diff_lam + l * 256, ws, l); }
    }
    }
#endif
    for (int l = 0; l < DEPTH; ++l) {
        const float* wl = I_w_in + (size_t)l * 1024 * NIN; const float* ng = I_norm_g + l * 1024;
#if DO_PRO
        for (int rep_ = 0; rep_ <= REP_PRO; ++rep_) {
        { OPAQUE_TID(); float (*tile)[65] = (float (*)[65])(lds + (tid >> 8) * 64 * 65 * 4);
          const int njobs = 2952 + (l == 0 ? 1152 : 0);
          for (int it_ = 0; it_ * (int)gridDim.x * 2 < njobs; ++it_) {
              int j = (it_ * (int)gridDim.x + (int)blockIdx.x) * 2 + (tid >> 8); const bool active = j < njobs;
              const float* src = wl; int ld = NIN, K = 1024, mode = 1, bx = 0, by = 0; bf16* dst = (bf16*)(ws + OFF_WIN); const float* ks = ng;
              if (j < 1536) { bx = j % 96; by = j / 96; }
              else if (j < 2304) { j -= 1536; bx = j % 48; by = j / 48; src = wl + 5920; mode = 0; dst = (bf16*)(ws + OFF_WMG); }
              else if (j < 2688) { j -= 2304; const int i = j >> 7, r = j & 127; bx = r & 15; by = r >> 4; src = (const float*)KIN(16 + i) + (size_t)l * 512 * 1024; ld = 1024; K = 512; mode = 0; dst = (bf16*)(ws + OFF_WBR) + (size_t)i * 1024 * 512; ks = nullptr; }
              else if (j < 2944) { j -= 2688; const int kv = j >> 7, r = j & 127; bx = r & 3; by = r >> 2; src = (kv ? I_w1_v : I_w1_k) + (size_t)l * 2048 * 256; ld = 256; K = 2048; mode = 3; dst = (bf16*)(ws + OFF_CW1) + (size_t)kv * 256 * 2048; ks = nullptr; }
              else if (j < 2952) { j -= 2944; const int kv = j >> 2; by = j & 3; src = (kv ? I_w2_v : I_w2_k) + (size_t)l * 256 * 64; ld = 64; K = 256; mode = kv ? 0 : 2; dst = (bf16*)(ws + OFF_CW2) + (size_t)kv * 64 * 256; ks = nullptr; }
              else { j -= 2952; const int ll = j / 576, r = j % 576; ld = 1024; mode = 0; ks = nullptr;
                  if (r < 256) { bx = r & 15; by = r >> 4; src = I_w_out + (size_t)ll * 1024 * 1024; dst = (bf16*)(ws + OFF_WOUT) + (size_t)ll * 1024 * 1024; }
                  else if (r < 512) { const int r2 = r - 256; bx = r2 & 15; by = r2 >> 4; src = I_w_pg + (size_t)ll * 1024 * 1024; dst = (bf16*)(ws + OFF_WPG) + (size_t)ll * 1024 * 1024; }
                  else { const int r2 = r - 512; bx = r2 & 15; by = r2 >> 4; src = I_w_ple + (size_t)ll * 256 * 1024; K = 256; dst = (bf16*)(ws + OFF_WPL) + (size_t)ll * 1024 * 256; } }
              conv_tile(active, tile, tid & 255, src, ld, K, dst, ks, mode, bx, by);
          } }
        { OPAQUE_TID(); if (blockIdx.x >= 64 && blockIdx.x < 96 && tid < 256) d_cb1_part(blockIdx.x - 64, tid, I_pe_k + l * 2048, I_w1_k + (size_t)l * 2048 * 256, I_pe_v + l * 2048, I_w1_v + (size_t)l * 2048 * 256, ws); }
        }
#endif
        if (l == 0) grid.sync(); else GSYNC();
        EpiCtx E{ws, I_b_forget + l * 8, l == 0 ? I_x : X, X, 0};
#if DO_INPROJ
        { OPAQUE_TID(); if (blockIdx.x == 0) d_cb1_sum(tid, I_b1_k + l * 256, I_b1_v + l * 256, ws); }
        for (int rep_ = 0; rep_ <= REP_INPROJ; ++rep_) { FAST_GEMM(EPI_INPROJ, ws + OFF_XB, ws + OFF_WIN, NP, 1024, true); }
#endif
        GSYNC();
#if DO_P2
        for (int rep_ = 0; rep_ <= REP_P2; ++rep_) {
        for (int u = blockIdx.x; u < 160; u += gridDim.x) { if (u < 128) compress_unit(lds, ws, u >> 6, (u >> 3) & 7, u & 7); else cumsum_unit(lds, ws, u - 128); }
        }
#endif
        GSYNC();
#if DO_ATTN
        for (int rep_ = (REP_FOX ? 1 : 0); rep_ >= 0; --rep_) for (int u = blockIdx.x; u < 512; u += gridDim.x) fox_unit(lds, ws, u & 31, u < 256 ? 15 - (u >> 5) : (u >> 5) - 8, rep_ > 0 ? REP_FOX : 0);
        __syncthreads();
        { const float lam = ((const float*)(ws + OFF_CTL))[CTL_LAM + l], lam_init = 0.8f - 0.6f * expf(-0.3f * (float)l);
          for (int rep_ = REP_DIFF; rep_ >= 0; --rep_) for (int u = blockIdx.x; u < 512; u += gridDim.x) diff_unit(lds, ws, u & 15, u < 256 ? 31 - (u >> 4) : (u >> 4) - 16, I_subln + l * 128, lam, lam_init, rep_ > 0); }
        __syncthreads();
        for (int rep_ = REP_NSA; rep_ >= 0; --rep_) for (int u = blockIdx.x; u < 512; u += gridDim.x) nsa_unit(lds, ws, u & 7, u < 256 ? 63 - (u >> 3) : (u >> 3) - 32, rep_ > 0);
#endif
        GSYNC();
#if DO_GATEBR
        for (int rep_ = 0; rep_ <= REP_GATEBR; ++rep_) {
        { pg8::Gemm g_{(const pg8::bf16_t*)(ws + OFF_XB), (const pg8::bf16_t*)(ws + OFF_WMG), M, 3072, 1024}; ChainOrder S_; S_.init((int)gridDim.x, (int)blockIdx.x, 0);
          EpiFast<EPI_GATE3> Ep_{E}; pg8::gemm_phase<EpiFast<EPI_GATE3>, ChainOrder, true, true>((PG8_LAS unsigned char*)lds, g_, S_, Ep_); }
        { pg8::Gemm g_{(const pg8::bf16_t*)(ws + OFF_ZA), (const pg8::bf16_t*)(ws + OFF_WBR), 3 * M, 3072, 512}; ChainOrder S_; S_.init((int)gridDim.x, (int)blockIdx.x, 1);
          EpiFast<EPI_BR3> Ep_{E}; pg8::gemm_phase<EpiFast<EPI_BR3>, ChainOrder, true, true>((PG8_LAS unsigned char*)lds, g_, S_, Ep_); }
        }
#endif
        GSYNC();
#if DO_OUT
        for (int rep_ = 0; rep_ <= (l == 0 ? REP_OUT : 0); ++rep_) FAST_GEMM(EPI_OUT, (const bf16*)(ws + OFF_MERGED), (const bf16*)(ws + OFF_WOUT) + (size_t)l * 1024 * 1024, 1024, 1024, false);
#endif
        GSYNC();
#if DO_PLE
        for (int rep_ = 0; rep_ <= REP_U; ++rep_) FAST_GEMM(EPI_U, (const bf16*)(ws + OFF_PB) + (size_t)l * M * 256, (const bf16*)(ws + OFF_WPL) + (size_t)l * 1024 * 256, 1024, 256, false);
        FAST_GEMM(EPI_PLE, (const bf16*)(ws + OFF_X1B), (const bf16*)(ws + OFF_WPG) + (size_t)l * 1024 * 1024, 1024, 1024, false);
#endif
        GSYNC();
#if DO_TAIL
        for (int rep_ = 0; rep_ < 10 * REP_SYNC; ++rep_) GSYNC();
        for (int rep_ = 0; rep_ <= REP_SUMSQ; ++rep_) { if (l + 1 < DEPTH) VRUN(256, M / 4, d_sumsq(vb, vt, X, ws)); }
#endif
    }
#if DO_TAIL
    VRUN(256, M / 4, d_final(vb, vt, X, I_final_g));
#endif
}
#undef I_x
#undef I_p
#undef I_pos
#undef I_norm_g
#undef I_w_in
#undef I_b_forget
#undef I_pe_k
#undef I_w1_k
#undef I_b1_k
#undef I_w2_k
#undef I_pe_v
#undef I_w1_v
#undef I_b1_v
#undef I_w2_v
#undef I_diff_lam
#undef I_subln
#undef I_w_out
#undef I_w_ple
#undef I_w_pg
#undef I_final_g
#undef KIN

extern "C" void kernel_launch(void* const* d_in, const int* in_sizes, int n_in, void* d_out, int out_size, void* d_ws, size_t ws_size, hipStream_t stream) {
    static int grid_blocks = 0;
    if (grid_blocks == 0) {
        if (n_in != 23 || ws_size < WS_NEED || out_size != M * DM) { fprintf(stderr, "kernel_launch: unexpected sizes (n_in %d ws %zu out %d)\n", n_in, ws_size, out_size); grid_blocks = -1; return; }
        int dev = 0, cus = 0, per_cu = 0;
        (void)hipGetDevice(&dev); (void)hipDeviceGetAttribute(&cus, hipDeviceAttributeMultiprocessorCount, dev);
        (void)hipFuncSetAttribute((const void*)mega, hipFuncAttributeMaxDynamicSharedMemorySize, LDS_BYTES);
        (void)hipOccupancyMaxActiveBlocksPerMultiprocessor(&per_cu, (const void*)mega, NT, LDS_BYTES);
        if (per_cu < 1) { fprintf(stderr, "kernel_launch: occupancy query says %d blocks per CU\n", per_cu); grid_blocks = -1; return; }
        grid_blocks = cus * 1;
        if (grid_blocks != 256) { fprintf(stderr, "kernel_launch: built for a 256-CU device (got %d)\n", cus); grid_blocks = -1; return; }
    }
    if (grid_blocks < 0) return;
    (void)hipMemsetAsync((char*)d_ws + OFF_CTL, 0, 262144, stream);
    KArgs a{};
    for (int i = 0; i < 23; ++i) a.in[i] = d_in[i];
    a.out = (float*)d_out; a.ws = (unsigned char*)d_ws;
    void* args[] = {&a};
    hipError_t e = hipLaunchCooperativeKernel((const void*)mega, dim3(grid_blocks), dim3(NT), args, LDS_BYTES, stream);
    if (e != hipSuccess) fprintf(stderr, "cooperative launch failed: %s (grid %d)\n", hipGetErrorString(e), grid_blocks);
}
```

```cpp
#include <hip/hip_runtime.h>
#include <hip/hip_cooperative_groups.h>
#include <cstdio>
#include <cstdint>

typedef unsigned short bf16;
typedef short bf16x8 __attribute__((ext_vector_type(8)));
typedef float f32x4 __attribute__((ext_vector_type(4)));
typedef float f32x16 __attribute__((ext_vector_type(16)));
typedef unsigned u32x4 __attribute__((ext_vector_type(4)));
typedef unsigned u32x2 __attribute__((ext_vector_type(2)));

constexpr int BATCH = 4, SEQ = 4096, DM = 1024, M = BATCH * SEQ, DEPTH = 2, NIN = 8992, NP = 6144;
constexpr float EPS = 1e-6f;
constexpr float LOG2E = 1.4426950408889634f;
constexpr float C2 = 0.125f * LOG2E;
constexpr size_t MiB = 1u << 20;
constexpr size_t OFF_CTL = 0;
constexpr size_t OFF_WIN = 1 * MiB, OFF_WMG = 13 * MiB, OFF_WBR = 19 * MiB, OFF_CW1 = 22 * MiB, OFF_CW2 = 24 * MiB, OFF_CB1 = 24 * MiB + 128 * 1024;
constexpr size_t OFF_WOUT = 25 * MiB, OFF_WPG = 29 * MiB, OFF_WPL = 33 * MiB;
constexpr size_t OFF_XB = 34 * MiB, OFF_ZA = 66 * MiB, OFF_ZB = 82 * MiB, OFF_ZC = 98 * MiB;
constexpr size_t OFF_COS = 114 * MiB, OFF_SIN = 116 * MiB, OFF_PB = 118 * MiB;
constexpr size_t OFF_LOGF = 134 * MiB, OFF_CF = 134 * MiB + 512 * 1024, OFF_GATES = 135 * MiB, OFF_SSP = 136 * MiB + 512 * 1024;
constexpr size_t OFF_KCMP = 136 * MiB + 768 * 1024, OFF_VCMP = 137 * MiB, OFF_SELM = 137 * MiB + 256 * 1024;
constexpr size_t OFF_QA = 139 * MiB, OFF_KA = 155 * MiB, OFF_VA = 171 * MiB, OFF_QB = 187 * MiB, OFF_QC = 203 * MiB, OFF_KC = 219 * MiB, OFF_VC = 235 * MiB;
constexpr size_t OFF_KCB = 251 * MiB, OFF_VCB = 255 * MiB, OFF_KSEL = 259 * MiB, OFF_KWIN = 263 * MiB, OFF_VSEL = 267 * MiB, OFF_VWIN = 271 * MiB;
constexpr size_t WS_NEED = 275 * MiB;
constexpr size_t OFF_G = 139 * MiB  , OFF_T = 235 * MiB  , OFF_MERGED = OFF_T, OFF_X1B = 203 * MiB, OFF_U = 139 * MiB;
constexpr int CTL_LAM = 64;

__device__ __forceinline__ bf16 f2bf(float f) { unsigned u = __float_as_uint(f); return (bf16)((u + 0x7fffu + ((u >> 16) & 1u)) >> 16); }
__device__ __forceinline__ float bf2f(bf16 h) { return __uint_as_float(((unsigned)h) << 16); }
__device__ __forceinline__ unsigned pk2(float lo, float hi) { typedef float f2_ __attribute__((ext_vector_type(2))); typedef __bf16 b2_ __attribute__((ext_vector_type(2))); f2_ v = {lo, hi}; b2_ b = __builtin_convertvector(v, b2_); return __builtin_bit_cast(unsigned, b); }
__device__ __forceinline__ float sigmoidf_(float x) { return 1.f / (1.f + __expf(-x)); }
__device__ __forceinline__ float siluf_(float x) { return x / (1.f + __expf(-x)); }
__device__ __forceinline__ float logsigmoidf_(float x) { return x >= 0.f ? -log1pf(expf(-x)) : x - log1pf(expf(x)); }

__device__ __forceinline__ int ktile_off(int s, int d) { return (s >> 6) * 4096 + (d >> 3) * 512 + (s & 63) * 8 + (d & 7); }
__device__ __forceinline__ int vtile_off(int s, int d) { return (s >> 6) * 4096 + (d >> 5) * 2048 + ((s & 63) >> 4) * 512 + (s & 15) * 32 + (d & 31); }
__device__ __forceinline__ int v128_off(int s, int d) { return (s >> 6) * 8192 + (d >> 5) * 2048 + ((s & 63) >> 4) * 512 + (s & 15) * 32 + (d & 31); }

template <int W> __device__ __forceinline__ void store_bf(bf16* dst, const float* v) {
    if constexpr (W == 4) { u32x2 o; o.x = pk2(v[0], v[1]); o.y = pk2(v[2], v[3]); *(u32x2*)dst = o; }
    else { u32x4 o; o.x = pk2(v[0], v[1]); o.y = pk2(v[2], v[3]); o.z = pk2(v[4], v[5]); o.w = pk2(v[6], v[7]); *(u32x4*)dst = o; }
}

__device__ __forceinline__ int win_srccol(int n) {
    const int seg = n >> 6, j = n & 63; const int il = ((j & 1) << 5) + (j >> 1);
    if (seg < 8) return 0 + n;
    if (seg < 16) return 512 + (n - 512);
    if (seg < 24) return 1024 + (n - 1024);
    if (seg < 32) return 1544 + (n - 1536);
    if (seg < 40) return 2056 + (seg - 32) * 64 + il;
    if (seg < 42) return 2568 + (n - 2560);
    if (seg < 44) return 2696 + (n - 2688);
    if (seg < 46) return 2824 + (seg - 44) * 64 + il;
    if (seg < 48) return 3080 + (seg - 46) * 64 + il;
    if (seg < 50) return 2952 + (n - 3072);
    if (seg < 52) return 3208 + (n - 3200);
    if (seg < 60) return 3360 + (n - 3328);
    if (seg < 68) return 3872 + (seg - 60) * 64 + il;
    if (seg < 76) return 4384 + (seg - 68) * 64 + il;
    if (seg < 84) return 4896 + (n - 4864);
    if (seg < 92) return 5408 + (n - 5376);
    if (seg == 92) { if (j < 8) return 1536 + j; if (j < 32) return 3336 + (j - 8); return -1; }
    return -1;
}

enum { EPI_INPROJ = 0, EPI_GATE = 1, EPI_BR0 = 2, EPI_BR1 = 3, EPI_BR2 = 4, EPI_OUT = 5, EPI_U = 6, EPI_PLE = 7, EPI_GATE3 = 9, EPI_BR3 = 10 };
struct EpiCtx { unsigned char* ws; const float* bfg; const float* xin; float* X; int gi; };

__device__ __forceinline__ float row_rstd(const unsigned char* ws, int row) {
    const f32x4 sp = *(const f32x4*)(ws + OFF_SSP + (size_t)row * 16);
    return rsqrtf(((sp[0] + sp[1]) + (sp[2] + sp[3])) * (1.f / 1024.f) + EPS);
}

enum { T_QA = 0, T_KA, T_VA, T_ZA, T_QB, T_CB, T_KROPE, T_VSW, T_ZB, T_QC, T_KC, T_VC, T_ZC, T_SPECIAL };
__device__ __forceinline__ int inproj_type(int t) {
    return t < 2 ? T_QA : t < 4 ? T_KA : t < 6 ? T_VA : t < 8 ? T_ZA : t < 10 ? T_QB : t == 10 ? T_CB : t == 11 ? T_KROPE : t == 12 ? T_VSW : t < 15 ? T_ZB : t < 17 ? T_QC : t < 19 ? T_KC : t < 21 ? T_VC : t < 23 ? T_ZC : T_SPECIAL;
}
struct Pre { float rs; float a[8]; float b[8]; };
template <int KIND, int T> __device__ __forceinline__ void pre_load(const EpiCtx& E, int row, int col, Pre& p) {
    unsigned char* ws = E.ws; const size_t idx = (size_t)row * 1024 + col;
    if constexpr (KIND == EPI_INPROJ) {
        if constexpr (T == T_KROPE || T == T_QC || T == T_KC) { const int d = col & 63;
            const f32x4 c = *(const f32x4*)((const float*)(ws + OFF_COS) + (size_t)row * 32 + (d >> 1)), s = *(const f32x4*)((const float*)(ws + OFF_SIN) + (size_t)row * 32 + (d >> 1));
#pragma unroll
            for (int i = 0; i < 4; ++i) { p.a[i] = c[i]; p.b[i] = s[i]; } }
    } else if constexpr (KIND == EPI_GATE || KIND == EPI_GATE3) {
    } else if constexpr (KIND == EPI_BR3) {
        const u32x4 g = *(const u32x4*)((const bf16*)(ws + OFF_G) + (size_t)E.gi * M * 1024 + idx);
#pragma unroll
        for (int i = 0; i < 4; ++i) { p.a[2 * i] = __uint_as_float(g[i] << 16); p.a[2 * i + 1] = __uint_as_float(g[i] & 0xffff0000u); }
        if (E.gi > 0) { const u32x4 t = *(const u32x4*)((const bf16*)(ws + OFF_T) + idx);
#pragma unroll
            for (int i = 0; i < 4; ++i) { p.b[2 * i] = __uint_as_float(t[i] << 16); p.b[2 * i + 1] = __uint_as_float(t[i] & 0xffff0000u); } }
        else {
#pragma unroll
            for (int i = 0; i < 8; ++i) p.b[i] = 0.f; }
    } else if constexpr (KIND == EPI_BR0 || KIND == EPI_BR1 || KIND == EPI_BR2) {
        const u32x4 g = *(const u32x4*)((const bf16*)(ws + OFF_G) + idx);
#pragma unroll
        for (int i = 0; i < 4; ++i) { p.a[2 * i] = __uint_as_float(g[i] << 16); p.a[2 * i + 1] = __uint_as_float(g[i] & 0xffff0000u); }
        if constexpr (KIND != EPI_BR0) { const u32x4 t = *(const u32x4*)((const bf16*)(ws + OFF_T) + idx);
#pragma unroll
            for (int i = 0; i < 4; ++i) { p.b[2 * i] = __uint_as_float(t[i] << 16); p.b[2 * i + 1] = __uint_as_float(t[i] & 0xffff0000u); } }
    } else if constexpr (KIND == EPI_OUT) { const f32x4 t0 = *(const f32x4*)(E.xin + idx), t1 = *(const f32x4*)(E.xin + idx + 4);
#pragma unroll
        for (int i = 0; i < 4; ++i) { p.a[i] = t0[i]; p.a[4 + i] = t1[i]; }
    } else if constexpr (KIND == EPI_PLE) { const f32x4 t0 = *(const f32x4*)(E.X + idx), t1 = *(const f32x4*)(E.X + idx + 4); const u32x4 u = *(const u32x4*)((const bf16*)(ws + OFF_U) + idx);
#pragma unroll
        for (int i = 0; i < 4; ++i) { p.a[i] = t0[i]; p.a[4 + i] = t1[i]; p.b[2 * i] = __uint_as_float(u[i] << 16); p.b[2 * i + 1] = __uint_as_float(u[i] & 0xffff0000u); }
    }
}
__device__ __forceinline__ void st_f32x8(float* dst, const float* v) { f32x4 a = {v[0], v[1], v[2], v[3]}, b = {v[4], v[5], v[6], v[7]}; *(f32x4*)dst = a; *(f32x4*)(dst + 4) = b; }
template <int KIND, int T> __device__ __forceinline__ void emit_fin(const EpiCtx& E, int row, int col, const float* a, const Pre& p) {
    constexpr int W = 8;
    unsigned char* ws = E.ws; const size_t idx = (size_t)row * 1024 + col;
    float v[W];
    if constexpr (KIND == EPI_INPROJ) {
        const float rs = p.rs;
#pragma unroll
        for (int i = 0; i < W; ++i) v[i] = a[i] * rs;
        const int b = row >> 12, s = row & 4095;
        if constexpr (T == T_KROPE || T == T_QC || T == T_KC) {
#pragma unroll
            for (int j = 0; j < 4; ++j) { const float c = p.a[j], sn = p.b[j], x1 = v[2 * j], x2 = v[2 * j + 1]; v[2 * j] = x1 * c - x2 * sn; v[2 * j + 1] = x2 * c + x1 * sn; } }
        if constexpr (T == T_QA) { const int cc = col, h = cc >> 6, d = cc & 63;
#pragma unroll
            for (int i = 0; i < W; ++i) v[i] *= C2;
            store_bf<W>((bf16*)(ws + OFF_QA) + ((size_t)(b * 8 + h) * 4096 + s) * 64 + d, v);
        } else if constexpr (T == T_KA) { const int cc = col - 512, h = cc >> 6, d = cc & 63;
            store_bf<W>((bf16*)(ws + OFF_KA) + (size_t)(b * 8 + h) * 262144 + ktile_off(s, d), v);
        } else if constexpr (T == T_VA) { const int cc = col - 1024, h = cc >> 6, d = cc & 63;
            store_bf<W>((bf16*)(ws + OFF_VA) + (size_t)(b * 8 + h) * 262144 + vtile_off(s, d), v);
        } else if constexpr (T == T_ZA || T == T_ZB || T == T_ZC) { const int cc = col - (T == T_ZA ? 1536 : T == T_ZB ? 3328 : 5376);
#pragma unroll
            for (int i = 0; i < W; ++i) v[i] = siluf_(v[i]);
            store_bf<W>((bf16*)(ws + (T == T_ZA ? OFF_ZA : T == T_ZB ? OFF_ZB : OFF_ZC)) + (size_t)row * 512 + cc, v);
        } else if constexpr (T == T_QB) { const int cc = col - 2048, h = cc >> 6, d = cc & 63;
#pragma unroll
            for (int i = 0; i < W; ++i) v[i] *= C2;
            store_bf<W>((bf16*)(ws + OFF_QB) + ((size_t)(b * 8 + h) * 4096 + s) * 64 + d, v);
        } else if constexpr (T == T_CB) { const int cc = col - 2560, g = (cc >> 6) & 1, d = cc & 63;
            store_bf<W>((bf16*)(ws + (cc < 128 ? OFF_KCB : OFF_VCB)) + ((size_t)(b * 2 + g) * 4096 + s) * 64 + d, v);
        } else if constexpr (T == T_KROPE) { const int cc = col - 2816, g = (cc >> 6) & 1, d = cc & 63;
            store_bf<W>((bf16*)(ws + (cc < 128 ? OFF_KSEL : OFF_KWIN)) + (size_t)(b * 2 + g) * 262144 + ktile_off(s, d), v);
        } else if constexpr (T == T_VSW) { const int cc = col - 3072, g = (cc >> 6) & 1, d = cc & 63;
            store_bf<W>((bf16*)(ws + (cc < 128 ? OFF_VSEL : OFF_VWIN)) + (size_t)(b * 2 + g) * 262144 + vtile_off(s, d), v);
        } else if constexpr (T == T_QC) { const int cc = col - 3840, h = cc >> 6, d = cc & 63;
#pragma unroll
            for (int i = 0; i < W; ++i) v[i] *= C2;
            store_bf<W>((bf16*)(ws + OFF_QC) + ((size_t)(b * 8 + h) * 4096 + s) * 64 + d, v);
        } else if constexpr (T == T_KC) { const int cc = col - 4352, h = cc >> 6, d = cc & 63;
            store_bf<W>((bf16*)(ws + OFF_KC) + (size_t)(b * 8 + h) * 262144 + ktile_off(s, d), v);
        } else if constexpr (T == T_VC) { const int cc = col - 4864, hc = cc >> 7, d = cc & 127;
            store_bf<W>((bf16*)(ws + OFF_VC) + (size_t)(b * 4 + hc) * 524288 + v128_off(s, d), v);
        } else { const int cc = col - 5888;
            if (cc < 8) { float* o = (float*)(ws + OFF_LOGF) + (size_t)row * 8 + cc;
#pragma unroll
                for (int i = 0; i < W; ++i) o[i] = logsigmoidf_(v[i] + E.bfg[cc + i]) * LOG2E;
            } else if (cc < 32) { float* o = (float*)(ws + OFF_GATES) + (size_t)row * 24 + (cc - 8);
#pragma unroll
                for (int i = 0; i < W; ++i) o[i] = sigmoidf_(v[i]);
            }
        }
    } else if constexpr (KIND == EPI_GATE3) {
#pragma unroll
        for (int i = 0; i < W; ++i) v[i] = sigmoidf_(a[i] * p.rs);
        store_bf<W>((bf16*)(ws + OFF_G) + (size_t)E.gi * M * 1024 + idx, v);
    } else if constexpr (KIND == EPI_BR3) {
#pragma unroll
        for (int i = 0; i < W; ++i) v[i] = p.a[i] * a[i] + p.b[i];
        store_bf<W>((bf16*)(ws + OFF_T) + idx, v);
    } else if constexpr (KIND == EPI_GATE) {
#pragma unroll
        for (int i = 0; i < W; ++i) v[i] = sigmoidf_(a[i] * p.rs);
        store_bf<W>((bf16*)(ws + OFF_G) + idx, v);
    } else if constexpr (KIND == EPI_BR0 || KIND == EPI_BR1 || KIND == EPI_BR2) {
#pragma unroll
        for (int i = 0; i < W; ++i) { v[i] = p.a[i] * a[i]; if (KIND != EPI_BR0) v[i] += p.b[i]; }
        if constexpr (KIND == EPI_BR2) store_bf<W>((bf16*)(ws + OFF_MERGED) + idx, v);
        else store_bf<W>((bf16*)(ws + OFF_T) + idx, v);
    } else if constexpr (KIND == EPI_OUT) {
#pragma unroll
        for (int i = 0; i < W; ++i) v[i] = p.a[i] + a[i];
        st_f32x8(E.X + idx, v);
        store_bf<W>((bf16*)(ws + OFF_X1B) + idx, v);
    } else if constexpr (KIND == EPI_U) {
        store_bf<W>((bf16*)(ws + OFF_U) + idx, a);
    } else if constexpr (KIND == EPI_PLE) {
#pragma unroll
        for (int i = 0; i < W; ++i) v[i] = p.a[i] + sigmoidf_(a[i]) * p.b[i];
        st_f32x8(E.X + idx, v);
        store_bf<W>((bf16*)(ws + OFF_XB) + idx, v);
    }
}

__device__ __forceinline__ void d_xprep(int vb, int vt, const float* x, unsigned char* ws) {
    const int row = vb * 4 + (vt >> 6), lane = vt & 63;
    const f32x4* xr = (const f32x4*)(x + (size_t)row * 1024) + lane; float ss = 0.f;
    bf16* o = (bf16*)(ws + OFF_XB) + (size_t)row * 1024;
#pragma unroll
    for (int j = 0; j < 4; ++j) { const f32x4 v = xr[64 * j]; ss += (v[0] * v[0] + v[1] * v[1]) + (v[2] * v[2] + v[3] * v[3]); float t[4] = {v[0], v[1], v[2], v[3]}; store_bf<4>(o + 256 * j + 4 * lane, t); }
#pragma unroll
    for (int of = 1; of < 64; of <<= 1) ss += __shfl_xor(ss, of);
    if (lane == 0) { f32x4 s = {ss, 0.f, 0.f, 0.f}; *(f32x4*)(ws + OFF_SSP + (size_t)row * 16) = s; }
}
__device__ __forceinline__ void d_sumsq(int vb, int vt, const float* x, unsigned char* ws) {
    const int row = vb * 4 + (vt >> 6), lane = vt & 63;
    const f32x4* xr = (const f32x4*)(x + (size_t)row * 1024) + lane; float ss = 0.f;
#pragma unroll
    for (int j = 0; j < 4; ++j) { const f32x4 v = xr[64 * j]; ss += (v[0] * v[0] + v[1] * v[1]) + (v[2] * v[2] + v[3] * v[3]); }
#pragma unroll
    for (int of = 1; of < 64; of <<= 1) ss += __shfl_xor(ss, of);
    if (lane == 0) { f32x4 s = {ss, 0.f, 0.f, 0.f}; *(f32x4*)(ws + OFF_SSP + (size_t)row * 16) = s; }
}
__device__ __forceinline__ void d_rope_table(int vb, int vt, const int* pos, unsigned char* ws) {
    const int idx = vb * 256 + vt, row = idx >> 5, i = idx & 31;
    const float inv = exp2f(-(float)i * (13.287712379549449f / 32.f));
    const float ang = (float)pos[row] * inv;
    float s, c; sincosf(ang, &s, &c);
    ((float*)(ws + OFF_COS))[idx] = c; ((float*)(ws + OFF_SIN))[idx] = s;
}
__device__ __forceinline__ void d_pconv(int vb, int vt, const float* p, unsigned char* ws) {
    const size_t i = ((size_t)vb * 256 + vt) * 4;
    const f32x4 v = *(const f32x4*)(p + i); float t[4] = {v[0], v[1], v[2], v[3]}; store_bf<4>((bf16*)(ws + OFF_PB) + i, t);
}
constexpr size_t OFF_CBPART = OFF_CTL + 65536;
__device__ __forceinline__ void d_cb1_part(int u, int vt, const float* pe_k, const float* w1_k, const float* pe_v, const float* w1_v, unsigned char* ws) {
    const int kv = u >> 4, kc = u & 15, j = vt;
    const float* pe = (kv ? pe_v : pe_k) + 128 * kc; const float* w1 = (kv ? w1_v : w1_k) + (size_t)(128 * kc) * 256 + j;
    float acc = 0.f;
#pragma unroll 16
    for (int k = 0; k < 128; ++k) acc += pe[k] * w1[(size_t)k * 256];
    ((float*)(ws + OFF_CBPART))[(kv * 16 + kc) * 256 + j] = acc;
}
__device__ __forceinline__ void d_cb1_sum(int vt, const float* b1_k, const float* b1_v, unsigned char* ws) {
    const int kv = vt >> 8, j = vt & 255; float acc = (kv ? b1_v : b1_k)[j];
#pragma unroll
    for (int kc = 0; kc < 16; ++kc) acc += ((const float*)(ws + OFF_CBPART))[(kv * 16 + kc) * 256 + j];
    ((float*)(ws + OFF_CB1))[kv * 256 + j] = acc;
}
__device__ __forceinline__ void d_lam(int vt, const float* dl, unsigned char* ws, int l) {
    if (vt == 0) { float s1 = 0.f, s2 = 0.f; for (int i = 0; i < 64; ++i) { s1 += dl[i] * dl[64 + i]; s2 += dl[128 + i] * dl[192 + i]; }
        const float li = 0.8f - 0.6f * expf(-0.3f * (float)l); ((float*)(ws + OFF_CTL))[CTL_LAM + l] = expf(s1) - expf(s2) + li; }
}
__device__ __forceinline__ void d_final(int vb, int vt, float* X, const float* g) {
    const int row = vb * 4 + (vt >> 6), lane = vt & 63;
    f32x4* xr = (f32x4*)(X + (size_t)row * 1024) + lane; f32x4 v[4]; float ss = 0.f;
#pragma unroll
    for (int j = 0; j < 4; ++j) { v[j] = xr[64 * j]; ss += (v[j][0] * v[j][0] + v[j][1] * v[j][1]) + (v[j][2] * v[j][2] + v[j][3] * v[j][3]); }
#pragma unroll
    for (int of = 1; of < 64; of <<= 1) ss += __shfl_xor(ss, of);
    const float rs = rsqrtf(ss * (1.f / 1024.f) + EPS);
#pragma unroll
    for (int j = 0; j < 4; ++j) { const f32x4 gg = *((const f32x4*)g + 64 * j + lane); xr[64 * j] = v[j] * rs * gg; }
}


namespace pg8 {
#define PG8_LAS __attribute__((address_space(3)))
typedef unsigned short bf16_t;
typedef short bf16x8 __attribute__((ext_vector_type(8)));
typedef float f32x4 __attribute__((ext_vector_type(4)));
typedef unsigned u32x4 __attribute__((ext_vector_type(4)));
constexpr int BM = 256, BK = 64, HALF = 128, HTB = HALF * BK * 2  , STAGE_BYTES = 8 * HTB, NXCD = 8, WGM = 8;

__host__ __device__ __forceinline__ int lds_byte(int r, int c) { const int st = (r >> 4) * 2 + (c >> 5), rr = r & 15, cc = c & 31, ob = rr * 64 + cc * 2; return st * 1024 + (ob ^ (((ob >> 9) & 1) << 5)); }
__host__ __device__ __forceinline__ void stage_rc(int b, int& R, int& C) { const int st = b / 1024, sb = b % 1024, swz = sb ^ (((sb >> 9) & 1) << 5); R = (st >> 1) * 16 + swz / 64; C = (st & 1) * 32 + (swz % 64) / 2; }
__host__ __device__ __forceinline__ int perm32(int rho) { const int n = rho >> 4, i = rho & 15; return 8 * (i >> 2) + 4 * n + (i & 3); }

struct Unit { int pm, pn; };
struct Gemm { const bf16_t* A; const bf16_t* Bt; int M, N, K; };

struct StaticOrder {
    int nM, nN, nwg, G, c;
    __host__ __device__ void init(int M, int N, int G_, int c_) { nM = M / BM; nN = N / BM; nwg = nM * nN; G = G_; c = c_; }
    __host__ __device__ bool next(int i, Unit& u) const {
        const long L = (long)i * G + c; if (L >= nwg) return false;
        int wgid = (int)L; { const int q = nwg / NXCD, r = nwg % NXCD, xcd = wgid % NXCD, off = wgid / NXCD; wgid = (xcd < r ? xcd * (q + 1) : r * (q + 1) + (xcd - r) * q) + off; }
        const int nig = WGM * nN, gid = wgid / nig, fm = gid * WGM, gsz = (nM - fm) < WGM ? (nM - fm) : WGM;
        u.pm = fm + ((wgid % nig) % gsz); u.pn = (wgid % nig) / gsz; return true;
    }
    __device__ __forceinline__ void a_ready(const Unit&) const {}
    __device__ __forceinline__ void done(const Unit&) const {}
};

__device__ __forceinline__ unsigned cvt_pk_bf16(float lo, float hi) { unsigned r; asm volatile("v_cvt_pk_bf16_f32 %0, %1, %2" : "=v"(r) : "v"(lo), "v"(hi)); return r; }
typedef float f32x2 __attribute__((ext_vector_type(2)));
template <class Epi, class Sched, bool ALIGN_EPI = false, bool SP2 = false>
__device__ __forceinline__ void gemm_phase(PG8_LAS unsigned char* lds, const Gemm g, const Sched& S, const Epi& E) {
    int tid_o = threadIdx.x; asm volatile("" : "+v"(tid_o));
    const int tid = tid_o, wid = __builtin_amdgcn_readfirstlane(tid >> 6), lane = tid & 63, wr = wid >> 2, wc = wid & 3, fr = lane & 15, fq = lane >> 4;
    const int K = g.K, nt = K / BK;
    unsigned voffA[2], voffB[2];
#pragma unroll
    for (int i = 0; i < 2; ++i) { int R, C; stage_rc(tid * 16 + i * 8192, R, C); const int Rb = Epi::PERM ? ((R & ~31) + perm32(R & 31)) : R;
        voffA[i] = (unsigned)(R * K + C) * 2u; voffB[i] = (unsigned)(Rb * K + C) * 2u; }
    const size_t kstep = (size_t)(BK * 2);
    const size_t hstep = (size_t)HALF * K * 2;
    const size_t tstep = 2 * hstep;
    const unsigned ldsw = (unsigned)wid * 1024u;
    const int aoff = lds_byte(wr * 64 + fr, fq * 8), boff = lds_byte(wc * 32 + fr, fq * 8);
#define PG8_SA(b, h) (((b) * 2 + (h)) * HTB)
#define PG8_SB(b, h) ((4 + (b) * 2 + (h)) * HTB)
#define PG8_STAGE(bufoff, gbase, voff) do { _Pragma("unroll") for (int _i = 0; _i < 2; ++_i) \
        __builtin_amdgcn_global_load_lds((const unsigned*)((const char*)(gbase) + (voff)[_i]), (PG8_LAS unsigned*)(lds + (bufoff) + ldsw + _i * 8192), 16, 0, 0); } while (0)
#define PG8_LDA(dst, b, h) do { _Pragma("unroll") for (int m = 0; m < 4; ++m) _Pragma("unroll") for (int k = 0; k < 2; ++k) dst[m][k] = *(const PG8_LAS bf16x8*)(lds + PG8_SA(b, h) + aoff + m * 2048 + k * 1024); } while (0)
#define PG8_LDB(dst, b, h) do { _Pragma("unroll") for (int n = 0; n < 2; ++n) _Pragma("unroll") for (int k = 0; k < 2; ++k) dst[n][k] = *(const PG8_LAS bf16x8*)(lds + PG8_SB(b, h) + boff + n * 2048 + k * 1024); } while (0)
#define PG8_MMA(ai, bj, At, Bt) do { __builtin_amdgcn_s_setprio(1); _Pragma("unroll") for (int m = 0; m < 4; ++m) _Pragma("unroll") for (int n = 0; n < 2; ++n) _Pragma("unroll") for (int k = 0; k < 2; ++k) \
        acc[ai][bj][m][n] = __builtin_amdgcn_mfma_f32_16x16x32_bf16(Bt[n][k], At[m][k], acc[ai][bj][m][n], 0, 0, 0); __builtin_amdgcn_s_setprio(0); } while (0)
#define PG8_WAIT_V(n) asm volatile("s_waitcnt vmcnt(" #n ")" ::: "memory")
#define PG8_WAIT_L(n) asm volatile("s_waitcnt lgkmcnt(" #n ")" ::: "memory")
#define PG8_BAR __builtin_amdgcn_s_barrier()
#define PG8_SCHED __builtin_amdgcn_sched_barrier(0)
    Unit cur, nxt; int ui = 0;
    if (!S.next(0, cur)) return;
    f32x4 acc[2][2][4][2];
#pragma unroll
    for (int a = 0; a < 2; ++a)
#pragma unroll
        for (int b = 0; b < 2; ++b)
#pragma unroll
            for (int m = 0; m < 4; ++m)
#pragma unroll
                for (int n = 0; n < 2; ++n) acc[a][b][m][n] = (f32x4){0.f, 0.f, 0.f, 0.f};
    bf16x8 At[4][2], B0[2][2], B1[2][2];
    const char* cA = (const char*)g.A + (size_t)cur.pm * tstep; const char* cB = (const char*)g.Bt + (size_t)cur.pn * tstep;
    S.a_ready(cur);
    if constexpr (SP2) {
        PG8_STAGE(PG8_SB(0, 0), cB, voffB); PG8_STAGE(PG8_SB(0, 1), cB + hstep, voffB); PG8_STAGE(PG8_SA(0, 0), cA, voffA); PG8_STAGE(PG8_SA(0, 1), cA + hstep, voffA);
        if (wr == 1) PG8_BAR;
        PG8_WAIT_V(2); PG8_BAR;
        PG8_STAGE(PG8_SB(1, 0), cB + kstep, voffB); PG8_STAGE(PG8_SA(1, 0), cA + kstep, voffA); PG8_STAGE(PG8_SB(1, 1), cB + hstep + kstep, voffB);
        PG8_WAIT_V(6); PG8_BAR;
    } else {
        PG8_STAGE(PG8_SB(0, 0), cB, voffB); PG8_STAGE(PG8_SA(0, 0), cA, voffA); PG8_STAGE(PG8_SB(0, 1), cB + hstep, voffB); PG8_STAGE(PG8_SA(0, 1), cA + hstep, voffA);
        if (wr == 1) PG8_BAR;
        PG8_WAIT_V(4); PG8_BAR;
        PG8_STAGE(PG8_SB(1, 0), cB + kstep, voffB); PG8_STAGE(PG8_SA(1, 0), cA + kstep, voffA); PG8_STAGE(PG8_SB(1, 1), cB + hstep + kstep, voffB);
        PG8_WAIT_V(6); PG8_BAR;
    }
    for (;;) {
        const bool has_next = S.next(ui + 1, nxt);
        const char* nA = has_next ? (const char*)g.A + (size_t)nxt.pm * tstep : cA; const char* nB = has_next ? (const char*)g.Bt + (size_t)nxt.pn * tstep : cB;
        for (int t = 0; t < nt; t += 2) {
            const bool last = (t == nt - 2);
            const char* a1 = cA + (size_t)(t + 1) * kstep;
            const char* a2 = last ? nA : cA + (size_t)(t + 2) * kstep; const char* b2 = last ? nB : cB + (size_t)(t + 2) * kstep;
            const char* a3 = a2 + kstep; const char* b3 = b2 + kstep;
            if (last && has_next) S.a_ready(nxt);
            if constexpr (SP2) {
            PG8_LDB(B0, 0, 0); PG8_LDB(B1, 0, 1); PG8_SCHED; PG8_LDA(At, 0, 0); PG8_STAGE(PG8_SA(1, 1), a1 + hstep, voffA);
            PG8_WAIT_V(8); PG8_WAIT_L(0); PG8_BAR; PG8_MMA(0, 0, At, B0); PG8_MMA(0, 1, At, B1); PG8_BAR; PG8_SCHED;
            PG8_LDA(At, 0, 1); PG8_STAGE(PG8_SB(0, 0), b2, voffB); PG8_STAGE(PG8_SB(0, 1), b2 + hstep, voffB); PG8_STAGE(PG8_SA(0, 0), a2, voffA);
            PG8_WAIT_V(8); PG8_WAIT_L(0); PG8_BAR; PG8_MMA(1, 0, At, B0); PG8_MMA(1, 1, At, B1); PG8_BAR; PG8_SCHED;
            PG8_LDB(B0, 1, 0); PG8_LDB(B1, 1, 1); PG8_SCHED; PG8_LDA(At, 1, 0); PG8_STAGE(PG8_SA(0, 1), a2 + hstep, voffA);
            PG8_WAIT_V(8); PG8_WAIT_L(0); PG8_BAR; PG8_MMA(0, 0, At, B0); PG8_MMA(0, 1, At, B1); PG8_BAR; PG8_SCHED;
            PG8_LDA(At, 1, 1); PG8_STAGE(PG8_SB(1, 0), b3, voffB); PG8_STAGE(PG8_SB(1, 1), b3 + hstep, voffB); PG8_STAGE(PG8_SA(1, 0), a3, voffA);
            PG8_WAIT_V(8); PG8_WAIT_L(0); PG8_BAR; PG8_MMA(1, 0, At, B0); PG8_MMA(1, 1, At, B1); PG8_BAR; PG8_SCHED;
            } else {
            PG8_LDB(B0, 0, 0); PG8_SCHED; PG8_LDA(At, 0, 0); PG8_STAGE(PG8_SA(1, 1), a1 + hstep, voffA);
            PG8_WAIT_L(8); PG8_BAR; PG8_WAIT_L(0); PG8_MMA(0, 0, At, B0); PG8_BAR; PG8_SCHED;
            PG8_LDB(B1, 0, 1); PG8_STAGE(PG8_SB(0, 0), b2, voffB);
            PG8_BAR; PG8_WAIT_L(0); PG8_MMA(0, 1, At, B1); PG8_BAR;
            PG8_LDA(At, 0, 1); PG8_STAGE(PG8_SA(0, 0), a2, voffA);
            PG8_BAR; PG8_WAIT_L(0); PG8_MMA(1, 0, At, B0); PG8_BAR; PG8_SCHED;
            PG8_STAGE(PG8_SB(0, 1), b2 + hstep, voffB);
            PG8_WAIT_V(6); PG8_BAR; PG8_MMA(1, 1, At, B1); PG8_BAR;
            PG8_LDB(B0, 1, 0); PG8_SCHED; PG8_LDA(At, 1, 0); PG8_STAGE(PG8_SA(0, 1), a2 + hstep, voffA);
            PG8_WAIT_L(8); PG8_BAR; PG8_WAIT_L(0); PG8_MMA(0, 0, At, B0); PG8_BAR; PG8_SCHED;
            PG8_LDB(B1, 1, 1); PG8_STAGE(PG8_SB(1, 0), b3, voffB);
            PG8_BAR; PG8_WAIT_L(0); PG8_MMA(0, 1, At, B1); PG8_BAR;
            PG8_LDA(At, 1, 1); PG8_STAGE(PG8_SA(1, 0), a3, voffA);
            PG8_BAR; PG8_WAIT_L(0); PG8_MMA(1, 0, At, B0); PG8_BAR; PG8_SCHED;
            PG8_STAGE(PG8_SB(1, 1), b3 + hstep, voffB);
            PG8_WAIT_V(6); PG8_BAR; PG8_MMA(1, 1, At, B1); PG8_BAR;
            }
        }
        if constexpr (ALIGN_EPI) { if (wr == 0) PG8_BAR; }
        if constexpr (!Epi::AFTER_DRAIN) { E(acc, cur, wr, wc, fr, fq); S.done(cur); }
        if (!has_next) break;
#pragma unroll
        for (int a = 0; a < 2; ++a)
#pragma unroll
            for (int b = 0; b < 2; ++b)
#pragma unroll
                for (int m = 0; m < 4; ++m)
#pragma unroll
                    for (int n = 0; n < 2; ++n) acc[a][b][m][n] = (f32x4){0.f, 0.f, 0.f, 0.f};
        cur = nxt; cA = nA; cB = nB; ++ui;
        if constexpr (ALIGN_EPI) { if (wr == 1) PG8_BAR; }
    }
    PG8_WAIT_V(0);
    if constexpr (!ALIGN_EPI) { if (wr == 0) PG8_BAR; }
    PG8_BAR;
    if constexpr (Epi::AFTER_DRAIN) { E.fused(acc, cur, wr, wc, fr, fq, lds, wid, lane); S.done(cur); }
#undef PG8_SA
#undef PG8_SB
#undef PG8_STAGE
#undef PG8_LDA
#undef PG8_LDB
#undef PG8_MMA
#undef PG8_WAIT_V
#undef PG8_WAIT_L
#undef PG8_BAR
#undef PG8_SCHED
}
}

template <int KIND> struct EpiFast {
    static constexpr bool PERM = true, AFTER_DRAIN = false;
    EpiCtx E;
    template <int T, int AI, int MH> __device__ __forceinline__ void grp(const pg8::f32x4 (&acc)[2][2][4][2], int row0, int col0, const float (&rs)[2][4]) const {
        Pre p00, p01, p10, p11;
        p00.rs = p01.rs = rs[AI][2 * MH]; p10.rs = p11.rs = rs[AI][2 * MH + 1];
        const int r0 = row0 + AI * 128 + (2 * MH) * 16, r1 = r0 + 16;
        if constexpr (KIND == EPI_PLE) {
            pre_load<KIND, T>(E, r0, col0, p00); pre_load<KIND, T>(E, r0, col0 + 128, p01);
            { const pg8::f32x4 v0 = acc[AI][0][2 * MH][0], v1 = acc[AI][0][2 * MH][1]; float v[8] = {v0[0], v0[1], v0[2], v0[3], v1[0], v1[1], v1[2], v1[3]}; emit_fin<KIND, T>(E, r0, col0, v, p00); }
            { const pg8::f32x4 v0 = acc[AI][1][2 * MH][0], v1 = acc[AI][1][2 * MH][1]; float v[8] = {v0[0], v0[1], v0[2], v0[3], v1[0], v1[1], v1[2], v1[3]}; emit_fin<KIND, T>(E, r0, col0 + 128, v, p01); }
            asm volatile("" ::: "memory");
            pre_load<KIND, T>(E, r1, col0, p10); pre_load<KIND, T>(E, r1, col0 + 128, p11);
            { const pg8::f32x4 v0 = acc[AI][0][2 * MH + 1][0], v1 = acc[AI][0][2 * MH + 1][1]; float v[8] = {v0[0], v0[1], v0[2], v0[3], v1[0], v1[1], v1[2], v1[3]}; emit_fin<KIND, T>(E, r1, col0, v, p10); }
            { const pg8::f32x4 v0 = acc[AI][1][2 * MH + 1][0], v1 = acc[AI][1][2 * MH + 1][1]; float v[8] = {v0[0], v0[1], v0[2], v0[3], v1[0], v1[1], v1[2], v1[3]}; emit_fin<KIND, T>(E, r1, col0 + 128, v, p11); }
            asm volatile("" ::: "memory");
            return;
        }
        pre_load<KIND, T>(E, r0, col0, p00); pre_load<KIND, T>(E, r0, col0 + 128, p01); pre_load<KIND, T>(E, r1, col0, p10); pre_load<KIND, T>(E, r1, col0 + 128, p11);
        { const pg8::f32x4 v0 = acc[AI][0][2 * MH][0], v1 = acc[AI][0][2 * MH][1]; float v[8] = {v0[0], v0[1], v0[2], v0[3], v1[0], v1[1], v1[2], v1[3]}; emit_fin<KIND, T>(E, r0, col0, v, p00); }
        { const pg8::f32x4 v0 = acc[AI][1][2 * MH][0], v1 = acc[AI][1][2 * MH][1]; float v[8] = {v0[0], v0[1], v0[2], v0[3], v1[0], v1[1], v1[2], v1[3]}; emit_fin<KIND, T>(E, r0, col0 + 128, v, p01); }
        { const pg8::f32x4 v0 = acc[AI][0][2 * MH + 1][0], v1 = acc[AI][0][2 * MH + 1][1]; float v[8] = {v0[0], v0[1], v0[2], v0[3], v1[0], v1[1], v1[2], v1[3]}; emit_fin<KIND, T>(E, r1, col0, v, p10); }
        { const pg8::f32x4 v0 = acc[AI][1][2 * MH + 1][0], v1 = acc[AI][1][2 * MH + 1][1]; float v[8] = {v0[0], v0[1], v0[2], v0[3], v1[0], v1[1], v1[2], v1[3]}; emit_fin<KIND, T>(E, r1, col0 + 128, v, p11); }
        asm volatile("" ::: "memory");
    }
    template <int T> __device__ __forceinline__ void run(const pg8::f32x4 (&acc)[2][2][4][2], int row0, int col0) const {
        float rs[2][4];
        if constexpr (KIND == EPI_INPROJ || KIND == EPI_GATE || KIND == EPI_GATE3) {
#pragma unroll
            for (int ai = 0; ai < 2; ++ai)
#pragma unroll
                for (int m = 0; m < 4; ++m) rs[ai][m] = row_rstd(E.ws, row0 + ai * 128 + m * 16);
        } else {
#pragma unroll
            for (int ai = 0; ai < 2; ++ai)
#pragma unroll
                for (int m = 0; m < 4; ++m) rs[ai][m] = 1.f; }
        grp<T, 0, 0>(acc, row0, col0, rs); grp<T, 0, 1>(acc, row0, col0, rs); grp<T, 1, 0>(acc, row0, col0, rs); grp<T, 1, 1>(acc, row0, col0, rs);
    }
    __device__ __forceinline__ void operator()(const pg8::f32x4 (&acc)[2][2][4][2], const pg8::Unit& u, int wr, int wc, int fr, int fq) const {
        const int row0 = u.pm * 256 + wr * 64 + fr, col0 = u.pn * 256 + wc * 32 + 8 * fq;
        if constexpr (KIND == EPI_INPROJ) {
            switch (inproj_type(u.pn)) {
                case T_QA: run<T_QA>(acc, row0, col0); break;
                case T_KA: run<T_KA>(acc, row0, col0); break;
                case T_VA: run<T_VA>(acc, row0, col0); break;
                case T_ZA: run<T_ZA>(acc, row0, col0); break;
                case T_QB: run<T_QB>(acc, row0, col0); break;
                case T_CB: run<T_CB>(acc, row0, col0); break;
                case T_KROPE: run<T_KROPE>(acc, row0, col0); break;
                case T_VSW: run<T_VSW>(acc, row0, col0); break;
                case T_ZB: run<T_ZB>(acc, row0, col0); break;
                case T_QC: run<T_QC>(acc, row0, col0); break;
                case T_KC: run<T_KC>(acc, row0, col0); break;
                case T_VC: run<T_VC>(acc, row0, col0); break;
                case T_ZC: run<T_ZC>(acc, row0, col0); break;
                default: run<T_SPECIAL>(acc, row0, col0); break;
            }
        } else if constexpr (KIND == EPI_GATE3 || KIND == EPI_BR3) {
            EpiFast<KIND> t = *this; t.E.gi = u.pn >> 2;
            t.template run<0>(acc, (u.pm & 63) * 256 + wr * 64 + fr, (u.pn & 3) * 256 + wc * 32 + 8 * fq);
        } else run<0>(acc, row0, col0);
    }
};
struct ChainOrder {
    int pm, pn4, rowmul;
    __device__ __forceinline__ void init(int G, int c, int rowmul_) { pg8::StaticOrder S0; S0.init(M, 1024, G, c); pg8::Unit u0; S0.next(0, u0); pm = u0.pm; pn4 = u0.pn; rowmul = rowmul_; }
    __device__ __forceinline__ bool next(int i, pg8::Unit& u) const { if (i >= 3) return false; u.pm = pm + 64 * i * rowmul; u.pn = 4 * i + pn4; return true; }
    __device__ __forceinline__ void a_ready(const pg8::Unit&) const {}
    __device__ __forceinline__ void done(const pg8::Unit&) const {}
};
#define FAST_GEMM(KIND, Aptr, Bptr, N_, K_, ALIGN) do { pg8::Gemm g_{(const pg8::bf16_t*)(Aptr), (const pg8::bf16_t*)(Bptr), M, (N_), (K_)}; pg8::StaticOrder S_; S_.init(M, (N_), (int)gridDim.x, (int)blockIdx.x); \
        EpiFast<KIND> Ep_{E}; pg8::gemm_phase<EpiFast<KIND>, pg8::StaticOrder, ALIGN, true>((PG8_LAS unsigned char*)lds, g_, S_, Ep_); } while (0)

#define LAS __attribute__((address_space(3)))
typedef short s16x4 __attribute__((ext_vector_type(4)));
typedef short v4i16_t __attribute__((ext_vector_type(4)));
typedef LAS const char* lds_cptr;
constexpr int A_KRING = 0, A_VRING = 49152, A_CFRING = 98304, A_MISC = 104448;
constexpr int A_SLOT = 16384;
constexpr int A_IMP = A_MISC, A_SELM = A_MISC + 16384, A_UMASK = A_SELM + 512, A_SEQ = A_UMASK + 16, A_WQ = A_SEQ + 80;
__device__ __forceinline__ void glds16(const void* gsrc, unsigned lds_dst) { unsigned keep;
    asm volatile("s_mov_b32 %0, m0\n\ts_mov_b32 m0, %2\n\ts_nop 0\n\tglobal_load_lds_dwordx4 %1, off\n\ts_mov_b32 m0, %0" : "=&s"(keep) : "v"(gsrc), "s"(lds_dst) : "memory"); }
__device__ __forceinline__ void glds4(const void* gsrc, unsigned lds_dst) { unsigned keep;
    asm volatile("s_mov_b32 %0, m0\n\ts_mov_b32 m0, %2\n\ts_nop 0\n\tglobal_load_lds_dword %1, off\n\ts_mov_b32 m0, %0" : "=&s"(keep) : "v"(gsrc), "s"(lds_dst) : "memory"); }
#define A_WAIT_BAR(N) asm volatile("s_waitcnt vmcnt(" #N ") lgkmcnt(0)\n\ts_barrier" ::: "memory")
constexpr int LDS_QSLOT = 131072 + 128;
#define Q_TAKE(qn, qc) unsigned qn = 0u; if (tid == 0) qn = __hip_atomic_fetch_add((qc), 1u, __ATOMIC_RELAXED, __HIP_MEMORY_SCOPE_AGENT)
#define Q_PARK(qn) do { if (tid == 0) *(volatile LAS unsigned*)((LAS unsigned char*)lds + LDS_QSLOT) = qn; } while (0)
__device__ __forceinline__ s16x4 vtr(lds_cptr p) { return __builtin_bit_cast(s16x4, __builtin_amdgcn_ds_read_tr16_b64_v4i16((LAS v4i16_t*)p)); }
__device__ __forceinline__ unsigned cvtpk(float lo, float hi) { typedef float f2 __attribute__((ext_vector_type(2))); typedef __bf16 b2 __attribute__((ext_vector_type(2))); f2 v = {lo, hi}; b2 b = __builtin_convertvector(v, b2); return __builtin_bit_cast(unsigned, b); }
__device__ __forceinline__ int crow(int r, int hi) { return (r & 3) + 8 * (r >> 2) + 4 * hi; }

template <int NDB> struct FlashSt { f32x16 o[NDB]; float m, l; };
template <int NDB> __device__ __forceinline__ void flash_init(FlashSt<NDB>& st) {
#pragma unroll
    for (int i = 0; i < NDB; ++i)
#pragma unroll
        for (int r = 0; r < 16; ++r) st.o[i][r] = 0.f;
    st.m = -1e30f; st.l = 0.f;
}
template <int NDB> __device__ __forceinline__ void flash_init3(FlashSt<NDB>& st) { flash_init<NDB>(st); st.m = 0.f; }
__device__ __forceinline__ void qk_tile(f32x16& p0, f32x16& p1, lds_cptr kslot, const bf16x8 (&qf)[4], int r32, int hi) {
    const lds_cptr kb = kslot + hi * 1024 + r32 * 16;
    bf16x8 ka[4], kc[4];
#pragma unroll
    for (int d0 = 0; d0 < 4; ++d0) { ka[d0] = *(const LAS bf16x8*)(kb + d0 * 2048); kc[d0] = *(const LAS bf16x8*)(kb + d0 * 2048 + 512); }
#pragma unroll
    for (int d0 = 0; d0 < 4; ++d0) {
        p0 = __builtin_amdgcn_mfma_f32_32x32x16_bf16(ka[d0], qf[d0], p0, 0, 0, 0);
        p1 = __builtin_amdgcn_mfma_f32_32x32x16_bf16(kc[d0], qf[d0], p1, 0, 0, 0);
    }
}
__device__ __forceinline__ float xhalf_max(float a) {
    auto rr = __builtin_amdgcn_permlane32_swap(__float_as_uint(a), __float_as_uint(a), false, false);
    return fmaxf(__uint_as_float(rr[0]), __uint_as_float(rr[1]));
}
__device__ __forceinline__ float rowmax32(const f32x16& p0, const f32x16& p1) {
    float a = fmaxf(p0[0], p1[0]);
#pragma unroll
    for (int r = 1; r < 16; ++r) a = fmaxf(a, fmaxf(p0[r], p1[r]));
    return xhalf_max(a);
}
template <int NDB> __device__ __forceinline__ void pv_tile(f32x16 (&o)[NDB], lds_cptr vslot_l, const f32x16& p0, const f32x16& p1) {
    bf16x8 pf[4];
    { u32x4 w;
      w.x = cvtpk(p0[0], p0[1]); w.y = cvtpk(p0[2], p0[3]); w.z = cvtpk(p0[4], p0[5]); w.w = cvtpk(p0[6], p0[7]); pf[0] = __builtin_bit_cast(bf16x8, w);
      w.x = cvtpk(p0[8], p0[9]); w.y = cvtpk(p0[10], p0[11]); w.z = cvtpk(p0[12], p0[13]); w.w = cvtpk(p0[14], p0[15]); pf[1] = __builtin_bit_cast(bf16x8, w);
      w.x = cvtpk(p1[0], p1[1]); w.y = cvtpk(p1[2], p1[3]); w.z = cvtpk(p1[4], p1[5]); w.w = cvtpk(p1[6], p1[7]); pf[2] = __builtin_bit_cast(bf16x8, w);
      w.x = cvtpk(p1[8], p1[9]); w.y = cvtpk(p1[10], p1[11]); w.z = cvtpk(p1[12], p1[13]); w.w = cvtpk(p1[14], p1[15]); pf[3] = __builtin_bit_cast(bf16x8, w); }
#pragma unroll
    for (int db = 0; db < NDB; ++db) {
        bf16x8 vf[4];
#pragma unroll
        for (int ks = 0; ks < 4; ++ks) { const s16x4 lo = vtr(vslot_l + db * 4096 + ks * 1024), hh = vtr(vslot_l + db * 4096 + ks * 1024 + 512);
            vf[ks] = (bf16x8){lo[0], lo[1], lo[2], lo[3], hh[0], hh[1], hh[2], hh[3]}; }
#pragma unroll
        for (int ks = 0; ks < 4; ++ks) o[db] = __builtin_amdgcn_mfma_f32_32x32x16_bf16(vf[ks], pf[ks], o[db], 0, 0, 0);
    }
}
template <int NDB> __device__ __forceinline__ void flash_update(FlashSt<NDB>& st, f32x16& p0, f32x16& p1, lds_cptr vslot_l) {
    const float rm = rowmax32(p0, p1);
    const float mn = fmaxf(st.m, rm), alpha = __builtin_amdgcn_exp2f(st.m - mn);
    st.m = mn;
    float ls = 0.f;
#pragma unroll
    for (int r = 0; r < 16; ++r) { p0[r] = __builtin_amdgcn_exp2f(p0[r] - mn); p1[r] = __builtin_amdgcn_exp2f(p1[r] - mn); ls += p0[r] + p1[r]; }
    st.l = st.l * alpha + ls;
#pragma unroll
    for (int db = 0; db < NDB; ++db)
#pragma unroll
        for (int r = 0; r < 16; ++r) st.o[db][r] *= alpha;
    pv_tile<NDB>(st.o, vslot_l, p0, p1);
}
__device__ __forceinline__ int lane_vbase(int lane) { return ((lane >> 4) & 1) * 32 + (lane & 3) * 8 + (4 * (lane >> 5) + ((lane & 15) >> 2)) * 64; }
#define DSR128(dst, addr, off) asm volatile("ds_read_b128 %0, %1 offset:%c2" : "=v"(dst) : "v"(addr), "i"(off) : "memory")
#define DSRTR(dst, addr, off) asm volatile("ds_read_b64_tr_b16 %0, %1 offset:%c2" : "=v"(dst) : "v"(addr), "i"(off) : "memory")
#define LGKM_WAIT0() do { asm volatile("s_waitcnt lgkmcnt(0)" ::: "memory"); __builtin_amdgcn_sched_barrier(0); } while (0)
__device__ __forceinline__ void qk_tile2(f32x16& p0, f32x16& p1, unsigned kaddr, const bf16x8 (&qf)[4]) {
    bf16x8 ka0, ka1, ka2, ka3, kc0, kc1, kc2, kc3;
    DSR128(ka0, kaddr, 0); DSR128(kc0, kaddr, 512); DSR128(ka1, kaddr, 2048); DSR128(kc1, kaddr, 2560);
    DSR128(ka2, kaddr, 4096); DSR128(kc2, kaddr, 4608); DSR128(ka3, kaddr, 6144); DSR128(kc3, kaddr, 6656);
    LGKM_WAIT0();
    __builtin_amdgcn_s_setprio(1);
    p0 = __builtin_amdgcn_mfma_f32_32x32x16_bf16(ka0, qf[0], p0, 0, 0, 0); p1 = __builtin_amdgcn_mfma_f32_32x32x16_bf16(kc0, qf[0], p1, 0, 0, 0);
    p0 = __builtin_amdgcn_mfma_f32_32x32x16_bf16(ka1, qf[1], p0, 0, 0, 0); p1 = __builtin_amdgcn_mfma_f32_32x32x16_bf16(kc1, qf[1], p1, 0, 0, 0);
    p0 = __builtin_amdgcn_mfma_f32_32x32x16_bf16(ka2, qf[2], p0, 0, 0, 0); p1 = __builtin_amdgcn_mfma_f32_32x32x16_bf16(kc2, qf[2], p1, 0, 0, 0);
    p0 = __builtin_amdgcn_mfma_f32_32x32x16_bf16(ka3, qf[3], p0, 0, 0, 0); p1 = __builtin_amdgcn_mfma_f32_32x32x16_bf16(kc3, qf[3], p1, 0, 0, 0);
    __builtin_amdgcn_s_setprio(0);
}
struct VFr { s16x4 lo[8], hi[8]; };
template <int DB0> __device__ __forceinline__ void v_issue(VFr& f, unsigned vaddr) {
    DSRTR(f.lo[0], vaddr, DB0 * 4096 + 0);    DSRTR(f.hi[0], vaddr, DB0 * 4096 + 512);
    DSRTR(f.lo[1], vaddr, DB0 * 4096 + 1024); DSRTR(f.hi[1], vaddr, DB0 * 4096 + 1536);
    DSRTR(f.lo[2], vaddr, DB0 * 4096 + 2048); DSRTR(f.hi[2], vaddr, DB0 * 4096 + 2560);
    DSRTR(f.lo[3], vaddr, DB0 * 4096 + 3072); DSRTR(f.hi[3], vaddr, DB0 * 4096 + 3584);
    DSRTR(f.lo[4], vaddr, DB0 * 4096 + 4096); DSRTR(f.hi[4], vaddr, DB0 * 4096 + 4608);
    DSRTR(f.lo[5], vaddr, DB0 * 4096 + 5120); DSRTR(f.hi[5], vaddr, DB0 * 4096 + 5632);
    DSRTR(f.lo[6], vaddr, DB0 * 4096 + 6144); DSRTR(f.hi[6], vaddr, DB0 * 4096 + 6656);
    DSRTR(f.lo[7], vaddr, DB0 * 4096 + 7168); DSRTR(f.hi[7], vaddr, DB0 * 4096 + 7680);
}
#define VFRAG(f, i) ((bf16x8){(f).lo[i][0], (f).lo[i][1], (f).lo[i][2], (f).lo[i][3], (f).hi[i][0], (f).hi[i][1], (f).hi[i][2], (f).hi[i][3]})
__device__ __forceinline__ void pv2(f32x16& oa, f32x16& ob, const VFr& f, const bf16x8 (&pf)[4]) {
    __builtin_amdgcn_s_setprio(1);
    oa = __builtin_amdgcn_mfma_f32_32x32x16_bf16(VFRAG(f, 0), pf[0], oa, 0, 0, 0); ob = __builtin_amdgcn_mfma_f32_32x32x16_bf16(VFRAG(f, 4), pf[0], ob, 0, 0, 0);
    oa = __builtin_amdgcn_mfma_f32_32x32x16_bf16(VFRAG(f, 1), pf[1], oa, 0, 0, 0); ob = __builtin_amdgcn_mfma_f32_32x32x16_bf16(VFRAG(f, 5), pf[1], ob, 0, 0, 0);
    oa = __builtin_amdgcn_mfma_f32_32x32x16_bf16(VFRAG(f, 2), pf[2], oa, 0, 0, 0); ob = __builtin_amdgcn_mfma_f32_32x32x16_bf16(VFRAG(f, 6), pf[2], ob, 0, 0, 0);
    oa = __builtin_amdgcn_mfma_f32_32x32x16_bf16(VFRAG(f, 3), pf[3], oa, 0, 0, 0); ob = __builtin_amdgcn_mfma_f32_32x32x16_bf16(VFRAG(f, 7), pf[3], ob, 0, 0, 0);
    __builtin_amdgcn_s_setprio(0);
}
__device__ __forceinline__ void pack_p(bf16x8 (&pf)[4], const f32x16& p0, const f32x16& p1) {
    u32x4 w;
    w.x = cvtpk(p0[0], p0[1]); w.y = cvtpk(p0[2], p0[3]); w.z = cvtpk(p0[4], p0[5]); w.w = cvtpk(p0[6], p0[7]); pf[0] = __builtin_bit_cast(bf16x8, w);
    w.x = cvtpk(p0[8], p0[9]); w.y = cvtpk(p0[10], p0[11]); w.z = cvtpk(p0[12], p0[13]); w.w = cvtpk(p0[14], p0[15]); pf[1] = __builtin_bit_cast(bf16x8, w);
    w.x = cvtpk(p1[0], p1[1]); w.y = cvtpk(p1[2], p1[3]); w.z = cvtpk(p1[4], p1[5]); w.w = cvtpk(p1[6], p1[7]); pf[2] = __builtin_bit_cast(bf16x8, w);
    w.x = cvtpk(p1[8], p1[9]); w.y = cvtpk(p1[10], p1[11]); w.z = cvtpk(p1[12], p1[13]); w.w = cvtpk(p1[14], p1[15]); pf[3] = __builtin_bit_cast(bf16x8, w);
}
template <int NDB> __device__ __forceinline__ void flash_update2(FlashSt<NDB>& st, f32x16& p0, f32x16& p1, unsigned vaddr) {
    VFr vf; v_issue<0>(vf, vaddr);
    const float rm = rowmax32(p0, p1);
    const float mn = fmaxf(st.m, rm), alpha = __builtin_amdgcn_exp2f(st.m - mn);
    st.m = mn;
    float ls = 0.f;
#pragma unroll
    for (int r = 0; r < 16; ++r) { p0[r] = __builtin_amdgcn_exp2f(p0[r] - mn); p1[r] = __builtin_amdgcn_exp2f(p1[r] - mn); ls += p0[r] + p1[r]; }
    st.l = st.l * alpha + ls;
#pragma unroll
    for (int db = 0; db < NDB; ++db)
#pragma unroll
        for (int r = 0; r < 16; ++r) st.o[db][r] *= alpha;
    bf16x8 pf[4]; pack_p(pf, p0, p1);
    LGKM_WAIT0();
    pv2(st.o[0], st.o[1], vf, pf);
    if constexpr (NDB == 4) { v_issue<2>(vf, vaddr); LGKM_WAIT0(); pv2(st.o[2], st.o[3], vf, pf); }
}
__device__ __forceinline__ float max3_(float a, float b, float c) { float r; asm("v_max3_f32 %0, %1, %2, %3" : "=v"(r) : "v"(a), "v"(b), "v"(c)); return r; }
__device__ __forceinline__ float rowmax32_asm(const f32x16& p0, const f32x16& p1) {
    float a = max3_(p0[0], p0[1], p1[0]), b = max3_(p0[2], p0[3], p1[1]); a = max3_(a, p1[2], p1[3]);
#pragma unroll
    for (int r = 4; r < 16; r += 4) { a = max3_(a, p0[r], p0[r + 1]); b = max3_(b, p0[r + 2], p0[r + 3]); a = max3_(a, p1[r], p1[r + 1]); b = max3_(b, p1[r + 2], p1[r + 3]); }
    float m; asm("v_max_f32_e32 %0, %1, %2" : "=v"(m) : "v"(a), "v"(b));
    auto rr = __builtin_amdgcn_permlane32_swap(__float_as_uint(m), __float_as_uint(m), false, false);
    float o; asm("v_max_f32_e32 %0, %1, %2" : "=v"(o) : "v"(__uint_as_float(rr[0])), "v"(__uint_as_float(rr[1]))); return o;
}
constexpr float FA_THR = 8.f;
template <int NDB> __device__ __forceinline__ bool flash_update3(FlashSt<NDB>& st, f32x16& p0, f32x16& p1, unsigned vaddr) {
    VFr vf; v_issue<0>(vf, vaddr);
    asm volatile("s_nop 15\n\ts_nop 7" : "+v"(p0), "+v"(p1));
    const float rm = rowmax32_asm(p0, p1);
    bool moved = false;
    if (__builtin_expect(__builtin_amdgcn_ballot_w64(rm > FA_THR) != 0ull, 0)) {
        const float dl = fmaxf(rm, 0.f), f = __builtin_amdgcn_exp2f(-dl);
        st.m += dl; st.l *= f;
#pragma unroll
        for (int r = 0; r < 16; ++r) { p0[r] -= dl; p1[r] -= dl; }
#pragma unroll
        for (int db = 0; db < NDB; ++db)
#pragma unroll
            for (int r = 0; r < 16; ++r) st.o[db][r] *= f;
        moved = true;
    }
    float ls = 0.f;
#pragma unroll
    for (int r = 0; r < 16; ++r) { p0[r] = __builtin_amdgcn_exp2f(p0[r]); p1[r] = __builtin_amdgcn_exp2f(p1[r]); ls += p0[r] + p1[r]; }
    st.l += ls;
    bf16x8 pf[4]; pack_p(pf, p0, p1);
    LGKM_WAIT0();
    pv2(st.o[0], st.o[1], vf, pf);
    if constexpr (NDB == 4) { v_issue<2>(vf, vaddr); LGKM_WAIT0(); pv2(st.o[2], st.o[3], vf, pf); }
    return moved;
}
__device__ __forceinline__ void pv_only2(f32x16 (&o)[2], unsigned vaddr, const f32x16& p0, const f32x16& p1) {
    VFr vf; v_issue<0>(vf, vaddr); bf16x8 pf[4]; pack_p(pf, p0, p1); LGKM_WAIT0(); pv2(o[0], o[1], vf, pf);
}

__device__ __forceinline__ void fox_unit(unsigned char* lds, unsigned char* ws, int bh, int qb, unsigned* qc, int dry = 0) {
    int tid_o = threadIdx.x; asm volatile("" : "+v"(tid_o));
    const int tid = tid_o, lane = tid & 63, wid = __builtin_amdgcn_readfirstlane(tid >> 6), r32 = lane & 31, hi = lane >> 5;
    const unsigned lds0 = (unsigned)(uintptr_t)lds;
    const lds_cptr L = (lds_cptr)lds;
    const int qrow = 256 * qb + 32 * wid + r32, wrow0 = 256 * qb + 32 * wid;
    const int NTl = 4 * (qb + 1);
    const char* Kg = (const char*)(ws + OFF_KA) + (size_t)bh * 524288 + wid * 1024 + lane * 16;
    const char* Vg = (const char*)(ws + OFF_VA) + (size_t)bh * 524288 + wid * 1024 + lane * 16;
    const char* Cg = (const char*)(ws + OFF_CF) + (size_t)bh * 16384 + lane * 4;
    const unsigned kdst = (unsigned)__builtin_amdgcn_readfirstlane(lds0 + A_KRING + wid * 1024), vdst = (unsigned)__builtin_amdgcn_readfirstlane(lds0 + A_VRING + wid * 1024),
                   cdst = (unsigned)__builtin_amdgcn_readfirstlane(lds0 + A_CFRING + wid * 256);
#define FOX_DMA(t, slot) do { glds16(Kg + (size_t)(t) * 8192, kdst + (slot) * A_SLOT); glds16(Vg + (size_t)(t) * 8192, vdst + (slot) * A_SLOT); glds4(Cg + (size_t)(t) * 256, cdst + (slot) * 2048); } while (0)
    asm volatile("s_waitcnt vmcnt(0)" ::: "memory");
    FOX_DMA(0, 0); FOX_DMA(1, 1);
    bf16x8 qf[4];
    { const bf16* Q = (const bf16*)(ws + OFF_QA) + ((size_t)bh * 4096 + qrow) * 64 + 8 * hi;
#pragma unroll
      for (int d0 = 0; d0 < 4; ++d0) qf[d0] = *(const bf16x8*)(Q + 16 * d0); }
    FlashSt<2> st; flash_init3<2>(st);
    const int vb = lane_vbase(lane);
    const unsigned kaddr0 = lds0 + A_KRING + hi * 1024 + r32 * 16, vaddr0 = lds0 + A_VRING + vb;
    Q_TAKE(qn, qc);
    asm volatile("" : "+v"(qf[0]), "+v"(qf[1]), "+v"(qf[2]), "+v"(qf[3]), "+v"(qn));
    asm volatile("s_waitcnt vmcnt(0)" ::: "memory");
    asm volatile("s_barrier" ::: "memory");
    Q_PARK(qn);
    int slot = 0;
    for (int t = 0; t < NTl; ++t) {
        const int s2 = (slot >= 1) ? slot - 1 : 2;
        if (t + 2 < NTl) FOX_DMA(t + 2, s2);
        if (64 * t <= wrow0 + 31 && dry != 4) {
            f32x16 p0, p1;
            { const unsigned ca = lds0 + A_CFRING + slot * 2048 + wid * 256 + 16 * hi; f32x4 c0, c1, c2, c3, c4, c5, c6, c7;
              DSR128(c0, ca, 0); DSR128(c1, ca, 32); DSR128(c2, ca, 64); DSR128(c3, ca, 96); DSR128(c4, ca, 128); DSR128(c5, ca, 160); DSR128(c6, ca, 192); DSR128(c7, ca, 224);
              LGKM_WAIT0();
              p0 = __builtin_shufflevector(__builtin_shufflevector(c0, c1, 0, 1, 2, 3, 4, 5, 6, 7), __builtin_shufflevector(c2, c3, 0, 1, 2, 3, 4, 5, 6, 7), 0, 1, 2, 3, 4, 5, 6, 7, 8, 9, 10, 11, 12, 13, 14, 15);
              p1 = __builtin_shufflevector(__builtin_shufflevector(c4, c5, 0, 1, 2, 3, 4, 5, 6, 7), __builtin_shufflevector(c6, c7, 0, 1, 2, 3, 4, 5, 6, 7), 0, 1, 2, 3, 4, 5, 6, 7, 8, 9, 10, 11, 12, 13, 14, 15);
              p0 = p0 - st.m; p1 = p1 - st.m; }
            qk_tile2(p0, p1, kaddr0 + slot * A_SLOT, qf);
            if (64 * t + 63 > wrow0) {
                const int kb = 64 * t + 4 * hi;
#pragma unroll
                for (int r = 0; r < 16; ++r) { const int kv = kb + (r & 3) + 8 * (r >> 2); if (kv > qrow) p0[r] = -INFINITY; if (kv + 32 > qrow) p1[r] = -INFINITY; }
            }
            if (dry != 3) (void)flash_update3<2>(st, p0, p1, vaddr0 + slot * A_SLOT); else { st.o[0] += p0; st.o[1] += p1; }
        }
        if (dry == 2) { asm volatile("s_waitcnt lgkmcnt(0)\n\ts_barrier" ::: "memory"); } else if (t + 2 < NTl) { A_WAIT_BAR(3); } else { A_WAIT_BAR(0); }
        slot = (slot == 2) ? 0 : slot + 1;
    }
#undef FOX_DMA
    const float lt = st.l + __shfl_xor(st.l, 32), il = 1.f / lt;
    const int b = bh >> 3, h = bh & 7;
    bf16* Y = (bf16*)(ws + OFF_ZA) + (size_t)(b * 4096 + qrow) * 512 + h * 64;
    bf16* Yd = dry ? (bf16*)(ws + OFF_SELM) + (tid * 64) : Y;
#pragma unroll
    for (int db = 0; db < 2; ++db)
#pragma unroll
        for (int rq = 0; rq < 4; ++rq) { bf16* yp = Y + 32 * db + 8 * rq + 4 * hi; bf16* yo = Yd + 32 * db + 8 * rq + 4 * hi; const u32x2 z = *(const u32x2*)yp;
            const float z0 = __uint_as_float(z.x << 16), z1 = __uint_as_float(z.x & 0xffff0000u), z2 = __uint_as_float(z.y << 16), z3 = __uint_as_float(z.y & 0xffff0000u);
            u32x2 o; o.x = pk2(st.o[db][4 * rq] * il * z0, st.o[db][4 * rq + 1] * il * z1); o.y = pk2(st.o[db][4 * rq + 2] * il * z2, st.o[db][4 * rq + 3] * il * z3);
            *(u32x2*)yo = o; }
}

__device__ __forceinline__ void diff_unit(unsigned char* lds, unsigned char* ws, int bhc, int qb, const float* subg, float lam, float lam_init, unsigned* qc, bool dry = false) {
    int tid_o = threadIdx.x; asm volatile("" : "+v"(tid_o));
    const int tid = tid_o, lane = tid & 63, wid = __builtin_amdgcn_readfirstlane(tid >> 6), r32 = lane & 31, hi = lane >> 5;
    const int map = wid >> 2, wl = wid & 3;
    const unsigned lds0 = (unsigned)(uintptr_t)lds;
    const lds_cptr L = (lds_cptr)lds;
    const int b = bhc >> 2, hc = bhc & 3;
    const int qrow = 128 * qb + 32 * wl + r32, wrow0 = 128 * qb + 32 * wl;
    const int NTl = 2 * (qb + 1);
    const char* Kg = (const char*)(ws + OFF_KC) + (size_t)(b * 8 + hc * 2) * 524288 + wid * 1024 + lane * 16;
    const char* Vg = (const char*)(ws + OFF_VC) + (size_t)bhc * 1048576 + wid * 1024 + lane * 16;
    const unsigned kdst = (unsigned)__builtin_amdgcn_readfirstlane(lds0 + A_KRING + wid * 1024), vdst = (unsigned)__builtin_amdgcn_readfirstlane(lds0 + A_VRING + wid * 1024);
#define DIFF_DMA(t, slot) do { glds16(Kg + (size_t)(t) * 8192, kdst + (slot) * A_SLOT); glds16(Kg + 524288 + (size_t)(t) * 8192, kdst + (slot) * A_SLOT + 8192); \
        glds16(Vg + (size_t)(t) * 16384, vdst + (slot) * A_SLOT); glds16(Vg + (size_t)(t) * 16384 + 8192, vdst + (slot) * A_SLOT + 8192); } while (0)
    asm volatile("s_waitcnt vmcnt(0)" ::: "memory");
    DIFF_DMA(0, 0); DIFF_DMA(1, 1);
    bf16x8 qf[4];
    { const bf16* Q = (const bf16*)(ws + OFF_QC) + ((size_t)(b * 8 + hc * 2 + map) * 4096 + qrow) * 64 + 8 * hi;
#pragma unroll
      for (int d0 = 0; d0 < 4; ++d0) qf[d0] = *(const bf16x8*)(Q + 16 * d0); }
    FlashSt<4> st; flash_init3<4>(st);
    f32x16 negm;
#pragma unroll
    for (int r = 0; r < 16; ++r) negm[r] = 0.f;
    const int vb = lane_vbase(lane);
    const unsigned kaddr0 = lds0 + A_KRING + map * 8192 + hi * 1024 + r32 * 16, vaddr0 = lds0 + A_VRING + vb;
    Q_TAKE(qn, qc);
    asm volatile("" : "+v"(qf[0]), "+v"(qf[1]), "+v"(qf[2]), "+v"(qf[3]), "+v"(qn));
    asm volatile("s_waitcnt vmcnt(0)" ::: "memory");
    asm volatile("s_barrier" ::: "memory");
    Q_PARK(qn);
    int slot = 0;
    for (int t = 0; t < NTl; ++t) {
        const int s2 = (slot >= 1) ? slot - 1 : 2;
        if (t + 2 < NTl) DIFF_DMA(t + 2, s2);
        if (64 * t <= wrow0 + 31) {
            f32x16 p0 = negm, p1 = negm;
            qk_tile2(p0, p1, kaddr0 + slot * A_SLOT, qf);
            if (64 * t + 63 > wrow0) {
                const int kb = 64 * t + 4 * hi;
#pragma unroll
                for (int r = 0; r < 16; ++r) { const int kv = kb + (r & 3) + 8 * (r >> 2); if (kv > qrow) p0[r] = -INFINITY; if (kv + 32 > qrow) p1[r] = -INFINITY; }
            }
            if (flash_update3<4>(st, p0, p1, vaddr0 + slot * A_SLOT)) {
#pragma unroll
                for (int r = 0; r < 16; ++r) negm[r] = -st.m; }
        }
        if (t + 2 < NTl) { A_WAIT_BAR(4); } else { A_WAIT_BAR(0); }
        slot = (slot == 2) ? 0 : slot + 1;
    }
#undef DIFF_DMA
    const float lt = st.l + __shfl_xor(st.l, 32), il = 1.f / lt;
    LAS float* stage = (LAS float*)lds + wl * 4096 + r32;
    if (map == 1) {
#pragma unroll
        for (int db = 0; db < 4; ++db)
#pragma unroll
            for (int r = 0; r < 16; ++r) stage[(32 * db + crow(r, hi)) * 32] = st.o[db][r] * il;
    }
    asm volatile("s_waitcnt lgkmcnt(0)\n\ts_barrier" ::: "memory");
    if (map == 0) {
        float ss = 0.f;
#pragma unroll
        for (int db = 0; db < 4; ++db)
#pragma unroll
            for (int r = 0; r < 16; ++r) { const float v = st.o[db][r] * il - lam * stage[(32 * db + crow(r, hi)) * 32]; st.o[db][r] = v; ss += v * v; }
        ss += __shfl_xor(ss, 32);
        const float rs = rsqrtf(ss * (1.f / 128.f) + EPS) * (1.f - lam_init);
        bf16* Y = (bf16*)(ws + OFF_ZC) + (size_t)(b * 4096 + qrow) * 512 + hc * 128;
        bf16* Yd = dry ? (bf16*)(ws + OFF_SELM) + (tid * 128) : Y;
#pragma unroll
        for (int db = 0; db < 4; ++db)
#pragma unroll
            for (int rq = 0; rq < 4; ++rq) { const int d = 32 * db + 8 * rq + 4 * hi; bf16* yp = Y + d; bf16* yo = Yd + d; const u32x2 z = *(const u32x2*)yp; const f32x4 g = *(const f32x4*)(subg + d);
                const float z0 = __uint_as_float(z.x << 16), z1 = __uint_as_float(z.x & 0xffff0000u), z2 = __uint_as_float(z.y << 16), z3 = __uint_as_float(z.y & 0xffff0000u);
                u32x2 o; o.x = pk2(st.o[db][4 * rq] * rs * g[0] * z0, st.o[db][4 * rq + 1] * rs * g[1] * z1); o.y = pk2(st.o[db][4 * rq + 2] * rs * g[2] * z2, st.o[db][4 * rq + 3] * rs * g[3] * z3);
                *(u32x2*)yo = o; }
    }
    asm volatile("s_waitcnt lgkmcnt(0)\n\ts_barrier" ::: "memory");
}

constexpr int N_SELM = 131072 + 256, N_UMASK = N_SELM + 512, N_SEQC = N_UMASK + 16, N_SEQD = N_SEQC + 80, N_CNT = N_SEQD + 16;
template <int MODE> __device__ __forceinline__ void nsa_ring(FlashSt<2>& st, unsigned char* lds, const char* Kg, const char* Vg, unsigned kdst, unsigned vdst, int n, int seqoff,
                                                             const bf16x8 (&qf)[4], int tb, int qloc, unsigned selLo, unsigned selHi, int r32, int hi, int vb) {
    const lds_cptr L = (lds_cptr)lds;
    const LAS unsigned char* seq = (const LAS unsigned char*)(L + seqoff);
    const unsigned lds0r = (unsigned)(uintptr_t)lds;
#define NSA_DMA(j, slot) do { glds16(Kg + (size_t)(j) * 8192, kdst + (slot) * A_SLOT); glds16(Vg + (size_t)(j) * 8192, vdst + (slot) * A_SLOT); } while (0)
    asm volatile("s_waitcnt vmcnt(0)" ::: "memory");
    { const int j0 = __builtin_amdgcn_readfirstlane((int)seq[0]); NSA_DMA(j0, 0); if (n > 1) { const int j1 = __builtin_amdgcn_readfirstlane((int)seq[1]); NSA_DMA(j1, 1); } }
    A_WAIT_BAR(0);
    int slot = 0;
    f32x16 negm;
#pragma unroll
    for (int r = 0; r < 16; ++r) negm[r] = 0.f;
    for (int i = 0; i < n; ++i) {
        const int s2 = (slot >= 1) ? slot - 1 : 2;
        if (i + 2 < n) { const int j2 = __builtin_amdgcn_readfirstlane((int)seq[i + 2]); NSA_DMA(j2, s2); }
        const int j = __builtin_amdgcn_readfirstlane((int)seq[i]);
        f32x16 p0 = negm, p1 = negm;
        qk_tile2(p0, p1, lds0r + A_KRING + hi * 1024 + r32 * 16 + slot * A_SLOT, qf);
        if (j == tb) {
#pragma unroll
            for (int r = 0; r < 16; ++r) { const int kv = 4 * hi + (r & 3) + 8 * (r >> 2); if (kv > qloc) p0[r] = -INFINITY; if (kv + 32 > qloc) p1[r] = -INFINITY; }
        } else if (MODE == 0) {
            const bool sel = (((j < 32) ? (selLo >> j) : (selHi >> (j - 32))) & 1u) != 0u;
            if (!sel) {
#pragma unroll
                for (int r = 0; r < 16; ++r) { p0[r] = -INFINITY; p1[r] = -INFINITY; } }
        } else if (j == tb - 8) {
#pragma unroll
            for (int r = 0; r < 16; ++r) { const int kv = 4 * hi + (r & 3) + 8 * (r >> 2); if (kv <= qloc) p0[r] = -INFINITY; if (kv + 32 <= qloc) p1[r] = -INFINITY; }
        }
        if (flash_update3<2>(st, p0, p1, lds0r + A_VRING + vb + slot * A_SLOT)) {
#pragma unroll
            for (int r = 0; r < 16; ++r) negm[r] = -st.m; }
        if (i + 2 < n) { A_WAIT_BAR(2); } else { A_WAIT_BAR(0); }
        slot = (slot == 2) ? 0 : slot + 1;
    }
#undef NSA_DMA
}
__device__ __forceinline__ void nsa_unit(unsigned char* lds, unsigned char* ws, int bg, int tb, unsigned* qc, bool dry = false) {
    int tid_o = threadIdx.x; asm volatile("" : "+v"(tid_o));
    const int tid = tid_o, lane = tid & 63, wid = __builtin_amdgcn_readfirstlane(tid >> 6), r32 = lane & 31, hi = lane >> 5;
    const unsigned lds0 = (unsigned)(uintptr_t)lds;
    const lds_cptr L = (lds_cptr)lds;
    const int b = bg >> 1, g = bg & 1, h = 4 * g + (wid >> 1), qloc = 32 * (wid & 1) + r32, t = 64 * tb + qloc, row = b * 4096 + t;
    const unsigned kdst = (unsigned)__builtin_amdgcn_readfirstlane(lds0 + A_KRING + wid * 1024), vdst = (unsigned)__builtin_amdgcn_readfirstlane(lds0 + A_VRING + wid * 1024);
    const int vb = lane_vbase(lane);
    LAS float* imp0 = (LAS float*)(L + 32768);
    LAS float* imp1 = (LAS float*)(L + 81920);
    LAS unsigned* selm = (LAS unsigned*)(L + N_SELM);
    LAS unsigned* umask = (LAS unsigned*)(L + N_UMASK);
    const int nvmax = 4 * tb + 3, nct = (nvmax + 63) >> 6;
    asm volatile("s_waitcnt vmcnt(0)" ::: "memory");
    { const char* Kc = (const char*)(ws + OFF_KCMP) + (size_t)bg * 32768 + wid * 1024 + lane * 16; const char* Vc = (const char*)(ws + OFF_VCMP) + (size_t)bg * 32768 + wid * 1024 + lane * 16;
      for (int ct = 0; ct < nct; ++ct) { glds16(Kc + ct * 8192, kdst + ct * 8192); glds16(Vc + ct * 8192, vdst + ct * 8192); } }
    bf16x8 qf[4];
    const bf16* Qp = (const bf16*)(ws + OFF_QB) + ((size_t)(b * 8 + h) * 4096 + t) * 64 + 8 * hi;
#pragma unroll
    for (int d0 = 0; d0 < 4; ++d0) qf[d0] = *(const bf16x8*)(Qp + 16 * d0);
    const float* gt = (const float*)(ws + OFF_GATES) + (size_t)row * 24 + (h & 7) * 3;
    float g0 = gt[0], g1 = gt[1], g2 = gt[2];
    Q_TAKE(qn, qc);
    asm volatile("" : "+v"(qf[0]), "+v"(qf[1]), "+v"(qf[2]), "+v"(qf[3]), "+v"(g0), "+v"(g1), "+v"(g2), "+v"(qn));
    A_WAIT_BAR(0);
    Q_PARK(qn);
    const int nv = (t >= 31) ? ((t - 31) >> 4) + 1 : 0;
    f32x16 y[2];
    {
        float m = -1e30f, l = 0.f;
        for (int ct = 0; ct < nct; ++ct) {
            f32x16 p0, p1;
#pragma unroll
            for (int r = 0; r < 16; ++r) { p0[r] = 0.f; p1[r] = 0.f; }
            qk_tile2(p0, p1, lds0 + A_KRING + hi * 1024 + r32 * 16 + ct * 8192, qf);
            const int cb = 64 * ct + 4 * hi;
#pragma unroll
            for (int r = 0; r < 16; ++r) { const int c = cb + (r & 3) + 8 * (r >> 2); if (c >= nv) p0[r] = -INFINITY; if (c + 32 >= nv) p1[r] = -INFINITY; }
            const float rm = rowmax32(p0, p1), mn = fmaxf(m, rm);
            float ls = 0.f;
#pragma unroll
            for (int r = 0; r < 16; ++r) ls += __builtin_amdgcn_exp2f(p0[r] - mn) + __builtin_amdgcn_exp2f(p1[r] - mn);
            l = l * __builtin_amdgcn_exp2f(m - mn) + ls; m = mn;
        }
        const float lt = l + __shfl_xor(l, 32), il = lt > 0.f ? 1.f / lt : 0.f;
        f32x16 oc[2];
#pragma unroll
        for (int r = 0; r < 16; ++r) { oc[0][r] = 0.f; oc[1][r] = 0.f; }
        float carry = 0.f;
        LAS float* ih = ((wid >> 1) == 0 ? imp0 : imp1 + ((wid >> 1) - 1) * 4096) + qloc * 64;
        const int isw = qloc ^ (hi << 5);
        for (int ct = 0; ct < nct; ++ct) {
            f32x16 p0, p1;
#pragma unroll
            for (int r = 0; r < 16; ++r) { p0[r] = 0.f; p1[r] = 0.f; }
            qk_tile2(p0, p1, lds0 + A_KRING + hi * 1024 + r32 * 16 + ct * 8192, qf);
            const int cb = 64 * ct + 4 * hi;
#pragma unroll
            for (int r = 0; r < 16; ++r) { const int c = cb + (r & 3) + 8 * (r >> 2);
                p0[r] = (c >= nv) ? 0.f : __builtin_amdgcn_exp2f(p0[r] - m) * il; p1[r] = (c + 32 >= nv) ? 0.f : __builtin_amdgcn_exp2f(p1[r] - m) * il; }
            {
                float qs[8], px[8];
#pragma unroll
                for (int k = 0; k < 4; ++k) { qs[k] = (p0[4 * k] + p0[4 * k + 1]) + (p0[4 * k + 2] + p0[4 * k + 3]); qs[4 + k] = (p1[4 * k] + p1[4 * k + 1]) + (p1[4 * k + 2] + p1[4 * k + 3]);
                    px[k] = __shfl_xor(p0[4 * k + 3], 32); px[4 + k] = __shfl_xor(p1[4 * k + 3], 32); }
#pragma unroll
                for (int k = 0; k < 8; ++k) { const float prev = k ? px[k - 1] : carry; ih[(16 * ct + 2 * k + hi) ^ isw] = qs[k] + (hi ? px[k] : prev); }
                carry = px[7];
            }
            pv_only2(oc, lds0 + A_VRING + vb + ct * 8192, p0, p1);
        }
#pragma unroll
        for (int r = 0; r < 16; ++r) { y[0][r] = g0 * oc[0][r]; y[1][r] = g0 * oc[1][r]; }
    }
    asm volatile("s_waitcnt lgkmcnt(0)\n\ts_barrier" ::: "memory");
    {
        const int q = lane, part = wid, j0 = 8 * part;
        LAS float* s0 = imp0 + q * 64;
        float sc[8];
#pragma unroll
        for (int i = 0; i < 8; ++i) { const int j = j0 + i; const bool forced = (j == 0) || (j == tb) || (j == tb - 1);
            const int c = (j ^ ((j & 1) << 5)) ^ q;
            const float sm = (s0[c] + imp1[q * 64 + c]) + (imp1[4096 + q * 64 + c] + imp1[8192 + q * 64 + c]);
            sc[i] = forced ? 1e30f : (j <= tb ? sm : -1e30f); }
#pragma unroll
        for (int i = 0; i < 8; ++i) { const int j = j0 + i; s0[(j ^ ((j & 1) << 5)) ^ q] = sc[i]; }
        asm volatile("s_waitcnt lgkmcnt(0)\n\ts_barrier" ::: "memory");
        int rank[8];
#pragma unroll
        for (int i = 0; i < 8; ++i) rank[i] = 0;
        const int kend = tb + 1, e1 = j0 < kend ? j0 : kend, e2 = j0 + 8 < kend ? j0 + 8 : kend;
#pragma unroll 4
        for (int k = 0; k < e1; ++k) { const float sk = s0[(k ^ ((k & 1) << 5)) ^ q];
#pragma unroll
            for (int i = 0; i < 8; ++i) rank[i] += (sk >= sc[i]) ? 1 : 0; }
        for (int k = e1; k < e2; ++k) { const float sk = s0[(k ^ ((k & 1) << 5)) ^ q];
#pragma unroll
            for (int i = 0; i < 8; ++i) rank[i] += (sk > sc[i] || (sk == sc[i] && k < j0 + i)) ? 1 : 0; }
#pragma unroll 4
        for (int k = e2; k < kend; ++k) { const float sk = s0[(k ^ ((k & 1) << 5)) ^ q];
#pragma unroll
            for (int i = 0; i < 8; ++i) rank[i] += (sk > sc[i]) ? 1 : 0; }
        unsigned bits = 0u, ub = 0u;
#pragma unroll
        for (int i = 0; i < 8; ++i) { const bool in = rank[i] < 16; bits |= in ? (1u << i) : 0u; ub |= (__builtin_amdgcn_ballot_w64(in) != 0ull) ? (1u << i) : 0u; }
        ((LAS unsigned char*)selm)[q * 8 + part] = (unsigned char)bits;
        if (lane == 0) ((LAS unsigned char*)umask)[part] = (unsigned char)ub;
        asm volatile("s_waitcnt lgkmcnt(0)\n\ts_barrier" ::: "memory");
        if (tid == 0) {
            LAS unsigned char* sq = (LAS unsigned char*)(L + N_SEQC); LAS unsigned char* sd = (LAS unsigned char*)(L + N_SEQD); LAS int* cnt = (LAS int*)(L + N_CNT);
            const unsigned long long um = ((unsigned long long)umask[1] << 32) | umask[0];
            int n = 0; sq[n++] = (unsigned char)tb;
            for (int j = 0; j < tb; ++j) if ((um >> j) & 1ull) sq[n++] = (unsigned char)j;
            cnt[0] = n;
            int n2 = 0; sd[n2++] = (unsigned char)tb;
            for (int j = (tb >= 8 ? tb - 8 : 0); j < tb; ++j) sd[n2++] = (unsigned char)j;
            cnt[1] = n2;
        }
        asm volatile("s_waitcnt lgkmcnt(0)\n\ts_barrier" ::: "memory");
    }
    const unsigned selLo = selm[qloc * 2], selHi = selm[qloc * 2 + 1];
    const int nC = __builtin_amdgcn_readfirstlane(((const LAS int*)(L + N_CNT))[0]), nD = __builtin_amdgcn_readfirstlane(((const LAS int*)(L + N_CNT))[1]);
    { const float* cs = (const float*)(ws + OFF_COS) + (size_t)row * 32 + 4 * hi; const float* sn = (const float*)(ws + OFF_SIN) + (size_t)row * 32 + 4 * hi;
#pragma unroll
      for (int d0 = 0; d0 < 4; ++d0) { const f32x4 c = *(const f32x4*)(cs + 8 * d0), s = *(const f32x4*)(sn + 8 * d0); u32x4 w = __builtin_bit_cast(u32x4, qf[d0]); u32x4 o;
#pragma unroll
          for (int e = 0; e < 4; ++e) { const float x1 = __uint_as_float(w[e] << 16), x2 = __uint_as_float(w[e] & 0xffff0000u); o[e] = pk2(x1 * c[e] - x2 * s[e], x2 * c[e] + x1 * s[e]); }
          qf[d0] = __builtin_bit_cast(bf16x8, o); } }
    asm volatile("" : "+v"(qf[0]), "+v"(qf[1]), "+v"(qf[2]), "+v"(qf[3]));
    {
        FlashSt<2> st; flash_init3<2>(st);
        const char* Kg = (const char*)(ws + OFF_KSEL) + (size_t)bg * 524288 + wid * 1024 + lane * 16; const char* Vg = (const char*)(ws + OFF_VSEL) + (size_t)bg * 524288 + wid * 1024 + lane * 16;
        nsa_ring<0>(st, lds, Kg, Vg, kdst, vdst, nC, N_SEQC, qf, tb, qloc, selLo, selHi, r32, hi, vb);
        const float lt = st.l + __shfl_xor(st.l, 32), sc = g1 / lt;
#pragma unroll
        for (int r = 0; r < 16; ++r) { y[0][r] += sc * st.o[0][r]; y[1][r] += sc * st.o[1][r]; }
    }
    {
        FlashSt<2> st; flash_init3<2>(st);
        const char* Kg = (const char*)(ws + OFF_KWIN) + (size_t)bg * 524288 + wid * 1024 + lane * 16; const char* Vg = (const char*)(ws + OFF_VWIN) + (size_t)bg * 524288 + wid * 1024 + lane * 16;
        nsa_ring<1>(st, lds, Kg, Vg, kdst, vdst, nD, N_SEQD, qf, tb, qloc, selLo, selHi, r32, hi, vb);
        const float lt = st.l + __shfl_xor(st.l, 32), sc = g2 / lt;
#pragma unroll
        for (int r = 0; r < 16; ++r) { y[0][r] += sc * st.o[0][r]; y[1][r] += sc * st.o[1][r]; }
    }
    bf16* Y = (bf16*)(ws + OFF_ZB) + (size_t)row * 512 + h * 64;
    bf16* Yd = dry ? (bf16*)(ws + OFF_SELM) + (tid * 64) : Y;
#pragma unroll
    for (int db = 0; db < 2; ++db)
#pragma unroll
        for (int rq = 0; rq < 4; ++rq) { bf16* yp = Y + 32 * db + 8 * rq + 4 * hi; bf16* yo = Yd + 32 * db + 8 * rq + 4 * hi; const u32x2 z = *(const u32x2*)yp;
            const float z0 = __uint_as_float(z.x << 16), z1 = __uint_as_float(z.x & 0xffff0000u), z2 = __uint_as_float(z.y << 16), z3 = __uint_as_float(z.y & 0xffff0000u);
            u32x2 o; o.x = pk2(y[db][4 * rq] * z0, y[db][4 * rq + 1] * z1); o.y = pk2(y[db][4 * rq + 2] * z2, y[db][4 * rq + 3] * z3);
            *(u32x2*)yo = o; }
}

__device__ __forceinline__ void compress_unit(unsigned char* lds, unsigned char* ws, int kv, int bg, int rc) {
    int tid_o = threadIdx.x; asm volatile("" : "+v"(tid_o));
    const int tid = tid_o, lane = tid & 63, wid = __builtin_amdgcn_readfirstlane(tid >> 6), r32 = lane & 31, hi = lane >> 5;
    const unsigned lds0 = (unsigned)(uintptr_t)lds;
    { const char* Ab = (const char*)(ws + (kv ? OFF_VCB : OFF_KCB)) + ((size_t)bg * 4096 + 512 * rc) * 128;
      asm volatile("s_waitcnt vmcnt(0)" ::: "memory");
#pragma unroll
      for (int i = 0; i < 9; ++i) { const int q = (i * 8 + wid) * 64 + lane, blk = q / 129, qq = q - blk * 129; const int sg = blk * 128 + (qq < 128 ? qq : 127);
          glds16(Ab + (size_t)sg * 16, (unsigned)__builtin_amdgcn_readfirstlane(lds0 + (i * 8 + wid) * 1024)); }
      asm volatile("s_waitcnt vmcnt(0)\n\ts_barrier" ::: "memory"); }
    const bf16* Bp = (const bf16*)(ws + OFF_CW1) + (size_t)kv * 256 * 2048 + ((size_t)wid * 128 * 64 + lane) * 8;
    const lds_cptr Al = (lds_cptr)lds + 2064 * r32 + 16 * hi;
    f32x16 acc;
#pragma unroll
    for (int r = 0; r < 16; ++r) acc[r] = 0.f;
#pragma unroll 8
    for (int l = 0; l < 32; ++l) {
        const lds_cptr ap = Al + l * 128 + (l >> 4) * 16;
#pragma unroll
        for (int q = 0; q < 4; ++q) {
            const bf16x8 a = *(const LAS bf16x8*)(ap + q * 32), w = *(const bf16x8*)(Bp + (size_t)(4 * l + q) * 512);
            acc = __builtin_amdgcn_mfma_f32_32x32x16_bf16(w, a, acc, 0, 0, 0);
        }
    }
    const float* cb = (const float*)(ws + OFF_CB1) + kv * 256 + 32 * wid + 4 * hi;
    bf16x8 hf[2];
    { float hv[16];
#pragma unroll
      for (int rq = 0; rq < 4; ++rq) { const f32x4 bb = *(const f32x4*)(cb + 8 * rq);
#pragma unroll
          for (int e = 0; e < 4; ++e) hv[4 * rq + e] = siluf_(acc[4 * rq + e] + bb[e]); }
      u32x4 w0, w1;
      w0.x = pk2(hv[0], hv[1]); w0.y = pk2(hv[2], hv[3]); w0.z = pk2(hv[4], hv[5]); w0.w = pk2(hv[6], hv[7]);
      w1.x = pk2(hv[8], hv[9]); w1.y = pk2(hv[10], hv[11]); w1.z = pk2(hv[12], hv[13]); w1.w = pk2(hv[14], hv[15]);
      hf[0] = __builtin_bit_cast(bf16x8, w0); hf[1] = __builtin_bit_cast(bf16x8, w1); }
    const bf16* W2 = (const bf16*)(ws + OFF_CW2) + (size_t)kv * 64 * 256 + 32 * wid + 4 * hi;
    f32x16 po[2];
#pragma unroll
    for (int dbk = 0; dbk < 2; ++dbk) {
#pragma unroll
        for (int r = 0; r < 16; ++r) po[dbk][r] = 0.f;
#pragma unroll
        for (int s = 0; s < 2; ++s) {
            const bf16* wr = W2 + (size_t)(32 * dbk + r32) * 256 + 16 * s;
            const u32x2 lo = *(const u32x2*)wr, hh = *(const u32x2*)(wr + 8);
            u32x4 wv; wv.x = lo.x; wv.y = lo.y; wv.z = hh.x; wv.w = hh.y;
            po[dbk] = __builtin_amdgcn_mfma_f32_32x32x16_bf16(__builtin_bit_cast(bf16x8, wv), hf[s], po[dbk], 0, 0, 0);
        }
    }
    LAS float* part = (LAS float*)lds;
    __syncthreads();
#pragma unroll
    for (int dbk = 0; dbk < 2; ++dbk)
#pragma unroll
        for (int r = 0; r < 16; ++r) part[(wid * 64 + 32 * dbk + crow(r, hi)) * 32 + r32] = po[dbk][r];
    __syncthreads();
    {
        const int row = tid & 31, d4 = tid >> 5, cc = 32 * rc + row;
        float o[4];
#pragma unroll
        for (int e = 0; e < 4; ++e) { float sum = 0.f;
#pragma unroll
            for (int w = 0; w < 8; ++w) sum += part[(w * 64 + 4 * d4 + e) * 32 + row];
            o[e] = (cc < 255) ? sum : 0.f; }
        bf16* dst = (bf16*)(ws + (kv ? OFF_VCMP : OFF_KCMP)) + (size_t)bg * 16384 + (kv ? vtile_off(cc, 4 * d4) : ktile_off(cc, 4 * d4));
        store_bf<4>(dst, o);
    }
    __syncthreads();
}
__device__ __forceinline__ void cumsum_unit(unsigned char* lds, unsigned char* ws, int bh) {
    int tid_o = threadIdx.x; asm volatile("" : "+v"(tid_o));
    const int tid = tid_o, lane = tid & 63, wid = tid >> 6, b = bh >> 3, h = bh & 7;
    const float* lf = (const float*)(ws + OFF_LOGF) + ((size_t)(b * 4096 + 8 * tid)) * 8 + h;
    float v[8]; float s = 0.f;
#pragma unroll
    for (int i = 0; i < 8; ++i) { s += lf[i * 8]; v[i] = s; }
    float incl = s;
#pragma unroll
    for (int of = 1; of < 64; of <<= 1) { const float t = __shfl_up(incl, of); if (lane >= of) incl += t; }
    LAS float* wsum = (LAS float*)lds;
    __syncthreads();
    if (lane == 63) wsum[wid] = incl;
    __syncthreads();
    float base = incl - s;
    for (int w = 0; w < wid; ++w) base += wsum[w];
    float* cf = (float*)(ws + OFF_CF) + (size_t)bh * 4096 + 8 * tid;
    f32x4 o0 = {-(base + v[0]), -(base + v[1]), -(base + v[2]), -(base + v[3])}, o1 = {-(base + v[4]), -(base + v[5]), -(base + v[6]), -(base + v[7])};
    *(f32x4*)cf = o0; *(f32x4*)(cf + 4) = o1;
    __syncthreads();
}

constexpr size_t OFF_BAR = OFF_CTL + 131072;
constexpr size_t OFF_Q = OFF_CTL + 0x28000;
constexpr int LDS_BARST = 131072 + 64;
#define XB_TMO      128
#define XB_XCNT(j)  (256  + 64 * (j))
#define XB_XSUB(j)  (1280 + 64 * (j))
#define XB_XGEN(j)  (2304 + 64 * (j))
#define XB_TOP      3328
#define XB_TOPGEN   3392
#define XCD_BAR_WORDS 3456
#define XB_SPIN_CAP (1u << 18)

__device__ __forceinline__ unsigned xb_ld(unsigned* p)              { return __hip_atomic_load(p, __ATOMIC_RELAXED, __HIP_MEMORY_SCOPE_AGENT); }
__device__ __forceinline__ unsigned xb_add(unsigned* p, unsigned v) { return __hip_atomic_fetch_add(p, v, __ATOMIC_RELAXED, __HIP_MEMORY_SCOPE_AGENT); }
__device__ __forceinline__ unsigned xb_xcc_id() { return (unsigned)__builtin_amdgcn_s_getreg((3 << 11) | 20) & 0xFu; }
#define XB_SPIN(cond, bar) do { unsigned _sp = 0; while (cond) { __builtin_amdgcn_s_sleep(1); \
    if ((++_sp & 255u) == 0u) { if (xb_ld(&(bar)[XB_TMO])) break; if (_sp > XB_SPIN_CAP) { atomicAdd(&(bar)[XB_TMO], 1u); break; } } } } while (0)

struct XcdBarrier {
    unsigned* bar; unsigned x;
    volatile LAS unsigned* st;
};

__device__ __forceinline__ XcdBarrier xcd_barrier_post(unsigned* bar, volatile LAS unsigned* st) {
    XcdBarrier b; b.bar = bar; b.x = xb_xcc_id(); b.st = st;
    if (threadIdx.x == 0) (void)xb_add(&bar[XB_XCNT(b.x)], 1u);
    return b;
}
__device__ __forceinline__ void xcd_barrier_complete(unsigned* bar, unsigned x, unsigned& nloc, unsigned& nx) {
    const unsigned G = gridDim.x * gridDim.y * gridDim.z;
    unsigned sum, cnt, mine, sp = 0u;
    for (;;) {
        sum = 0u; cnt = 0u; mine = 0u;
#pragma unroll
        for (unsigned j = 0; j < 16; ++j) { const unsigned c = xb_ld(&bar[XB_XCNT(j)]); sum += c; cnt += (c > 0u) ? 1u : 0u; mine = (j == x) ? c : mine; }
        if (sum == G) break;
        __builtin_amdgcn_s_sleep(1);
        if ((++sp & 255u) == 0u) { if (xb_ld(&bar[XB_TMO])) break; if (sp > XB_SPIN_CAP) { atomicAdd(&bar[XB_TMO], 1u); break; } }
    }
    nloc = mine > 0u ? mine : 1u; nx = cnt > 0u ? cnt : 1u;
}

__device__ __forceinline__ void xcd_barrier(const XcdBarrier& b) {
    asm volatile("s_waitcnt vmcnt(0)" ::: "memory");
    __syncthreads();
    if (threadIdx.x == 0) {
        unsigned* bar = b.bar;
        __builtin_amdgcn_s_waitcnt(0);
        unsigned nloc = b.st[0], nx = b.st[1];
        if (nloc == 0u) { xcd_barrier_complete(bar, b.x, nloc, nx); b.st[0] = nloc; b.st[1] = nx; }
        const unsigned old = xb_add(&bar[XB_XSUB(b.x)], 1u);
        const unsigned gen = old / nloc;
        if (old + 1u == (gen + 1u) * nloc) {
            __builtin_amdgcn_fence(__ATOMIC_RELEASE, "agent");
            asm volatile("s_waitcnt vmcnt(0)" ::: "memory");
            const unsigned og = xb_add(&bar[XB_TOP], 1u);
            const unsigned tg = og / nx;
            if (og + 1u == (tg + 1u) * nx) xb_add(&bar[XB_TOPGEN], 1u);
            else XB_SPIN(xb_ld(&bar[XB_TOPGEN]) == tg, bar);
            __builtin_amdgcn_fence(__ATOMIC_ACQUIRE, "agent");
            xb_add(&bar[XB_XGEN(b.x)], 1u);
            asm volatile("s_waitcnt vmcnt(0)" ::: "memory");
        } else {
            XB_SPIN(xb_ld(&bar[XB_XGEN(b.x)]) == gen, bar);
            __builtin_amdgcn_fence(__ATOMIC_ACQUIRE, "agent");
            asm volatile("s_waitcnt vmcnt(0)" ::: "memory");
        }
    }
    __syncthreads();
}

struct KArgs;
__device__ __forceinline__ void conv_tile(bool active, float (*tile)[65], int vt, const float* src, int ld, int K, bf16* dst, const float* kscale, int mode, int bx, int by) {
    const int n0 = bx * 64, k0 = by * 64, tx = vt & 63, ty = vt >> 6;
    const int n = n0 + tx;
    const int sc = (mode == 0 || mode == 3) ? n : mode == 1 ? win_srccol(n) : (n & ~63) + ((n & 1) << 5) + ((n & 63) >> 1);
    if (active) {
        float v[16];
#pragma unroll
        for (int i = 0; i < 16; ++i) v[i] = (sc >= 0) ? src[(size_t)(k0 + 4 * i + ty) * ld + sc] : 0.f;
        if (kscale) {
#pragma unroll
            for (int i = 0; i < 16; ++i) v[i] *= kscale[k0 + 4 * i + ty]; }
#pragma unroll
        for (int i = 0; i < 16; ++i) tile[tx][4 * i + ty] = v[i];
    }
    __syncthreads();
    if (active) {
#pragma unroll
        for (int p = 0; p < 2; ++p) { const int it = vt + 256 * p, r = it >> 3, c = it & 7; const float* t = &tile[r][8 * c];
            u32x4 o; o.x = pk2(t[0], t[1]); o.y = pk2(t[2], t[3]); o.z = pk2(t[4], t[5]); o.w = pk2(t[6], t[7]);
            const int nn = n0 + r, kk = k0 + 8 * c;
            if (mode == 3) *(u32x4*)(dst + ((size_t)((nn >> 5) * (K >> 4) + (kk >> 4)) * 64 + (nn & 31) + 32 * ((kk & 15) >> 3)) * 8) = o;
            else *(u32x4*)(dst + (size_t)nn * K + kk) = o; }
    }
    __syncthreads();
}
namespace cg = cooperative_groups;
constexpr int NT = 512;
constexpr int LDS_BYTES = 147456;
struct KArgs { const void* in[23]; float* out; unsigned char* ws; };

#define OPAQUE_TID() int tid = threadIdx.x; asm volatile("" : "+v"(tid))
#define VRUN(VT, NVB, CALL) do { OPAQUE_TID(); constexpr int per_ = NT / (VT); for (int vb = blockIdx.x * per_ + tid / (VT); vb < (NVB); vb += gridDim.x * per_) { const int vt = tid % (VT); CALL; } } while (0)
#define VRUN_BAR(NVB, CALL) do { OPAQUE_TID(); float (*tile)[65] = (float (*)[65])(lds + (tid >> 8) * 64 * 65 * 4); (void)tile; const int nvb_ = (NVB); for (int it_ = 0; it_ * (int)gridDim.x * 2 < nvb_; ++it_) { const int vb = (it_ * (int)gridDim.x + (int)blockIdx.x) * 2 + (tid >> 8); const int vt = tid & 255; const bool active = vb < nvb_; CALL; } } while (0)

#ifndef REP_U
#define REP_U 0
#endif
#ifndef REP_SYNC
#define REP_SYNC 0
#endif
#ifndef REP_SUMSQ
#define REP_SUMSQ 0
#endif
#ifndef REP_P0
#define REP_P0 0
#endif
#ifndef REP_PRO
#define REP_PRO 0
#endif
#ifndef REP_INPROJ
#define REP_INPROJ 0
#endif
#ifndef REP_P2
#define REP_P2 0
#endif
#ifndef REP_FOX
#define REP_FOX 0
#endif
#ifndef REP_DIFF
#define REP_DIFF 0
#endif
#ifndef REP_NSA
#define REP_NSA 0
#endif
#ifndef REP_GATEBR
#define REP_GATEBR 0
#endif
#ifndef REP_OUT
#define REP_OUT 0
#endif
#ifndef DO_ALL
#define DO_ALL 1
#endif
#ifndef DO_PRO
#define DO_PRO DO_ALL
#endif
#ifndef DO_INPROJ
#define DO_INPROJ DO_ALL
#endif
#ifndef DO_P2
#define DO_P2 DO_ALL
#endif
#ifndef DO_ATTN
#define DO_ATTN DO_ALL
#endif
#ifndef DO_GATEBR
#define DO_GATEBR DO_ALL
#endif
#ifndef DO_OUT
#define DO_OUT DO_ALL
#endif
#ifndef DO_PLE
#define DO_PLE DO_ALL
#endif
#ifndef DO_TAIL
#define DO_TAIL DO_ALL
#endif
__global__ void __launch_bounds__(NT) mega(KArgs a) {
    extern __shared__ __attribute__((aligned(16))) unsigned char lds[];
    cg::grid_group grid = cg::this_grid();
    { volatile LAS unsigned* st0 = (volatile LAS unsigned*)((LAS unsigned char*)lds + LDS_BARST); if (threadIdx.x < 2) st0[threadIdx.x] = 0u; }
    __syncthreads();
    const XcdBarrier xbar = xcd_barrier_post((unsigned*)(a.ws + OFF_BAR), (volatile LAS unsigned*)((LAS unsigned char*)lds + LDS_BARST));
#define GSYNC() xcd_barrier(xbar)
    unsigned char* ws = a.ws; float* X = a.out;
    typedef const KArgs __attribute__((address_space(4)))* kargp_t;
#define KIN(i) ([&]() { kargp_t kp_ = (kargp_t)__builtin_amdgcn_kernarg_segment_ptr(); asm volatile("" : "+s"(kp_)); return kp_->in[i]; }())
#define I_x ((const float*)KIN(0))
#define I_p ((const float*)KIN(1))
#define I_pos ((const int*)KIN(2))
#define I_norm_g ((const float*)KIN(3))
#define I_w_in ((const float*)KIN(4))
#define I_b_forget ((const float*)KIN(5))
#define I_pe_k ((const float*)KIN(6))
#define I_w1_k ((const float*)KIN(7))
#define I_b1_k ((const float*)KIN(8))
#define I_w2_k ((const float*)KIN(9))
#define I_pe_v ((const float*)KIN(10))
#define I_w1_v ((const float*)KIN(11))
#define I_b1_v ((const float*)KIN(12))
#define I_w2_v ((const float*)KIN(13))
#define I_diff_lam ((const float*)KIN(14))
#define I_subln ((const float*)KIN(15))
#define I_w_out ((const float*)KIN(19))
#define I_w_ple ((const float*)KIN(20))
#define I_w_pg ((const float*)KIN(21))
#define I_final_g ((const float*)KIN(22))
#if DO_PRO
    for (int rep0_ = 0; rep0_ <= REP_P0; ++rep0_) {
    VRUN(256, M / 4, d_xprep(vb, vt, I_x, ws));
    VRUN(256, M * 32 / 256, d_rope_table(vb, vt, I_pos, ws));
    VRUN(256, (2 * M * 256 / 4) / 256, d_pconv(vb, vt, I_p, ws));
    for (int l = 0; l < DEPTH; ++l) {
        { OPAQUE_TID(); if (blockIdx.x == 0 && tid < 64) d_lam(tid, I_diff_lam + l * 256, ws, l); }
    }
    }
#endif
    for (int l = 0; l < DEPTH; ++l) {
        const float* wl = I_w_in + (size_t)l * 1024 * NIN; const float* ng = I_norm_g + l * 1024;
#if DO_PRO
        for (int rep_ = 0; rep_ <= REP_PRO; ++rep_) {
        { OPAQUE_TID(); float (*tile)[65] = (float (*)[65])(lds + (tid >> 8) * 64 * 65 * 4);
          const int njobs = 2952 + (l == 0 ? 1152 : 0);
          for (int it_ = 0; it_ * (int)gridDim.x * 2 < njobs; ++it_) {
              int j = (it_ * (int)gridDim.x + (int)blockIdx.x) * 2 + (tid >> 8); const bool active = j < njobs;
              const float* src = wl; int ld = NIN, K = 1024, mode = 1, bx = 0, by = 0; bf16* dst = (bf16*)(ws + OFF_WIN); const float* ks = ng;
              if (j < 1536) { bx = j % 96; by = j / 96; }
              else if (j < 2304) { j -= 1536; bx = j % 48; by = j / 48; src = wl + 5920; mode = 0; dst = (bf16*)(ws + OFF_WMG); }
              else if (j < 2688) { j -= 2304; const int i = j >> 7, r = j & 127; bx = r & 15; by = r >> 4; src = (const float*)KIN(16 + i) + (size_t)l * 512 * 1024; ld = 1024; K = 512; mode = 0; dst = (bf16*)(ws + OFF_WBR) + (size_t)i * 1024 * 512; ks = nullptr; }
              else if (j < 2944) { j -= 2688; const int kv = j >> 7, r = j & 127; bx = r & 3; by = r >> 2; src = (kv ? I_w1_v : I_w1_k) + (size_t)l * 2048 * 256; ld = 256; K = 2048; mode = 3; dst = (bf16*)(ws + OFF_CW1) + (size_t)kv * 256 * 2048; ks = nullptr; }
              else if (j < 2952) { j -= 2944; const int kv = j >> 2; by = j & 3; src = (kv ? I_w2_v : I_w2_k) + (size_t)l * 256 * 64; ld = 64; K = 256; mode = kv ? 0 : 2; dst = (bf16*)(ws + OFF_CW2) + (size_t)kv * 64 * 256; ks = nullptr; }
              else { j -= 2952; const int ll = j / 576, r = j % 576; ld = 1024; mode = 0; ks = nullptr;
                  if (r < 256) { bx = r & 15; by = r >> 4; src = I_w_out + (size_t)ll * 1024 * 1024; dst = (bf16*)(ws + OFF_WOUT) + (size_t)ll * 1024 * 1024; }
                  else if (r < 512) { const int r2 = r - 256; bx = r2 & 15; by = r2 >> 4; src = I_w_pg + (size_t)ll * 1024 * 1024; dst = (bf16*)(ws + OFF_WPG) + (size_t)ll * 1024 * 1024; }
                  else { const int r2 = r - 512; bx = r2 & 15; by = r2 >> 4; src = I_w_ple + (size_t)ll * 256 * 1024; K = 256; dst = (bf16*)(ws + OFF_WPL) + (size_t)ll * 1024 * 256; } }
              conv_tile(active, tile, tid & 255, src, ld, K, dst, ks, mode, bx, by);
          } }
        { OPAQUE_TID(); if (blockIdx.x >= 64 && blockIdx.x < 96 && tid < 256) d_cb1_part(blockIdx.x - 64, tid, I_pe_k + l * 2048, I_w1_k + (size_t)l * 2048 * 256, I_pe_v + l * 2048, I_w1_v + (size_t)l * 2048 * 256, ws); }
        }
#endif
        if (l == 0) grid.sync(); else GSYNC();
        EpiCtx E{ws, I_b_forget + l * 8, l == 0 ? I_x : X, X, 0};
#if DO_INPROJ
        { OPAQUE_TID(); if (blockIdx.x == 0) d_cb1_sum(tid, I_b1_k + l * 256, I_b1_v + l * 256, ws); }
        for (int rep_ = 0; rep_ <= REP_INPROJ; ++rep_) { FAST_GEMM(EPI_INPROJ, ws + OFF_XB, ws + OFF_WIN, NP, 1024, true); }
#endif
        GSYNC();
#if DO_ATTN
        { OPAQUE_TID();
          unsigned* qc = (unsigned*)(ws + OFF_Q) + 64 * l; unsigned* p2c = (unsigned*)(ws + OFF_Q) + 64 * (2 + l);
          const float lam = ((const float*)(ws + OFF_CTL))[CTL_LAM + l], lam_init = 0.8f - 0.6f * expf(-0.3f * (float)l);
          if (tid == 0) *(volatile LAS unsigned*)((LAS unsigned char*)lds + LDS_QSLOT) = xb_add(qc, 1u);
          bool p2seen = false;
          for (;;) {
              __syncthreads();
              const int u = __builtin_amdgcn_readfirstlane((int)*(volatile LAS unsigned*)((LAS unsigned char*)lds + LDS_QSLOT));
              if (u >= 1696) break;
              if (u < 160) {
                  if (u < 128) compress_unit(lds, ws, u >> 6, (u >> 3) & 7, u & 7); else cumsum_unit(lds, ws, u - 128);
                  asm volatile("s_waitcnt vmcnt(0)" ::: "memory");
                  __syncthreads();
                  if (tid == 0) { __builtin_amdgcn_fence(__ATOMIC_RELEASE, "agent"); asm volatile("s_waitcnt vmcnt(0)" ::: "memory"); (void)xb_add(p2c, 1u);
                                  *(volatile LAS unsigned*)((LAS unsigned char*)lds + LDS_QSLOT) = xb_add(qc, 1u); }
              } else if (u < 672) { const int v = u - 160; diff_unit(lds, ws, v & 15, 31 - (v >> 4), I_subln + l * 128, lam, lam_init, qc); }
              else {
                  if (!p2seen) {
                      if (tid == 0) { XB_SPIN(xb_ld(p2c) < 160u, xbar.bar); __builtin_amdgcn_fence(__ATOMIC_ACQUIRE, "agent"); asm volatile("s_waitcnt vmcnt(0)" ::: "memory"); }
                      __syncthreads(); p2seen = true; }
                  const int w = u - 672, qb = 15 - (w >> 6), r = w & 63;
                  if (r < 32) fox_unit(lds, ws, r, qb, qc); else nsa_unit(lds, ws, (r - 32) & 7, 4 * qb + 3 - ((r - 32) >> 3), qc);
              }
          }
        }
#endif
        GSYNC();
#if DO_GATEBR
        for (int rep_ = 0; rep_ <= REP_GATEBR; ++rep_) {
        { pg8::Gemm g_{(const pg8::bf16_t*)(ws + OFF_XB), (const pg8::bf16_t*)(ws + OFF_WMG), M, 3072, 1024}; ChainOrder S_; S_.init((int)gridDim.x, (int)blockIdx.x, 0);
          EpiFast<EPI_GATE3> Ep_{E}; pg8::gemm_phase<EpiFast<EPI_GATE3>, ChainOrder, true, true>((PG8_LAS unsigned char*)lds, g_, S_, Ep_); }
        { pg8::Gemm g_{(const pg8::bf16_t*)(ws + OFF_ZA), (const pg8::bf16_t*)(ws + OFF_WBR), 3 * M, 3072, 512}; ChainOrder S_; S_.init((int)gridDim.x, (int)blockIdx.x, 1);
          EpiFast<EPI_BR3> Ep_{E}; pg8::gemm_phase<EpiFast<EPI_BR3>, ChainOrder, true, true>((PG8_LAS unsigned char*)lds, g_, S_, Ep_); }
        }
#endif
        GSYNC();
#if DO_OUT
        for (int rep_ = 0; rep_ <= (l == 0 ? REP_OUT : 0); ++rep_) FAST_GEMM(EPI_OUT, (const bf16*)(ws + OFF_MERGED), (const bf16*)(ws + OFF_WOUT) + (size_t)l * 1024 * 1024, 1024, 1024, false);
#endif
        GSYNC();
#if DO_PLE
        for (int rep_ = 0; rep_ <= REP_U; ++rep_) FAST_GEMM(EPI_U, (const bf16*)(ws + OFF_PB) + (size_t)l * M * 256, (const bf16*)(ws + OFF_WPL) + (size_t)l * 1024 * 256, 1024, 256, false);
        FAST_GEMM(EPI_PLE, (const bf16*)(ws + OFF_X1B), (const bf16*)(ws + OFF_WPG) + (size_t)l * 1024 * 1024, 1024, 1024, false);
#endif
        GSYNC();
#if DO_TAIL
        for (int rep_ = 0; rep_ < 10 * REP_SYNC; ++rep_) GSYNC();
        for (int rep_ = 0; rep_ <= REP_SUMSQ; ++rep_) { if (l + 1 < DEPTH) VRUN(256, M / 4, d_sumsq(vb, vt, X, ws)); }
#endif
    }
#if DO_TAIL
    VRUN(256, M / 4, d_final(vb, vt, X, I_final_g));
#endif
}
#undef I_x
#undef I_p
#undef I_pos
#undef I_norm_g
#undef I_w_in
#undef I_b_forget
#undef I_pe_k
#undef I_w1_k
#undef I_b1_k
#undef I_w2_k
#undef I_pe_v
#undef I_w1_v
#undef I_b1_v
#undef I_w2_v
#undef I_diff_lam
#undef I_subln
#undef I_w_out
#undef I_w_ple
#undef I_w_pg
#undef I_final_g
#undef KIN

extern "C" void kernel_launch(void* const* d_in, const int* in_sizes, int n_in, void* d_out, int out_size, void* d_ws, size_t ws_size, hipStream_t stream) {
    static int grid_blocks = 0;
    if (grid_blocks == 0) {
        if (n_in != 23 || ws_size < WS_NEED || out_size != M * DM) { fprintf(stderr, "kernel_launch: unexpected sizes (n_in %d ws %zu out %d)\n", n_in, ws_size, out_size); grid_blocks = -1; return; }
        int dev = 0, cus = 0, per_cu = 0;
        (void)hipGetDevice(&dev); (void)hipDeviceGetAttribute(&cus, hipDeviceAttributeMultiprocessorCount, dev);
        (void)hipFuncSetAttribute((const void*)mega, hipFuncAttributeMaxDynamicSharedMemorySize, LDS_BYTES);
        (void)hipOccupancyMaxActiveBlocksPerMultiprocessor(&per_cu, (const void*)mega, NT, LDS_BYTES);
        if (per_cu < 1) { fprintf(stderr, "kernel_launch: occupancy query says %d blocks per CU\n", per_cu); grid_blocks = -1; return; }
        grid_blocks = cus * 1;
        if (grid_blocks != 256) { fprintf(stderr, "kernel_launch: built for a 256-CU device (got %d)\n", cus); grid_blocks = -1; return; }
    }
    if (grid_blocks < 0) return;
    (void)hipMemsetAsync((char*)d_ws + OFF_CTL, 0, 262144, stream);
    KArgs a{};
    for (int i = 0; i < 23; ++i) a.in[i] = d_in[i];
    a.out = (float*)d_out; a.ws = (unsigned char*)d_ws;
    void* args[] = {&a};
    hipError_t e = hipLaunchCooperativeKernel((const void*)mega, dim3(grid_blocks), dim3(NT), args, LDS_BYTES, stream);
    if (e != hipSuccess) fprintf(stderr, "cooperative launch failed: %s (grid %d)\n", hipGetErrorString(e), grid_blocks);
}
```

```cpp
#include <hip/hip_runtime.h>
#include <hip/hip_cooperative_groups.h>
#include <cstdio>
#include <cstdint>

typedef unsigned short bf16;
typedef short bf16x8 __attribute__((ext_vector_type(8)));
typedef float f32x4 __attribute__((ext_vector_type(4)));
typedef float f32x16 __attribute__((ext_vector_type(16)));
typedef unsigned u32x4 __attribute__((ext_vector_type(4)));
typedef unsigned u32x2 __attribute__((ext_vector_type(2)));

constexpr int BATCH = 4, SEQ = 4096, DM = 1024, M = BATCH * SEQ, DEPTH = 2, NIN = 8992, NP = 6144;
constexpr float EPS = 1e-6f;
constexpr float LOG2E = 1.4426950408889634f;
constexpr float C2 = 0.125f * LOG2E;
constexpr size_t MiB = 1u << 20;
constexpr size_t OFF_CTL = 0;
constexpr size_t OFF_WIN = 1 * MiB, OFF_WMG = 13 * MiB, OFF_WBR = 19 * MiB, OFF_CW1 = 22 * MiB, OFF_CW2 = 24 * MiB, OFF_CB1 = 24 * MiB + 128 * 1024;
constexpr size_t OFF_WOUT = 25 * MiB, OFF_WPG = 29 * MiB, OFF_WPL = 33 * MiB;
constexpr size_t OFF_XB = 34 * MiB, OFF_ZA = 66 * MiB, OFF_ZB = 82 * MiB, OFF_ZC = 98 * MiB;
constexpr size_t OFF_COS = 114 * MiB, OFF_SIN = 116 * MiB, OFF_PB = 118 * MiB;
constexpr size_t OFF_LOGF = 134 * MiB, OFF_CF = 134 * MiB + 512 * 1024, OFF_GATES = 135 * MiB, OFF_SSP = 136 * MiB + 512 * 1024;
constexpr size_t OFF_KCMP = 136 * MiB + 768 * 1024, OFF_VCMP = 137 * MiB, OFF_SELM = 137 * MiB + 256 * 1024;
constexpr size_t OFF_QA = 139 * MiB, OFF_KA = 155 * MiB, OFF_VA = 171 * MiB, OFF_QB = 187 * MiB, OFF_QC = 203 * MiB, OFF_KC = 219 * MiB, OFF_VC = 235 * MiB;
constexpr size_t OFF_KCB = 251 * MiB, OFF_VCB = 255 * MiB, OFF_KSEL = 259 * MiB, OFF_KWIN = 263 * MiB, OFF_VSEL = 267 * MiB, OFF_VWIN = 271 * MiB;
constexpr size_t WS_NEED = 275 * MiB;
constexpr size_t OFF_G = 139 * MiB  , OFF_T = 235 * MiB  , OFF_MERGED = OFF_T, OFF_X1B = 203 * MiB, OFF_U = 139 * MiB;
constexpr int CTL_LAM = 64;

__device__ __forceinline__ bf16 f2bf(float f) { unsigned u = __float_as_uint(f); return (bf16)((u + 0x7fffu + ((u >> 16) & 1u)) >> 16); }
__device__ __forceinline__ float bf2f(bf16 h) { return __uint_as_float(((unsigned)h) << 16); }
__device__ __forceinline__ unsigned pk2(float lo, float hi) { typedef float f2_ __attribute__((ext_vector_type(2))); typedef __bf16 b2_ __attribute__((ext_vector_type(2))); f2_ v = {lo, hi}; b2_ b = __builtin_convertvector(v, b2_); return __builtin_bit_cast(unsigned, b); }
__device__ __forceinline__ float sigmoidf_(float x) { return 1.f / (1.f + __expf(-x)); }
__device__ __forceinline__ float siluf_(float x) { return x / (1.f + __expf(-x)); }
__device__ __forceinline__ float logsigmoidf_(float x) { return x >= 0.f ? -log1pf(expf(-x)) : x - log1pf(expf(x)); }

__device__ __forceinline__ int ktile_off(int s, int d) { return (s >> 6) * 4096 + (d >> 3) * 512 + (s & 63) * 8 + (d & 7); }
__device__ __forceinline__ int vtile_off(int s, int d) { return (s >> 6) * 4096 + (d >> 5) * 2048 + ((s & 63) >> 4) * 512 + (s & 15) * 32 + (d & 31); }
__device__ __forceinline__ int v128_off(int s, int d) { return (s >> 6) * 8192 + (d >> 5) * 2048 + ((s & 63) >> 4) * 512 + (s & 15) * 32 + (d & 31); }

template <int W> __device__ __forceinline__ void store_bf(bf16* dst, const float* v) {
    if constexpr (W == 4) { u32x2 o; o.x = pk2(v[0], v[1]); o.y = pk2(v[2], v[3]); *(u32x2*)dst = o; }
    else { u32x4 o; o.x = pk2(v[0], v[1]); o.y = pk2(v[2], v[3]); o.z = pk2(v[4], v[5]); o.w = pk2(v[6], v[7]); *(u32x4*)dst = o; }
}

__device__ __forceinline__ int win_srccol(int n) {
    const int seg = n >> 6, j = n & 63; const int il = ((j & 1) << 5) + (j >> 1);
    if (seg < 8) return 0 + n;
    if (seg < 16) return 512 + (n - 512);
    if (seg < 24) return 1024 + (n - 1024);
    if (seg < 32) return 1544 + (n - 1536);
    if (seg < 40) return 2056 + (seg - 32) * 64 + il;
    if (seg < 42) return 2568 + (n - 2560);
    if (seg < 44) return 2696 + (n - 2688);
    if (seg < 46) return 2824 + (seg - 44) * 64 + il;
    if (seg < 48) return 3080 + (seg - 46) * 64 + il;
    if (seg < 50) return 2952 + (n - 3072);
    if (seg < 52) return 3208 + (n - 3200);
    if (seg < 60) return 3360 + (n - 3328);
    if (seg < 68) return 3872 + (seg - 60) * 64 + il;
    if (seg < 76) return 4384 + (seg - 68) * 64 + il;
    if (seg < 84) return 4896 + (n - 4864);
    if (seg < 92) return 5408 + (n - 5376);
    if (seg == 92) { if (j < 8) return 1536 + j; if (j < 32) return 3336 + (j - 8); return -1; }
    return -1;
}

enum { EPI_INPROJ = 0, EPI_GATE = 1, EPI_BR0 = 2, EPI_BR1 = 3, EPI_BR2 = 4, EPI_OUT = 5, EPI_U = 6, EPI_PLE = 7, EPI_GATE3 = 9, EPI_BR3 = 10 };
struct EpiCtx { unsigned char* ws; const float* bfg; const float* xin; float* X; int gi; };

__device__ __forceinline__ float row_rstd(const unsigned char* ws, int row) {
    const f32x4 sp = *(const f32x4*)(ws + OFF_SSP + (size_t)row * 16);
    return rsqrtf(((sp[0] + sp[1]) + (sp[2] + sp[3])) * (1.f / 1024.f) + EPS);
}

enum { T_QA = 0, T_KA, T_VA, T_ZA, T_QB, T_CB, T_KROPE, T_VSW, T_ZB, T_QC, T_KC, T_VC, T_ZC, T_SPECIAL };
__device__ __forceinline__ int inproj_type(int t) {
    return t < 2 ? T_QA : t < 4 ? T_KA : t < 6 ? T_VA : t < 8 ? T_ZA : t < 10 ? T_QB : t == 10 ? T_CB : t == 11 ? T_KROPE : t == 12 ? T_VSW : t < 15 ? T_ZB : t < 17 ? T_QC : t < 19 ? T_KC : t < 21 ? T_VC : t < 23 ? T_ZC : T_SPECIAL;
}
struct Pre { float rs; float a[8]; float b[8]; };
template <int KIND, int T> __device__ __forceinline__ void pre_load(const EpiCtx& E, int row, int col, Pre& p) {
    unsigned char* ws = E.ws; const size_t idx = (size_t)row * 1024 + col;
    if constexpr (KIND == EPI_INPROJ) {
        if constexpr (T == T_KROPE || T == T_QC || T == T_KC) { const int d = col & 63;
            const f32x4 c = *(const f32x4*)((const float*)(ws + OFF_COS) + (size_t)row * 32 + (d >> 1)), s = *(const f32x4*)((const float*)(ws + OFF_SIN) + (size_t)row * 32 + (d >> 1));
#pragma unroll
            for (int i = 0; i < 4; ++i) { p.a[i] = c[i]; p.b[i] = s[i]; } }
    } else if constexpr (KIND == EPI_GATE || KIND == EPI_GATE3) {
    } else if constexpr (KIND == EPI_BR3) {
        const u32x4 g = *(const u32x4*)((const bf16*)(ws + OFF_G) + (size_t)E.gi * M * 1024 + idx);
#pragma unroll
        for (int i = 0; i < 4; ++i) { p.a[2 * i] = __uint_as_float(g[i] << 16); p.a[2 * i + 1] = __uint_as_float(g[i] & 0xffff0000u); }
        if (E.gi > 0) { const u32x4 t = *(const u32x4*)((const bf16*)(ws + OFF_T) + idx);
#pragma unroll
            for (int i = 0; i < 4; ++i) { p.b[2 * i] = __uint_as_float(t[i] << 16); p.b[2 * i + 1] = __uint_as_float(t[i] & 0xffff0000u); } }
        else {
#pragma unroll
            for (int i = 0; i < 8; ++i) p.b[i] = 0.f; }
    } else if constexpr (KIND == EPI_BR0 || KIND == EPI_BR1 || KIND == EPI_BR2) {
        const u32x4 g = *(const u32x4*)((const bf16*)(ws + OFF_G) + idx);
#pragma unroll
        for (int i = 0; i < 4; ++i) { p.a[2 * i] = __uint_as_float(g[i] << 16); p.a[2 * i + 1] = __uint_as_float(g[i] & 0xffff0000u); }
        if constexpr (KIND != EPI_BR0) { const u32x4 t = *(const u32x4*)((const bf16*)(ws + OFF_T) + idx);
#pragma unroll
            for (int i = 0; i < 4; ++i) { p.b[2 * i] = __uint_as_float(t[i] << 16); p.b[2 * i + 1] = __uint_as_float(t[i] & 0xffff0000u); } }
    } else if constexpr (KIND == EPI_OUT) { const f32x4 t0 = *(const f32x4*)(E.xin + idx), t1 = *(const f32x4*)(E.xin + idx + 4);
#pragma unroll
        for (int i = 0; i < 4; ++i) { p.a[i] = t0[i]; p.a[4 + i] = t1[i]; }
    } else if constexpr (KIND == EPI_PLE) { const u32x4 t = *(const u32x4*)((const bf16*)(ws + OFF_X1B) + idx); const u32x4 u = *(const u32x4*)((const bf16*)(ws + OFF_U) + idx);
#pragma unroll
        for (int i = 0; i < 4; ++i) { p.a[2 * i] = __uint_as_float(t[i] << 16); p.a[2 * i + 1] = __uint_as_float(t[i] & 0xffff0000u); p.b[2 * i] = __uint_as_float(u[i] << 16); p.b[2 * i + 1] = __uint_as_float(u[i] & 0xffff0000u); }
    }
}
__device__ __forceinline__ void st_f32x8(float* dst, const float* v) { f32x4 a = {v[0], v[1], v[2], v[3]}, b = {v[4], v[5], v[6], v[7]}; *(f32x4*)dst = a; *(f32x4*)(dst + 4) = b; }
template <int KIND, int T> __device__ __forceinline__ void emit_fin(const EpiCtx& E, int row, int col, const float* a, const Pre& p) {
    constexpr int W = 8;
    unsigned char* ws = E.ws; const size_t idx = (size_t)row * 1024 + col;
    float v[W];
    if constexpr (KIND == EPI_INPROJ) {
        const float rs = p.rs;
#pragma unroll
        for (int i = 0; i < W; ++i) v[i] = a[i] * rs;
        const int b = row >> 12, s = row & 4095;
        if constexpr (T == T_KROPE || T == T_QC || T == T_KC) {
#pragma unroll
            for (int j = 0; j < 4; ++j) { const float c = p.a[j], sn = p.b[j], x1 = v[2 * j], x2 = v[2 * j + 1]; v[2 * j] = x1 * c - x2 * sn; v[2 * j + 1] = x2 * c + x1 * sn; } }
        if constexpr (T == T_QA) { const int cc = col, h = cc >> 6, d = cc & 63;
#pragma unroll
            for (int i = 0; i < W; ++i) v[i] *= C2;
            store_bf<W>((bf16*)(ws + OFF_QA) + ((size_t)(b * 8 + h) * 4096 + s) * 64 + d, v);
        } else if constexpr (T == T_KA) { const int cc = col - 512, h = cc >> 6, d = cc & 63;
            store_bf<W>((bf16*)(ws + OFF_KA) + (size_t)(b * 8 + h) * 262144 + ktile_off(s, d), v);
        } else if constexpr (T == T_VA) { const int cc = col - 1024, h = cc >> 6, d = cc & 63;
            store_bf<W>((bf16*)(ws + OFF_VA) + (size_t)(b * 8 + h) * 262144 + vtile_off(s, d), v);
        } else if constexpr (T == T_ZA || T == T_ZB || T == T_ZC) { const int cc = col - (T == T_ZA ? 1536 : T == T_ZB ? 3328 : 5376);
#pragma unroll
            for (int i = 0; i < W; ++i) v[i] = siluf_(v[i]);
            store_bf<W>((bf16*)(ws + (T == T_ZA ? OFF_ZA : T == T_ZB ? OFF_ZB : OFF_ZC)) + (size_t)row * 512 + cc, v);
        } else if constexpr (T == T_QB) { const int cc = col - 2048, h = cc >> 6, d = cc & 63;
#pragma unroll
            for (int i = 0; i < W; ++i) v[i] *= C2;
            store_bf<W>((bf16*)(ws + OFF_QB) + ((size_t)(b * 8 + h) * 4096 + s) * 64 + d, v);
        } else if constexpr (T == T_CB) { const int cc = col - 2560, g = (cc >> 6) & 1, d = cc & 63;
            store_bf<W>((bf16*)(ws + (cc < 128 ? OFF_KCB : OFF_VCB)) + ((size_t)(b * 2 + g) * 4096 + s) * 64 + d, v);
        } else if constexpr (T == T_KROPE) { const int cc = col - 2816, g = (cc >> 6) & 1, d = cc & 63;
            store_bf<W>((bf16*)(ws + (cc < 128 ? OFF_KSEL : OFF_KWIN)) + (size_t)(b * 2 + g) * 262144 + ktile_off(s, d), v);
        } else if constexpr (T == T_VSW) { const int cc = col - 3072, g = (cc >> 6) & 1, d = cc & 63;
            store_bf<W>((bf16*)(ws + (cc < 128 ? OFF_VSEL : OFF_VWIN)) + (size_t)(b * 2 + g) * 262144 + vtile_off(s, d), v);
        } else if constexpr (T == T_QC) { const int cc = col - 3840, h = cc >> 6, d = cc & 63;
#pragma unroll
            for (int i = 0; i < W; ++i) v[i] *= C2;
            store_bf<W>((bf16*)(ws + OFF_QC) + ((size_t)(b * 8 + h) * 4096 + s) * 64 + d, v);
        } else if constexpr (T == T_KC) { const int cc = col - 4352, h = cc >> 6, d = cc & 63;
            store_bf<W>((bf16*)(ws + OFF_KC) + (size_t)(b * 8 + h) * 262144 + ktile_off(s, d), v);
        } else if constexpr (T == T_VC) { const int cc = col - 4864, hc = cc >> 7, d = cc & 127;
            store_bf<W>((bf16*)(ws + OFF_VC) + (size_t)(b * 4 + hc) * 524288 + v128_off(s, d), v);
        } else { const int cc = col - 5888;
            if (cc < 8) { float* o = (float*)(ws + OFF_LOGF) + (size_t)row * 8 + cc;
#pragma unroll
                for (int i = 0; i < W; ++i) o[i] = logsigmoidf_(v[i] + E.bfg[cc + i]) * LOG2E;
            } else if (cc < 32) { float* o = (float*)(ws + OFF_GATES) + (size_t)row * 24 + (cc - 8);
#pragma unroll
                for (int i = 0; i < W; ++i) o[i] = sigmoidf_(v[i]);
            }
        }
    } else if constexpr (KIND == EPI_GATE3) {
#pragma unroll
        for (int i = 0; i < W; ++i) v[i] = sigmoidf_(a[i] * p.rs);
        store_bf<W>((bf16*)(ws + OFF_G) + (size_t)E.gi * M * 1024 + idx, v);
    } else if constexpr (KIND == EPI_BR3) {
#pragma unroll
        for (int i = 0; i < W; ++i) v[i] = p.a[i] * a[i] + p.b[i];
        store_bf<W>((bf16*)(ws + OFF_T) + idx, v);
    } else if constexpr (KIND == EPI_GATE) {
#pragma unroll
        for (int i = 0; i < W; ++i) v[i] = sigmoidf_(a[i] * p.rs);
        store_bf<W>((bf16*)(ws + OFF_G) + idx, v);
    } else if constexpr (KIND == EPI_BR0 || KIND == EPI_BR1 || KIND == EPI_BR2) {
#pragma unroll
        for (int i = 0; i < W; ++i) { v[i] = p.a[i] * a[i]; if (KIND != EPI_BR0) v[i] += p.b[i]; }
        if constexpr (KIND == EPI_BR2) store_bf<W>((bf16*)(ws + OFF_MERGED) + idx, v);
        else store_bf<W>((bf16*)(ws + OFF_T) + idx, v);
    } else if constexpr (KIND == EPI_OUT) {
#pragma unroll
        for (int i = 0; i < W; ++i) v[i] = p.a[i] + a[i];
        store_bf<W>((bf16*)(ws + OFF_X1B) + idx, v);
    } else if constexpr (KIND == EPI_U) {
        store_bf<W>((bf16*)(ws + OFF_U) + idx, a);
    } else if constexpr (KIND == EPI_PLE) {
#pragma unroll
        for (int i = 0; i < W; ++i) v[i] = p.a[i] + sigmoidf_(a[i]) * p.b[i];
        st_f32x8(E.X + idx, v);
        store_bf<W>((bf16*)(ws + OFF_XB) + idx, v);
    }
}

__device__ __forceinline__ void d_xprep(int vb, int vt, const float* x, unsigned char* ws) {
    const int row = vb * 4 + (vt >> 6), lane = vt & 63;
    const f32x4* xr = (const f32x4*)(x + (size_t)row * 1024) + lane; float ss = 0.f;
    bf16* o = (bf16*)(ws + OFF_XB) + (size_t)row * 1024;
#pragma unroll
    for (int j = 0; j < 4; ++j) { const f32x4 v = xr[64 * j]; ss += (v[0] * v[0] + v[1] * v[1]) + (v[2] * v[2] + v[3] * v[3]); float t[4] = {v[0], v[1], v[2], v[3]}; store_bf<4>(o + 256 * j + 4 * lane, t); }
#pragma unroll
    for (int of = 1; of < 64; of <<= 1) ss += __shfl_xor(ss, of);
    if (lane == 0) { f32x4 s = {ss, 0.f, 0.f, 0.f}; *(f32x4*)(ws + OFF_SSP + (size_t)row * 16) = s; }
}
__device__ __forceinline__ void d_sumsq(int vb, int vt, const float* x, unsigned char* ws) {
    const int row = vb * 4 + (vt >> 6), lane = vt & 63;
    const f32x4* xr = (const f32x4*)(x + (size_t)row * 1024) + lane; float ss = 0.f;
#pragma unroll
    for (int j = 0; j < 4; ++j) { const f32x4 v = xr[64 * j]; ss += (v[0] * v[0] + v[1] * v[1]) + (v[2] * v[2] + v[3] * v[3]); }
#pragma unroll
    for (int of = 1; of < 64; of <<= 1) ss += __shfl_xor(ss, of);
    if (lane == 0) { f32x4 s = {ss, 0.f, 0.f, 0.f}; *(f32x4*)(ws + OFF_SSP + (size_t)row * 16) = s; }
}
__device__ __forceinline__ void d_rope_table(int vb, int vt, const int* pos, unsigned char* ws) {
    const int idx = vb * 256 + vt, row = idx >> 5, i = idx & 31;
    const float inv = exp2f(-(float)i * (13.287712379549449f / 32.f));
    const float ang = (float)pos[row] * inv;
    float s, c; sincosf(ang, &s, &c);
    ((float*)(ws + OFF_COS))[idx] = c; ((float*)(ws + OFF_SIN))[idx] = s;
}
__device__ __forceinline__ void d_pconv(int vb, int vt, const float* p, unsigned char* ws) {
    const size_t i = ((size_t)vb * 256 + vt) * 4;
    const f32x4 v = *(const f32x4*)(p + i); float t[4] = {v[0], v[1], v[2], v[3]}; store_bf<4>((bf16*)(ws + OFF_PB) + i, t);
}
constexpr size_t OFF_CBPART = OFF_CTL + 65536;
__device__ __forceinline__ void d_cb1_part(int u, int vt, const float* pe_k, const float* w1_k, const float* pe_v, const float* w1_v, unsigned char* ws) {
    const int kv = u >> 4, kc = u & 15, j = vt;
    const float* pe = (kv ? pe_v : pe_k) + 128 * kc; const float* w1 = (kv ? w1_v : w1_k) + (size_t)(128 * kc) * 256 + j;
    float acc = 0.f;
#pragma unroll 16
    for (int k = 0; k < 128; ++k) acc += pe[k] * w1[(size_t)k * 256];
    ((float*)(ws + OFF_CBPART))[(kv * 16 + kc) * 256 + j] = acc;
}
__device__ __forceinline__ void d_cb1_sum(int vt, const float* b1_k, const float* b1_v, unsigned char* ws) {
    const int kv = vt >> 8, j = vt & 255; float acc = (kv ? b1_v : b1_k)[j];
#pragma unroll
    for (int kc = 0; kc < 16; ++kc) acc += ((const float*)(ws + OFF_CBPART))[(kv * 16 + kc) * 256 + j];
    ((float*)(ws + OFF_CB1))[kv * 256 + j] = acc;
}
__device__ __forceinline__ void d_lam(int vt, const float* dl, unsigned char* ws, int l) {
    if (vt == 0) { float s1 = 0.f, s2 = 0.f; for (int i = 0; i < 64; ++i) { s1 += dl[i] * dl[64 + i]; s2 += dl[128 + i] * dl[192 + i]; }
        const float li = 0.8f - 0.6f * expf(-0.3f * (float)l); ((float*)(ws + OFF_CTL))[CTL_LAM + l] = expf(s1) - expf(s2) + li; }
}
__device__ __forceinline__ void d_final(int vb, int vt, float* X, const float* g) {
    const int row = vb * 4 + (vt >> 6), lane = vt & 63;
    f32x4* xr = (f32x4*)(X + (size_t)row * 1024) + lane; f32x4 v[4]; float ss = 0.f;
#pragma unroll
    for (int j = 0; j < 4; ++j) { v[j] = xr[64 * j]; ss += (v[j][0] * v[j][0] + v[j][1] * v[j][1]) + (v[j][2] * v[j][2] + v[j][3] * v[j][3]); }
#pragma unroll
    for (int of = 1; of < 64; of <<= 1) ss += __shfl_xor(ss, of);
    const float rs = rsqrtf(ss * (1.f / 1024.f) + EPS);
#pragma unroll
    for (int j = 0; j < 4; ++j) { const f32x4 gg = *((const f32x4*)g + 64 * j + lane); xr[64 * j] = v[j] * rs * gg; }
}


namespace pg8 {
#define PG8_LAS __attribute__((address_space(3)))
typedef unsigned short bf16_t;
typedef short bf16x8 __attribute__((ext_vector_type(8)));
typedef float f32x4 __attribute__((ext_vector_type(4)));
typedef unsigned u32x4 __attribute__((ext_vector_type(4)));
constexpr int BM = 256, BK = 64, HALF = 128, HTB = HALF * BK * 2  , STAGE_BYTES = 8 * HTB, NXCD = 8, WGM = 8;

__host__ __device__ __forceinline__ int lds_byte(int r, int c) { const int st = (r >> 4) * 2 + (c >> 5), rr = r & 15, cc = c & 31, ob = rr * 64 + cc * 2; return st * 1024 + (ob ^ (((ob >> 9) & 1) << 5)); }
__host__ __device__ __forceinline__ void stage_rc(int b, int& R, int& C) { const int st = b / 1024, sb = b % 1024, swz = sb ^ (((sb >> 9) & 1) << 5); R = (st >> 1) * 16 + swz / 64; C = (st & 1) * 32 + (swz % 64) / 2; }
__host__ __device__ __forceinline__ int perm32(int rho) { const int n = rho >> 4, i = rho & 15; return 8 * (i >> 2) + 4 * n + (i & 3); }

struct Unit { int pm, pn; };
struct Gemm { const bf16_t* A; const bf16_t* Bt; int M, N, K; };

struct StaticOrder {
    int nM, nN, nwg, G, c;
    __host__ __device__ void init(int M, int N, int G_, int c_) { nM = M / BM; nN = N / BM; nwg = nM * nN; G = G_; c = c_; }
    __host__ __device__ bool next(int i, Unit& u) const {
        const long L = (long)i * G + c; if (L >= nwg) return false;
        int wgid = (int)L; { const int q = nwg / NXCD, r = nwg % NXCD, xcd = wgid % NXCD, off = wgid / NXCD; wgid = (xcd < r ? xcd * (q + 1) : r * (q + 1) + (xcd - r) * q) + off; }
        const int nig = WGM * nN, gid = wgid / nig, fm = gid * WGM, gsz = (nM - fm) < WGM ? (nM - fm) : WGM;
        u.pm = fm + ((wgid % nig) % gsz); u.pn = (wgid % nig) / gsz; return true;
    }
    __device__ __forceinline__ void a_ready(const Unit&) const {}
    __device__ __forceinline__ void done(const Unit&) const {}
};

__device__ __forceinline__ unsigned cvt_pk_bf16(float lo, float hi) { unsigned r; asm volatile("v_cvt_pk_bf16_f32 %0, %1, %2" : "=v"(r) : "v"(lo), "v"(hi)); return r; }
typedef float f32x2 __attribute__((ext_vector_type(2)));
template <class Epi, class Sched, bool ALIGN_EPI = false, bool SP2 = false>
__device__ __forceinline__ void gemm_phase(PG8_LAS unsigned char* lds, const Gemm g, const Sched& S, const Epi& E) {
    int tid_o = threadIdx.x; asm volatile("" : "+v"(tid_o));
    const int tid = tid_o, wid = __builtin_amdgcn_readfirstlane(tid >> 6), lane = tid & 63, wr = wid >> 2, wc = wid & 3, fr = lane & 15, fq = lane >> 4;
    const int K = g.K, nt = K / BK;
    unsigned voffA[2], voffB[2];
#pragma unroll
    for (int i = 0; i < 2; ++i) { int R, C; stage_rc(tid * 16 + i * 8192, R, C); const int Rb = Epi::PERM ? ((R & ~31) + perm32(R & 31)) : R;
        voffA[i] = (unsigned)(R * K + C) * 2u; voffB[i] = (unsigned)(Rb * K + C) * 2u; }
    const size_t kstep = (size_t)(BK * 2);
    const size_t hstep = (size_t)HALF * K * 2;
    const size_t tstep = 2 * hstep;
    const unsigned ldsw = (unsigned)wid * 1024u;
    const int aoff = lds_byte(wr * 64 + fr, fq * 8), boff = lds_byte(wc * 32 + fr, fq * 8);
#define PG8_SA(b, h) (((b) * 2 + (h)) * HTB)
#define PG8_SB(b, h) ((4 + (b) * 2 + (h)) * HTB)
#define PG8_STAGE(bufoff, gbase, voff) do { _Pragma("unroll") for (int _i = 0; _i < 2; ++_i) \
        __builtin_amdgcn_global_load_lds((const unsigned*)((const char*)(gbase) + (voff)[_i]), (PG8_LAS unsigned*)(lds + (bufoff) + ldsw + _i * 8192), 16, 0, 0); } while (0)
#define PG8_LDA(dst, b, h) do { _Pragma("unroll") for (int m = 0; m < 4; ++m) _Pragma("unroll") for (int k = 0; k < 2; ++k) dst[m][k] = *(const PG8_LAS bf16x8*)(lds + PG8_SA(b, h) + aoff + m * 2048 + k * 1024); } while (0)
#define PG8_LDB(dst, b, h) do { _Pragma("unroll") for (int n = 0; n < 2; ++n) _Pragma("unroll") for (int k = 0; k < 2; ++k) dst[n][k] = *(const PG8_LAS bf16x8*)(lds + PG8_SB(b, h) + boff + n * 2048 + k * 1024); } while (0)
#define PG8_MMA(ai, bj, At, Bt) do { __builtin_amdgcn_s_setprio(1); _Pragma("unroll") for (int m = 0; m < 4; ++m) _Pragma("unroll") for (int n = 0; n < 2; ++n) _Pragma("unroll") for (int k = 0; k < 2; ++k) \
        acc[ai][bj][m][n] = __builtin_amdgcn_mfma_f32_16x16x32_bf16(Bt[n][k], At[m][k], acc[ai][bj][m][n], 0, 0, 0); __builtin_amdgcn_s_setprio(0); } while (0)
#define PG8_WAIT_V(n) asm volatile("s_waitcnt vmcnt(" #n ")" ::: "memory")
#define PG8_WAIT_L(n) asm volatile("s_waitcnt lgkmcnt(" #n ")" ::: "memory")
#define PG8_BAR __builtin_amdgcn_s_barrier()
#define PG8_SCHED __builtin_amdgcn_sched_barrier(0)
    Unit cur, nxt; int ui = 0;
    if (!S.next(0, cur)) return;
    f32x4 acc[2][2][4][2];
#pragma unroll
    for (int a = 0; a < 2; ++a)
#pragma unroll
        for (int b = 0; b < 2; ++b)
#pragma unroll
            for (int m = 0; m < 4; ++m)
#pragma unroll
                for (int n = 0; n < 2; ++n) acc[a][b][m][n] = (f32x4){0.f, 0.f, 0.f, 0.f};
    bf16x8 At[4][2], B0[2][2], B1[2][2];
    const char* cA = (const char*)g.A + (size_t)cur.pm * tstep; const char* cB = (const char*)g.Bt + (size_t)cur.pn * tstep;
    S.a_ready(cur);
    if constexpr (SP2) {
        PG8_STAGE(PG8_SB(0, 0), cB, voffB); PG8_STAGE(PG8_SB(0, 1), cB + hstep, voffB); PG8_STAGE(PG8_SA(0, 0), cA, voffA); PG8_STAGE(PG8_SA(0, 1), cA + hstep, voffA);
        if (wr == 1) PG8_BAR;
        PG8_WAIT_V(2); PG8_BAR;
        PG8_STAGE(PG8_SB(1, 0), cB + kstep, voffB); PG8_STAGE(PG8_SA(1, 0), cA + kstep, voffA); PG8_STAGE(PG8_SB(1, 1), cB + hstep + kstep, voffB);
        PG8_WAIT_V(6); PG8_BAR;
    } else {
        PG8_STAGE(PG8_SB(0, 0), cB, voffB); PG8_STAGE(PG8_SA(0, 0), cA, voffA); PG8_STAGE(PG8_SB(0, 1), cB + hstep, voffB); PG8_STAGE(PG8_SA(0, 1), cA + hstep, voffA);
        if (wr == 1) PG8_BAR;
        PG8_WAIT_V(4); PG8_BAR;
        PG8_STAGE(PG8_SB(1, 0), cB + kstep, voffB); PG8_STAGE(PG8_SA(1, 0), cA + kstep, voffA); PG8_STAGE(PG8_SB(1, 1), cB + hstep + kstep, voffB);
        PG8_WAIT_V(6); PG8_BAR;
    }
    for (;;) {
        const bool has_next = S.next(ui + 1, nxt);
        const char* nA = has_next ? (const char*)g.A + (size_t)nxt.pm * tstep : cA; const char* nB = has_next ? (const char*)g.Bt + (size_t)nxt.pn * tstep : cB;
        for (int t = 0; t < nt; t += 2) {
            const bool last = (t == nt - 2);
            const char* a1 = cA + (size_t)(t + 1) * kstep;
            const char* a2 = last ? nA : cA + (size_t)(t + 2) * kstep; const char* b2 = last ? nB : cB + (size_t)(t + 2) * kstep;
            const char* a3 = a2 + kstep; const char* b3 = b2 + kstep;
            if (last && has_next) S.a_ready(nxt);
            if constexpr (SP2) {
            PG8_LDB(B0, 0, 0); PG8_LDB(B1, 0, 1); PG8_SCHED; PG8_LDA(At, 0, 0); PG8_STAGE(PG8_SA(1, 1), a1 + hstep, voffA);
            PG8_WAIT_V(8); PG8_WAIT_L(0); PG8_BAR; PG8_MMA(0, 0, At, B0); PG8_MMA(0, 1, At, B1); PG8_BAR; PG8_SCHED;
            PG8_LDA(At, 0, 1); PG8_STAGE(PG8_SB(0, 0), b2, voffB); PG8_STAGE(PG8_SB(0, 1), b2 + hstep, voffB); PG8_STAGE(PG8_SA(0, 0), a2, voffA);
            PG8_WAIT_V(8); PG8_WAIT_L(0); PG8_BAR; PG8_MMA(1, 0, At, B0); PG8_MMA(1, 1, At, B1); PG8_BAR; PG8_SCHED;
            PG8_LDB(B0, 1, 0); PG8_LDB(B1, 1, 1); PG8_SCHED; PG8_LDA(At, 1, 0); PG8_STAGE(PG8_SA(0, 1), a2 + hstep, voffA);
            PG8_WAIT_V(8); PG8_WAIT_L(0); PG8_BAR; PG8_MMA(0, 0, At, B0); PG8_MMA(0, 1, At, B1); PG8_BAR; PG8_SCHED;
            PG8_LDA(At, 1, 1); PG8_STAGE(PG8_SB(1, 0), b3, voffB); PG8_STAGE(PG8_SB(1, 1), b3 + hstep, voffB); PG8_STAGE(PG8_SA(1, 0), a3, voffA);
            PG8_WAIT_V(8); PG8_WAIT_L(0); PG8_BAR; PG8_MMA(1, 0, At, B0); PG8_MMA(1, 1, At, B1); PG8_BAR; PG8_SCHED;
            } else {
            PG8_LDB(B0, 0, 0); PG8_SCHED; PG8_LDA(At, 0, 0); PG8_STAGE(PG8_SA(1, 1), a1 + hstep, voffA);
            PG8_WAIT_L(8); PG8_BAR; PG8_WAIT_L(0); PG8_MMA(0, 0, At, B0); PG8_BAR; PG8_SCHED;
            PG8_LDB(B1, 0, 1); PG8_STAGE(PG8_SB(0, 0), b2, voffB);
            PG8_BAR; PG8_WAIT_L(0); PG8_MMA(0, 1, At, B1); PG8_BAR;
            PG8_LDA(At, 0, 1); PG8_STAGE(PG8_SA(0, 0), a2, voffA);
            PG8_BAR; PG8_WAIT_L(0); PG8_MMA(1, 0, At, B0); PG8_BAR; PG8_SCHED;
            PG8_STAGE(PG8_SB(0, 1), b2 + hstep, voffB);
            PG8_WAIT_V(6); PG8_BAR; PG8_MMA(1, 1, At, B1); PG8_BAR;
            PG8_LDB(B0, 1, 0); PG8_SCHED; PG8_LDA(At, 1, 0); PG8_STAGE(PG8_SA(0, 1), a2 + hstep, voffA);
            PG8_WAIT_L(8); PG8_BAR; PG8_WAIT_L(0); PG8_MMA(0, 0, At, B0); PG8_BAR; PG8_SCHED;
            PG8_LDB(B1, 1, 1); PG8_STAGE(PG8_SB(1, 0), b3, voffB);
            PG8_BAR; PG8_WAIT_L(0); PG8_MMA(0, 1, At, B1); PG8_BAR;
            PG8_LDA(At, 1, 1); PG8_STAGE(PG8_SA(1, 0), a3, voffA);
            PG8_BAR; PG8_WAIT_L(0); PG8_MMA(1, 0, At, B0); PG8_BAR; PG8_SCHED;
            PG8_STAGE(PG8_SB(1, 1), b3 + hstep, voffB);
            PG8_WAIT_V(6); PG8_BAR; PG8_MMA(1, 1, At, B1); PG8_BAR;
            }
        }
        if constexpr (ALIGN_EPI) { if (wr == 0) PG8_BAR; }
        if constexpr (!Epi::AFTER_DRAIN) { E(acc, cur, wr, wc, fr, fq); S.done(cur); }
        if (!has_next) break;
#pragma unroll
        for (int a = 0; a < 2; ++a)
#pragma unroll
            for (int b = 0; b < 2; ++b)
#pragma unroll
                for (int m = 0; m < 4; ++m)
#pragma unroll
                    for (int n = 0; n < 2; ++n) acc[a][b][m][n] = (f32x4){0.f, 0.f, 0.f, 0.f};
        cur = nxt; cA = nA; cB = nB; ++ui;
        if constexpr (ALIGN_EPI) { if (wr == 1) PG8_BAR; }
    }
    PG8_WAIT_V(0);
    if constexpr (!ALIGN_EPI) { if (wr == 0) PG8_BAR; }
    PG8_BAR;
    if constexpr (Epi::AFTER_DRAIN) { E.fused(acc, cur, wr, wc, fr, fq, lds, wid, lane); S.done(cur); }
#undef PG8_SA
#undef PG8_SB
#undef PG8_STAGE
#undef PG8_LDA
#undef PG8_LDB
#undef PG8_MMA
#undef PG8_WAIT_V
#undef PG8_WAIT_L
#undef PG8_BAR
#undef PG8_SCHED
}
}

template <int KIND> struct EpiFast {
    static constexpr bool PERM = true, AFTER_DRAIN = false;
    EpiCtx E;
    template <int T, int AI, int MH> __device__ __forceinline__ void grp(const pg8::f32x4 (&acc)[2][2][4][2], int row0, int col0, const float (&rs)[2][4]) const {
        Pre p00, p01, p10, p11;
        p00.rs = p01.rs = rs[AI][2 * MH]; p10.rs = p11.rs = rs[AI][2 * MH + 1];
        const int r0 = row0 + AI * 128 + (2 * MH) * 16, r1 = r0 + 16;
        if constexpr (KIND == EPI_PLE) {
            pre_load<KIND, T>(E, r0, col0, p00); pre_load<KIND, T>(E, r0, col0 + 128, p01);
            { const pg8::f32x4 v0 = acc[AI][0][2 * MH][0], v1 = acc[AI][0][2 * MH][1]; float v[8] = {v0[0], v0[1], v0[2], v0[3], v1[0], v1[1], v1[2], v1[3]}; emit_fin<KIND, T>(E, r0, col0, v, p00); }
            { const pg8::f32x4 v0 = acc[AI][1][2 * MH][0], v1 = acc[AI][1][2 * MH][1]; float v[8] = {v0[0], v0[1], v0[2], v0[3], v1[0], v1[1], v1[2], v1[3]}; emit_fin<KIND, T>(E, r0, col0 + 128, v, p01); }
            asm volatile("" ::: "memory");
            pre_load<KIND, T>(E, r1, col0, p10); pre_load<KIND, T>(E, r1, col0 + 128, p11);
            { const pg8::f32x4 v0 = acc[AI][0][2 * MH + 1][0], v1 = acc[AI][0][2 * MH + 1][1]; float v[8] = {v0[0], v0[1], v0[2], v0[3], v1[0], v1[1], v1[2], v1[3]}; emit_fin<KIND, T>(E, r1, col0, v, p10); }
            { const pg8::f32x4 v0 = acc[AI][1][2 * MH + 1][0], v1 = acc[AI][1][2 * MH + 1][1]; float v[8] = {v0[0], v0[1], v0[2], v0[3], v1[0], v1[1], v1[2], v1[3]}; emit_fin<KIND, T>(E, r1, col0 + 128, v, p11); }
            asm volatile("" ::: "memory");
            return;
        }
        pre_load<KIND, T>(E, r0, col0, p00); pre_load<KIND, T>(E, r0, col0 + 128, p01); pre_load<KIND, T>(E, r1, col0, p10); pre_load<KIND, T>(E, r1, col0 + 128, p11);
        { const pg8::f32x4 v0 = acc[AI][0][2 * MH][0], v1 = acc[AI][0][2 * MH][1]; float v[8] = {v0[0], v0[1], v0[2], v0[3], v1[0], v1[1], v1[2], v1[3]}; emit_fin<KIND, T>(E, r0, col0, v, p00); }
        { const pg8::f32x4 v0 = acc[AI][1][2 * MH][0], v1 = acc[AI][1][2 * MH][1]; float v[8] = {v0[0], v0[1], v0[2], v0[3], v1[0], v1[1], v1[2], v1[3]}; emit_fin<KIND, T>(E, r0, col0 + 128, v, p01); }
        { const pg8::f32x4 v0 = acc[AI][0][2 * MH + 1][0], v1 = acc[AI][0][2 * MH + 1][1]; float v[8] = {v0[0], v0[1], v0[2], v0[3], v1[0], v1[1], v1[2], v1[3]}; emit_fin<KIND, T>(E, r1, col0, v, p10); }
        { const pg8::f32x4 v0 = acc[AI][1][2 * MH + 1][0], v1 = acc[AI][1][2 * MH + 1][1]; float v[8] = {v0[0], v0[1], v0[2], v0[3], v1[0], v1[1], v1[2], v1[3]}; emit_fin<KIND, T>(E, r1, col0 + 128, v, p11); }
        asm volatile("" ::: "memory");
    }
    template <int T> __device__ __forceinline__ void run(const pg8::f32x4 (&acc)[2][2][4][2], int row0, int col0) const {
        float rs[2][4];
        if constexpr (KIND == EPI_INPROJ || KIND == EPI_GATE || KIND == EPI_GATE3) {
#pragma unroll
            for (int ai = 0; ai < 2; ++ai)
#pragma unroll
                for (int m = 0; m < 4; ++m) rs[ai][m] = row_rstd(E.ws, row0 + ai * 128 + m * 16);
        } else {
#pragma unroll
            for (int ai = 0; ai < 2; ++ai)
#pragma unroll
                for (int m = 0; m < 4; ++m) rs[ai][m] = 1.f; }
        grp<T, 0, 0>(acc, row0, col0, rs); grp<T, 0, 1>(acc, row0, col0, rs); grp<T, 1, 0>(acc, row0, col0, rs); grp<T, 1, 1>(acc, row0, col0, rs);
    }
    __device__ __forceinline__ void operator()(const pg8::f32x4 (&acc)[2][2][4][2], const pg8::Unit& u, int wr, int wc, int fr, int fq) const {
        const int row0 = u.pm * 256 + wr * 64 + fr, col0 = u.pn * 256 + wc * 32 + 8 * fq;
        if constexpr (KIND == EPI_INPROJ) {
            switch (inproj_type(u.pn)) {
                case T_QA: run<T_QA>(acc, row0, col0); break;
                case T_KA: run<T_KA>(acc, row0, col0); break;
                case T_VA: run<T_VA>(acc, row0, col0); break;
                case T_ZA: run<T_ZA>(acc, row0, col0); break;
                case T_QB: run<T_QB>(acc, row0, col0); break;
                case T_CB: run<T_CB>(acc, row0, col0); break;
                case T_KROPE: run<T_KROPE>(acc, row0, col0); break;
                case T_VSW: run<T_VSW>(acc, row0, col0); break;
                case T_ZB: run<T_ZB>(acc, row0, col0); break;
                case T_QC: run<T_QC>(acc, row0, col0); break;
                case T_KC: run<T_KC>(acc, row0, col0); break;
                case T_VC: run<T_VC>(acc, row0, col0); break;
                case T_ZC: run<T_ZC>(acc, row0, col0); break;
                default: run<T_SPECIAL>(acc, row0, col0); break;
            }
        } else if constexpr (KIND == EPI_GATE3 || KIND == EPI_BR3) {
            EpiFast<KIND> t = *this; t.E.gi = u.pn >> 2;
            t.template run<0>(acc, (u.pm & 63) * 256 + wr * 64 + fr, (u.pn & 3) * 256 + wc * 32 + 8 * fq);
        } else run<0>(acc, row0, col0);
    }
};
struct ChainOrder {
    int pm, pn4, rowmul;
    __device__ __forceinline__ void init(int G, int c, int rowmul_) { pg8::StaticOrder S0; S0.init(M, 1024, G, c); pg8::Unit u0; S0.next(0, u0); pm = u0.pm; pn4 = u0.pn; rowmul = rowmul_; }
    __device__ __forceinline__ bool next(int i, pg8::Unit& u) const { if (i >= 3) return false; u.pm = pm + 64 * i * rowmul; u.pn = 4 * i + pn4; return true; }
    __device__ __forceinline__ void a_ready(const pg8::Unit&) const {}
    __device__ __forceinline__ void done(const pg8::Unit&) const {}
};
#define FAST_GEMM(KIND, Aptr, Bptr, N_, K_, ALIGN) do { pg8::Gemm g_{(const pg8::bf16_t*)(Aptr), (const pg8::bf16_t*)(Bptr), M, (N_), (K_)}; pg8::StaticOrder S_; S_.init(M, (N_), (int)gridDim.x, (int)blockIdx.x); \
        EpiFast<KIND> Ep_{E}; pg8::gemm_phase<EpiFast<KIND>, pg8::StaticOrder, ALIGN, true>((PG8_LAS unsigned char*)lds, g_, S_, Ep_); } while (0)

#define LAS __attribute__((address_space(3)))
typedef short s16x4 __attribute__((ext_vector_type(4)));
typedef short v4i16_t __attribute__((ext_vector_type(4)));
typedef LAS const char* lds_cptr;
constexpr int A_KRING = 0, A_VRING = 49152, A_CFRING = 98304, A_MISC = 104448;
constexpr int A_SLOT = 16384;
constexpr int A_IMP = A_MISC, A_SELM = A_MISC + 16384, A_UMASK = A_SELM + 512, A_SEQ = A_UMASK + 16, A_WQ = A_SEQ + 80;
__device__ __forceinline__ void glds16(const void* gsrc, unsigned lds_dst) { unsigned keep;
    asm volatile("s_mov_b32 %0, m0\n\ts_mov_b32 m0, %2\n\ts_nop 0\n\tglobal_load_lds_dwordx4 %1, off\n\ts_mov_b32 m0, %0" : "=&s"(keep) : "v"(gsrc), "s"(lds_dst) : "memory"); }
__device__ __forceinline__ void glds4(const void* gsrc, unsigned lds_dst) { unsigned keep;
    asm volatile("s_mov_b32 %0, m0\n\ts_mov_b32 m0, %2\n\ts_nop 0\n\tglobal_load_lds_dword %1, off\n\ts_mov_b32 m0, %0" : "=&s"(keep) : "v"(gsrc), "s"(lds_dst) : "memory"); }
#define A_WAIT_BAR(N) asm volatile("s_waitcnt vmcnt(" #N ") lgkmcnt(0)\n\ts_barrier" ::: "memory")
constexpr int LDS_QSLOT = 131072 + 128;
#define Q_TAKE(qn, qc) unsigned qn = 0u; if (tid == 0) qn = __hip_atomic_fetch_add((qc), 1u, __ATOMIC_RELAXED, __HIP_MEMORY_SCOPE_AGENT)
#define Q_PARK(qn) do { if (tid == 0) *(volatile LAS unsigned*)((LAS unsigned char*)lds + LDS_QSLOT) = qn; } while (0)
__device__ __forceinline__ s16x4 vtr(lds_cptr p) { return __builtin_bit_cast(s16x4, __builtin_amdgcn_ds_read_tr16_b64_v4i16((LAS v4i16_t*)p)); }
__device__ __forceinline__ unsigned cvtpk(float lo, float hi) { typedef float f2 __attribute__((ext_vector_type(2))); typedef __bf16 b2 __attribute__((ext_vector_type(2))); f2 v = {lo, hi}; b2 b = __builtin_convertvector(v, b2); return __builtin_bit_cast(unsigned, b); }
__device__ __forceinline__ int crow(int r, int hi) { return (r & 3) + 8 * (r >> 2) + 4 * hi; }

template <int NDB> struct FlashSt { f32x16 o[NDB]; float m, l; };
template <int NDB> __device__ __forceinline__ void flash_init(FlashSt<NDB>& st) {
#pragma unroll
    for (int i = 0; i < NDB; ++i)
#pragma unroll
        for (int r = 0; r < 16; ++r) st.o[i][r] = 0.f;
    st.m = -1e30f; st.l = 0.f;
}
template <int NDB> __device__ __forceinline__ void flash_init3(FlashSt<NDB>& st) { flash_init<NDB>(st); st.m = 0.f; }
__device__ __forceinline__ void qk_tile(f32x16& p0, f32x16& p1, lds_cptr kslot, const bf16x8 (&qf)[4], int r32, int hi) {
    const lds_cptr kb = kslot + hi * 1024 + r32 * 16;
    bf16x8 ka[4], kc[4];
#pragma unroll
    for (int d0 = 0; d0 < 4; ++d0) { ka[d0] = *(const LAS bf16x8*)(kb + d0 * 2048); kc[d0] = *(const LAS bf16x8*)(kb + d0 * 2048 + 512); }
#pragma unroll
    for (int d0 = 0; d0 < 4; ++d0) {
        p0 = __builtin_amdgcn_mfma_f32_32x32x16_bf16(ka[d0], qf[d0], p0, 0, 0, 0);
        p1 = __builtin_amdgcn_mfma_f32_32x32x16_bf16(kc[d0], qf[d0], p1, 0, 0, 0);
    }
}
__device__ __forceinline__ float xhalf_max(float a) {
    auto rr = __builtin_amdgcn_permlane32_swap(__float_as_uint(a), __float_as_uint(a), false, false);
    return fmaxf(__uint_as_float(rr[0]), __uint_as_float(rr[1]));
}
__device__ __forceinline__ float rowmax32(const f32x16& p0, const f32x16& p1) {
    float a = fmaxf(p0[0], p1[0]);
#pragma unroll
    for (int r = 1; r < 16; ++r) a = fmaxf(a, fmaxf(p0[r], p1[r]));
    return xhalf_max(a);
}
template <int NDB> __device__ __forceinline__ void pv_tile(f32x16 (&o)[NDB], lds_cptr vslot_l, const f32x16& p0, const f32x16& p1) {
    bf16x8 pf[4];
    { u32x4 w;
      w.x = cvtpk(p0[0], p0[1]); w.y = cvtpk(p0[2], p0[3]); w.z = cvtpk(p0[4], p0[5]); w.w = cvtpk(p0[6], p0[7]); pf[0] = __builtin_bit_cast(bf16x8, w);
      w.x = cvtpk(p0[8], p0[9]); w.y = cvtpk(p0[10], p0[11]); w.z = cvtpk(p0[12], p0[13]); w.w = cvtpk(p0[14], p0[15]); pf[1] = __builtin_bit_cast(bf16x8, w);
      w.x = cvtpk(p1[0], p1[1]); w.y = cvtpk(p1[2], p1[3]); w.z = cvtpk(p1[4], p1[5]); w.w = cvtpk(p1[6], p1[7]); pf[2] = __builtin_bit_cast(bf16x8, w);
      w.x = cvtpk(p1[8], p1[9]); w.y = cvtpk(p1[10], p1[11]); w.z = cvtpk(p1[12], p1[13]); w.w = cvtpk(p1[14], p1[15]); pf[3] = __builtin_bit_cast(bf16x8, w); }
#pragma unroll
    for (int db = 0; db < NDB; ++db) {
        bf16x8 vf[4];
#pragma unroll
        for (int ks = 0; ks < 4; ++ks) { const s16x4 lo = vtr(vslot_l + db * 4096 + ks * 1024), hh = vtr(vslot_l + db * 4096 + ks * 1024 + 512);
            vf[ks] = (bf16x8){lo[0], lo[1], lo[2], lo[3], hh[0], hh[1], hh[2], hh[3]}; }
#pragma unroll
        for (int ks = 0; ks < 4; ++ks) o[db] = __builtin_amdgcn_mfma_f32_32x32x16_bf16(vf[ks], pf[ks], o[db], 0, 0, 0);
    }
}
template <int NDB> __device__ __forceinline__ void flash_update(FlashSt<NDB>& st, f32x16& p0, f32x16& p1, lds_cptr vslot_l) {
    const float rm = rowmax32(p0, p1);
    const float mn = fmaxf(st.m, rm), alpha = __builtin_amdgcn_exp2f(st.m - mn);
    st.m = mn;
    float ls = 0.f;
#pragma unroll
    for (int r = 0; r < 16; ++r) { p0[r] = __builtin_amdgcn_exp2f(p0[r] - mn); p1[r] = __builtin_amdgcn_exp2f(p1[r] - mn); ls += p0[r] + p1[r]; }
    st.l = st.l * alpha + ls;
#pragma unroll
    for (int db = 0; db < NDB; ++db)
#pragma unroll
        for (int r = 0; r < 16; ++r) st.o[db][r] *= alpha;
    pv_tile<NDB>(st.o, vslot_l, p0, p1);
}
__device__ __forceinline__ int lane_vbase(int lane) { return ((lane >> 4) & 1) * 32 + (lane & 3) * 8 + (4 * (lane >> 5) + ((lane & 15) >> 2)) * 64; }
#define DSR128(dst, addr, off) asm volatile("ds_read_b128 %0, %1 offset:%c2" : "=v"(dst) : "v"(addr), "i"(off) : "memory")
#define DSRTR(dst, addr, off) asm volatile("ds_read_b64_tr_b16 %0, %1 offset:%c2" : "=v"(dst) : "v"(addr), "i"(off) : "memory")
#define LGKM_WAIT0() do { asm volatile("s_waitcnt lgkmcnt(0)" ::: "memory"); __builtin_amdgcn_sched_barrier(0); } while (0)
__device__ __forceinline__ void qk_tile2(f32x16& p0, f32x16& p1, unsigned kaddr, const bf16x8 (&qf)[4]) {
    bf16x8 ka0, ka1, ka2, ka3, kc0, kc1, kc2, kc3;
    DSR128(ka0, kaddr, 0); DSR128(kc0, kaddr, 512); DSR128(ka1, kaddr, 2048); DSR128(kc1, kaddr, 2560);
    DSR128(ka2, kaddr, 4096); DSR128(kc2, kaddr, 4608); DSR128(ka3, kaddr, 6144); DSR128(kc3, kaddr, 6656);
    LGKM_WAIT0();
    __builtin_amdgcn_s_setprio(1);
    p0 = __builtin_amdgcn_mfma_f32_32x32x16_bf16(ka0, qf[0], p0, 0, 0, 0); p1 = __builtin_amdgcn_mfma_f32_32x32x16_bf16(kc0, qf[0], p1, 0, 0, 0);
    p0 = __builtin_amdgcn_mfma_f32_32x32x16_bf16(ka1, qf[1], p0, 0, 0, 0); p1 = __builtin_amdgcn_mfma_f32_32x32x16_bf16(kc1, qf[1], p1, 0, 0, 0);
    p0 = __builtin_amdgcn_mfma_f32_32x32x16_bf16(ka2, qf[2], p0, 0, 0, 0); p1 = __builtin_amdgcn_mfma_f32_32x32x16_bf16(kc2, qf[2], p1, 0, 0, 0);
    p0 = __builtin_amdgcn_mfma_f32_32x32x16_bf16(ka3, qf[3], p0, 0, 0, 0); p1 = __builtin_amdgcn_mfma_f32_32x32x16_bf16(kc3, qf[3], p1, 0, 0, 0);
    __builtin_amdgcn_s_setprio(0);
}
struct VFr { s16x4 lo[8], hi[8]; };
template <int DB0> __device__ __forceinline__ void v_issue(VFr& f, unsigned vaddr) {
    DSRTR(f.lo[0], vaddr, DB0 * 4096 + 0);    DSRTR(f.hi[0], vaddr, DB0 * 4096 + 512);
    DSRTR(f.lo[1], vaddr, DB0 * 4096 + 1024); DSRTR(f.hi[1], vaddr, DB0 * 4096 + 1536);
    DSRTR(f.lo[2], vaddr, DB0 * 4096 + 2048); DSRTR(f.hi[2], vaddr, DB0 * 4096 + 2560);
    DSRTR(f.lo[3], vaddr, DB0 * 4096 + 3072); DSRTR(f.hi[3], vaddr, DB0 * 4096 + 3584);
    DSRTR(f.lo[4], vaddr, DB0 * 4096 + 4096); DSRTR(f.hi[4], vaddr, DB0 * 4096 + 4608);
    DSRTR(f.lo[5], vaddr, DB0 * 4096 + 5120); DSRTR(f.hi[5], vaddr, DB0 * 4096 + 5632);
    DSRTR(f.lo[6], vaddr, DB0 * 4096 + 6144); DSRTR(f.hi[6], vaddr, DB0 * 4096 + 6656);
    DSRTR(f.lo[7], vaddr, DB0 * 4096 + 7168); DSRTR(f.hi[7], vaddr, DB0 * 4096 + 7680);
}
#define VFRAG(f, i) ((bf16x8){(f).lo[i][0], (f).lo[i][1], (f).lo[i][2], (f).lo[i][3], (f).hi[i][0], (f).hi[i][1], (f).hi[i][2], (f).hi[i][3]})
__device__ __forceinline__ void pv2(f32x16& oa, f32x16& ob, const VFr& f, const bf16x8 (&pf)[4]) {
    __builtin_amdgcn_s_setprio(1);
    oa = __builtin_amdgcn_mfma_f32_32x32x16_bf16(VFRAG(f, 0), pf[0], oa, 0, 0, 0); ob = __builtin_amdgcn_mfma_f32_32x32x16_bf16(VFRAG(f, 4), pf[0], ob, 0, 0, 0);
    oa = __builtin_amdgcn_mfma_f32_32x32x16_bf16(VFRAG(f, 1), pf[1], oa, 0, 0, 0); ob = __builtin_amdgcn_mfma_f32_32x32x16_bf16(VFRAG(f, 5), pf[1], ob, 0, 0, 0);
    oa = __builtin_amdgcn_mfma_f32_32x32x16_bf16(VFRAG(f, 2), pf[2], oa, 0, 0, 0); ob = __builtin_amdgcn_mfma_f32_32x32x16_bf16(VFRAG(f, 6), pf[2], ob, 0, 0, 0);
    oa = __builtin_amdgcn_mfma_f32_32x32x16_bf16(VFRAG(f, 3), pf[3], oa, 0, 0, 0); ob = __builtin_amdgcn_mfma_f32_32x32x16_bf16(VFRAG(f, 7), pf[3], ob, 0, 0, 0);
    __builtin_amdgcn_s_setprio(0);
}
__device__ __forceinline__ void pack_p(bf16x8 (&pf)[4], const f32x16& p0, const f32x16& p1) {
    u32x4 w;
    w.x = cvtpk(p0[0], p0[1]); w.y = cvtpk(p0[2], p0[3]); w.z = cvtpk(p0[4], p0[5]); w.w = cvtpk(p0[6], p0[7]); pf[0] = __builtin_bit_cast(bf16x8, w);
    w.x = cvtpk(p0[8], p0[9]); w.y = cvtpk(p0[10], p0[11]); w.z = cvtpk(p0[12], p0[13]); w.w = cvtpk(p0[14], p0[15]); pf[1] = __builtin_bit_cast(bf16x8, w);
    w.x = cvtpk(p1[0], p1[1]); w.y = cvtpk(p1[2], p1[3]); w.z = cvtpk(p1[4], p1[5]); w.w = cvtpk(p1[6], p1[7]); pf[2] = __builtin_bit_cast(bf16x8, w);
    w.x = cvtpk(p1[8], p1[9]); w.y = cvtpk(p1[10], p1[11]); w.z = cvtpk(p1[12], p1[13]); w.w = cvtpk(p1[14], p1[15]); pf[3] = __builtin_bit_cast(bf16x8, w);
}
template <int NDB> __device__ __forceinline__ void flash_update2(FlashSt<NDB>& st, f32x16& p0, f32x16& p1, unsigned vaddr) {
    VFr vf; v_issue<0>(vf, vaddr);
    const float rm = rowmax32(p0, p1);
    const float mn = fmaxf(st.m, rm), alpha = __builtin_amdgcn_exp2f(st.m - mn);
    st.m = mn;
    float ls = 0.f;
#pragma unroll
    for (int r = 0; r < 16; ++r) { p0[r] = __builtin_amdgcn_exp2f(p0[r] - mn); p1[r] = __builtin_amdgcn_exp2f(p1[r] - mn); ls += p0[r] + p1[r]; }
    st.l = st.l * alpha + ls;
#pragma unroll
    for (int db = 0; db < NDB; ++db)
#pragma unroll
        for (int r = 0; r < 16; ++r) st.o[db][r] *= alpha;
    bf16x8 pf[4]; pack_p(pf, p0, p1);
    LGKM_WAIT0();
    pv2(st.o[0], st.o[1], vf, pf);
    if constexpr (NDB == 4) { v_issue<2>(vf, vaddr); LGKM_WAIT0(); pv2(st.o[2], st.o[3], vf, pf); }
}
__device__ __forceinline__ float max3_(float a, float b, float c) { float r; asm("v_max3_f32 %0, %1, %2, %3" : "=v"(r) : "v"(a), "v"(b), "v"(c)); return r; }
__device__ __forceinline__ float rowmax32_asm(const f32x16& p0, const f32x16& p1) {
    float a = max3_(p0[0], p0[1], p1[0]), b = max3_(p0[2], p0[3], p1[1]); a = max3_(a, p1[2], p1[3]);
#pragma unroll
    for (int r = 4; r < 16; r += 4) { a = max3_(a, p0[r], p0[r + 1]); b = max3_(b, p0[r + 2], p0[r + 3]); a = max3_(a, p1[r], p1[r + 1]); b = max3_(b, p1[r + 2], p1[r + 3]); }
    float m; asm("v_max_f32_e32 %0, %1, %2" : "=v"(m) : "v"(a), "v"(b));
    auto rr = __builtin_amdgcn_permlane32_swap(__float_as_uint(m), __float_as_uint(m), false, false);
    float o; asm("v_max_f32_e32 %0, %1, %2" : "=v"(o) : "v"(__uint_as_float(rr[0])), "v"(__uint_as_float(rr[1]))); return o;
}
constexpr float FA_THR = 8.f;
template <int NDB> __device__ __forceinline__ bool flash_update3(FlashSt<NDB>& st, f32x16& p0, f32x16& p1, unsigned vaddr) {
    VFr vf; v_issue<0>(vf, vaddr);
    asm volatile("s_nop 15\n\ts_nop 7" : "+v"(p0), "+v"(p1));
    const float rm = rowmax32_asm(p0, p1);
    bool moved = false;
    if (__builtin_expect(__builtin_amdgcn_ballot_w64(rm > FA_THR) != 0ull, 0)) {
        const float dl = fmaxf(rm, 0.f), f = __builtin_amdgcn_exp2f(-dl);
        st.m += dl; st.l *= f;
#pragma unroll
        for (int r = 0; r < 16; ++r) { p0[r] -= dl; p1[r] -= dl; }
#pragma unroll
        for (int db = 0; db < NDB; ++db)
#pragma unroll
            for (int r = 0; r < 16; ++r) st.o[db][r] *= f;
        moved = true;
    }
    float ls = 0.f;
#pragma unroll
    for (int r = 0; r < 16; ++r) { p0[r] = __builtin_amdgcn_exp2f(p0[r]); p1[r] = __builtin_amdgcn_exp2f(p1[r]); ls += p0[r] + p1[r]; }
    st.l += ls;
    bf16x8 pf[4]; pack_p(pf, p0, p1);
    LGKM_WAIT0();
    pv2(st.o[0], st.o[1], vf, pf);
    if constexpr (NDB == 4) { v_issue<2>(vf, vaddr); LGKM_WAIT0(); pv2(st.o[2], st.o[3], vf, pf); }
    return moved;
}
__device__ __forceinline__ void pv_only2(f32x16 (&o)[2], unsigned vaddr, const f32x16& p0, const f32x16& p1) {
    VFr vf; v_issue<0>(vf, vaddr); bf16x8 pf[4]; pack_p(pf, p0, p1); LGKM_WAIT0(); pv2(o[0], o[1], vf, pf);
}

__device__ __forceinline__ void fox_unit(unsigned char* lds, unsigned char* ws, int bh, int qb, unsigned* qc, int dry = 0) {
    int tid_o = threadIdx.x; asm volatile("" : "+v"(tid_o));
    const int tid = tid_o, lane = tid & 63, wid = __builtin_amdgcn_readfirstlane(tid >> 6), r32 = lane & 31, hi = lane >> 5;
    const unsigned lds0 = (unsigned)(uintptr_t)lds;
    const lds_cptr L = (lds_cptr)lds;
    const int qrow = 256 * qb + 32 * wid + r32, wrow0 = 256 * qb + 32 * wid;
    const int NTl = 4 * (qb + 1);
    const char* Kg = (const char*)(ws + OFF_KA) + (size_t)bh * 524288 + wid * 1024 + lane * 16;
    const char* Vg = (const char*)(ws + OFF_VA) + (size_t)bh * 524288 + wid * 1024 + lane * 16;
    const char* Cg = (const char*)(ws + OFF_CF) + (size_t)bh * 16384 + lane * 4;
    const unsigned kdst = (unsigned)__builtin_amdgcn_readfirstlane(lds0 + A_KRING + wid * 1024), vdst = (unsigned)__builtin_amdgcn_readfirstlane(lds0 + A_VRING + wid * 1024),
                   cdst = (unsigned)__builtin_amdgcn_readfirstlane(lds0 + A_CFRING + wid * 256);
#define FOX_DMA(t, slot) do { glds16(Kg + (size_t)(t) * 8192, kdst + (slot) * A_SLOT); glds16(Vg + (size_t)(t) * 8192, vdst + (slot) * A_SLOT); glds4(Cg + (size_t)(t) * 256, cdst + (slot) * 2048); } while (0)
    asm volatile("s_waitcnt vmcnt(0)" ::: "memory");
    FOX_DMA(0, 0); FOX_DMA(1, 1);
    bf16x8 qf[4];
    { const bf16* Q = (const bf16*)(ws + OFF_QA) + ((size_t)bh * 4096 + qrow) * 64 + 8 * hi;
#pragma unroll
      for (int d0 = 0; d0 < 4; ++d0) qf[d0] = *(const bf16x8*)(Q + 16 * d0); }
    FlashSt<2> st; flash_init3<2>(st);
    const int vb = lane_vbase(lane);
    const unsigned kaddr0 = lds0 + A_KRING + hi * 1024 + r32 * 16, vaddr0 = lds0 + A_VRING + vb;
    Q_TAKE(qn, qc);
    asm volatile("" : "+v"(qf[0]), "+v"(qf[1]), "+v"(qf[2]), "+v"(qf[3]), "+v"(qn));
    asm volatile("s_waitcnt vmcnt(0)" ::: "memory");
    asm volatile("s_barrier" ::: "memory");
    Q_PARK(qn);
    int slot = 0;
    for (int t = 0; t < NTl; ++t) {
        const int s2 = (slot >= 1) ? slot - 1 : 2;
        if (t + 2 < NTl) FOX_DMA(t + 2, s2);
        if (64 * t <= wrow0 + 31 && dry != 4) {
            f32x16 p0, p1;
            { const unsigned ca = lds0 + A_CFRING + slot * 2048 + wid * 256 + 16 * hi; f32x4 c0, c1, c2, c3, c4, c5, c6, c7;
              DSR128(c0, ca, 0); DSR128(c1, ca, 32); DSR128(c2, ca, 64); DSR128(c3, ca, 96); DSR128(c4, ca, 128); DSR128(c5, ca, 160); DSR128(c6, ca, 192); DSR128(c7, ca, 224);
              LGKM_WAIT0();
              p0 = __builtin_shufflevector(__builtin_shufflevector(c0, c1, 0, 1, 2, 3, 4, 5, 6, 7), __builtin_shufflevector(c2, c3, 0, 1, 2, 3, 4, 5, 6, 7), 0, 1, 2, 3, 4, 5, 6, 7, 8, 9, 10, 11, 12, 13, 14, 15);
              p1 = __builtin_shufflevector(__builtin_shufflevector(c4, c5, 0, 1, 2, 3, 4, 5, 6, 7), __builtin_shufflevector(c6, c7, 0, 1, 2, 3, 4, 5, 6, 7), 0, 1, 2, 3, 4, 5, 6, 7, 8, 9, 10, 11, 12, 13, 14, 15);
              p0 = p0 - st.m; p1 = p1 - st.m; }
            qk_tile2(p0, p1, kaddr0 + slot * A_SLOT, qf);
            if (64 * t + 63 > wrow0) {
                const int kb = 64 * t + 4 * hi;
#pragma unroll
                for (int r = 0; r < 16; ++r) { const int kv = kb + (r & 3) + 8 * (r >> 2); if (kv > qrow) p0[r] = -INFINITY; if (kv + 32 > qrow) p1[r] = -INFINITY; }
            }
            if (dry != 3) (void)flash_update3<2>(st, p0, p1, vaddr0 + slot * A_SLOT); else { st.o[0] += p0; st.o[1] += p1; }
        }
        if (dry == 2) { asm volatile("s_waitcnt lgkmcnt(0)\n\ts_barrier" ::: "memory"); } else if (t + 2 < NTl) { A_WAIT_BAR(3); } else { A_WAIT_BAR(0); }
        slot = (slot == 2) ? 0 : slot + 1;
    }
#undef FOX_DMA
    const float lt = st.l + __shfl_xor(st.l, 32), il = 1.f / lt;
    const int b = bh >> 3, h = bh & 7;
    bf16* Y = (bf16*)(ws + OFF_ZA) + (size_t)(b * 4096 + qrow) * 512 + h * 64;
    bf16* Yd = dry ? (bf16*)(ws + OFF_SELM) + (tid * 64) : Y;
#pragma unroll
    for (int db = 0; db < 2; ++db)
#pragma unroll
        for (int rq = 0; rq < 4; ++rq) { bf16* yp = Y + 32 * db + 8 * rq + 4 * hi; bf16* yo = Yd + 32 * db + 8 * rq + 4 * hi; const u32x2 z = *(const u32x2*)yp;
            const float z0 = __uint_as_float(z.x << 16), z1 = __uint_as_float(z.x & 0xffff0000u), z2 = __uint_as_float(z.y << 16), z3 = __uint_as_float(z.y & 0xffff0000u);
            u32x2 o; o.x = pk2(st.o[db][4 * rq] * il * z0, st.o[db][4 * rq + 1] * il * z1); o.y = pk2(st.o[db][4 * rq + 2] * il * z2, st.o[db][4 * rq + 3] * il * z3);
            *(u32x2*)yo = o; }
}

__device__ __forceinline__ void diff_unit(unsigned char* lds, unsigned char* ws, int bhc, int qb, const float* subg, float lam, float lam_init, unsigned* qc, bool dry = false) {
    int tid_o = threadIdx.x; asm volatile("" : "+v"(tid_o));
    const int tid = tid_o, lane = tid & 63, wid = __builtin_amdgcn_readfirstlane(tid >> 6), r32 = lane & 31, hi = lane >> 5;
    const int map = wid >> 2, wl = wid & 3;
    const unsigned lds0 = (unsigned)(uintptr_t)lds;
    const lds_cptr L = (lds_cptr)lds;
    const int b = bhc >> 2, hc = bhc & 3;
    const int qrow = 128 * qb + 32 * wl + r32, wrow0 = 128 * qb + 32 * wl;
    const int NTl = 2 * (qb + 1);
    const char* Kg = (const char*)(ws + OFF_KC) + (size_t)(b * 8 + hc * 2) * 524288 + wid * 1024 + lane * 16;
    const char* Vg = (const char*)(ws + OFF_VC) + (size_t)bhc * 1048576 + wid * 1024 + lane * 16;
    const unsigned kdst = (unsigned)__builtin_amdgcn_readfirstlane(lds0 + A_KRING + wid * 1024), vdst = (unsigned)__builtin_amdgcn_readfirstlane(lds0 + A_VRING + wid * 1024);
#define DIFF_DMA(t, slot) do { glds16(Kg + (size_t)(t) * 8192, kdst + (slot) * A_SLOT); glds16(Kg + 524288 + (size_t)(t) * 8192, kdst + (slot) * A_SLOT + 8192); \
        glds16(Vg + (size_t)(t) * 16384, vdst + (slot) * A_SLOT); glds16(Vg + (size_t)(t) * 16384 + 8192, vdst + (slot) * A_SLOT + 8192); } while (0)
    asm volatile("s_waitcnt vmcnt(0)" ::: "memory");
    DIFF_DMA(0, 0); DIFF_DMA(1, 1);
    bf16x8 qf[4];
    { const bf16* Q = (const bf16*)(ws + OFF_QC) + ((size_t)(b * 8 + hc * 2 + map) * 4096 + qrow) * 64 + 8 * hi;
#pragma unroll
      for (int d0 = 0; d0 < 4; ++d0) qf[d0] = *(const bf16x8*)(Q + 16 * d0); }
    FlashSt<4> st; flash_init3<4>(st);
    f32x16 negm;
#pragma unroll
    for (int r = 0; r < 16; ++r) negm[r] = 0.f;
    const int vb = lane_vbase(lane);
    const unsigned kaddr0 = lds0 + A_KRING + map * 8192 + hi * 1024 + r32 * 16, vaddr0 = lds0 + A_VRING + vb;
    Q_TAKE(qn, qc);
    asm volatile("" : "+v"(qf[0]), "+v"(qf[1]), "+v"(qf[2]), "+v"(qf[3]), "+v"(qn));
    asm volatile("s_waitcnt vmcnt(0)" ::: "memory");
    asm volatile("s_barrier" ::: "memory");
    Q_PARK(qn);
    int slot = 0;
    for (int t = 0; t < NTl; ++t) {
        const int s2 = (slot >= 1) ? slot - 1 : 2;
        if (t + 2 < NTl) DIFF_DMA(t + 2, s2);
        if (64 * t <= wrow0 + 31) {
            f32x16 p0 = negm, p1 = negm;
            qk_tile2(p0, p1, kaddr0 + slot * A_SLOT, qf);
            if (64 * t + 63 > wrow0) {
                const int kb = 64 * t + 4 * hi;
#pragma unroll
                for (int r = 0; r < 16; ++r) { const int kv = kb + (r & 3) + 8 * (r >> 2); if (kv > qrow) p0[r] = -INFINITY; if (kv + 32 > qrow) p1[r] = -INFINITY; }
            }
            if (flash_update3<4>(st, p0, p1, vaddr0 + slot * A_SLOT)) {
#pragma unroll
                for (int r = 0; r < 16; ++r) negm[r] = -st.m; }
        }
        if (t + 2 < NTl) { A_WAIT_BAR(4); } else { A_WAIT_BAR(0); }
        slot = (slot == 2) ? 0 : slot + 1;
    }
#undef DIFF_DMA
    const float lt = st.l + __shfl_xor(st.l, 32), il = 1.f / lt;
    LAS float* stage = (LAS float*)lds + wl * 4096 + r32;
    if (map == 1) {
#pragma unroll
        for (int db = 0; db < 4; ++db)
#pragma unroll
            for (int r = 0; r < 16; ++r) stage[(32 * db + crow(r, hi)) * 32] = st.o[db][r] * il;
    }
    asm volatile("s_waitcnt lgkmcnt(0)\n\ts_barrier" ::: "memory");
    if (map == 0) {
        float ss = 0.f;
#pragma unroll
        for (int db = 0; db < 4; ++db)
#pragma unroll
            for (int r = 0; r < 16; ++r) { const float v = st.o[db][r] * il - lam * stage[(32 * db + crow(r, hi)) * 32]; st.o[db][r] = v; ss += v * v; }
        ss += __shfl_xor(ss, 32);
        const float rs = rsqrtf(ss * (1.f / 128.f) + EPS) * (1.f - lam_init);
        bf16* Y = (bf16*)(ws + OFF_ZC) + (size_t)(b * 4096 + qrow) * 512 + hc * 128;
        bf16* Yd = dry ? (bf16*)(ws + OFF_SELM) + (tid * 128) : Y;
#pragma unroll
        for (int db = 0; db < 4; ++db)
#pragma unroll
            for (int rq = 0; rq < 4; ++rq) { const int d = 32 * db + 8 * rq + 4 * hi; bf16* yp = Y + d; bf16* yo = Yd + d; const u32x2 z = *(const u32x2*)yp; const f32x4 g = *(const f32x4*)(subg + d);
                const float z0 = __uint_as_float(z.x << 16), z1 = __uint_as_float(z.x & 0xffff0000u), z2 = __uint_as_float(z.y << 16), z3 = __uint_as_float(z.y & 0xffff0000u);
                u32x2 o; o.x = pk2(st.o[db][4 * rq] * rs * g[0] * z0, st.o[db][4 * rq + 1] * rs * g[1] * z1); o.y = pk2(st.o[db][4 * rq + 2] * rs * g[2] * z2, st.o[db][4 * rq + 3] * rs * g[3] * z3);
                *(u32x2*)yo = o; }
    }
    asm volatile("s_waitcnt lgkmcnt(0)\n\ts_barrier" ::: "memory");
}

constexpr int N_SELM = 131072 + 256, N_UMASK = N_SELM + 512, N_SEQC = N_UMASK + 16, N_SEQD = N_SEQC + 80, N_CNT = N_SEQD + 16;
template <int MODE> __device__ __forceinline__ void nsa_ring(FlashSt<2>& st, unsigned char* lds, const char* Kg, const char* Vg, unsigned kdst, unsigned vdst, int n, int seqoff,
                                                             const bf16x8 (&qf)[4], int tb, int qloc, unsigned selLo, unsigned selHi, int r32, int hi, int vb) {
    const lds_cptr L = (lds_cptr)lds;
    const LAS unsigned char* seq = (const LAS unsigned char*)(L + seqoff);
    const unsigned lds0r = (unsigned)(uintptr_t)lds;
#define NSA_DMA(j, slot) do { glds16(Kg + (size_t)(j) * 8192, kdst + (slot) * A_SLOT); glds16(Vg + (size_t)(j) * 8192, vdst + (slot) * A_SLOT); } while (0)
    asm volatile("s_waitcnt vmcnt(0)" ::: "memory");
    { const int j0 = __builtin_amdgcn_readfirstlane((int)seq[0]); NSA_DMA(j0, 0); if (n > 1) { const int j1 = __builtin_amdgcn_readfirstlane((int)seq[1]); NSA_DMA(j1, 1); } }
    A_WAIT_BAR(0);
    int slot = 0;
    f32x16 negm;
#pragma unroll
    for (int r = 0; r < 16; ++r) negm[r] = 0.f;
    for (int i = 0; i < n; ++i) {
        const int s2 = (slot >= 1) ? slot - 1 : 2;
        if (i + 2 < n) { const int j2 = __builtin_amdgcn_readfirstlane((int)seq[i + 2]); NSA_DMA(j2, s2); }
        const int j = __builtin_amdgcn_readfirstlane((int)seq[i]);
        f32x16 p0 = negm, p1 = negm;
        qk_tile2(p0, p1, lds0r + A_KRING + hi * 1024 + r32 * 16 + slot * A_SLOT, qf);
        if (j == tb) {
#pragma unroll
            for (int r = 0; r < 16; ++r) { const int kv = 4 * hi + (r & 3) + 8 * (r >> 2); if (kv > qloc) p0[r] = -INFINITY; if (kv + 32 > qloc) p1[r] = -INFINITY; }
        } else if (MODE == 0) {
            const bool sel = (((j < 32) ? (selLo >> j) : (selHi >> (j - 32))) & 1u) != 0u;
            if (!sel) {
#pragma unroll
                for (int r = 0; r < 16; ++r) { p0[r] = -INFINITY; p1[r] = -INFINITY; } }
        } else if (j == tb - 8) {
#pragma unroll
            for (int r = 0; r < 16; ++r) { const int kv = 4 * hi + (r & 3) + 8 * (r >> 2); if (kv <= qloc) p0[r] = -INFINITY; if (kv + 32 <= qloc) p1[r] = -INFINITY; }
        }
        if (flash_update3<2>(st, p0, p1, lds0r + A_VRING + vb + slot * A_SLOT)) {
#pragma unroll
            for (int r = 0; r < 16; ++r) negm[r] = -st.m; }
        if (i + 2 < n) { A_WAIT_BAR(2); } else { A_WAIT_BAR(0); }
        slot = (slot == 2) ? 0 : slot + 1;
    }
#undef NSA_DMA
}
__device__ __forceinline__ void nsa_unit(unsigned char* lds, unsigned char* ws, int bg, int tb, unsigned* qc, bool dry = false) {
    int tid_o = threadIdx.x; asm volatile("" : "+v"(tid_o));
    const int tid = tid_o, lane = tid & 63, wid = __builtin_amdgcn_readfirstlane(tid >> 6), r32 = lane & 31, hi = lane >> 5;
    const unsigned lds0 = (unsigned)(uintptr_t)lds;
    const lds_cptr L = (lds_cptr)lds;
    const int b = bg >> 1, g = bg & 1, h = 4 * g + (wid >> 1), qloc = 32 * (wid & 1) + r32, t = 64 * tb + qloc, row = b * 4096 + t;
    const unsigned kdst = (unsigned)__builtin_amdgcn_readfirstlane(lds0 + A_KRING + wid * 1024), vdst = (unsigned)__builtin_amdgcn_readfirstlane(lds0 + A_VRING + wid * 1024);
    const int vb = lane_vbase(lane);
    LAS float* imp0 = (LAS float*)(L + 32768);
    LAS float* imp1 = (LAS float*)(L + 81920);
    LAS unsigned* selm = (LAS unsigned*)(L + N_SELM);
    LAS unsigned* umask = (LAS unsigned*)(L + N_UMASK);
    const int nvmax = 4 * tb + 3, nct = (nvmax + 63) >> 6;
    asm volatile("s_waitcnt vmcnt(0)" ::: "memory");
    { const char* Kc = (const char*)(ws + OFF_KCMP) + (size_t)bg * 32768 + wid * 1024 + lane * 16; const char* Vc = (const char*)(ws + OFF_VCMP) + (size_t)bg * 32768 + wid * 1024 + lane * 16;
      for (int ct = 0; ct < nct; ++ct) { glds16(Kc + ct * 8192, kdst + ct * 8192); glds16(Vc + ct * 8192, vdst + ct * 8192); } }
    bf16x8 qf[4];
    const bf16* Qp = (const bf16*)(ws + OFF_QB) + ((size_t)(b * 8 + h) * 4096 + t) * 64 + 8 * hi;
#pragma unroll
    for (int d0 = 0; d0 < 4; ++d0) qf[d0] = *(const bf16x8*)(Qp + 16 * d0);
    const float* gt = (const float*)(ws + OFF_GATES) + (size_t)row * 24 + (h & 7) * 3;
    float g0 = gt[0], g1 = gt[1], g2 = gt[2];
    Q_TAKE(qn, qc);
    asm volatile("" : "+v"(qf[0]), "+v"(qf[1]), "+v"(qf[2]), "+v"(qf[3]), "+v"(g0), "+v"(g1), "+v"(g2), "+v"(qn));
    A_WAIT_BAR(0);
    Q_PARK(qn);
    const int nv = (t >= 31) ? ((t - 31) >> 4) + 1 : 0;
    f32x16 y[2];
    {
        float m = -1e30f, l = 0.f;
        for (int ct = 0; ct < nct; ++ct) {
            f32x16 p0, p1;
#pragma unroll
            for (int r = 0; r < 16; ++r) { p0[r] = 0.f; p1[r] = 0.f; }
            qk_tile2(p0, p1, lds0 + A_KRING + hi * 1024 + r32 * 16 + ct * 8192, qf);
            const int cb = 64 * ct + 4 * hi;
#pragma unroll
            for (int r = 0; r < 16; ++r) { const int c = cb + (r & 3) + 8 * (r >> 2); if (c >= nv) p0[r] = -INFINITY; if (c + 32 >= nv) p1[r] = -INFINITY; }
            const float rm = rowmax32(p0, p1), mn = fmaxf(m, rm);
            float ls = 0.f;
#pragma unroll
            for (int r = 0; r < 16; ++r) ls += __builtin_amdgcn_exp2f(p0[r] - mn) + __builtin_amdgcn_exp2f(p1[r] - mn);
            l = l * __builtin_amdgcn_exp2f(m - mn) + ls; m = mn;
        }
        const float lt = l + __shfl_xor(l, 32), il = lt > 0.f ? 1.f / lt : 0.f;
        f32x16 oc[2];
#pragma unroll
        for (int r = 0; r < 16; ++r) { oc[0][r] = 0.f; oc[1][r] = 0.f; }
        float carry = 0.f;
        LAS float* ih = ((wid >> 1) == 0 ? imp0 : imp1 + ((wid >> 1) - 1) * 4096) + qloc * 64;
        const int isw = qloc ^ (hi << 5);
        for (int ct = 0; ct < nct; ++ct) {
            f32x16 p0, p1;
#pragma unroll
            for (int r = 0; r < 16; ++r) { p0[r] = 0.f; p1[r] = 0.f; }
            qk_tile2(p0, p1, lds0 + A_KRING + hi * 1024 + r32 * 16 + ct * 8192, qf);
            const int cb = 64 * ct + 4 * hi;
#pragma unroll
            for (int r = 0; r < 16; ++r) { const int c = cb + (r & 3) + 8 * (r >> 2);
                p0[r] = (c >= nv) ? 0.f : __builtin_amdgcn_exp2f(p0[r] - m) * il; p1[r] = (c + 32 >= nv) ? 0.f : __builtin_amdgcn_exp2f(p1[r] - m) * il; }
            {
                float qs[8], px[8];
#pragma unroll
                for (int k = 0; k < 4; ++k) { qs[k] = (p0[4 * k] + p0[4 * k + 1]) + (p0[4 * k + 2] + p0[4 * k + 3]); qs[4 + k] = (p1[4 * k] + p1[4 * k + 1]) + (p1[4 * k + 2] + p1[4 * k + 3]);
                    px[k] = __shfl_xor(p0[4 * k + 3], 32); px[4 + k] = __shfl_xor(p1[4 * k + 3], 32); }
#pragma unroll
                for (int k = 0; k < 8; ++k) { const float prev = k ? px[k - 1] : carry; ih[(16 * ct + 2 * k + hi) ^ isw] = qs[k] + (hi ? px[k] : prev); }
                carry = px[7];
            }
            pv_only2(oc, lds0 + A_VRING + vb + ct * 8192, p0, p1);
        }
#pragma unroll
        for (int r = 0; r < 16; ++r) { y[0][r] = g0 * oc[0][r]; y[1][r] = g0 * oc[1][r]; }
    }
    asm volatile("s_waitcnt lgkmcnt(0)\n\ts_barrier" ::: "memory");
    {
        const int q = lane, part = wid, j0 = 8 * part;
        LAS float* s0 = imp0 + q * 64;
        float sc[8];
#pragma unroll
        for (int i = 0; i < 8; ++i) { const int j = j0 + i; const bool forced = (j == 0) || (j == tb) || (j == tb - 1);
            const int c = (j ^ ((j & 1) << 5)) ^ q;
            const float sm = (s0[c] + imp1[q * 64 + c]) + (imp1[4096 + q * 64 + c] + imp1[8192 + q * 64 + c]);
            sc[i] = forced ? 1e30f : (j <= tb ? sm : -1e30f); }
#pragma unroll
        for (int i = 0; i < 8; ++i) { const int j = j0 + i; s0[(j ^ ((j & 1) << 5)) ^ q] = sc[i]; }
        asm volatile("s_waitcnt lgkmcnt(0)\n\ts_barrier" ::: "memory");
        int rank[8];
#pragma unroll
        for (int i = 0; i < 8; ++i) rank[i] = 0;
        const int kend = tb + 1, e1 = j0 < kend ? j0 : kend, e2 = j0 + 8 < kend ? j0 + 8 : kend;
#pragma unroll 4
        for (int k = 0; k < e1; ++k) { const float sk = s0[(k ^ ((k & 1) << 5)) ^ q];
#pragma unroll
            for (int i = 0; i < 8; ++i) rank[i] += (sk >= sc[i]) ? 1 : 0; }
        for (int k = e1; k < e2; ++k) { const float sk = s0[(k ^ ((k & 1) << 5)) ^ q];
#pragma unroll
            for (int i = 0; i < 8; ++i) rank[i] += (sk > sc[i] || (sk == sc[i] && k < j0 + i)) ? 1 : 0; }
#pragma unroll 4
        for (int k = e2; k < kend; ++k) { const float sk = s0[(k ^ ((k & 1) << 5)) ^ q];
#pragma unroll
            for (int i = 0; i < 8; ++i) rank[i] += (sk > sc[i]) ? 1 : 0; }
        unsigned bits = 0u, ub = 0u;
#pragma unroll
        for (int i = 0; i < 8; ++i) { const bool in = rank[i] < 16; bits |= in ? (1u << i) : 0u; ub |= (__builtin_amdgcn_ballot_w64(in) != 0ull) ? (1u << i) : 0u; }
        ((LAS unsigned char*)selm)[q * 8 + part] = (unsigned char)bits;
        if (lane == 0) ((LAS unsigned char*)umask)[part] = (unsigned char)ub;
        asm volatile("s_waitcnt lgkmcnt(0)\n\ts_barrier" ::: "memory");
        if (tid == 0) {
            LAS unsigned char* sq = (LAS unsigned char*)(L + N_SEQC); LAS unsigned char* sd = (LAS unsigned char*)(L + N_SEQD); LAS int* cnt = (LAS int*)(L + N_CNT);
            const unsigned long long um = ((unsigned long long)umask[1] << 32) | umask[0];
            int n = 0; sq[n++] = (unsigned char)tb;
            for (int j = 0; j < tb; ++j) if ((um >> j) & 1ull) sq[n++] = (unsigned char)j;
            cnt[0] = n;
            int n2 = 0; sd[n2++] = (unsigned char)tb;
            for (int j = (tb >= 8 ? tb - 8 : 0); j < tb; ++j) sd[n2++] = (unsigned char)j;
            cnt[1] = n2;
        }
        asm volatile("s_waitcnt lgkmcnt(0)\n\ts_barrier" ::: "memory");
    }
    const unsigned selLo = selm[qloc * 2], selHi = selm[qloc * 2 + 1];
    const int nC = __builtin_amdgcn_readfirstlane(((const LAS int*)(L + N_CNT))[0]), nD = __builtin_amdgcn_readfirstlane(((const LAS int*)(L + N_CNT))[1]);
    { const float* cs = (const float*)(ws + OFF_COS) + (size_t)row * 32 + 4 * hi; const float* sn = (const float*)(ws + OFF_SIN) + (size_t)row * 32 + 4 * hi;
#pragma unroll
      for (int d0 = 0; d0 < 4; ++d0) { const f32x4 c = *(const f32x4*)(cs + 8 * d0), s = *(const f32x4*)(sn + 8 * d0); u32x4 w = __builtin_bit_cast(u32x4, qf[d0]); u32x4 o;
#pragma unroll
          for (int e = 0; e < 4; ++e) { const float x1 = __uint_as_float(w[e] << 16), x2 = __uint_as_float(w[e] & 0xffff0000u); o[e] = pk2(x1 * c[e] - x2 * s[e], x2 * c[e] + x1 * s[e]); }
          qf[d0] = __builtin_bit_cast(bf16x8, o); } }
    asm volatile("" : "+v"(qf[0]), "+v"(qf[1]), "+v"(qf[2]), "+v"(qf[3]));
    {
        FlashSt<2> st; flash_init3<2>(st);
        const char* Kg = (const char*)(ws + OFF_KSEL) + (size_t)bg * 524288 + wid * 1024 + lane * 16; const char* Vg = (const char*)(ws + OFF_VSEL) + (size_t)bg * 524288 + wid * 1024 + lane * 16;
        nsa_ring<0>(st, lds, Kg, Vg, kdst, vdst, nC, N_SEQC, qf, tb, qloc, selLo, selHi, r32, hi, vb);
        const float lt = st.l + __shfl_xor(st.l, 32), sc = g1 / lt;
#pragma unroll
        for (int r = 0; r < 16; ++r) { y[0][r] += sc * st.o[0][r]; y[1][r] += sc * st.o[1][r]; }
    }
    {
        FlashSt<2> st; flash_init3<2>(st);
        const char* Kg = (const char*)(ws + OFF_KWIN) + (size_t)bg * 524288 + wid * 1024 + lane * 16; const char* Vg = (const char*)(ws + OFF_VWIN) + (size_t)bg * 524288 + wid * 1024 + lane * 16;
        nsa_ring<1>(st, lds, Kg, Vg, kdst, vdst, nD, N_SEQD, qf, tb, qloc, selLo, selHi, r32, hi, vb);
        const float lt = st.l + __shfl_xor(st.l, 32), sc = g2 / lt;
#pragma unroll
        for (int r = 0; r < 16; ++r) { y[0][r] += sc * st.o[0][r]; y[1][r] += sc * st.o[1][r]; }
    }
    bf16* Y = (bf16*)(ws + OFF_ZB) + (size_t)row * 512 + h * 64;
    bf16* Yd = dry ? (bf16*)(ws + OFF_SELM) + (tid * 64) : Y;
#pragma unroll
    for (int db = 0; db < 2; ++db)
#pragma unroll
        for (int rq = 0; rq < 4; ++rq) { bf16* yp = Y + 32 * db + 8 * rq + 4 * hi; bf16* yo = Yd + 32 * db + 8 * rq + 4 * hi; const u32x2 z = *(const u32x2*)yp;
            const float z0 = __uint_as_float(z.x << 16), z1 = __uint_as_float(z.x & 0xffff0000u), z2 = __uint_as_float(z.y << 16), z3 = __uint_as_float(z.y & 0xffff0000u);
            u32x2 o; o.x = pk2(y[db][4 * rq] * z0, y[db][4 * rq + 1] * z1); o.y = pk2(y[db][4 * rq + 2] * z2, y[db][4 * rq + 3] * z3);
            *(u32x2*)yo = o; }
}

__device__ __forceinline__ void compress_unit(unsigned char* lds, unsigned char* ws, int kv, int bg, int rc) {
    int tid_o = threadIdx.x; asm volatile("" : "+v"(tid_o));
    const int tid = tid_o, lane = tid & 63, wid = __builtin_amdgcn_readfirstlane(tid >> 6), r32 = lane & 31, hi = lane >> 5;
    const unsigned lds0 = (unsigned)(uintptr_t)lds;
    { const char* Ab = (const char*)(ws + (kv ? OFF_VCB : OFF_KCB)) + ((size_t)bg * 4096 + 512 * rc) * 128;
      asm volatile("s_waitcnt vmcnt(0)" ::: "memory");
#pragma unroll
      for (int i = 0; i < 9; ++i) { const int q = (i * 8 + wid) * 64 + lane, blk = q / 129, qq = q - blk * 129; const int sg = blk * 128 + (qq < 128 ? qq : 127);
          glds16(Ab + (size_t)sg * 16, (unsigned)__builtin_amdgcn_readfirstlane(lds0 + (i * 8 + wid) * 1024)); }
      asm volatile("s_waitcnt vmcnt(0)\n\ts_barrier" ::: "memory"); }
    const bf16* Bp = (const bf16*)(ws + OFF_CW1) + (size_t)kv * 256 * 2048 + ((size_t)wid * 128 * 64 + lane) * 8;
    const lds_cptr Al = (lds_cptr)lds + 2064 * r32 + 16 * hi;
    f32x16 acc;
#pragma unroll
    for (int r = 0; r < 16; ++r) acc[r] = 0.f;
#pragma unroll 8
    for (int l = 0; l < 32; ++l) {
        const lds_cptr ap = Al + l * 128 + (l >> 4) * 16;
#pragma unroll
        for (int q = 0; q < 4; ++q) {
            const bf16x8 a = *(const LAS bf16x8*)(ap + q * 32), w = *(const bf16x8*)(Bp + (size_t)(4 * l + q) * 512);
            acc = __builtin_amdgcn_mfma_f32_32x32x16_bf16(w, a, acc, 0, 0, 0);
        }
    }
    const float* cb = (const float*)(ws + OFF_CB1) + kv * 256 + 32 * wid + 4 * hi;
    bf16x8 hf[2];
    { float hv[16];
#pragma unroll
      for (int rq = 0; rq < 4; ++rq) { const f32x4 bb = *(const f32x4*)(cb + 8 * rq);
#pragma unroll
          for (int e = 0; e < 4; ++e) hv[4 * rq + e] = siluf_(acc[4 * rq + e] + bb[e]); }
      u32x4 w0, w1;
      w0.x = pk2(hv[0], hv[1]); w0.y = pk2(hv[2], hv[3]); w0.z = pk2(hv[4], hv[5]); w0.w = pk2(hv[6], hv[7]);
      w1.x = pk2(hv[8], hv[9]); w1.y = pk2(hv[10], hv[11]); w1.z = pk2(hv[12], hv[13]); w1.w = pk2(hv[14], hv[15]);
      hf[0] = __builtin_bit_cast(bf16x8, w0); hf[1] = __builtin_bit_cast(bf16x8, w1); }
    const bf16* W2 = (const bf16*)(ws + OFF_CW2) + (size_t)kv * 64 * 256 + 32 * wid + 4 * hi;
    f32x16 po[2];
#pragma unroll
    for (int dbk = 0; dbk < 2; ++dbk) {
#pragma unroll
        for (int r = 0; r < 16; ++r) po[dbk][r] = 0.f;
#pragma unroll
        for (int s = 0; s < 2; ++s) {
            const bf16* wr = W2 + (size_t)(32 * dbk + r32) * 256 + 16 * s;
            const u32x2 lo = *(const u32x2*)wr, hh = *(const u32x2*)(wr + 8);
            u32x4 wv; wv.x = lo.x; wv.y = lo.y; wv.z = hh.x; wv.w = hh.y;
            po[dbk] = __builtin_amdgcn_mfma_f32_32x32x16_bf16(__builtin_bit_cast(bf16x8, wv), hf[s], po[dbk], 0, 0, 0);
        }
    }
    LAS float* part = (LAS float*)lds;
    __syncthreads();
#pragma unroll
    for (int dbk = 0; dbk < 2; ++dbk)
#pragma unroll
        for (int r = 0; r < 16; ++r) part[(wid * 64 + 32 * dbk + crow(r, hi)) * 32 + r32] = po[dbk][r];
    __syncthreads();
    {
        const int row = tid & 31, d4 = tid >> 5, cc = 32 * rc + row;
        float o[4];
#pragma unroll
        for (int e = 0; e < 4; ++e) { float sum = 0.f;
#pragma unroll
            for (int w = 0; w < 8; ++w) sum += part[(w * 64 + 4 * d4 + e) * 32 + row];
            o[e] = (cc < 255) ? sum : 0.f; }
        bf16* dst = (bf16*)(ws + (kv ? OFF_VCMP : OFF_KCMP)) + (size_t)bg * 16384 + (kv ? vtile_off(cc, 4 * d4) : ktile_off(cc, 4 * d4));
        store_bf<4>(dst, o);
    }
    __syncthreads();
}
__device__ __forceinline__ void cumsum_unit(unsigned char* lds, unsigned char* ws, int bh) {
    int tid_o = threadIdx.x; asm volatile("" : "+v"(tid_o));
    const int tid = tid_o, lane = tid & 63, wid = tid >> 6, b = bh >> 3, h = bh & 7;
    const float* lf = (const float*)(ws + OFF_LOGF) + ((size_t)(b * 4096 + 8 * tid)) * 8 + h;
    float v[8]; float s = 0.f;
#pragma unroll
    for (int i = 0; i < 8; ++i) { s += lf[i * 8]; v[i] = s; }
    float incl = s;
#pragma unroll
    for (int of = 1; of < 64; of <<= 1) { const float t = __shfl_up(incl, of); if (lane >= of) incl += t; }
    LAS float* wsum = (LAS float*)lds;
    __syncthreads();
    if (lane == 63) wsum[wid] = incl;
    __syncthreads();
    float base = incl - s;
    for (int w = 0; w < wid; ++w) base += wsum[w];
    float* cf = (float*)(ws + OFF_CF) + (size_t)bh * 4096 + 8 * tid;
    f32x4 o0 = {-(base + v[0]), -(base + v[1]), -(base + v[2]), -(base + v[3])}, o1 = {-(base + v[4]), -(base + v[5]), -(base + v[6]), -(base + v[7])};
    *(f32x4*)cf = o0; *(f32x4*)(cf + 4) = o1;
    __syncthreads();
}

constexpr size_t OFF_BAR = OFF_CTL + 131072;
constexpr size_t OFF_Q = OFF_CTL + 0x28000;
constexpr int LDS_BARST = 131072 + 64;
#define XB_TMO      128
#define XB_XCNT(j)  (256  + 64 * (j))
#define XB_XSUB(j)  (1280 + 64 * (j))
#define XB_XGEN(j)  (2304 + 64 * (j))
#define XB_TOP      3328
#define XB_TOPGEN   3392
#define XCD_BAR_WORDS 3456
#define XB_SPIN_CAP (1u << 18)

__device__ __forceinline__ unsigned xb_ld(unsigned* p)              { return __hip_atomic_load(p, __ATOMIC_RELAXED, __HIP_MEMORY_SCOPE_AGENT); }
__device__ __forceinline__ unsigned xb_add(unsigned* p, unsigned v) { return __hip_atomic_fetch_add(p, v, __ATOMIC_RELAXED, __HIP_MEMORY_SCOPE_AGENT); }
__device__ __forceinline__ unsigned xb_xcc_id() { return (unsigned)__builtin_amdgcn_s_getreg((3 << 11) | 20) & 0xFu; }
#define XB_SPIN(cond, bar) do { unsigned _sp = 0; while (cond) { __builtin_amdgcn_s_sleep(1); \
    if ((++_sp & 255u) == 0u) { if (xb_ld(&(bar)[XB_TMO])) break; if (_sp > XB_SPIN_CAP) { atomicAdd(&(bar)[XB_TMO], 1u); break; } } } } while (0)

struct XcdBarrier {
    unsigned* bar; unsigned x;
    volatile LAS unsigned* st;
};

__device__ __forceinline__ XcdBarrier xcd_barrier_post(unsigned* bar, volatile LAS unsigned* st) {
    XcdBarrier b; b.bar = bar; b.x = xb_xcc_id(); b.st = st;
    if (threadIdx.x == 0) (void)xb_add(&bar[XB_XCNT(b.x)], 1u);
    return b;
}
__device__ __forceinline__ void xcd_barrier_complete(unsigned* bar, unsigned x, unsigned& nloc, unsigned& nx) {
    const unsigned G = gridDim.x * gridDim.y * gridDim.z;
    unsigned sum, cnt, mine, sp = 0u;
    for (;;) {
        sum = 0u; cnt = 0u; mine = 0u;
#pragma unroll
        for (unsigned j = 0; j < 16; ++j) { const unsigned c = xb_ld(&bar[XB_XCNT(j)]); sum += c; cnt += (c > 0u) ? 1u : 0u; mine = (j == x) ? c : mine; }
        if (sum == G) break;
        __builtin_amdgcn_s_sleep(1);
        if ((++sp & 255u) == 0u) { if (xb_ld(&bar[XB_TMO])) break; if (sp > XB_SPIN_CAP) { atomicAdd(&bar[XB_TMO], 1u); break; } }
    }
    nloc = mine > 0u ? mine : 1u; nx = cnt > 0u ? cnt : 1u;
}

__device__ __forceinline__ void xcd_barrier(const XcdBarrier& b) {
    asm volatile("s_waitcnt vmcnt(0)" ::: "memory");
    __syncthreads();
    if (threadIdx.x == 0) {
        unsigned* bar = b.bar;
        __builtin_amdgcn_s_waitcnt(0);
        unsigned nloc = b.st[0], nx = b.st[1];
        if (nloc == 0u) { xcd_barrier_complete(bar, b.x, nloc, nx); b.st[0] = nloc; b.st[1] = nx; }
        const unsigned old = xb_add(&bar[XB_XSUB(b.x)], 1u);
        const unsigned gen = old / nloc;
        if (old + 1u == (gen + 1u) * nloc) {
            __builtin_amdgcn_fence(__ATOMIC_RELEASE, "agent");
            asm volatile("s_waitcnt vmcnt(0)" ::: "memory");
            const unsigned og = xb_add(&bar[XB_TOP], 1u);
            const unsigned tg = og / nx;
            if (og + 1u == (tg + 1u) * nx) xb_add(&bar[XB_TOPGEN], 1u);
            else XB_SPIN(xb_ld(&bar[XB_TOPGEN]) == tg, bar);
            __builtin_amdgcn_fence(__ATOMIC_ACQUIRE, "agent");
            xb_add(&bar[XB_XGEN(b.x)], 1u);
            asm volatile("s_waitcnt vmcnt(0)" ::: "memory");
        } else {
            XB_SPIN(xb_ld(&bar[XB_XGEN(b.x)]) == gen, bar);
            __builtin_amdgcn_fence(__ATOMIC_ACQUIRE, "agent");
            asm volatile("s_waitcnt vmcnt(0)" ::: "memory");
        }
    }
    __syncthreads();
}

struct KArgs;
__device__ __forceinline__ void conv_tile(bool active, float (*tile)[65], int vt, const float* src, int ld, int K, bf16* dst, const float* kscale, int mode, int bx, int by) {
    const int n0 = bx * 64, k0 = by * 64, tx = vt & 63, ty = vt >> 6;
    const int n = n0 + tx;
    const int sc = (mode == 0 || mode == 3) ? n : mode == 1 ? win_srccol(n) : (n & ~63) + ((n & 1) << 5) + ((n & 63) >> 1);
    if (active) {
        float v[16];
#pragma unroll
        for (int i = 0; i < 16; ++i) v[i] = (sc >= 0) ? src[(size_t)(k0 + 4 * i + ty) * ld + sc] : 0.f;
        if (kscale) {
#pragma unroll
            for (int i = 0; i < 16; ++i) v[i] *= kscale[k0 + 4 * i + ty]; }
#pragma unroll
        for (int i = 0; i < 16; ++i) tile[tx][4 * i + ty] = v[i];
    }
    __syncthreads();
    if (active) {
#pragma unroll
        for (int p = 0; p < 2; ++p) { const int it = vt + 256 * p, r = it >> 3, c = it & 7; const float* t = &tile[r][8 * c];
            u32x4 o; o.x = pk2(t[0], t[1]); o.y = pk2(t[2], t[3]); o.z = pk2(t[4], t[5]); o.w = pk2(t[6], t[7]);
            const int nn = n0 + r, kk = k0 + 8 * c;
            if (mode == 3) *(u32x4*)(dst + ((size_t)((nn >> 5) * (K >> 4) + (kk >> 4)) * 64 + (nn & 31) + 32 * ((kk & 15) >> 3)) * 8) = o;
            else *(u32x4*)(dst + (size_t)nn * K + kk) = o; }
    }
    __syncthreads();
}
namespace cg = cooperative_groups;
constexpr int NT = 512;
constexpr int LDS_BYTES = 147456;
struct KArgs { const void* in[23]; float* out; unsigned char* ws; };

#define OPAQUE_TID() int tid = threadIdx.x; asm volatile("" : "+v"(tid))
#define VRUN(VT, NVB, CALL) do { OPAQUE_TID(); constexpr int per_ = NT / (VT); for (int vb = blockIdx.x * per_ + tid / (VT); vb < (NVB); vb += gridDim.x * per_) { const int vt = tid % (VT); CALL; } } while (0)
#define VRUN_BAR(NVB, CALL) do { OPAQUE_TID(); float (*tile)[65] = (float (*)[65])(lds + (tid >> 8) * 64 * 65 * 4); (void)tile; const int nvb_ = (NVB); for (int it_ = 0; it_ * (int)gridDim.x * 2 < nvb_; ++it_) { const int vb = (it_ * (int)gridDim.x + (int)blockIdx.x) * 2 + (tid >> 8); const int vt = tid & 255; const bool active = vb < nvb_; CALL; } } while (0)

#ifndef REP_U
#define REP_U 0
#endif
#ifndef REP_SYNC
#define REP_SYNC 0
#endif
#ifndef REP_SUMSQ
#define REP_SUMSQ 0
#endif
#ifndef REP_P0
#define REP_P0 0
#endif
#ifndef REP_PRO
#define REP_PRO 0
#endif
#ifndef REP_INPROJ
#define REP_INPROJ 0
#endif
#ifndef REP_P2
#define REP_P2 0
#endif
#ifndef REP_FOX
#define REP_FOX 0
#endif
#ifndef REP_DIFF
#define REP_DIFF 0
#endif
#ifndef REP_NSA
#define REP_NSA 0
#endif
#ifndef REP_GATEBR
#define REP_GATEBR 0
#endif
#ifndef REP_OUT
#define REP_OUT 0
#endif
#ifndef DO_ALL
#define DO_ALL 1
#endif
#ifndef DO_PRO
#define DO_PRO DO_ALL
#endif
#ifndef DO_INPROJ
#define DO_INPROJ DO_ALL
#endif
#ifndef DO_P2
#define DO_P2 DO_ALL
#endif
#ifndef DO_ATTN
#define DO_ATTN DO_ALL
#endif
#ifndef DO_GATEBR
#define DO_GATEBR DO_ALL
#endif
#ifndef DO_OUT
#define DO_OUT DO_ALL
#endif
#ifndef DO_PLE
#define DO_PLE DO_ALL
#endif
#ifndef DO_TAIL
#define DO_TAIL DO_ALL
#endif
__global__ void __launch_bounds__(NT) mega(KArgs a) {
    extern __shared__ __attribute__((aligned(16))) unsigned char lds[];
    cg::grid_group grid = cg::this_grid();
    { volatile LAS unsigned* st0 = (volatile LAS unsigned*)((LAS unsigned char*)lds + LDS_BARST); if (threadIdx.x < 2) st0[threadIdx.x] = 0u; }
    __syncthreads();
    const XcdBarrier xbar = xcd_barrier_post((unsigned*)(a.ws + OFF_BAR), (volatile LAS unsigned*)((LAS unsigned char*)lds + LDS_BARST));
#define GSYNC() xcd_barrier(xbar)
    unsigned char* ws = a.ws; float* X = a.out;
    typedef const KArgs __attribute__((address_space(4)))* kargp_t;
#define KIN(i) ([&]() { kargp_t kp_ = (kargp_t)__builtin_amdgcn_kernarg_segment_ptr(); asm volatile("" : "+s"(kp_)); return kp_->in[i]; }())
#define I_x ((const float*)KIN(0))
#define I_p ((const float*)KIN(1))
#define I_pos ((const int*)KIN(2))
#define I_norm_g ((const float*)KIN(3))
#define I_w_in ((const float*)KIN(4))
#define I_b_forget ((const float*)KIN(5))
#define I_pe_k ((const float*)KIN(6))
#define I_w1_k ((const float*)KIN(7))
#define I_b1_k ((const float*)KIN(8))
#define I_w2_k ((const float*)KIN(9))
#define I_pe_v ((const float*)KIN(10))
#define I_w1_v ((const float*)KIN(11))
#define I_b1_v ((const float*)KIN(12))
#define I_w2_v ((const float*)KIN(13))
#define I_diff_lam ((const float*)KIN(14))
#define I_subln ((const float*)KIN(15))
#define I_w_out ((const float*)KIN(19))
#define I_w_ple ((const float*)KIN(20))
#define I_w_pg ((const float*)KIN(21))
#define I_final_g ((const float*)KIN(22))
#if DO_PRO
    for (int rep0_ = 0; rep0_ <= REP_P0; ++rep0_) {
    VRUN(256, M / 4, d_xprep(vb, vt, I_x, ws));
    VRUN(256, M * 32 / 256, d_rope_table(vb, vt, I_pos, ws));
    VRUN(256, (2 * M * 256 / 4) / 256, d_pconv(vb, vt, I_p, ws));
    for (int l = 0; l < DEPTH; ++l) {
        { OPAQUE_TID(); if (blockIdx.x == 0 && tid < 64) d_lam(tid, I_diff_lam + l * 256, ws, l); }
    }
    }
#endif
    for (int l = 0; l < DEPTH; ++l) {
        const float* wl = I_w_in + (size_t)l * 1024 * NIN; const float* ng = I_norm_g + l * 1024;
#if DO_PRO
        for (int rep_ = 0; rep_ <= REP_PRO; ++rep_) {
        { OPAQUE_TID(); float (*tile)[65] = (float (*)[65])(lds + (tid >> 8) * 64 * 65 * 4);
          const int njobs = 2952 + (l == 0 ? 1152 : 0);
          for (int it_ = 0; it_ * (int)gridDim.x * 2 < njobs; ++it_) {
              int j = (it_ * (int)gridDim.x + (int)blockIdx.x) * 2 + (tid >> 8); const bool active = j < njobs;
              const float* src = wl; int ld = NIN, K = 1024, mode = 1, bx = 0, by = 0; bf16* dst = (bf16*)(ws + OFF_WIN); const float* ks = ng;
              if (j < 1536) { bx = j % 96; by = j / 96; }
              else if (j < 2304) { j -= 1536; bx = j % 48; by = j / 48; src = wl + 5920; mode = 0; dst = (bf16*)(ws + OFF_WMG); }
              else if (j < 2688) { j -= 2304; const int i = j >> 7, r = j & 127; bx = r & 15; by = r >> 4; src = (const float*)KIN(16 + i) + (size_t)l * 512 * 1024; ld = 1024; K = 512; mode = 0; dst = (bf16*)(ws + OFF_WBR) + (size_t)i * 1024 * 512; ks = nullptr; }
              else if (j < 2944) { j -= 2688; const int kv = j >> 7, r = j & 127; bx = r & 3; by = r >> 2; src = (kv ? I_w1_v : I_w1_k) + (size_t)l * 2048 * 256; ld = 256; K = 2048; mode = 3; dst = (bf16*)(ws + OFF_CW1) + (size_t)kv * 256 * 2048; ks = nullptr; }
              else if (j < 2952) { j -= 2944; const int kv = j >> 2; by = j & 3; src = (kv ? I_w2_v : I_w2_k) + (size_t)l * 256 * 64; ld = 64; K = 256; mode = kv ? 0 : 2; dst = (bf16*)(ws + OFF_CW2) + (size_t)kv * 64 * 256; ks = nullptr; }
              else { j -= 2952; const int ll = j / 576, r = j % 576; ld = 1024; mode = 0; ks = nullptr;
                  if (r < 256) { bx = r & 15; by = r >> 4; src = I_w_out + (size_t)ll * 1024 * 1024; dst = (bf16*)(ws + OFF_WOUT) + (size_t)ll * 1024 * 1024; }
                  else if (r < 512) { const int r2 = r - 256; bx = r2 & 15; by = r2 >> 4; src = I_w_pg + (size_t)ll * 1024 * 1024; dst = (bf16*)(ws + OFF_WPG) + (size_t)ll * 1024 * 1024; }
                  else { const int r2 = r - 512; bx = r2 & 15; by = r2 >> 4; src = I_w_ple + (size_t)ll * 256 * 1024; K = 256; dst = (bf16*)(ws + OFF_WPL) + (size_t)ll * 1024 * 256; } }
              conv_tile(active, tile, tid & 255, src, ld, K, dst, ks, mode, bx, by);
          } }
        { OPAQUE_TID(); if (blockIdx.x >= 64 && blockIdx.x < 96 && tid < 256) d_cb1_part(blockIdx.x - 64, tid, I_pe_k + l * 2048, I_w1_k + (size_t)l * 2048 * 256, I_pe_v + l * 2048, I_w1_v + (size_t)l * 2048 * 256, ws); }
        }
#endif
        if (l == 0) grid.sync(); else GSYNC();
        EpiCtx E{ws, I_b_forget + l * 8, l == 0 ? I_x : X, X, 0};
#if DO_INPROJ
        { OPAQUE_TID(); if (blockIdx.x == 0) d_cb1_sum(tid, I_b1_k + l * 256, I_b1_v + l * 256, ws); }
        for (int rep_ = 0; rep_ <= REP_INPROJ; ++rep_) { FAST_GEMM(EPI_INPROJ, ws + OFF_XB, ws + OFF_WIN, NP, 1024, true); }
#endif
        GSYNC();
#if DO_ATTN
        { OPAQUE_TID();
          unsigned* qc = (unsigned*)(ws + OFF_Q) + 64 * l; unsigned* p2c = (unsigned*)(ws + OFF_Q) + 64 * (2 + l);
          const float lam = ((const float*)(ws + OFF_CTL))[CTL_LAM + l], lam_init = 0.8f - 0.6f * expf(-0.3f * (float)l);
          if (tid == 0) *(volatile LAS unsigned*)((LAS unsigned char*)lds + LDS_QSLOT) = xb_add(qc, 1u);
          bool p2seen = false;
          for (;;) {
              __syncthreads();
              const int u = __builtin_amdgcn_readfirstlane((int)*(volatile LAS unsigned*)((LAS unsigned char*)lds + LDS_QSLOT));
              if (u >= 1696) break;
              if (u < 160) {
                  if (u < 128) compress_unit(lds, ws, u >> 6, (u >> 3) & 7, u & 7); else cumsum_unit(lds, ws, u - 128);
                  asm volatile("s_waitcnt vmcnt(0)" ::: "memory");
                  __syncthreads();
                  if (tid == 0) { __builtin_amdgcn_fence(__ATOMIC_RELEASE, "agent"); asm volatile("s_waitcnt vmcnt(0)" ::: "memory"); (void)xb_add(p2c, 1u);
                                  *(volatile LAS unsigned*)((LAS unsigned char*)lds + LDS_QSLOT) = xb_add(qc, 1u); }
              } else if (u < 672) { const int v = u - 160; diff_unit(lds, ws, v & 15, 31 - (v >> 4), I_subln + l * 128, lam, lam_init, qc); }
              else {
                  if (!p2seen) {
                      if (tid == 0) { XB_SPIN(xb_ld(p2c) < 160u, xbar.bar); __builtin_amdgcn_fence(__ATOMIC_ACQUIRE, "agent"); asm volatile("s_waitcnt vmcnt(0)" ::: "memory"); }
                      __syncthreads(); p2seen = true; }
                  const int w = u - 672, qb = 15 - (w >> 6), r = w & 63;
                  if (r < 32) fox_unit(lds, ws, r, qb, qc); else nsa_unit(lds, ws, (r - 32) & 7, 4 * qb + 3 - ((r - 32) >> 3), qc);
              }
          }
        }
#endif
        GSYNC();
#if DO_GATEBR
        for (int rep_ = 0; rep_ <= REP_GATEBR; ++rep_) {
        { pg8::Gemm g_{(const pg8::bf16_t*)(ws + OFF_XB), (const pg8::bf16_t*)(ws + OFF_WMG), M, 3072, 1024}; ChainOrder S_; S_.init((int)gridDim.x, (int)blockIdx.x, 0);
          EpiFast<EPI_GATE3> Ep_{E}; pg8::gemm_phase<EpiFast<EPI_GATE3>, ChainOrder, true, true>((PG8_LAS unsigned char*)lds, g_, S_, Ep_); }
        { pg8::Gemm g_{(const pg8::bf16_t*)(ws + OFF_ZA), (const pg8::bf16_t*)(ws + OFF_WBR), 3 * M, 3072, 512}; ChainOrder S_; S_.init((int)gridDim.x, (int)blockIdx.x, 1);
          EpiFast<EPI_BR3> Ep_{E}; pg8::gemm_phase<EpiFast<EPI_BR3>, ChainOrder, true, true>((PG8_LAS unsigned char*)lds, g_, S_, Ep_); }
        }
#endif
        GSYNC();
#if DO_OUT
        for (int rep_ = 0; rep_ <= (l == 0 ? REP_OUT : 0); ++rep_) FAST_GEMM(EPI_OUT, (const bf16*)(ws + OFF_MERGED), (const bf16*)(ws + OFF_WOUT) + (size_t)l * 1024 * 1024, 1024, 1024, false);
#endif
        GSYNC();
#if DO_PLE
        for (int rep_ = 0; rep_ <= REP_U; ++rep_) FAST_GEMM(EPI_U, (const bf16*)(ws + OFF_PB) + (size_t)l * M * 256, (const bf16*)(ws + OFF_WPL) + (size_t)l * 1024 * 256, 1024, 256, false);
        FAST_GEMM(EPI_PLE, (const bf16*)(ws + OFF_X1B), (const bf16*)(ws + OFF_WPG) + (size_t)l * 1024 * 1024, 1024, 1024, false);
#endif
        GSYNC();
#if DO_TAIL
        for (int rep_ = 0; rep_ < 10 * REP_SYNC; ++rep_) GSYNC();
        for (int rep_ = 0; rep_ <= REP_SUMSQ; ++rep_) { if (l + 1 < DEPTH) VRUN(256, M / 4, d_sumsq(vb, vt, X, ws)); }
#endif
    }
#if DO_TAIL
    VRUN(256, M / 4, d_final(vb, vt, X, I_final_g));
#endif
}
#undef I_x
#undef I_p
#undef I_pos
#undef I_norm_g
#undef I_w_in
#undef I_b_forget
#undef I_pe_k
#undef I_w1_k
#undef I_b1_k
#undef I_w2_k
#undef I_pe_v
#undef I_w1_v
#undef I_b1_v
#undef I_w2_v
#undef I_diff_lam
#undef I_subln
#undef I_w_out
#undef I_w_ple
#undef I_w_pg
#undef I_final_g
#undef KIN

extern "C" void kernel_launch(void* const* d_in, const int* in_sizes, int n_in, void* d_out, int out_size, void* d_ws, size_t ws_size, hipStream_t stream) {
    static int grid_blocks = 0;
    if (grid_blocks == 0) {
        if (n_in != 23 || ws_size < WS_NEED || out_size != M * DM) { fprintf(stderr, "kernel_launch: unexpected sizes (n_in %d ws %zu out %d)\n", n_in, ws_size, out_size); grid_blocks = -1; return; }
        int dev = 0, cus = 0, per_cu = 0;
        (void)hipGetDevice(&dev); (void)hipDeviceGetAttribute(&cus, hipDeviceAttributeMultiprocessorCount, dev);
        (void)hipFuncSetAttribute((const void*)mega, hipFuncAttributeMaxDynamicSharedMemorySize, LDS_BYTES);
        (void)hipOccupancyMaxActiveBlocksPerMultiprocessor(&per_cu, (const void*)mega, NT, LDS_BYTES);
        if (per_cu < 1) { fprintf(stderr, "kernel_launch: occupancy query says %d blocks per CU\n", per_cu); grid_blocks = -1; return; }
        grid_blocks = cus * 1;
        if (grid_blocks != 256) { fprintf(stderr, "kernel_launch: built for a 256-CU device (got %d)\n", cus); grid_blocks = -1; return; }
    }
    if (grid_blocks < 0) return;
    (void)hipMemsetAsync((char*)d_ws + OFF_CTL, 0, 262144, stream);
    KArgs a{};
    for (int i = 0; i < 23; ++i) a.in[i] = d_in[i];
    a.out = (float*)d_out; a.ws = (unsigned char*)d_ws;
    void* args[] = {&a};
    hipError_t e = hipLaunchCooperativeKernel((const void*)mega, dim3(grid_blocks), dim3(NT), args, LDS_BYTES, stream);
    if (e != hipSuccess) fprintf(stderr, "cooperative launch failed: %s (grid %d)\n", hipGetErrorString(e), grid_blocks);
}
```

```cpp
#include <hip/hip_runtime.h>
#include <hip/hip_cooperative_groups.h>
#include <cstdio>
#include <cstdint>

typedef unsigned short bf16;
typedef short bf16x8 __attribute__((ext_vector_type(8)));
typedef float f32x4 __attribute__((ext_vector_type(4)));
typedef float f32x16 __attribute__((ext_vector_type(16)));
typedef unsigned u32x4 __attribute__((ext_vector_type(4)));
typedef unsigned u32x2 __attribute__((ext_vector_type(2)));

constexpr int BATCH = 4, SEQ = 4096, DM = 1024, M = BATCH * SEQ, DEPTH = 2, NIN = 8992, NP = 6144;
constexpr float EPS = 1e-6f;
constexpr float LOG2E = 1.4426950408889634f;
constexpr float C2 = 0.125f * LOG2E;
constexpr size_t MiB = 1u << 20;
constexpr size_t OFF_CTL = 0;
constexpr size_t OFF_WIN = 1 * MiB, OFF_WMG = 13 * MiB, OFF_WBR = 19 * MiB, OFF_CW1 = 22 * MiB, OFF_CW2 = 24 * MiB, OFF_CB1 = 24 * MiB + 128 * 1024;
constexpr size_t OFF_WOUT = 25 * MiB, OFF_WPG = 29 * MiB, OFF_WPL = 33 * MiB;
constexpr size_t OFF_XB = 34 * MiB, OFF_ZA = 66 * MiB, OFF_ZB = 82 * MiB, OFF_ZC = 98 * MiB;
constexpr size_t OFF_COS = 114 * MiB, OFF_SIN = 116 * MiB, OFF_PB = 118 * MiB;
constexpr size_t OFF_LOGF = 134 * MiB, OFF_CF = 134 * MiB + 512 * 1024, OFF_GATES = 135 * MiB, OFF_SSP = 136 * MiB + 512 * 1024;
constexpr size_t OFF_KCMP = 136 * MiB + 768 * 1024, OFF_VCMP = 137 * MiB, OFF_SELM = 137 * MiB + 256 * 1024;
constexpr size_t OFF_QA = 139 * MiB, OFF_KA = 155 * MiB, OFF_VA = 171 * MiB, OFF_QB = 187 * MiB, OFF_QC = 203 * MiB, OFF_KC = 219 * MiB, OFF_VC = 235 * MiB;
constexpr size_t OFF_KCB = 251 * MiB, OFF_VCB = 255 * MiB, OFF_KSEL = 259 * MiB, OFF_KWIN = 263 * MiB, OFF_VSEL = 267 * MiB, OFF_VWIN = 271 * MiB;
constexpr size_t WS_NEED = 275 * MiB;
constexpr size_t OFF_G = 139 * MiB  , OFF_T = 235 * MiB  , OFF_MERGED = OFF_T, OFF_X1B = 203 * MiB, OFF_U = 139 * MiB;
constexpr int CTL_LAM = 64;

__device__ __forceinline__ bf16 f2bf(float f) { unsigned u = __float_as_uint(f); return (bf16)((u + 0x7fffu + ((u >> 16) & 1u)) >> 16); }
__device__ __forceinline__ float bf2f(bf16 h) { return __uint_as_float(((unsigned)h) << 16); }
__device__ __forceinline__ unsigned pk2(float lo, float hi) { typedef float f2_ __attribute__((ext_vector_type(2))); typedef __bf16 b2_ __attribute__((ext_vector_type(2))); f2_ v = {lo, hi}; b2_ b = __builtin_convertvector(v, b2_); return __builtin_bit_cast(unsigned, b); }
__device__ __forceinline__ float sigmoidf_(float x) { return 1.f / (1.f + __expf(-x)); }
__device__ __forceinline__ float siluf_(float x) { return x / (1.f + __expf(-x)); }
__device__ __forceinline__ float logsigmoidf_(float x) { return x >= 0.f ? -log1pf(expf(-x)) : x - log1pf(expf(x)); }

__device__ __forceinline__ int ktile_off(int s, int d) { return (s >> 6) * 4096 + (d >> 3) * 512 + (s & 63) * 8 + (d & 7); }
__device__ __forceinline__ int vtile_off(int s, int d) { return (s >> 6) * 4096 + (d >> 5) * 2048 + ((s & 63) >> 4) * 512 + (s & 15) * 32 + (d & 31); }
__device__ __forceinline__ int v128_off(int s, int d) { return (s >> 6) * 8192 + (d >> 5) * 2048 + ((s & 63) >> 4) * 512 + (s & 15) * 32 + (d & 31); }

template <int W> __device__ __forceinline__ void store_bf(bf16* dst, const float* v) {
    if constexpr (W == 4) { u32x2 o; o.x = pk2(v[0], v[1]); o.y = pk2(v[2], v[3]); *(u32x2*)dst = o; }
    else { u32x4 o; o.x = pk2(v[0], v[1]); o.y = pk2(v[2], v[3]); o.z = pk2(v[4], v[5]); o.w = pk2(v[6], v[7]); *(u32x4*)dst = o; }
}

__device__ __forceinline__ int win_srccol(int n) {
    const int seg = n >> 6, j = n & 63; const int il = ((j & 1) << 5) + (j >> 1);
    if (seg < 8) return 0 + n;
    if (seg < 16) return 512 + (n - 512);
    if (seg < 24) return 1024 + (n - 1024);
    if (seg < 32) return 1544 + (n - 1536);
    if (seg < 40) return 2056 + (seg - 32) * 64 + il;
    if (seg < 42) return 2568 + (n - 2560);
    if (seg < 44) return 2696 + (n - 2688);
    if (seg < 46) return 2824 + (seg - 44) * 64 + il;
    if (seg < 48) return 3080 + (seg - 46) * 64 + il;
    if (seg < 50) return 2952 + (n - 3072);
    if (seg < 52) return 3208 + (n - 3200);
    if (seg < 60) return 3360 + (n - 3328);
    if (seg < 68) return 3872 + (seg - 60) * 64 + il;
    if (seg < 76) return 4384 + (seg - 68) * 64 + il;
    if (seg < 84) return 4896 + (n - 4864);
    if (seg < 92) return 5408 + (n - 5376);
    if (seg == 92) { if (j < 8) return 1536 + j; if (j < 32) return 3336 + (j - 8); return -1; }
    return -1;
}

enum { EPI_INPROJ = 0, EPI_GATE = 1, EPI_BR0 = 2, EPI_BR1 = 3, EPI_BR2 = 4, EPI_OUT = 5, EPI_U = 6, EPI_PLE = 7, EPI_GATE3 = 9, EPI_BR3 = 10 };
struct EpiCtx { unsigned char* ws; const float* bfg; const float* xin; float* X; int gi; };

__device__ __forceinline__ float row_rstd(const unsigned char* ws, int row) {
    const f32x4 sp = *(const f32x4*)(ws + OFF_SSP + (size_t)row * 16);
    return rsqrtf(((sp[0] + sp[1]) + (sp[2] + sp[3])) * (1.f / 1024.f) + EPS);
}

enum { T_QA = 0, T_KA, T_VA, T_ZA, T_QB, T_CB, T_KROPE, T_VSW, T_ZB, T_QC, T_KC, T_VC, T_ZC, T_SPECIAL };
__device__ __forceinline__ int inproj_type(int t) {
    return t < 2 ? T_QA : t < 4 ? T_KA : t < 6 ? T_VA : t < 8 ? T_ZA : t < 10 ? T_QB : t == 10 ? T_CB : t == 11 ? T_KROPE : t == 12 ? T_VSW : t < 15 ? T_ZB : t < 17 ? T_QC : t < 19 ? T_KC : t < 21 ? T_VC : t < 23 ? T_ZC : T_SPECIAL;
}
struct Pre { float rs; u32x4 ra, rb; f32x4 fa, fb; };
template <int KIND, int T> __device__ __forceinline__ void pre_load(const EpiCtx& E, int row, int col, Pre& p) {
    unsigned char* ws = E.ws; const size_t idx = (size_t)row * 1024 + col;
    if constexpr (KIND == EPI_INPROJ) {
        if constexpr (T == T_KROPE || T == T_QC || T == T_KC) { const int d = col & 63;
            p.fa = *(const f32x4*)((const float*)(ws + OFF_COS) + (size_t)row * 32 + (d >> 1)); p.fb = *(const f32x4*)((const float*)(ws + OFF_SIN) + (size_t)row * 32 + (d >> 1)); }
    } else if constexpr (KIND == EPI_GATE || KIND == EPI_GATE3) {
    } else if constexpr (KIND == EPI_BR3) {
        p.ra = *(const u32x4*)((const bf16*)(ws + OFF_G) + (size_t)E.gi * M * 1024 + idx);
        if (E.gi > 0) p.rb = *(const u32x4*)((const bf16*)(ws + OFF_T) + idx); else p.rb = (u32x4){0u, 0u, 0u, 0u};
    } else if constexpr (KIND == EPI_BR0 || KIND == EPI_BR1 || KIND == EPI_BR2) {
        p.ra = *(const u32x4*)((const bf16*)(ws + OFF_G) + idx);
        if constexpr (KIND != EPI_BR0) p.rb = *(const u32x4*)((const bf16*)(ws + OFF_T) + idx); else p.rb = (u32x4){0u, 0u, 0u, 0u};
    } else if constexpr (KIND == EPI_OUT) { p.fa = *(const f32x4*)(E.xin + idx); p.fb = *(const f32x4*)(E.xin + idx + 4);
    } else if constexpr (KIND == EPI_PLE) { p.ra = *(const u32x4*)((const bf16*)(ws + OFF_X1B) + idx); p.rb = *(const u32x4*)((const bf16*)(ws + OFF_U) + idx);
    }
}
__device__ __forceinline__ void st_f32x8(float* dst, const float* v) { f32x4 a = {v[0], v[1], v[2], v[3]}, b = {v[4], v[5], v[6], v[7]}; *(f32x4*)dst = a; *(f32x4*)(dst + 4) = b; }
template <int KIND, int T> __device__ __forceinline__ void emit_fin(const EpiCtx& E, int row, int col, const float* a, const Pre& p) {
    constexpr int W = 8;
    unsigned char* ws = E.ws; const size_t idx = (size_t)row * 1024 + col;
    float v[W], pa[8], pb[8];
    if constexpr (KIND == EPI_BR3 || KIND == EPI_BR0 || KIND == EPI_BR1 || KIND == EPI_BR2 || KIND == EPI_PLE) {
#pragma unroll
        for (int i = 0; i < 4; ++i) { pa[2 * i] = __uint_as_float(p.ra[i] << 16); pa[2 * i + 1] = __uint_as_float(p.ra[i] & 0xffff0000u); pb[2 * i] = __uint_as_float(p.rb[i] << 16); pb[2 * i + 1] = __uint_as_float(p.rb[i] & 0xffff0000u); }
    } else {
#pragma unroll
        for (int i = 0; i < 4; ++i) { pa[i] = p.fa[i]; pa[4 + i] = p.fb[i]; pb[i] = p.fb[i]; pb[4 + i] = 0.f; }
    }
    if constexpr (KIND == EPI_INPROJ) {
        const float rs = p.rs;
#pragma unroll
        for (int i = 0; i < W; ++i) v[i] = a[i] * rs;
        const int b = row >> 12, s = row & 4095;
        if constexpr (T == T_KROPE || T == T_QC || T == T_KC) {
#pragma unroll
            for (int j = 0; j < 4; ++j) { const float c = pa[j], sn = pb[j], x1 = v[2 * j], x2 = v[2 * j + 1]; v[2 * j] = x1 * c - x2 * sn; v[2 * j + 1] = x2 * c + x1 * sn; } }
        if constexpr (T == T_QA) { const int cc = col, h = cc >> 6, d = cc & 63;
#pragma unroll
            for (int i = 0; i < W; ++i) v[i] *= C2;
            store_bf<W>((bf16*)(ws + OFF_QA) + ((size_t)(b * 8 + h) * 4096 + s) * 64 + d, v);
        } else if constexpr (T == T_KA) { const int cc = col - 512, h = cc >> 6, d = cc & 63;
            store_bf<W>((bf16*)(ws + OFF_KA) + (size_t)(b * 8 + h) * 262144 + ktile_off(s, d), v);
        } else if constexpr (T == T_VA) { const int cc = col - 1024, h = cc >> 6, d = cc & 63;
            store_bf<W>((bf16*)(ws + OFF_VA) + (size_t)(b * 8 + h) * 262144 + vtile_off(s, d), v);
        } else if constexpr (T == T_ZA || T == T_ZB || T == T_ZC) { const int cc = col - (T == T_ZA ? 1536 : T == T_ZB ? 3328 : 5376);
#pragma unroll
            for (int i = 0; i < W; ++i) v[i] = siluf_(v[i]);
            store_bf<W>((bf16*)(ws + (T == T_ZA ? OFF_ZA : T == T_ZB ? OFF_ZB : OFF_ZC)) + (size_t)row * 512 + cc, v);
        } else if constexpr (T == T_QB) { const int cc = col - 2048, h = cc >> 6, d = cc & 63;
#pragma unroll
            for (int i = 0; i < W; ++i) v[i] *= C2;
            store_bf<W>((bf16*)(ws + OFF_QB) + ((size_t)(b * 8 + h) * 4096 + s) * 64 + d, v);
        } else if constexpr (T == T_CB) { const int cc = col - 2560, g = (cc >> 6) & 1, d = cc & 63;
            store_bf<W>((bf16*)(ws + (cc < 128 ? OFF_KCB : OFF_VCB)) + ((size_t)(b * 2 + g) * 4096 + s) * 64 + d, v);
        } else if constexpr (T == T_KROPE) { const int cc = col - 2816, g = (cc >> 6) & 1, d = cc & 63;
            store_bf<W>((bf16*)(ws + (cc < 128 ? OFF_KSEL : OFF_KWIN)) + (size_t)(b * 2 + g) * 262144 + ktile_off(s, d), v);
        } else if constexpr (T == T_VSW) { const int cc = col - 3072, g = (cc >> 6) & 1, d = cc & 63;
            store_bf<W>((bf16*)(ws + (cc < 128 ? OFF_VSEL : OFF_VWIN)) + (size_t)(b * 2 + g) * 262144 + vtile_off(s, d), v);
        } else if constexpr (T == T_QC) { const int cc = col - 3840, h = cc >> 6, d = cc & 63;
#pragma unroll
            for (int i = 0; i < W; ++i) v[i] *= C2;
            store_bf<W>((bf16*)(ws + OFF_QC) + ((size_t)(b * 8 + h) * 4096 + s) * 64 + d, v);
        } else if constexpr (T == T_KC) { const int cc = col - 4352, h = cc >> 6, d = cc & 63;
            store_bf<W>((bf16*)(ws + OFF_KC) + (size_t)(b * 8 + h) * 262144 + ktile_off(s, d), v);
        } else if constexpr (T == T_VC) { const int cc = col - 4864, hc = cc >> 7, d = cc & 127;
            store_bf<W>((bf16*)(ws + OFF_VC) + (size_t)(b * 4 + hc) * 524288 + v128_off(s, d), v);
        } else { const int cc = col - 5888;
            if (cc < 8) { float* o = (float*)(ws + OFF_LOGF) + (size_t)row * 8 + cc;
#pragma unroll
                for (int i = 0; i < W; ++i) o[i] = logsigmoidf_(v[i] + E.bfg[cc + i]) * LOG2E;
            } else if (cc < 32) { float* o = (float*)(ws + OFF_GATES) + (size_t)row * 24 + (cc - 8);
#pragma unroll
                for (int i = 0; i < W; ++i) o[i] = sigmoidf_(v[i]);
            }
        }
    } else if constexpr (KIND == EPI_GATE3) {
#pragma unroll
        for (int i = 0; i < W; ++i) v[i] = sigmoidf_(a[i] * p.rs);
        store_bf<W>((bf16*)(ws + OFF_G) + (size_t)E.gi * M * 1024 + idx, v);
    } else if constexpr (KIND == EPI_BR3) {
#pragma unroll
        for (int i = 0; i < W; ++i) v[i] = pa[i] * a[i] + pb[i];
        store_bf<W>((bf16*)(ws + OFF_T) + idx, v);
    } else if constexpr (KIND == EPI_GATE) {
#pragma unroll
        for (int i = 0; i < W; ++i) v[i] = sigmoidf_(a[i] * p.rs);
        store_bf<W>((bf16*)(ws + OFF_G) + idx, v);
    } else if constexpr (KIND == EPI_BR0 || KIND == EPI_BR1 || KIND == EPI_BR2) {
#pragma unroll
        for (int i = 0; i < W; ++i) { v[i] = pa[i] * a[i]; if (KIND != EPI_BR0) v[i] += pb[i]; }
        if constexpr (KIND == EPI_BR2) store_bf<W>((bf16*)(ws + OFF_MERGED) + idx, v);
        else store_bf<W>((bf16*)(ws + OFF_T) + idx, v);
    } else if constexpr (KIND == EPI_OUT) {
#pragma unroll
        for (int i = 0; i < W; ++i) v[i] = pa[i] + a[i];
        store_bf<W>((bf16*)(ws + OFF_X1B) + idx, v);
    } else if constexpr (KIND == EPI_U) {
        store_bf<W>((bf16*)(ws + OFF_U) + idx, a);
    } else if constexpr (KIND == EPI_PLE) {
#pragma unroll
        for (int i = 0; i < W; ++i) v[i] = pa[i] + sigmoidf_(a[i]) * pb[i];
        st_f32x8(E.X + idx, v);
    }
}

__device__ __forceinline__ void d_xprep(int vb, int vt, const float* x, unsigned char* ws) {
    const int row = vb * 4 + (vt >> 6), lane = vt & 63;
    const f32x4* xr = (const f32x4*)(x + (size_t)row * 1024) + lane; float ss = 0.f;
    bf16* o = (bf16*)(ws + OFF_XB) + (size_t)row * 1024;
    f32x4 v[4];
#pragma unroll
    for (int j = 0; j < 4; ++j) { v[j] = xr[64 * j]; ss += (v[j][0] * v[j][0] + v[j][1] * v[j][1]) + (v[j][2] * v[j][2] + v[j][3] * v[j][3]); }
#pragma unroll
    for (int of = 1; of < 64; of <<= 1) ss += __shfl_xor(ss, of);
    const float rs = rsqrtf(ss * (1.f / 1024.f) + EPS);
#pragma unroll
    for (int j = 0; j < 4; ++j) { float t[4] = {v[j][0] * rs, v[j][1] * rs, v[j][2] * rs, v[j][3] * rs}; store_bf<4>(o + 256 * j + 4 * lane, t); }
}
__device__ __forceinline__ void d_sumsq(int vb, int vt, const float* x, unsigned char* ws) {
    const int row = vb * 4 + (vt >> 6), lane = vt & 63;
    const f32x4* xr = (const f32x4*)(x + (size_t)row * 1024) + lane; float ss = 0.f;
    bf16* o = (bf16*)(ws + OFF_XB) + (size_t)row * 1024;
    f32x4 v[4];
#pragma unroll
    for (int j = 0; j < 4; ++j) { v[j] = xr[64 * j]; ss += (v[j][0] * v[j][0] + v[j][1] * v[j][1]) + (v[j][2] * v[j][2] + v[j][3] * v[j][3]); }
#pragma unroll
    for (int of = 1; of < 64; of <<= 1) ss += __shfl_xor(ss, of);
    const float rs = rsqrtf(ss * (1.f / 1024.f) + EPS);
#pragma unroll
    for (int j = 0; j < 4; ++j) { float t[4] = {v[j][0] * rs, v[j][1] * rs, v[j][2] * rs, v[j][3] * rs}; store_bf<4>(o + 256 * j + 4 * lane, t); }
}
__device__ __forceinline__ void d_rope_table(int vb, int vt, const int* pos, unsigned char* ws) {
    const int idx = vb * 256 + vt, row = idx >> 5, i = idx & 31;
    const float inv = exp2f(-(float)i * (13.287712379549449f / 32.f));
    const float ang = (float)pos[row] * inv;
    float s, c; sincosf(ang, &s, &c);
    ((float*)(ws + OFF_COS))[idx] = c; ((float*)(ws + OFF_SIN))[idx] = s;
}
__device__ __forceinline__ void d_pconv(int vb, int vt, const float* p, unsigned char* ws) {
    const size_t i = ((size_t)vb * 256 + vt) * 4;
    const f32x4 v = *(const f32x4*)(p + i); float t[4] = {v[0], v[1], v[2], v[3]}; store_bf<4>((bf16*)(ws + OFF_PB) + i, t);
}
constexpr size_t OFF_CBPART = OFF_CTL + 65536;
__device__ __forceinline__ void d_cb1_part(int u, int vt, const float* pe_k, const float* w1_k, const float* pe_v, const float* w1_v, unsigned char* ws) {
    const int kv = u >> 4, kc = u & 15, j = vt;
    const float* pe = (kv ? pe_v : pe_k) + 128 * kc; const float* w1 = (kv ? w1_v : w1_k) + (size_t)(128 * kc) * 256 + j;
    float acc = 0.f;
#pragma unroll 16
    for (int k = 0; k < 128; ++k) acc += pe[k] * w1[(size_t)k * 256];
    ((float*)(ws + OFF_CBPART))[(kv * 16 + kc) * 256 + j] = acc;
}
__device__ __forceinline__ void d_cb1_sum(int vt, const float* b1_k, const float* b1_v, unsigned char* ws) {
    const int kv = vt >> 8, j = vt & 255; float acc = (kv ? b1_v : b1_k)[j];
#pragma unroll
    for (int kc = 0; kc < 16; ++kc) acc += ((const float*)(ws + OFF_CBPART))[(kv * 16 + kc) * 256 + j];
    ((float*)(ws + OFF_CB1))[kv * 256 + j] = acc;
}
__device__ __forceinline__ void d_lam(int vt, const float* dl, unsigned char* ws, int l) {
    if (vt == 0) { float s1 = 0.f, s2 = 0.f; for (int i = 0; i < 64; ++i) { s1 += dl[i] * dl[64 + i]; s2 += dl[128 + i] * dl[192 + i]; }
        const float li = 0.8f - 0.6f * expf(-0.3f * (float)l); ((float*)(ws + OFF_CTL))[CTL_LAM + l] = expf(s1) - expf(s2) + li; }
}
__device__ __forceinline__ void d_final(int vb, int vt, float* X, const float* g) {
    const int row = vb * 4 + (vt >> 6), lane = vt & 63;
    f32x4* xr = (f32x4*)(X + (size_t)row * 1024) + lane; f32x4 v[4]; float ss = 0.f;
#pragma unroll
    for (int j = 0; j < 4; ++j) { v[j] = xr[64 * j]; ss += (v[j][0] * v[j][0] + v[j][1] * v[j][1]) + (v[j][2] * v[j][2] + v[j][3] * v[j][3]); }
#pragma unroll
    for (int of = 1; of < 64; of <<= 1) ss += __shfl_xor(ss, of);
    const float rs = rsqrtf(ss * (1.f / 1024.f) + EPS);
#pragma unroll
    for (int j = 0; j < 4; ++j) { const f32x4 gg = *((const f32x4*)g + 64 * j + lane); xr[64 * j] = v[j] * rs * gg; }
}


namespace pg8 {
#define PG8_LAS __attribute__((address_space(3)))
typedef unsigned short bf16_t;
typedef short bf16x8 __attribute__((ext_vector_type(8)));
typedef float f32x4 __attribute__((ext_vector_type(4)));
typedef unsigned u32x4 __attribute__((ext_vector_type(4)));
constexpr int BM = 256, BK = 64, HALF = 128, HTB = HALF * BK * 2  , STAGE_BYTES = 8 * HTB, NXCD = 8, WGM = 8;

__host__ __device__ __forceinline__ int lds_byte(int r, int c) { const int st = (r >> 4) * 2 + (c >> 5), rr = r & 15, cc = c & 31, ob = rr * 64 + cc * 2; return st * 1024 + (ob ^ (((ob >> 9) & 1) << 5)); }
__host__ __device__ __forceinline__ void stage_rc(int b, int& R, int& C) { const int st = b / 1024, sb = b % 1024, swz = sb ^ (((sb >> 9) & 1) << 5); R = (st >> 1) * 16 + swz / 64; C = (st & 1) * 32 + (swz % 64) / 2; }
__host__ __device__ __forceinline__ int perm32(int rho) { const int n = rho >> 4, i = rho & 15; return 8 * (i >> 2) + 4 * n + (i & 3); }

struct Unit { int pm, pn; };
struct Gemm { const bf16_t* A; const bf16_t* Bt; int M, N, K; };

struct StaticOrder {
    int nM, nN, nwg, G, c;
    __host__ __device__ void init(int M, int N, int G_, int c_) { nM = M / BM; nN = N / BM; nwg = nM * nN; G = G_; c = c_; }
    __host__ __device__ bool next(int i, Unit& u) const {
        const long L = (long)i * G + c; if (L >= nwg) return false;
        int wgid = (int)L; { const int q = nwg / NXCD, r = nwg % NXCD, xcd = wgid % NXCD, off = wgid / NXCD; wgid = (xcd < r ? xcd * (q + 1) : r * (q + 1) + (xcd - r) * q) + off; }
        const int nig = WGM * nN, gid = wgid / nig, fm = gid * WGM, gsz = (nM - fm) < WGM ? (nM - fm) : WGM;
        u.pm = fm + ((wgid % nig) % gsz); u.pn = (wgid % nig) / gsz; return true;
    }
    __device__ __forceinline__ void a_ready(const Unit&) const {}
    __device__ __forceinline__ void done(const Unit&) const {}
};

__device__ __forceinline__ unsigned cvt_pk_bf16(float lo, float hi) { unsigned r; asm volatile("v_cvt_pk_bf16_f32 %0, %1, %2" : "=v"(r) : "v"(lo), "v"(hi)); return r; }
typedef float f32x2 __attribute__((ext_vector_type(2)));
template <class Epi, class Sched, bool ALIGN_EPI = false, bool SP2 = false>
__device__ __forceinline__ void gemm_phase(PG8_LAS unsigned char* lds, const Gemm g, const Sched& S, const Epi& E) {
    int tid_o = threadIdx.x; asm volatile("" : "+v"(tid_o));
    const int tid = tid_o, wid = __builtin_amdgcn_readfirstlane(tid >> 6), lane = tid & 63, wr = wid >> 2, wc = wid & 3, fr = lane & 15, fq = lane >> 4;
    const int K = g.K, nt = K / BK;
    unsigned voffA[2], voffB[2];
#pragma unroll
    for (int i = 0; i < 2; ++i) { int R, C; stage_rc(tid * 16 + i * 8192, R, C); const int Rb = Epi::PERM ? ((R & ~31) + perm32(R & 31)) : R;
        voffA[i] = (unsigned)(R * K + C) * 2u; voffB[i] = (unsigned)(Rb * K + C) * 2u; }
    const size_t kstep = (size_t)(BK * 2);
    const size_t hstep = (size_t)HALF * K * 2;
    const size_t tstep = 2 * hstep;
    const unsigned ldsw = (unsigned)wid * 1024u;
    const int aoff = lds_byte(wr * 64 + fr, fq * 8), boff = lds_byte(wc * 32 + fr, fq * 8);
#define PG8_SA(b, h) (((b) * 2 + (h)) * HTB)
#define PG8_SB(b, h) ((4 + (b) * 2 + (h)) * HTB)
#define PG8_STAGE(bufoff, gbase, voff) do { _Pragma("unroll") for (int _i = 0; _i < 2; ++_i) \
        __builtin_amdgcn_global_load_lds((const unsigned*)((const char*)(gbase) + (voff)[_i]), (PG8_LAS unsigned*)(lds + (bufoff) + ldsw + _i * 8192), 16, 0, 0); } while (0)
#define PG8_LDA(dst, b, h) do { _Pragma("unroll") for (int m = 0; m < 4; ++m) _Pragma("unroll") for (int k = 0; k < 2; ++k) dst[m][k] = *(const PG8_LAS bf16x8*)(lds + PG8_SA(b, h) + aoff + m * 2048 + k * 1024); } while (0)
#define PG8_LDB(dst, b, h) do { _Pragma("unroll") for (int n = 0; n < 2; ++n) _Pragma("unroll") for (int k = 0; k < 2; ++k) dst[n][k] = *(const PG8_LAS bf16x8*)(lds + PG8_SB(b, h) + boff + n * 2048 + k * 1024); } while (0)
#define PG8_MMA(ai, bj, At, Bt) do { __builtin_amdgcn_s_setprio(1); _Pragma("unroll") for (int m = 0; m < 4; ++m) _Pragma("unroll") for (int n = 0; n < 2; ++n) _Pragma("unroll") for (int k = 0; k < 2; ++k) \
        acc[ai][bj][m][n] = __builtin_amdgcn_mfma_f32_16x16x32_bf16(Bt[n][k], At[m][k], acc[ai][bj][m][n], 0, 0, 0); __builtin_amdgcn_s_setprio(0); } while (0)
#define PG8_WAIT_V(n) asm volatile("s_waitcnt vmcnt(" #n ")" ::: "memory")
#define PG8_WAIT_L(n) asm volatile("s_waitcnt lgkmcnt(" #n ")" ::: "memory")
#define PG8_BAR __builtin_amdgcn_s_barrier()
#define PG8_SCHED __builtin_amdgcn_sched_barrier(0)
    Unit cur, nxt; int ui = 0;
    if (!S.next(0, cur)) return;
    f32x4 acc[2][2][4][2];
#pragma unroll
    for (int a = 0; a < 2; ++a)
#pragma unroll
        for (int b = 0; b < 2; ++b)
#pragma unroll
            for (int m = 0; m < 4; ++m)
#pragma unroll
                for (int n = 0; n < 2; ++n) acc[a][b][m][n] = (f32x4){0.f, 0.f, 0.f, 0.f};
    bf16x8 At[4][2], B0[2][2], B1[2][2];
    const char* cA = (const char*)g.A + (size_t)cur.pm * tstep; const char* cB = (const char*)g.Bt + (size_t)cur.pn * tstep;
    S.a_ready(cur);
    if constexpr (SP2) {
        PG8_STAGE(PG8_SB(0, 0), cB, voffB); PG8_STAGE(PG8_SB(0, 1), cB + hstep, voffB); PG8_STAGE(PG8_SA(0, 0), cA, voffA); PG8_STAGE(PG8_SA(0, 1), cA + hstep, voffA);
        if (wr == 1) PG8_BAR;
        PG8_WAIT_V(2); PG8_BAR;
        PG8_STAGE(PG8_SB(1, 0), cB + kstep, voffB); PG8_STAGE(PG8_SA(1, 0), cA + kstep, voffA); PG8_STAGE(PG8_SB(1, 1), cB + hstep + kstep, voffB);
        PG8_WAIT_V(6); PG8_BAR;
    } else {
        PG8_STAGE(PG8_SB(0, 0), cB, voffB); PG8_STAGE(PG8_SA(0, 0), cA, voffA); PG8_STAGE(PG8_SB(0, 1), cB + hstep, voffB); PG8_STAGE(PG8_SA(0, 1), cA + hstep, voffA);
        if (wr == 1) PG8_BAR;
        PG8_WAIT_V(4); PG8_BAR;
        PG8_STAGE(PG8_SB(1, 0), cB + kstep, voffB); PG8_STAGE(PG8_SA(1, 0), cA + kstep, voffA); PG8_STAGE(PG8_SB(1, 1), cB + hstep + kstep, voffB);
        PG8_WAIT_V(6); PG8_BAR;
    }
    for (;;) {
        const bool has_next = S.next(ui + 1, nxt);
        const char* nA = has_next ? (const char*)g.A + (size_t)nxt.pm * tstep : cA; const char* nB = has_next ? (const char*)g.Bt + (size_t)nxt.pn * tstep : cB;
        for (int t = 0; t < nt; t += 2) {
            const bool last = (t == nt - 2);
            const char* a1 = cA + (size_t)(t + 1) * kstep;
            const char* a2 = last ? nA : cA + (size_t)(t + 2) * kstep; const char* b2 = last ? nB : cB + (size_t)(t + 2) * kstep;
            const char* a3 = a2 + kstep; const char* b3 = b2 + kstep;
            if (last && has_next) S.a_ready(nxt);
            if constexpr (SP2) {
            PG8_LDB(B0, 0, 0); PG8_LDB(B1, 0, 1); PG8_SCHED; PG8_LDA(At, 0, 0); PG8_STAGE(PG8_SA(1, 1), a1 + hstep, voffA);
            PG8_WAIT_V(8); PG8_WAIT_L(0); PG8_BAR; PG8_MMA(0, 0, At, B0); PG8_MMA(0, 1, At, B1); PG8_BAR; PG8_SCHED;
            PG8_LDA(At, 0, 1); PG8_STAGE(PG8_SB(0, 0), b2, voffB); PG8_STAGE(PG8_SB(0, 1), b2 + hstep, voffB); PG8_STAGE(PG8_SA(0, 0), a2, voffA);
            PG8_WAIT_V(8); PG8_WAIT_L(0); PG8_BAR; PG8_MMA(1, 0, At, B0); PG8_MMA(1, 1, At, B1); PG8_BAR; PG8_SCHED;
            PG8_LDB(B0, 1, 0); PG8_LDB(B1, 1, 1); PG8_SCHED; PG8_LDA(At, 1, 0); PG8_STAGE(PG8_SA(0, 1), a2 + hstep, voffA);
            PG8_WAIT_V(8); PG8_WAIT_L(0); PG8_BAR; PG8_MMA(0, 0, At, B0); PG8_MMA(0, 1, At, B1); PG8_BAR; PG8_SCHED;
            PG8_LDA(At, 1, 1); PG8_STAGE(PG8_SB(1, 0), b3, voffB); PG8_STAGE(PG8_SB(1, 1), b3 + hstep, voffB); PG8_STAGE(PG8_SA(1, 0), a3, voffA);
            PG8_WAIT_V(8); PG8_WAIT_L(0); PG8_BAR; PG8_MMA(1, 0, At, B0); PG8_MMA(1, 1, At, B1); PG8_BAR; PG8_SCHED;
            } else {
            PG8_LDB(B0, 0, 0); PG8_SCHED; PG8_LDA(At, 0, 0); PG8_STAGE(PG8_SA(1, 1), a1 + hstep, voffA);
            PG8_WAIT_L(8); PG8_BAR; PG8_WAIT_L(0); PG8_MMA(0, 0, At, B0); PG8_BAR; PG8_SCHED;
            PG8_LDB(B1, 0, 1); PG8_STAGE(PG8_SB(0, 0), b2, voffB);
            PG8_BAR; PG8_WAIT_L(0); PG8_MMA(0, 1, At, B1); PG8_BAR;
            PG8_LDA(At, 0, 1); PG8_STAGE(PG8_SA(0, 0), a2, voffA);
            PG8_BAR; PG8_WAIT_L(0); PG8_MMA(1, 0, At, B0); PG8_BAR; PG8_SCHED;
            PG8_STAGE(PG8_SB(0, 1), b2 + hstep, voffB);
            PG8_WAIT_V(6); PG8_BAR; PG8_MMA(1, 1, At, B1); PG8_BAR;
            PG8_LDB(B0, 1, 0); PG8_SCHED; PG8_LDA(At, 1, 0); PG8_STAGE(PG8_SA(0, 1), a2 + hstep, voffA);
            PG8_WAIT_L(8); PG8_BAR; PG8_WAIT_L(0); PG8_MMA(0, 0, At, B0); PG8_BAR; PG8_SCHED;
            PG8_LDB(B1, 1, 1); PG8_STAGE(PG8_SB(1, 0), b3, voffB);
            PG8_BAR; PG8_WAIT_L(0); PG8_MMA(0, 1, At, B1); PG8_BAR;
            PG8_LDA(At, 1, 1); PG8_STAGE(PG8_SA(1, 0), a3, voffA);
            PG8_BAR; PG8_WAIT_L(0); PG8_MMA(1, 0, At, B0); PG8_BAR; PG8_SCHED;
            PG8_STAGE(PG8_SB(1, 1), b3 + hstep, voffB);
            PG8_WAIT_V(6); PG8_BAR; PG8_MMA(1, 1, At, B1); PG8_BAR;
            }
        }
        if constexpr (ALIGN_EPI) { if (wr == 0) PG8_BAR; }
        if constexpr (!Epi::AFTER_DRAIN) { E(acc, cur, wr, wc, fr, fq); S.done(cur); }
        if (!has_next) break;
#pragma unroll
        for (int a = 0; a < 2; ++a)
#pragma unroll
            for (int b = 0; b < 2; ++b)
#pragma unroll
                for (int m = 0; m < 4; ++m)
#pragma unroll
                    for (int n = 0; n < 2; ++n) acc[a][b][m][n] = (f32x4){0.f, 0.f, 0.f, 0.f};
        cur = nxt; cA = nA; cB = nB; ++ui;
        if constexpr (ALIGN_EPI) { if (wr == 1) PG8_BAR; }
    }
    PG8_WAIT_V(0);
    if constexpr (!ALIGN_EPI) { if (wr == 0) PG8_BAR; }
    PG8_BAR;
    if constexpr (Epi::AFTER_DRAIN) { E.fused(acc, cur, wr, wc, fr, fq, lds, wid, lane); S.done(cur); }
#undef PG8_SA
#undef PG8_SB
#undef PG8_STAGE
#undef PG8_LDA
#undef PG8_LDB
#undef PG8_MMA
#undef PG8_WAIT_V
#undef PG8_WAIT_L
#undef PG8_BAR
#undef PG8_SCHED
}
}

template <int KIND> struct EpiFast {
    static constexpr bool PERM = true, AFTER_DRAIN = false;
    EpiCtx E;
    template <int T, int AI, int MH> __device__ __forceinline__ void grp_load(int row0, int col0, Pre (&p)[4]) const {
        const int r0 = row0 + AI * 128 + (2 * MH) * 16, r1 = r0 + 16;
        p[0].rs = p[1].rs = p[2].rs = p[3].rs = 1.f;
        pre_load<KIND, T>(E, r0, col0, p[0]); pre_load<KIND, T>(E, r0, col0 + 128, p[1]); pre_load<KIND, T>(E, r1, col0, p[2]); pre_load<KIND, T>(E, r1, col0 + 128, p[3]);
        asm volatile("" ::: "memory");
    }
    template <int T, int AI, int MH> __device__ __forceinline__ void grp_emit(const pg8::f32x4 (&acc)[2][2][4][2], int row0, int col0, const Pre (&p)[4]) const {
        const int r0 = row0 + AI * 128 + (2 * MH) * 16, r1 = r0 + 16;
        { const pg8::f32x4 v0 = acc[AI][0][2 * MH][0], v1 = acc[AI][0][2 * MH][1]; float v[8] = {v0[0], v0[1], v0[2], v0[3], v1[0], v1[1], v1[2], v1[3]}; emit_fin<KIND, T>(E, r0, col0, v, p[0]); }
        { const pg8::f32x4 v0 = acc[AI][1][2 * MH][0], v1 = acc[AI][1][2 * MH][1]; float v[8] = {v0[0], v0[1], v0[2], v0[3], v1[0], v1[1], v1[2], v1[3]}; emit_fin<KIND, T>(E, r0, col0 + 128, v, p[1]); }
        { const pg8::f32x4 v0 = acc[AI][0][2 * MH + 1][0], v1 = acc[AI][0][2 * MH + 1][1]; float v[8] = {v0[0], v0[1], v0[2], v0[3], v1[0], v1[1], v1[2], v1[3]}; emit_fin<KIND, T>(E, r1, col0, v, p[2]); }
        { const pg8::f32x4 v0 = acc[AI][1][2 * MH + 1][0], v1 = acc[AI][1][2 * MH + 1][1]; float v[8] = {v0[0], v0[1], v0[2], v0[3], v1[0], v1[1], v1[2], v1[3]}; emit_fin<KIND, T>(E, r1, col0 + 128, v, p[3]); }
        asm volatile("" ::: "memory");
    }
    template <int T> __device__ __forceinline__ void run(const pg8::f32x4 (&acc)[2][2][4][2], int row0, int col0) const {
        Pre pA[4], pB[4];
        grp_load<T, 0, 0>(row0, col0, pA); grp_load<T, 0, 1>(row0, col0, pB);
        grp_emit<T, 0, 0>(acc, row0, col0, pA); grp_load<T, 1, 0>(row0, col0, pA);
        grp_emit<T, 0, 1>(acc, row0, col0, pB); grp_load<T, 1, 1>(row0, col0, pB);
        grp_emit<T, 1, 0>(acc, row0, col0, pA); grp_emit<T, 1, 1>(acc, row0, col0, pB);
    }
    __device__ __forceinline__ void operator()(const pg8::f32x4 (&acc)[2][2][4][2], const pg8::Unit& u, int wr, int wc, int fr, int fq) const {
        const int row0 = u.pm * 256 + wr * 64 + fr, col0 = u.pn * 256 + wc * 32 + 8 * fq;
        if constexpr (KIND == EPI_INPROJ) {
            switch (inproj_type(u.pn)) {
                case T_QA: run<T_QA>(acc, row0, col0); break;
                case T_KA: run<T_KA>(acc, row0, col0); break;
                case T_VA: run<T_VA>(acc, row0, col0); break;
                case T_ZA: run<T_ZA>(acc, row0, col0); break;
                case T_QB: run<T_QB>(acc, row0, col0); break;
                case T_CB: run<T_CB>(acc, row0, col0); break;
                case T_KROPE: run<T_KROPE>(acc, row0, col0); break;
                case T_VSW: run<T_VSW>(acc, row0, col0); break;
                case T_ZB: run<T_ZB>(acc, row0, col0); break;
                case T_QC: run<T_QC>(acc, row0, col0); break;
                case T_KC: run<T_KC>(acc, row0, col0); break;
                case T_VC: run<T_VC>(acc, row0, col0); break;
                case T_ZC: run<T_ZC>(acc, row0, col0); break;
                default: run<T_SPECIAL>(acc, row0, col0); break;
            }
        } else if constexpr (KIND == EPI_GATE3 || KIND == EPI_BR3) {
            EpiFast<KIND> t = *this; t.E.gi = u.pn >> 2;
            t.template run<0>(acc, (u.pm & 63) * 256 + wr * 64 + fr, (u.pn & 3) * 256 + wc * 32 + 8 * fq);
        } else run<0>(acc, row0, col0);
    }
};
struct ChainOrder {
    int pm, pn4, rowmul;
    __device__ __forceinline__ void init(int G, int c, int rowmul_) { pg8::StaticOrder S0; S0.init(M, 1024, G, c); pg8::Unit u0; S0.next(0, u0); pm = u0.pm; pn4 = u0.pn; rowmul = rowmul_; }
    __device__ __forceinline__ bool next(int i, pg8::Unit& u) const { if (i >= 3) return false; u.pm = pm + 64 * i * rowmul; u.pn = 4 * i + pn4; return true; }
    __device__ __forceinline__ void a_ready(const pg8::Unit&) const {}
    __device__ __forceinline__ void done(const pg8::Unit&) const {}
};
#define FAST_GEMM(KIND, Aptr, Bptr, N_, K_, ALIGN) do { pg8::Gemm g_{(const pg8::bf16_t*)(Aptr), (const pg8::bf16_t*)(Bptr), M, (N_), (K_)}; pg8::StaticOrder S_; S_.init(M, (N_), (int)gridDim.x, (int)blockIdx.x); \
        EpiFast<KIND> Ep_{E}; pg8::gemm_phase<EpiFast<KIND>, pg8::StaticOrder, ALIGN, true>((PG8_LAS unsigned char*)lds, g_, S_, Ep_); } while (0)

#define LAS __attribute__((address_space(3)))
typedef short s16x4 __attribute__((ext_vector_type(4)));
typedef short v4i16_t __attribute__((ext_vector_type(4)));
typedef LAS const char* lds_cptr;
constexpr int A_KRING = 0, A_VRING = 49152, A_CFRING = 98304, A_MISC = 104448;
constexpr int A_SLOT = 16384;
constexpr int A_IMP = A_MISC, A_SELM = A_MISC + 16384, A_UMASK = A_SELM + 512, A_SEQ = A_UMASK + 16, A_WQ = A_SEQ + 80;
__device__ __forceinline__ void glds16(const void* gsrc, unsigned lds_dst) { unsigned keep;
    asm volatile("s_mov_b32 %0, m0\n\ts_mov_b32 m0, %2\n\ts_nop 0\n\tglobal_load_lds_dwordx4 %1, off\n\ts_mov_b32 m0, %0" : "=&s"(keep) : "v"(gsrc), "s"(lds_dst) : "memory"); }
__device__ __forceinline__ void glds4(const void* gsrc, unsigned lds_dst) { unsigned keep;
    asm volatile("s_mov_b32 %0, m0\n\ts_mov_b32 m0, %2\n\ts_nop 0\n\tglobal_load_lds_dword %1, off\n\ts_mov_b32 m0, %0" : "=&s"(keep) : "v"(gsrc), "s"(lds_dst) : "memory"); }
#define A_WAIT_BAR(N) asm volatile("s_waitcnt vmcnt(" #N ") lgkmcnt(0)\n\ts_barrier" ::: "memory")
constexpr int LDS_QSLOT = 131072 + 128;
#define Q_TAKE(qn, qc) unsigned qn = 0u; if (tid == 0) qn = __hip_atomic_fetch_add((qc), 1u, __ATOMIC_RELAXED, __HIP_MEMORY_SCOPE_AGENT)
#define Q_PARK(qn) do { if (tid == 0) *(volatile LAS unsigned*)((LAS unsigned char*)lds + LDS_QSLOT) = qn; } while (0)
__device__ __forceinline__ s16x4 vtr(lds_cptr p) { return __builtin_bit_cast(s16x4, __builtin_amdgcn_ds_read_tr16_b64_v4i16((LAS v4i16_t*)p)); }
__device__ __forceinline__ unsigned cvtpk(float lo, float hi) { typedef float f2 __attribute__((ext_vector_type(2))); typedef __bf16 b2 __attribute__((ext_vector_type(2))); f2 v = {lo, hi}; b2 b = __builtin_convertvector(v, b2); return __builtin_bit_cast(unsigned, b); }
__device__ __forceinline__ int crow(int r, int hi) { return (r & 3) + 8 * (r >> 2) + 4 * hi; }

template <int NDB> struct FlashSt { f32x16 o[NDB]; float m, l; };
template <int NDB> __device__ __forceinline__ void flash_init(FlashSt<NDB>& st) {
#pragma unroll
    for (int i = 0; i < NDB; ++i)
#pragma unroll
        for (int r = 0; r < 16; ++r) st.o[i][r] = 0.f;
    st.m = -1e30f; st.l = 0.f;
}
template <int NDB> __device__ __forceinline__ void flash_init3(FlashSt<NDB>& st) { flash_init<NDB>(st); st.m = 0.f; }
__device__ __forceinline__ void qk_tile(f32x16& p0, f32x16& p1, lds_cptr kslot, const bf16x8 (&qf)[4], int r32, int hi) {
    const lds_cptr kb = kslot + hi * 1024 + r32 * 16;
    bf16x8 ka[4], kc[4];
#pragma unroll
    for (int d0 = 0; d0 < 4; ++d0) { ka[d0] = *(const LAS bf16x8*)(kb + d0 * 2048); kc[d0] = *(const LAS bf16x8*)(kb + d0 * 2048 + 512); }
#pragma unroll
    for (int d0 = 0; d0 < 4; ++d0) {
        p0 = __builtin_amdgcn_mfma_f32_32x32x16_bf16(ka[d0], qf[d0], p0, 0, 0, 0);
        p1 = __builtin_amdgcn_mfma_f32_32x32x16_bf16(kc[d0], qf[d0], p1, 0, 0, 0);
    }
}
__device__ __forceinline__ float xhalf_max(float a) {
    auto rr = __builtin_amdgcn_permlane32_swap(__float_as_uint(a), __float_as_uint(a), false, false);
    return fmaxf(__uint_as_float(rr[0]), __uint_as_float(rr[1]));
}
__device__ __forceinline__ float rowmax32(const f32x16& p0, const f32x16& p1) {
    float a = fmaxf(p0[0], p1[0]);
#pragma unroll
    for (int r = 1; r < 16; ++r) a = fmaxf(a, fmaxf(p0[r], p1[r]));
    return xhalf_max(a);
}
template <int NDB> __device__ __forceinline__ void pv_tile(f32x16 (&o)[NDB], lds_cptr vslot_l, const f32x16& p0, const f32x16& p1) {
    bf16x8 pf[4];
    { u32x4 w;
      w.x = cvtpk(p0[0], p0[1]); w.y = cvtpk(p0[2], p0[3]); w.z = cvtpk(p0[4], p0[5]); w.w = cvtpk(p0[6], p0[7]); pf[0] = __builtin_bit_cast(bf16x8, w);
      w.x = cvtpk(p0[8], p0[9]); w.y = cvtpk(p0[10], p0[11]); w.z = cvtpk(p0[12], p0[13]); w.w = cvtpk(p0[14], p0[15]); pf[1] = __builtin_bit_cast(bf16x8, w);
      w.x = cvtpk(p1[0], p1[1]); w.y = cvtpk(p1[2], p1[3]); w.z = cvtpk(p1[4], p1[5]); w.w = cvtpk(p1[6], p1[7]); pf[2] = __builtin_bit_cast(bf16x8, w);
      w.x = cvtpk(p1[8], p1[9]); w.y = cvtpk(p1[10], p1[11]); w.z = cvtpk(p1[12], p1[13]); w.w = cvtpk(p1[14], p1[15]); pf[3] = __builtin_bit_cast(bf16x8, w); }
#pragma unroll
    for (int db = 0; db < NDB; ++db) {
        bf16x8 vf[4];
#pragma unroll
        for (int ks = 0; ks < 4; ++ks) { const s16x4 lo = vtr(vslot_l + db * 4096 + ks * 1024), hh = vtr(vslot_l + db * 4096 + ks * 1024 + 512);
            vf[ks] = (bf16x8){lo[0], lo[1], lo[2], lo[3], hh[0], hh[1], hh[2], hh[3]}; }
#pragma unroll
        for (int ks = 0; ks < 4; ++ks) o[db] = __builtin_amdgcn_mfma_f32_32x32x16_bf16(vf[ks], pf[ks], o[db], 0, 0, 0);
    }
}
template <int NDB> __device__ __forceinline__ void flash_update(FlashSt<NDB>& st, f32x16& p0, f32x16& p1, lds_cptr vslot_l) {
    const float rm = rowmax32(p0, p1);
    const float mn = fmaxf(st.m, rm), alpha = __builtin_amdgcn_exp2f(st.m - mn);
    st.m = mn;
    float ls = 0.f;
#pragma unroll
    for (int r = 0; r < 16; ++r) { p0[r] = __builtin_amdgcn_exp2f(p0[r] - mn); p1[r] = __builtin_amdgcn_exp2f(p1[r] - mn); ls += p0[r] + p1[r]; }
    st.l = st.l * alpha + ls;
#pragma unroll
    for (int db = 0; db < NDB; ++db)
#pragma unroll
        for (int r = 0; r < 16; ++r) st.o[db][r] *= alpha;
    pv_tile<NDB>(st.o, vslot_l, p0, p1);
}
__device__ __forceinline__ int lane_vbase(int lane) { return ((lane >> 4) & 1) * 32 + (lane & 3) * 8 + (4 * (lane >> 5) + ((lane & 15) >> 2)) * 64; }
#define DSR128(dst, addr, off) asm volatile("ds_read_b128 %0, %1 offset:%c2" : "=v"(dst) : "v"(addr), "i"(off) : "memory")
#define DSRTR(dst, addr, off) asm volatile("ds_read_b64_tr_b16 %0, %1 offset:%c2" : "=v"(dst) : "v"(addr), "i"(off) : "memory")
#define LGKM_WAIT0() do { asm volatile("s_waitcnt lgkmcnt(0)" ::: "memory"); __builtin_amdgcn_sched_barrier(0); } while (0)
__device__ __forceinline__ void qk_tile2(f32x16& p0, f32x16& p1, unsigned kaddr, const bf16x8 (&qf)[4]) {
    bf16x8 ka0, ka1, ka2, ka3, kc0, kc1, kc2, kc3;
    DSR128(ka0, kaddr, 0); DSR128(kc0, kaddr, 512); DSR128(ka1, kaddr, 2048); DSR128(kc1, kaddr, 2560);
    DSR128(ka2, kaddr, 4096); DSR128(kc2, kaddr, 4608); DSR128(ka3, kaddr, 6144); DSR128(kc3, kaddr, 6656);
    LGKM_WAIT0();
    __builtin_amdgcn_s_setprio(1);
    p0 = __builtin_amdgcn_mfma_f32_32x32x16_bf16(ka0, qf[0], p0, 0, 0, 0); p1 = __builtin_amdgcn_mfma_f32_32x32x16_bf16(kc0, qf[0], p1, 0, 0, 0);
    p0 = __builtin_amdgcn_mfma_f32_32x32x16_bf16(ka1, qf[1], p0, 0, 0, 0); p1 = __builtin_amdgcn_mfma_f32_32x32x16_bf16(kc1, qf[1], p1, 0, 0, 0);
    p0 = __builtin_amdgcn_mfma_f32_32x32x16_bf16(ka2, qf[2], p0, 0, 0, 0); p1 = __builtin_amdgcn_mfma_f32_32x32x16_bf16(kc2, qf[2], p1, 0, 0, 0);
    p0 = __builtin_amdgcn_mfma_f32_32x32x16_bf16(ka3, qf[3], p0, 0, 0, 0); p1 = __builtin_amdgcn_mfma_f32_32x32x16_bf16(kc3, qf[3], p1, 0, 0, 0);
    __builtin_amdgcn_s_setprio(0);
}
struct VFr { s16x4 lo[8], hi[8]; };
template <int DB0> __device__ __forceinline__ void v_issue(VFr& f, unsigned vaddr) {
    DSRTR(f.lo[0], vaddr, DB0 * 4096 + 0);    DSRTR(f.hi[0], vaddr, DB0 * 4096 + 512);
    DSRTR(f.lo[1], vaddr, DB0 * 4096 + 1024); DSRTR(f.hi[1], vaddr, DB0 * 4096 + 1536);
    DSRTR(f.lo[2], vaddr, DB0 * 4096 + 2048); DSRTR(f.hi[2], vaddr, DB0 * 4096 + 2560);
    DSRTR(f.lo[3], vaddr, DB0 * 4096 + 3072); DSRTR(f.hi[3], vaddr, DB0 * 4096 + 3584);
    DSRTR(f.lo[4], vaddr, DB0 * 4096 + 4096); DSRTR(f.hi[4], vaddr, DB0 * 4096 + 4608);
    DSRTR(f.lo[5], vaddr, DB0 * 4096 + 5120); DSRTR(f.hi[5], vaddr, DB0 * 4096 + 5632);
    DSRTR(f.lo[6], vaddr, DB0 * 4096 + 6144); DSRTR(f.hi[6], vaddr, DB0 * 4096 + 6656);
    DSRTR(f.lo[7], vaddr, DB0 * 4096 + 7168); DSRTR(f.hi[7], vaddr, DB0 * 4096 + 7680);
}
#define VFRAG(f, i) ((bf16x8){(f).lo[i][0], (f).lo[i][1], (f).lo[i][2], (f).lo[i][3], (f).hi[i][0], (f).hi[i][1], (f).hi[i][2], (f).hi[i][3]})
__device__ __forceinline__ void pv2(f32x16& oa, f32x16& ob, const VFr& f, const bf16x8 (&pf)[4]) {
    __builtin_amdgcn_s_setprio(1);
    oa = __builtin_amdgcn_mfma_f32_32x32x16_bf16(VFRAG(f, 0), pf[0], oa, 0, 0, 0); ob = __builtin_amdgcn_mfma_f32_32x32x16_bf16(VFRAG(f, 4), pf[0], ob, 0, 0, 0);
    oa = __builtin_amdgcn_mfma_f32_32x32x16_bf16(VFRAG(f, 1), pf[1], oa, 0, 0, 0); ob = __builtin_amdgcn_mfma_f32_32x32x16_bf16(VFRAG(f, 5), pf[1], ob, 0, 0, 0);
    oa = __builtin_amdgcn_mfma_f32_32x32x16_bf16(VFRAG(f, 2), pf[2], oa, 0, 0, 0); ob = __builtin_amdgcn_mfma_f32_32x32x16_bf16(VFRAG(f, 6), pf[2], ob, 0, 0, 0);
    oa = __builtin_amdgcn_mfma_f32_32x32x16_bf16(VFRAG(f, 3), pf[3], oa, 0, 0, 0); ob = __builtin_amdgcn_mfma_f32_32x32x16_bf16(VFRAG(f, 7), pf[3], ob, 0, 0, 0);
    __builtin_amdgcn_s_setprio(0);
}
__device__ __forceinline__ void pack_p(bf16x8 (&pf)[4], const f32x16& p0, const f32x16& p1) {
    u32x4 w;
    w.x = cvtpk(p0[0], p0[1]); w.y = cvtpk(p0[2], p0[3]); w.z = cvtpk(p0[4], p0[5]); w.w = cvtpk(p0[6], p0[7]); pf[0] = __builtin_bit_cast(bf16x8, w);
    w.x = cvtpk(p0[8], p0[9]); w.y = cvtpk(p0[10], p0[11]); w.z = cvtpk(p0[12], p0[13]); w.w = cvtpk(p0[14], p0[15]); pf[1] = __builtin_bit_cast(bf16x8, w);
    w.x = cvtpk(p1[0], p1[1]); w.y = cvtpk(p1[2], p1[3]); w.z = cvtpk(p1[4], p1[5]); w.w = cvtpk(p1[6], p1[7]); pf[2] = __builtin_bit_cast(bf16x8, w);
    w.x = cvtpk(p1[8], p1[9]); w.y = cvtpk(p1[10], p1[11]); w.z = cvtpk(p1[12], p1[13]); w.w = cvtpk(p1[14], p1[15]); pf[3] = __builtin_bit_cast(bf16x8, w);
}
template <int NDB> __device__ __forceinline__ void flash_update2(FlashSt<NDB>& st, f32x16& p0, f32x16& p1, unsigned vaddr) {
    VFr vf; v_issue<0>(vf, vaddr);
    const float rm = rowmax32(p0, p1);
    const float mn = fmaxf(st.m, rm), alpha = __builtin_amdgcn_exp2f(st.m - mn);
    st.m = mn;
    float ls = 0.f;
#pragma unroll
    for (int r = 0; r < 16; ++r) { p0[r] = __builtin_amdgcn_exp2f(p0[r] - mn); p1[r] = __builtin_amdgcn_exp2f(p1[r] - mn); ls += p0[r] + p1[r]; }
    st.l = st.l * alpha + ls;
#pragma unroll
    for (int db = 0; db < NDB; ++db)
#pragma unroll
        for (int r = 0; r < 16; ++r) st.o[db][r] *= alpha;
    bf16x8 pf[4]; pack_p(pf, p0, p1);
    LGKM_WAIT0();
    pv2(st.o[0], st.o[1], vf, pf);
    if constexpr (NDB == 4) { v_issue<2>(vf, vaddr); LGKM_WAIT0(); pv2(st.o[2], st.o[3], vf, pf); }
}
__device__ __forceinline__ float max3_(float a, float b, float c) { float r; asm("v_max3_f32 %0, %1, %2, %3" : "=v"(r) : "v"(a), "v"(b), "v"(c)); return r; }
__device__ __forceinline__ float rowmax32_asm(const f32x16& p0, const f32x16& p1) {
    float a = max3_(p0[0], p0[1], p1[0]), b = max3_(p0[2], p0[3], p1[1]); a = max3_(a, p1[2], p1[3]);
#pragma unroll
    for (int r = 4; r < 16; r += 4) { a = max3_(a, p0[r], p0[r + 1]); b = max3_(b, p0[r + 2], p0[r + 3]); a = max3_(a, p1[r], p1[r + 1]); b = max3_(b, p1[r + 2], p1[r + 3]); }
    float m; asm("v_max_f32_e32 %0, %1, %2" : "=v"(m) : "v"(a), "v"(b));
    auto rr = __builtin_amdgcn_permlane32_swap(__float_as_uint(m), __float_as_uint(m), false, false);
    float o; asm("v_max_f32_e32 %0, %1, %2" : "=v"(o) : "v"(__uint_as_float(rr[0])), "v"(__uint_as_float(rr[1]))); return o;
}
constexpr float FA_THR = 8.f;
template <int NDB> __device__ __forceinline__ bool flash_update3(FlashSt<NDB>& st, f32x16& p0, f32x16& p1, unsigned vaddr) {
    VFr vf; v_issue<0>(vf, vaddr);
    asm volatile("s_nop 15\n\ts_nop 7" : "+v"(p0), "+v"(p1));
    const float rm = rowmax32_asm(p0, p1);
    bool moved = false;
    if (__builtin_expect(__builtin_amdgcn_ballot_w64(rm > FA_THR) != 0ull, 0)) {
        const float dl = fmaxf(rm, 0.f), f = __builtin_amdgcn_exp2f(-dl);
        st.m += dl; st.l *= f;
#pragma unroll
        for (int r = 0; r < 16; ++r) { p0[r] -= dl; p1[r] -= dl; }
#pragma unroll
        for (int db = 0; db < NDB; ++db)
#pragma unroll
            for (int r = 0; r < 16; ++r) st.o[db][r] *= f;
        moved = true;
    }
    float ls = 0.f;
#pragma unroll
    for (int r = 0; r < 16; ++r) { p0[r] = __builtin_amdgcn_exp2f(p0[r]); p1[r] = __builtin_amdgcn_exp2f(p1[r]); ls += p0[r] + p1[r]; }
    st.l += ls;
    bf16x8 pf[4]; pack_p(pf, p0, p1);
    LGKM_WAIT0();
    pv2(st.o[0], st.o[1], vf, pf);
    if constexpr (NDB == 4) { v_issue<2>(vf, vaddr); LGKM_WAIT0(); pv2(st.o[2], st.o[3], vf, pf); }
    return moved;
}
__device__ __forceinline__ void pv_only2(f32x16 (&o)[2], unsigned vaddr, const f32x16& p0, const f32x16& p1) {
    VFr vf; v_issue<0>(vf, vaddr); bf16x8 pf[4]; pack_p(pf, p0, p1); LGKM_WAIT0(); pv2(o[0], o[1], vf, pf);
}

__device__ __forceinline__ void fox_unit(unsigned char* lds, unsigned char* ws, int bh, int qb, unsigned* qc, int dry = 0) {
    int tid_o = threadIdx.x; asm volatile("" : "+v"(tid_o));
    const int tid = tid_o, lane = tid & 63, wid = __builtin_amdgcn_readfirstlane(tid >> 6), r32 = lane & 31, hi = lane >> 5;
    const unsigned lds0 = (unsigned)(uintptr_t)lds;
    const lds_cptr L = (lds_cptr)lds;
    const int qrow = 256 * qb + 32 * wid + r32, wrow0 = 256 * qb + 32 * wid;
    const int NTl = 4 * (qb + 1);
    const char* Kg = (const char*)(ws + OFF_KA) + (size_t)bh * 524288 + wid * 1024 + lane * 16;
    const char* Vg = (const char*)(ws + OFF_VA) + (size_t)bh * 524288 + wid * 1024 + lane * 16;
    const char* Cg = (const char*)(ws + OFF_CF) + (size_t)bh * 16384 + lane * 4;
    const unsigned kdst = (unsigned)__builtin_amdgcn_readfirstlane(lds0 + A_KRING + wid * 1024), vdst = (unsigned)__builtin_amdgcn_readfirstlane(lds0 + A_VRING + wid * 1024),
                   cdst = (unsigned)__builtin_amdgcn_readfirstlane(lds0 + A_CFRING + wid * 256);
#define FOX_DMA(t, slot) do { glds16(Kg + (size_t)(t) * 8192, kdst + (slot) * A_SLOT); glds16(Vg + (size_t)(t) * 8192, vdst + (slot) * A_SLOT); glds4(Cg + (size_t)(t) * 256, cdst + (slot) * 2048); } while (0)
    asm volatile("s_waitcnt vmcnt(0)" ::: "memory");
    FOX_DMA(0, 0); FOX_DMA(1, 1);
    bf16x8 qf[4];
    { const bf16* Q = (const bf16*)(ws + OFF_QA) + ((size_t)bh * 4096 + qrow) * 64 + 8 * hi;
#pragma unroll
      for (int d0 = 0; d0 < 4; ++d0) qf[d0] = *(const bf16x8*)(Q + 16 * d0); }
    FlashSt<2> st; flash_init3<2>(st);
    const int vb = lane_vbase(lane);
    const unsigned kaddr0 = lds0 + A_KRING + hi * 1024 + r32 * 16, vaddr0 = lds0 + A_VRING + vb;
    Q_TAKE(qn, qc);
    asm volatile("" : "+v"(qf[0]), "+v"(qf[1]), "+v"(qf[2]), "+v"(qf[3]), "+v"(qn));
    asm volatile("s_waitcnt vmcnt(0)" ::: "memory");
    asm volatile("s_barrier" ::: "memory");
    Q_PARK(qn);
    int slot = 0;
    for (int t = 0; t < NTl; ++t) {
        const int s2 = (slot >= 1) ? slot - 1 : 2;
        if (t + 2 < NTl) FOX_DMA(t + 2, s2);
        if (64 * t <= wrow0 + 31 && dry != 4) {
            f32x16 p0, p1;
            { const unsigned ca = lds0 + A_CFRING + slot * 2048 + wid * 256 + 16 * hi; f32x4 c0, c1, c2, c3, c4, c5, c6, c7;
              DSR128(c0, ca, 0); DSR128(c1, ca, 32); DSR128(c2, ca, 64); DSR128(c3, ca, 96); DSR128(c4, ca, 128); DSR128(c5, ca, 160); DSR128(c6, ca, 192); DSR128(c7, ca, 224);
              LGKM_WAIT0();
              p0 = __builtin_shufflevector(__builtin_shufflevector(c0, c1, 0, 1, 2, 3, 4, 5, 6, 7), __builtin_shufflevector(c2, c3, 0, 1, 2, 3, 4, 5, 6, 7), 0, 1, 2, 3, 4, 5, 6, 7, 8, 9, 10, 11, 12, 13, 14, 15);
              p1 = __builtin_shufflevector(__builtin_shufflevector(c4, c5, 0, 1, 2, 3, 4, 5, 6, 7), __builtin_shufflevector(c6, c7, 0, 1, 2, 3, 4, 5, 6, 7), 0, 1, 2, 3, 4, 5, 6, 7, 8, 9, 10, 11, 12, 13, 14, 15);
              p0 = p0 - st.m; p1 = p1 - st.m; }
            qk_tile2(p0, p1, kaddr0 + slot * A_SLOT, qf);
            if (64 * t + 63 > wrow0) {
                const int kb = 64 * t + 4 * hi;
#pragma unroll
                for (int r = 0; r < 16; ++r) { const int kv = kb + (r & 3) + 8 * (r >> 2); if (kv > qrow) p0[r] = -INFINITY; if (kv + 32 > qrow) p1[r] = -INFINITY; }
            }
            if (dry != 3) (void)flash_update3<2>(st, p0, p1, vaddr0 + slot * A_SLOT); else { st.o[0] += p0; st.o[1] += p1; }
        }
        if (dry == 2) { asm volatile("s_waitcnt lgkmcnt(0)\n\ts_barrier" ::: "memory"); } else if (t + 2 < NTl) { A_WAIT_BAR(3); } else { A_WAIT_BAR(0); }
        slot = (slot == 2) ? 0 : slot + 1;
    }
#undef FOX_DMA
    const float lt = st.l + __shfl_xor(st.l, 32), il = 1.f / lt;
    const int b = bh >> 3, h = bh & 7;
    bf16* Y = (bf16*)(ws + OFF_ZA) + (size_t)(b * 4096 + qrow) * 512 + h * 64;
    bf16* Yd = dry ? (bf16*)(ws + OFF_SELM) + (tid * 64) : Y;
#pragma unroll
    for (int db = 0; db < 2; ++db)
#pragma unroll
        for (int rq = 0; rq < 4; ++rq) { bf16* yp = Y + 32 * db + 8 * rq + 4 * hi; bf16* yo = Yd + 32 * db + 8 * rq + 4 * hi; const u32x2 z = *(const u32x2*)yp;
            const float z0 = __uint_as_float(z.x << 16), z1 = __uint_as_float(z.x & 0xffff0000u), z2 = __uint_as_float(z.y << 16), z3 = __uint_as_float(z.y & 0xffff0000u);
            u32x2 o; o.x = pk2(st.o[db][4 * rq] * il * z0, st.o[db][4 * rq + 1] * il * z1); o.y = pk2(st.o[db][4 * rq + 2] * il * z2, st.o[db][4 * rq + 3] * il * z3);
            *(u32x2*)yo = o; }
}

__device__ __forceinline__ void diff_unit(unsigned char* lds, unsigned char* ws, int bhc, int qb, const float* subg, float lam, float lam_init, unsigned* qc, bool dry = false) {
    int tid_o = threadIdx.x; asm volatile("" : "+v"(tid_o));
    const int tid = tid_o, lane = tid & 63, wid = __builtin_amdgcn_readfirstlane(tid >> 6), r32 = lane & 31, hi = lane >> 5;
    const int map = wid >> 2, wl = wid & 3;
    const unsigned lds0 = (unsigned)(uintptr_t)lds;
    const lds_cptr L = (lds_cptr)lds;
    const int b = bhc >> 2, hc = bhc & 3;
    const int qrow = 128 * qb + 32 * wl + r32, wrow0 = 128 * qb + 32 * wl;
    const int NTl = 2 * (qb + 1);
    const char* Kg = (const char*)(ws + OFF_KC) + (size_t)(b * 8 + hc * 2) * 524288 + wid * 1024 + lane * 16;
    const char* Vg = (const char*)(ws + OFF_VC) + (size_t)bhc * 1048576 + wid * 1024 + lane * 16;
    const unsigned kdst = (unsigned)__builtin_amdgcn_readfirstlane(lds0 + A_KRING + wid * 1024), vdst = (unsigned)__builtin_amdgcn_readfirstlane(lds0 + A_VRING + wid * 1024);
#define DIFF_DMA(t, slot) do { glds16(Kg + (size_t)(t) * 8192, kdst + (slot) * A_SLOT); glds16(Kg + 524288 + (size_t)(t) * 8192, kdst + (slot) * A_SLOT + 8192); \
        glds16(Vg + (size_t)(t) * 16384, vdst + (slot) * A_SLOT); glds16(Vg + (size_t)(t) * 16384 + 8192, vdst + (slot) * A_SLOT + 8192); } while (0)
    asm volatile("s_waitcnt vmcnt(0)" ::: "memory");
    DIFF_DMA(0, 0); DIFF_DMA(1, 1);
    bf16x8 qf[4];
    { const bf16* Q = (const bf16*)(ws + OFF_QC) + ((size_t)(b * 8 + hc * 2 + map) * 4096 + qrow) * 64 + 8 * hi;
#pragma unroll
      for (int d0 = 0; d0 < 4; ++d0) qf[d0] = *(const bf16x8*)(Q + 16 * d0); }
    FlashSt<4> st; flash_init3<4>(st);
    f32x16 negm;
#pragma unroll
    for (int r = 0; r < 16; ++r) negm[r] = 0.f;
    const int vb = lane_vbase(lane);
    const unsigned kaddr0 = lds0 + A_KRING + map * 8192 + hi * 1024 + r32 * 16, vaddr0 = lds0 + A_VRING + vb;
    Q_TAKE(qn, qc);
    asm volatile("" : "+v"(qf[0]), "+v"(qf[1]), "+v"(qf[2]), "+v"(qf[3]), "+v"(qn));
    asm volatile("s_waitcnt vmcnt(0)" ::: "memory");
    asm volatile("s_barrier" ::: "memory");
    Q_PARK(qn);
    int slot = 0;
    for (int t = 0; t < NTl; ++t) {
        const int s2 = (slot >= 1) ? slot - 1 : 2;
        if (t + 2 < NTl) DIFF_DMA(t + 2, s2);
        if (64 * t <= wrow0 + 31) {
            f32x16 p0 = negm, p1 = negm;
            qk_tile2(p0, p1, kaddr0 + slot * A_SLOT, qf);
            if (64 * t + 63 > wrow0) {
                const int kb = 64 * t + 4 * hi;
#pragma unroll
                for (int r = 0; r < 16; ++r) { const int kv = kb + (r & 3) + 8 * (r >> 2); if (kv > qrow) p0[r] = -INFINITY; if (kv + 32 > qrow) p1[r] = -INFINITY; }
            }
            if (flash_update3<4>(st, p0, p1, vaddr0 + slot * A_SLOT)) {
#pragma unroll
                for (int r = 0; r < 16; ++r) negm[r] = -st.m; }
        }
        if (t + 2 < NTl) { A_WAIT_BAR(4); } else { A_WAIT_BAR(0); }
        slot = (slot == 2) ? 0 : slot + 1;
    }
#undef DIFF_DMA
    const float lt = st.l + __shfl_xor(st.l, 32), il = 1.f / lt;
    LAS float* stage = (LAS float*)lds + wl * 4096 + r32;
    if (map == 1) {
#pragma unroll
        for (int db = 0; db < 4; ++db)
#pragma unroll
            for (int r = 0; r < 16; ++r) stage[(32 * db + crow(r, hi)) * 32] = st.o[db][r] * il;
    }
    asm volatile("s_waitcnt lgkmcnt(0)\n\ts_barrier" ::: "memory");
    if (map == 0) {
        float ss = 0.f;
#pragma unroll
        for (int db = 0; db < 4; ++db)
#pragma unroll
            for (int r = 0; r < 16; ++r) { const float v = st.o[db][r] * il - lam * stage[(32 * db + crow(r, hi)) * 32]; st.o[db][r] = v; ss += v * v; }
        ss += __shfl_xor(ss, 32);
        const float rs = rsqrtf(ss * (1.f / 128.f) + EPS) * (1.f - lam_init);
        bf16* Y = (bf16*)(ws + OFF_ZC) + (size_t)(b * 4096 + qrow) * 512 + hc * 128;
        bf16* Yd = dry ? (bf16*)(ws + OFF_SELM) + (tid * 128) : Y;
#pragma unroll
        for (int db = 0; db < 4; ++db)
#pragma unroll
            for (int rq = 0; rq < 4; ++rq) { const int d = 32 * db + 8 * rq + 4 * hi; bf16* yp = Y + d; bf16* yo = Yd + d; const u32x2 z = *(const u32x2*)yp; const f32x4 g = *(const f32x4*)(subg + d);
                const float z0 = __uint_as_float(z.x << 16), z1 = __uint_as_float(z.x & 0xffff0000u), z2 = __uint_as_float(z.y << 16), z3 = __uint_as_float(z.y & 0xffff0000u);
                u32x2 o; o.x = pk2(st.o[db][4 * rq] * rs * g[0] * z0, st.o[db][4 * rq + 1] * rs * g[1] * z1); o.y = pk2(st.o[db][4 * rq + 2] * rs * g[2] * z2, st.o[db][4 * rq + 3] * rs * g[3] * z3);
                *(u32x2*)yo = o; }
    }
    asm volatile("s_waitcnt lgkmcnt(0)\n\ts_barrier" ::: "memory");
}

constexpr int N_SELM = 131072 + 256, N_UMASK = N_SELM + 512, N_SEQC = N_UMASK + 16, N_SEQD = N_SEQC + 80, N_CNT = N_SEQD + 16;
template <int MODE> __device__ __forceinline__ void nsa_ring(FlashSt<2>& st, unsigned char* lds, const char* Kg, const char* Vg, unsigned kdst, unsigned vdst, int n, int seqoff,
                                                             const bf16x8 (&qf)[4], int tb, int qloc, unsigned selLo, unsigned selHi, int r32, int hi, int vb) {
    const lds_cptr L = (lds_cptr)lds;
    const LAS unsigned char* seq = (const LAS unsigned char*)(L + seqoff);
    const unsigned lds0r = (unsigned)(uintptr_t)lds;
#define NSA_DMA(j, slot) do { glds16(Kg + (size_t)(j) * 8192, kdst + (slot) * A_SLOT); glds16(Vg + (size_t)(j) * 8192, vdst + (slot) * A_SLOT); } while (0)
    asm volatile("s_waitcnt vmcnt(0)" ::: "memory");
    { const int j0 = __builtin_amdgcn_readfirstlane((int)seq[0]); NSA_DMA(j0, 0); if (n > 1) { const int j1 = __builtin_amdgcn_readfirstlane((int)seq[1]); NSA_DMA(j1, 1); } }
    A_WAIT_BAR(0);
    int slot = 0;
    f32x16 negm;
#pragma unroll
    for (int r = 0; r < 16; ++r) negm[r] = 0.f;
    for (int i = 0; i < n; ++i) {
        const int s2 = (slot >= 1) ? slot - 1 : 2;
        if (i + 2 < n) { const int j2 = __builtin_amdgcn_readfirstlane((int)seq[i + 2]); NSA_DMA(j2, s2); }
        const int j = __builtin_amdgcn_readfirstlane((int)seq[i]);
        f32x16 p0 = negm, p1 = negm;
        qk_tile2(p0, p1, lds0r + A_KRING + hi * 1024 + r32 * 16 + slot * A_SLOT, qf);
        if (j == tb) {
#pragma unroll
            for (int r = 0; r < 16; ++r) { const int kv = 4 * hi + (r & 3) + 8 * (r >> 2); if (kv > qloc) p0[r] = -INFINITY; if (kv + 32 > qloc) p1[r] = -INFINITY; }
        } else if (MODE == 0) {
            const bool sel = (((j < 32) ? (selLo >> j) : (selHi >> (j - 32))) & 1u) != 0u;
            if (!sel) {
#pragma unroll
                for (int r = 0; r < 16; ++r) { p0[r] = -INFINITY; p1[r] = -INFINITY; } }
        } else if (j == tb - 8) {
#pragma unroll
            for (int r = 0; r < 16; ++r) { const int kv = 4 * hi + (r & 3) + 8 * (r >> 2); if (kv <= qloc) p0[r] = -INFINITY; if (kv + 32 <= qloc) p1[r] = -INFINITY; }
        }
        if (flash_update3<2>(st, p0, p1, lds0r + A_VRING + vb + slot * A_SLOT)) {
#pragma unroll
            for (int r = 0; r < 16; ++r) negm[r] = -st.m; }
        if (i + 2 < n) { A_WAIT_BAR(2); } else { A_WAIT_BAR(0); }
        slot = (slot == 2) ? 0 : slot + 1;
    }
#undef NSA_DMA
}
__device__ __forceinline__ void nsa_unit(unsigned char* lds, unsigned char* ws, int bg, int tb, unsigned* qc, bool dry = false) {
    int tid_o = threadIdx.x; asm volatile("" : "+v"(tid_o));
    const int tid = tid_o, lane = tid & 63, wid = __builtin_amdgcn_readfirstlane(tid >> 6), r32 = lane & 31, hi = lane >> 5;
    const unsigned lds0 = (unsigned)(uintptr_t)lds;
    const lds_cptr L = (lds_cptr)lds;
    const int b = bg >> 1, g = bg & 1, h = 4 * g + (wid >> 1), qloc = 32 * (wid & 1) + r32, t = 64 * tb + qloc, row = b * 4096 + t;
    const unsigned kdst = (unsigned)__builtin_amdgcn_readfirstlane(lds0 + A_KRING + wid * 1024), vdst = (unsigned)__builtin_amdgcn_readfirstlane(lds0 + A_VRING + wid * 1024);
    const int vb = lane_vbase(lane);
    LAS float* imp0 = (LAS float*)(L + 32768);
    LAS float* imp1 = (LAS float*)(L + 81920);
    LAS unsigned* selm = (LAS unsigned*)(L + N_SELM);
    LAS unsigned* umask = (LAS unsigned*)(L + N_UMASK);
    const int nvmax = 4 * tb + 3, nct = (nvmax + 63) >> 6;
    asm volatile("s_waitcnt vmcnt(0)" ::: "memory");
    { const char* Kc = (const char*)(ws + OFF_KCMP) + (size_t)bg * 32768 + wid * 1024 + lane * 16; const char* Vc = (const char*)(ws + OFF_VCMP) + (size_t)bg * 32768 + wid * 1024 + lane * 16;
      for (int ct = 0; ct < nct; ++ct) { glds16(Kc + ct * 8192, kdst + ct * 8192); glds16(Vc + ct * 8192, vdst + ct * 8192); } }
    bf16x8 qf[4];
    const bf16* Qp = (const bf16*)(ws + OFF_QB) + ((size_t)(b * 8 + h) * 4096 + t) * 64 + 8 * hi;
#pragma unroll
    for (int d0 = 0; d0 < 4; ++d0) qf[d0] = *(const bf16x8*)(Qp + 16 * d0);
    const float* gt = (const float*)(ws + OFF_GATES) + (size_t)row * 24 + (h & 7) * 3;
    float g0 = gt[0], g1 = gt[1], g2 = gt[2];
    Q_TAKE(qn, qc);
    asm volatile("" : "+v"(qf[0]), "+v"(qf[1]), "+v"(qf[2]), "+v"(qf[3]), "+v"(g0), "+v"(g1), "+v"(g2), "+v"(qn));
    A_WAIT_BAR(0);
    Q_PARK(qn);
    const int nv = (t >= 31) ? ((t - 31) >> 4) + 1 : 0;
    f32x16 y[2];
    {
        float m = -1e30f, l = 0.f;
        for (int ct = 0; ct < nct; ++ct) {
            f32x16 p0, p1;
#pragma unroll
            for (int r = 0; r < 16; ++r) { p0[r] = 0.f; p1[r] = 0.f; }
            qk_tile2(p0, p1, lds0 + A_KRING + hi * 1024 + r32 * 16 + ct * 8192, qf);
            const int cb = 64 * ct + 4 * hi;
#pragma unroll
            for (int r = 0; r < 16; ++r) { const int c = cb + (r & 3) + 8 * (r >> 2); if (c >= nv) p0[r] = -INFINITY; if (c + 32 >= nv) p1[r] = -INFINITY; }
            const float rm = rowmax32(p0, p1), mn = fmaxf(m, rm);
            float ls = 0.f;
#pragma unroll
            for (int r = 0; r < 16; ++r) ls += __builtin_amdgcn_exp2f(p0[r] - mn) + __builtin_amdgcn_exp2f(p1[r] - mn);
            l = l * __builtin_amdgcn_exp2f(m - mn) + ls; m = mn;
        }
        const float lt = l + __shfl_xor(l, 32), il = lt > 0.f ? 1.f / lt : 0.f;
        f32x16 oc[2];
#pragma unroll
        for (int r = 0; r < 16; ++r) { oc[0][r] = 0.f; oc[1][r] = 0.f; }
        float carry = 0.f;
        LAS float* ih = ((wid >> 1) == 0 ? imp0 : imp1 + ((wid >> 1) - 1) * 4096) + qloc * 64;
        const int isw = qloc ^ (hi << 5);
        for (int ct = 0; ct < nct; ++ct) {
            f32x16 p0, p1;
#pragma unroll
            for (int r = 0; r < 16; ++r) { p0[r] = 0.f; p1[r] = 0.f; }
            qk_tile2(p0, p1, lds0 + A_KRING + hi * 1024 + r32 * 16 + ct * 8192, qf);
            const int cb = 64 * ct + 4 * hi;
#pragma unroll
            for (int r = 0; r < 16; ++r) { const int c = cb + (r & 3) + 8 * (r >> 2);
                p0[r] = (c >= nv) ? 0.f : __builtin_amdgcn_exp2f(p0[r] - m) * il; p1[r] = (c + 32 >= nv) ? 0.f : __builtin_amdgcn_exp2f(p1[r] - m) * il; }
            {
                float qs[8], px[8];
#pragma unroll
                for (int k = 0; k < 4; ++k) { qs[k] = (p0[4 * k] + p0[4 * k + 1]) + (p0[4 * k + 2] + p0[4 * k + 3]); qs[4 + k] = (p1[4 * k] + p1[4 * k + 1]) + (p1[4 * k + 2] + p1[4 * k + 3]);
                    px[k] = __shfl_xor(p0[4 * k + 3], 32); px[4 + k] = __shfl_xor(p1[4 * k + 3], 32); }
#pragma unroll
                for (int k = 0; k < 8; ++k) { const float prev = k ? px[k - 1] : carry; ih[(16 * ct + 2 * k + hi) ^ isw] = qs[k] + (hi ? px[k] : prev); }
                carry = px[7];
            }
            pv_only2(oc, lds0 + A_VRING + vb + ct * 8192, p0, p1);
        }
#pragma unroll
        for (int r = 0; r < 16; ++r) { y[0][r] = g0 * oc[0][r]; y[1][r] = g0 * oc[1][r]; }
    }
    asm volatile("s_waitcnt lgkmcnt(0)\n\ts_barrier" ::: "memory");
    {
        const int q = lane, part = wid, j0 = 8 * part;
        LAS float* s0 = imp0 + q * 64;
        float sc[8];
#pragma unroll
        for (int i = 0; i < 8; ++i) { const int j = j0 + i; const bool forced = (j == 0) || (j == tb) || (j == tb - 1);
            const int c = (j ^ ((j & 1) << 5)) ^ q;
            const float sm = (s0[c] + imp1[q * 64 + c]) + (imp1[4096 + q * 64 + c] + imp1[8192 + q * 64 + c]);
            sc[i] = forced ? 1e30f : (j <= tb ? sm : -1e30f); }
#pragma unroll
        for (int i = 0; i < 8; ++i) { const int j = j0 + i; s0[(j ^ ((j & 1) << 5)) ^ q] = sc[i]; }
        asm volatile("s_waitcnt lgkmcnt(0)\n\ts_barrier" ::: "memory");
        int rank[8];
#pragma unroll
        for (int i = 0; i < 8; ++i) rank[i] = 0;
        const int kend = tb + 1, e1 = j0 < kend ? j0 : kend, e2 = j0 + 8 < kend ? j0 + 8 : kend;
#pragma unroll 4
        for (int k = 0; k < e1; ++k) { const float sk = s0[(k ^ ((k & 1) << 5)) ^ q];
#pragma unroll
            for (int i = 0; i < 8; ++i) rank[i] += (sk >= sc[i]) ? 1 : 0; }
        for (int k = e1; k < e2; ++k) { const float sk = s0[(k ^ ((k & 1) << 5)) ^ q];
#pragma unroll
            for (int i = 0; i < 8; ++i) rank[i] += (sk > sc[i] || (sk == sc[i] && k < j0 + i)) ? 1 : 0; }
#pragma unroll 4
        for (int k = e2; k < kend; ++k) { const float sk = s0[(k ^ ((k & 1) << 5)) ^ q];
#pragma unroll
            for (int i = 0; i < 8; ++i) rank[i] += (sk > sc[i]) ? 1 : 0; }
        unsigned bits = 0u, ub = 0u;
#pragma unroll
        for (int i = 0; i < 8; ++i) { const bool in = rank[i] < 16; bits |= in ? (1u << i) : 0u; ub |= (__builtin_amdgcn_ballot_w64(in) != 0ull) ? (1u << i) : 0u; }
        ((LAS unsigned char*)selm)[q * 8 + part] = (unsigned char)bits;
        if (lane == 0) ((LAS unsigned char*)umask)[part] = (unsigned char)ub;
        asm volatile("s_waitcnt lgkmcnt(0)\n\ts_barrier" ::: "memory");
        if (tid == 0) {
            LAS unsigned char* sq = (LAS unsigned char*)(L + N_SEQC); LAS unsigned char* sd = (LAS unsigned char*)(L + N_SEQD); LAS int* cnt = (LAS int*)(L + N_CNT);
            const unsigned long long um = ((unsigned long long)umask[1] << 32) | umask[0];
            int n = 0; sq[n++] = (unsigned char)tb;
            for (int j = 0; j < tb; ++j) if ((um >> j) & 1ull) sq[n++] = (unsigned char)j;
            cnt[0] = n;
            int n2 = 0; sd[n2++] = (unsigned char)tb;
            for (int j = (tb >= 8 ? tb - 8 : 0); j < tb; ++j) sd[n2++] = (unsigned char)j;
            cnt[1] = n2;
        }
        asm volatile("s_waitcnt lgkmcnt(0)\n\ts_barrier" ::: "memory");
    }
    const unsigned selLo = selm[qloc * 2], selHi = selm[qloc * 2 + 1];
    const int nC = __builtin_amdgcn_readfirstlane(((const LAS int*)(L + N_CNT))[0]), nD = __builtin_amdgcn_readfirstlane(((const LAS int*)(L + N_CNT))[1]);
    { const float* cs = (const float*)(ws + OFF_COS) + (size_t)row * 32 + 4 * hi; const float* sn = (const float*)(ws + OFF_SIN) + (size_t)row * 32 + 4 * hi;
#pragma unroll
      for (int d0 = 0; d0 < 4; ++d0) { const f32x4 c = *(const f32x4*)(cs + 8 * d0), s = *(const f32x4*)(sn + 8 * d0); u32x4 w = __builtin_bit_cast(u32x4, qf[d0]); u32x4 o;
#pragma unroll
          for (int e = 0; e < 4; ++e) { const float x1 = __uint_as_float(w[e] << 16), x2 = __uint_as_float(w[e] & 0xffff0000u); o[e] = pk2(x1 * c[e] - x2 * s[e], x2 * c[e] + x1 * s[e]); }
          qf[d0] = __builtin_bit_cast(bf16x8, o); } }
    asm volatile("" : "+v"(qf[0]), "+v"(qf[1]), "+v"(qf[2]), "+v"(qf[3]));
    {
        FlashSt<2> st; flash_init3<2>(st);
        const char* Kg = (const char*)(ws + OFF_KSEL) + (size_t)bg * 524288 + wid * 1024 + lane * 16; const char* Vg = (const char*)(ws + OFF_VSEL) + (size_t)bg * 524288 + wid * 1024 + lane * 16;
        nsa_ring<0>(st, lds, Kg, Vg, kdst, vdst, nC, N_SEQC, qf, tb, qloc, selLo, selHi, r32, hi, vb);
        const float lt = st.l + __shfl_xor(st.l, 32), sc = g1 / lt;
#pragma unroll
        for (int r = 0; r < 16; ++r) { y[0][r] += sc * st.o[0][r]; y[1][r] += sc * st.o[1][r]; }
    }
    {
        FlashSt<2> st; flash_init3<2>(st);
        const char* Kg = (const char*)(ws + OFF_KWIN) + (size_t)bg * 524288 + wid * 1024 + lane * 16; const char* Vg = (const char*)(ws + OFF_VWIN) + (size_t)bg * 524288 + wid * 1024 + lane * 16;
        nsa_ring<1>(st, lds, Kg, Vg, kdst, vdst, nD, N_SEQD, qf, tb, qloc, selLo, selHi, r32, hi, vb);
        const float lt = st.l + __shfl_xor(st.l, 32), sc = g2 / lt;
#pragma unroll
        for (int r = 0; r < 16; ++r) { y[0][r] += sc * st.o[0][r]; y[1][r] += sc * st.o[1][r]; }
    }
    bf16* Y = (bf16*)(ws + OFF_ZB) + (size_t)row * 512 + h * 64;
    bf16* Yd = dry ? (bf16*)(ws + OFF_SELM) + (tid * 64) : Y;
#pragma unroll
    for (int db = 0; db < 2; ++db)
#pragma unroll
        for (int rq = 0; rq < 4; ++rq) { bf16* yp = Y + 32 * db + 8 * rq + 4 * hi; bf16* yo = Yd + 32 * db + 8 * rq + 4 * hi; const u32x2 z = *(const u32x2*)yp;
            const float z0 = __uint_as_float(z.x << 16), z1 = __uint_as_float(z.x & 0xffff0000u), z2 = __uint_as_float(z.y << 16), z3 = __uint_as_float(z.y & 0xffff0000u);
            u32x2 o; o.x = pk2(y[db][4 * rq] * z0, y[db][4 * rq + 1] * z1); o.y = pk2(y[db][4 * rq + 2] * z2, y[db][4 * rq + 3] * z3);
            *(u32x2*)yo = o; }
}

__device__ __forceinline__ void compress_unit(unsigned char* lds, unsigned char* ws, int kv, int bg, int rc) {
    int tid_o = threadIdx.x; asm volatile("" : "+v"(tid_o));
    const int tid = tid_o, lane = tid & 63, wid = __builtin_amdgcn_readfirstlane(tid >> 6), r32 = lane & 31, hi = lane >> 5;
    const unsigned lds0 = (unsigned)(uintptr_t)lds;
    { const char* Ab = (const char*)(ws + (kv ? OFF_VCB : OFF_KCB)) + ((size_t)bg * 4096 + 512 * rc) * 128;
      asm volatile("s_waitcnt vmcnt(0)" ::: "memory");
#pragma unroll
      for (int i = 0; i < 9; ++i) { const int q = (i * 8 + wid) * 64 + lane, blk = q / 129, qq = q - blk * 129; const int sg = blk * 128 + (qq < 128 ? qq : 127);
          glds16(Ab + (size_t)sg * 16, (unsigned)__builtin_amdgcn_readfirstlane(lds0 + (i * 8 + wid) * 1024)); }
      asm volatile("s_waitcnt vmcnt(0)\n\ts_barrier" ::: "memory"); }
    const bf16* Bp = (const bf16*)(ws + OFF_CW1) + (size_t)kv * 256 * 2048 + ((size_t)wid * 128 * 64 + lane) * 8;
    const lds_cptr Al = (lds_cptr)lds + 2064 * r32 + 16 * hi;
    f32x16 acc;
#pragma unroll
    for (int r = 0; r < 16; ++r) acc[r] = 0.f;
#pragma unroll 8
    for (int l = 0; l < 32; ++l) {
        const lds_cptr ap = Al + l * 128 + (l >> 4) * 16;
#pragma unroll
        for (int q = 0; q < 4; ++q) {
            const bf16x8 a = *(const LAS bf16x8*)(ap + q * 32), w = *(const bf16x8*)(Bp + (size_t)(4 * l + q) * 512);
            acc = __builtin_amdgcn_mfma_f32_32x32x16_bf16(w, a, acc, 0, 0, 0);
        }
    }
    const float* cb = (const float*)(ws + OFF_CB1) + kv * 256 + 32 * wid + 4 * hi;
    bf16x8 hf[2];
    { float hv[16];
#pragma unroll
      for (int rq = 0; rq < 4; ++rq) { const f32x4 bb = *(const f32x4*)(cb + 8 * rq);
#pragma unroll
          for (int e = 0; e < 4; ++e) hv[4 * rq + e] = siluf_(acc[4 * rq + e] + bb[e]); }
      u32x4 w0, w1;
      w0.x = pk2(hv[0], hv[1]); w0.y = pk2(hv[2], hv[3]); w0.z = pk2(hv[4], hv[5]); w0.w = pk2(hv[6], hv[7]);
      w1.x = pk2(hv[8], hv[9]); w1.y = pk2(hv[10], hv[11]); w1.z = pk2(hv[12], hv[13]); w1.w = pk2(hv[14], hv[15]);
      hf[0] = __builtin_bit_cast(bf16x8, w0); hf[1] = __builtin_bit_cast(bf16x8, w1); }
    const bf16* W2 = (const bf16*)(ws + OFF_CW2) + (size_t)kv * 64 * 256 + 32 * wid + 4 * hi;
    f32x16 po[2];
#pragma unroll
    for (int dbk = 0; dbk < 2; ++dbk) {
#pragma unroll
        for (int r = 0; r < 16; ++r) po[dbk][r] = 0.f;
#pragma unroll
        for (int s = 0; s < 2; ++s) {
            const bf16* wr = W2 + (size_t)(32 * dbk + r32) * 256 + 16 * s;
            const u32x2 lo = *(const u32x2*)wr, hh = *(const u32x2*)(wr + 8);
            u32x4 wv; wv.x = lo.x; wv.y = lo.y; wv.z = hh.x; wv.w = hh.y;
            po[dbk] = __builtin_amdgcn_mfma_f32_32x32x16_bf16(__builtin_bit_cast(bf16x8, wv), hf[s], po[dbk], 0, 0, 0);
        }
    }
    LAS float* part = (LAS float*)lds;
    __syncthreads();
#pragma unroll
    for (int dbk = 0; dbk < 2; ++dbk)
#pragma unroll
        for (int r = 0; r < 16; ++r) part[(wid * 64 + 32 * dbk + crow(r, hi)) * 32 + r32] = po[dbk][r];
    __syncthreads();
    {
        const int row = tid & 31, d4 = tid >> 5, cc = 32 * rc + row;
        float o[4];
#pragma unroll
        for (int e = 0; e < 4; ++e) { float sum = 0.f;
#pragma unroll
            for (int w = 0; w < 8; ++w) sum += part[(w * 64 + 4 * d4 + e) * 32 + row];
            o[e] = (cc < 255) ? sum : 0.f; }
        bf16* dst = (bf16*)(ws + (kv ? OFF_VCMP : OFF_KCMP)) + (size_t)bg * 16384 + (kv ? vtile_off(cc, 4 * d4) : ktile_off(cc, 4 * d4));
        store_bf<4>(dst, o);
    }
    __syncthreads();
}
__device__ __forceinline__ void cumsum_unit(unsigned char* lds, unsigned char* ws, int bh) {
    int tid_o = threadIdx.x; asm volatile("" : "+v"(tid_o));
    const int tid = tid_o, lane = tid & 63, wid = tid >> 6, b = bh >> 3, h = bh & 7;
    const float* lf = (const float*)(ws + OFF_LOGF) + ((size_t)(b * 4096 + 8 * tid)) * 8 + h;
    float v[8]; float s = 0.f;
#pragma unroll
    for (int i = 0; i < 8; ++i) { s += lf[i * 8]; v[i] = s; }
    float incl = s;
#pragma unroll
    for (int of = 1; of < 64; of <<= 1) { const float t = __shfl_up(incl, of); if (lane >= of) incl += t; }
    LAS float* wsum = (LAS float*)lds;
    __syncthreads();
    if (lane == 63) wsum[wid] = incl;
    __syncthreads();
    float base = incl - s;
    for (int w = 0; w < wid; ++w) base += wsum[w];
    float* cf = (float*)(ws + OFF_CF) + (size_t)bh * 4096 + 8 * tid;
    f32x4 o0 = {-(base + v[0]), -(base + v[1]), -(base + v[2]), -(base + v[3])}, o1 = {-(base + v[4]), -(base + v[5]), -(base + v[6]), -(base + v[7])};
    *(f32x4*)cf = o0; *(f32x4*)(cf + 4) = o1;
    __syncthreads();
}

constexpr size_t OFF_BAR = OFF_CTL + 131072;
constexpr size_t OFF_Q = OFF_CTL + 0x28000;
constexpr int LDS_BARST = 131072 + 64;
#define XB_TMO      128
#define XB_XCNT(j)  (256  + 64 * (j))
#define XB_XSUB(j)  (1280 + 64 * (j))
#define XB_XGEN(j)  (2304 + 64 * (j))
#define XB_TOP      3328
#define XB_TOPGEN   3392
#define XCD_BAR_WORDS 3456
#define XB_SPIN_CAP (1u << 18)

__device__ __forceinline__ unsigned xb_ld(unsigned* p)              { return __hip_atomic_load(p, __ATOMIC_RELAXED, __HIP_MEMORY_SCOPE_AGENT); }
__device__ __forceinline__ unsigned xb_add(unsigned* p, unsigned v) { return __hip_atomic_fetch_add(p, v, __ATOMIC_RELAXED, __HIP_MEMORY_SCOPE_AGENT); }
__device__ __forceinline__ unsigned xb_xcc_id() { return (unsigned)__builtin_amdgcn_s_getreg((3 << 11) | 20) & 0xFu; }
#define XB_SPIN(cond, bar) do { unsigned _sp = 0; while (cond) { __builtin_amdgcn_s_sleep(1); \
    if ((++_sp & 255u) == 0u) { if (xb_ld(&(bar)[XB_TMO])) break; if (_sp > XB_SPIN_CAP) { atomicAdd(&(bar)[XB_TMO], 1u); break; } } } } while (0)

struct XcdBarrier {
    unsigned* bar; unsigned x;
    volatile LAS unsigned* st;
};

__device__ __forceinline__ XcdBarrier xcd_barrier_post(unsigned* bar, volatile LAS unsigned* st) {
    XcdBarrier b; b.bar = bar; b.x = xb_xcc_id(); b.st = st;
    if (threadIdx.x == 0) (void)xb_add(&bar[XB_XCNT(b.x)], 1u);
    return b;
}
__device__ __forceinline__ void xcd_barrier_complete(unsigned* bar, unsigned x, unsigned& nloc, unsigned& nx) {
    const unsigned G = gridDim.x * gridDim.y * gridDim.z;
    unsigned sum, cnt, mine, sp = 0u;
    for (;;) {
        sum = 0u; cnt = 0u; mine = 0u;
#pragma unroll
        for (unsigned j = 0; j < 16; ++j) { const unsigned c = xb_ld(&bar[XB_XCNT(j)]); sum += c; cnt += (c > 0u) ? 1u : 0u; mine = (j == x) ? c : mine; }
        if (sum == G) break;
        __builtin_amdgcn_s_sleep(1);
        if ((++sp & 255u) == 0u) { if (xb_ld(&bar[XB_TMO])) break; if (sp > XB_SPIN_CAP) { atomicAdd(&bar[XB_TMO], 1u); break; } }
    }
    nloc = mine > 0u ? mine : 1u; nx = cnt > 0u ? cnt : 1u;
}

__device__ __forceinline__ void xcd_barrier(const XcdBarrier& b) {
    asm volatile("s_waitcnt vmcnt(0)" ::: "memory");
    __syncthreads();
    if (threadIdx.x == 0) {
        unsigned* bar = b.bar;
        __builtin_amdgcn_s_waitcnt(0);
        unsigned nloc = b.st[0], nx = b.st[1];
        if (nloc == 0u) { xcd_barrier_complete(bar, b.x, nloc, nx); b.st[0] = nloc; b.st[1] = nx; }
        const unsigned old = xb_add(&bar[XB_XSUB(b.x)], 1u);
        const unsigned gen = old / nloc;
        if (old + 1u == (gen + 1u) * nloc) {
            __builtin_amdgcn_fence(__ATOMIC_RELEASE, "agent");
            asm volatile("s_waitcnt vmcnt(0)" ::: "memory");
            const unsigned og = xb_add(&bar[XB_TOP], 1u);
            const unsigned tg = og / nx;
            if (og + 1u == (tg + 1u) * nx) xb_add(&bar[XB_TOPGEN], 1u);
            else XB_SPIN(xb_ld(&bar[XB_TOPGEN]) == tg, bar);
            __builtin_amdgcn_fence(__ATOMIC_ACQUIRE, "agent");
            xb_add(&bar[XB_XGEN(b.x)], 1u);
            asm volatile("s_waitcnt vmcnt(0)" ::: "memory");
        } else {
            XB_SPIN(xb_ld(&bar[XB_XGEN(b.x)]) == gen, bar);
            __builtin_amdgcn_fence(__ATOMIC_ACQUIRE, "agent");
            asm volatile("s_waitcnt vmcnt(0)" ::: "memory");
        }
    }
    __syncthreads();
}

struct KArgs;
__device__ __forceinline__ void conv_tile(bool active, float (*tile)[65], int vt, const float* src, int ld, int K, bf16* dst, const float* kscale, int mode, int bx, int by) {
    const int n0 = bx * 64, k0 = by * 64, tx = vt & 63, ty = vt >> 6;
    const int n = n0 + tx;
    const int sc = (mode == 0 || mode == 3) ? n : mode == 1 ? win_srccol(n) : (n & ~63) + ((n & 1) << 5) + ((n & 63) >> 1);
    if (active) {
        float v[16];
#pragma unroll
        for (int i = 0; i < 16; ++i) v[i] = (sc >= 0) ? src[(size_t)(k0 + 4 * i + ty) * ld + sc] : 0.f;
        if (kscale) {
#pragma unroll
            for (int i = 0; i < 16; ++i) v[i] *= kscale[k0 + 4 * i + ty]; }
#pragma unroll
        for (int i = 0; i < 16; ++i) tile[tx][4 * i + ty] = v[i];
    }
    __syncthreads();
    if (active) {
#pragma unroll
        for (int p = 0; p < 2; ++p) { const int it = vt + 256 * p, r = it >> 3, c = it & 7; const float* t = &tile[r][8 * c];
            u32x4 o; o.x = pk2(t[0], t[1]); o.y = pk2(t[2], t[3]); o.z = pk2(t[4], t[5]); o.w = pk2(t[6], t[7]);
            const int nn = n0 + r, kk = k0 + 8 * c;
            if (mode == 3) *(u32x4*)(dst + ((size_t)((nn >> 5) * (K >> 4) + (kk >> 4)) * 64 + (nn & 31) + 32 * ((kk & 15) >> 3)) * 8) = o;
            else *(u32x4*)(dst + (size_t)nn * K + kk) = o; }
    }
    __syncthreads();
}
namespace cg = cooperative_groups;
constexpr int NT = 512;
constexpr int LDS_BYTES = 147456;
struct KArgs { const void* in[23]; float* out; unsigned char* ws; };

#define OPAQUE_TID() int tid = threadIdx.x; asm volatile("" : "+v"(tid))
#define VRUN(VT, NVB, CALL) do { OPAQUE_TID(); constexpr int per_ = NT / (VT); for (int vb = blockIdx.x * per_ + tid / (VT); vb < (NVB); vb += gridDim.x * per_) { const int vt = tid % (VT); CALL; } } while (0)
#define VRUN_BAR(NVB, CALL) do { OPAQUE_TID(); float (*tile)[65] = (float (*)[65])(lds + (tid >> 8) * 64 * 65 * 4); (void)tile; const int nvb_ = (NVB); for (int it_ = 0; it_ * (int)gridDim.x * 2 < nvb_; ++it_) { const int vb = (it_ * (int)gridDim.x + (int)blockIdx.x) * 2 + (tid >> 8); const int vt = tid & 255; const bool active = vb < nvb_; CALL; } } while (0)

#ifndef REP_U
#define REP_U 0
#endif
#ifndef REP_SYNC
#define REP_SYNC 0
#endif
#ifndef REP_SUMSQ
#define REP_SUMSQ 0
#endif
#ifndef REP_P0
#define REP_P0 0
#endif
#ifndef REP_PRO
#define REP_PRO 0
#endif
#ifndef REP_INPROJ
#define REP_INPROJ 0
#endif
#ifndef REP_P2
#define REP_P2 0
#endif
#ifndef REP_FOX
#define REP_FOX 0
#endif
#ifndef REP_DIFF
#define REP_DIFF 0
#endif
#ifndef REP_NSA
#define REP_NSA 0
#endif
#ifndef REP_GATEBR
#define REP_GATEBR 0
#endif
#ifndef REP_OUT
#define REP_OUT 0
#endif
#ifndef DO_ALL
#define DO_ALL 1
#endif
#ifndef DO_PRO
#define DO_PRO DO_ALL
#endif
#ifndef DO_INPROJ
#define DO_INPROJ DO_ALL
#endif
#ifndef DO_P2
#define DO_P2 DO_ALL
#endif
#ifndef DO_ATTN
#define DO_ATTN DO_ALL
#endif
#ifndef DO_GATEBR
#define DO_GATEBR DO_ALL
#endif
#ifndef DO_OUT
#define DO_OUT DO_ALL
#endif
#ifndef DO_PLE
#define DO_PLE DO_ALL
#endif
#ifndef DO_TAIL
#define DO_TAIL DO_ALL
#endif
__global__ void __launch_bounds__(NT) mega(KArgs a) {
    extern __shared__ __attribute__((aligned(16))) unsigned char lds[];
    cg::grid_group grid = cg::this_grid();
    { volatile LAS unsigned* st0 = (volatile LAS unsigned*)((LAS unsigned char*)lds + LDS_BARST); if (threadIdx.x < 2) st0[threadIdx.x] = 0u; }
    __syncthreads();
    const XcdBarrier xbar = xcd_barrier_post((unsigned*)(a.ws + OFF_BAR), (volatile LAS unsigned*)((LAS unsigned char*)lds + LDS_BARST));
#define GSYNC() xcd_barrier(xbar)
    unsigned char* ws = a.ws; float* X = a.out;
    typedef const KArgs __attribute__((address_space(4)))* kargp_t;
#define KIN(i) ([&]() { kargp_t kp_ = (kargp_t)__builtin_amdgcn_kernarg_segment_ptr(); asm volatile("" : "+s"(kp_)); return kp_->in[i]; }())
#define I_x ((const float*)KIN(0))
#define I_p ((const float*)KIN(1))
#define I_pos ((const int*)KIN(2))
#define I_norm_g ((const float*)KIN(3))
#define I_w_in ((const float*)KIN(4))
#define I_b_forget ((const float*)KIN(5))
#define I_pe_k ((const float*)KIN(6))
#define I_w1_k ((const float*)KIN(7))
#define I_b1_k ((const float*)KIN(8))
#define I_w2_k ((const float*)KIN(9))
#define I_pe_v ((const float*)KIN(10))
#define I_w1_v ((const float*)KIN(11))
#define I_b1_v ((const float*)KIN(12))
#define I_w2_v ((const float*)KIN(13))
#define I_diff_lam ((const float*)KIN(14))
#define I_subln ((const float*)KIN(15))
#define I_w_out ((const float*)KIN(19))
#define I_w_ple ((const float*)KIN(20))
#define I_w_pg ((const float*)KIN(21))
#define I_final_g ((const float*)KIN(22))
#if DO_PRO
    for (int rep0_ = 0; rep0_ <= REP_P0; ++rep0_) {
    VRUN(256, M / 4, d_xprep(vb, vt, I_x, ws));
    VRUN(256, M * 32 / 256, d_rope_table(vb, vt, I_pos, ws));
    VRUN(256, (2 * M * 256 / 4) / 256, d_pconv(vb, vt, I_p, ws));
    for (int l = 0; l < DEPTH; ++l) {
        { OPAQUE_TID(); if (blockIdx.x == 0 && tid < 64) d_lam(tid, I_diff_lam + l * 256, ws, l); }
    }
    }
#endif
    for (int l = 0; l < DEPTH; ++l) {
        const float* wl = I_w_in + (size_t)l * 1024 * NIN; const float* ng = I_norm_g + l * 1024;
#if DO_PRO
        for (int rep_ = 0; rep_ <= REP_PRO; ++rep_) {
        { OPAQUE_TID(); float (*tile)[65] = (float (*)[65])(lds + (tid >> 8) * 64 * 65 * 4);
          const int njobs = 2952 + (l == 0 ? 1152 : 0);
          for (int it_ = 0; it_ * (int)gridDim.x * 2 < njobs; ++it_) {
              int j = (it_ * (int)gridDim.x + (int)blockIdx.x) * 2 + (tid >> 8); const bool active = j < njobs;
              const float* src = wl; int ld = NIN, K = 1024, mode = 1, bx = 0, by = 0; bf16* dst = (bf16*)(ws + OFF_WIN); const float* ks = ng;
              if (j < 1536) { bx = j % 96; by = j / 96; }
              else if (j < 2304) { j -= 1536; bx = j % 48; by = j / 48; src = wl + 5920; mode = 0; dst = (bf16*)(ws + OFF_WMG); }
              else if (j < 2688) { j -= 2304; const int i = j >> 7, r = j & 127; bx = r & 15; by = r >> 4; src = (const float*)KIN(16 + i) + (size_t)l * 512 * 1024; ld = 1024; K = 512; mode = 0; dst = (bf16*)(ws + OFF_WBR) + (size_t)i * 1024 * 512; ks = nullptr; }
              else if (j < 2944) { j -= 2688; const int kv = j >> 7, r = j & 127; bx = r & 3; by = r >> 2; src = (kv ? I_w1_v : I_w1_k) + (size_t)l * 2048 * 256; ld = 256; K = 2048; mode = 3; dst = (bf16*)(ws + OFF_CW1) + (size_t)kv * 256 * 2048; ks = nullptr; }
              else if (j < 2952) { j -= 2944; const int kv = j >> 2; by = j & 3; src = (kv ? I_w2_v : I_w2_k) + (size_t)l * 256 * 64; ld = 64; K = 256; mode = kv ? 0 : 2; dst = (bf16*)(ws + OFF_CW2) + (size_t)kv * 64 * 256; ks = nullptr; }
              else { j -= 2952; const int ll = j / 576, r = j % 576; ld = 1024; mode = 0; ks = nullptr;
                  if (r < 256) { bx = r & 15; by = r >> 4; src = I_w_out + (size_t)ll * 1024 * 1024; dst = (bf16*)(ws + OFF_WOUT) + (size_t)ll * 1024 * 1024; }
                  else if (r < 512) { const int r2 = r - 256; bx = r2 & 15; by = r2 >> 4; src = I_w_pg + (size_t)ll * 1024 * 1024; dst = (bf16*)(ws + OFF_WPG) + (size_t)ll * 1024 * 1024; }
                  else { const int r2 = r - 512; bx = r2 & 15; by = r2 >> 4; src = I_w_ple + (size_t)ll * 256 * 1024; K = 256; dst = (bf16*)(ws + OFF_WPL) + (size_t)ll * 1024 * 256; } }
              conv_tile(active, tile, tid & 255, src, ld, K, dst, ks, mode, bx, by);
          } }
        { OPAQUE_TID(); if (blockIdx.x >= 64 && blockIdx.x < 96 && tid < 256) d_cb1_part(blockIdx.x - 64, tid, I_pe_k + l * 2048, I_w1_k + (size_t)l * 2048 * 256, I_pe_v + l * 2048, I_w1_v + (size_t)l * 2048 * 256, ws); }
        }
#endif
        if (l == 0) grid.sync(); else GSYNC();
        EpiCtx E{ws, I_b_forget + l * 8, l == 0 ? I_x : X, X, 0};
#if DO_INPROJ
        { OPAQUE_TID(); if (blockIdx.x == 0) d_cb1_sum(tid, I_b1_k + l * 256, I_b1_v + l * 256, ws); }
        for (int rep_ = 0; rep_ <= REP_INPROJ; ++rep_) { FAST_GEMM(EPI_INPROJ, ws + OFF_XB, ws + OFF_WIN, NP, 1024, true); }
#endif
        GSYNC();
#if DO_ATTN
        { OPAQUE_TID();
          unsigned* qc = (unsigned*)(ws + OFF_Q) + 64 * l; unsigned* p2c = (unsigned*)(ws + OFF_Q) + 64 * (2 + l);
          const float lam = ((const float*)(ws + OFF_CTL))[CTL_LAM + l], lam_init = 0.8f - 0.6f * expf(-0.3f * (float)l);
          if (tid == 0) *(volatile LAS unsigned*)((LAS unsigned char*)lds + LDS_QSLOT) = xb_add(qc, 1u);
          bool p2seen = false;
          for (;;) {
              __syncthreads();
              const int u = __builtin_amdgcn_readfirstlane((int)*(volatile LAS unsigned*)((LAS unsigned char*)lds + LDS_QSLOT));
              if (u >= 1696) break;
              if (u < 160) {
                  if (u < 128) compress_unit(lds, ws, u >> 6, (u >> 3) & 7, u & 7); else cumsum_unit(lds, ws, u - 128);
                  asm volatile("s_waitcnt vmcnt(0)" ::: "memory");
                  __syncthreads();
                  if (tid == 0) { __builtin_amdgcn_fence(__ATOMIC_RELEASE, "agent"); asm volatile("s_waitcnt vmcnt(0)" ::: "memory"); (void)xb_add(p2c, 1u);
                                  *(volatile LAS unsigned*)((LAS unsigned char*)lds + LDS_QSLOT) = xb_add(qc, 1u); }
              } else if (u < 672) { const int v = u - 160; diff_unit(lds, ws, v & 15, 31 - (v >> 4), I_subln + l * 128, lam, lam_init, qc); }
              else {
                  if (!p2seen) {
                      if (tid == 0) { XB_SPIN(xb_ld(p2c) < 160u, xbar.bar); __builtin_amdgcn_fence(__ATOMIC_ACQUIRE, "agent"); asm volatile("s_waitcnt vmcnt(0)" ::: "memory"); }
                      __syncthreads(); p2seen = true; }
                  const int w = u - 672, qb = 15 - (w >> 6), r = w & 63;
                  if (r < 32) fox_unit(lds, ws, r, qb, qc); else nsa_unit(lds, ws, (r - 32) & 7, 4 * qb + 3 - ((r - 32) >> 3), qc);
              }
          }
        }
#endif
        GSYNC();
#if DO_GATEBR
        for (int rep_ = 0; rep_ <= REP_GATEBR; ++rep_) {
        { pg8::Gemm g_{(const pg8::bf16_t*)(ws + OFF_XB), (const pg8::bf16_t*)(ws + OFF_WMG), M, 3072, 1024}; ChainOrder S_; S_.init((int)gridDim.x, (int)blockIdx.x, 0);
          EpiFast<EPI_GATE3> Ep_{E}; pg8::gemm_phase<EpiFast<EPI_GATE3>, ChainOrder, true, true>((PG8_LAS unsigned char*)lds, g_, S_, Ep_); }
        { pg8::Gemm g_{(const pg8::bf16_t*)(ws + OFF_ZA), (const pg8::bf16_t*)(ws + OFF_WBR), 3 * M, 3072, 512}; ChainOrder S_; S_.init((int)gridDim.x, (int)blockIdx.x, 1);
          EpiFast<EPI_BR3> Ep_{E}; pg8::gemm_phase<EpiFast<EPI_BR3>, ChainOrder, true, true>((PG8_LAS unsigned char*)lds, g_, S_, Ep_); }
        }
#endif
        GSYNC();
#if DO_OUT
        for (int rep_ = 0; rep_ <= (l == 0 ? REP_OUT : 0); ++rep_) FAST_GEMM(EPI_OUT, (const bf16*)(ws + OFF_MERGED), (const bf16*)(ws + OFF_WOUT) + (size_t)l * 1024 * 1024, 1024, 1024, false);
#endif
        GSYNC();
#if DO_PLE
        for (int rep_ = 0; rep_ <= REP_U; ++rep_) FAST_GEMM(EPI_U, (const bf16*)(ws + OFF_PB) + (size_t)l * M * 256, (const bf16*)(ws + OFF_WPL) + (size_t)l * 1024 * 256, 1024, 256, false);
        FAST_GEMM(EPI_PLE, (const bf16*)(ws + OFF_X1B), (const bf16*)(ws + OFF_WPG) + (size_t)l * 1024 * 1024, 1024, 1024, false);
#endif
        GSYNC();
#if DO_TAIL
        for (int rep_ = 0; rep_ < 10 * REP_SYNC; ++rep_) GSYNC();
        for (int rep_ = 0; rep_ <= REP_SUMSQ; ++rep_) { if (l + 1 < DEPTH) VRUN(256, M / 4, d_sumsq(vb, vt, X, ws)); }
#endif
    }
#if DO_TAIL
    VRUN(256, M / 4, d_final(vb, vt, X, I_final_g));
#endif
}
#undef I_x
#undef I_p
#undef I_pos
#undef I_norm_g
#undef I_w_in
#undef I_b_forget
#undef I_pe_k
#undef I_w1_k
#undef I_b1_k
#undef I_w2_k
#undef I_pe_v
#undef I_w1_v
#undef I_b1_v
#undef I_w2_v
#undef I_diff_lam
#undef I_subln
#undef I_w_out
#undef I_w_ple
#undef I_w_pg
#undef I_final_g
#undef KIN

extern "C" void kernel_launch(void* const* d_in, const int* in_sizes, int n_in, void* d_out, int out_size, void* d_ws, size_t ws_size, hipStream_t stream) {
    static int grid_blocks = 0;
    if (grid_blocks == 0) {
        if (n_in != 23 || ws_size < WS_NEED || out_size != M * DM) { fprintf(stderr, "kernel_launch: unexpected sizes (n_in %d ws %zu out %d)\n", n_in, ws_size, out_size); grid_blocks = -1; return; }
        int dev = 0, cus = 0, per_cu = 0;
        (void)hipGetDevice(&dev); (void)hipDeviceGetAttribute(&cus, hipDeviceAttributeMultiprocessorCount, dev);
        (void)hipFuncSetAttribute((const void*)mega, hipFuncAttributeMaxDynamicSharedMemorySize, LDS_BYTES);
        (void)hipOccupancyMaxActiveBlocksPerMultiprocessor(&per_cu, (const void*)mega, NT, LDS_BYTES);
        if (per_cu < 1) { fprintf(stderr, "kernel_launch: occupancy query says %d blocks per CU\n", per_cu); grid_blocks = -1; return; }
        grid_blocks = cus * 1;
        if (grid_blocks != 256) { fprintf(stderr, "kernel_launch: built for a 256-CU device (got %d)\n", cus); grid_blocks = -1; return; }
    }
    if (grid_blocks < 0) return;
    (void)hipMemsetAsync((char*)d_ws + OFF_CTL, 0, 262144, stream);
    KArgs a{};
    for (int i = 0; i < 23; ++i) a.in[i] = d_in[i];
    a.out = (float*)d_out; a.ws = (unsigned char*)d_ws;
    void* args[] = {&a};
    hipError_t e = hipLaunchCooperativeKernel((const void*)mega, dim3(grid_blocks), dim3(NT), args, LDS_BYTES, stream);
    if (e != hipSuccess) fprintf(stderr, "cooperative launch failed: %s (grid %d)\n", hipGetErrorString(e), grid_blocks);
}
```

```cpp
#include <hip/hip_runtime.h>
#include <hip/hip_cooperative_groups.h>
#include <cstdio>
#include <cstdint>

typedef unsigned short bf16;
typedef short bf16x8 __attribute__((ext_vector_type(8)));
typedef float f32x4 __attribute__((ext_vector_type(4)));
typedef float f32x16 __attribute__((ext_vector_type(16)));
typedef unsigned u32x4 __attribute__((ext_vector_type(4)));
typedef unsigned u32x2 __attribute__((ext_vector_type(2)));

constexpr int BATCH = 4, SEQ = 4096, DM = 1024, M = BATCH * SEQ, DEPTH = 2, NIN = 8992, NP = 6144;
constexpr float EPS = 1e-6f;
constexpr float LOG2E = 1.4426950408889634f;
constexpr float C2 = 0.125f * LOG2E;
constexpr size_t MiB = 1u << 20;
constexpr size_t OFF_CTL = 0;
constexpr size_t OFF_WIN = 1 * MiB, OFF_WMG = 13 * MiB, OFF_WBR = 19 * MiB, OFF_CW1 = 22 * MiB, OFF_CW2 = 24 * MiB, OFF_CB1 = 24 * MiB + 128 * 1024;
constexpr size_t OFF_WOUT = 25 * MiB, OFF_WPG = 29 * MiB, OFF_WPL = 33 * MiB;
constexpr size_t OFF_XB = 34 * MiB, OFF_ZA = 66 * MiB, OFF_ZB = 82 * MiB, OFF_ZC = 98 * MiB;
constexpr size_t OFF_COS = 114 * MiB, OFF_SIN = 116 * MiB, OFF_PB = 118 * MiB;
constexpr size_t OFF_LOGF = 134 * MiB, OFF_CF = 134 * MiB + 512 * 1024, OFF_GATES = 135 * MiB, OFF_SSP = 136 * MiB + 512 * 1024;
constexpr size_t OFF_KCMP = 136 * MiB + 768 * 1024, OFF_VCMP = 137 * MiB, OFF_SELM = 137 * MiB + 256 * 1024;
constexpr size_t OFF_QA = 139 * MiB, OFF_KA = 155 * MiB, OFF_VA = 171 * MiB, OFF_QB = 187 * MiB, OFF_QC = 203 * MiB, OFF_KC = 219 * MiB, OFF_VC = 235 * MiB;
constexpr size_t OFF_KCB = 251 * MiB, OFF_VCB = 255 * MiB, OFF_KSEL = 259 * MiB, OFF_KWIN = 263 * MiB, OFF_VSEL = 267 * MiB, OFF_VWIN = 271 * MiB;
constexpr size_t WS_NEED = 275 * MiB;
constexpr size_t OFF_G = 139 * MiB  , OFF_T = 235 * MiB  , OFF_MERGED = OFF_T, OFF_X1B = 203 * MiB, OFF_U = 139 * MiB;
constexpr int CTL_LAM = 64;

__device__ __forceinline__ bf16 f2bf(float f) { unsigned u = __float_as_uint(f); return (bf16)((u + 0x7fffu + ((u >> 16) & 1u)) >> 16); }
__device__ __forceinline__ float bf2f(bf16 h) { return __uint_as_float(((unsigned)h) << 16); }
__device__ __forceinline__ unsigned pk2(float lo, float hi) { typedef float f2_ __attribute__((ext_vector_type(2))); typedef __bf16 b2_ __attribute__((ext_vector_type(2))); f2_ v = {lo, hi}; b2_ b = __builtin_convertvector(v, b2_); return __builtin_bit_cast(unsigned, b); }
__device__ __forceinline__ float sigmoidf_(float x) { return 1.f / (1.f + __expf(-x)); }
__device__ __forceinline__ float siluf_(float x) { return x / (1.f + __expf(-x)); }
__device__ __forceinline__ float logsigmoidf_(float x) { return x >= 0.f ? -log1pf(expf(-x)) : x - log1pf(expf(x)); }

__device__ __forceinline__ int ktile_off(int s, int d) { return (s >> 6) * 4096 + (d >> 3) * 512 + (s & 63) * 8 + (d & 7); }
__device__ __forceinline__ int vtile_off(int s, int d) { return (s >> 6) * 4096 + (d >> 5) * 2048 + ((s & 63) >> 4) * 512 + (s & 15) * 32 + (d & 31); }
__device__ __forceinline__ int v128_off(int s, int d) { return (s >> 6) * 8192 + (d >> 5) * 2048 + ((s & 63) >> 4) * 512 + (s & 15) * 32 + (d & 31); }

template <int W> __device__ __forceinline__ void store_bf(bf16* dst, const float* v) {
    if constexpr (W == 4) { u32x2 o; o.x = pk2(v[0], v[1]); o.y = pk2(v[2], v[3]); *(u32x2*)dst = o; }
    else { u32x4 o; o.x = pk2(v[0], v[1]); o.y = pk2(v[2], v[3]); o.z = pk2(v[4], v[5]); o.w = pk2(v[6], v[7]); *(u32x4*)dst = o; }
}

__device__ __forceinline__ int win_srccol(int n) {
    const int seg = n >> 6, j = n & 63; const int il = ((j & 1) << 5) + (j >> 1);
    if (seg < 8) return 0 + n;
    if (seg < 16) return 512 + (n - 512);
    if (seg < 24) return 1024 + (n - 1024);
    if (seg < 32) return 1544 + (n - 1536);
    if (seg < 40) return 2056 + (seg - 32) * 64 + il;
    if (seg < 42) return 2568 + (n - 2560);
    if (seg < 44) return 2696 + (n - 2688);
    if (seg < 46) return 2824 + (seg - 44) * 64 + il;
    if (seg < 48) return 3080 + (seg - 46) * 64 + il;
    if (seg < 50) return 2952 + (n - 3072);
    if (seg < 52) return 3208 + (n - 3200);
    if (seg < 60) return 3360 + (n - 3328);
    if (seg < 68) return 3872 + (seg - 60) * 64 + il;
    if (seg < 76) return 4384 + (seg - 68) * 64 + il;
    if (seg < 84) return 4896 + (n - 4864);
    if (seg < 92) return 5408 + (n - 5376);
    if (seg == 92) { if (j < 8) return 1536 + j; if (j < 32) return 3336 + (j - 8); return -1; }
    return -1;
}

enum { EPI_INPROJ = 0, EPI_GATE = 1, EPI_BR0 = 2, EPI_BR1 = 3, EPI_BR2 = 4, EPI_OUT = 5, EPI_U = 6, EPI_PLE = 7, EPI_GATE3 = 9, EPI_BR3 = 10 };
struct EpiCtx { unsigned char* ws; const float* bfg; const float* xin; float* X; int gi; };

__device__ __forceinline__ float row_rstd(const unsigned char* ws, int row) {
    const f32x4 sp = *(const f32x4*)(ws + OFF_SSP + (size_t)row * 16);
    return rsqrtf(((sp[0] + sp[1]) + (sp[2] + sp[3])) * (1.f / 1024.f) + EPS);
}

enum { T_QA = 0, T_KA, T_VA, T_ZA, T_QB, T_CB, T_KROPE, T_VSW, T_ZB, T_QC, T_KC, T_VC, T_ZC, T_SPECIAL };
__device__ __forceinline__ int inproj_type(int t) {
    return t < 2 ? T_QA : t < 4 ? T_KA : t < 6 ? T_VA : t < 8 ? T_ZA : t < 10 ? T_QB : t == 10 ? T_CB : t == 11 ? T_KROPE : t == 12 ? T_VSW : t < 15 ? T_ZB : t < 17 ? T_QC : t < 19 ? T_KC : t < 21 ? T_VC : t < 23 ? T_ZC : T_SPECIAL;
}
struct Pre { float rs; u32x4 ra, rb; f32x4 fa, fb; };
template <int KIND, int T> __device__ __forceinline__ void pre_load(const EpiCtx& E, int row, int col, Pre& p) {
    unsigned char* ws = E.ws; const size_t idx = (size_t)row * 1024 + col;
    if constexpr (KIND == EPI_INPROJ) {
        if constexpr (T == T_KROPE || T == T_QC || T == T_KC) { const int d = col & 63;
            p.fa = *(const f32x4*)((const float*)(ws + OFF_COS) + (size_t)row * 32 + (d >> 1)); p.fb = *(const f32x4*)((const float*)(ws + OFF_SIN) + (size_t)row * 32 + (d >> 1)); }
    } else if constexpr (KIND == EPI_GATE || KIND == EPI_GATE3) {
    } else if constexpr (KIND == EPI_BR3) {
        p.ra = *(const u32x4*)((const bf16*)(ws + OFF_G) + (size_t)E.gi * M * 1024 + idx);
        if (E.gi > 0) p.rb = *(const u32x4*)((const bf16*)(ws + OFF_T) + idx); else p.rb = (u32x4){0u, 0u, 0u, 0u};
    } else if constexpr (KIND == EPI_BR0 || KIND == EPI_BR1 || KIND == EPI_BR2) {
        p.ra = *(const u32x4*)((const bf16*)(ws + OFF_G) + idx);
        if constexpr (KIND != EPI_BR0) p.rb = *(const u32x4*)((const bf16*)(ws + OFF_T) + idx); else p.rb = (u32x4){0u, 0u, 0u, 0u};
    } else if constexpr (KIND == EPI_OUT) { p.fa = *(const f32x4*)(E.xin + idx); p.fb = *(const f32x4*)(E.xin + idx + 4);
    } else if constexpr (KIND == EPI_PLE) { p.ra = *(const u32x4*)((const bf16*)(ws + OFF_X1B) + idx); p.rb = *(const u32x4*)((const bf16*)(ws + OFF_U) + idx);
    }
}
__device__ __forceinline__ void st_f32x8(float* dst, const float* v) { f32x4 a = {v[0], v[1], v[2], v[3]}, b = {v[4], v[5], v[6], v[7]}; *(f32x4*)dst = a; *(f32x4*)(dst + 4) = b; }
template <int KIND, int T> __device__ __forceinline__ void emit_fin(const EpiCtx& E, int row, int col, const float* a, const Pre& p) {
    constexpr int W = 8;
    unsigned char* ws = E.ws; const size_t idx = (size_t)row * 1024 + col;
    float v[W], pa[8], pb[8];
    if constexpr (KIND == EPI_BR3 || KIND == EPI_BR0 || KIND == EPI_BR1 || KIND == EPI_BR2 || KIND == EPI_PLE) {
#pragma unroll
        for (int i = 0; i < 4; ++i) { pa[2 * i] = __uint_as_float(p.ra[i] << 16); pa[2 * i + 1] = __uint_as_float(p.ra[i] & 0xffff0000u); pb[2 * i] = __uint_as_float(p.rb[i] << 16); pb[2 * i + 1] = __uint_as_float(p.rb[i] & 0xffff0000u); }
    } else {
#pragma unroll
        for (int i = 0; i < 4; ++i) { pa[i] = p.fa[i]; pa[4 + i] = p.fb[i]; pb[i] = p.fb[i]; pb[4 + i] = 0.f; }
    }
    if constexpr (KIND == EPI_INPROJ) {
        const float rs = p.rs;
#pragma unroll
        for (int i = 0; i < W; ++i) v[i] = a[i] * rs;
        const int b = row >> 12, s = row & 4095;
        if constexpr (T == T_KROPE || T == T_QC || T == T_KC) {
#pragma unroll
            for (int j = 0; j < 4; ++j) { const float c = pa[j], sn = pb[j], x1 = v[2 * j], x2 = v[2 * j + 1]; v[2 * j] = x1 * c - x2 * sn; v[2 * j + 1] = x2 * c + x1 * sn; } }
        if constexpr (T == T_QA) { const int cc = col, h = cc >> 6, d = cc & 63;
#pragma unroll
            for (int i = 0; i < W; ++i) v[i] *= C2;
            store_bf<W>((bf16*)(ws + OFF_QA) + ((size_t)(b * 8 + h) * 4096 + s) * 64 + d, v);
        } else if constexpr (T == T_KA) { const int cc = col - 512, h = cc >> 6, d = cc & 63;
            store_bf<W>((bf16*)(ws + OFF_KA) + (size_t)(b * 8 + h) * 262144 + ktile_off(s, d), v);
        } else if constexpr (T == T_VA) { const int cc = col - 1024, h = cc >> 6, d = cc & 63;
            store_bf<W>((bf16*)(ws + OFF_VA) + (size_t)(b * 8 + h) * 262144 + vtile_off(s, d), v);
        } else if constexpr (T == T_ZA || T == T_ZB || T == T_ZC) { const int cc = col - (T == T_ZA ? 1536 : T == T_ZB ? 3328 : 5376);
#pragma unroll
            for (int i = 0; i < W; ++i) v[i] = siluf_(v[i]);
            store_bf<W>((bf16*)(ws + (T == T_ZA ? OFF_ZA : T == T_ZB ? OFF_ZB : OFF_ZC)) + (size_t)row * 512 + cc, v);
        } else if constexpr (T == T_QB) { const int cc = col - 2048, h = cc >> 6, d = cc & 63;
#pragma unroll
            for (int i = 0; i < W; ++i) v[i] *= C2;
            store_bf<W>((bf16*)(ws + OFF_QB) + ((size_t)(b * 8 + h) * 4096 + s) * 64 + d, v);
        } else if constexpr (T == T_CB) { const int cc = col - 2560, g = (cc >> 6) & 1, d = cc & 63;
            store_bf<W>((bf16*)(ws + (cc < 128 ? OFF_KCB : OFF_VCB)) + ((size_t)(b * 2 + g) * 4096 + s) * 64 + d, v);
        } else if constexpr (T == T_KROPE) { const int cc = col - 2816, g = (cc >> 6) & 1, d = cc & 63;
            store_bf<W>((bf16*)(ws + (cc < 128 ? OFF_KSEL : OFF_KWIN)) + (size_t)(b * 2 + g) * 262144 + ktile_off(s, d), v);
        } else if constexpr (T == T_VSW) { const int cc = col - 3072, g = (cc >> 6) & 1, d = cc & 63;
            store_bf<W>((bf16*)(ws + (cc < 128 ? OFF_VSEL : OFF_VWIN)) + (size_t)(b * 2 + g) * 262144 + vtile_off(s, d), v);
        } else if constexpr (T == T_QC) { const int cc = col - 3840, h = cc >> 6, d = cc & 63;
#pragma unroll
            for (int i = 0; i < W; ++i) v[i] *= C2;
            store_bf<W>((bf16*)(ws + OFF_QC) + ((size_t)(b * 8 + h) * 4096 + s) * 64 + d, v);
        } else if constexpr (T == T_KC) { const int cc = col - 4352, h = cc >> 6, d = cc & 63;
            store_bf<W>((bf16*)(ws + OFF_KC) + (size_t)(b * 8 + h) * 262144 + ktile_off(s, d), v);
        } else if constexpr (T == T_VC) { const int cc = col - 4864, hc = cc >> 7, d = cc & 127;
            store_bf<W>((bf16*)(ws + OFF_VC) + (size_t)(b * 4 + hc) * 524288 + v128_off(s, d), v);
        } else { const int cc = col - 5888;
            if (cc < 8) { float* o = (float*)(ws + OFF_LOGF) + (size_t)row * 8 + cc;
#pragma unroll
                for (int i = 0; i < W; ++i) o[i] = logsigmoidf_(v[i] + E.bfg[cc + i]) * LOG2E;
            } else if (cc < 32) { float* o = (float*)(ws + OFF_GATES) + (size_t)row * 24 + (cc - 8);
#pragma unroll
                for (int i = 0; i < W; ++i) o[i] = sigmoidf_(v[i]);
            }
        }
    } else if constexpr (KIND == EPI_GATE3) {
#pragma unroll
        for (int i = 0; i < W; ++i) v[i] = sigmoidf_(a[i] * p.rs);
        store_bf<W>((bf16*)(ws + OFF_G) + (size_t)E.gi * M * 1024 + idx, v);
    } else if constexpr (KIND == EPI_BR3) {
#pragma unroll
        for (int i = 0; i < W; ++i) v[i] = pa[i] * a[i] + pb[i];
        store_bf<W>((bf16*)(ws + OFF_T) + idx, v);
    } else if constexpr (KIND == EPI_GATE) {
#pragma unroll
        for (int i = 0; i < W; ++i) v[i] = sigmoidf_(a[i] * p.rs);
        store_bf<W>((bf16*)(ws + OFF_G) + idx, v);
    } else if constexpr (KIND == EPI_BR0 || KIND == EPI_BR1 || KIND == EPI_BR2) {
#pragma unroll
        for (int i = 0; i < W; ++i) { v[i] = pa[i] * a[i]; if (KIND != EPI_BR0) v[i] += pb[i]; }
        if constexpr (KIND == EPI_BR2) store_bf<W>((bf16*)(ws + OFF_MERGED) + idx, v);
        else store_bf<W>((bf16*)(ws + OFF_T) + idx, v);
    } else if constexpr (KIND == EPI_OUT) {
#pragma unroll
        for (int i = 0; i < W; ++i) v[i] = pa[i] + a[i];
        store_bf<W>((bf16*)(ws + OFF_X1B) + idx, v);
    } else if constexpr (KIND == EPI_U) {
        store_bf<W>((bf16*)(ws + OFF_U) + idx, a);
    } else if constexpr (KIND == EPI_PLE) {
#pragma unroll
        for (int i = 0; i < W; ++i) v[i] = pa[i] + sigmoidf_(a[i]) * pb[i];
        st_f32x8(E.X + idx, v);
    }
}

__device__ __forceinline__ void d_xprep(int vb, int vt, const float* x, unsigned char* ws) {
    const int row = vb * 4 + (vt >> 6), lane = vt & 63;
    const f32x4* xr = (const f32x4*)(x + (size_t)row * 1024) + lane; float ss = 0.f;
    bf16* o = (bf16*)(ws + OFF_XB) + (size_t)row * 1024;
    f32x4 v[4];
#pragma unroll
    for (int j = 0; j < 4; ++j) { v[j] = xr[64 * j]; ss += (v[j][0] * v[j][0] + v[j][1] * v[j][1]) + (v[j][2] * v[j][2] + v[j][3] * v[j][3]); }
#pragma unroll
    for (int of = 1; of < 64; of <<= 1) ss += __shfl_xor(ss, of);
    const float rs = rsqrtf(ss * (1.f / 1024.f) + EPS);
#pragma unroll
    for (int j = 0; j < 4; ++j) { float t[4] = {v[j][0] * rs, v[j][1] * rs, v[j][2] * rs, v[j][3] * rs}; store_bf<4>(o + 256 * j + 4 * lane, t); }
}
__device__ __forceinline__ void d_sumsq(int vb, int vt, const float* x, unsigned char* ws) {
    const int row = vb * 4 + (vt >> 6), lane = vt & 63;
    const f32x4* xr = (const f32x4*)(x + (size_t)row * 1024) + lane; float ss = 0.f;
    bf16* o = (bf16*)(ws + OFF_XB) + (size_t)row * 1024;
    f32x4 v[4];
#pragma unroll
    for (int j = 0; j < 4; ++j) { v[j] = xr[64 * j]; ss += (v[j][0] * v[j][0] + v[j][1] * v[j][1]) + (v[j][2] * v[j][2] + v[j][3] * v[j][3]); }
#pragma unroll
    for (int of = 1; of < 64; of <<= 1) ss += __shfl_xor(ss, of);
    const float rs = rsqrtf(ss * (1.f / 1024.f) + EPS);
#pragma unroll
    for (int j = 0; j < 4; ++j) { float t[4] = {v[j][0] * rs, v[j][1] * rs, v[j][2] * rs, v[j][3] * rs}; store_bf<4>(o + 256 * j + 4 * lane, t); }
}
__device__ __forceinline__ void d_rope_table(int vb, int vt, const int* pos, unsigned char* ws) {
    const int idx = vb * 256 + vt, row = idx >> 5, i = idx & 31;
    const float inv = exp2f(-(float)i * (13.287712379549449f / 32.f));
    const float ang = (float)pos[row] * inv;
    float s, c; sincosf(ang, &s, &c);
    ((float*)(ws + OFF_COS))[idx] = c; ((float*)(ws + OFF_SIN))[idx] = s;
}
__device__ __forceinline__ void d_pconv(int vb, int vt, const float* p, unsigned char* ws) {
    const size_t i = ((size_t)vb * 256 + vt) * 4;
    const f32x4 v = *(const f32x4*)(p + i); float t[4] = {v[0], v[1], v[2], v[3]}; store_bf<4>((bf16*)(ws + OFF_PB) + i, t);
}
constexpr size_t OFF_CBPART = OFF_CTL + 65536;
__device__ __forceinline__ void d_cb1_part(int u, int vt, const float* pe_k, const float* w1_k, const float* pe_v, const float* w1_v, unsigned char* ws) {
    const int kv = u >> 4, kc = u & 15, j = vt;
    const float* pe = (kv ? pe_v : pe_k) + 128 * kc; const float* w1 = (kv ? w1_v : w1_k) + (size_t)(128 * kc) * 256 + j;
    float acc = 0.f;
#pragma unroll 16
    for (int k = 0; k < 128; ++k) acc += pe[k] * w1[(size_t)k * 256];
    ((float*)(ws + OFF_CBPART))[(kv * 16 + kc) * 256 + j] = acc;
}
__device__ __forceinline__ void d_cb1_sum(int vt, const float* b1_k, const float* b1_v, unsigned char* ws) {
    const int kv = vt >> 8, j = vt & 255; float acc = (kv ? b1_v : b1_k)[j];
#pragma unroll
    for (int kc = 0; kc < 16; ++kc) acc += ((const float*)(ws + OFF_CBPART))[(kv * 16 + kc) * 256 + j];
    ((float*)(ws + OFF_CB1))[kv * 256 + j] = acc;
}
__device__ __forceinline__ void d_lam(int vt, const float* dl, unsigned char* ws, int l) {
    if (vt == 0) { float s1 = 0.f, s2 = 0.f; for (int i = 0; i < 64; ++i) { s1 += dl[i] * dl[64 + i]; s2 += dl[128 + i] * dl[192 + i]; }
        const float li = 0.8f - 0.6f * expf(-0.3f * (float)l); ((float*)(ws + OFF_CTL))[CTL_LAM + l] = expf(s1) - expf(s2) + li; }
}
__device__ __forceinline__ void d_final(int vb, int vt, float* X, const float* g) {
    const int row = vb * 4 + (vt >> 6), lane = vt & 63;
    f32x4* xr = (f32x4*)(X + (size_t)row * 1024) + lane; f32x4 v[4]; float ss = 0.f;
#pragma unroll
    for (int j = 0; j < 4; ++j) { v[j] = xr[64 * j]; ss += (v[j][0] * v[j][0] + v[j][1] * v[j][1]) + (v[j][2] * v[j][2] + v[j][3] * v[j][3]); }
#pragma unroll
    for (int of = 1; of < 64; of <<= 1) ss += __shfl_xor(ss, of);
    const float rs = rsqrtf(ss * (1.f / 1024.f) + EPS);
#pragma unroll
    for (int j = 0; j < 4; ++j) { const f32x4 gg = *((const f32x4*)g + 64 * j + lane); xr[64 * j] = v[j] * rs * gg; }
}


namespace pg8 {
#define PG8_LAS __attribute__((address_space(3)))
typedef unsigned short bf16_t;
typedef short bf16x8 __attribute__((ext_vector_type(8)));
typedef float f32x4 __attribute__((ext_vector_type(4)));
typedef unsigned u32x4 __attribute__((ext_vector_type(4)));
constexpr int BM = 256, BK = 64, HALF = 128, HTB = HALF * BK * 2  , STAGE_BYTES = 8 * HTB, NXCD = 8, WGM = 8;

__host__ __device__ __forceinline__ int lds_byte(int r, int c) { const int st = (r >> 4) * 2 + (c >> 5), rr = r & 15, cc = c & 31, ob = rr * 64 + cc * 2; return st * 1024 + (ob ^ (((ob >> 9) & 1) << 5)); }
__host__ __device__ __forceinline__ void stage_rc(int b, int& R, int& C) { const int st = b / 1024, sb = b % 1024, swz = sb ^ (((sb >> 9) & 1) << 5); R = (st >> 1) * 16 + swz / 64; C = (st & 1) * 32 + (swz % 64) / 2; }
__host__ __device__ __forceinline__ int perm32(int rho) { const int n = rho >> 4, i = rho & 15; return 8 * (i >> 2) + 4 * n + (i & 3); }

struct Unit { int pm, pn; };
struct Gemm { const bf16_t* A; const bf16_t* Bt; int M, N, K; };

struct StaticOrder {
    int nM, nN, nwg, G, c;
    __host__ __device__ void init(int M, int N, int G_, int c_) { nM = M / BM; nN = N / BM; nwg = nM * nN; G = G_; c = c_; }
    __host__ __device__ bool next(int i, Unit& u) const {
        const long L = (long)i * G + c; if (L >= nwg) return false;
        int wgid = (int)L; { const int q = nwg / NXCD, r = nwg % NXCD, xcd = wgid % NXCD, off = wgid / NXCD; wgid = (xcd < r ? xcd * (q + 1) : r * (q + 1) + (xcd - r) * q) + off; }
        const int nig = WGM * nN, gid = wgid / nig, fm = gid * WGM, gsz = (nM - fm) < WGM ? (nM - fm) : WGM;
        u.pm = fm + ((wgid % nig) % gsz); u.pn = (wgid % nig) / gsz; return true;
    }
    __device__ __forceinline__ void a_ready(const Unit&) const {}
    __device__ __forceinline__ void done(const Unit&) const {}
};

__device__ __forceinline__ unsigned cvt_pk_bf16(float lo, float hi) { unsigned r; asm volatile("v_cvt_pk_bf16_f32 %0, %1, %2" : "=v"(r) : "v"(lo), "v"(hi)); return r; }
typedef float f32x2 __attribute__((ext_vector_type(2)));
template <class Epi, class Sched, bool ALIGN_EPI = false, bool SP2 = false>
__device__ __forceinline__ void gemm_phase(PG8_LAS unsigned char* lds, const Gemm g, const Sched& S, const Epi& E) {
    int tid_o = threadIdx.x; asm volatile("" : "+v"(tid_o));
    const int tid = tid_o, wid = __builtin_amdgcn_readfirstlane(tid >> 6), lane = tid & 63, wr = wid >> 2, wc = wid & 3, fr = lane & 15, fq = lane >> 4;
    const int K = g.K, nt = K / BK;
    unsigned voffA[2], voffB[2];
#pragma unroll
    for (int i = 0; i < 2; ++i) { int R, C; stage_rc(tid * 16 + i * 8192, R, C); const int Rb = Epi::PERM ? ((R & ~31) + perm32(R & 31)) : R;
        voffA[i] = (unsigned)(R * K + C) * 2u; voffB[i] = (unsigned)(Rb * K + C) * 2u; }
    const size_t kstep = (size_t)(BK * 2);
    const size_t hstep = (size_t)HALF * K * 2;
    const size_t tstep = 2 * hstep;
    const unsigned ldsw = (unsigned)wid * 1024u;
    const int aoff = lds_byte(wr * 64 + fr, fq * 8), boff = lds_byte(wc * 32 + fr, fq * 8);
#define PG8_SA(b, h) (((b) * 2 + (h)) * HTB)
#define PG8_SB(b, h) ((4 + (b) * 2 + (h)) * HTB)
#define PG8_STAGE(bufoff, gbase, voff) do { _Pragma("unroll") for (int _i = 0; _i < 2; ++_i) \
        __builtin_amdgcn_global_load_lds((const unsigned*)((const char*)(gbase) + (voff)[_i]), (PG8_LAS unsigned*)(lds + (bufoff) + ldsw + _i * 8192), 16, 0, 0); } while (0)
#define PG8_LDA(dst, b, h) do { _Pragma("unroll") for (int m = 0; m < 4; ++m) _Pragma("unroll") for (int k = 0; k < 2; ++k) dst[m][k] = *(const PG8_LAS bf16x8*)(lds + PG8_SA(b, h) + aoff + m * 2048 + k * 1024); } while (0)
#define PG8_LDB(dst, b, h) do { _Pragma("unroll") for (int n = 0; n < 2; ++n) _Pragma("unroll") for (int k = 0; k < 2; ++k) dst[n][k] = *(const PG8_LAS bf16x8*)(lds + PG8_SB(b, h) + boff + n * 2048 + k * 1024); } while (0)
#define PG8_MMA(ai, bj, At, Bt) do { __builtin_amdgcn_s_setprio(1); _Pragma("unroll") for (int m = 0; m < 4; ++m) _Pragma("unroll") for (int n = 0; n < 2; ++n) _Pragma("unroll") for (int k = 0; k < 2; ++k) \
        acc[ai][bj][m][n] = __builtin_amdgcn_mfma_f32_16x16x32_bf16(Bt[n][k], At[m][k], acc[ai][bj][m][n], 0, 0, 0); __builtin_amdgcn_s_setprio(0); } while (0)
#define PG8_WAIT_V(n) asm volatile("s_waitcnt vmcnt(" #n ")" ::: "memory")
#define PG8_WAIT_L(n) asm volatile("s_waitcnt lgkmcnt(" #n ")" ::: "memory")
#define PG8_BAR __builtin_amdgcn_s_barrier()
#define PG8_SCHED __builtin_amdgcn_sched_barrier(0)
    Unit cur, nxt; int ui = 0;
    if (!S.next(0, cur)) return;
    f32x4 acc[2][2][4][2];
#pragma unroll
    for (int a = 0; a < 2; ++a)
#pragma unroll
        for (int b = 0; b < 2; ++b)
#pragma unroll
            for (int m = 0; m < 4; ++m)
#pragma unroll
                for (int n = 0; n < 2; ++n) acc[a][b][m][n] = (f32x4){0.f, 0.f, 0.f, 0.f};
    bf16x8 At[4][2], B0[2][2], B1[2][2];
    const char* cA = (const char*)g.A + (size_t)cur.pm * tstep; const char* cB = (const char*)g.Bt + (size_t)cur.pn * tstep;
    S.a_ready(cur);
    if constexpr (SP2) {
        PG8_STAGE(PG8_SB(0, 0), cB, voffB); PG8_STAGE(PG8_SB(0, 1), cB + hstep, voffB); PG8_STAGE(PG8_SA(0, 0), cA, voffA); PG8_STAGE(PG8_SA(0, 1), cA + hstep, voffA);
        if (wr == 1) PG8_BAR;
        PG8_WAIT_V(2); PG8_BAR;
        PG8_STAGE(PG8_SB(1, 0), cB + kstep, voffB); PG8_STAGE(PG8_SA(1, 0), cA + kstep, voffA); PG8_STAGE(PG8_SB(1, 1), cB + hstep + kstep, voffB);
        PG8_WAIT_V(6); PG8_BAR;
    } else {
        PG8_STAGE(PG8_SB(0, 0), cB, voffB); PG8_STAGE(PG8_SA(0, 0), cA, voffA); PG8_STAGE(PG8_SB(0, 1), cB + hstep, voffB); PG8_STAGE(PG8_SA(0, 1), cA + hstep, voffA);
        if (wr == 1) PG8_BAR;
        PG8_WAIT_V(4); PG8_BAR;
        PG8_STAGE(PG8_SB(1, 0), cB + kstep, voffB); PG8_STAGE(PG8_SA(1, 0), cA + kstep, voffA); PG8_STAGE(PG8_SB(1, 1), cB + hstep + kstep, voffB);
        PG8_WAIT_V(6); PG8_BAR;
    }
    for (;;) {
        const bool has_next = S.next(ui + 1, nxt);
        const char* nA = has_next ? (const char*)g.A + (size_t)nxt.pm * tstep : cA; const char* nB = has_next ? (const char*)g.Bt + (size_t)nxt.pn * tstep : cB;
        for (int t = 0; t < nt; t += 2) {
            const bool last = (t == nt - 2);
            const char* a1 = cA + (size_t)(t + 1) * kstep;
            const char* a2 = last ? nA : cA + (size_t)(t + 2) * kstep; const char* b2 = last ? nB : cB + (size_t)(t + 2) * kstep;
            const char* a3 = a2 + kstep; const char* b3 = b2 + kstep;
            if (last && has_next) S.a_ready(nxt);
            if constexpr (SP2) {
            PG8_LDB(B0, 0, 0); PG8_LDB(B1, 0, 1); PG8_SCHED; PG8_LDA(At, 0, 0); PG8_STAGE(PG8_SA(1, 1), a1 + hstep, voffA);
            PG8_WAIT_V(8); PG8_WAIT_L(0); PG8_BAR; PG8_MMA(0, 0, At, B0); PG8_MMA(0, 1, At, B1); PG8_BAR; PG8_SCHED;
            PG8_LDA(At, 0, 1); PG8_STAGE(PG8_SB(0, 0), b2, voffB); PG8_STAGE(PG8_SB(0, 1), b2 + hstep, voffB); PG8_STAGE(PG8_SA(0, 0), a2, voffA);
            PG8_WAIT_V(8); PG8_WAIT_L(0); PG8_BAR; PG8_MMA(1, 0, At, B0); PG8_MMA(1, 1, At, B1); PG8_BAR; PG8_SCHED;
            PG8_LDB(B0, 1, 0); PG8_LDB(B1, 1, 1); PG8_SCHED; PG8_LDA(At, 1, 0); PG8_STAGE(PG8_SA(0, 1), a2 + hstep, voffA);
            PG8_WAIT_V(8); PG8_WAIT_L(0); PG8_BAR; PG8_MMA(0, 0, At, B0); PG8_MMA(0, 1, At, B1); PG8_BAR; PG8_SCHED;
            PG8_LDA(At, 1, 1); PG8_STAGE(PG8_SB(1, 0), b3, voffB); PG8_STAGE(PG8_SB(1, 1), b3 + hstep, voffB); PG8_STAGE(PG8_SA(1, 0), a3, voffA);
            PG8_WAIT_V(8); PG8_WAIT_L(0); PG8_BAR; PG8_MMA(1, 0, At, B0); PG8_MMA(1, 1, At, B1); PG8_BAR; PG8_SCHED;
            } else {
            PG8_LDB(B0, 0, 0); PG8_SCHED; PG8_LDA(At, 0, 0); PG8_STAGE(PG8_SA(1, 1), a1 + hstep, voffA);
            PG8_WAIT_L(8); PG8_BAR; PG8_WAIT_L(0); PG8_MMA(0, 0, At, B0); PG8_BAR; PG8_SCHED;
            PG8_LDB(B1, 0, 1); PG8_STAGE(PG8_SB(0, 0), b2, voffB);
            PG8_BAR; PG8_WAIT_L(0); PG8_MMA(0, 1, At, B1); PG8_BAR;
            PG8_LDA(At, 0, 1); PG8_STAGE(PG8_SA(0, 0), a2, voffA);
            PG8_BAR; PG8_WAIT_L(0); PG8_MMA(1, 0, At, B0); PG8_BAR; PG8_SCHED;
            PG8_STAGE(PG8_SB(0, 1), b2 + hstep, voffB);
            PG8_WAIT_V(6); PG8_BAR; PG8_MMA(1, 1, At, B1); PG8_BAR;
            PG8_LDB(B0, 1, 0); PG8_SCHED; PG8_LDA(At, 1, 0); PG8_STAGE(PG8_SA(0, 1), a2 + hstep, voffA);
            PG8_WAIT_L(8); PG8_BAR; PG8_WAIT_L(0); PG8_MMA(0, 0, At, B0); PG8_BAR; PG8_SCHED;
            PG8_LDB(B1, 1, 1); PG8_STAGE(PG8_SB(1, 0), b3, voffB);
            PG8_BAR; PG8_WAIT_L(0); PG8_MMA(0, 1, At, B1); PG8_BAR;
            PG8_LDA(At, 1, 1); PG8_STAGE(PG8_SA(1, 0), a3, voffA);
            PG8_BAR; PG8_WAIT_L(0); PG8_MMA(1, 0, At, B0); PG8_BAR; PG8_SCHED;
            PG8_STAGE(PG8_SB(1, 1), b3 + hstep, voffB);
            PG8_WAIT_V(6); PG8_BAR; PG8_MMA(1, 1, At, B1); PG8_BAR;
            }
        }
        if constexpr (ALIGN_EPI) { if (wr == 0) PG8_BAR; }
        if constexpr (!Epi::AFTER_DRAIN) { E(acc, cur, wr, wc, fr, fq); S.done(cur); }
        if (!has_next) break;
#pragma unroll
        for (int a = 0; a < 2; ++a)
#pragma unroll
            for (int b = 0; b < 2; ++b)
#pragma unroll
                for (int m = 0; m < 4; ++m)
#pragma unroll
                    for (int n = 0; n < 2; ++n) acc[a][b][m][n] = (f32x4){0.f, 0.f, 0.f, 0.f};
        cur = nxt; cA = nA; cB = nB; ++ui;
        if constexpr (ALIGN_EPI) { if (wr == 1) PG8_BAR; }
    }
    PG8_WAIT_V(0);
    if constexpr (!ALIGN_EPI) { if (wr == 0) PG8_BAR; }
    PG8_BAR;
    if constexpr (Epi::AFTER_DRAIN) { E.fused(acc, cur, wr, wc, fr, fq, lds, wid, lane); S.done(cur); }
#undef PG8_SA
#undef PG8_SB
#undef PG8_STAGE
#undef PG8_LDA
#undef PG8_LDB
#undef PG8_MMA
#undef PG8_WAIT_V
#undef PG8_WAIT_L
#undef PG8_BAR
#undef PG8_SCHED
}
}

template <int KIND> struct EpiFast {
    static constexpr bool PERM = true, AFTER_DRAIN = false;
    EpiCtx E;
    template <int T, int AI, int MH> __device__ __forceinline__ void grp_load(int row0, int col0, Pre (&p)[4]) const {
        const int r0 = row0 + AI * 128 + (2 * MH) * 16, r1 = r0 + 16;
        p[0].rs = p[1].rs = p[2].rs = p[3].rs = 1.f;
        pre_load<KIND, T>(E, r0, col0, p[0]); pre_load<KIND, T>(E, r0, col0 + 128, p[1]); pre_load<KIND, T>(E, r1, col0, p[2]); pre_load<KIND, T>(E, r1, col0 + 128, p[3]);
        asm volatile("" ::: "memory");
    }
    template <int T, int AI, int MH> __device__ __forceinline__ void grp_emit(const pg8::f32x4 (&acc)[2][2][4][2], int row0, int col0, const Pre (&p)[4]) const {
        const int r0 = row0 + AI * 128 + (2 * MH) * 16, r1 = r0 + 16;
        { const pg8::f32x4 v0 = acc[AI][0][2 * MH][0], v1 = acc[AI][0][2 * MH][1]; float v[8] = {v0[0], v0[1], v0[2], v0[3], v1[0], v1[1], v1[2], v1[3]}; emit_fin<KIND, T>(E, r0, col0, v, p[0]); }
        { const pg8::f32x4 v0 = acc[AI][1][2 * MH][0], v1 = acc[AI][1][2 * MH][1]; float v[8] = {v0[0], v0[1], v0[2], v0[3], v1[0], v1[1], v1[2], v1[3]}; emit_fin<KIND, T>(E, r0, col0 + 128, v, p[1]); }
        { const pg8::f32x4 v0 = acc[AI][0][2 * MH + 1][0], v1 = acc[AI][0][2 * MH + 1][1]; float v[8] = {v0[0], v0[1], v0[2], v0[3], v1[0], v1[1], v1[2], v1[3]}; emit_fin<KIND, T>(E, r1, col0, v, p[2]); }
        { const pg8::f32x4 v0 = acc[AI][1][2 * MH + 1][0], v1 = acc[AI][1][2 * MH + 1][1]; float v[8] = {v0[0], v0[1], v0[2], v0[3], v1[0], v1[1], v1[2], v1[3]}; emit_fin<KIND, T>(E, r1, col0 + 128, v, p[3]); }
        asm volatile("" ::: "memory");
    }
    template <int T> __device__ __forceinline__ void run(const pg8::f32x4 (&acc)[2][2][4][2], int row0, int col0) const {
        Pre pA[4], pB[4];
        grp_load<T, 0, 0>(row0, col0, pA); grp_load<T, 0, 1>(row0, col0, pB);
        grp_emit<T, 0, 0>(acc, row0, col0, pA); grp_load<T, 1, 0>(row0, col0, pA);
        grp_emit<T, 0, 1>(acc, row0, col0, pB); grp_load<T, 1, 1>(row0, col0, pB);
        grp_emit<T, 1, 0>(acc, row0, col0, pA); grp_emit<T, 1, 1>(acc, row0, col0, pB);
    }
    __device__ __forceinline__ void operator()(const pg8::f32x4 (&acc)[2][2][4][2], const pg8::Unit& u, int wr, int wc, int fr, int fq) const {
        const int row0 = u.pm * 256 + wr * 64 + fr, col0 = u.pn * 256 + wc * 32 + 8 * fq;
        if constexpr (KIND == EPI_INPROJ) {
            switch (inproj_type(u.pn)) {
                case T_QA: run<T_QA>(acc, row0, col0); break;
                case T_KA: run<T_KA>(acc, row0, col0); break;
                case T_VA: run<T_VA>(acc, row0, col0); break;
                case T_ZA: run<T_ZA>(acc, row0, col0); break;
                case T_QB: run<T_QB>(acc, row0, col0); break;
                case T_CB: run<T_CB>(acc, row0, col0); break;
                case T_KROPE: run<T_KROPE>(acc, row0, col0); break;
                case T_VSW: run<T_VSW>(acc, row0, col0); break;
                case T_ZB: run<T_ZB>(acc, row0, col0); break;
                case T_QC: run<T_QC>(acc, row0, col0); break;
                case T_KC: run<T_KC>(acc, row0, col0); break;
                case T_VC: run<T_VC>(acc, row0, col0); break;
                case T_ZC: run<T_ZC>(acc, row0, col0); break;
                default: run<T_SPECIAL>(acc, row0, col0); break;
            }
        } else if constexpr (KIND == EPI_GATE3 || KIND == EPI_BR3) {
            EpiFast<KIND> t = *this; t.E.gi = u.pn >> 2;
            t.template run<0>(acc, (u.pm & 63) * 256 + wr * 64 + fr, (u.pn & 3) * 256 + wc * 32 + 8 * fq);
        } else run<0>(acc, row0, col0);
    }
};
struct ChainOrder {
    int pm, pn4, rowmul;
    __device__ __forceinline__ void init(int G, int c, int rowmul_) { pg8::StaticOrder S0; S0.init(M, 1024, G, c); pg8::Unit u0; S0.next(0, u0); pm = u0.pm; pn4 = u0.pn; rowmul = rowmul_; }
    __device__ __forceinline__ bool next(int i, pg8::Unit& u) const { if (i >= 3) return false; u.pm = pm + 64 * i * rowmul; u.pn = 4 * i + pn4; return true; }
    __device__ __forceinline__ void a_ready(const pg8::Unit&) const {}
    __device__ __forceinline__ void done(const pg8::Unit&) const {}
};
#define FAST_GEMM(KIND, Aptr, Bptr, N_, K_, ALIGN) do { pg8::Gemm g_{(const pg8::bf16_t*)(Aptr), (const pg8::bf16_t*)(Bptr), M, (N_), (K_)}; pg8::StaticOrder S_; S_.init(M, (N_), (int)gridDim.x, (int)blockIdx.x); \
        EpiFast<KIND> Ep_{E}; pg8::gemm_phase<EpiFast<KIND>, pg8::StaticOrder, ALIGN, true>((PG8_LAS unsigned char*)lds, g_, S_, Ep_); } while (0)

#define LAS __attribute__((address_space(3)))
typedef short s16x4 __attribute__((ext_vector_type(4)));
typedef short v4i16_t __attribute__((ext_vector_type(4)));
typedef LAS const char* lds_cptr;
constexpr int A_KRING = 0, A_VRING = 49152, A_CFRING = 98304, A_MISC = 104448;
constexpr int A_SLOT = 16384;
constexpr int A_IMP = A_MISC, A_SELM = A_MISC + 16384, A_UMASK = A_SELM + 512, A_SEQ = A_UMASK + 16, A_WQ = A_SEQ + 80;
__device__ __forceinline__ void glds16(const void* gsrc, unsigned lds_dst) { unsigned keep;
    asm volatile("s_mov_b32 %0, m0\n\ts_mov_b32 m0, %2\n\ts_nop 0\n\tglobal_load_lds_dwordx4 %1, off\n\ts_mov_b32 m0, %0" : "=&s"(keep) : "v"(gsrc), "s"(lds_dst) : "memory"); }
__device__ __forceinline__ void glds4(const void* gsrc, unsigned lds_dst) { unsigned keep;
    asm volatile("s_mov_b32 %0, m0\n\ts_mov_b32 m0, %2\n\ts_nop 0\n\tglobal_load_lds_dword %1, off\n\ts_mov_b32 m0, %0" : "=&s"(keep) : "v"(gsrc), "s"(lds_dst) : "memory"); }
#define A_WAIT_BAR(N) asm volatile("s_waitcnt vmcnt(" #N ") lgkmcnt(0)\n\ts_barrier" ::: "memory")
constexpr int LDS_QSLOT = 131072 + 128;
#define Q_TAKE(qn, qc) unsigned qn = 0u; if (tid == 0) qn = __hip_atomic_fetch_add((qc), 1u, __ATOMIC_RELAXED, __HIP_MEMORY_SCOPE_AGENT)
#define Q_PARK(qn) do { if (tid == 0) *(volatile LAS unsigned*)((LAS unsigned char*)lds + LDS_QSLOT) = qn; } while (0)
__device__ __forceinline__ s16x4 vtr(lds_cptr p) { return __builtin_bit_cast(s16x4, __builtin_amdgcn_ds_read_tr16_b64_v4i16((LAS v4i16_t*)p)); }
__device__ __forceinline__ unsigned cvtpk(float lo, float hi) { typedef float f2 __attribute__((ext_vector_type(2))); typedef __bf16 b2 __attribute__((ext_vector_type(2))); f2 v = {lo, hi}; b2 b = __builtin_convertvector(v, b2); return __builtin_bit_cast(unsigned, b); }
__device__ __forceinline__ int crow(int r, int hi) { return (r & 3) + 8 * (r >> 2) + 4 * hi; }

template <int NDB> struct FlashSt { f32x16 o[NDB]; float m, l; };
template <int NDB> __device__ __forceinline__ void flash_init(FlashSt<NDB>& st) {
#pragma unroll
    for (int i = 0; i < NDB; ++i)
#pragma unroll
        for (int r = 0; r < 16; ++r) st.o[i][r] = 0.f;
    st.m = -1e30f; st.l = 0.f;
}
template <int NDB> __device__ __forceinline__ void flash_init3(FlashSt<NDB>& st) { flash_init<NDB>(st); st.m = 0.f; }
__device__ __forceinline__ void qk_tile(f32x16& p0, f32x16& p1, lds_cptr kslot, const bf16x8 (&qf)[4], int r32, int hi) {
    const lds_cptr kb = kslot + hi * 1024 + r32 * 16;
    bf16x8 ka[4], kc[4];
#pragma unroll
    for (int d0 = 0; d0 < 4; ++d0) { ka[d0] = *(const LAS bf16x8*)(kb + d0 * 2048); kc[d0] = *(const LAS bf16x8*)(kb + d0 * 2048 + 512); }
#pragma unroll
    for (int d0 = 0; d0 < 4; ++d0) {
        p0 = __builtin_amdgcn_mfma_f32_32x32x16_bf16(ka[d0], qf[d0], p0, 0, 0, 0);
        p1 = __builtin_amdgcn_mfma_f32_32x32x16_bf16(kc[d0], qf[d0], p1, 0, 0, 0);
    }
}
__device__ __forceinline__ float xhalf_max(float a) {
    auto rr = __builtin_amdgcn_permlane32_swap(__float_as_uint(a), __float_as_uint(a), false, false);
    return fmaxf(__uint_as_float(rr[0]), __uint_as_float(rr[1]));
}
__device__ __forceinline__ float rowmax32(const f32x16& p0, const f32x16& p1) {
    float a = fmaxf(p0[0], p1[0]);
#pragma unroll
    for (int r = 1; r < 16; ++r) a = fmaxf(a, fmaxf(p0[r], p1[r]));
    return xhalf_max(a);
}
template <int NDB> __device__ __forceinline__ void pv_tile(f32x16 (&o)[NDB], lds_cptr vslot_l, const f32x16& p0, const f32x16& p1) {
    bf16x8 pf[4];
    { u32x4 w;
      w.x = cvtpk(p0[0], p0[1]); w.y = cvtpk(p0[2], p0[3]); w.z = cvtpk(p0[4], p0[5]); w.w = cvtpk(p0[6], p0[7]); pf[0] = __builtin_bit_cast(bf16x8, w);
      w.x = cvtpk(p0[8], p0[9]); w.y = cvtpk(p0[10], p0[11]); w.z = cvtpk(p0[12], p0[13]); w.w = cvtpk(p0[14], p0[15]); pf[1] = __builtin_bit_cast(bf16x8, w);
      w.x = cvtpk(p1[0], p1[1]); w.y = cvtpk(p1[2], p1[3]); w.z = cvtpk(p1[4], p1[5]); w.w = cvtpk(p1[6], p1[7]); pf[2] = __builtin_bit_cast(bf16x8, w);
      w.x = cvtpk(p1[8], p1[9]); w.y = cvtpk(p1[10], p1[11]); w.z = cvtpk(p1[12], p1[13]); w.w = cvtpk(p1[14], p1[15]); pf[3] = __builtin_bit_cast(bf16x8, w); }
#pragma unroll
    for (int db = 0; db < NDB; ++db) {
        bf16x8 vf[4];
#pragma unroll
        for (int ks = 0; ks < 4; ++ks) { const s16x4 lo = vtr(vslot_l + db * 4096 + ks * 1024), hh = vtr(vslot_l + db * 4096 + ks * 1024 + 512);
            vf[ks] = (bf16x8){lo[0], lo[1], lo[2], lo[3], hh[0], hh[1], hh[2], hh[3]}; }
#pragma unroll
        for (int ks = 0; ks < 4; ++ks) o[db] = __builtin_amdgcn_mfma_f32_32x32x16_bf16(vf[ks], pf[ks], o[db], 0, 0, 0);
    }
}
template <int NDB> __device__ __forceinline__ void flash_update(FlashSt<NDB>& st, f32x16& p0, f32x16& p1, lds_cptr vslot_l) {
    const float rm = rowmax32(p0, p1);
    const float mn = fmaxf(st.m, rm), alpha = __builtin_amdgcn_exp2f(st.m - mn);
    st.m = mn;
    float ls = 0.f;
#pragma unroll
    for (int r = 0; r < 16; ++r) { p0[r] = __builtin_amdgcn_exp2f(p0[r] - mn); p1[r] = __builtin_amdgcn_exp2f(p1[r] - mn); ls += p0[r] + p1[r]; }
    st.l = st.l * alpha + ls;
#pragma unroll
    for (int db = 0; db < NDB; ++db)
#pragma unroll
        for (int r = 0; r < 16; ++r) st.o[db][r] *= alpha;
    pv_tile<NDB>(st.o, vslot_l, p0, p1);
}
__device__ __forceinline__ int lane_vbase(int lane) { return ((lane >> 4) & 1) * 32 + (lane & 3) * 8 + (4 * (lane >> 5) + ((lane & 15) >> 2)) * 64; }
#define DSR128(dst, addr, off) asm volatile("ds_read_b128 %0, %1 offset:%c2" : "=v"(dst) : "v"(addr), "i"(off) : "memory")
#define DSRTR(dst, addr, off) asm volatile("ds_read_b64_tr_b16 %0, %1 offset:%c2" : "=v"(dst) : "v"(addr), "i"(off) : "memory")
#define LGKM_WAIT0() do { asm volatile("s_waitcnt lgkmcnt(0)" ::: "memory"); __builtin_amdgcn_sched_barrier(0); } while (0)
__device__ __forceinline__ void qk_tile2(f32x16& p0, f32x16& p1, unsigned kaddr, const bf16x8 (&qf)[4]) {
    bf16x8 ka0, ka1, ka2, ka3, kc0, kc1, kc2, kc3;
    DSR128(ka0, kaddr, 0); DSR128(kc0, kaddr, 512); DSR128(ka1, kaddr, 2048); DSR128(kc1, kaddr, 2560);
    DSR128(ka2, kaddr, 4096); DSR128(kc2, kaddr, 4608); DSR128(ka3, kaddr, 6144); DSR128(kc3, kaddr, 6656);
    LGKM_WAIT0();
    __builtin_amdgcn_s_setprio(1);
    p0 = __builtin_amdgcn_mfma_f32_32x32x16_bf16(ka0, qf[0], p0, 0, 0, 0); p1 = __builtin_amdgcn_mfma_f32_32x32x16_bf16(kc0, qf[0], p1, 0, 0, 0);
    p0 = __builtin_amdgcn_mfma_f32_32x32x16_bf16(ka1, qf[1], p0, 0, 0, 0); p1 = __builtin_amdgcn_mfma_f32_32x32x16_bf16(kc1, qf[1], p1, 0, 0, 0);
    p0 = __builtin_amdgcn_mfma_f32_32x32x16_bf16(ka2, qf[2], p0, 0, 0, 0); p1 = __builtin_amdgcn_mfma_f32_32x32x16_bf16(kc2, qf[2], p1, 0, 0, 0);
    p0 = __builtin_amdgcn_mfma_f32_32x32x16_bf16(ka3, qf[3], p0, 0, 0, 0); p1 = __builtin_amdgcn_mfma_f32_32x32x16_bf16(kc3, qf[3], p1, 0, 0, 0);
    __builtin_amdgcn_s_setprio(0);
}
struct VFr { s16x4 lo[8], hi[8]; };
template <int DB0> __device__ __forceinline__ void v_issue(VFr& f, unsigned vaddr) {
    DSRTR(f.lo[0], vaddr, DB0 * 4096 + 0);    DSRTR(f.hi[0], vaddr, DB0 * 4096 + 512);
    DSRTR(f.lo[1], vaddr, DB0 * 4096 + 1024); DSRTR(f.hi[1], vaddr, DB0 * 4096 + 1536);
    DSRTR(f.lo[2], vaddr, DB0 * 4096 + 2048); DSRTR(f.hi[2], vaddr, DB0 * 4096 + 2560);
    DSRTR(f.lo[3], vaddr, DB0 * 4096 + 3072); DSRTR(f.hi[3], vaddr, DB0 * 4096 + 3584);
    DSRTR(f.lo[4], vaddr, DB0 * 4096 + 4096); DSRTR(f.hi[4], vaddr, DB0 * 4096 + 4608);
    DSRTR(f.lo[5], vaddr, DB0 * 4096 + 5120); DSRTR(f.hi[5], vaddr, DB0 * 4096 + 5632);
    DSRTR(f.lo[6], vaddr, DB0 * 4096 + 6144); DSRTR(f.hi[6], vaddr, DB0 * 4096 + 6656);
    DSRTR(f.lo[7], vaddr, DB0 * 4096 + 7168); DSRTR(f.hi[7], vaddr, DB0 * 4096 + 7680);
}
#define VFRAG(f, i) ((bf16x8){(f).lo[i][0], (f).lo[i][1], (f).lo[i][2], (f).lo[i][3], (f).hi[i][0], (f).hi[i][1], (f).hi[i][2], (f).hi[i][3]})
__device__ __forceinline__ void pv2(f32x16& oa, f32x16& ob, const VFr& f, const bf16x8 (&pf)[4]) {
    __builtin_amdgcn_s_setprio(1);
    oa = __builtin_amdgcn_mfma_f32_32x32x16_bf16(VFRAG(f, 0), pf[0], oa, 0, 0, 0); ob = __builtin_amdgcn_mfma_f32_32x32x16_bf16(VFRAG(f, 4), pf[0], ob, 0, 0, 0);
    oa = __builtin_amdgcn_mfma_f32_32x32x16_bf16(VFRAG(f, 1), pf[1], oa, 0, 0, 0); ob = __builtin_amdgcn_mfma_f32_32x32x16_bf16(VFRAG(f, 5), pf[1], ob, 0, 0, 0);
    oa = __builtin_amdgcn_mfma_f32_32x32x16_bf16(VFRAG(f, 2), pf[2], oa, 0, 0, 0); ob = __builtin_amdgcn_mfma_f32_32x32x16_bf16(VFRAG(f, 6), pf[2], ob, 0, 0, 0);
    oa = __builtin_amdgcn_mfma_f32_32x32x16_bf16(VFRAG(f, 3), pf[3], oa, 0, 0, 0); ob = __builtin_amdgcn_mfma_f32_32x32x16_bf16(VFRAG(f, 7), pf[3], ob, 0, 0, 0);
    __builtin_amdgcn_s_setprio(0);
}
__device__ __forceinline__ void pack_p(bf16x8 (&pf)[4], const f32x16& p0, const f32x16& p1) {
    u32x4 w;
    w.x = cvtpk(p0[0], p0[1]); w.y = cvtpk(p0[2], p0[3]); w.z = cvtpk(p0[4], p0[5]); w.w = cvtpk(p0[6], p0[7]); pf[0] = __builtin_bit_cast(bf16x8, w);
    w.x = cvtpk(p0[8], p0[9]); w.y = cvtpk(p0[10], p0[11]); w.z = cvtpk(p0[12], p0[13]); w.w = cvtpk(p0[14], p0[15]); pf[1] = __builtin_bit_cast(bf16x8, w);
    w.x = cvtpk(p1[0], p1[1]); w.y = cvtpk(p1[2], p1[3]); w.z = cvtpk(p1[4], p1[5]); w.w = cvtpk(p1[6], p1[7]); pf[2] = __builtin_bit_cast(bf16x8, w);
    w.x = cvtpk(p1[8], p1[9]); w.y = cvtpk(p1[10], p1[11]); w.z = cvtpk(p1[12], p1[13]); w.w = cvtpk(p1[14], p1[15]); pf[3] = __builtin_bit_cast(bf16x8, w);
}
template <int NDB> __device__ __forceinline__ void flash_update2(FlashSt<NDB>& st, f32x16& p0, f32x16& p1, unsigned vaddr) {
    VFr vf; v_issue<0>(vf, vaddr);
    const float rm = rowmax32(p0, p1);
    const float mn = fmaxf(st.m, rm), alpha = __builtin_amdgcn_exp2f(st.m - mn);
    st.m = mn;
    float ls = 0.f;
#pragma unroll
    for (int r = 0; r < 16; ++r) { p0[r] = __builtin_amdgcn_exp2f(p0[r] - mn); p1[r] = __builtin_amdgcn_exp2f(p1[r] - mn); ls += p0[r] + p1[r]; }
    st.l = st.l * alpha + ls;
#pragma unroll
    for (int db = 0; db < NDB; ++db)
#pragma unroll
        for (int r = 0; r < 16; ++r) st.o[db][r] *= alpha;
    bf16x8 pf[4]; pack_p(pf, p0, p1);
    LGKM_WAIT0();
    pv2(st.o[0], st.o[1], vf, pf);
    if constexpr (NDB == 4) { v_issue<2>(vf, vaddr); LGKM_WAIT0(); pv2(st.o[2], st.o[3], vf, pf); }
}
__device__ __forceinline__ float max3_(float a, float b, float c) { float r; asm("v_max3_f32 %0, %1, %2, %3" : "=v"(r) : "v"(a), "v"(b), "v"(c)); return r; }
__device__ __forceinline__ float rowmax32_asm(const f32x16& p0, const f32x16& p1) {
    float a = max3_(p0[0], p0[1], p1[0]), b = max3_(p0[2], p0[3], p1[1]); a = max3_(a, p1[2], p1[3]);
#pragma unroll
    for (int r = 4; r < 16; r += 4) { a = max3_(a, p0[r], p0[r + 1]); b = max3_(b, p0[r + 2], p0[r + 3]); a = max3_(a, p1[r], p1[r + 1]); b = max3_(b, p1[r + 2], p1[r + 3]); }
    float m; asm("v_max_f32_e32 %0, %1, %2" : "=v"(m) : "v"(a), "v"(b));
    auto rr = __builtin_amdgcn_permlane32_swap(__float_as_uint(m), __float_as_uint(m), false, false);
    float o; asm("v_max_f32_e32 %0, %1, %2" : "=v"(o) : "v"(__uint_as_float(rr[0])), "v"(__uint_as_float(rr[1]))); return o;
}
constexpr float FA_THR = 8.f;
template <int NDB> __device__ __forceinline__ bool flash_update3(FlashSt<NDB>& st, f32x16& p0, f32x16& p1, unsigned vaddr) {
    VFr vf; v_issue<0>(vf, vaddr);
    asm volatile("s_nop 15\n\ts_nop 7" : "+v"(p0), "+v"(p1));
    const float rm = rowmax32_asm(p0, p1);
    bool moved = false;
    if (__builtin_expect(__builtin_amdgcn_ballot_w64(rm > FA_THR) != 0ull, 0)) {
        const float dl = fmaxf(rm, 0.f), f = __builtin_amdgcn_exp2f(-dl);
        st.m += dl; st.l *= f;
#pragma unroll
        for (int r = 0; r < 16; ++r) { p0[r] -= dl; p1[r] -= dl; }
#pragma unroll
        for (int db = 0; db < NDB; ++db)
#pragma unroll
            for (int r = 0; r < 16; ++r) st.o[db][r] *= f;
        moved = true;
    }
    float ls = 0.f;
#pragma unroll
    for (int r = 0; r < 16; ++r) { p0[r] = __builtin_amdgcn_exp2f(p0[r]); p1[r] = __builtin_amdgcn_exp2f(p1[r]); ls += p0[r] + p1[r]; }
    st.l += ls;
    bf16x8 pf[4]; pack_p(pf, p0, p1);
    LGKM_WAIT0();
    pv2(st.o[0], st.o[1], vf, pf);
    if constexpr (NDB == 4) { v_issue<2>(vf, vaddr); LGKM_WAIT0(); pv2(st.o[2], st.o[3], vf, pf); }
    return moved;
}
__device__ __forceinline__ void pv_only2(f32x16 (&o)[2], unsigned vaddr, const f32x16& p0, const f32x16& p1) {
    VFr vf; v_issue<0>(vf, vaddr); bf16x8 pf[4]; pack_p(pf, p0, p1); LGKM_WAIT0(); pv2(o[0], o[1], vf, pf);
}

__device__ __forceinline__ void fox_unit(unsigned char* lds, unsigned char* ws, int bh, int qb, unsigned* qc, int dry = 0) {
    int tid_o = threadIdx.x; asm volatile("" : "+v"(tid_o));
    const int tid = tid_o, lane = tid & 63, wid = __builtin_amdgcn_readfirstlane(tid >> 6), r32 = lane & 31, hi = lane >> 5;
    const unsigned lds0 = (unsigned)(uintptr_t)lds;
    const lds_cptr L = (lds_cptr)lds;
    const int qrow = 256 * qb + 32 * wid + r32, wrow0 = 256 * qb + 32 * wid;
    const int NTl = 4 * (qb + 1);
    const char* Kg = (const char*)(ws + OFF_KA) + (size_t)bh * 524288 + wid * 1024 + lane * 16;
    const char* Vg = (const char*)(ws + OFF_VA) + (size_t)bh * 524288 + wid * 1024 + lane * 16;
    const char* Cg = (const char*)(ws + OFF_CF) + (size_t)bh * 16384 + lane * 4;
    const unsigned kdst = (unsigned)__builtin_amdgcn_readfirstlane(lds0 + A_KRING + wid * 1024), vdst = (unsigned)__builtin_amdgcn_readfirstlane(lds0 + A_VRING + wid * 1024),
                   cdst = (unsigned)__builtin_amdgcn_readfirstlane(lds0 + A_CFRING + wid * 256);
#define FOX_DMA(t, slot) do { glds16(Kg + (size_t)(t) * 8192, kdst + (slot) * A_SLOT); glds16(Vg + (size_t)(t) * 8192, vdst + (slot) * A_SLOT); glds4(Cg + (size_t)(t) * 256, cdst + (slot) * 2048); } while (0)
    asm volatile("s_waitcnt vmcnt(0)" ::: "memory");
    FOX_DMA(0, 0); FOX_DMA(1, 1);
    bf16x8 qf[4];
    { const bf16* Q = (const bf16*)(ws + OFF_QA) + ((size_t)bh * 4096 + qrow) * 64 + 8 * hi;
#pragma unroll
      for (int d0 = 0; d0 < 4; ++d0) qf[d0] = *(const bf16x8*)(Q + 16 * d0); }
    FlashSt<2> st; flash_init3<2>(st);
    const int vb = lane_vbase(lane);
    const unsigned kaddr0 = lds0 + A_KRING + hi * 1024 + r32 * 16, vaddr0 = lds0 + A_VRING + vb;
    Q_TAKE(qn, qc);
    asm volatile("" : "+v"(qf[0]), "+v"(qf[1]), "+v"(qf[2]), "+v"(qf[3]), "+v"(qn));
    asm volatile("s_waitcnt vmcnt(0)" ::: "memory");
    asm volatile("s_barrier" ::: "memory");
    Q_PARK(qn);
    int slot = 0;
    for (int t = 0; t < NTl; ++t) {
        const int s2 = (slot >= 1) ? slot - 1 : 2;
        if (t + 2 < NTl) FOX_DMA(t + 2, s2);
        if (64 * t <= wrow0 + 31 && dry != 4) {
            f32x16 p0, p1;
            { const unsigned ca = lds0 + A_CFRING + slot * 2048 + wid * 256 + 16 * hi; f32x4 c0, c1, c2, c3, c4, c5, c6, c7;
              DSR128(c0, ca, 0); DSR128(c1, ca, 32); DSR128(c2, ca, 64); DSR128(c3, ca, 96); DSR128(c4, ca, 128); DSR128(c5, ca, 160); DSR128(c6, ca, 192); DSR128(c7, ca, 224);
              LGKM_WAIT0();
              p0 = __builtin_shufflevector(__builtin_shufflevector(c0, c1, 0, 1, 2, 3, 4, 5, 6, 7), __builtin_shufflevector(c2, c3, 0, 1, 2, 3, 4, 5, 6, 7), 0, 1, 2, 3, 4, 5, 6, 7, 8, 9, 10, 11, 12, 13, 14, 15);
              p1 = __builtin_shufflevector(__builtin_shufflevector(c4, c5, 0, 1, 2, 3, 4, 5, 6, 7), __builtin_shufflevector(c6, c7, 0, 1, 2, 3, 4, 5, 6, 7), 0, 1, 2, 3, 4, 5, 6, 7, 8, 9, 10, 11, 12, 13, 14, 15);
              p0 = p0 - st.m; p1 = p1 - st.m; }
            qk_tile2(p0, p1, kaddr0 + slot * A_SLOT, qf);
            if (64 * t + 63 > wrow0) {
                const int kb = 64 * t + 4 * hi;
#pragma unroll
                for (int r = 0; r < 16; ++r) { const int kv = kb + (r & 3) + 8 * (r >> 2); if (kv > qrow) p0[r] = -INFINITY; if (kv + 32 > qrow) p1[r] = -INFINITY; }
            }
            if (dry != 3) (void)flash_update3<2>(st, p0, p1, vaddr0 + slot * A_SLOT); else { st.o[0] += p0; st.o[1] += p1; }
        }
        if (dry == 2) { asm volatile("s_waitcnt lgkmcnt(0)\n\ts_barrier" ::: "memory"); } else if (t + 2 < NTl) { A_WAIT_BAR(3); } else { A_WAIT_BAR(0); }
        slot = (slot == 2) ? 0 : slot + 1;
    }
#undef FOX_DMA
    const float lt = st.l + __shfl_xor(st.l, 32), il = 1.f / lt;
    const int b = bh >> 3, h = bh & 7;
    bf16* Y = (bf16*)(ws + OFF_ZA) + (size_t)(b * 4096 + qrow) * 512 + h * 64;
    bf16* Yd = dry ? (bf16*)(ws + OFF_SELM) + (tid * 64) : Y;
#pragma unroll
    for (int db = 0; db < 2; ++db)
#pragma unroll
        for (int rq = 0; rq < 4; ++rq) { bf16* yp = Y + 32 * db + 8 * rq + 4 * hi; bf16* yo = Yd + 32 * db + 8 * rq + 4 * hi; const u32x2 z = *(const u32x2*)yp;
            const float z0 = __uint_as_float(z.x << 16), z1 = __uint_as_float(z.x & 0xffff0000u), z2 = __uint_as_float(z.y << 16), z3 = __uint_as_float(z.y & 0xffff0000u);
            u32x2 o; o.x = pk2(st.o[db][4 * rq] * il * z0, st.o[db][4 * rq + 1] * il * z1); o.y = pk2(st.o[db][4 * rq + 2] * il * z2, st.o[db][4 * rq + 3] * il * z3);
            *(u32x2*)yo = o; }
}

__device__ __forceinline__ void diff_unit(unsigned char* lds, unsigned char* ws, int bhc, int qb, const float* subg, float lam, float lam_init, unsigned* qc, bool dry = false) {
    int tid_o = threadIdx.x; asm volatile("" : "+v"(tid_o));
    const int tid = tid_o, lane = tid & 63, wid = __builtin_amdgcn_readfirstlane(tid >> 6), r32 = lane & 31, hi = lane >> 5;
    const int map = wid >> 2, wl = wid & 3;
    const unsigned lds0 = (unsigned)(uintptr_t)lds;
    const lds_cptr L = (lds_cptr)lds;
    const int b = bhc >> 2, hc = bhc & 3;
    const int qrow = 128 * qb + 32 * wl + r32, wrow0 = 128 * qb + 32 * wl;
    const int NTl = 2 * (qb + 1);
    const char* Kg = (const char*)(ws + OFF_KC) + (size_t)(b * 8 + hc * 2) * 524288 + wid * 1024 + lane * 16;
    const char* Vg = (const char*)(ws + OFF_VC) + (size_t)bhc * 1048576 + wid * 1024 + lane * 16;
    const unsigned kdst = (unsigned)__builtin_amdgcn_readfirstlane(lds0 + A_KRING + wid * 1024), vdst = (unsigned)__builtin_amdgcn_readfirstlane(lds0 + A_VRING + wid * 1024);
#define DIFF_DMA(t, slot) do { glds16(Kg + (size_t)(t) * 8192, kdst + (slot) * A_SLOT); glds16(Kg + 524288 + (size_t)(t) * 8192, kdst + (slot) * A_SLOT + 8192); \
        glds16(Vg + (size_t)(t) * 16384, vdst + (slot) * A_SLOT); glds16(Vg + (size_t)(t) * 16384 + 8192, vdst + (slot) * A_SLOT + 8192); } while (0)
    asm volatile("s_waitcnt vmcnt(0)" ::: "memory");
    DIFF_DMA(0, 0); DIFF_DMA(1, 1);
    bf16x8 qf[4];
    { const bf16* Q = (const bf16*)(ws + OFF_QC) + ((size_t)(b * 8 + hc * 2 + map) * 4096 + qrow) * 64 + 8 * hi;
#pragma unroll
      for (int d0 = 0; d0 < 4; ++d0) qf[d0] = *(const bf16x8*)(Q + 16 * d0); }
    FlashSt<4> st; flash_init3<4>(st);
    f32x16 negm;
#pragma unroll
    for (int r = 0; r < 16; ++r) negm[r] = 0.f;
    const int vb = lane_vbase(lane);
    const unsigned kaddr0 = lds0 + A_KRING + map * 8192 + hi * 1024 + r32 * 16, vaddr0 = lds0 + A_VRING + vb;
    Q_TAKE(qn, qc);
    asm volatile("" : "+v"(qf[0]), "+v"(qf[1]), "+v"(qf[2]), "+v"(qf[3]), "+v"(qn));
    asm volatile("s_waitcnt vmcnt(0)" ::: "memory");
    asm volatile("s_barrier" ::: "memory");
    Q_PARK(qn);
    int slot = 0;
    for (int t = 0; t < NTl; ++t) {
        const int s2 = (slot >= 1) ? slot - 1 : 2;
        if (t + 2 < NTl) DIFF_DMA(t + 2, s2);
        if (64 * t <= wrow0 + 31) {
            f32x16 p0 = negm, p1 = negm;
            qk_tile2(p0, p1, kaddr0 + slot * A_SLOT, qf);
            if (64 * t + 63 > wrow0) {
                const int kb = 64 * t + 4 * hi;
#pragma unroll
                for (int r = 0; r < 16; ++r) { const int kv = kb + (r & 3) + 8 * (r >> 2); if (kv > qrow) p0[r] = -INFINITY; if (kv + 32 > qrow) p1[r] = -INFINITY; }
            }
            if (flash_update3<4>(st, p0, p1, vaddr0 + slot * A_SLOT)) {
#pragma unroll
                for (int r = 0; r < 16; ++r) negm[r] = -st.m; }
        }
        if (t + 2 < NTl) { A_WAIT_BAR(4); } else { A_WAIT_BAR(0); }
        slot = (slot == 2) ? 0 : slot + 1;
    }
#undef DIFF_DMA
    const float lt = st.l + __shfl_xor(st.l, 32), il = 1.f / lt;
    LAS float* stage = (LAS float*)lds + wl * 4096 + r32;
    if (map == 1) {
#pragma unroll
        for (int db = 0; db < 4; ++db)
#pragma unroll
            for (int r = 0; r < 16; ++r) stage[(32 * db + crow(r, hi)) * 32] = st.o[db][r] * il;
    }
    asm volatile("s_waitcnt lgkmcnt(0)\n\ts_barrier" ::: "memory");
    if (map == 0) {
        float ss = 0.f;
#pragma unroll
        for (int db = 0; db < 4; ++db)
#pragma unroll
            for (int r = 0; r < 16; ++r) { const float v = st.o[db][r] * il - lam * stage[(32 * db + crow(r, hi)) * 32]; st.o[db][r] = v; ss += v * v; }
        ss += __shfl_xor(ss, 32);
        const float rs = rsqrtf(ss * (1.f / 128.f) + EPS) * (1.f - lam_init);
        bf16* Y = (bf16*)(ws + OFF_ZC) + (size_t)(b * 4096 + qrow) * 512 + hc * 128;
        bf16* Yd = dry ? (bf16*)(ws + OFF_SELM) + (tid * 128) : Y;
#pragma unroll
        for (int db = 0; db < 4; ++db)
#pragma unroll
            for (int rq = 0; rq < 4; ++rq) { const int d = 32 * db + 8 * rq + 4 * hi; bf16* yp = Y + d; bf16* yo = Yd + d; const u32x2 z = *(const u32x2*)yp; const f32x4 g = *(const f32x4*)(subg + d);
                const float z0 = __uint_as_float(z.x << 16), z1 = __uint_as_float(z.x & 0xffff0000u), z2 = __uint_as_float(z.y << 16), z3 = __uint_as_float(z.y & 0xffff0000u);
                u32x2 o; o.x = pk2(st.o[db][4 * rq] * rs * g[0] * z0, st.o[db][4 * rq + 1] * rs * g[1] * z1); o.y = pk2(st.o[db][4 * rq + 2] * rs * g[2] * z2, st.o[db][4 * rq + 3] * rs * g[3] * z3);
                *(u32x2*)yo = o; }
    }
    asm volatile("s_waitcnt lgkmcnt(0)\n\ts_barrier" ::: "memory");
}

constexpr int N_SELM = 131072 + 256, N_UMASK = N_SELM + 512, N_SEQC = N_UMASK + 16, N_SEQD = N_SEQC + 80, N_CNT = N_SEQD + 16;
template <int MODE> __device__ __forceinline__ void nsa_ring(FlashSt<2>& st, int& slot, unsigned char* lds, const char* Kg, const char* Vg, int nt, int t0, int t1,
                                                             unsigned kdst, unsigned vdst, int n, int seqoff, const bf16x8 (&qf)[4], int tb, int qloc, unsigned selLo, unsigned selHi, int r32, int hi, int vb) {
    const lds_cptr L = (lds_cptr)lds;
    const LAS unsigned char* seq = (const LAS unsigned char*)(L + seqoff);
    const unsigned lds0r = (unsigned)(uintptr_t)lds;
#define NSA_DMA(j, sl) do { glds16(Kg + (size_t)(j) * 8192, kdst + (sl) * A_SLOT); glds16(Vg + (size_t)(j) * 8192, vdst + (sl) * A_SLOT); } while (0)
#define NSA_DMAT(j, sl) do { glds16(Kg + (OFF_KWIN - OFF_KSEL) + (size_t)(j) * 8192, kdst + (sl) * A_SLOT); glds16(Vg + (OFF_VWIN - OFF_VSEL) + (size_t)(j) * 8192, vdst + (sl) * A_SLOT); } while (0)
    if constexpr (MODE == 0) {
        const int s1 = (slot == 2) ? 0 : slot + 1;
        if (n > 1) { const int j1 = __builtin_amdgcn_readfirstlane((int)seq[1]); NSA_DMA(j1, s1); } else { NSA_DMAT(t0, s1); }
        A_WAIT_BAR(0);
    }
    f32x16 negm;
#pragma unroll
    for (int r = 0; r < 16; ++r) negm[r] = 0.f;
    for (int i = 0; i < n; ++i) {
        const int s2 = (slot >= 1) ? slot - 1 : 2;
        bool issued = false;
        if (i + 2 < n) { const int j2 = __builtin_amdgcn_readfirstlane((int)seq[i + 2]); NSA_DMA(j2, s2); issued = true; }
        else if (MODE == 0 && i + 2 - n < nt) { const int jt = (i + 2 - n == 0) ? t0 : t1; NSA_DMAT(jt, s2); issued = true; }
        const int j = __builtin_amdgcn_readfirstlane((int)seq[i]);
        f32x16 p0 = negm, p1 = negm;
        qk_tile2(p0, p1, lds0r + A_KRING + hi * 1024 + r32 * 16 + slot * A_SLOT, qf);
        if (j == tb) {
#pragma unroll
            for (int r = 0; r < 16; ++r) { const int kv = 4 * hi + (r & 3) + 8 * (r >> 2); if (kv > qloc) p0[r] = -INFINITY; if (kv + 32 > qloc) p1[r] = -INFINITY; }
        } else if (MODE == 0) {
            const bool sel = (((j < 32) ? (selLo >> j) : (selHi >> (j - 32))) & 1u) != 0u;
            if (!sel) {
#pragma unroll
                for (int r = 0; r < 16; ++r) { p0[r] = -INFINITY; p1[r] = -INFINITY; } }
        } else if (j == tb - 8) {
#pragma unroll
            for (int r = 0; r < 16; ++r) { const int kv = 4 * hi + (r & 3) + 8 * (r >> 2); if (kv <= qloc) p0[r] = -INFINITY; if (kv + 32 <= qloc) p1[r] = -INFINITY; }
        }
        if (flash_update3<2>(st, p0, p1, lds0r + A_VRING + vb + slot * A_SLOT)) {
#pragma unroll
            for (int r = 0; r < 16; ++r) negm[r] = -st.m; }
        if (issued) { A_WAIT_BAR(2); } else { A_WAIT_BAR(0); }
        slot = (slot == 2) ? 0 : slot + 1;
    }
#undef NSA_DMA
#undef NSA_DMAT
}
__device__ __forceinline__ void nsa_unit(unsigned char* lds, unsigned char* ws, int bg, int tb, unsigned* qc, bool dry = false) {
    int tid_o = threadIdx.x; asm volatile("" : "+v"(tid_o));
    const int tid = tid_o, lane = tid & 63, wid = __builtin_amdgcn_readfirstlane(tid >> 6), r32 = lane & 31, hi = lane >> 5;
    const unsigned lds0 = (unsigned)(uintptr_t)lds;
    const lds_cptr L = (lds_cptr)lds;
    const int b = bg >> 1, g = bg & 1, h = 4 * g + (wid >> 1), qloc = 32 * (wid & 1) + r32, t = 64 * tb + qloc, row = b * 4096 + t;
    const unsigned kdst = (unsigned)__builtin_amdgcn_readfirstlane(lds0 + A_KRING + wid * 1024), vdst = (unsigned)__builtin_amdgcn_readfirstlane(lds0 + A_VRING + wid * 1024);
    const int vb = lane_vbase(lane);
    LAS float* imp0 = (LAS float*)(L + 32768);
    LAS float* imp1 = (LAS float*)(L + 81920);
    LAS unsigned* selm = (LAS unsigned*)(L + N_SELM);
    LAS unsigned* umask = (LAS unsigned*)(L + N_UMASK);
    const int nvmax = 4 * tb + 3, nct = (nvmax + 63) >> 6;
    asm volatile("s_waitcnt vmcnt(0)" ::: "memory");
    { const char* Kc = (const char*)(ws + OFF_KCMP) + (size_t)bg * 32768 + wid * 1024 + lane * 16; const char* Vc = (const char*)(ws + OFF_VCMP) + (size_t)bg * 32768 + wid * 1024 + lane * 16;
      for (int ct = 0; ct < nct; ++ct) { glds16(Kc + ct * 8192, kdst + ct * 8192); glds16(Vc + ct * 8192, vdst + ct * 8192); } }
    bf16x8 qf[4];
    const bf16* Qp = (const bf16*)(ws + OFF_QB) + ((size_t)(b * 8 + h) * 4096 + t) * 64 + 8 * hi;
#pragma unroll
    for (int d0 = 0; d0 < 4; ++d0) qf[d0] = *(const bf16x8*)(Qp + 16 * d0);
    const float* gt = (const float*)(ws + OFF_GATES) + (size_t)row * 24 + (h & 7) * 3;
    float g0 = gt[0], g1 = gt[1], g2 = gt[2];
    Q_TAKE(qn, qc);
    asm volatile("" : "+v"(qf[0]), "+v"(qf[1]), "+v"(qf[2]), "+v"(qf[3]), "+v"(g0), "+v"(g1), "+v"(g2), "+v"(qn));
    A_WAIT_BAR(0);
    Q_PARK(qn);
    const int nv = (t >= 31) ? ((t - 31) >> 4) + 1 : 0;
    f32x16 y[2];
    {
        float m = -1e30f, l = 0.f;
        for (int ct = 0; ct < nct; ++ct) {
            f32x16 p0, p1;
#pragma unroll
            for (int r = 0; r < 16; ++r) { p0[r] = 0.f; p1[r] = 0.f; }
            qk_tile2(p0, p1, lds0 + A_KRING + hi * 1024 + r32 * 16 + ct * 8192, qf);
            const int cb = 64 * ct + 4 * hi;
#pragma unroll
            for (int r = 0; r < 16; ++r) { const int c = cb + (r & 3) + 8 * (r >> 2); if (c >= nv) p0[r] = -INFINITY; if (c + 32 >= nv) p1[r] = -INFINITY; }
            const float rm = rowmax32(p0, p1), mn = fmaxf(m, rm);
            float ls = 0.f;
#pragma unroll
            for (int r = 0; r < 16; ++r) ls += __builtin_amdgcn_exp2f(p0[r] - mn) + __builtin_amdgcn_exp2f(p1[r] - mn);
            l = l * __builtin_amdgcn_exp2f(m - mn) + ls; m = mn;
        }
        const float lt = l + __shfl_xor(l, 32), il = lt > 0.f ? 1.f / lt : 0.f;
        f32x16 oc[2];
#pragma unroll
        for (int r = 0; r < 16; ++r) { oc[0][r] = 0.f; oc[1][r] = 0.f; }
        float carry = 0.f;
        LAS float* ih = ((wid >> 1) == 0 ? imp0 : imp1 + ((wid >> 1) - 1) * 4096) + qloc * 64;
        const int isw = qloc ^ (hi << 5);
        for (int ct = 0; ct < nct; ++ct) {
            f32x16 p0, p1;
#pragma unroll
            for (int r = 0; r < 16; ++r) { p0[r] = 0.f; p1[r] = 0.f; }
            qk_tile2(p0, p1, lds0 + A_KRING + hi * 1024 + r32 * 16 + ct * 8192, qf);
            const int cb = 64 * ct + 4 * hi;
#pragma unroll
            for (int r = 0; r < 16; ++r) { const int c = cb + (r & 3) + 8 * (r >> 2);
                p0[r] = (c >= nv) ? 0.f : __builtin_amdgcn_exp2f(p0[r] - m) * il; p1[r] = (c + 32 >= nv) ? 0.f : __builtin_amdgcn_exp2f(p1[r] - m) * il; }
            {
                float qs[8], px[8];
#pragma unroll
                for (int k = 0; k < 4; ++k) { qs[k] = (p0[4 * k] + p0[4 * k + 1]) + (p0[4 * k + 2] + p0[4 * k + 3]); qs[4 + k] = (p1[4 * k] + p1[4 * k + 1]) + (p1[4 * k + 2] + p1[4 * k + 3]);
                    px[k] = __shfl_xor(p0[4 * k + 3], 32); px[4 + k] = __shfl_xor(p1[4 * k + 3], 32); }
#pragma unroll
                for (int k = 0; k < 8; ++k) { const float prev = k ? px[k - 1] : carry; ih[(16 * ct + 2 * k + hi) ^ isw] = qs[k] + (hi ? px[k] : prev); }
                carry = px[7];
            }
            pv_only2(oc, lds0 + A_VRING + vb + ct * 8192, p0, p1);
        }
#pragma unroll
        for (int r = 0; r < 16; ++r) { y[0][r] = g0 * oc[0][r]; y[1][r] = g0 * oc[1][r]; }
    }
    asm volatile("s_waitcnt lgkmcnt(0)\n\ts_barrier" ::: "memory");
    const char* KgC = (const char*)(ws + OFF_KSEL) + (size_t)bg * 524288 + wid * 1024 + lane * 16; const char* VgC = (const char*)(ws + OFF_VSEL) + (size_t)bg * 524288 + wid * 1024 + lane * 16;
    glds16(KgC + (size_t)tb * 8192, kdst); glds16(VgC + (size_t)tb * 8192, vdst);
    f32x4 rc[4], rsn[4];
    { const float* cs = (const float*)(ws + OFF_COS) + (size_t)row * 32 + 4 * hi; const float* sn = (const float*)(ws + OFF_SIN) + (size_t)row * 32 + 4 * hi;
#pragma unroll
      for (int d0 = 0; d0 < 4; ++d0) { rc[d0] = *(const f32x4*)(cs + 8 * d0); rsn[d0] = *(const f32x4*)(sn + 8 * d0); } }
    {
        const int q = lane, part = wid, j0 = 8 * part;
        LAS float* s0 = imp0 + q * 64;
        float sc[8];
#pragma unroll
        for (int i = 0; i < 8; ++i) { const int j = j0 + i; const bool forced = (j == 0) || (j == tb) || (j == tb - 1);
            const int c = (j ^ ((j & 1) << 5)) ^ q;
            const float sm = (s0[c] + imp1[q * 64 + c]) + (imp1[4096 + q * 64 + c] + imp1[8192 + q * 64 + c]);
            sc[i] = forced ? 1e30f : (j <= tb ? sm : -1e30f); }
#pragma unroll
        for (int i = 0; i < 8; ++i) { const int j = j0 + i; s0[(j ^ ((j & 1) << 5)) ^ q] = sc[i]; }
        asm volatile("s_waitcnt lgkmcnt(0)\n\ts_barrier" ::: "memory");
        int rank[8];
#pragma unroll
        for (int i = 0; i < 8; ++i) rank[i] = 0;
        const int kend = tb + 1, e1 = j0 < kend ? j0 : kend, e2 = j0 + 8 < kend ? j0 + 8 : kend;
#pragma unroll 4
        for (int k = 0; k < e1; ++k) { const float sk = s0[(k ^ ((k & 1) << 5)) ^ q];
#pragma unroll
            for (int i = 0; i < 8; ++i) rank[i] += (sk >= sc[i]) ? 1 : 0; }
        for (int k = e1; k < e2; ++k) { const float sk = s0[(k ^ ((k & 1) << 5)) ^ q];
#pragma unroll
            for (int i = 0; i < 8; ++i) rank[i] += (sk > sc[i] || (sk == sc[i] && k < j0 + i)) ? 1 : 0; }
#pragma unroll 4
        for (int k = e2; k < kend; ++k) { const float sk = s0[(k ^ ((k & 1) << 5)) ^ q];
#pragma unroll
            for (int i = 0; i < 8; ++i) rank[i] += (sk > sc[i]) ? 1 : 0; }
        unsigned bits = 0u, ub = 0u;
#pragma unroll
        for (int i = 0; i < 8; ++i) { const bool in = rank[i] < 16; bits |= in ? (1u << i) : 0u; ub |= (__builtin_amdgcn_ballot_w64(in) != 0ull) ? (1u << i) : 0u; }
        ((LAS unsigned char*)selm)[q * 8 + part] = (unsigned char)bits;
        if (lane == 0) ((LAS unsigned char*)umask)[part] = (unsigned char)ub;
        asm volatile("s_waitcnt lgkmcnt(0)\n\ts_barrier" ::: "memory");
        if (tid == 0) {
            LAS unsigned char* sq = (LAS unsigned char*)(L + N_SEQC); LAS unsigned char* sd = (LAS unsigned char*)(L + N_SEQD); LAS int* cnt = (LAS int*)(L + N_CNT);
            const unsigned long long um = ((unsigned long long)umask[1] << 32) | umask[0];
            int n = 0; sq[n++] = (unsigned char)tb;
            for (int j = 0; j < tb; ++j) if ((um >> j) & 1ull) sq[n++] = (unsigned char)j;
            cnt[0] = n;
            int n2 = 0; sd[n2++] = (unsigned char)tb;
            for (int j = (tb >= 8 ? tb - 8 : 0); j < tb; ++j) sd[n2++] = (unsigned char)j;
            cnt[1] = n2;
        }
        asm volatile("s_waitcnt lgkmcnt(0)\n\ts_barrier" ::: "memory");
    }
    const unsigned selLo = selm[qloc * 2], selHi = selm[qloc * 2 + 1];
    const int nC = __builtin_amdgcn_readfirstlane(((const LAS int*)(L + N_CNT))[0]), nD = __builtin_amdgcn_readfirstlane(((const LAS int*)(L + N_CNT))[1]);
    {
#pragma unroll
      for (int d0 = 0; d0 < 4; ++d0) { const f32x4 c = rc[d0], s = rsn[d0]; u32x4 w = __builtin_bit_cast(u32x4, qf[d0]); u32x4 o;
#pragma unroll
          for (int e = 0; e < 4; ++e) { const float x1 = __uint_as_float(w[e] << 16), x2 = __uint_as_float(w[e] & 0xffff0000u); o[e] = pk2(x1 * c[e] - x2 * s[e], x2 * c[e] + x1 * s[e]); }
          qf[d0] = __builtin_bit_cast(bf16x8, o); } }
    asm volatile("" : "+v"(qf[0]), "+v"(qf[1]), "+v"(qf[2]), "+v"(qf[3]));
    int slot = 0;
    {
        FlashSt<2> st; flash_init3<2>(st);
        nsa_ring<0>(st, slot, lds, KgC, VgC, nD < 2 ? nD : 2, tb, tb >= 8 ? tb - 8 : 0, kdst, vdst, nC, N_SEQC, qf, tb, qloc, selLo, selHi, r32, hi, vb);
        const float lt = st.l + __shfl_xor(st.l, 32), sc = g1 / lt;
#pragma unroll
        for (int r = 0; r < 16; ++r) { y[0][r] += sc * st.o[0][r]; y[1][r] += sc * st.o[1][r]; }
    }
    {
        FlashSt<2> st; flash_init3<2>(st);
        nsa_ring<1>(st, slot, lds, KgC + (OFF_KWIN - OFF_KSEL), VgC + (OFF_VWIN - OFF_VSEL), 0, 0, 0, kdst, vdst, nD, N_SEQD, qf, tb, qloc, selLo, selHi, r32, hi, vb);
        const float lt = st.l + __shfl_xor(st.l, 32), sc = g2 / lt;
#pragma unroll
        for (int r = 0; r < 16; ++r) { y[0][r] += sc * st.o[0][r]; y[1][r] += sc * st.o[1][r]; }
    }
    bf16* Y = (bf16*)(ws + OFF_ZB) + (size_t)row * 512 + h * 64;
    bf16* Yd = dry ? (bf16*)(ws + OFF_SELM) + (tid * 64) : Y;
#pragma unroll
    for (int db = 0; db < 2; ++db)
#pragma unroll
        for (int rq = 0; rq < 4; ++rq) { bf16* yp = Y + 32 * db + 8 * rq + 4 * hi; bf16* yo = Yd + 32 * db + 8 * rq + 4 * hi; const u32x2 z = *(const u32x2*)yp;
            const float z0 = __uint_as_float(z.x << 16), z1 = __uint_as_float(z.x & 0xffff0000u), z2 = __uint_as_float(z.y << 16), z3 = __uint_as_float(z.y & 0xffff0000u);
            u32x2 o; o.x = pk2(y[db][4 * rq] * z0, y[db][4 * rq + 1] * z1); o.y = pk2(y[db][4 * rq + 2] * z2, y[db][4 * rq + 3] * z3);
            *(u32x2*)yo = o; }
}

__device__ __forceinline__ void compress_unit(unsigned char* lds, unsigned char* ws, int kv, int bg, int rc) {
    int tid_o = threadIdx.x; asm volatile("" : "+v"(tid_o));
    const int tid = tid_o, lane = tid & 63, wid = __builtin_amdgcn_readfirstlane(tid >> 6), r32 = lane & 31, hi = lane >> 5;
    const unsigned lds0 = (unsigned)(uintptr_t)lds;
    { const char* Ab = (const char*)(ws + (kv ? OFF_VCB : OFF_KCB)) + ((size_t)bg * 4096 + 512 * rc) * 128;
      asm volatile("s_waitcnt vmcnt(0)" ::: "memory");
#pragma unroll
      for (int i = 0; i < 9; ++i) { const int q = (i * 8 + wid) * 64 + lane, blk = q / 129, qq = q - blk * 129; const int sg = blk * 128 + (qq < 128 ? qq : 127);
          glds16(Ab + (size_t)sg * 16, (unsigned)__builtin_amdgcn_readfirstlane(lds0 + (i * 8 + wid) * 1024)); }
      asm volatile("s_waitcnt vmcnt(0)\n\ts_barrier" ::: "memory"); }
    const bf16* Bp = (const bf16*)(ws + OFF_CW1) + (size_t)kv * 256 * 2048 + ((size_t)wid * 128 * 64 + lane) * 8;
    const lds_cptr Al = (lds_cptr)lds + 2064 * r32 + 16 * hi;
    f32x16 acc;
#pragma unroll
    for (int r = 0; r < 16; ++r) acc[r] = 0.f;
#pragma unroll 8
    for (int l = 0; l < 32; ++l) {
        const lds_cptr ap = Al + l * 128 + (l >> 4) * 16;
#pragma unroll
        for (int q = 0; q < 4; ++q) {
            const bf16x8 a = *(const LAS bf16x8*)(ap + q * 32), w = *(const bf16x8*)(Bp + (size_t)(4 * l + q) * 512);
            acc = __builtin_amdgcn_mfma_f32_32x32x16_bf16(w, a, acc, 0, 0, 0);
        }
    }
    const float* cb = (const float*)(ws + OFF_CB1) + kv * 256 + 32 * wid + 4 * hi;
    bf16x8 hf[2];
    { float hv[16];
#pragma unroll
      for (int rq = 0; rq < 4; ++rq) { const f32x4 bb = *(const f32x4*)(cb + 8 * rq);
#pragma unroll
          for (int e = 0; e < 4; ++e) hv[4 * rq + e] = siluf_(acc[4 * rq + e] + bb[e]); }
      u32x4 w0, w1;
      w0.x = pk2(hv[0], hv[1]); w0.y = pk2(hv[2], hv[3]); w0.z = pk2(hv[4], hv[5]); w0.w = pk2(hv[6], hv[7]);
      w1.x = pk2(hv[8], hv[9]); w1.y = pk2(hv[10], hv[11]); w1.z = pk2(hv[12], hv[13]); w1.w = pk2(hv[14], hv[15]);
      hf[0] = __builtin_bit_cast(bf16x8, w0); hf[1] = __builtin_bit_cast(bf16x8, w1); }
    const bf16* W2 = (const bf16*)(ws + OFF_CW2) + (size_t)kv * 64 * 256 + 32 * wid + 4 * hi;
    f32x16 po[2];
#pragma unroll
    for (int dbk = 0; dbk < 2; ++dbk) {
#pragma unroll
        for (int r = 0; r < 16; ++r) po[dbk][r] = 0.f;
#pragma unroll
        for (int s = 0; s < 2; ++s) {
            const bf16* wr = W2 + (size_t)(32 * dbk + r32) * 256 + 16 * s;
            const u32x2 lo = *(const u32x2*)wr, hh = *(const u32x2*)(wr + 8);
            u32x4 wv; wv.x = lo.x; wv.y = lo.y; wv.z = hh.x; wv.w = hh.y;
            po[dbk] = __builtin_amdgcn_mfma_f32_32x32x16_bf16(__builtin_bit_cast(bf16x8, wv), hf[s], po[dbk], 0, 0, 0);
        }
    }
    LAS float* part = (LAS float*)lds;
    __syncthreads();
#pragma unroll
    for (int dbk = 0; dbk < 2; ++dbk)
#pragma unroll
        for (int r = 0; r < 16; ++r) part[(wid * 64 + 32 * dbk + crow(r, hi)) * 32 + r32] = po[dbk][r];
    __syncthreads();
    {
        const int row = tid & 31, d4 = tid >> 5, cc = 32 * rc + row;
        float o[4];
#pragma unroll
        for (int e = 0; e < 4; ++e) { float sum = 0.f;
#pragma unroll
            for (int w = 0; w < 8; ++w) sum += part[(w * 64 + 4 * d4 + e) * 32 + row];
            o[e] = (cc < 255) ? sum : 0.f; }
        bf16* dst = (bf16*)(ws + (kv ? OFF_VCMP : OFF_KCMP)) + (size_t)bg * 16384 + (kv ? vtile_off(cc, 4 * d4) : ktile_off(cc, 4 * d4));
        store_bf<4>(dst, o);
    }
    __syncthreads();
}
__device__ __forceinline__ void cumsum_unit(unsigned char* lds, unsigned char* ws, int bh) {
    int tid_o = threadIdx.x; asm volatile("" : "+v"(tid_o));
    const int tid = tid_o, lane = tid & 63, wid = tid >> 6, b = bh >> 3, h = bh & 7;
    const float* lf = (const float*)(ws + OFF_LOGF) + ((size_t)(b * 4096 + 8 * tid)) * 8 + h;
    float v[8]; float s = 0.f;
#pragma unroll
    for (int i = 0; i < 8; ++i) { s += lf[i * 8]; v[i] = s; }
    float incl = s;
#pragma unroll
    for (int of = 1; of < 64; of <<= 1) { const float t = __shfl_up(incl, of); if (lane >= of) incl += t; }
    LAS float* wsum = (LAS float*)lds;
    __syncthreads();
    if (lane == 63) wsum[wid] = incl;
    __syncthreads();
    float base = incl - s;
    for (int w = 0; w < wid; ++w) base += wsum[w];
    float* cf = (float*)(ws + OFF_CF) + (size_t)bh * 4096 + 8 * tid;
    f32x4 o0 = {-(base + v[0]), -(base + v[1]), -(base + v[2]), -(base + v[3])}, o1 = {-(base + v[4]), -(base + v[5]), -(base + v[6]), -(base + v[7])};
    *(f32x4*)cf = o0; *(f32x4*)(cf + 4) = o1;
    __syncthreads();
}

constexpr size_t OFF_BAR = OFF_CTL + 131072;
constexpr size_t OFF_Q = OFF_CTL + 0x28000;
constexpr int LDS_BARST = 131072 + 64;
#define XB_TMO      128
#define XB_XCNT(j)  (256  + 64 * (j))
#define XB_XSUB(j)  (1280 + 64 * (j))
#define XB_XGEN(j)  (2304 + 64 * (j))
#define XB_TOP      3328
#define XB_TOPGEN   3392
#define XCD_BAR_WORDS 3456
#define XB_SPIN_CAP (1u << 18)

__device__ __forceinline__ unsigned xb_ld(unsigned* p)              { return __hip_atomic_load(p, __ATOMIC_RELAXED, __HIP_MEMORY_SCOPE_AGENT); }
__device__ __forceinline__ unsigned xb_add(unsigned* p, unsigned v) { return __hip_atomic_fetch_add(p, v, __ATOMIC_RELAXED, __HIP_MEMORY_SCOPE_AGENT); }
__device__ __forceinline__ unsigned xb_xcc_id() { return (unsigned)__builtin_amdgcn_s_getreg((3 << 11) | 20) & 0xFu; }
#define XB_SPIN(cond, bar) do { unsigned _sp = 0; while (cond) { __builtin_amdgcn_s_sleep(1); \
    if ((++_sp & 255u) == 0u) { if (xb_ld(&(bar)[XB_TMO])) break; if (_sp > XB_SPIN_CAP) { atomicAdd(&(bar)[XB_TMO], 1u); break; } } } } while (0)

struct XcdBarrier {
    unsigned* bar; unsigned x;
    volatile LAS unsigned* st;
};

__device__ __forceinline__ XcdBarrier xcd_barrier_post(unsigned* bar, volatile LAS unsigned* st) {
    XcdBarrier b; b.bar = bar; b.x = xb_xcc_id(); b.st = st;
    if (threadIdx.x == 0) (void)xb_add(&bar[XB_XCNT(b.x)], 1u);
    return b;
}
__device__ __forceinline__ void xcd_barrier_complete(unsigned* bar, unsigned x, unsigned& nloc, unsigned& nx) {
    const unsigned G = gridDim.x * gridDim.y * gridDim.z;
    unsigned sum, cnt, mine, sp = 0u;
    for (;;) {
        sum = 0u; cnt = 0u; mine = 0u;
#pragma unroll
        for (unsigned j = 0; j < 16; ++j) { const unsigned c = xb_ld(&bar[XB_XCNT(j)]); sum += c; cnt += (c > 0u) ? 1u : 0u; mine = (j == x) ? c : mine; }
        if (sum == G) break;
        __builtin_amdgcn_s_sleep(1);
        if ((++sp & 255u) == 0u) { if (xb_ld(&bar[XB_TMO])) break; if (sp > XB_SPIN_CAP) { atomicAdd(&bar[XB_TMO], 1u); break; } }
    }
    nloc = mine > 0u ? mine : 1u; nx = cnt > 0u ? cnt : 1u;
}

__device__ __forceinline__ void xcd_barrier(const XcdBarrier& b) {
    asm volatile("s_waitcnt vmcnt(0)" ::: "memory");
    __syncthreads();
    if (threadIdx.x == 0) {
        unsigned* bar = b.bar;
        __builtin_amdgcn_s_waitcnt(0);
        unsigned nloc = b.st[0], nx = b.st[1];
        if (nloc == 0u) { xcd_barrier_complete(bar, b.x, nloc, nx); b.st[0] = nloc; b.st[1] = nx; }
        const unsigned old = xb_add(&bar[XB_XSUB(b.x)], 1u);
        const unsigned gen = old / nloc;
        if (old + 1u == (gen + 1u) * nloc) {
            __builtin_amdgcn_fence(__ATOMIC_RELEASE, "agent");
            asm volatile("s_waitcnt vmcnt(0)" ::: "memory");
            const unsigned og = xb_add(&bar[XB_TOP], 1u);
            const unsigned tg = og / nx;
            if (og + 1u == (tg + 1u) * nx) xb_add(&bar[XB_TOPGEN], 1u);
            else XB_SPIN(xb_ld(&bar[XB_TOPGEN]) == tg, bar);
            __builtin_amdgcn_fence(__ATOMIC_ACQUIRE, "agent");
            xb_add(&bar[XB_XGEN(b.x)], 1u);
            asm volatile("s_waitcnt vmcnt(0)" ::: "memory");
        } else {
            XB_SPIN(xb_ld(&bar[XB_XGEN(b.x)]) == gen, bar);
            __builtin_amdgcn_fence(__ATOMIC_ACQUIRE, "agent");
            asm volatile("s_waitcnt vmcnt(0)" ::: "memory");
        }
    }
    __syncthreads();
}

struct KArgs;
__device__ __forceinline__ void conv_tile(bool active, float (*tile)[65], int vt, const float* src, int ld, int K, bf16* dst, const float* kscale, int mode, int bx, int by) {
    const int n0 = bx * 64, k0 = by * 64, tx = vt & 63, ty = vt >> 6;
    const int n = n0 + tx;
    const int sc = (mode == 0 || mode == 3) ? n : mode == 1 ? win_srccol(n) : (n & ~63) + ((n & 1) << 5) + ((n & 63) >> 1);
    if (active) {
        float v[16];
#pragma unroll
        for (int i = 0; i < 16; ++i) v[i] = (sc >= 0) ? src[(size_t)(k0 + 4 * i + ty) * ld + sc] : 0.f;
        if (kscale) {
#pragma unroll
            for (int i = 0; i < 16; ++i) v[i] *= kscale[k0 + 4 * i + ty]; }
#pragma unroll
        for (int i = 0; i < 16; ++i) tile[tx][4 * i + ty] = v[i];
    }
    __syncthreads();
    if (active) {
#pragma unroll
        for (int p = 0; p < 2; ++p) { const int it = vt + 256 * p, r = it >> 3, c = it & 7; const float* t = &tile[r][8 * c];
            u32x4 o; o.x = pk2(t[0], t[1]); o.y = pk2(t[2], t[3]); o.z = pk2(t[4], t[5]); o.w = pk2(t[6], t[7]);
            const int nn = n0 + r, kk = k0 + 8 * c;
            if (mode == 3) *(u32x4*)(dst + ((size_t)((nn >> 5) * (K >> 4) + (kk >> 4)) * 64 + (nn & 31) + 32 * ((kk & 15) >> 3)) * 8) = o;
            else *(u32x4*)(dst + (size_t)nn * K + kk) = o; }
    }
    __syncthreads();
}
namespace cg = cooperative_groups;
constexpr int NT = 512;
constexpr int LDS_BYTES = 147456;
struct KArgs { const void* in[23]; float* out; unsigned char* ws; };

#define OPAQUE_TID() int tid = threadIdx.x; asm volatile("" : "+v"(tid))
#define VRUN(VT, NVB, CALL) do { OPAQUE_TID(); constexpr int per_ = NT / (VT); for (int vb = blockIdx.x * per_ + tid / (VT); vb < (NVB); vb += gridDim.x * per_) { const int vt = tid % (VT); CALL; } } while (0)
#define VRUN_BAR(NVB, CALL) do { OPAQUE_TID(); float (*tile)[65] = (float (*)[65])(lds + (tid >> 8) * 64 * 65 * 4); (void)tile; const int nvb_ = (NVB); for (int it_ = 0; it_ * (int)gridDim.x * 2 < nvb_; ++it_) { const int vb = (it_ * (int)gridDim.x + (int)blockIdx.x) * 2 + (tid >> 8); const int vt = tid & 255; const bool active = vb < nvb_; CALL; } } while (0)

#ifndef REP_U
#define REP_U 0
#endif
#ifndef REP_SYNC
#define REP_SYNC 0
#endif
#ifndef REP_SUMSQ
#define REP_SUMSQ 0
#endif
#ifndef REP_P0
#define REP_P0 0
#endif
#ifndef REP_PRO
#define REP_PRO 0
#endif
#ifndef REP_INPROJ
#define REP_INPROJ 0
#endif
#ifndef REP_P2
#define REP_P2 0
#endif
#ifndef REP_FOX
#define REP_FOX 0
#endif
#ifndef REP_DIFF
#define REP_DIFF 0
#endif
#ifndef REP_NSA
#define REP_NSA 0
#endif
#ifndef REP_GATEBR
#define REP_GATEBR 0
#endif
#ifndef REP_OUT
#define REP_OUT 0
#endif
#ifndef DO_ALL
#define DO_ALL 1
#endif
#ifndef DO_PRO
#define DO_PRO DO_ALL
#endif
#ifndef DO_INPROJ
#define DO_INPROJ DO_ALL
#endif
#ifndef DO_P2
#define DO_P2 DO_ALL
#endif
#ifndef DO_ATTN
#define DO_ATTN DO_ALL
#endif
#ifndef DO_GATEBR
#define DO_GATEBR DO_ALL
#endif
#ifndef DO_OUT
#define DO_OUT DO_ALL
#endif
#ifndef DO_PLE
#define DO_PLE DO_ALL
#endif
#ifndef DO_TAIL
#define DO_TAIL DO_ALL
#endif
__global__ void __launch_bounds__(NT) mega(KArgs a) {
    extern __shared__ __attribute__((aligned(16))) unsigned char lds[];
    cg::grid_group grid = cg::this_grid();
    { volatile LAS unsigned* st0 = (volatile LAS unsigned*)((LAS unsigned char*)lds + LDS_BARST); if (threadIdx.x < 2) st0[threadIdx.x] = 0u; }
    __syncthreads();
    const XcdBarrier xbar = xcd_barrier_post((unsigned*)(a.ws + OFF_BAR), (volatile LAS unsigned*)((LAS unsigned char*)lds + LDS_BARST));
#define GSYNC() xcd_barrier(xbar)
    unsigned char* ws = a.ws; float* X = a.out;
    typedef const KArgs __attribute__((address_space(4)))* kargp_t;
#define KIN(i) ([&]() { kargp_t kp_ = (kargp_t)__builtin_amdgcn_kernarg_segment_ptr(); asm volatile("" : "+s"(kp_)); return kp_->in[i]; }())
#define I_x ((const float*)KIN(0))
#define I_p ((const float*)KIN(1))
#define I_pos ((const int*)KIN(2))
#define I_norm_g ((const float*)KIN(3))
#define I_w_in ((const float*)KIN(4))
#define I_b_forget ((const float*)KIN(5))
#define I_pe_k ((const float*)KIN(6))
#define I_w1_k ((const float*)KIN(7))
#define I_b1_k ((const float*)KIN(8))
#define I_w2_k ((const float*)KIN(9))
#define I_pe_v ((const float*)KIN(10))
#define I_w1_v ((const float*)KIN(11))
#define I_b1_v ((const float*)KIN(12))
#define I_w2_v ((const float*)KIN(13))
#define I_diff_lam ((const float*)KIN(14))
#define I_subln ((const float*)KIN(15))
#define I_w_out ((const float*)KIN(19))
#define I_w_ple ((const float*)KIN(20))
#define I_w_pg ((const float*)KIN(21))
#define I_final_g ((const float*)KIN(22))
#if DO_PRO
    for (int rep0_ = 0; rep0_ <= REP_P0; ++rep0_) {
    VRUN(256, M / 4, d_xprep(vb, vt, I_x, ws));
    VRUN(256, M * 32 / 256, d_rope_table(vb, vt, I_pos, ws));
    VRUN(256, (2 * M * 256 / 4) / 256, d_pconv(vb, vt, I_p, ws));
    for (int l = 0; l < DEPTH; ++l) {
        { OPAQUE_TID(); if (blockIdx.x == 0 && tid < 64) d_lam(tid, I_diff_lam + l * 256, ws, l); }
    }
    }
#endif
    for (int l = 0; l < DEPTH; ++l) {
        const float* wl = I_w_in + (size_t)l * 1024 * NIN; const float* ng = I_norm_g + l * 1024;
#if DO_PRO
        for (int rep_ = 0; rep_ <= REP_PRO; ++rep_) {
        { OPAQUE_TID(); float (*tile)[65] = (float (*)[65])(lds + (tid >> 8) * 64 * 65 * 4);
          const int njobs = 2952 + (l == 0 ? 1152 : 0);
          for (int it_ = 0; it_ * (int)gridDim.x * 2 < njobs; ++it_) {
              int j = (it_ * (int)gridDim.x + (int)blockIdx.x) * 2 + (tid >> 8); const bool active = j < njobs;
              const float* src = wl; int ld = NIN, K = 1024, mode = 1, bx = 0, by = 0; bf16* dst = (bf16*)(ws + OFF_WIN); const float* ks = ng;
              if (j < 1536) { bx = j % 96; by = j / 96; }
              else if (j < 2304) { j -= 1536; bx = j % 48; by = j / 48; src = wl + 5920; mode = 0; dst = (bf16*)(ws + OFF_WMG); }
              else if (j < 2688) { j -= 2304; const int i = j >> 7, r = j & 127; bx = r & 15; by = r >> 4; src = (const float*)KIN(16 + i) + (size_t)l * 512 * 1024; ld = 1024; K = 512; mode = 0; dst = (bf16*)(ws + OFF_WBR) + (size_t)i * 1024 * 512; ks = nullptr; }
              else if (j < 2944) { j -= 2688; const int kv = j >> 7, r = j & 127; bx = r & 3; by = r >> 2; src = (kv ? I_w1_v : I_w1_k) + (size_t)l * 2048 * 256; ld = 256; K = 2048; mode = 3; dst = (bf16*)(ws + OFF_CW1) + (size_t)kv * 256 * 2048; ks = nullptr; }
              else if (j < 2952) { j -= 2944; const int kv = j >> 2; by = j & 3; src = (kv ? I_w2_v : I_w2_k) + (size_t)l * 256 * 64; ld = 64; K = 256; mode = kv ? 0 : 2; dst = (bf16*)(ws + OFF_CW2) + (size_t)kv * 64 * 256; ks = nullptr; }
              else { j -= 2952; const int ll = j / 576, r = j % 576; ld = 1024; mode = 0; ks = nullptr;
                  if (r < 256) { bx = r & 15; by = r >> 4; src = I_w_out + (size_t)ll * 1024 * 1024; dst = (bf16*)(ws + OFF_WOUT) + (size_t)ll * 1024 * 1024; }
                  else if (r < 512) { const int r2 = r - 256; bx = r2 & 15; by = r2 >> 4; src = I_w_pg + (size_t)ll * 1024 * 1024; dst = (bf16*)(ws + OFF_WPG) + (size_t)ll * 1024 * 1024; }
                  else { const int r2 = r - 512; bx = r2 & 15; by = r2 >> 4; src = I_w_ple + (size_t)ll * 256 * 1024; K = 256; dst = (bf16*)(ws + OFF_WPL) + (size_t)ll * 1024 * 256; } }
              conv_tile(active, tile, tid & 255, src, ld, K, dst, ks, mode, bx, by);
          } }
        { OPAQUE_TID(); if (blockIdx.x >= 64 && blockIdx.x < 96 && tid < 256) d_cb1_part(blockIdx.x - 64, tid, I_pe_k + l * 2048, I_w1_k + (size_t)l * 2048 * 256, I_pe_v + l * 2048, I_w1_v + (size_t)l * 2048 * 256, ws); }
        }
#endif
        if (l == 0) grid.sync(); else GSYNC();
        EpiCtx E{ws, I_b_forget + l * 8, l == 0 ? I_x : X, X, 0};
#if DO_INPROJ
        { OPAQUE_TID(); if (blockIdx.x == 0) d_cb1_sum(tid, I_b1_k + l * 256, I_b1_v + l * 256, ws); }
        for (int rep_ = 0; rep_ <= REP_INPROJ; ++rep_) { FAST_GEMM(EPI_INPROJ, ws + OFF_XB, ws + OFF_WIN, NP, 1024, true); }
#endif
        GSYNC();
#if DO_ATTN
        { OPAQUE_TID();
          unsigned* qc = (unsigned*)(ws + OFF_Q) + 64 * l; unsigned* p2c = (unsigned*)(ws + OFF_Q) + 64 * (2 + l);
          const float lam = ((const float*)(ws + OFF_CTL))[CTL_LAM + l], lam_init = 0.8f - 0.6f * expf(-0.3f * (float)l);
          if (tid == 0) *(volatile LAS unsigned*)((LAS unsigned char*)lds + LDS_QSLOT) = xb_add(qc, 1u);
          bool p2seen = false;
          for (;;) {
              __syncthreads();
              const int u = __builtin_amdgcn_readfirstlane((int)*(volatile LAS unsigned*)((LAS unsigned char*)lds + LDS_QSLOT));
              if (u >= 1696) break;
              if (u < 160) {
                  if (u < 128) compress_unit(lds, ws, u >> 6, (u >> 3) & 7, u & 7); else cumsum_unit(lds, ws, u - 128);
                  asm volatile("s_waitcnt vmcnt(0)" ::: "memory");
                  __syncthreads();
                  if (tid == 0) { __builtin_amdgcn_fence(__ATOMIC_RELEASE, "agent"); asm volatile("s_waitcnt vmcnt(0)" ::: "memory"); (void)xb_add(p2c, 1u);
                                  *(volatile LAS unsigned*)((LAS unsigned char*)lds + LDS_QSLOT) = xb_add(qc, 1u); }
              } else if (u < 672) { const int v = u - 160; diff_unit(lds, ws, v & 15, 31 - (v >> 4), I_subln + l * 128, lam, lam_init, qc); }
              else {
                  if (!p2seen) {
                      if (tid == 0) { XB_SPIN(xb_ld(p2c) < 160u, xbar.bar); __builtin_amdgcn_fence(__ATOMIC_ACQUIRE, "agent"); asm volatile("s_waitcnt vmcnt(0)" ::: "memory"); }
                      __syncthreads(); p2seen = true; }
                  const int w = u - 672, qb = 15 - (w >> 6), r = w & 63;
                  if (r < 32) fox_unit(lds, ws, r, qb, qc); else nsa_unit(lds, ws, (r - 32) & 7, 4 * qb + 3 - ((r - 32) >> 3), qc);
              }
          }
        }
#endif
        GSYNC();
#if DO_GATEBR
        for (int rep_ = 0; rep_ <= REP_GATEBR; ++rep_) {
        { pg8::Gemm g_{(const pg8::bf16_t*)(ws + OFF_XB), (const pg8::bf16_t*)(ws + OFF_WMG), M, 3072, 1024}; ChainOrder S_; S_.init((int)gridDim.x, (int)blockIdx.x, 0);
          EpiFast<EPI_GATE3> Ep_{E}; pg8::gemm_phase<EpiFast<EPI_GATE3>, ChainOrder, true, true>((PG8_LAS unsigned char*)lds, g_, S_, Ep_); }
        { pg8::Gemm g_{(const pg8::bf16_t*)(ws + OFF_ZA), (const pg8::bf16_t*)(ws + OFF_WBR), 3 * M, 3072, 512}; ChainOrder S_; S_.init((int)gridDim.x, (int)blockIdx.x, 1);
          EpiFast<EPI_BR3> Ep_{E}; pg8::gemm_phase<EpiFast<EPI_BR3>, ChainOrder, true, true>((PG8_LAS unsigned char*)lds, g_, S_, Ep_); }
        }
#endif
        GSYNC();
#if DO_OUT
        for (int rep_ = 0; rep_ <= (l == 0 ? REP_OUT : 0); ++rep_) FAST_GEMM(EPI_OUT, (const bf16*)(ws + OFF_MERGED), (const bf16*)(ws + OFF_WOUT) + (size_t)l * 1024 * 1024, 1024, 1024, false);
#endif
        GSYNC();
#if DO_PLE
        for (int rep_ = 0; rep_ <= REP_U; ++rep_) FAST_GEMM(EPI_U, (const bf16*)(ws + OFF_PB) + (size_t)l * M * 256, (const bf16*)(ws + OFF_WPL) + (size_t)l * 1024 * 256, 1024, 256, false);
        FAST_GEMM(EPI_PLE, (const bf16*)(ws + OFF_X1B), (const bf16*)(ws + OFF_WPG) + (size_t)l * 1024 * 1024, 1024, 1024, false);
#endif
        GSYNC();
#if DO_TAIL
        for (int rep_ = 0; rep_ < 10 * REP_SYNC; ++rep_) GSYNC();
        for (int rep_ = 0; rep_ <= REP_SUMSQ; ++rep_) { if (l + 1 < DEPTH) VRUN(256, M / 4, d_sumsq(vb, vt, X, ws)); }
#endif
    }
#if DO_TAIL
    VRUN(256, M / 4, d_final(vb, vt, X, I_final_g));
#endif
}
#undef I_x
#undef I_p
#undef I_pos
#undef I_norm_g
#undef I_w_in
#undef I_b_forget
#undef I_pe_k
#undef I_w1_k
#undef I_b1_k
#undef I_w2_k
#undef I_pe_v
#undef I_w1_v
#undef I_b1_v
#undef I_w2_v
#undef I_diff_lam
#undef I_subln
#undef I_w_out
#undef I_w_ple
#undef I_w_pg
#undef I_final_g
#undef KIN

extern "C" void kernel_launch(void* const* d_in, const int* in_sizes, int n_in, void* d_out, int out_size, void* d_ws, size_t ws_size, hipStream_t stream) {
    static int grid_blocks = 0;
    if (grid_blocks == 0) {
        if (n_in != 23 || ws_size < WS_NEED || out_size != M * DM) { fprintf(stderr, "kernel_launch: unexpected sizes (n_in %d ws %zu out %d)\n", n_in, ws_size, out_size); grid_blocks = -1; return; }
        int dev = 0, cus = 0, per_cu = 0;
        (void)hipGetDevice(&dev); (void)hipDeviceGetAttribute(&cus, hipDeviceAttributeMultiprocessorCount, dev);
        (void)hipFuncSetAttribute((const void*)mega, hipFuncAttributeMaxDynamicSharedMemorySize, LDS_BYTES);
        (void)hipOccupancyMaxActiveBlocksPerMultiprocessor(&per_cu, (const void*)mega, NT, LDS_BYTES);
        if (per_cu < 1) { fprintf(stderr, "kernel_launch: occupancy query says %d blocks per CU\n", per_cu); grid_blocks = -1; return; }
        grid_blocks = cus * 1;
        if (grid_blocks != 256) { fprintf(stderr, "kernel_launch: built for a 256-CU device (got %d)\n", cus); grid_blocks = -1; return; }
    }
    if (grid_blocks < 0) return;
    (void)hipMemsetAsync((char*)d_ws + OFF_CTL, 0, 262144, stream);
    KArgs a{};
    for (int i = 0; i < 23; ++i) a.in[i] = d_in[i];
    a.out = (float*)d_out; a.ws = (unsigned char*)d_ws;
    void* args[] = {&a};
    hipError_t e = hipLaunchCooperativeKernel((const void*)mega, dim3(grid_blocks), dim3(NT), args, LDS_BYTES, stream);
    if (e != hipSuccess) fprintf(stderr, "cooperative launch failed: %s (grid %d)\n", hipGetErrorString(e), grid_blocks);
}
```
